# Optimizing an MI355X kernel written in HIP

```python
import jax, jax.numpy as jnp
from jax import lax
import numpy as np

D_MODEL = 1024
BATCH = 16
SEQ = 256
DEPTH = 2
DEC_BATCH = 8
DEC_SEQ = 2048
PAST_LEN = 256

GRID_W = 64
EPS = 1e-6
MLA_HEADS = 4
Q_LORA = 384
KV_LORA = 256
QK_NOPE = 128
QK_ROPE = 64
V_HEAD = 128
MLA_WIDTH = MLA_HEADS * V_HEAD
ROPE_BASE = 10000.0
Q_BLOCK = 128
LRU_WIDTH = 512
LRU_BLOCKS = 4
LRU_BLOCK = LRU_WIDTH // LRU_BLOCKS
CONV_W = 4
CONV_LEFT = 2
LRU_C = 8.0
IN_COLS = Q_LORA + KV_LORA + QK_ROPE + 2 * LRU_WIDTH
IN_SPLITS = (Q_LORA, Q_LORA + KV_LORA, Q_LORA + KV_LORA + QK_ROPE, Q_LORA + KV_LORA + QK_ROPE + LRU_WIDTH)
POOL_WINDOWS = (2, 4, 8, 16)
POOL_GROUP = D_MODEL // len(POOL_WINDOWS)
PEER_HEADS = 8
N_KEYS = 128
N_EXPERTS = N_KEYS * N_KEYS
PEER_DKEY = 256
PEER_TOPK = 16
PEER_CHUNK = 128

kernel_name = "hybrid_diffusion_mla_rglru_pool_peer_step"


def rmsnorm(x, g):
    xf = x.astype(jnp.float32)
    y = xf * lax.rsqrt(jnp.mean(xf * xf, axis=-1, keepdims=True) + EPS)
    return (y * g.astype(jnp.float32)).astype(x.dtype)


def ada_params(cvec, w_mod, b_mod):
    m = jax.nn.silu(cvec) @ w_mod + b_mod
    return jnp.split(m[:, None, :], 6, axis=-1)


def axial_rope(n_tok):
    n_rows = n_tok // GRID_W
    rows = jnp.repeat(jnp.arange(n_rows, dtype=jnp.float32), GRID_W)
    cols = jnp.tile(jnp.arange(GRID_W, dtype=jnp.float32), n_rows)
    axis_dim = QK_ROPE // 2
    inv_freq = ROPE_BASE ** (-jnp.arange(0, axis_dim, 2, dtype=jnp.float32) / axis_dim)
    ang = jnp.concatenate([rows[:, None] * inv_freq, cols[:, None] * inv_freq], axis=-1)
    return jnp.cos(ang), jnp.sin(ang)


def apply_rope(x, cos, sin):
    xf = x.astype(jnp.float32)
    x1, x2 = xf[..., 0::2], xf[..., 1::2]
    rot = jnp.stack([x1 * cos - x2 * sin, x1 * sin + x2 * cos], axis=-1)
    return rot.reshape(x.shape).astype(x.dtype)


def mla_attention(q_nope, q_rope, k_nope, k_rope, v):
    B, Sq, H, _ = q_nope.shape
    nb = Sq // Q_BLOCK
    scale = (QK_NOPE + QK_ROPE) ** -0.5

    def to_blocks(t):
        return jnp.moveaxis(t.reshape(B, nb, Q_BLOCK, *t.shape[2:]), 1, 0)

    def one_block(qs):
        qn, qr = qs
        s = (jnp.einsum('bqhd,bkhd->bhqk', qn, k_nope).astype(jnp.float32)
             + jnp.einsum('bqhd,bkd->bhqk', qr, k_rope).astype(jnp.float32)) * scale
        p = jax.nn.softmax(s, axis=-1).astype(v.dtype)
        return jnp.einsum('bhqk,bkhd->bqhd', p, v)

    out = lax.map(one_block, (to_blocks(q_nope), to_blocks(q_rope)))
    return jnp.moveaxis(out, 0, 1).reshape(B, Sq, H * V_HEAD)


def depthwise_conv(x, w, b):
    S = x.shape[1]
    xp = jnp.pad(x, ((0, 0), (CONV_LEFT, CONV_W - 1 - CONV_LEFT), (0, 0)))
    y = xp[:, 0:S] * w[0]
    for k in range(1, CONV_W):
        y = y + xp[:, k:k + S] * w[k]
    return y + b


def rglru_coeffs(x, w_r, b_r, w_i, b_i, lam):
    B, S, _ = x.shape
    xf = x.astype(jnp.float32)
    xb = xf.reshape(B, S, LRU_BLOCKS, LRU_BLOCK)
    r = jax.nn.sigmoid(jnp.einsum('bsnc,ncd->bsnd', xb, w_r.astype(jnp.float32)).reshape(B, S, LRU_WIDTH) + b_r)
    i = jax.nn.sigmoid(jnp.einsum('bsnc,ncd->bsnd', xb, w_i.astype(jnp.float32)).reshape(B, S, LRU_WIDTH) + b_i)
    log_a = -LRU_C * r * jax.nn.softplus(-lam.astype(jnp.float32))
    a = jnp.exp(log_a)
    bx = jnp.sqrt(-jnp.expm1(2.0 * log_a)) * (i * xf)
    return a, bx


def linear_scan(a, bx, h0, reverse):
    def combine(l, r):
        a_l, b_l = l
        a_r, b_r = r
        return a_l * a_r, a_r * b_l + b_r
    A, Bc = lax.associative_scan(combine, (a, bx), axis=1, reverse=reverse)
    return A * h0[:, None, :] + Bc


def attn_lru_mixer(h, w_in, g_q, w_uq, g_kv, w_ukv, conv_w, conv_b, w_rg, b_rg, w_ig, b_ig, lam, w_o, ctx=None):
    B, S, _ = h.shape
    cq, ckv, krope, ux, ug = jnp.split(h @ w_in, IN_SPLITS, axis=-1)
    q = (rmsnorm(cq, g_q) @ w_uq).reshape(B, S, MLA_HEADS, QK_NOPE + QK_ROPE)
    q_nope, q_rope = q[..., :QK_NOPE], q[..., QK_NOPE:]
    ckv = rmsnorm(ckv, g_kv)
    if ctx is None:
        ckv_keys, krope_keys = ckv, krope
    else:
        ctx_ckv, ctx_krope, ctx_lru = ctx
        cos, sin = axial_rope(S)
        q_rope = apply_rope(q_rope, cos[:, None, :], sin[:, None, :])
        ckv_keys = jnp.concatenate([ctx_ckv.astype(ckv.dtype), ckv], axis=1)
        krope_keys = jnp.concatenate([ctx_krope.astype(krope.dtype), apply_rope(krope, cos, sin)], axis=1)
    Sk = ckv_keys.shape[1]
    kv = (ckv_keys @ w_ukv).reshape(B, Sk, MLA_HEADS, QK_NOPE + V_HEAD)
    attn = mla_attention(q_nope, q_rope, kv[..., :QK_NOPE], krope_keys, kv[..., QK_NOPE:])
    xc = depthwise_conv(ux, conv_w, conv_b)
    a_f, b_f = rglru_coeffs(xc, w_rg[0], b_rg[0], w_ig[0], b_ig[0], lam[0])
    a_b, b_b = rglru_coeffs(xc, w_rg[1], b_rg[1], w_ig[1], b_ig[1], lam[1])
    if ctx is None:
        h0_f = jnp.zeros((B, LRU_WIDTH), jnp.float32)
        h0_b = jnp.zeros((B, LRU_WIDTH), jnp.float32)
    else:
        h0_f = ctx_lru[:, 0].astype(jnp.float32)
        h0_b = ctx_lru[:, 1].astype(jnp.float32)
    h_f = linear_scan(a_f, b_f, h0_f, reverse=False)
    h_b = linear_scan(a_b, b_b, h0_b, reverse=True)
    rec = ((h_f + h_b) * jax.nn.gelu(ug.astype(jnp.float32))).astype(attn.dtype)
    out = jnp.concatenate([attn, rec], axis=-1) @ w_o
    if ctx is None:
        return out, (ckv, krope, jnp.stack([h_f[:, -1], h_b[:, 0]], axis=1))
    return out, None


def pool_mixer(h, w_pool, s_pool):
    B, S, _ = h.shape
    hf = h.astype(jnp.float32)
    cs = jnp.pad(jnp.cumsum(hf, axis=1), ((0, 0), (1, 0), (0, 0)))
    t = jnp.arange(S)
    outs = []
    for g, w in enumerate(POOL_WINDOWS):
        lo = jnp.clip(t - w // 2, 0, S)
        hi = jnp.clip(t + w - w // 2, 0, S)
        csg = cs[..., g * POOL_GROUP:(g + 1) * POOL_GROUP]
        mean = (csg[:, hi] - csg[:, lo]) / (hi - lo).astype(jnp.float32)[None, :, None]
        outs.append(mean - hf[..., g * POOL_GROUP:(g + 1) * POOL_GROUP])
    d = jnp.stack(outs, axis=2)
    y = jnp.einsum('bsgc,gcd->bsgd', d, w_pool.astype(jnp.float32)).reshape(B, S, D_MODEL)
    return (y * s_pool).astype(h.dtype)


def peer_ffn(h, w_q, sub_keys, u, v):
    B, S, D = h.shape
    xs = h.reshape((B * S) // PEER_CHUNK, PEER_CHUNK, D)
    half = PEER_DKEY // 2

    def chunk(xc):
        q = (xc @ w_q).reshape(PEER_CHUNK, PEER_HEADS, 2, half)
        s = jnp.einsum('thpc,hpnc->thpn', q, sub_keys).astype(jnp.float32)
        sv, si = lax.top_k(s, PEER_TOPK)
        cand = sv[..., 0, :, None] + sv[..., 1, None, :]
        cidx = si[..., 0, :, None] * N_KEYS + si[..., 1, None, :]
        fv, fi = lax.top_k(cand.reshape(PEER_CHUNK, PEER_HEADS, PEER_TOPK * PEER_TOPK), PEER_TOPK)
        eidx = jnp.take_along_axis(cidx.reshape(PEER_CHUNK, PEER_HEADS, PEER_TOPK * PEER_TOPK), fi, axis=-1)
        gates = jax.nn.softmax(fv, axis=-1)
        ue = jnp.take(u, eidx, axis=0)
        ve = jnp.take(v, eidx, axis=0)
        act = jax.nn.gelu(jnp.einsum('thkd,td->thk', ue, xc).astype(jnp.float32))
        return jnp.einsum('thk,thkd->td', (gates * act).astype(xc.dtype), ve)

    return lax.map(chunk, xs).reshape(B, S, D)


def setup_inputs(seed: int = 0) -> dict:
    key = jax.random.key(seed)
    ks = iter(jax.random.split(key, 64))

    def nrm(shape, s):
        return jax.random.normal(next(ks), shape, jnp.float32) * s

    def gain(n):
        return 1.0 + nrm((n,), 0.05)

    def lam_init():
        a_c = jax.random.uniform(next(ks), (2, LRU_WIDTH), jnp.float32, 0.9, 0.999)
        a = a_c ** (1.0 / LRU_C)
        return jnp.log(a) - jnp.log1p(-a)

    d_in = D_MODEL ** -0.5
    inp = {}
    inp['x_prompt'] = nrm((BATCH, SEQ, D_MODEL), 1.0)
    inp['x_sample'] = nrm((DEC_BATCH, DEC_SEQ, D_MODEL), 1.0)
    inp['cache_ckv_l0'] = nrm((DEC_BATCH, PAST_LEN, KV_LORA), 1.0)
    inp['cache_krope_l0'] = nrm((DEC_BATCH, PAST_LEN, QK_ROPE), 1.0)
    inp['state_lru_l0'] = nrm((DEC_BATCH, 2, LRU_WIDTH), 0.5)
    inp['c'] = nrm((DEC_BATCH, D_MODEL), 1.0)
    inp['c_ctx'] = nrm((D_MODEL,), 1.0)
    inp['w_mod_l0'] = nrm((D_MODEL, 6 * D_MODEL), 0.5 * d_in)
    inp['b_mod_l0'] = nrm((6 * D_MODEL,), 0.01)
    inp['w_mod_l1'] = nrm((D_MODEL, 6 * D_MODEL), 0.5 * d_in)
    inp['b_mod_l1'] = nrm((6 * D_MODEL,), 0.01)
    inp['g_mix_l0'] = gain(D_MODEL)
    inp['g_ffn_l0'] = gain(D_MODEL)
    inp['g_mix_l1'] = gain(D_MODEL)
    inp['g_ffn_l1'] = gain(D_MODEL)
    inp['w_in_l0'] = nrm((D_MODEL, IN_COLS), d_in)
    inp['g_q_l0'] = gain(Q_LORA)
    inp['w_uq_l0'] = nrm((Q_LORA, MLA_HEADS * (QK_NOPE + QK_ROPE)), Q_LORA ** -0.5)
    inp['g_kv_l0'] = gain(KV_LORA)
    inp['w_ukv_l0'] = nrm((KV_LORA, MLA_HEADS * (QK_NOPE + V_HEAD)), KV_LORA ** -0.5)
    inp['conv_w_l0'] = nrm((CONV_W, LRU_WIDTH), CONV_W ** -0.5)
    inp['conv_b_l0'] = nrm((LRU_WIDTH,), 0.01)
    inp['w_rg_l0'] = nrm((2, LRU_BLOCKS, LRU_BLOCK, LRU_BLOCK), LRU_BLOCK ** -0.5)
    inp['b_rg_l0'] = nrm((2, LRU_WIDTH), 0.01)
    inp['w_ig_l0'] = nrm((2, LRU_BLOCKS, LRU_BLOCK, LRU_BLOCK), LRU_BLOCK ** -0.5)
    inp['b_ig_l0'] = nrm((2, LRU_WIDTH), 0.01)
    inp['lam_l0'] = lam_init()
    inp['w_o_l0'] = nrm((MLA_WIDTH + LRU_WIDTH, D_MODEL), (MLA_WIDTH + LRU_WIDTH) ** -0.5)
    inp['w_pool_l1'] = nrm((len(POOL_WINDOWS), POOL_GROUP, POOL_GROUP), POOL_GROUP ** -0.5)
    inp['s_pool_l1'] = 1.0 + nrm((D_MODEL,), 0.1)
    for l in range(DEPTH):
        inp['peer_wq_l%d' % l] = nrm((D_MODEL, PEER_HEADS * PEER_DKEY), d_in)
        inp['peer_keys_l%d' % l] = nrm((PEER_HEADS, 2, N_KEYS, PEER_DKEY // 2), (PEER_DKEY // 2) ** -0.5)
        inp['peer_u_l%d' % l] = nrm((N_EXPERTS, D_MODEL), d_in)
        inp['peer_v_l%d' % l] = nrm((N_EXPERTS, D_MODEL), PEER_HEADS ** -0.5)
    inp['g_final'] = gain(D_MODEL)
    return inp


def reference(x_prompt, x_sample, cache_ckv_l0, cache_krope_l0, state_lru_l0, c, c_ctx,
              w_mod_l0, b_mod_l0, w_mod_l1, b_mod_l1,
              g_mix_l0, g_ffn_l0, g_mix_l1, g_ffn_l1,
              w_in_l0, g_q_l0, w_uq_l0, g_kv_l0, w_ukv_l0, conv_w_l0, conv_b_l0,
              w_rg_l0, b_rg_l0, w_ig_l0, b_ig_l0, lam_l0, w_o_l0,
              w_pool_l1, s_pool_l1,
              peer_wq_l0, peer_keys_l0, peer_u_l0, peer_v_l0,
              peer_wq_l1, peer_keys_l1, peer_u_l1, peer_v_l1,
              g_final):
    w_mod = (w_mod_l0, w_mod_l1)
    b_mod = (b_mod_l0, b_mod_l1)
    g_mix = (g_mix_l0, g_mix_l1)
    g_ffn = (g_ffn_l0, g_ffn_l1)
    even_mixers = ((w_in_l0, g_q_l0, w_uq_l0, g_kv_l0, w_ukv_l0, conv_w_l0, conv_b_l0,
                    w_rg_l0, b_rg_l0, w_ig_l0, b_ig_l0, lam_l0, w_o_l0),)
    odd_mixers = ((w_pool_l1, s_pool_l1),)
    peers = ((peer_wq_l0, peer_keys_l0, peer_u_l0, peer_v_l0),
             (peer_wq_l1, peer_keys_l1, peer_u_l1, peer_v_l1))

    def trunk(x, cvec, ctx_caches):
        new_state = []
        for layer in range(DEPTH):
            sh_m, sc_m, gt_m, sh_f, sc_f, gt_f = ada_params(cvec, w_mod[layer], b_mod[layer])
            h = rmsnorm(x, g_mix[layer]) * (1.0 + sc_m) + sh_m
            if layer % 2 == 0:
                ctx = None if ctx_caches is None else ctx_caches[layer // 2]
                mix, st = attn_lru_mixer(h, *even_mixers[layer // 2], ctx=ctx)
                if ctx is None:
                    new_state.append(st)
            else:
                mix = pool_mixer(h, *odd_mixers[layer // 2])
            x = x + gt_m * mix
            h = rmsnorm(x, g_ffn[layer]) * (1.0 + sc_f) + sh_f
            x = x + gt_f * peer_ffn(h, *peers[layer])
        return rmsnorm(x, g_final), new_state

    y_prompt, prompt_state = trunk(x_prompt, c_ctx[None, :], None)
    y_sample, _ = trunk(x_sample, c, ((cache_ckv_l0, cache_krope_l0, state_lru_l0),))
    new_ckv_l0, new_krope_l0, new_lru_l0 = prompt_state[0]
    return (y_prompt, y_sample, new_ckv_l0, new_krope_l0, new_lru_l0)
```

```cpp
#include <hip/hip_runtime.h>
#include <hip/hip_cooperative_groups.h>
#include <cstdio>
#include <cstdint>
namespace cg = cooperative_groups;

#ifndef MK_LAUNCHES
#define MK_LAUNCHES 1
#endif

typedef unsigned short bf16_t;
typedef unsigned char u8_t;
typedef float f32x16 __attribute__((ext_vector_type(16)));
typedef float f32x2 __attribute__((ext_vector_type(2)));
typedef unsigned u32x4 __attribute__((ext_vector_type(4)));

#define T_TOK 20480
#define T_CTX 4096
#define R_KEYS 22528
#define NSTAGE 18
#define LAS __attribute__((address_space(3)))

#define XB_TMO      128
#define XB_XCNT(j)  (256  + 64 * (j))
#define XB_XSUB(j)  (1280 + 64 * (j))
#define XB_XGEN(j)  (2304 + 64 * (j))
#define XB_TOP      3328
#define XB_TOPGEN   3392
#define XCD_BAR_WORDS 3456
#define XB_SPIN_CAP (1u << 22)
__device__ __forceinline__ unsigned xb_ld(unsigned* p)              { return __hip_atomic_load(p, __ATOMIC_RELAXED, __HIP_MEMORY_SCOPE_AGENT); }
__device__ __forceinline__ unsigned xb_add(unsigned* p, unsigned v) { return __hip_atomic_fetch_add(p, v, __ATOMIC_RELAXED, __HIP_MEMORY_SCOPE_AGENT); }
__device__ __forceinline__ unsigned xb_xcc_id() { return (unsigned)__builtin_amdgcn_s_getreg((3 << 11) | 20) & 0xFu; }
#define XB_SPIN(cond, bar) do { unsigned _sp = 0; while (cond) { __builtin_amdgcn_s_sleep(1); \
    if ((++_sp & 255u) == 0u) { if (xb_ld(&(bar)[XB_TMO])) break; if (_sp > XB_SPIN_CAP) { atomicAdd(&(bar)[XB_TMO], 1u); break; } } } } while (0)
struct XcdBarrier { unsigned* bar; unsigned x; volatile LAS unsigned* st; };
__device__ __forceinline__ XcdBarrier xcd_barrier_post(unsigned* bar, volatile LAS unsigned* st) {
    XcdBarrier b; b.bar = bar; b.x = xb_xcc_id(); b.st = st;
    if (threadIdx.x == 0) (void)xb_add(&bar[XB_XCNT(b.x)], 1u);
    return b;
}
__device__ __forceinline__ void xcd_barrier_complete(unsigned* bar, unsigned x, unsigned& nloc, unsigned& nx) {
    const unsigned G = gridDim.x * gridDim.y * gridDim.z;
    unsigned sum, cnt, mine, sp = 0u;
    for (;;) {
        sum = 0u; cnt = 0u; mine = 0u;
#pragma unroll
        for (unsigned j = 0; j < 16; ++j) { const unsigned c = xb_ld(&bar[XB_XCNT(j)]); sum += c; cnt += (c > 0u) ? 1u : 0u; mine = (j == x) ? c : mine; }
        if (sum == G) break;
        __builtin_amdgcn_s_sleep(1);
        if ((++sp & 255u) == 0u) { if (xb_ld(&bar[XB_TMO])) break; if (sp > XB_SPIN_CAP) { atomicAdd(&bar[XB_TMO], 1u); break; } }
    }
    nloc = mine > 0u ? mine : 1u; nx = cnt > 0u ? cnt : 1u;
}
__device__ __forceinline__ void xcd_barrier(const XcdBarrier& b) {
    asm volatile("s_waitcnt vmcnt(0)" ::: "memory");
    __syncthreads();
    if (threadIdx.x == 0) {
        unsigned* bar = b.bar;
        __builtin_amdgcn_s_waitcnt(0);
        unsigned nloc = b.st[0], nx = b.st[1];
        if (nloc == 0u) { xcd_barrier_complete(bar, b.x, nloc, nx); b.st[0] = nloc; b.st[1] = nx; }
        const unsigned old = xb_add(&bar[XB_XSUB(b.x)], 1u);
        const unsigned gen = old / nloc;
        if (old + 1u == (gen + 1u) * nloc) {
            __builtin_amdgcn_fence(__ATOMIC_RELEASE, "agent");
            asm volatile("s_waitcnt vmcnt(0)" ::: "memory");
            const unsigned og = xb_add(&bar[XB_TOP], 1u);
            const unsigned tg = og / nx;
            if (og + 1u == (tg + 1u) * nx) xb_add(&bar[XB_TOPGEN], 1u);
            else XB_SPIN(xb_ld(&bar[XB_TOPGEN]) == tg, bar);
            __builtin_amdgcn_fence(__ATOMIC_ACQUIRE, "agent");
            xb_add(&bar[XB_XGEN(b.x)], 1u);
            asm volatile("s_waitcnt vmcnt(0)" ::: "memory");
        } else {
            XB_SPIN(xb_ld(&bar[XB_XGEN(b.x)]) == gen, bar);
            __builtin_amdgcn_fence(__ATOMIC_ACQUIRE, "agent");
            asm volatile("s_waitcnt vmcnt(0)" ::: "memory");
        }
    }
    __syncthreads();
}

struct Params {
    const float *x_prompt, *x_sample, *cache_ckv, *cache_krope, *state_lru, *c, *c_ctx;
    const float *w_mod[2], *b_mod[2], *g_mix[2], *g_ffn[2];
    const float *w_in, *g_q, *w_uq, *g_kv, *w_ukv, *conv_w, *conv_b, *w_rg, *b_rg, *w_ig, *b_ig, *lam, *w_o, *w_pool, *s_pool;
    const float *peer_wq[2], *peer_keys[2], *peer_u[2], *peer_v[2];
    const float* g_final;
    float* out;
    unsigned* bar; float* mod; float* ropetab;
    bf16_t *wt_in, *wt_uq, *wt_ukv, *wt_gate, *wt_o, *wt_pool, *wt_pq[2], *keysb[2];
    u8_t *u8[2], *v8[2]; float *su[2], *sv[2];
    bf16_t *hbuf, *P, *cqn, *ckvk, *kropek, *xc, *ug, *q, *Kn, *vT, *bxb, *qp, *h3;
    float *a, *agg, *xres, *gates; int* eidx;
};

extern __shared__ __attribute__((aligned(16))) unsigned char smem[];

__device__ __forceinline__ float bf2f(bf16_t v) { return __uint_as_float(((unsigned)v) << 16); }
__device__ __forceinline__ bf16_t f2bf(float f) { unsigned u = __float_as_uint(f); u += 0x7fffu + ((u >> 16) & 1u); return (bf16_t)(u >> 16); }
__device__ __forceinline__ float wave_sum(float v) {
    v += __shfl_xor(v, 32); v += __shfl_xor(v, 16); v += __shfl_xor(v, 8); v += __shfl_xor(v, 4); v += __shfl_xor(v, 2); v += __shfl_xor(v, 1); return v;
}
__device__ __forceinline__ float wave_max(float v) {
    v = fmaxf(v, __shfl_xor(v, 32)); v = fmaxf(v, __shfl_xor(v, 16)); v = fmaxf(v, __shfl_xor(v, 8)); v = fmaxf(v, __shfl_xor(v, 4)); v = fmaxf(v, __shfl_xor(v, 2)); v = fmaxf(v, __shfl_xor(v, 1)); return v;
}
__device__ __forceinline__ float gelu_tanh(float x) {
    const float u = 0.7978845608028654f * (x + 0.044715f * x * x * x);
    const float e = __expf(2.f * u);
    const float th = 1.f - 2.f / (e + 1.f);
    return 0.5f * x * (1.f + th);
}
__device__ __forceinline__ float sigmoidf_(float x) { return 1.f / (1.f + __expf(-x)); }
__device__ __forceinline__ float silu_(float x) { return x / (1.f + __expf(-x)); }

struct TokInfo { int smp, b, s, S, mi, keyrow; };
__device__ __forceinline__ TokInfo tokinfo(int T) {
    TokInfo t;
    if (T < T_CTX) { t.smp = 0; t.b = T >> 8; t.s = T & 255; t.S = 256; t.mi = 0; t.keyrow = T; }
    else { const int u = T - T_CTX; t.smp = 1; t.b = u >> 11; t.s = u & 2047; t.S = 2048; t.mi = 1 + t.b; t.keyrow = T_CTX + t.b * 2304 + 256 + t.s; }
    return t;
}
__device__ __forceinline__ const float* x_in_row(const Params& p, int T) { return T < T_CTX ? p.x_prompt + (size_t)T * 1024 : p.x_sample + (size_t)(T - T_CTX) * 1024; }
__device__ __forceinline__ const float* modv(const Params& p, int l, int mi, int j) { return p.mod + ((size_t)(l * 9 + mi) * 6 + j) * 1024; }

__device__ __forceinline__ void unpack8(const uint4 r, float (&f)[8]) {
    f[0] = __uint_as_float(r.x << 16); f[1] = __uint_as_float(r.x & 0xffff0000u);
    f[2] = __uint_as_float(r.y << 16); f[3] = __uint_as_float(r.y & 0xffff0000u);
    f[4] = __uint_as_float(r.z << 16); f[5] = __uint_as_float(r.z & 0xffff0000u);
    f[6] = __uint_as_float(r.w << 16); f[7] = __uint_as_float(r.w & 0xffff0000u);
}

typedef __bf16 bf16x8_t __attribute__((ext_vector_type(8)));
__device__ __forceinline__ int lds_off(int row, int chunk) { return row * 128 + ((chunk ^ ((row >> 1) & 7)) << 4); }
template <int TM, int TN, int WM, int WN>
__device__ __forceinline__ void gemm_acc(const bf16_t* __restrict__ As, int lda, const bf16_t* __restrict__ Bs, int ldb, int K, f32x16 (&acc)[TM][TN]) {
    static_assert(TM * WM == 4 && TN * WN == 4 && WM * WN == 4, "block tile is 128 x 128, 4 waves");
    const int tid = threadIdx.x, lane = tid & 63, wid = tid >> 6, wm = wid / WN, wn = wid % WN, hl = lane >> 5, cl = lane & 31;
#pragma unroll
    for (int i = 0; i < TM; ++i)
#pragma unroll
        for (int j = 0; j < TN; ++j)
#pragma unroll
            for (int r = 0; r < 16; ++r) acc[i][j][r] = 0.f;
    const int srow = tid >> 3, sch = tid & 7;
    const bf16_t* ga = As + (size_t)srow * lda + sch * 8;
    const bf16_t* gb = Bs + (size_t)srow * ldb + sch * 8;
    u32x4 ra[4], rb[4];
#pragma unroll
    for (int i = 0; i < 4; ++i) { ra[i] = *(const u32x4*)(ga + (size_t)(32 * i) * lda); rb[i] = *(const u32x4*)(gb + (size_t)(32 * i) * ldb); }
    __syncthreads();
#pragma unroll
    for (int i = 0; i < 4; ++i) { *(u32x4*)(smem + lds_off(srow + 32 * i, sch)) = ra[i]; *(u32x4*)(smem + 16384 + lds_off(srow + 32 * i, sch)) = rb[i]; }
    __syncthreads();
    const int nk = K >> 6;
    for (int kt = 0; kt < nk; ++kt) {
        const int cur = (kt & 1) * 32768, nxt = 32768 - cur;
        if (kt + 1 < nk) {
#pragma unroll
            for (int i = 0; i < 4; ++i) { ra[i] = *(const u32x4*)(ga + (size_t)(32 * i) * lda + (kt + 1) * 64); rb[i] = *(const u32x4*)(gb + (size_t)(32 * i) * ldb + (kt + 1) * 64); }
        }
#pragma unroll
        for (int ks = 0; ks < 4; ++ks) {
            bf16x8_t af[TM], bfr[TN];
#pragma unroll
            for (int i = 0; i < TM; ++i) af[i] = __builtin_bit_cast(bf16x8_t, *(const u32x4*)(smem + cur + lds_off(32 * (TM * wm + i) + cl, 2 * ks + hl)));
#pragma unroll
            for (int j = 0; j < TN; ++j) bfr[j] = __builtin_bit_cast(bf16x8_t, *(const u32x4*)(smem + cur + 16384 + lds_off(32 * (TN * wn + j) + cl, 2 * ks + hl)));
#pragma unroll
            for (int i = 0; i < TM; ++i)
#pragma unroll
                for (int j = 0; j < TN; ++j) acc[i][j] = __builtin_amdgcn_mfma_f32_32x32x16_bf16(af[i], bfr[j], acc[i][j], 0, 0, 0);
        }
        if (kt + 1 < nk) {
#pragma unroll
            for (int i = 0; i < 4; ++i) { *(u32x4*)(smem + nxt + lds_off(srow + 32 * i, sch)) = ra[i]; *(u32x4*)(smem + nxt + 16384 + lds_off(srow + 32 * i, sch)) = rb[i]; }
        }
        __syncthreads();
    }
}
#define ACC_ROW(TMv, wm, i, r, hl) (32 * ((TMv) * (wm) + (i)) + ((r) & 3) + 8 * ((r) >> 2) + 4 * (hl))
#define ACC_COL(TNv, wn, j, cl)    (32 * ((TNv) * (wn) + (j)) + (cl))

#define N_ADA 192
#define NW_IN   (1792 * 1024)
#define NW_UQ   (768 * 384)
#define NW_UKV  (1024 * 256)
#define NW_GATE (4 * 512 * 128)
#define NW_O    (1024 * 1024)
#define NW_POOL (4 * 256 * 256)
#define NW_PQ   (2048 * 1024)
#define NW_KEYS (16 * 128 * 128)
#define NW_CKV  (8 * 256 * 256)
#define NW_CKR  (8 * 256 * 64)
#define NW_ROPE 3072
#define NW_TOTAL (NW_IN + NW_UQ + NW_UKV + NW_GATE + NW_O + NW_POOL + 2 * NW_PQ + 2 * NW_KEYS + NW_CKV + NW_CKR + NW_ROPE)
#define N_CONV_ITEMS ((NW_TOTAL + 4095) / 4096)
#define N_FP8_ITEMS (65536 / 4)

__device__ __forceinline__ void conv_elem(const Params& p, int e) {
    if (e < NW_IN) { const int n = e >> 10, k = e & 1023; p.wt_in[e] = n < 1728 ? f2bf(p.w_in[(size_t)k * 1728 + n]) : (bf16_t)0; return; } e -= NW_IN;
    if (e < NW_UQ) { const int n = e / 384, k = e % 384; p.wt_uq[e] = f2bf(p.w_uq[(size_t)k * 768 + n]); return; } e -= NW_UQ;
    if (e < NW_UKV) { const int n = e >> 8, k = e & 255; p.wt_ukv[e] = f2bf(p.w_ukv[(size_t)k * 1024 + n]); return; } e -= NW_UKV;
    if (e < NW_GATE) {
        const int c = e & 127, cg = (e >> 7) & 511, nb = e >> 16;
        const int dir = cg >> 8, dg = (cg >> 6) & 3, ri = (cg >> 5) & 1, d = dg * 32 + (cg & 31);
        const float* src = ri ? p.w_ig : p.w_rg;
        p.wt_gate[e] = f2bf(src[(((size_t)dir * 4 + nb) * 128 + c) * 128 + d]); return; } e -= NW_GATE;
    if (e < NW_O) { const int n = e >> 10, k = e & 1023; p.wt_o[e] = f2bf(p.w_o[(size_t)k * 1024 + n]); return; } e -= NW_O;
    if (e < NW_POOL) { const int c = e & 255, d = (e >> 8) & 255, g = e >> 16; p.wt_pool[e] = f2bf(p.w_pool[((size_t)g * 256 + c) * 256 + d]); return; } e -= NW_POOL;
#pragma unroll
    for (int l = 0; l < 2; ++l) { if (e < NW_PQ) { const int n = e >> 10, k = e & 1023; p.wt_pq[l][e] = f2bf(p.peer_wq[l][(size_t)k * 2048 + n]); return; } e -= NW_PQ; }
#pragma unroll
    for (int l = 0; l < 2; ++l) { if (e < NW_KEYS) { p.keysb[l][e] = f2bf(p.peer_keys[l][e]); return; } e -= NW_KEYS; }
    if (e < NW_CKV) { const int col = e & 255, j = (e >> 8) & 255, b = e >> 16; p.ckvk[(size_t)(T_CTX + b * 2304 + j) * 256 + col] = f2bf(p.cache_ckv[e]); return; } e -= NW_CKV;
    if (e < NW_CKR) { const int col = e & 63, j = (e >> 6) & 255, b = e >> 14; p.kropek[(size_t)(T_CTX + b * 2304 + j) * 64 + col] = f2bf(p.cache_krope[e]); return; } e -= NW_CKR;
    if (e < NW_ROPE) {
        int idx = e, isrow = e < 1024; if (!isrow) idx -= 1024;
        const int half = isrow ? 512 : 1024; const int sn = idx >= half; if (sn) idx -= half;
        const int pos = idx >> 4, fi = idx & 15;
        const float invf = exp2f(-(float)fi * (13.287712379549449f / 16.f));
        const float ang = (float)pos * invf;
        p.ropetab[e] = sn ? sinf(ang) : cosf(ang); return; }
}

__device__ void st_prologue(const Params& p) {
    const int tid = threadIdx.x, lane = tid & 63, wid = tid >> 6;
    const int n_items = N_ADA + N_CONV_ITEMS + N_FP8_ITEMS;
    for (int item = blockIdx.x; item < n_items; item += gridDim.x) {
        if (item < N_ADA) {
            float* svec = (float*)smem;
            float* red = (float*)(smem + 9 * 1024 * 4);
            __syncthreads();
            for (int i = tid; i < 9 * 1024; i += 256) { const int bc = i >> 10, k = i & 1023; const float cv = bc == 0 ? p.c_ctx[k] : p.c[(size_t)(bc - 1) * 1024 + k]; svec[i] = silu_(cv); }
            __syncthreads();
            const int cidx = item * 64 + (tid & 63), l = cidx / 6144, col = cidx % 6144, kq = tid >> 6;
            const float* w = p.w_mod[l] + col;
            float acc[9];
#pragma unroll
            for (int b = 0; b < 9; ++b) acc[b] = 0.f;
            for (int k = kq * 256; k < kq * 256 + 256; ++k) {
                const float wv = w[(size_t)k * 6144];
#pragma unroll
                for (int b = 0; b < 9; ++b) acc[b] += wv * svec[b * 1024 + k];
            }
#pragma unroll
            for (int b = 0; b < 9; ++b) red[(kq * 9 + b) * 64 + (tid & 63)] = acc[b];
            __syncthreads();
            if (kq == 0) {
                const float bias = p.b_mod[l][col];
#pragma unroll
                for (int b = 0; b < 9; ++b) {
                    const int c64 = tid & 63;
                    const float v = red[(0 * 9 + b) * 64 + c64] + red[(1 * 9 + b) * 64 + c64] + red[(2 * 9 + b) * 64 + c64] + red[(3 * 9 + b) * 64 + c64] + bias;
                    p.mod[(size_t)(l * 9 + b) * 6144 + col] = v;
                }
            }
        } else if (item < N_ADA + N_CONV_ITEMS) {
            const int base = (item - N_ADA) * 4096;
            for (int i = tid; i < 4096; i += 256) { const int e = base + i; if (e < NW_TOTAL) conv_elem(p, e); }
        } else {
            const int row = (item - N_ADA - N_CONV_ITEMS) * 4 + wid;
            const int tb = row >> 14, er = row & 16383, l = tb >> 1;
            const float* src = ((tb & 1) ? p.peer_v[l] : p.peer_u[l]) + (size_t)er * 1024 + lane * 16;
            u8_t* dst = ((tb & 1) ? p.v8[l] : p.u8[l]) + (size_t)er * 1024 + lane * 16;
            float* sc = ((tb & 1) ? p.sv[l] : p.su[l]) + er;
            float v[16];
#pragma unroll
            for (int j = 0; j < 4; ++j) { const float4 f = *(const float4*)(src + 4 * j); v[4 * j] = f.x; v[4 * j + 1] = f.y; v[4 * j + 2] = f.z; v[4 * j + 3] = f.w; }
            float am = 0.f;
#pragma unroll
            for (int j = 0; j < 16; ++j) am = fmaxf(am, fabsf(v[j]));
            am = wave_max(am);
            const float scale = am > 0.f ? am * (1.f / 224.f) : 1.f, inv = am > 0.f ? 224.f / am : 1.f;
            unsigned w[4];
#pragma unroll
            for (int j = 0; j < 4; ++j) {
                int pk = 0;
                pk = __builtin_amdgcn_cvt_pk_fp8_f32(v[4 * j] * inv, v[4 * j + 1] * inv, pk, false);
                pk = __builtin_amdgcn_cvt_pk_fp8_f32(v[4 * j + 2] * inv, v[4 * j + 3] * inv, pk, true);
                w[j] = (unsigned)pk;
            }
            *(uint4*)dst = make_uint4(w[0], w[1], w[2], w[3]);
            if (lane == 0) *sc = scale;
        }
    }
}

template <int SRC>
__device__ void st_norm(const Params& p, int l, int which, const float* g, bf16_t* dst) {
    const int lane = threadIdx.x & 63, wid = threadIdx.x >> 6;
    for (int T = blockIdx.x * 4 + wid; T < T_TOK; T += gridDim.x * 4) {
        const float* src = (SRC == 0 ? x_in_row(p, T) : p.xres + (size_t)T * 1024) + lane * 16;
        const TokInfo ti = tokinfo(T);
        float v[16]; float ss = 0.f;
#pragma unroll
        for (int j = 0; j < 4; ++j) { const float4 f = *(const float4*)(src + 4 * j); v[4 * j] = f.x; v[4 * j + 1] = f.y; v[4 * j + 2] = f.z; v[4 * j + 3] = f.w; }
#pragma unroll
        for (int j = 0; j < 16; ++j) ss += v[j] * v[j];
        ss = wave_sum(ss);
        const float rstd = rsqrtf(ss * (1.f / 1024.f) + 1e-6f);
        const float* sh = modv(p, l, ti.mi, which ? 3 : 0) + lane * 16; const float* sc = modv(p, l, ti.mi, which ? 4 : 1) + lane * 16; const float* gg = g + lane * 16;
        unsigned w[8];
#pragma unroll
        for (int j = 0; j < 8; ++j) {
            const float a0 = v[2 * j] * rstd * gg[2 * j] * (1.f + sc[2 * j]) + sh[2 * j];
            const float a1 = v[2 * j + 1] * rstd * gg[2 * j + 1] * (1.f + sc[2 * j + 1]) + sh[2 * j + 1];
            w[j] = (unsigned)f2bf(a0) | ((unsigned)f2bf(a1) << 16);
        }
        uint4* d = (uint4*)(dst + (size_t)T * 1024 + lane * 16);
        d[0] = make_uint4(w[0], w[1], w[2], w[3]); d[1] = make_uint4(w[4], w[5], w[6], w[7]);
    }
}

__device__ void st_gemm1(const Params& p) {
    const int lane = threadIdx.x & 63, wid = threadIdx.x >> 6, wm = wid >> 1, wn = wid & 1, hl = lane >> 5, cl = lane & 31;
    for (int item = blockIdx.x; item < 160 * 14; item += gridDim.x) {
        const int tn = item % 14, tm = item / 14;
        f32x16 acc[2][2];
        gemm_acc<2, 2, 2, 2>(p.hbuf + (size_t)tm * 128 * 1024, 1024, p.wt_in + (size_t)tn * 128 * 1024, 1024, 1024, acc);
#pragma unroll
        for (int i = 0; i < 2; ++i)
#pragma unroll
            for (int j = 0; j < 2; ++j)
#pragma unroll
                for (int r = 0; r < 16; ++r) {
                    const int row = tm * 128 + ACC_ROW(2, wm, i, r, hl), col = tn * 128 + ACC_COL(2, wn, j, cl);
                    p.P[(size_t)row * 1792 + col] = f2bf(acc[i][j][r]);
                }
    }
}

__device__ void st_postproj(const Params& p) {
    const int lane = threadIdx.x & 63, wid = threadIdx.x >> 6;
    float* o_ckv = p.out + 20971520, *o_kr = p.out + 22020096;
    for (int T = blockIdx.x * 4 + wid; T < T_TOK; T += gridDim.x * 4) {
        const TokInfo ti = tokinfo(T);
        const bf16_t* Pr = p.P + (size_t)T * 1792;
        {
            float v[6]; float ss = 0.f;
#pragma unroll
            for (int j = 0; j < 6; ++j) { v[j] = bf2f(Pr[lane + 64 * j]); ss += v[j] * v[j]; }
            ss = wave_sum(ss);
            const float rstd = rsqrtf(ss * (1.f / 384.f) + 1e-6f);
#pragma unroll
            for (int j = 0; j < 6; ++j) p.cqn[(size_t)T * 384 + lane + 64 * j] = f2bf(v[j] * rstd * p.g_q[lane + 64 * j]);
        }
        {
            float v[4]; float ss = 0.f;
#pragma unroll
            for (int j = 0; j < 4; ++j) { v[j] = bf2f(Pr[384 + lane + 64 * j]); ss += v[j] * v[j]; }
            ss = wave_sum(ss);
            const float rstd = rsqrtf(ss * (1.f / 256.f) + 1e-6f);
#pragma unroll
            for (int j = 0; j < 4; ++j) {
                const float y = v[j] * rstd * p.g_kv[lane + 64 * j];
                p.ckvk[(size_t)ti.keyrow * 256 + lane + 64 * j] = f2bf(y);
                if (!ti.smp) o_ckv[(size_t)T * 256 + lane + 64 * j] = y;
            }
        }
        {
            const float v = bf2f(Pr[640 + lane]);
            float y = v;
            if (ti.smp) {
                const float o = __shfl_xor(v, 1);
                const int pr = lane >> 1, gr = ti.s >> 6, gc = ti.s & 63;
                const float cs = pr < 16 ? p.ropetab[gr * 16 + pr] : p.ropetab[1024 + gc * 16 + (pr - 16)];
                const float sn = pr < 16 ? p.ropetab[512 + gr * 16 + pr] : p.ropetab[2048 + gc * 16 + (pr - 16)];
                y = (lane & 1) ? (o * sn + v * cs) : (v * cs - o * sn);
            } else {
                o_kr[(size_t)T * 64 + lane] = v;
            }
            p.kropek[(size_t)ti.keyrow * 64 + lane] = f2bf(y);
        }
        {
#pragma unroll
            for (int j = 0; j < 8; ++j) {
                const int ch = lane + 64 * j;
                float y = p.conv_b[ch];
#pragma unroll
                for (int k = 0; k < 4; ++k) {
                    const int s2 = ti.s + k - 2;
                    if (s2 >= 0 && s2 < ti.S) y += p.conv_w[k * 512 + ch] * bf2f(p.P[(size_t)(T + k - 2) * 1792 + 704 + ch]);
                }
                p.xc[(size_t)T * 512 + ch] = f2bf(y);
                p.ug[(size_t)T * 512 + ch] = Pr[1216 + ch];
            }
        }
    }
}

#define N_G2 (160 * 6)
#define N_G3 (176 * 8)
#define N_G4 (160 * 16)
__device__ void st_gemm234(const Params& p) {
    const int lane = threadIdx.x & 63, wid = threadIdx.x >> 6, wm = wid >> 1, wn = wid & 1, hl = lane >> 5, cl = lane & 31;
    for (int item = blockIdx.x; item < N_G2 + N_G3 + N_G4; item += gridDim.x) {
        f32x16 acc[2][2];
        if (item < N_G2) {
            const int tn = item % 6, tm = item / 6;
            gemm_acc<2, 2, 2, 2>(p.wt_uq + (size_t)tn * 128 * 384, 384, p.cqn + (size_t)tm * 128 * 384, 384, 384, acc);
            const float qs = 0.07216878364870322f * 1.4426950408889634f;
#pragma unroll
            for (int j = 0; j < 2; ++j) {
                const int T = tm * 128 + ACC_COL(2, wn, j, cl);
                const TokInfo ti = tokinfo(T);
                const int gr = ti.s >> 6, gc = ti.s & 63;
#pragma unroll
                for (int i = 0; i < 2; ++i)
#pragma unroll
                    for (int r = 0; r < 16; r += 2) {
                        const int n = tn * 128 + ACC_ROW(2, wm, i, r, hl);
                        float v0 = acc[i][j][r], v1 = acc[i][j][r + 1];
                        const int d = n % 192;
                        if (ti.smp && d >= 128) {
                            const int pr = (d - 128) >> 1;
                            const float cs = pr < 16 ? p.ropetab[gr * 16 + pr] : p.ropetab[1024 + gc * 16 + (pr - 16)];
                            const float sn = pr < 16 ? p.ropetab[512 + gr * 16 + pr] : p.ropetab[2048 + gc * 16 + (pr - 16)];
                            const float t0 = v0 * cs - v1 * sn, t1 = v0 * sn + v1 * cs; v0 = t0; v1 = t1;
                        }
                        *(unsigned*)(p.q + (size_t)T * 768 + n) = (unsigned)f2bf(v0 * qs) | ((unsigned)f2bf(v1 * qs) << 16);
                    }
            }
        } else if (item < N_G2 + N_G3) {
            const int it = item - N_G2, tn = it & 7, tm = it >> 3, h = tn >> 1;
            if ((tn & 1) == 0) {
                gemm_acc<2, 2, 2, 2>(p.ckvk + (size_t)tm * 128 * 256, 256, p.wt_ukv + (size_t)tn * 128 * 256, 256, 256, acc);
#pragma unroll
                for (int i = 0; i < 2; ++i)
#pragma unroll
                    for (int j = 0; j < 2; ++j)
#pragma unroll
                        for (int r = 0; r < 16; ++r) {
                            const int row = tm * 128 + ACC_ROW(2, wm, i, r, hl), dcol = ACC_COL(2, wn, j, cl);
                            p.Kn[(size_t)row * 512 + h * 128 + dcol] = f2bf(acc[i][j][r]);
                        }
            } else {
                gemm_acc<2, 2, 2, 2>(p.wt_ukv + (size_t)tn * 128 * 256, 256, p.ckvk + (size_t)tm * 128 * 256, 256, 256, acc);
#pragma unroll
                for (int j = 0; j < 2; ++j) {
                    const int R = tm * 128 + ACC_COL(2, wn, j, cl);
                    size_t base; int Sk, pos;
                    if (R < T_CTX) { Sk = 256; pos = R & 255; base = (size_t)((R >> 8) * 4 + h) * 128 * 256; }
                    else { const int u = R - T_CTX; Sk = 2304; pos = u % 2304; base = (size_t)T_CTX * 512 + (size_t)((u / 2304) * 4 + h) * 128 * 2304; }
#pragma unroll
                    for (int i = 0; i < 2; ++i)
#pragma unroll
                        for (int r = 0; r < 16; ++r) {
                            const int dv = ACC_ROW(2, wm, i, r, hl);
                            p.vT[base + (size_t)dv * Sk + pos] = f2bf(acc[i][j][r]);
                        }
                }
            }
        } else {
            const int it = item - N_G2 - N_G3, tj = it & 3, nb = (it >> 2) & 3, tm = it >> 4;
            gemm_acc<2, 2, 2, 2>(p.xc + (size_t)tm * 128 * 512 + nb * 128, 512, p.wt_gate + ((size_t)nb * 512 + tj * 128) * 128, 128, 128, acc);
            const int dir = tj >> 1, dg = (tj & 1) * 2 + wn, ch = nb * 128 + dg * 32 + cl;
            const float brg = p.b_rg[dir * 512 + ch], big = p.b_ig[dir * 512 + ch];
            const float nl = -p.lam[dir * 512 + ch];
            const float sp = fmaxf(nl, 0.f) + log1pf(__expf(-fabsf(nl)));
#pragma unroll
            for (int i = 0; i < 2; ++i)
#pragma unroll
                for (int r = 0; r < 16; ++r) {
                    const int T = tm * 128 + ACC_ROW(2, wm, i, r, hl);
                    const float rg = sigmoidf_(acc[i][0][r] + brg), ig = sigmoidf_(acc[i][1][r] + big);
                    const float la = -8.f * rg * sp;
                    const float av = __expf(la);
                    const float mult = sqrtf(fmaxf(-expm1f(2.f * la), 0.f));
                    const float xv = bf2f(p.xc[(size_t)T * 512 + ch]);
                    p.a[((size_t)T * 2 + dir) * 512 + ch] = av;
                    p.bxb[((size_t)T * 2 + dir) * 512 + ch] = f2bf(mult * ig * xv);
                }
        }
    }
}

#define N_ATT (128 + 512)
#define N_S1 (640 * 4)
__device__ void scan_s1_item(const Params& p, int it) {
    const int chunk = it >> 2, dc = (it & 3) * 256 + threadIdx.x, dir = dc >> 9, ch = dc & 511;
    const int T0 = chunk * 32;
    float A = 1.f, B = 0.f;
    for (int i = 0; i < 32; ++i) {
        const int T = dir ? (T0 + 31 - i) : (T0 + i);
        const float av = p.a[((size_t)T * 2 + dir) * 512 + ch], bv = bf2f(p.bxb[((size_t)T * 2 + dir) * 512 + ch]);
        A *= av; B = B * av + bv;
    }
    *(float2*)(p.agg + (((size_t)chunk * 2 + dir) * 512 + ch) * 2) = make_float2(A, B);
}
__device__ void attn_item_simple(const Params& p, int it) {
    int seq, h, qb, Sk, T0, R0; size_t vbase;
    if (it < 128) { seq = it >> 3; h = (it >> 1) & 3; qb = it & 1; Sk = 256; T0 = seq * 256 + qb * 128; R0 = seq * 256; vbase = (size_t)(seq * 4 + h) * 128 * 256; }
    else { const int u = it - 128; seq = u >> 6; h = (u >> 4) & 3; qb = u & 15; Sk = 2304; T0 = T_CTX + seq * 2048 + qb * 128; R0 = T_CTX + seq * 2304; vbase = (size_t)T_CTX * 512 + (size_t)(seq * 4 + h) * 128 * 2304; }
    const int tid = threadIdx.x, qi = tid >> 1, half = tid & 1;
    const int T = T0 + qi;
    __syncthreads();
    {
        const uint4* qg = (const uint4*)(p.q + (size_t)T0 * 768 + h * 192);
        for (int i = tid; i < 128 * 24; i += 256) { const int r = i / 24, c = i % 24; ((uint4*)smem)[i] = qg[(size_t)r * 96 + c]; }
    }
    __syncthreads();
    const uint4* qv4 = (const uint4*)smem + qi * 24;
    float o[64];
#pragma unroll
    for (int j = 0; j < 64; ++j) o[j] = 0.f;
    float m = -1e30f, l = 0.f;
    for (int key = 0; key < Sk; ++key) {
        const uint4* k4 = (const uint4*)(p.Kn + (size_t)(R0 + key) * 512 + h * 128);
        const uint4* r4 = (const uint4*)(p.kropek + (size_t)(R0 + key) * 64);
        float s = 0.f;
#pragma unroll 4
        for (int j = 0; j < 24; ++j) {
            const uint4 kk = j < 16 ? k4[j] : r4[j - 16];
            const uint4 qq = qv4[j];
            const unsigned kw[4] = {kk.x, kk.y, kk.z, kk.w}, qw[4] = {qq.x, qq.y, qq.z, qq.w};
#pragma unroll
            for (int e = 0; e < 4; ++e) {
                const unsigned a = qw[e], b = kw[e];
                s += __uint_as_float(a << 16) * __uint_as_float(b << 16) + __uint_as_float(a & 0xffff0000u) * __uint_as_float(b & 0xffff0000u);
            }
        }
        const float mn = fmaxf(m, s), alpha = exp2f(m - mn), pe = exp2f(s - mn);
        l = l * alpha + pe; m = mn;
        const bf16_t* vp = p.vT + vbase + (size_t)(half * 64) * Sk + key;
#pragma unroll
        for (int j = 0; j < 64; ++j) o[j] = o[j] * alpha + pe * bf2f(vp[(size_t)j * Sk]);
    }
    const float inv = 1.f / l;
    bf16_t* dst = p.hbuf + (size_t)T * 1024 + h * 128 + half * 64;
#pragma unroll
    for (int j = 0; j < 64; j += 2) *(unsigned*)(dst + j) = (unsigned)f2bf(o[j] * inv) | ((unsigned)f2bf(o[j + 1] * inv) << 16);
}
__device__ void st_attn_s1(const Params& p) {
    for (int item = blockIdx.x; item < N_ATT + N_S1; item += gridDim.x) {
        if (item < N_ATT) attn_item_simple(p, N_ATT - 1 - item);
        else scan_s1_item(p, item - N_ATT);
    }
}

__device__ void st_scan3(const Params& p) {
    const int tid = threadIdx.x;
    float* hf = (float*)smem;
    float* hb = hf + 32 * 128;
    float* o_lru = p.out + 22282240;
    for (int item = blockIdx.x; item < 640 * 4; item += gridDim.x) {
        const int chunk = item >> 2, cgp = item & 3, T0 = chunk * 32;
        const TokInfo ti = tokinfo(T0);
        const int nch = ti.S >> 5, c0 = chunk - (ti.s >> 5), cpos = ti.s >> 5;
        const int dir = tid >> 7, ch = cgp * 128 + (tid & 127);
        float hcur = ti.smp ? p.state_lru[((size_t)ti.b * 2 + dir) * 512 + ch] : 0.f;
        if (dir == 0) { for (int cc = 0; cc < cpos; ++cc) { const float2 ab = *(const float2*)(p.agg + (((size_t)(c0 + cc) * 2 + 0) * 512 + ch) * 2); hcur = ab.x * hcur + ab.y; } }
        else { for (int cc = nch - 1; cc > cpos; --cc) { const float2 ab = *(const float2*)(p.agg + (((size_t)(c0 + cc) * 2 + 1) * 512 + ch) * 2); hcur = ab.x * hcur + ab.y; } }
        __syncthreads();
        for (int i = 0; i < 32; ++i) {
            const int tl = dir ? 31 - i : i, T = T0 + tl;
            const float av = p.a[((size_t)T * 2 + dir) * 512 + ch], bv = bf2f(p.bxb[((size_t)T * 2 + dir) * 512 + ch]);
            hcur = av * hcur + bv;
            (dir ? hb : hf)[tl * 128 + (tid & 127)] = hcur;
        }
        if (!ti.smp) {
            if (dir == 0 && cpos == nch - 1) o_lru[((size_t)ti.b * 2 + 0) * 512 + ch] = hcur;
            if (dir == 1 && cpos == 0) o_lru[((size_t)ti.b * 2 + 1) * 512 + ch] = hcur;
        }
        __syncthreads();
        for (int i = tid; i < 32 * 128; i += 256) {
            const int tl = i >> 7, c = i & 127, T = T0 + tl, chh = cgp * 128 + c;
            const float g = gelu_tanh(bf2f(p.ug[(size_t)T * 512 + chh]));
            p.hbuf[(size_t)T * 1024 + 512 + chh] = f2bf((hf[i] + hb[i]) * g);
        }
    }
}

__device__ void st_gemm_o(const Params& p) {
    const int lane = threadIdx.x & 63, wid = threadIdx.x >> 6, wm = wid >> 1, wn = wid & 1, hl = lane >> 5, cl = lane & 31;
    for (int item = blockIdx.x; item < 160 * 8; item += gridDim.x) {
        const int tn = item & 7, tm = item >> 3;
        f32x16 acc[2][2];
        gemm_acc<2, 2, 2, 2>(p.hbuf + (size_t)tm * 128 * 1024, 1024, p.wt_o + (size_t)tn * 128 * 1024, 1024, 1024, acc);
        const int mi = tokinfo(tm * 128).mi;
#pragma unroll
        for (int j = 0; j < 2; ++j) {
            const int col = tn * 128 + ACC_COL(2, wn, j, cl);
            const float gt = modv(p, 0, mi, 2)[col];
#pragma unroll
            for (int i = 0; i < 2; ++i)
#pragma unroll
                for (int r = 0; r < 16; ++r) {
                    const int row = tm * 128 + ACC_ROW(2, wm, i, r, hl);
                    p.xres[(size_t)row * 1024 + col] = x_in_row(p, row)[col] + gt * acc[i][j][r];
                }
        }
    }
}

__device__ void st_gemm_pq(const Params& p, int l) {
    const int lane = threadIdx.x & 63, wid = threadIdx.x >> 6, wm = wid >> 1, wn = wid & 1, hl = lane >> 5, cl = lane & 31;
    for (int item = blockIdx.x; item < 160 * 16; item += gridDim.x) {
        const int tn = item & 15, tm = item >> 4;
        f32x16 acc[2][2];
        gemm_acc<2, 2, 2, 2>(p.hbuf + (size_t)tm * 128 * 1024, 1024, p.wt_pq[l] + (size_t)tn * 128 * 1024, 1024, 1024, acc);
#pragma unroll
        for (int i = 0; i < 2; ++i)
#pragma unroll
            for (int j = 0; j < 2; ++j)
#pragma unroll
                for (int r = 0; r < 16; ++r) {
                    const int row = tm * 128 + ACC_ROW(2, wm, i, r, hl), col = tn * 128 + ACC_COL(2, wn, j, cl);
                    p.qp[(size_t)row * 2048 + col] = f2bf(acc[i][j][r]);
                }
    }
}

__device__ __forceinline__ void ins16(float (&top)[16], float x) {
#pragma unroll
    for (int i = 0; i < 16; ++i) { const float hi = fmaxf(top[i], x); x = fminf(top[i], x); top[i] = hi; }
}
__device__ void st_peer_topk(const Params& p, int l) {
    const int lane = threadIdx.x & 63, wid = threadIdx.x >> 6, hl = lane >> 5, cl = lane & 31;
    for (int item = blockIdx.x; item < 160 * 8; item += gridDim.x) {
        const int h = item & 7, tm = item >> 3;
        const int T = tm * 128 + 32 * wid + cl;
        float top[2][16];
#pragma unroll
        for (int pp = 0; pp < 2; ++pp) {
            f32x16 acc[4][1];
            gemm_acc<4, 1, 1, 4>(p.keysb[l] + (size_t)(h * 2 + pp) * 128 * 128, 128, p.qp + (size_t)tm * 128 * 2048 + h * 256 + pp * 128, 2048, 128, acc);
#pragma unroll
            for (int i = 0; i < 16; ++i) top[pp][i] = -INFINITY;
#pragma unroll
            for (int i = 0; i < 4; ++i) {
                __builtin_amdgcn_sched_barrier(0);
#pragma unroll
                for (int r = 0; r < 16; ++r) {
                    const int n = ACC_ROW(4, 0, i, r, hl);
                    const float x = __uint_as_float((__float_as_uint(acc[i][0][r]) & 0xffffff80u) | (unsigned)n);
                    ins16(top[pp], x);
                }
            }
            __builtin_amdgcn_sched_barrier(0);
            float oth[16];
#pragma unroll
            for (int i = 0; i < 16; ++i) oth[i] = __shfl_xor(top[pp][i], 32);
#pragma unroll
            for (int i = 0; i < 16; ++i) ins16(top[pp], oth[i]);
        }
        float fv[16];
#pragma unroll
        for (int i = 0; i < 16; ++i) fv[i] = -INFINITY;
#pragma unroll
        for (int i = 0; i < 16; ++i)
#pragma unroll
            for (int j = 0; j < 16; ++j)
                if ((i + 1) * (j + 1) <= 16) {
                    const float cv = __uint_as_float(__float_as_uint(top[0][i]) & 0xffffff80u) + __uint_as_float(__float_as_uint(top[1][j]) & 0xffffff80u);
                    ins16(fv, __uint_as_float((__float_as_uint(cv) & 0xffffff00u) | (unsigned)(i * 16 + j)));
                }
        unsigned* tab = (unsigned*)smem + (size_t)threadIdx.x * 8;
#pragma unroll
        for (int k = 0; k < 4; ++k) {
            tab[k] = (__float_as_uint(top[0][4 * k]) & 127u) | ((__float_as_uint(top[0][4 * k + 1]) & 127u) << 8) | ((__float_as_uint(top[0][4 * k + 2]) & 127u) << 16) | ((__float_as_uint(top[0][4 * k + 3]) & 127u) << 24);
            tab[4 + k] = (__float_as_uint(top[1][4 * k]) & 127u) | ((__float_as_uint(top[1][4 * k + 1]) & 127u) << 8) | ((__float_as_uint(top[1][4 * k + 2]) & 127u) << 16) | ((__float_as_uint(top[1][4 * k + 3]) & 127u) << 24);
        }
        const u8_t* tabb = (const u8_t*)tab;
        int fe[16];
#pragma unroll
        for (int i = 0; i < 16; ++i) {
            const unsigned code = __float_as_uint(fv[i]) & 255u;
            fe[i] = (int)tabb[code >> 4] * 128 + (int)tabb[16 + (code & 15u)];
            fv[i] = __uint_as_float(__float_as_uint(fv[i]) & 0xffffff00u);
        }
        float sum = 0.f, ev[16];
#pragma unroll
        for (int i = 0; i < 16; ++i) { ev[i] = __expf(fv[i] - fv[0]); sum += ev[i]; }
        const float inv = 1.f / sum;
        if (hl == 0) {
#pragma unroll
            for (int i = 0; i < 16; ++i) { p.gates[(size_t)T * 128 + h * 16 + i] = ev[i] * inv; p.eidx[(size_t)T * 128 + h * 16 + i] = fe[i]; }
        }
    }
}

__device__ void st_peer_gather(const Params& p, int l) {
    const int lane = threadIdx.x & 63, wid = threadIdx.x >> 6;
    const u8_t* U = p.u8[l]; const u8_t* V = p.v8[l]; const float* SU = p.su[l]; const float* SV = p.sv[l];
    for (int T = blockIdx.x * 4 + wid; T < T_TOK; T += gridDim.x * 4) {
        const TokInfo ti = tokinfo(T);
        float hv[16];
        {
            const uint4* hp = (const uint4*)(p.hbuf + (size_t)T * 1024 + lane * 16);
            float t8[8]; unpack8(hp[0], t8);
#pragma unroll
            for (int j = 0; j < 8; ++j) hv[j] = t8[j];
            unpack8(hp[1], t8);
#pragma unroll
            for (int j = 0; j < 8; ++j) hv[8 + j] = t8[j];
        }
        const int e0 = p.eidx[(size_t)T * 128 + lane], e1 = p.eidx[(size_t)T * 128 + 64 + lane];
        const float g0 = p.gates[(size_t)T * 128 + lane], g1 = p.gates[(size_t)T * 128 + 64 + lane];
        float outv[16];
#pragma unroll
        for (int j = 0; j < 16; ++j) outv[j] = 0.f;
        for (int k = 0; k < 128; ++k) {
            const int e = __builtin_amdgcn_readlane(k < 64 ? e0 : e1, k & 63);
            const float gk = __int_as_float(__builtin_amdgcn_readlane(__float_as_int(k < 64 ? g0 : g1), k & 63));
            const uint4 ur = *(const uint4*)(U + (size_t)e * 1024 + lane * 16);
            const uint4 vr = *(const uint4*)(V + (size_t)e * 1024 + lane * 16);
            const unsigned uw[4] = {ur.x, ur.y, ur.z, ur.w}, vw[4] = {vr.x, vr.y, vr.z, vr.w};
            float d = 0.f;
#pragma unroll
            for (int j = 0; j < 4; ++j) {
                const f32x2 lo = __builtin_amdgcn_cvt_pk_f32_fp8((int)uw[j], false), hi = __builtin_amdgcn_cvt_pk_f32_fp8((int)uw[j], true);
                d += lo.x * hv[4 * j] + lo.y * hv[4 * j + 1] + hi.x * hv[4 * j + 2] + hi.y * hv[4 * j + 3];
            }
            d = wave_sum(d);
            const float z = d * SU[e];
            const float w = gk * gelu_tanh(z) * SV[e];
#pragma unroll
            for (int j = 0; j < 4; ++j) {
                const f32x2 lo = __builtin_amdgcn_cvt_pk_f32_fp8((int)vw[j], false), hi = __builtin_amdgcn_cvt_pk_f32_fp8((int)vw[j], true);
                outv[4 * j] += w * lo.x; outv[4 * j + 1] += w * lo.y; outv[4 * j + 2] += w * hi.x; outv[4 * j + 3] += w * hi.y;
            }
        }
        float* xr = p.xres + (size_t)T * 1024 + lane * 16;
        const float* gt = modv(p, l, ti.mi, 5) + lane * 16;
        float xn[16]; float ss = 0.f;
#pragma unroll
        for (int j = 0; j < 4; ++j) { const float4 f = *(const float4*)(xr + 4 * j); xn[4 * j] = f.x + gt[4 * j] * outv[4 * j]; xn[4 * j + 1] = f.y + gt[4 * j + 1] * outv[4 * j + 1]; xn[4 * j + 2] = f.z + gt[4 * j + 2] * outv[4 * j + 2]; xn[4 * j + 3] = f.w + gt[4 * j + 3] * outv[4 * j + 3]; }
#pragma unroll
        for (int j = 0; j < 16; ++j) ss += xn[j] * xn[j];
        ss = wave_sum(ss);
        const float rstd = rsqrtf(ss * (1.f / 1024.f) + 1e-6f);
        if (l == 0) {
#pragma unroll
            for (int j = 0; j < 4; ++j) *(float4*)(xr + 4 * j) = make_float4(xn[4 * j], xn[4 * j + 1], xn[4 * j + 2], xn[4 * j + 3]);
            const float* sh = modv(p, 1, ti.mi, 0) + lane * 16; const float* sc = modv(p, 1, ti.mi, 1) + lane * 16; const float* gg = p.g_mix[1] + lane * 16;
            unsigned w[8];
#pragma unroll
            for (int j = 0; j < 8; ++j) {
                const float a0 = xn[2 * j] * rstd * gg[2 * j] * (1.f + sc[2 * j]) + sh[2 * j];
                const float a1 = xn[2 * j + 1] * rstd * gg[2 * j + 1] * (1.f + sc[2 * j + 1]) + sh[2 * j + 1];
                w[j] = (unsigned)f2bf(a0) | ((unsigned)f2bf(a1) << 16);
            }
            uint4* d = (uint4*)(p.h3 + (size_t)T * 1024 + lane * 16);
            d[0] = make_uint4(w[0], w[1], w[2], w[3]); d[1] = make_uint4(w[4], w[5], w[6], w[7]);
        } else {
            const float* gg = p.g_final + lane * 16;
            float* y = p.out + (size_t)T * 1024 + lane * 16;
#pragma unroll
            for (int j = 0; j < 4; ++j) *(float4*)(y + 4 * j) = make_float4(xn[4 * j] * rstd * gg[4 * j], xn[4 * j + 1] * rstd * gg[4 * j + 1], xn[4 * j + 2] * rstd * gg[4 * j + 2], xn[4 * j + 3] * rstd * gg[4 * j + 3]);
        }
    }
}

__device__ void st_pool(const Params& p) {
    const int tid = threadIdx.x;
    for (int T = blockIdx.x; T < T_TOK; T += gridDim.x) {
        const TokInfo ti = tokinfo(T);
        for (int c = tid; c < 1024; c += 256) {
            const int g = c >> 8, w = 2 << g;
            const int lo = max(ti.s - w / 2, 0), hi = min(ti.s + w / 2, ti.S);
            float s = 0.f;
            for (int t2 = lo; t2 < hi; ++t2) s += bf2f(p.h3[(size_t)(T - ti.s + t2) * 1024 + c]);
            const float d = s / (float)(hi - lo) - bf2f(p.h3[(size_t)T * 1024 + c]);
            p.hbuf[(size_t)T * 1024 + c] = f2bf(d);
        }
    }
}

__device__ void st_gemm_pool(const Params& p) {
    const int lane = threadIdx.x & 63, wid = threadIdx.x >> 6, wm = wid >> 1, wn = wid & 1, hl = lane >> 5, cl = lane & 31;
    for (int item = blockIdx.x; item < 160 * 8; item += gridDim.x) {
        const int tn = item & 7, tm = item >> 3, g = tn >> 1;
        f32x16 acc[2][2];
        gemm_acc<2, 2, 2, 2>(p.hbuf + (size_t)tm * 128 * 1024 + g * 256, 1024, p.wt_pool + ((size_t)g * 256 + (tn & 1) * 128) * 256, 256, 256, acc);
        const int mi = tokinfo(tm * 128).mi;
#pragma unroll
        for (int j = 0; j < 2; ++j) {
            const int col = tn * 128 + ACC_COL(2, wn, j, cl);
            const float gs = modv(p, 1, mi, 2)[col] * p.s_pool[col];
#pragma unroll
            for (int i = 0; i < 2; ++i)
#pragma unroll
                for (int r = 0; r < 16; ++r) {
                    const int row = tm * 128 + ACC_ROW(2, wm, i, r, hl);
                    p.xres[(size_t)row * 1024 + col] += gs * acc[i][j][r];
                }
        }
    }
}

__device__ __forceinline__ void run_stage(const Params& p, int s) {
#ifdef ONLY_STAGE
    if (s != ONLY_STAGE) return;
#endif
    switch (s) {
        case 0: st_prologue(p); break;
        case 1: st_norm<0>(p, 0, 0, p.g_mix[0], p.hbuf); break;
        case 2: st_gemm1(p); break;
        case 3: st_postproj(p); break;
        case 4: st_gemm234(p); break;
        case 5: st_attn_s1(p); break;
        case 6: st_scan3(p); break;
        case 7: st_gemm_o(p); break;
        case 8: st_norm<1>(p, 0, 1, p.g_ffn[0], p.hbuf); break;
        case 9: st_gemm_pq(p, 0); break;
        case 10: st_peer_topk(p, 0); break;
        case 11: st_peer_gather(p, 0); break;
        case 12: st_pool(p); break;
        case 13: st_gemm_pool(p); break;
        case 14: st_norm<1>(p, 1, 1, p.g_ffn[1], p.hbuf); break;
        case 15: st_gemm_pq(p, 1); break;
        case 16: st_peer_topk(p, 1); break;
        case 17: st_peer_gather(p, 1); break;
        default: break;
    }
}

__global__ void __launch_bounds__(256, 2) fwd_mega(Params p) {
    cg::grid_group grid = cg::this_grid();
    volatile LAS unsigned* st = (volatile LAS unsigned*)(smem + 65536);
    if (threadIdx.x == 0) { st[0] = 0; st[1] = 0; st[2] = 0; st[3] = 0; }
    __syncthreads();
    XcdBarrier b = xcd_barrier_post(p.bar, st);
    if (p.bar == nullptr) grid.sync();
#define MK_ST(k) run_stage(p, k); if ((k) + 1 < NSTAGE) xcd_barrier(b);
    MK_ST(0) MK_ST(1) MK_ST(2) MK_ST(3) MK_ST(4) MK_ST(5) MK_ST(6) MK_ST(7) MK_ST(8) MK_ST(9) MK_ST(10) MK_ST(11) MK_ST(12) MK_ST(13) MK_ST(14) MK_ST(15) MK_ST(16) MK_ST(17)
}
__global__ void __launch_bounds__(256, 2) fwd_stage(Params p, int s) { run_stage(p, s); }

extern "C" void kernel_launch(void* const* d_in, const int* in_sizes, int n_in, void* d_out, int out_size, void* d_ws, size_t ws_size, hipStream_t stream) {
    constexpr size_t kDynLds = 65536 + 1024;
    static int grid_blocks = 0;
    if (!grid_blocks) {
        int dev = 0, cus = 0, per_cu = 0;
        (void)hipGetDevice(&dev);
        (void)hipDeviceGetAttribute(&cus, hipDeviceAttributeMultiprocessorCount, dev);
        (void)hipFuncSetAttribute((const void*)fwd_mega, hipFuncAttributeMaxDynamicSharedMemorySize, (int)kDynLds);
        (void)hipFuncSetAttribute((const void*)fwd_stage, hipFuncAttributeMaxDynamicSharedMemorySize, (int)kDynLds);
        (void)hipOccupancyMaxActiveBlocksPerMultiprocessor(&per_cu, fwd_mega, 256, kDynLds);
        if (per_cu > 2) per_cu = 2;
        if (per_cu < 1) per_cu = 1;
        grid_blocks = cus * per_cu;
    }
    Params p{};
    const float* const* in = (const float* const*)d_in;
    p.x_prompt = in[0]; p.x_sample = in[1]; p.cache_ckv = in[2]; p.cache_krope = in[3]; p.state_lru = in[4]; p.c = in[5]; p.c_ctx = in[6];
    p.w_mod[0] = in[7]; p.b_mod[0] = in[8]; p.w_mod[1] = in[9]; p.b_mod[1] = in[10];
    p.g_mix[0] = in[11]; p.g_ffn[0] = in[12]; p.g_mix[1] = in[13]; p.g_ffn[1] = in[14];
    p.w_in = in[15]; p.g_q = in[16]; p.w_uq = in[17]; p.g_kv = in[18]; p.w_ukv = in[19]; p.conv_w = in[20]; p.conv_b = in[21];
    p.w_rg = in[22]; p.b_rg = in[23]; p.w_ig = in[24]; p.b_ig = in[25]; p.lam = in[26]; p.w_o = in[27]; p.w_pool = in[28]; p.s_pool = in[29];
    p.peer_wq[0] = in[30]; p.peer_keys[0] = in[31]; p.peer_u[0] = in[32]; p.peer_v[0] = in[33];
    p.peer_wq[1] = in[34]; p.peer_keys[1] = in[35]; p.peer_u[1] = in[36]; p.peer_v[1] = in[37];
    p.g_final = in[38];
    p.out = (float*)d_out;
    char* base = (char*)d_ws; size_t off = 0;
    auto take = [&](size_t bytes) { char* r = base + off; off += (bytes + 255) & ~(size_t)255; return r; };
    const size_t MiB = 1u << 20;
    p.bar = (unsigned*)take(16384);
    p.mod = (float*)take((size_t)2 * 9 * 6144 * 4);
    p.ropetab = (float*)take(3072 * 4);
    p.wt_in = (bf16_t*)take((size_t)NW_IN * 2); p.wt_uq = (bf16_t*)take((size_t)NW_UQ * 2); p.wt_ukv = (bf16_t*)take((size_t)NW_UKV * 2);
    p.wt_gate = (bf16_t*)take((size_t)NW_GATE * 2); p.wt_o = (bf16_t*)take((size_t)NW_O * 2); p.wt_pool = (bf16_t*)take((size_t)NW_POOL * 2);
    p.wt_pq[0] = (bf16_t*)take((size_t)NW_PQ * 2); p.wt_pq[1] = (bf16_t*)take((size_t)NW_PQ * 2);
    p.keysb[0] = (bf16_t*)take((size_t)NW_KEYS * 2); p.keysb[1] = (bf16_t*)take((size_t)NW_KEYS * 2);
    for (int l = 0; l < 2; ++l) { p.u8[l] = (u8_t*)take(16 * MiB); p.v8[l] = (u8_t*)take(16 * MiB); p.su[l] = (float*)take(65536); p.sv[l] = (float*)take(65536); }
    char* regX = take(80 * MiB);
    char* regQ = take(80 * MiB);
    char* regH = take(40 * MiB);
    p.P = (bf16_t*)regX; p.a = (float*)regX; p.xres = (float*)regX;
    p.bxb = (bf16_t*)regQ; p.q = (bf16_t*)(regQ + 40 * MiB); p.agg = (float*)(regQ + 70 * MiB); p.qp = (bf16_t*)regQ; p.h3 = (bf16_t*)regQ;
    p.hbuf = (bf16_t*)regH;
    p.cqn = (bf16_t*)take((size_t)T_TOK * 384 * 2); p.ckvk = (bf16_t*)take((size_t)R_KEYS * 256 * 2); p.kropek = (bf16_t*)take((size_t)R_KEYS * 64 * 2);
    p.xc = (bf16_t*)take((size_t)T_TOK * 512 * 2); p.ug = (bf16_t*)take((size_t)T_TOK * 512 * 2);
    p.Kn = (bf16_t*)take((size_t)R_KEYS * 512 * 2); p.vT = (bf16_t*)take((size_t)R_KEYS * 512 * 2);
    p.gates = (float*)p.Kn; p.eidx = (int*)((char*)p.Kn + (size_t)T_TOK * 128 * 4);
    if (off > ws_size) fprintf(stderr, "workspace too small: need %zu have %zu\n", off, ws_size);
    (void)hipMemsetAsync(d_ws, 0, 16384, stream);
#if MK_LAUNCHES == 1
    void* args[] = {&p};
    hipError_t e = hipLaunchCooperativeKernel((void*)fwd_mega, dim3(grid_blocks), dim3(256), args, kDynLds, stream);
    if (e != hipSuccess) fprintf(stderr, "cooperative launch failed: %s (grid %d)\n", hipGetErrorString(e), grid_blocks);
#else
    for (int s = 0; s < NSTAGE; ++s) hipLaunchKernelGGL(fwd_stage, dim3(grid_blocks), dim3(256), kDynLds, stream, p, s);
#endif
}
```

```cpp
#include <hip/hip_runtime.h>
#include <hip/hip_cooperative_groups.h>
#include <cstdio>
#include <cstdint>
namespace cg = cooperative_groups;

#ifndef MK_LAUNCHES
#define MK_LAUNCHES 1
#endif

typedef unsigned short bf16_t;
typedef unsigned char u8_t;
typedef float f32x16 __attribute__((ext_vector_type(16)));
typedef float f32x2 __attribute__((ext_vector_type(2)));
typedef unsigned u32x4 __attribute__((ext_vector_type(4)));

#define T_TOK 20480
#define T_CTX 4096
#define R_KEYS 22528
#define NSTAGE 18
#define LAS __attribute__((address_space(3)))

#define XB_TMO      128
#define XB_XCNT(j)  (256  + 64 * (j))
#define XB_XSUB(j)  (1280 + 64 * (j))
#define XB_XGEN(j)  (2304 + 64 * (j))
#define XB_TOP      3328
#define XB_TOPGEN   3392
#define XCD_BAR_WORDS 3456
#define XB_SPIN_CAP (1u << 22)
__device__ __forceinline__ unsigned xb_ld(unsigned* p)              { return __hip_atomic_load(p, __ATOMIC_RELAXED, __HIP_MEMORY_SCOPE_AGENT); }
__device__ __forceinline__ unsigned xb_add(unsigned* p, unsigned v) { return __hip_atomic_fetch_add(p, v, __ATOMIC_RELAXED, __HIP_MEMORY_SCOPE_AGENT); }
__device__ __forceinline__ unsigned xb_xcc_id() { return (unsigned)__builtin_amdgcn_s_getreg((3 << 11) | 20) & 0xFu; }
#define XB_SPIN(cond, bar) do { unsigned _sp = 0; while (cond) { __builtin_amdgcn_s_sleep(1); \
    if ((++_sp & 255u) == 0u) { if (xb_ld(&(bar)[XB_TMO])) break; if (_sp > XB_SPIN_CAP) { atomicAdd(&(bar)[XB_TMO], 1u); break; } } } } while (0)
struct XcdBarrier { unsigned* bar; unsigned x; volatile LAS unsigned* st; };
__device__ __forceinline__ XcdBarrier xcd_barrier_post(unsigned* bar, volatile LAS unsigned* st) {
    XcdBarrier b; b.bar = bar; b.x = xb_xcc_id(); b.st = st;
    if (threadIdx.x == 0) (void)xb_add(&bar[XB_XCNT(b.x)], 1u);
    return b;
}
__device__ __forceinline__ void xcd_barrier_complete(unsigned* bar, unsigned x, unsigned& nloc, unsigned& nx) {
    const unsigned G = gridDim.x * gridDim.y * gridDim.z;
    unsigned sum, cnt, mine, sp = 0u;
    for (;;) {
        sum = 0u; cnt = 0u; mine = 0u;
#pragma unroll
        for (unsigned j = 0; j < 16; ++j) { const unsigned c = xb_ld(&bar[XB_XCNT(j)]); sum += c; cnt += (c > 0u) ? 1u : 0u; mine = (j == x) ? c : mine; }
        if (sum == G) break;
        __builtin_amdgcn_s_sleep(1);
        if ((++sp & 255u) == 0u) { if (xb_ld(&bar[XB_TMO])) break; if (sp > XB_SPIN_CAP) { atomicAdd(&bar[XB_TMO], 1u); break; } }
    }
    nloc = mine > 0u ? mine : 1u; nx = cnt > 0u ? cnt : 1u;
}
__device__ __forceinline__ void xcd_barrier(const XcdBarrier& b) {
    asm volatile("s_waitcnt vmcnt(0)" ::: "memory");
    __syncthreads();
    if (threadIdx.x == 0) {
        unsigned* bar = b.bar;
        __builtin_amdgcn_s_waitcnt(0);
        unsigned nloc = b.st[0], nx = b.st[1];
        if (nloc == 0u) { xcd_barrier_complete(bar, b.x, nloc, nx); b.st[0] = nloc; b.st[1] = nx; }
        const unsigned old = xb_add(&bar[XB_XSUB(b.x)], 1u);
        const unsigned gen = old / nloc;
        if (old + 1u == (gen + 1u) * nloc) {
            __builtin_amdgcn_fence(__ATOMIC_RELEASE, "agent");
            asm volatile("s_waitcnt vmcnt(0)" ::: "memory");
            const unsigned og = xb_add(&bar[XB_TOP], 1u);
            const unsigned tg = og / nx;
            if (og + 1u == (tg + 1u) * nx) xb_add(&bar[XB_TOPGEN], 1u);
            else XB_SPIN(xb_ld(&bar[XB_TOPGEN]) == tg, bar);
            __builtin_amdgcn_fence(__ATOMIC_ACQUIRE, "agent");
            xb_add(&bar[XB_XGEN(b.x)], 1u);
            asm volatile("s_waitcnt vmcnt(0)" ::: "memory");
        } else {
            XB_SPIN(xb_ld(&bar[XB_XGEN(b.x)]) == gen, bar);
            __builtin_amdgcn_fence(__ATOMIC_ACQUIRE, "agent");
            asm volatile("s_waitcnt vmcnt(0)" ::: "memory");
        }
    }
    __syncthreads();
}

struct Params {
    const float *x_prompt, *x_sample, *cache_ckv, *cache_krope, *state_lru, *c, *c_ctx;
    const float *w_mod[2], *b_mod[2], *g_mix[2], *g_ffn[2];
    const float *w_in, *g_q, *w_uq, *g_kv, *w_ukv, *conv_w, *conv_b, *w_rg, *b_rg, *w_ig, *b_ig, *lam, *w_o, *w_pool, *s_pool;
    const float *peer_wq[2], *peer_keys[2], *peer_u[2], *peer_v[2];
    const float* g_final;
    float* out;
    unsigned* bar; float* mod; float* ropetab;
    bf16_t *wt_in, *wt_uq, *wt_ukv, *wt_gate, *wt_o, *wt_pool, *wt_pq[2], *keysb[2];
    u8_t *u8[2], *v8[2]; float *su[2], *sv[2];
    bf16_t *hbuf, *P, *cqn, *ckvk, *kropek, *xc, *ug, *q, *Kn, *vT, *bxb, *qp, *h3;
    float *a, *agg, *xres, *gates; int* eidx;
};

extern __shared__ __attribute__((aligned(16))) unsigned char smem[];

__device__ __forceinline__ float bf2f(bf16_t v) { return __uint_as_float(((unsigned)v) << 16); }
typedef __bf16 bf16x2_t __attribute__((ext_vector_type(2)));
__device__ __forceinline__ bf16_t f2bf(float f) { return __builtin_bit_cast(unsigned short, (__bf16)f); }
__device__ __forceinline__ unsigned pack_bf16(float a, float b) { bf16x2_t v = {(__bf16)a, (__bf16)b}; return __builtin_bit_cast(unsigned, v); }
__device__ __forceinline__ float wave_sum(float v) {
    v += __shfl_xor(v, 32); v += __shfl_xor(v, 16); v += __shfl_xor(v, 8); v += __shfl_xor(v, 4); v += __shfl_xor(v, 2); v += __shfl_xor(v, 1); return v;
}
__device__ __forceinline__ float wave_max(float v) {
    v = fmaxf(v, __shfl_xor(v, 32)); v = fmaxf(v, __shfl_xor(v, 16)); v = fmaxf(v, __shfl_xor(v, 8)); v = fmaxf(v, __shfl_xor(v, 4)); v = fmaxf(v, __shfl_xor(v, 2)); v = fmaxf(v, __shfl_xor(v, 1)); return v;
}
__device__ __forceinline__ float gelu_tanh(float x) {
    const float u = 0.7978845608028654f * (x + 0.044715f * x * x * x);
    const float e = __expf(2.f * u);
    const float th = 1.f - 2.f / (e + 1.f);
    return 0.5f * x * (1.f + th);
}
__device__ __forceinline__ float sigmoidf_(float x) { return 1.f / (1.f + __expf(-x)); }
__device__ __forceinline__ float silu_(float x) { return x / (1.f + __expf(-x)); }

struct TokInfo { int smp, b, s, S, mi, keyrow; };
__device__ __forceinline__ TokInfo tokinfo(int T) {
    TokInfo t;
    if (T < T_CTX) { t.smp = 0; t.b = T >> 8; t.s = T & 255; t.S = 256; t.mi = 0; t.keyrow = T; }
    else { const int u = T - T_CTX; t.smp = 1; t.b = u >> 11; t.s = u & 2047; t.S = 2048; t.mi = 1 + t.b; t.keyrow = T_CTX + t.b * 2304 + 256 + t.s; }
    return t;
}
__device__ __forceinline__ const float* x_in_row(const Params& p, int T) { return T < T_CTX ? p.x_prompt + (size_t)T * 1024 : p.x_sample + (size_t)(T - T_CTX) * 1024; }
__device__ __forceinline__ const float* modv(const Params& p, int l, int mi, int j) { return p.mod + ((size_t)(l * 9 + mi) * 6 + j) * 1024; }

__device__ __forceinline__ void unpack8(const uint4 r, float (&f)[8]) {
    f[0] = __uint_as_float(r.x << 16); f[1] = __uint_as_float(r.x & 0xffff0000u);
    f[2] = __uint_as_float(r.y << 16); f[3] = __uint_as_float(r.y & 0xffff0000u);
    f[4] = __uint_as_float(r.z << 16); f[5] = __uint_as_float(r.z & 0xffff0000u);
    f[6] = __uint_as_float(r.w << 16); f[7] = __uint_as_float(r.w & 0xffff0000u);
}

typedef __bf16 bf16x8_t __attribute__((ext_vector_type(8)));
__device__ __forceinline__ int lds_off(int row, int chunk) { return row * 128 + ((chunk ^ ((row >> 1) & 7)) << 4); }
template <int TM, int TN, int WM, int WN>
__device__ __forceinline__ void gemm_acc(const bf16_t* __restrict__ As, int lda, const bf16_t* __restrict__ Bs, int ldb, int K, f32x16 (&acc)[TM][TN]) {
    static_assert(TM * WM == 4 && TN * WN == 4 && WM * WN == 4, "block tile is 128 x 128, 4 waves");
    const int tid = threadIdx.x, lane = tid & 63, wid = tid >> 6, wm = wid / WN, wn = wid % WN, hl = lane >> 5, cl = lane & 31;
#pragma unroll
    for (int i = 0; i < TM; ++i)
#pragma unroll
        for (int j = 0; j < TN; ++j)
#pragma unroll
            for (int r = 0; r < 16; ++r) acc[i][j][r] = 0.f;
    const int srow = tid >> 3, sch = tid & 7;
    const bf16_t* ga = As + (size_t)srow * lda + sch * 8;
    const bf16_t* gb = Bs + (size_t)srow * ldb + sch * 8;
    u32x4 ra[4], rb[4];
#pragma unroll
    for (int i = 0; i < 4; ++i) { ra[i] = *(const u32x4*)(ga + (size_t)(32 * i) * lda); rb[i] = *(const u32x4*)(gb + (size_t)(32 * i) * ldb); }
    __syncthreads();
#pragma unroll
    for (int i = 0; i < 4; ++i) { *(u32x4*)(smem + lds_off(srow + 32 * i, sch)) = ra[i]; *(u32x4*)(smem + 16384 + lds_off(srow + 32 * i, sch)) = rb[i]; }
    __syncthreads();
    const int nk = K >> 6;
    for (int kt = 0; kt < nk; ++kt) {
        const int cur = (kt & 1) * 32768, nxt = 32768 - cur;
        if (kt + 1 < nk) {
#pragma unroll
            for (int i = 0; i < 4; ++i) { ra[i] = *(const u32x4*)(ga + (size_t)(32 * i) * lda + (kt + 1) * 64); rb[i] = *(const u32x4*)(gb + (size_t)(32 * i) * ldb + (kt + 1) * 64); }
        }
#pragma unroll
        for (int ks = 0; ks < 4; ++ks) {
            bf16x8_t af[TM], bfr[TN];
#pragma unroll
            for (int i = 0; i < TM; ++i) af[i] = __builtin_bit_cast(bf16x8_t, *(const u32x4*)(smem + cur + lds_off(32 * (TM * wm + i) + cl, 2 * ks + hl)));
#pragma unroll
            for (int j = 0; j < TN; ++j) bfr[j] = __builtin_bit_cast(bf16x8_t, *(const u32x4*)(smem + cur + 16384 + lds_off(32 * (TN * wn + j) + cl, 2 * ks + hl)));
#pragma unroll
            for (int i = 0; i < TM; ++i)
#pragma unroll
                for (int j = 0; j < TN; ++j) acc[i][j] = __builtin_amdgcn_mfma_f32_32x32x16_bf16(af[i], bfr[j], acc[i][j], 0, 0, 0);
        }
        if (kt + 1 < nk) {
#pragma unroll
            for (int i = 0; i < 4; ++i) { *(u32x4*)(smem + nxt + lds_off(srow + 32 * i, sch)) = ra[i]; *(u32x4*)(smem + nxt + 16384 + lds_off(srow + 32 * i, sch)) = rb[i]; }
        }
        __syncthreads();
    }
}
#define ACC_ROW(TMv, wm, i, r, hl) (32 * ((TMv) * (wm) + (i)) + ((r) & 3) + 8 * ((r) >> 2) + 4 * (hl))
#define ACC_COL(TNv, wn, j, cl)    (32 * ((TNv) * (wn) + (j)) + (cl))

#define N_ADA 192
#define NW_IN   (1792 * 1024)
#define NW_UQ   (768 * 384)
#define NW_UKV  (1024 * 256)
#define NW_GATE (4 * 512 * 128)
#define NW_O    (1024 * 1024)
#define NW_POOL (4 * 256 * 256)
#define NW_PQ   (2048 * 1024)
#define NW_KEYS (16 * 128 * 128)
#define NW_CKV  (8 * 256 * 256)
#define NW_CKR  (8 * 256 * 64)
#define NW_ROPE 3072
#define NW_TOTAL (NW_IN + NW_UQ + NW_UKV + NW_GATE + NW_O + NW_POOL + 2 * NW_PQ + 2 * NW_KEYS + NW_CKV + NW_CKR + NW_ROPE)
#define N_CONV_ITEMS ((NW_TOTAL + 4095) / 4096)
#define N_FP8_ITEMS (65536 / 4)

__device__ __forceinline__ void conv_elem(const Params& p, int e) {
    if (e < NW_IN) { const int n = e >> 10, k = e & 1023; p.wt_in[e] = n < 1728 ? f2bf(p.w_in[(size_t)k * 1728 + n]) : (bf16_t)0; return; } e -= NW_IN;
    if (e < NW_UQ) { const int n = e / 384, k = e % 384; p.wt_uq[e] = f2bf(p.w_uq[(size_t)k * 768 + n]); return; } e -= NW_UQ;
    if (e < NW_UKV) { const int n = e >> 8, k = e & 255; p.wt_ukv[e] = f2bf(p.w_ukv[(size_t)k * 1024 + n]); return; } e -= NW_UKV;
    if (e < NW_GATE) {
        const int c = e & 127, cg = (e >> 7) & 511, nb = e >> 16;
        const int dir = cg >> 8, dg = (cg >> 6) & 3, ri = (cg >> 5) & 1, d = dg * 32 + (cg & 31);
        const float* src = ri ? p.w_ig : p.w_rg;
        p.wt_gate[e] = f2bf(src[(((size_t)dir * 4 + nb) * 128 + c) * 128 + d]); return; } e -= NW_GATE;
    if (e < NW_O) { const int n = e >> 10, k = e & 1023; p.wt_o[e] = f2bf(p.w_o[(size_t)k * 1024 + n]); return; } e -= NW_O;
    if (e < NW_POOL) { const int c = e & 255, d = (e >> 8) & 255, g = e >> 16; p.wt_pool[e] = f2bf(p.w_pool[((size_t)g * 256 + c) * 256 + d]); return; } e -= NW_POOL;
#pragma unroll
    for (int l = 0; l < 2; ++l) { if (e < NW_PQ) { const int n = e >> 10, k = e & 1023; p.wt_pq[l][e] = f2bf(p.peer_wq[l][(size_t)k * 2048 + n]); return; } e -= NW_PQ; }
#pragma unroll
    for (int l = 0; l < 2; ++l) { if (e < NW_KEYS) { p.keysb[l][e] = f2bf(p.peer_keys[l][e]); return; } e -= NW_KEYS; }
    if (e < NW_CKV) { const int col = e & 255, j = (e >> 8) & 255, b = e >> 16; p.ckvk[(size_t)(T_CTX + b * 2304 + j) * 256 + col] = f2bf(p.cache_ckv[e]); return; } e -= NW_CKV;
    if (e < NW_CKR) { const int col = e & 63, j = (e >> 6) & 255, b = e >> 14; p.kropek[(size_t)(T_CTX + b * 2304 + j) * 64 + col] = f2bf(p.cache_krope[e]); return; } e -= NW_CKR;
    if (e < NW_ROPE) {
        int idx = e, isrow = e < 1024; if (!isrow) idx -= 1024;
        const int half = isrow ? 512 : 1024; const int sn = idx >= half; if (sn) idx -= half;
        const int pos = idx >> 4, fi = idx & 15;
        const float invf = exp2f(-(float)fi * (13.287712379549449f / 16.f));
        const float ang = (float)pos * invf;
        p.ropetab[e] = sn ? sinf(ang) : cosf(ang); return; }
}

__device__ void st_prologue(const Params& p) {
    const int tid = threadIdx.x, lane = tid & 63, wid = tid >> 6;
    const int n_items = N_ADA + N_CONV_ITEMS + N_FP8_ITEMS;
    for (int item = blockIdx.x; item < n_items; item += gridDim.x) {
        if (item < N_ADA) {
            float* svec = (float*)smem;
            float* red = (float*)(smem + 9 * 1024 * 4);
            __syncthreads();
            for (int i = tid; i < 9 * 1024; i += 256) { const int bc = i >> 10, k = i & 1023; const float cv = bc == 0 ? p.c_ctx[k] : p.c[(size_t)(bc - 1) * 1024 + k]; svec[i] = silu_(cv); }
            __syncthreads();
            const int cidx = item * 64 + (tid & 63), l = cidx / 6144, col = cidx % 6144, kq = tid >> 6;
            const float* w = p.w_mod[l] + col;
            float acc[9];
#pragma unroll
            for (int b = 0; b < 9; ++b) acc[b] = 0.f;
            for (int k = kq * 256; k < kq * 256 + 256; ++k) {
                const float wv = w[(size_t)k * 6144];
#pragma unroll
                for (int b = 0; b < 9; ++b) acc[b] += wv * svec[b * 1024 + k];
            }
#pragma unroll
            for (int b = 0; b < 9; ++b) red[(kq * 9 + b) * 64 + (tid & 63)] = acc[b];
            __syncthreads();
            if (kq == 0) {
                const float bias = p.b_mod[l][col];
#pragma unroll
                for (int b = 0; b < 9; ++b) {
                    const int c64 = tid & 63;
                    const float v = red[(0 * 9 + b) * 64 + c64] + red[(1 * 9 + b) * 64 + c64] + red[(2 * 9 + b) * 64 + c64] + red[(3 * 9 + b) * 64 + c64] + bias;
                    p.mod[(size_t)(l * 9 + b) * 6144 + col] = v;
                }
            }
        } else if (item < N_ADA + N_CONV_ITEMS) {
            const int base = (item - N_ADA) * 4096;
            for (int i = tid; i < 4096; i += 256) { const int e = base + i; if (e < NW_TOTAL) conv_elem(p, e); }
        } else {
            const int row = (item - N_ADA - N_CONV_ITEMS) * 4 + wid;
            const int tb = row >> 14, er = row & 16383, l = tb >> 1;
            const float* src = ((tb & 1) ? p.peer_v[l] : p.peer_u[l]) + (size_t)er * 1024 + lane * 16;
            u8_t* dst = ((tb & 1) ? p.v8[l] : p.u8[l]) + (size_t)er * 1024 + lane * 16;
            float* sc = ((tb & 1) ? p.sv[l] : p.su[l]) + er;
            float v[16];
#pragma unroll
            for (int j = 0; j < 4; ++j) { const float4 f = *(const float4*)(src + 4 * j); v[4 * j] = f.x; v[4 * j + 1] = f.y; v[4 * j + 2] = f.z; v[4 * j + 3] = f.w; }
            float am = 0.f;
#pragma unroll
            for (int j = 0; j < 16; ++j) am = fmaxf(am, fabsf(v[j]));
            am = wave_max(am);
            const float scale = am > 0.f ? am * (1.f / 224.f) : 1.f, inv = am > 0.f ? 224.f / am : 1.f;
            unsigned w[4];
#pragma unroll
            for (int j = 0; j < 4; ++j) {
                int pk = 0;
                pk = __builtin_amdgcn_cvt_pk_fp8_f32(v[4 * j] * inv, v[4 * j + 1] * inv, pk, false);
                pk = __builtin_amdgcn_cvt_pk_fp8_f32(v[4 * j + 2] * inv, v[4 * j + 3] * inv, pk, true);
                w[j] = (unsigned)pk;
            }
            *(uint4*)dst = make_uint4(w[0], w[1], w[2], w[3]);
            if (lane == 0) *sc = scale;
        }
    }
}

template <int SRC>
__device__ void st_norm(const Params& p, int l, int which, const float* g, bf16_t* dst) {
    const int lane = threadIdx.x & 63, wid = threadIdx.x >> 6;
    for (int T = blockIdx.x * 4 + wid; T < T_TOK; T += gridDim.x * 4) {
        const float* src = (SRC == 0 ? x_in_row(p, T) : p.xres + (size_t)T * 1024) + lane * 16;
        const TokInfo ti = tokinfo(T);
        float v[16]; float ss = 0.f;
#pragma unroll
        for (int j = 0; j < 4; ++j) { const float4 f = *(const float4*)(src + 4 * j); v[4 * j] = f.x; v[4 * j + 1] = f.y; v[4 * j + 2] = f.z; v[4 * j + 3] = f.w; }
#pragma unroll
        for (int j = 0; j < 16; ++j) ss += v[j] * v[j];
        ss = wave_sum(ss);
        const float rstd = rsqrtf(ss * (1.f / 1024.f) + 1e-6f);
        const float* sh = modv(p, l, ti.mi, which ? 3 : 0) + lane * 16; const float* sc = modv(p, l, ti.mi, which ? 4 : 1) + lane * 16; const float* gg = g + lane * 16;
        unsigned w[8];
#pragma unroll
        for (int j = 0; j < 8; ++j) {
            const float a0 = v[2 * j] * rstd * gg[2 * j] * (1.f + sc[2 * j]) + sh[2 * j];
            const float a1 = v[2 * j + 1] * rstd * gg[2 * j + 1] * (1.f + sc[2 * j + 1]) + sh[2 * j + 1];
            w[j] = (unsigned)f2bf(a0) | ((unsigned)f2bf(a1) << 16);
        }
        uint4* d = (uint4*)(dst + (size_t)T * 1024 + lane * 16);
        d[0] = make_uint4(w[0], w[1], w[2], w[3]); d[1] = make_uint4(w[4], w[5], w[6], w[7]);
    }
}

__device__ void st_gemm1(const Params& p) {
    const int lane = threadIdx.x & 63, wid = threadIdx.x >> 6, wm = wid >> 1, wn = wid & 1, hl = lane >> 5, cl = lane & 31;
    for (int item = blockIdx.x; item < 160 * 14; item += gridDim.x) {
        const int tn = item % 14, tm = item / 14;
        f32x16 acc[2][2];
        gemm_acc<2, 2, 2, 2>(p.hbuf + (size_t)tm * 128 * 1024, 1024, p.wt_in + (size_t)tn * 128 * 1024, 1024, 1024, acc);
#pragma unroll
        for (int i = 0; i < 2; ++i)
#pragma unroll
            for (int j = 0; j < 2; ++j)
#pragma unroll
                for (int r = 0; r < 16; ++r) {
                    const int row = tm * 128 + ACC_ROW(2, wm, i, r, hl), col = tn * 128 + ACC_COL(2, wn, j, cl);
                    p.P[(size_t)row * 1792 + col] = f2bf(acc[i][j][r]);
                }
    }
}

__device__ void st_postproj(const Params& p) {
    const int lane = threadIdx.x & 63, wid = threadIdx.x >> 6;
    float* o_ckv = p.out + 20971520, *o_kr = p.out + 22020096;
    for (int T = blockIdx.x * 4 + wid; T < T_TOK; T += gridDim.x * 4) {
        const TokInfo ti = tokinfo(T);
        const bf16_t* Pr = p.P + (size_t)T * 1792;
        {
            float v[6]; float ss = 0.f;
#pragma unroll
            for (int j = 0; j < 6; ++j) { v[j] = bf2f(Pr[lane + 64 * j]); ss += v[j] * v[j]; }
            ss = wave_sum(ss);
            const float rstd = rsqrtf(ss * (1.f / 384.f) + 1e-6f);
#pragma unroll
            for (int j = 0; j < 6; ++j) p.cqn[(size_t)T * 384 + lane + 64 * j] = f2bf(v[j] * rstd * p.g_q[lane + 64 * j]);
        }
        {
            float v[4]; float ss = 0.f;
#pragma unroll
            for (int j = 0; j < 4; ++j) { v[j] = bf2f(Pr[384 + lane + 64 * j]); ss += v[j] * v[j]; }
            ss = wave_sum(ss);
            const float rstd = rsqrtf(ss * (1.f / 256.f) + 1e-6f);
#pragma unroll
            for (int j = 0; j < 4; ++j) {
                const float y = v[j] * rstd * p.g_kv[lane + 64 * j];
                p.ckvk[(size_t)ti.keyrow * 256 + lane + 64 * j] = f2bf(y);
                if (!ti.smp) o_ckv[(size_t)T * 256 + lane + 64 * j] = y;
            }
        }
        {
            const float v = bf2f(Pr[640 + lane]);
            float y = v;
            if (ti.smp) {
                const float o = __shfl_xor(v, 1);
                const int pr = lane >> 1, gr = ti.s >> 6, gc = ti.s & 63;
                const float cs = pr < 16 ? p.ropetab[gr * 16 + pr] : p.ropetab[1024 + gc * 16 + (pr - 16)];
                const float sn = pr < 16 ? p.ropetab[512 + gr * 16 + pr] : p.ropetab[2048 + gc * 16 + (pr - 16)];
                y = (lane & 1) ? (o * sn + v * cs) : (v * cs - o * sn);
            } else {
                o_kr[(size_t)T * 64 + lane] = v;
            }
            p.kropek[(size_t)ti.keyrow * 64 + lane] = f2bf(y);
        }
        {
#pragma unroll
            for (int j = 0; j < 8; ++j) {
                const int ch = lane + 64 * j;
                float y = p.conv_b[ch];
#pragma unroll
                for (int k = 0; k < 4; ++k) {
                    const int s2 = ti.s + k - 2;
                    if (s2 >= 0 && s2 < ti.S) y += p.conv_w[k * 512 + ch] * bf2f(p.P[(size_t)(T + k - 2) * 1792 + 704 + ch]);
                }
                p.xc[(size_t)T * 512 + ch] = f2bf(y);
                p.ug[(size_t)T * 512 + ch] = Pr[1216 + ch];
            }
        }
    }
}

#define N_G2 (160 * 6)
#define N_G3 (176 * 8)
#define N_G4 (160 * 16)
__device__ void st_gemm234(const Params& p) {
    const int lane = threadIdx.x & 63, wid = threadIdx.x >> 6, wm = wid >> 1, wn = wid & 1, hl = lane >> 5, cl = lane & 31;
    for (int item = blockIdx.x; item < N_G2 + N_G3 + N_G4; item += gridDim.x) {
        f32x16 acc[2][2];
        if (item < N_G2) {
            const int tn = item % 6, tm = item / 6;
            gemm_acc<2, 2, 2, 2>(p.wt_uq + (size_t)tn * 128 * 384, 384, p.cqn + (size_t)tm * 128 * 384, 384, 384, acc);
            const float qs = 0.07216878364870322f * 1.4426950408889634f;
#pragma unroll
            for (int j = 0; j < 2; ++j) {
                const int T = tm * 128 + ACC_COL(2, wn, j, cl);
                const TokInfo ti = tokinfo(T);
                const int gr = ti.s >> 6, gc = ti.s & 63;
#pragma unroll
                for (int i = 0; i < 2; ++i)
#pragma unroll
                    for (int r = 0; r < 16; r += 2) {
                        const int n = tn * 128 + ACC_ROW(2, wm, i, r, hl);
                        float v0 = acc[i][j][r], v1 = acc[i][j][r + 1];
                        const int d = n % 192;
                        if (ti.smp && d >= 128) {
                            const int pr = (d - 128) >> 1;
                            const float cs = pr < 16 ? p.ropetab[gr * 16 + pr] : p.ropetab[1024 + gc * 16 + (pr - 16)];
                            const float sn = pr < 16 ? p.ropetab[512 + gr * 16 + pr] : p.ropetab[2048 + gc * 16 + (pr - 16)];
                            const float t0 = v0 * cs - v1 * sn, t1 = v0 * sn + v1 * cs; v0 = t0; v1 = t1;
                        }
                        *(unsigned*)(p.q + (size_t)T * 768 + n) = (unsigned)f2bf(v0 * qs) | ((unsigned)f2bf(v1 * qs) << 16);
                    }
            }
        } else if (item < N_G2 + N_G3) {
            const int it = item - N_G2, tn = it & 7, tm = it >> 3, h = tn >> 1;
            if ((tn & 1) == 0) {
                gemm_acc<2, 2, 2, 2>(p.ckvk + (size_t)tm * 128 * 256, 256, p.wt_ukv + (size_t)tn * 128 * 256, 256, 256, acc);
#pragma unroll
                for (int i = 0; i < 2; ++i)
#pragma unroll
                    for (int j = 0; j < 2; ++j)
#pragma unroll
                        for (int r = 0; r < 16; ++r) {
                            const int row = tm * 128 + ACC_ROW(2, wm, i, r, hl), dcol = ACC_COL(2, wn, j, cl);
                            p.Kn[(size_t)row * 512 + h * 128 + dcol] = f2bf(acc[i][j][r]);
                        }
            } else {
                gemm_acc<2, 2, 2, 2>(p.wt_ukv + (size_t)tn * 128 * 256, 256, p.ckvk + (size_t)tm * 128 * 256, 256, 256, acc);
#pragma unroll
                for (int j = 0; j < 2; ++j) {
                    const int R = tm * 128 + ACC_COL(2, wn, j, cl);
                    size_t base; int Sk, pos;
                    if (R < T_CTX) { Sk = 256; pos = R & 255; base = (size_t)((R >> 8) * 4 + h) * 128 * 256; }
                    else { const int u = R - T_CTX; Sk = 2304; pos = u % 2304; base = (size_t)T_CTX * 512 + (size_t)((u / 2304) * 4 + h) * 128 * 2304; }
#pragma unroll
                    for (int i = 0; i < 2; ++i)
#pragma unroll
                        for (int r = 0; r < 16; ++r) {
                            const int dv = ACC_ROW(2, wm, i, r, hl);
                            p.vT[base + (size_t)dv * Sk + pos] = f2bf(acc[i][j][r]);
                        }
                }
            }
        } else {
            const int it = item - N_G2 - N_G3, tj = it & 3, nb = (it >> 2) & 3, tm = it >> 4;
            gemm_acc<2, 2, 2, 2>(p.xc + (size_t)tm * 128 * 512 + nb * 128, 512, p.wt_gate + ((size_t)nb * 512 + tj * 128) * 128, 128, 128, acc);
            const int dir = tj >> 1, dg = (tj & 1) * 2 + wn, ch = nb * 128 + dg * 32 + cl;
            const float brg = p.b_rg[dir * 512 + ch], big = p.b_ig[dir * 512 + ch];
            const float nl = -p.lam[dir * 512 + ch];
            const float sp = fmaxf(nl, 0.f) + log1pf(__expf(-fabsf(nl)));
#pragma unroll
            for (int i = 0; i < 2; ++i)
#pragma unroll
                for (int r = 0; r < 16; ++r) {
                    const int T = tm * 128 + ACC_ROW(2, wm, i, r, hl);
                    const float rg = sigmoidf_(acc[i][0][r] + brg), ig = sigmoidf_(acc[i][1][r] + big);
                    const float la = -8.f * rg * sp;
                    const float av = __expf(la);
                    const float mult = sqrtf(fmaxf(-expm1f(2.f * la), 0.f));
                    const float xv = bf2f(p.xc[(size_t)T * 512 + ch]);
                    p.a[((size_t)T * 2 + dir) * 512 + ch] = av;
                    p.bxb[((size_t)T * 2 + dir) * 512 + ch] = f2bf(mult * ig * xv);
                }
        }
    }
}

#define N_ATT (128 + 512)
#define N_S1 (640 * 4)
__device__ void scan_s1_item(const Params& p, int it) {
    const int chunk = it >> 2, dc = (it & 3) * 256 + threadIdx.x, dir = dc >> 9, ch = dc & 511;
    const int T0 = chunk * 32;
    float A = 1.f, B = 0.f;
    for (int i = 0; i < 32; ++i) {
        const int T = dir ? (T0 + 31 - i) : (T0 + i);
        const float av = p.a[((size_t)T * 2 + dir) * 512 + ch], bv = bf2f(p.bxb[((size_t)T * 2 + dir) * 512 + ch]);
        A *= av; B = B * av + bv;
    }
    *(float2*)(p.agg + (((size_t)chunk * 2 + dir) * 512 + ch) * 2) = make_float2(A, B);
}
__device__ void attn_item_simple(const Params& p, int it) {
    int seq, h, qb, Sk, T0, R0; size_t vbase;
    if (it < 128) { seq = it >> 3; h = (it >> 1) & 3; qb = it & 1; Sk = 256; T0 = seq * 256 + qb * 128; R0 = seq * 256; vbase = (size_t)(seq * 4 + h) * 128 * 256; }
    else { const int u = it - 128; seq = u >> 6; h = (u >> 4) & 3; qb = u & 15; Sk = 2304; T0 = T_CTX + seq * 2048 + qb * 128; R0 = T_CTX + seq * 2304; vbase = (size_t)T_CTX * 512 + (size_t)(seq * 4 + h) * 128 * 2304; }
    const int tid = threadIdx.x, qi = tid >> 1, half = tid & 1;
    const int T = T0 + qi;
    __syncthreads();
    {
        const uint4* qg = (const uint4*)(p.q + (size_t)T0 * 768 + h * 192);
        for (int i = tid; i < 128 * 24; i += 256) { const int r = i / 24, c = i % 24; ((uint4*)smem)[i] = qg[(size_t)r * 96 + c]; }
    }
    __syncthreads();
    const uint4* qv4 = (const uint4*)smem + qi * 24;
    float o[64];
#pragma unroll
    for (int j = 0; j < 64; ++j) o[j] = 0.f;
    float m = -1e30f, l = 0.f;
    for (int key = 0; key < Sk; ++key) {
        const uint4* k4 = (const uint4*)(p.Kn + (size_t)(R0 + key) * 512 + h * 128);
        const uint4* r4 = (const uint4*)(p.kropek + (size_t)(R0 + key) * 64);
        float s = 0.f;
#pragma unroll 4
        for (int j = 0; j < 24; ++j) {
            const uint4 kk = j < 16 ? k4[j] : r4[j - 16];
            const uint4 qq = qv4[j];
            const unsigned kw[4] = {kk.x, kk.y, kk.z, kk.w}, qw[4] = {qq.x, qq.y, qq.z, qq.w};
#pragma unroll
            for (int e = 0; e < 4; ++e) {
                const unsigned a = qw[e], b = kw[e];
                s += __uint_as_float(a << 16) * __uint_as_float(b << 16) + __uint_as_float(a & 0xffff0000u) * __uint_as_float(b & 0xffff0000u);
            }
        }
        const float mn = fmaxf(m, s), alpha = exp2f(m - mn), pe = exp2f(s - mn);
        l = l * alpha + pe; m = mn;
        const bf16_t* vp = p.vT + vbase + (size_t)(half * 64) * Sk + key;
#pragma unroll
        for (int j = 0; j < 64; ++j) o[j] = o[j] * alpha + pe * bf2f(vp[(size_t)j * Sk]);
    }
    const float inv = 1.f / l;
    bf16_t* dst = p.hbuf + (size_t)T * 1024 + h * 128 + half * 64;
#pragma unroll
    for (int j = 0; j < 64; j += 2) *(unsigned*)(dst + j) = (unsigned)f2bf(o[j] * inv) | ((unsigned)f2bf(o[j + 1] * inv) << 16);
}

__device__ __forceinline__ int perm23(int r) { return (r & 0x13) | ((r & 4) << 1) | ((r & 8) >> 1); }
__device__ void attn_item_mfma(const Params& p, int it) {
    int seq, h, qb, Sk, T0, R0; size_t vbase;
    if (it < 128) { seq = it >> 3; h = (it >> 1) & 3; qb = it & 1; Sk = 256; T0 = seq * 256 + qb * 128; R0 = seq * 256; vbase = (size_t)(seq * 4 + h) * 128 * 256; }
    else { const int u = it - 128; seq = u >> 6; h = (u >> 4) & 3; qb = u & 15; Sk = 2304; T0 = T_CTX + seq * 2048 + qb * 128; R0 = T_CTX + seq * 2304; vbase = (size_t)T_CTX * 512 + (size_t)(seq * 4 + h) * 128 * 2304; }
    const int tid = threadIdx.x, lane = tid & 63, wid = tid >> 6, hl = lane >> 5, cl = lane & 31;
    bf16x8_t qf[12];
    {
        const bf16_t* qrow = p.q + (size_t)(T0 + 32 * wid + cl) * 768 + h * 192 + 8 * hl;
#pragma unroll
        for (int ks = 0; ks < 12; ++ks) qf[ks] = __builtin_bit_cast(bf16x8_t, *(const u32x4*)(qrow + 16 * ks));
    }
    f32x16 oacc[4];
#pragma unroll
    for (int d = 0; d < 4; ++d)
#pragma unroll
        for (int r = 0; r < 16; ++r) oacc[d][r] = 0.f;
    float m = -1e30f, lsum = 0.f;
    const bf16_t* gk = p.Kn + (size_t)(R0 + (tid >> 4)) * 512 + h * 128 + (tid & 15) * 8;
    const bf16_t* gr = p.kropek + (size_t)(R0 + (tid >> 3)) * 64 + (tid & 7) * 8;
    const bf16_t* gv = p.vT + vbase + (size_t)(tid >> 3) * Sk + (tid & 7) * 8;
    const int lk = ((tid & 15) >> 3) * 8192 + lds_off(tid >> 4, tid & 7);
    u32x4 rk[4], rr[2], rv[4];
    const int nt = Sk >> 6;
#pragma unroll
    for (int i = 0; i < 4; ++i) rk[i] = *(const u32x4*)(gk + (size_t)(16 * i) * 512);
#pragma unroll
    for (int i = 0; i < 2; ++i) rr[i] = *(const u32x4*)(gr + (size_t)(32 * i) * 64);
#pragma unroll
    for (int i = 0; i < 4; ++i) rv[i] = *(const u32x4*)(gv + (size_t)(32 * i) * Sk);
    (void)lk;
    __syncthreads();
    for (int t = 0; t < nt; ++t) {
#pragma unroll
        for (int i = 0; i < 4; ++i) *(u32x4*)(smem + ((tid & 15) >> 3) * 8192 + lds_off((tid >> 4) + 16 * i, tid & 7)) = rk[i];
#pragma unroll
        for (int i = 0; i < 2; ++i) *(u32x4*)(smem + 16384 + lds_off((tid >> 3) + 32 * i, tid & 7)) = rr[i];
#pragma unroll
        for (int i = 0; i < 4; ++i) *(u32x4*)(smem + 24576 + lds_off((tid >> 3) + 32 * i, tid & 7)) = rv[i];
        __syncthreads();
        if (t + 1 < nt) {
            const size_t ko = (size_t)(t + 1) * 64;
#pragma unroll
            for (int i = 0; i < 4; ++i) rk[i] = *(const u32x4*)(gk + (ko + 16 * i) * 512);
#pragma unroll
            for (int i = 0; i < 2; ++i) rr[i] = *(const u32x4*)(gr + (ko + 32 * i) * 64);
#pragma unroll
            for (int i = 0; i < 4; ++i) rv[i] = *(const u32x4*)(gv + (size_t)(32 * i) * Sk + ko);
        }
        f32x16 sacc[2];
#pragma unroll
        for (int kb = 0; kb < 2; ++kb) {
#pragma unroll
            for (int r = 0; r < 16; ++r) sacc[kb][r] = 0.f;
            const int krow = 32 * kb + perm23(cl);
#pragma unroll
            for (int ks = 0; ks < 12; ++ks) {
                const bf16x8_t kf = __builtin_bit_cast(bf16x8_t, *(const u32x4*)(smem + (ks >> 2) * 8192 + lds_off(krow, 2 * (ks & 3) + hl)));
                sacc[kb] = __builtin_amdgcn_mfma_f32_32x32x16_bf16(kf, qf[ks], sacc[kb], 0, 0, 0);
            }
        }
        float mx = sacc[0][0];
#pragma unroll
        for (int r = 1; r < 16; ++r) mx = fmaxf(mx, sacc[0][r]);
#pragma unroll
        for (int r = 0; r < 16; ++r) mx = fmaxf(mx, sacc[1][r]);
        mx = fmaxf(mx, __shfl_xor(mx, 32));
        const float mn = fmaxf(m, mx), alpha = __builtin_amdgcn_exp2f(m - mn);
        m = mn;
        float ps = 0.f;
        bf16x8_t pf[2][2];
#pragma unroll
        for (int kb = 0; kb < 2; ++kb)
#pragma unroll
            for (int s2 = 0; s2 < 2; ++s2) {
                float e[8];
#pragma unroll
                for (int j = 0; j < 8; ++j) { e[j] = __builtin_amdgcn_exp2f(sacc[kb][8 * s2 + j] - mn); ps += e[j]; }
                u32x4 w; w.x = pack_bf16(e[0], e[1]); w.y = pack_bf16(e[2], e[3]); w.z = pack_bf16(e[4], e[5]); w.w = pack_bf16(e[6], e[7]);
                pf[kb][s2] = __builtin_bit_cast(bf16x8_t, w);
            }
        lsum = lsum * alpha + ps;
#pragma unroll
        for (int d = 0; d < 4; ++d)
#pragma unroll
            for (int r = 0; r < 16; ++r) oacc[d][r] *= alpha;
#pragma unroll
        for (int d = 0; d < 4; ++d)
#pragma unroll
            for (int kb = 0; kb < 2; ++kb)
#pragma unroll
                for (int s2 = 0; s2 < 2; ++s2) {
                    const bf16x8_t vf = __builtin_bit_cast(bf16x8_t, *(const u32x4*)(smem + 24576 + lds_off(32 * d + cl, 4 * kb + 2 * s2 + hl)));
                    oacc[d] = __builtin_amdgcn_mfma_f32_32x32x16_bf16(vf, pf[kb][s2], oacc[d], 0, 0, 0);
                }
        __syncthreads();
    }
    lsum += __shfl_xor(lsum, 32);
    const float inv = 1.f / lsum;
    bf16_t* dst = p.hbuf + (size_t)(T0 + 32 * wid + cl) * 1024 + h * 128 + 4 * hl;
#pragma unroll
    for (int d = 0; d < 4; ++d)
#pragma unroll
        for (int g = 0; g < 4; ++g) {
            uint2 w; w.x = pack_bf16(oacc[d][4 * g] * inv, oacc[d][4 * g + 1] * inv); w.y = pack_bf16(oacc[d][4 * g + 2] * inv, oacc[d][4 * g + 3] * inv);
            *(uint2*)(dst + 32 * d + 8 * g) = w;
        }
}
__device__ void st_attn_s1(const Params& p) {
    for (int item = blockIdx.x; item < N_ATT + N_S1; item += gridDim.x) {
        if (item < N_ATT) {
#ifdef ATTN_SIMPLE
            attn_item_simple(p, N_ATT - 1 - item);
#else
            attn_item_mfma(p, N_ATT - 1 - item);
#endif
        }
        else scan_s1_item(p, item - N_ATT);
    }
}

__device__ void st_scan3(const Params& p) {
    const int tid = threadIdx.x;
    float* hf = (float*)smem;
    float* hb = hf + 32 * 128;
    float* o_lru = p.out + 22282240;
    for (int item = blockIdx.x; item < 640 * 4; item += gridDim.x) {
        const int chunk = item >> 2, cgp = item & 3, T0 = chunk * 32;
        const TokInfo ti = tokinfo(T0);
        const int nch = ti.S >> 5, c0 = chunk - (ti.s >> 5), cpos = ti.s >> 5;
        const int dir = tid >> 7, ch = cgp * 128 + (tid & 127);
        float hcur = ti.smp ? p.state_lru[((size_t)ti.b * 2 + dir) * 512 + ch] : 0.f;
        if (dir == 0) { for (int cc = 0; cc < cpos; ++cc) { const float2 ab = *(const float2*)(p.agg + (((size_t)(c0 + cc) * 2 + 0) * 512 + ch) * 2); hcur = ab.x * hcur + ab.y; } }
        else { for (int cc = nch - 1; cc > cpos; --cc) { const float2 ab = *(const float2*)(p.agg + (((size_t)(c0 + cc) * 2 + 1) * 512 + ch) * 2); hcur = ab.x * hcur + ab.y; } }
        __syncthreads();
        for (int i = 0; i < 32; ++i) {
            const int tl = dir ? 31 - i : i, T = T0 + tl;
            const float av = p.a[((size_t)T * 2 + dir) * 512 + ch], bv = bf2f(p.bxb[((size_t)T * 2 + dir) * 512 + ch]);
            hcur = av * hcur + bv;
            (dir ? hb : hf)[tl * 128 + (tid & 127)] = hcur;
        }
        if (!ti.smp) {
            if (dir == 0 && cpos == nch - 1) o_lru[((size_t)ti.b * 2 + 0) * 512 + ch] = hcur;
            if (dir == 1 && cpos == 0) o_lru[((size_t)ti.b * 2 + 1) * 512 + ch] = hcur;
        }
        __syncthreads();
        for (int i = tid; i < 32 * 128; i += 256) {
            const int tl = i >> 7, c = i & 127, T = T0 + tl, chh = cgp * 128 + c;
            const float g = gelu_tanh(bf2f(p.ug[(size_t)T * 512 + chh]));
            p.hbuf[(size_t)T * 1024 + 512 + chh] = f2bf((hf[i] + hb[i]) * g);
        }
    }
}

__device__ void st_gemm_o(const Params& p) {
    const int lane = threadIdx.x & 63, wid = threadIdx.x >> 6, wm = wid >> 1, wn = wid & 1, hl = lane >> 5, cl = lane & 31;
    for (int item = blockIdx.x; item < 160 * 8; item += gridDim.x) {
        const int tn = item & 7, tm = item >> 3;
        f32x16 acc[2][2];
        gemm_acc<2, 2, 2, 2>(p.hbuf + (size_t)tm * 128 * 1024, 1024, p.wt_o + (size_t)tn * 128 * 1024, 1024, 1024, acc);
        const int mi = tokinfo(tm * 128).mi;
#pragma unroll
        for (int j = 0; j < 2; ++j) {
            const int col = tn * 128 + ACC_COL(2, wn, j, cl);
            const float gt = modv(p, 0, mi, 2)[col];
#pragma unroll
            for (int i = 0; i < 2; ++i)
#pragma unroll
                for (int r = 0; r < 16; ++r) {
                    const int row = tm * 128 + ACC_ROW(2, wm, i, r, hl);
                    p.xres[(size_t)row * 1024 + col] = x_in_row(p, row)[col] + gt * acc[i][j][r];
                }
        }
    }
}

__device__ void st_gemm_pq(const Params& p, int l) {
    const int lane = threadIdx.x & 63, wid = threadIdx.x >> 6, wm = wid >> 1, wn = wid & 1, hl = lane >> 5, cl = lane & 31;
    for (int item = blockIdx.x; item < 160 * 16; item += gridDim.x) {
        const int tn = item & 15, tm = item >> 4;
        f32x16 acc[2][2];
        gemm_acc<2, 2, 2, 2>(p.hbuf + (size_t)tm * 128 * 1024, 1024, p.wt_pq[l] + (size_t)tn * 128 * 1024, 1024, 1024, acc);
#pragma unroll
        for (int i = 0; i < 2; ++i)
#pragma unroll
            for (int j = 0; j < 2; ++j)
#pragma unroll
                for (int r = 0; r < 16; ++r) {
                    const int row = tm * 128 + ACC_ROW(2, wm, i, r, hl), col = tn * 128 + ACC_COL(2, wn, j, cl);
                    p.qp[(size_t)row * 2048 + col] = f2bf(acc[i][j][r]);
                }
    }
}

__device__ __forceinline__ void ins16(float (&top)[16], float x) {
#pragma unroll
    for (int i = 0; i < 16; ++i) { const float hi = fmaxf(top[i], x); x = fminf(top[i], x); top[i] = hi; }
}
__device__ void st_peer_topk(const Params& p, int l) {
    const int lane = threadIdx.x & 63, wid = threadIdx.x >> 6, hl = lane >> 5, cl = lane & 31;
    for (int item = blockIdx.x; item < 160 * 8; item += gridDim.x) {
        const int h = item & 7, tm = item >> 3;
        const int T = tm * 128 + 32 * wid + cl;
        float top[2][16];
#pragma unroll
        for (int pp = 0; pp < 2; ++pp) {
            f32x16 acc[4][1];
            gemm_acc<4, 1, 1, 4>(p.keysb[l] + (size_t)(h * 2 + pp) * 128 * 128, 128, p.qp + (size_t)tm * 128 * 2048 + h * 256 + pp * 128, 2048, 128, acc);
#pragma unroll
            for (int i = 0; i < 16; ++i) top[pp][i] = -INFINITY;
#pragma unroll
            for (int i = 0; i < 4; ++i) {
                __builtin_amdgcn_sched_barrier(0);
#pragma unroll
                for (int r = 0; r < 16; ++r) {
                    const int n = ACC_ROW(4, 0, i, r, hl);
                    const float x = __uint_as_float((__float_as_uint(acc[i][0][r]) & 0xffffff80u) | (unsigned)n);
                    ins16(top[pp], x);
                }
            }
            __builtin_amdgcn_sched_barrier(0);
            float oth[16];
#pragma unroll
            for (int i = 0; i < 16; ++i) oth[i] = __shfl_xor(top[pp][i], 32);
#pragma unroll
            for (int i = 0; i < 16; ++i) ins16(top[pp], oth[i]);
        }
        float fv[16];
#pragma unroll
        for (int i = 0; i < 16; ++i) fv[i] = -INFINITY;
#pragma unroll
        for (int i = 0; i < 16; ++i)
#pragma unroll
            for (int j = 0; j < 16; ++j)
                if ((i + 1) * (j + 1) <= 16) {
                    const float cv = __uint_as_float(__float_as_uint(top[0][i]) & 0xffffff80u) + __uint_as_float(__float_as_uint(top[1][j]) & 0xffffff80u);
                    ins16(fv, __uint_as_float((__float_as_uint(cv) & 0xffffff00u) | (unsigned)(i * 16 + j)));
                }
        unsigned* tab = (unsigned*)smem + (size_t)threadIdx.x * 8;
#pragma unroll
        for (int k = 0; k < 4; ++k) {
            tab[k] = (__float_as_uint(top[0][4 * k]) & 127u) | ((__float_as_uint(top[0][4 * k + 1]) & 127u) << 8) | ((__float_as_uint(top[0][4 * k + 2]) & 127u) << 16) | ((__float_as_uint(top[0][4 * k + 3]) & 127u) << 24);
            tab[4 + k] = (__float_as_uint(top[1][4 * k]) & 127u) | ((__float_as_uint(top[1][4 * k + 1]) & 127u) << 8) | ((__float_as_uint(top[1][4 * k + 2]) & 127u) << 16) | ((__float_as_uint(top[1][4 * k + 3]) & 127u) << 24);
        }
        const u8_t* tabb = (const u8_t*)tab;
        int fe[16];
#pragma unroll
        for (int i = 0; i < 16; ++i) {
            const unsigned code = __float_as_uint(fv[i]) & 255u;
            fe[i] = (int)tabb[code >> 4] * 128 + (int)tabb[16 + (code & 15u)];
            fv[i] = __uint_as_float(__float_as_uint(fv[i]) & 0xffffff00u);
        }
        float sum = 0.f, ev[16];
#pragma unroll
        for (int i = 0; i < 16; ++i) { ev[i] = __expf(fv[i] - fv[0]); sum += ev[i]; }
        const float inv = 1.f / sum;
        if (hl == 0) {
#pragma unroll
            for (int i = 0; i < 16; ++i) { p.gates[(size_t)T * 128 + h * 16 + i] = ev[i] * inv; p.eidx[(size_t)T * 128 + h * 16 + i] = fe[i]; }
        }
    }
}

__device__ void st_peer_gather(const Params& p, int l) {
    const int lane = threadIdx.x & 63, wid = threadIdx.x >> 6;
    const u8_t* U = p.u8[l]; const u8_t* V = p.v8[l]; const float* SU = p.su[l]; const float* SV = p.sv[l];
    for (int T = blockIdx.x * 4 + wid; T < T_TOK; T += gridDim.x * 4) {
        const TokInfo ti = tokinfo(T);
        float hv[16];
        {
            const uint4* hp = (const uint4*)(p.hbuf + (size_t)T * 1024 + lane * 16);
            float t8[8]; unpack8(hp[0], t8);
#pragma unroll
            for (int j = 0; j < 8; ++j) hv[j] = t8[j];
            unpack8(hp[1], t8);
#pragma unroll
            for (int j = 0; j < 8; ++j) hv[8 + j] = t8[j];
        }
        const int e0 = p.eidx[(size_t)T * 128 + lane], e1 = p.eidx[(size_t)T * 128 + 64 + lane];
        const float g0 = p.gates[(size_t)T * 128 + lane], g1 = p.gates[(size_t)T * 128 + 64 + lane];
        float outv[16];
#pragma unroll
        for (int j = 0; j < 16; ++j) outv[j] = 0.f;
        for (int k = 0; k < 128; ++k) {
            const int e = __builtin_amdgcn_readlane(k < 64 ? e0 : e1, k & 63);
            const float gk = __int_as_float(__builtin_amdgcn_readlane(__float_as_int(k < 64 ? g0 : g1), k & 63));
            const uint4 ur = *(const uint4*)(U + (size_t)e * 1024 + lane * 16);
            const uint4 vr = *(const uint4*)(V + (size_t)e * 1024 + lane * 16);
            const unsigned uw[4] = {ur.x, ur.y, ur.z, ur.w}, vw[4] = {vr.x, vr.y, vr.z, vr.w};
            float d = 0.f;
#pragma unroll
            for (int j = 0; j < 4; ++j) {
                const f32x2 lo = __builtin_amdgcn_cvt_pk_f32_fp8((int)uw[j], false), hi = __builtin_amdgcn_cvt_pk_f32_fp8((int)uw[j], true);
                d += lo.x * hv[4 * j] + lo.y * hv[4 * j + 1] + hi.x * hv[4 * j + 2] + hi.y * hv[4 * j + 3];
            }
            d = wave_sum(d);
            const float z = d * SU[e];
            const float w = gk * gelu_tanh(z) * SV[e];
#pragma unroll
            for (int j = 0; j < 4; ++j) {
                const f32x2 lo = __builtin_amdgcn_cvt_pk_f32_fp8((int)vw[j], false), hi = __builtin_amdgcn_cvt_pk_f32_fp8((int)vw[j], true);
                outv[4 * j] += w * lo.x; outv[4 * j + 1] += w * lo.y; outv[4 * j + 2] += w * hi.x; outv[4 * j + 3] += w * hi.y;
            }
        }
        float* xr = p.xres + (size_t)T * 1024 + lane * 16;
        const float* gt = modv(p, l, ti.mi, 5) + lane * 16;
        float xn[16]; float ss = 0.f;
#pragma unroll
        for (int j = 0; j < 4; ++j) { const float4 f = *(const float4*)(xr + 4 * j); xn[4 * j] = f.x + gt[4 * j] * outv[4 * j]; xn[4 * j + 1] = f.y + gt[4 * j + 1] * outv[4 * j + 1]; xn[4 * j + 2] = f.z + gt[4 * j + 2] * outv[4 * j + 2]; xn[4 * j + 3] = f.w + gt[4 * j + 3] * outv[4 * j + 3]; }
#pragma unroll
        for (int j = 0; j < 16; ++j) ss += xn[j] * xn[j];
        ss = wave_sum(ss);
        const float rstd = rsqrtf(ss * (1.f / 1024.f) + 1e-6f);
        if (l == 0) {
#pragma unroll
            for (int j = 0; j < 4; ++j) *(float4*)(xr + 4 * j) = make_float4(xn[4 * j], xn[4 * j + 1], xn[4 * j + 2], xn[4 * j + 3]);
            const float* sh = modv(p, 1, ti.mi, 0) + lane * 16; const float* sc = modv(p, 1, ti.mi, 1) + lane * 16; const float* gg = p.g_mix[1] + lane * 16;
            unsigned w[8];
#pragma unroll
            for (int j = 0; j < 8; ++j) {
                const float a0 = xn[2 * j] * rstd * gg[2 * j] * (1.f + sc[2 * j]) + sh[2 * j];
                const float a1 = xn[2 * j + 1] * rstd * gg[2 * j + 1] * (1.f + sc[2 * j + 1]) + sh[2 * j + 1];
                w[j] = (unsigned)f2bf(a0) | ((unsigned)f2bf(a1) << 16);
            }
            uint4* d = (uint4*)(p.h3 + (size_t)T * 1024 + lane * 16);
            d[0] = make_uint4(w[0], w[1], w[2], w[3]); d[1] = make_uint4(w[4], w[5], w[6], w[7]);
        } else {
            const float* gg = p.g_final + lane * 16;
            float* y = p.out + (size_t)T * 1024 + lane * 16;
#pragma unroll
            for (int j = 0; j < 4; ++j) *(float4*)(y + 4 * j) = make_float4(xn[4 * j] * rstd * gg[4 * j], xn[4 * j + 1] * rstd * gg[4 * j + 1], xn[4 * j + 2] * rstd * gg[4 * j + 2], xn[4 * j + 3] * rstd * gg[4 * j + 3]);
        }
    }
}

__device__ void st_pool(const Params& p) {
    const int tid = threadIdx.x;
    for (int T = blockIdx.x; T < T_TOK; T += gridDim.x) {
        const TokInfo ti = tokinfo(T);
        for (int c = tid; c < 1024; c += 256) {
            const int g = c >> 8, w = 2 << g;
            const int lo = max(ti.s - w / 2, 0), hi = min(ti.s + w / 2, ti.S);
            float s = 0.f;
            for (int t2 = lo; t2 < hi; ++t2) s += bf2f(p.h3[(size_t)(T - ti.s + t2) * 1024 + c]);
            const float d = s / (float)(hi - lo) - bf2f(p.h3[(size_t)T * 1024 + c]);
            p.hbuf[(size_t)T * 1024 + c] = f2bf(d);
        }
    }
}

__device__ void st_gemm_pool(const Params& p) {
    const int lane = threadIdx.x & 63, wid = threadIdx.x >> 6, wm = wid >> 1, wn = wid & 1, hl = lane >> 5, cl = lane & 31;
    for (int item = blockIdx.x; item < 160 * 8; item += gridDim.x) {
        const int tn = item & 7, tm = item >> 3, g = tn >> 1;
        f32x16 acc[2][2];
        gemm_acc<2, 2, 2, 2>(p.hbuf + (size_t)tm * 128 * 1024 + g * 256, 1024, p.wt_pool + ((size_t)g * 256 + (tn & 1) * 128) * 256, 256, 256, acc);
        const int mi = tokinfo(tm * 128).mi;
#pragma unroll
        for (int j = 0; j < 2; ++j) {
            const int col = tn * 128 + ACC_COL(2, wn, j, cl);
            const float gs = modv(p, 1, mi, 2)[col] * p.s_pool[col];
#pragma unroll
            for (int i = 0; i < 2; ++i)
#pragma unroll
                for (int r = 0; r < 16; ++r) {
                    const int row = tm * 128 + ACC_ROW(2, wm, i, r, hl);
                    p.xres[(size_t)row * 1024 + col] += gs * acc[i][j][r];
                }
        }
    }
}

__device__ __forceinline__ void run_stage(const Params& p, int s) {
#ifdef ONLY_STAGE
    if (s != ONLY_STAGE) return;
#endif
    switch (s) {
        case 0: st_prologue(p); break;
        case 1: st_norm<0>(p, 0, 0, p.g_mix[0], p.hbuf); break;
        case 2: st_gemm1(p); break;
        case 3: st_postproj(p); break;
        case 4: st_gemm234(p); break;
        case 5: st_attn_s1(p); break;
        case 6: st_scan3(p); break;
        case 7: st_gemm_o(p); break;
        case 8: st_norm<1>(p, 0, 1, p.g_ffn[0], p.hbuf); break;
        case 9: st_gemm_pq(p, 0); break;
        case 10: st_peer_topk(p, 0); break;
        case 11: st_peer_gather(p, 0); break;
        case 12: st_pool(p); break;
        case 13: st_gemm_pool(p); break;
        case 14: st_norm<1>(p, 1, 1, p.g_ffn[1], p.hbuf); break;
        case 15: st_gemm_pq(p, 1); break;
        case 16: st_peer_topk(p, 1); break;
        case 17: st_peer_gather(p, 1); break;
        default: break;
    }
}

__global__ void __launch_bounds__(256, 2) fwd_mega(Params p) {
    cg::grid_group grid = cg::this_grid();
    volatile LAS unsigned* st = (volatile LAS unsigned*)(smem + 65536);
    if (threadIdx.x == 0) { st[0] = 0; st[1] = 0; st[2] = 0; st[3] = 0; }
    __syncthreads();
    XcdBarrier b = xcd_barrier_post(p.bar, st);
    if (p.bar == nullptr) grid.sync();
#define MK_ST(k) run_stage(p, k); if ((k) + 1 < NSTAGE) xcd_barrier(b);
    MK_ST(0) MK_ST(1) MK_ST(2) MK_ST(3) MK_ST(4) MK_ST(5) MK_ST(6) MK_ST(7) MK_ST(8) MK_ST(9) MK_ST(10) MK_ST(11) MK_ST(12) MK_ST(13) MK_ST(14) MK_ST(15) MK_ST(16) MK_ST(17)
}
__global__ void __launch_bounds__(256, 2) fwd_stage(Params p, int s) { run_stage(p, s); }

extern "C" void kernel_launch(void* const* d_in, const int* in_sizes, int n_in, void* d_out, int out_size, void* d_ws, size_t ws_size, hipStream_t stream) {
    constexpr size_t kDynLds = 65536 + 1024;
    static int grid_blocks = 0;
    if (!grid_blocks) {
        int dev = 0, cus = 0, per_cu = 0;
        (void)hipGetDevice(&dev);
        (void)hipDeviceGetAttribute(&cus, hipDeviceAttributeMultiprocessorCount, dev);
        (void)hipFuncSetAttribute((const void*)fwd_mega, hipFuncAttributeMaxDynamicSharedMemorySize, (int)kDynLds);
        (void)hipFuncSetAttribute((const void*)fwd_stage, hipFuncAttributeMaxDynamicSharedMemorySize, (int)kDynLds);
        (void)hipOccupancyMaxActiveBlocksPerMultiprocessor(&per_cu, fwd_mega, 256, kDynLds);
        if (per_cu > 2) per_cu = 2;
        if (per_cu < 1) per_cu = 1;
        grid_blocks = cus * per_cu;
    }
    Params p{};
    const float* const* in = (const float* const*)d_in;
    p.x_prompt = in[0]; p.x_sample = in[1]; p.cache_ckv = in[2]; p.cache_krope = in[3]; p.state_lru = in[4]; p.c = in[5]; p.c_ctx = in[6];
    p.w_mod[0] = in[7]; p.b_mod[0] = in[8]; p.w_mod[1] = in[9]; p.b_mod[1] = in[10];
    p.g_mix[0] = in[11]; p.g_ffn[0] = in[12]; p.g_mix[1] = in[13]; p.g_ffn[1] = in[14];
    p.w_in = in[15]; p.g_q = in[16]; p.w_uq = in[17]; p.g_kv = in[18]; p.w_ukv = in[19]; p.conv_w = in[20]; p.conv_b = in[21];
    p.w_rg = in[22]; p.b_rg = in[23]; p.w_ig = in[24]; p.b_ig = in[25]; p.lam = in[26]; p.w_o = in[27]; p.w_pool = in[28]; p.s_pool = in[29];
    p.peer_wq[0] = in[30]; p.peer_keys[0] = in[31]; p.peer_u[0] = in[32]; p.peer_v[0] = in[33];
    p.peer_wq[1] = in[34]; p.peer_keys[1] = in[35]; p.peer_u[1] = in[36]; p.peer_v[1] = in[37];
    p.g_final = in[38];
    p.out = (float*)d_out;
    char* base = (char*)d_ws; size_t off = 0;
    auto take = [&](size_t bytes) { char* r = base + off; off += (bytes + 255) & ~(size_t)255; return r; };
    const size_t MiB = 1u << 20;
    p.bar = (unsigned*)take(16384);
    p.mod = (float*)take((size_t)2 * 9 * 6144 * 4);
    p.ropetab = (float*)take(3072 * 4);
    p.wt_in = (bf16_t*)take((size_t)NW_IN * 2); p.wt_uq = (bf16_t*)take((size_t)NW_UQ * 2); p.wt_ukv = (bf16_t*)take((size_t)NW_UKV * 2);
    p.wt_gate = (bf16_t*)take((size_t)NW_GATE * 2); p.wt_o = (bf16_t*)take((size_t)NW_O * 2); p.wt_pool = (bf16_t*)take((size_t)NW_POOL * 2);
    p.wt_pq[0] = (bf16_t*)take((size_t)NW_PQ * 2); p.wt_pq[1] = (bf16_t*)take((size_t)NW_PQ * 2);
    p.keysb[0] = (bf16_t*)take((size_t)NW_KEYS * 2); p.keysb[1] = (bf16_t*)take((size_t)NW_KEYS * 2);
    for (int l = 0; l < 2; ++l) { p.u8[l] = (u8_t*)take(16 * MiB); p.v8[l] = (u8_t*)take(16 * MiB); p.su[l] = (float*)take(65536); p.sv[l] = (float*)take(65536); }
    char* regX = take(80 * MiB);
    char* regQ = take(80 * MiB);
    char* regH = take(40 * MiB);
    p.P = (bf16_t*)regX; p.a = (float*)regX; p.xres = (float*)regX;
    p.bxb = (bf16_t*)regQ; p.q = (bf16_t*)(regQ + 40 * MiB); p.agg = (float*)(regQ + 70 * MiB); p.qp = (bf16_t*)regQ; p.h3 = (bf16_t*)regQ;
    p.hbuf = (bf16_t*)regH;
    p.cqn = (bf16_t*)take((size_t)T_TOK * 384 * 2); p.ckvk = (bf16_t*)take((size_t)R_KEYS * 256 * 2); p.kropek = (bf16_t*)take((size_t)R_KEYS * 64 * 2);
    p.xc = (bf16_t*)take((size_t)T_TOK * 512 * 2); p.ug = (bf16_t*)take((size_t)T_TOK * 512 * 2);
    p.Kn = (bf16_t*)take((size_t)R_KEYS * 512 * 2); p.vT = (bf16_t*)take((size_t)R_KEYS * 512 * 2);
    p.gates = (float*)p.Kn; p.eidx = (int*)((char*)p.Kn + (size_t)T_TOK * 128 * 4);
    if (off > ws_size) fprintf(stderr, "workspace too small: need %zu have %zu\n", off, ws_size);
    (void)hipMemsetAsync(d_ws, 0, 16384, stream);
#if MK_LAUNCHES == 1
    void* args[] = {&p};
    hipError_t e = hipLaunchCooperativeKernel((void*)fwd_mega, dim3(grid_blocks), dim3(256), args, kDynLds, stream);
    if (e != hipSuccess) fprintf(stderr, "cooperative launch failed: %s (grid %d)\n", hipGetErrorString(e), grid_blocks);
#else
    for (int s = 0; s < NSTAGE; ++s) hipLaunchKernelGGL(fwd_stage, dim3(grid_blocks), dim3(256), kDynLds, stream, p, s);
#endif
}
```

```cpp
#include <hip/hip_runtime.h>
#include <hip/hip_cooperative_groups.h>
#include <cstdio>
#include <cstdint>
namespace cg = cooperative_groups;

#ifndef MK_LAUNCHES
#define MK_LAUNCHES 1
#endif

typedef unsigned short bf16_t;
typedef unsigned char u8_t;
typedef float f32x16 __attribute__((ext_vector_type(16)));
typedef float f32x2 __attribute__((ext_vector_type(2)));
typedef unsigned u32x4 __attribute__((ext_vector_type(4)));

#define T_TOK 20480
#define T_CTX 4096
#define R_KEYS 22528
#define NSTAGE 18
#define LAS __attribute__((address_space(3)))

#define XB_TMO      128
#define XB_XCNT(j)  (256  + 64 * (j))
#define XB_XSUB(j)  (1280 + 64 * (j))
#define XB_XGEN(j)  (2304 + 64 * (j))
#define XB_TOP      3328
#define XB_TOPGEN   3392
#define XCD_BAR_WORDS 3456
#define XB_SPIN_CAP (1u << 22)
__device__ __forceinline__ unsigned xb_ld(unsigned* p)              { return __hip_atomic_load(p, __ATOMIC_RELAXED, __HIP_MEMORY_SCOPE_AGENT); }
__device__ __forceinline__ unsigned xb_add(unsigned* p, unsigned v) { return __hip_atomic_fetch_add(p, v, __ATOMIC_RELAXED, __HIP_MEMORY_SCOPE_AGENT); }
__device__ __forceinline__ unsigned xb_xcc_id() { return (unsigned)__builtin_amdgcn_s_getreg((3 << 11) | 20) & 0xFu; }
#define XB_SPIN(cond, bar) do { unsigned _sp = 0; while (cond) { __builtin_amdgcn_s_sleep(1); \
    if ((++_sp & 255u) == 0u) { if (xb_ld(&(bar)[XB_TMO])) break; if (_sp > XB_SPIN_CAP) { atomicAdd(&(bar)[XB_TMO], 1u); break; } } } } while (0)
struct XcdBarrier { unsigned* bar; unsigned x; volatile LAS unsigned* st; };
__device__ __forceinline__ XcdBarrier xcd_barrier_post(unsigned* bar, volatile LAS unsigned* st) {
    XcdBarrier b; b.bar = bar; b.x = xb_xcc_id(); b.st = st;
    if (threadIdx.x == 0) (void)xb_add(&bar[XB_XCNT(b.x)], 1u);
    return b;
}
__device__ __forceinline__ void xcd_barrier_complete(unsigned* bar, unsigned x, unsigned& nloc, unsigned& nx) {
    const unsigned G = gridDim.x * gridDim.y * gridDim.z;
    unsigned sum, cnt, mine, sp = 0u;
    for (;;) {
        sum = 0u; cnt = 0u; mine = 0u;
#pragma unroll
        for (unsigned j = 0; j < 16; ++j) { const unsigned c = xb_ld(&bar[XB_XCNT(j)]); sum += c; cnt += (c > 0u) ? 1u : 0u; mine = (j == x) ? c : mine; }
        if (sum == G) break;
        __builtin_amdgcn_s_sleep(1);
        if ((++sp & 255u) == 0u) { if (xb_ld(&bar[XB_TMO])) break; if (sp > XB_SPIN_CAP) { atomicAdd(&bar[XB_TMO], 1u); break; } }
    }
    nloc = mine > 0u ? mine : 1u; nx = cnt > 0u ? cnt : 1u;
}
__device__ __forceinline__ void xcd_barrier(const XcdBarrier& b) {
    asm volatile("s_waitcnt vmcnt(0)" ::: "memory");
    __syncthreads();
    if (threadIdx.x == 0) {
        unsigned* bar = b.bar;
        __builtin_amdgcn_s_waitcnt(0);
        unsigned nloc = b.st[0], nx = b.st[1];
        if (nloc == 0u) { xcd_barrier_complete(bar, b.x, nloc, nx); b.st[0] = nloc; b.st[1] = nx; }
        const unsigned old = xb_add(&bar[XB_XSUB(b.x)], 1u);
        const unsigned gen = old / nloc;
        if (old + 1u == (gen + 1u) * nloc) {
            __builtin_amdgcn_fence(__ATOMIC_RELEASE, "agent");
            asm volatile("s_waitcnt vmcnt(0)" ::: "memory");
            const unsigned og = xb_add(&bar[XB_TOP], 1u);
            const unsigned tg = og / nx;
            if (og + 1u == (tg + 1u) * nx) xb_add(&bar[XB_TOPGEN], 1u);
            else XB_SPIN(xb_ld(&bar[XB_TOPGEN]) == tg, bar);
            __builtin_amdgcn_fence(__ATOMIC_ACQUIRE, "agent");
            xb_add(&bar[XB_XGEN(b.x)], 1u);
            asm volatile("s_waitcnt vmcnt(0)" ::: "memory");
        } else {
            XB_SPIN(xb_ld(&bar[XB_XGEN(b.x)]) == gen, bar);
            __builtin_amdgcn_fence(__ATOMIC_ACQUIRE, "agent");
            asm volatile("s_waitcnt vmcnt(0)" ::: "memory");
        }
    }
    __syncthreads();
}

struct Params {
    const float *x_prompt, *x_sample, *cache_ckv, *cache_krope, *state_lru, *c, *c_ctx;
    const float *w_mod[2], *b_mod[2], *g_mix[2], *g_ffn[2];
    const float *w_in, *g_q, *w_uq, *g_kv, *w_ukv, *conv_w, *conv_b, *w_rg, *b_rg, *w_ig, *b_ig, *lam, *w_o, *w_pool, *s_pool;
    const float *peer_wq[2], *peer_keys[2], *peer_u[2], *peer_v[2];
    const float* g_final;
    float* out;
    unsigned* bar; float* mod; float* ropetab;
    bf16_t *wt_in, *wt_uq, *wt_ukv, *wt_gate, *wt_o, *wt_pool, *wt_pq[2], *keysb[2];
    u8_t *u8[2], *v8[2]; float *su[2], *sv[2];
    bf16_t *hbuf, *P, *cqn, *ckvk, *kropek, *xc, *ug, *q, *Kn, *vT, *bxb, *qp, *h3;
    float *a, *agg, *xres, *gates; int* eidx;
};

extern __shared__ __attribute__((aligned(16))) unsigned char smem[];

__device__ __forceinline__ float bf2f(bf16_t v) { return __uint_as_float(((unsigned)v) << 16); }
typedef __bf16 bf16x2_t __attribute__((ext_vector_type(2)));
__device__ __forceinline__ bf16_t f2bf(float f) { return __builtin_bit_cast(unsigned short, (__bf16)f); }
__device__ __forceinline__ unsigned pack_bf16(float a, float b) { bf16x2_t v = {(__bf16)a, (__bf16)b}; return __builtin_bit_cast(unsigned, v); }
typedef unsigned u32x2 __attribute__((ext_vector_type(2)));
#define DPP_F(v, ctrl) __int_as_float(__builtin_amdgcn_update_dpp(0, __float_as_int(v), ctrl, 0xf, 0xf, true))
__device__ __forceinline__ float wave_sum(float v) {
    v += DPP_F(v, 0xB1); v += DPP_F(v, 0x4E); v += DPP_F(v, 0x141); v += DPP_F(v, 0x128);
    u32x2 r = __builtin_amdgcn_permlane16_swap(__float_as_uint(v), __float_as_uint(v), false, false);
    v = __uint_as_float(r[0]) + __uint_as_float(r[1]);
    r = __builtin_amdgcn_permlane32_swap(__float_as_uint(v), __float_as_uint(v), false, false);
    return __uint_as_float(r[0]) + __uint_as_float(r[1]);
}
__device__ __forceinline__ float wave_max(float v) {
    v = fmaxf(v, DPP_F(v, 0xB1)); v = fmaxf(v, DPP_F(v, 0x4E)); v = fmaxf(v, DPP_F(v, 0x141)); v = fmaxf(v, DPP_F(v, 0x128));
    u32x2 r = __builtin_amdgcn_permlane16_swap(__float_as_uint(v), __float_as_uint(v), false, false);
    v = fmaxf(__uint_as_float(r[0]), __uint_as_float(r[1]));
    r = __builtin_amdgcn_permlane32_swap(__float_as_uint(v), __float_as_uint(v), false, false);
    return fmaxf(__uint_as_float(r[0]), __uint_as_float(r[1]));
}
__device__ __forceinline__ float gelu_tanh(float x) {
    const float u = 0.7978845608028654f * (x + 0.044715f * x * x * x);
    const float e = __expf(2.f * u);
    const float th = 1.f - 2.f / (e + 1.f);
    return 0.5f * x * (1.f + th);
}
__device__ __forceinline__ float sigmoidf_(float x) { return 1.f / (1.f + __expf(-x)); }
__device__ __forceinline__ float silu_(float x) { return x / (1.f + __expf(-x)); }

struct TokInfo { int smp, b, s, S, mi, keyrow; };
__device__ __forceinline__ TokInfo tokinfo(int T) {
    TokInfo t;
    if (T < T_CTX) { t.smp = 0; t.b = T >> 8; t.s = T & 255; t.S = 256; t.mi = 0; t.keyrow = T; }
    else { const int u = T - T_CTX; t.smp = 1; t.b = u >> 11; t.s = u & 2047; t.S = 2048; t.mi = 1 + t.b; t.keyrow = T_CTX + t.b * 2304 + 256 + t.s; }
    return t;
}
__device__ __forceinline__ const float* x_in_row(const Params& p, int T) { return T < T_CTX ? p.x_prompt + (size_t)T * 1024 : p.x_sample + (size_t)(T - T_CTX) * 1024; }
__device__ __forceinline__ const float* modv(const Params& p, int l, int mi, int j) { return p.mod + ((size_t)(l * 9 + mi) * 6 + j) * 1024; }

__device__ __forceinline__ void unpack8(const uint4 r, float (&f)[8]) {
    f[0] = __uint_as_float(r.x << 16); f[1] = __uint_as_float(r.x & 0xffff0000u);
    f[2] = __uint_as_float(r.y << 16); f[3] = __uint_as_float(r.y & 0xffff0000u);
    f[4] = __uint_as_float(r.z << 16); f[5] = __uint_as_float(r.z & 0xffff0000u);
    f[6] = __uint_as_float(r.w << 16); f[7] = __uint_as_float(r.w & 0xffff0000u);
}

typedef __bf16 bf16x8_t __attribute__((ext_vector_type(8)));
__device__ __forceinline__ int lds_off(int row, int chunk) { return row * 128 + ((chunk ^ ((row >> 1) & 7)) << 4); }
template <int TM, int TN, int WM, int WN>
__device__ __forceinline__ void gemm_acc(const bf16_t* __restrict__ As, int lda, const bf16_t* __restrict__ Bs, int ldb, int K, f32x16 (&acc)[TM][TN]) {
    static_assert(TM * WM == 4 && TN * WN == 4 && WM * WN == 4, "block tile is 128 x 128, 4 waves");
    const int tid = threadIdx.x, lane = tid & 63, wid = tid >> 6, wm = wid / WN, wn = wid % WN, hl = lane >> 5, cl = lane & 31;
#pragma unroll
    for (int i = 0; i < TM; ++i)
#pragma unroll
        for (int j = 0; j < TN; ++j)
#pragma unroll
            for (int r = 0; r < 16; ++r) acc[i][j][r] = 0.f;
    const int srow0 = wid * 32 + (lane >> 3), pc = lane & 7;
    const bf16_t* ga[4]; const bf16_t* gb[4];
#pragma unroll
    for (int i = 0; i < 4; ++i) {
        const int row = srow0 + 8 * i, lc = pc ^ ((row >> 1) & 7);
        ga[i] = As + (size_t)row * lda + lc * 8; gb[i] = Bs + (size_t)row * ldb + lc * 8;
    }
    unsigned char* lbase = smem + wid * 4096 + lane * 16;
    __syncthreads();
#pragma unroll
    for (int i = 0; i < 4; ++i) {
        __builtin_amdgcn_global_load_lds((const unsigned*)ga[i], (unsigned*)(lbase + i * 1024), 16, 0, 0);
        __builtin_amdgcn_global_load_lds((const unsigned*)gb[i], (unsigned*)(lbase + 16384 + i * 1024), 16, 0, 0);
    }
    asm volatile("s_waitcnt vmcnt(0)" ::: "memory");
    __syncthreads();
    const int nk = K >> 6;
    for (int kt = 0; kt < nk; ++kt) {
        const int cur = (kt & 1) * 32768, nxt = 32768 - cur;
        if (kt + 1 < nk) {
#pragma unroll
            for (int i = 0; i < 4; ++i) {
                __builtin_amdgcn_global_load_lds((const unsigned*)(ga[i] + (kt + 1) * 64), (unsigned*)(lbase + nxt + i * 1024), 16, 0, 0);
                __builtin_amdgcn_global_load_lds((const unsigned*)(gb[i] + (kt + 1) * 64), (unsigned*)(lbase + nxt + 16384 + i * 1024), 16, 0, 0);
            }
        }
#pragma unroll
        for (int ks = 0; ks < 4; ++ks) {
            bf16x8_t af[TM], bfr[TN];
#pragma unroll
            for (int i = 0; i < TM; ++i) af[i] = __builtin_bit_cast(bf16x8_t, *(const u32x4*)(smem + cur + lds_off(32 * (TM * wm + i) + cl, 2 * ks + hl)));
#pragma unroll
            for (int j = 0; j < TN; ++j) bfr[j] = __builtin_bit_cast(bf16x8_t, *(const u32x4*)(smem + cur + 16384 + lds_off(32 * (TN * wn + j) + cl, 2 * ks + hl)));
#pragma unroll
            for (int i = 0; i < TM; ++i)
#pragma unroll
                for (int j = 0; j < TN; ++j) acc[i][j] = __builtin_amdgcn_mfma_f32_32x32x16_bf16(af[i], bfr[j], acc[i][j], 0, 0, 0);
        }
        asm volatile("s_waitcnt vmcnt(0)" ::: "memory");
        __syncthreads();
    }
}
#define ACC_ROW(TMv, wm, i, r, hl) (32 * ((TMv) * (wm) + (i)) + ((r) & 3) + 8 * ((r) >> 2) + 4 * (hl))
#define ACC_COL(TNv, wn, j, cl)    (32 * ((TNv) * (wn) + (j)) + (cl))

#define N_ADA 192
#define NW_IN   (1792 * 1024)
#define NW_UQ   (768 * 384)
#define NW_UKV  (1024 * 256)
#define NW_GATE (4 * 512 * 128)
#define NW_O    (1024 * 1024)
#define NW_POOL (4 * 256 * 256)
#define NW_PQ   (2048 * 1024)
#define NW_KEYS (16 * 128 * 128)
#define NW_CKV  (8 * 256 * 256)
#define NW_CKR  (8 * 256 * 64)
#define NW_ROPE 3072
#define NW_TOTAL (NW_IN + NW_UQ + NW_UKV + NW_GATE + NW_O + NW_POOL + 2 * NW_PQ + 2 * NW_KEYS + NW_CKV + NW_CKR + NW_ROPE)
#define N_CONV_ITEMS ((NW_TOTAL + 4095) / 4096)
#define N_FP8_ITEMS (65536 / 4)

__device__ __forceinline__ void conv_elem(const Params& p, int e) {
    if (e < NW_IN) { const int n = e >> 10, k = e & 1023; p.wt_in[e] = n < 1728 ? f2bf(p.w_in[(size_t)k * 1728 + n]) : (bf16_t)0; return; } e -= NW_IN;
    if (e < NW_UQ) { const int n = e / 384, k = e % 384; p.wt_uq[e] = f2bf(p.w_uq[(size_t)k * 768 + n]); return; } e -= NW_UQ;
    if (e < NW_UKV) { const int n = e >> 8, k = e & 255; p.wt_ukv[e] = f2bf(p.w_ukv[(size_t)k * 1024 + n]); return; } e -= NW_UKV;
    if (e < NW_GATE) {
        const int c = e & 127, cg = (e >> 7) & 511, nb = e >> 16;
        const int dir = cg >> 8, dg = (cg >> 6) & 3, ri = (cg >> 5) & 1, d = dg * 32 + (cg & 31);
        const float* src = ri ? p.w_ig : p.w_rg;
        p.wt_gate[e] = f2bf(src[(((size_t)dir * 4 + nb) * 128 + c) * 128 + d]); return; } e -= NW_GATE;
    if (e < NW_O) { const int n = e >> 10, k = e & 1023; p.wt_o[e] = f2bf(p.w_o[(size_t)k * 1024 + n]); return; } e -= NW_O;
    if (e < NW_POOL) { const int c = e & 255, d = (e >> 8) & 255, g = e >> 16; p.wt_pool[e] = f2bf(p.w_pool[((size_t)g * 256 + c) * 256 + d]); return; } e -= NW_POOL;
#pragma unroll
    for (int l = 0; l < 2; ++l) { if (e < NW_PQ) { const int n = e >> 10, k = e & 1023; p.wt_pq[l][e] = f2bf(p.peer_wq[l][(size_t)k * 2048 + n]); return; } e -= NW_PQ; }
#pragma unroll
    for (int l = 0; l < 2; ++l) { if (e < NW_KEYS) { p.keysb[l][e] = f2bf(p.peer_keys[l][e]); return; } e -= NW_KEYS; }
    if (e < NW_CKV) { const int col = e & 255, j = (e >> 8) & 255, b = e >> 16; p.ckvk[(size_t)(T_CTX + b * 2304 + j) * 256 + col] = f2bf(p.cache_ckv[e]); return; } e -= NW_CKV;
    if (e < NW_CKR) { const int col = e & 63, j = (e >> 6) & 255, b = e >> 14; p.kropek[(size_t)(T_CTX + b * 2304 + j) * 64 + col] = f2bf(p.cache_krope[e]); return; } e -= NW_CKR;
    if (e < NW_ROPE) {
        int idx = e, isrow = e < 1024; if (!isrow) idx -= 1024;
        const int half = isrow ? 512 : 1024; const int sn = idx >= half; if (sn) idx -= half;
        const int pos = idx >> 4, fi = idx & 15;
        const float invf = exp2f(-(float)fi * (13.287712379549449f / 16.f));
        const float ang = (float)pos * invf;
        p.ropetab[e] = sn ? sinf(ang) : cosf(ang); return; }
}

__device__ void st_prologue(const Params& p) {
    const int tid = threadIdx.x, lane = tid & 63, wid = tid >> 6;
    const int n_items = N_ADA + N_CONV_ITEMS + N_FP8_ITEMS;
    for (int item = blockIdx.x; item < n_items; item += gridDim.x) {
        if (item < N_ADA) {
            float* svec = (float*)smem;
            float* red = (float*)(smem + 9 * 1024 * 4);
            __syncthreads();
            for (int i = tid; i < 9 * 1024; i += 256) { const int bc = i >> 10, k = i & 1023; const float cv = bc == 0 ? p.c_ctx[k] : p.c[(size_t)(bc - 1) * 1024 + k]; svec[i] = silu_(cv); }
            __syncthreads();
            const int cidx = item * 64 + (tid & 63), l = cidx / 6144, col = cidx % 6144, kq = tid >> 6;
            const float* w = p.w_mod[l] + col;
            float acc[9];
#pragma unroll
            for (int b = 0; b < 9; ++b) acc[b] = 0.f;
            for (int k = kq * 256; k < kq * 256 + 256; ++k) {
                const float wv = w[(size_t)k * 6144];
#pragma unroll
                for (int b = 0; b < 9; ++b) acc[b] += wv * svec[b * 1024 + k];
            }
#pragma unroll
            for (int b = 0; b < 9; ++b) red[(kq * 9 + b) * 64 + (tid & 63)] = acc[b];
            __syncthreads();
            if (kq == 0) {
                const float bias = p.b_mod[l][col];
#pragma unroll
                for (int b = 0; b < 9; ++b) {
                    const int c64 = tid & 63;
                    const float v = red[(0 * 9 + b) * 64 + c64] + red[(1 * 9 + b) * 64 + c64] + red[(2 * 9 + b) * 64 + c64] + red[(3 * 9 + b) * 64 + c64] + bias;
                    p.mod[(size_t)(l * 9 + b) * 6144 + col] = v;
                }
            }
        } else if (item < N_ADA + N_CONV_ITEMS) {
            const int base = (item - N_ADA) * 4096;
            for (int i = tid; i < 4096; i += 256) { const int e = base + i; if (e < NW_TOTAL) conv_elem(p, e); }
        } else {
            const int row = (item - N_ADA - N_CONV_ITEMS) * 4 + wid;
            const int tb = row >> 14, er = row & 16383, l = tb >> 1;
            const float* src = ((tb & 1) ? p.peer_v[l] : p.peer_u[l]) + (size_t)er * 1024 + lane * 16;
            u8_t* dst = ((tb & 1) ? p.v8[l] : p.u8[l]) + (size_t)er * 1024 + lane * 16;
            float* sc = ((tb & 1) ? p.sv[l] : p.su[l]) + er;
            float v[16];
#pragma unroll
            for (int j = 0; j < 4; ++j) { const float4 f = *(const float4*)(src + 4 * j); v[4 * j] = f.x; v[4 * j + 1] = f.y; v[4 * j + 2] = f.z; v[4 * j + 3] = f.w; }
            float am = 0.f;
#pragma unroll
            for (int j = 0; j < 16; ++j) am = fmaxf(am, fabsf(v[j]));
            am = wave_max(am);
            const float scale = am > 0.f ? am * (1.f / 224.f) : 1.f, inv = am > 0.f ? 224.f / am : 1.f;
            unsigned w[4];
#pragma unroll
            for (int j = 0; j < 4; ++j) {
                int pk = 0;
                pk = __builtin_amdgcn_cvt_pk_fp8_f32(v[4 * j] * inv, v[4 * j + 1] * inv, pk, false);
                pk = __builtin_amdgcn_cvt_pk_fp8_f32(v[4 * j + 2] * inv, v[4 * j + 3] * inv, pk, true);
                w[j] = (unsigned)pk;
            }
            *(uint4*)dst = make_uint4(w[0], w[1], w[2], w[3]);
            if (lane == 0) *sc = scale;
        }
    }
}

template <int SRC>
__device__ void st_norm(const Params& p, int l, int which, const float* g, bf16_t* dst) {
    const int lane = threadIdx.x & 63, wid = threadIdx.x >> 6;
    for (int T = blockIdx.x * 4 + wid; T < T_TOK; T += gridDim.x * 4) {
        const float* src = (SRC == 0 ? x_in_row(p, T) : p.xres + (size_t)T * 1024) + lane * 16;
        const TokInfo ti = tokinfo(T);
        float v[16]; float ss = 0.f;
#pragma unroll
        for (int j = 0; j < 4; ++j) { const float4 f = *(const float4*)(src + 4 * j); v[4 * j] = f.x; v[4 * j + 1] = f.y; v[4 * j + 2] = f.z; v[4 * j + 3] = f.w; }
#pragma unroll
        for (int j = 0; j < 16; ++j) ss += v[j] * v[j];
        ss = wave_sum(ss);
        const float rstd = rsqrtf(ss * (1.f / 1024.f) + 1e-6f);
        const float* sh = modv(p, l, ti.mi, which ? 3 : 0) + lane * 16; const float* sc = modv(p, l, ti.mi, which ? 4 : 1) + lane * 16; const float* gg = g + lane * 16;
        unsigned w[8];
#pragma unroll
        for (int j = 0; j < 8; ++j) {
            const float a0 = v[2 * j] * rstd * gg[2 * j] * (1.f + sc[2 * j]) + sh[2 * j];
            const float a1 = v[2 * j + 1] * rstd * gg[2 * j + 1] * (1.f + sc[2 * j + 1]) + sh[2 * j + 1];
            w[j] = (unsigned)f2bf(a0) | ((unsigned)f2bf(a1) << 16);
        }
        uint4* d = (uint4*)(dst + (size_t)T * 1024 + lane * 16);
        d[0] = make_uint4(w[0], w[1], w[2], w[3]); d[1] = make_uint4(w[4], w[5], w[6], w[7]);
    }
}

__device__ void st_gemm1(const Params& p) {
    const int lane = threadIdx.x & 63, wid = threadIdx.x >> 6, wm = wid >> 1, wn = wid & 1, hl = lane >> 5, cl = lane & 31;
    for (int item = blockIdx.x; item < 160 * 14; item += gridDim.x) {
        const int tn = item % 14, tm = item / 14;
        f32x16 acc[2][2];
        gemm_acc<2, 2, 2, 2>(p.hbuf + (size_t)tm * 128 * 1024, 1024, p.wt_in + (size_t)tn * 128 * 1024, 1024, 1024, acc);
#pragma unroll
        for (int i = 0; i < 2; ++i)
#pragma unroll
            for (int j = 0; j < 2; ++j)
#pragma unroll
                for (int r = 0; r < 16; ++r) {
                    const int row = tm * 128 + ACC_ROW(2, wm, i, r, hl), col = tn * 128 + ACC_COL(2, wn, j, cl);
                    p.P[(size_t)row * 1792 + col] = f2bf(acc[i][j][r]);
                }
    }
}

__device__ void st_postproj(const Params& p) {
    const int lane = threadIdx.x & 63, wid = threadIdx.x >> 6;
    float* o_ckv = p.out + 20971520, *o_kr = p.out + 22020096;
    for (int T = blockIdx.x * 4 + wid; T < T_TOK; T += gridDim.x * 4) {
        const TokInfo ti = tokinfo(T);
        const bf16_t* Pr = p.P + (size_t)T * 1792;
        float cq[8], ck[8];
#pragma unroll
        for (int j = 0; j < 8; ++j) { cq[j] = 0.f; ck[j] = 0.f; }
        if (lane < 48) unpack8(*(const uint4*)(Pr + lane * 8), cq);
        if (lane < 32) unpack8(*(const uint4*)(Pr + 384 + lane * 8), ck);
        float s1 = 0.f, s2 = 0.f;
#pragma unroll
        for (int j = 0; j < 8; ++j) { s1 += cq[j] * cq[j]; s2 += ck[j] * ck[j]; }
        s1 = wave_sum(s1); s2 = wave_sum(s2);
        const float r1 = rsqrtf(s1 * (1.f / 384.f) + 1e-6f), r2 = rsqrtf(s2 * (1.f / 256.f) + 1e-6f);
        if (lane < 48) {
            const float4 ga = *(const float4*)(p.g_q + lane * 8), gb = *(const float4*)(p.g_q + lane * 8 + 4);
            uint4 o; o.x = pack_bf16(cq[0] * r1 * ga.x, cq[1] * r1 * ga.y); o.y = pack_bf16(cq[2] * r1 * ga.z, cq[3] * r1 * ga.w);
            o.z = pack_bf16(cq[4] * r1 * gb.x, cq[5] * r1 * gb.y); o.w = pack_bf16(cq[6] * r1 * gb.z, cq[7] * r1 * gb.w);
            *(uint4*)(p.cqn + (size_t)T * 384 + lane * 8) = o;
        }
        if (lane < 32) {
            const float4 ga = *(const float4*)(p.g_kv + lane * 8), gb = *(const float4*)(p.g_kv + lane * 8 + 4);
            float y[8] = {ck[0] * r2 * ga.x, ck[1] * r2 * ga.y, ck[2] * r2 * ga.z, ck[3] * r2 * ga.w, ck[4] * r2 * gb.x, ck[5] * r2 * gb.y, ck[6] * r2 * gb.z, ck[7] * r2 * gb.w};
            uint4 o; o.x = pack_bf16(y[0], y[1]); o.y = pack_bf16(y[2], y[3]); o.z = pack_bf16(y[4], y[5]); o.w = pack_bf16(y[6], y[7]);
            *(uint4*)(p.ckvk + (size_t)ti.keyrow * 256 + lane * 8) = o;
            if (!ti.smp) { float4* d = (float4*)(o_ckv + (size_t)T * 256 + lane * 8); d[0] = make_float4(y[0], y[1], y[2], y[3]); d[1] = make_float4(y[4], y[5], y[6], y[7]); }
        }
        if (lane < 8) {
            float v[8]; unpack8(*(const uint4*)(Pr + 640 + lane * 8), v);
            float y[8];
            if (ti.smp) {
                const int gr = ti.s >> 6, gc = ti.s & 63;
#pragma unroll
                for (int i = 0; i < 4; ++i) {
                    const int pr = lane * 4 + i;
                    const float cs = pr < 16 ? p.ropetab[gr * 16 + pr] : p.ropetab[1024 + gc * 16 + (pr - 16)];
                    const float sn = pr < 16 ? p.ropetab[512 + gr * 16 + pr] : p.ropetab[2048 + gc * 16 + (pr - 16)];
                    y[2 * i] = v[2 * i] * cs - v[2 * i + 1] * sn; y[2 * i + 1] = v[2 * i] * sn + v[2 * i + 1] * cs;
                }
            } else {
#pragma unroll
                for (int i = 0; i < 8; ++i) y[i] = v[i];
                float4* d = (float4*)(o_kr + (size_t)T * 64 + lane * 8); d[0] = make_float4(v[0], v[1], v[2], v[3]); d[1] = make_float4(v[4], v[5], v[6], v[7]);
            }
            uint4 o; o.x = pack_bf16(y[0], y[1]); o.y = pack_bf16(y[2], y[3]); o.z = pack_bf16(y[4], y[5]); o.w = pack_bf16(y[6], y[7]);
            *(uint4*)(p.kropek + (size_t)ti.keyrow * 64 + lane * 8) = o;
        }
        {
            const int ch = lane * 8;
            float y[8];
            { const float4 a = *(const float4*)(p.conv_b + ch), b = *(const float4*)(p.conv_b + ch + 4); y[0] = a.x; y[1] = a.y; y[2] = a.z; y[3] = a.w; y[4] = b.x; y[5] = b.y; y[6] = b.z; y[7] = b.w; }
#pragma unroll
            for (int k = 0; k < 4; ++k) {
                const int s2i = ti.s + k - 2;
                if (s2i >= 0 && s2i < ti.S) {
                    float u[8]; unpack8(*(const uint4*)(p.P + (size_t)(T + k - 2) * 1792 + 704 + ch), u);
                    const float4 a = *(const float4*)(p.conv_w + k * 512 + ch), b = *(const float4*)(p.conv_w + k * 512 + ch + 4);
                    y[0] += a.x * u[0]; y[1] += a.y * u[1]; y[2] += a.z * u[2]; y[3] += a.w * u[3]; y[4] += b.x * u[4]; y[5] += b.y * u[5]; y[6] += b.z * u[6]; y[7] += b.w * u[7];
                }
            }
            uint4 o; o.x = pack_bf16(y[0], y[1]); o.y = pack_bf16(y[2], y[3]); o.z = pack_bf16(y[4], y[5]); o.w = pack_bf16(y[6], y[7]);
            *(uint4*)(p.xc + (size_t)T * 512 + ch) = o;
            *(uint4*)(p.ug + (size_t)T * 512 + ch) = *(const uint4*)(Pr + 1216 + ch);
        }
    }
}

#define N_G2 (160 * 6)
#define N_G3 (176 * 8)
#define N_G4 (160 * 16)
__device__ void st_gemm234(const Params& p) {
    const int lane = threadIdx.x & 63, wid = threadIdx.x >> 6, wm = wid >> 1, wn = wid & 1, hl = lane >> 5, cl = lane & 31;
    for (int item = blockIdx.x; item < N_G2 + N_G3 + N_G4; item += gridDim.x) {
        f32x16 acc[2][2];
        if (item < N_G2) {
            const int tn = item % 6, tm = item / 6;
            gemm_acc<2, 2, 2, 2>(p.wt_uq + (size_t)tn * 128 * 384, 384, p.cqn + (size_t)tm * 128 * 384, 384, 384, acc);
            const float qs = 0.07216878364870322f * 1.4426950408889634f;
#pragma unroll
            for (int j = 0; j < 2; ++j) {
                const int T = tm * 128 + ACC_COL(2, wn, j, cl);
                const TokInfo ti = tokinfo(T);
                const int gr = ti.s >> 6, gc = ti.s & 63;
#pragma unroll
                for (int i = 0; i < 2; ++i)
#pragma unroll
                    for (int r = 0; r < 16; r += 2) {
                        const int n = tn * 128 + ACC_ROW(2, wm, i, r, hl);
                        float v0 = acc[i][j][r], v1 = acc[i][j][r + 1];
                        const int d = n % 192;
                        if (ti.smp && d >= 128) {
                            const int pr = (d - 128) >> 1;
                            const float cs = pr < 16 ? p.ropetab[gr * 16 + pr] : p.ropetab[1024 + gc * 16 + (pr - 16)];
                            const float sn = pr < 16 ? p.ropetab[512 + gr * 16 + pr] : p.ropetab[2048 + gc * 16 + (pr - 16)];
                            const float t0 = v0 * cs - v1 * sn, t1 = v0 * sn + v1 * cs; v0 = t0; v1 = t1;
                        }
                        *(unsigned*)(p.q + (size_t)T * 768 + n) = (unsigned)f2bf(v0 * qs) | ((unsigned)f2bf(v1 * qs) << 16);
                    }
            }
        } else if (item < N_G2 + N_G3) {
            const int it = item - N_G2, tn = it & 7, tm = it >> 3, h = tn >> 1;
            if ((tn & 1) == 0) {
                gemm_acc<2, 2, 2, 2>(p.ckvk + (size_t)tm * 128 * 256, 256, p.wt_ukv + (size_t)tn * 128 * 256, 256, 256, acc);
#pragma unroll
                for (int i = 0; i < 2; ++i)
#pragma unroll
                    for (int j = 0; j < 2; ++j)
#pragma unroll
                        for (int r = 0; r < 16; ++r) {
                            const int row = tm * 128 + ACC_ROW(2, wm, i, r, hl), dcol = ACC_COL(2, wn, j, cl);
                            p.Kn[(size_t)row * 512 + h * 128 + dcol] = f2bf(acc[i][j][r]);
                        }
            } else {
                gemm_acc<2, 2, 2, 2>(p.wt_ukv + (size_t)tn * 128 * 256, 256, p.ckvk + (size_t)tm * 128 * 256, 256, 256, acc);
#pragma unroll
                for (int j = 0; j < 2; ++j) {
                    const int R = tm * 128 + ACC_COL(2, wn, j, cl);
                    size_t base; int Sk, pos;
                    if (R < T_CTX) { Sk = 256; pos = R & 255; base = (size_t)((R >> 8) * 4 + h) * 128 * 256; }
                    else { const int u = R - T_CTX; Sk = 2304; pos = u % 2304; base = (size_t)T_CTX * 512 + (size_t)((u / 2304) * 4 + h) * 128 * 2304; }
#pragma unroll
                    for (int i = 0; i < 2; ++i)
#pragma unroll
                        for (int r = 0; r < 16; ++r) {
                            const int dv = ACC_ROW(2, wm, i, r, hl);
                            p.vT[base + (size_t)dv * Sk + pos] = f2bf(acc[i][j][r]);
                        }
                }
            }
        } else {
            const int it = item - N_G2 - N_G3, tj = it & 3, nb = (it >> 2) & 3, tm = it >> 4;
            gemm_acc<2, 2, 2, 2>(p.xc + (size_t)tm * 128 * 512 + nb * 128, 512, p.wt_gate + ((size_t)nb * 512 + tj * 128) * 128, 128, 128, acc);
            const int dir = tj >> 1, dg = (tj & 1) * 2 + wn, ch = nb * 128 + dg * 32 + cl;
            const float brg = p.b_rg[dir * 512 + ch], big = p.b_ig[dir * 512 + ch];
            const float nl = -p.lam[dir * 512 + ch];
            const float sp = fmaxf(nl, 0.f) + log1pf(__expf(-fabsf(nl)));
#pragma unroll
            for (int i = 0; i < 2; ++i)
#pragma unroll
                for (int r = 0; r < 16; ++r) {
                    const int T = tm * 128 + ACC_ROW(2, wm, i, r, hl);
                    const float rg = sigmoidf_(acc[i][0][r] + brg), ig = sigmoidf_(acc[i][1][r] + big);
                    const float la = -8.f * rg * sp;
                    const float av = __expf(la);
                    const float mult = sqrtf(fmaxf(-expm1f(2.f * la), 0.f));
                    const float xv = bf2f(p.xc[(size_t)T * 512 + ch]);
                    p.a[((size_t)T * 2 + dir) * 512 + ch] = av;
                    p.bxb[((size_t)T * 2 + dir) * 512 + ch] = f2bf(mult * ig * xv);
                }
        }
    }
}

#define N_ATT (128 + 512)
#define SCH 64
#define NCHK (T_TOK / SCH)
#define N_S1 (NCHK * 4)
__device__ void scan_s1_item(const Params& p, int it) {
    const int chunk = it >> 2, dc = (it & 3) * 256 + threadIdx.x, dir = dc >> 9, ch = dc & 511;
    const int T0 = chunk * SCH;
    float A = 1.f, B = 0.f;
#pragma unroll 8
    for (int i = 0; i < SCH; ++i) {
        const int T = dir ? (T0 + SCH - 1 - i) : (T0 + i);
        const float av = p.a[((size_t)T * 2 + dir) * 512 + ch], bv = bf2f(p.bxb[((size_t)T * 2 + dir) * 512 + ch]);
        A *= av; B = B * av + bv;
    }
    *(float2*)(p.agg + (((size_t)chunk * 2 + dir) * 512 + ch) * 2) = make_float2(A, B);
}
__device__ void attn_item_simple(const Params& p, int it) {
    int seq, h, qb, Sk, T0, R0; size_t vbase;
    if (it < 128) { seq = it >> 3; h = (it >> 1) & 3; qb = it & 1; Sk = 256; T0 = seq * 256 + qb * 128; R0 = seq * 256; vbase = (size_t)(seq * 4 + h) * 128 * 256; }
    else { const int u = it - 128; seq = u >> 6; h = (u >> 4) & 3; qb = u & 15; Sk = 2304; T0 = T_CTX + seq * 2048 + qb * 128; R0 = T_CTX + seq * 2304; vbase = (size_t)T_CTX * 512 + (size_t)(seq * 4 + h) * 128 * 2304; }
    const int tid = threadIdx.x, qi = tid >> 1, half = tid & 1;
    const int T = T0 + qi;
    __syncthreads();
    {
        const uint4* qg = (const uint4*)(p.q + (size_t)T0 * 768 + h * 192);
        for (int i = tid; i < 128 * 24; i += 256) { const int r = i / 24, c = i % 24; ((uint4*)smem)[i] = qg[(size_t)r * 96 + c]; }
    }
    __syncthreads();
    const uint4* qv4 = (const uint4*)smem + qi * 24;
    float o[64];
#pragma unroll
    for (int j = 0; j < 64; ++j) o[j] = 0.f;
    float m = -1e30f, l = 0.f;
    for (int key = 0; key < Sk; ++key) {
        const uint4* k4 = (const uint4*)(p.Kn + (size_t)(R0 + key) * 512 + h * 128);
        const uint4* r4 = (const uint4*)(p.kropek + (size_t)(R0 + key) * 64);
        float s = 0.f;
#pragma unroll 4
        for (int j = 0; j < 24; ++j) {
            const uint4 kk = j < 16 ? k4[j] : r4[j - 16];
            const uint4 qq = qv4[j];
            const unsigned kw[4] = {kk.x, kk.y, kk.z, kk.w}, qw[4] = {qq.x, qq.y, qq.z, qq.w};
#pragma unroll
            for (int e = 0; e < 4; ++e) {
                const unsigned a = qw[e], b = kw[e];
                s += __uint_as_float(a << 16) * __uint_as_float(b << 16) + __uint_as_float(a & 0xffff0000u) * __uint_as_float(b & 0xffff0000u);
            }
        }
        const float mn = fmaxf(m, s), alpha = exp2f(m - mn), pe = exp2f(s - mn);
        l = l * alpha + pe; m = mn;
        const bf16_t* vp = p.vT + vbase + (size_t)(half * 64) * Sk + key;
#pragma unroll
        for (int j = 0; j < 64; ++j) o[j] = o[j] * alpha + pe * bf2f(vp[(size_t)j * Sk]);
    }
    const float inv = 1.f / l;
    bf16_t* dst = p.hbuf + (size_t)T * 1024 + h * 128 + half * 64;
#pragma unroll
    for (int j = 0; j < 64; j += 2) *(unsigned*)(dst + j) = (unsigned)f2bf(o[j] * inv) | ((unsigned)f2bf(o[j + 1] * inv) << 16);
}

__device__ __forceinline__ int perm23(int r) { return (r & 0x13) | ((r & 4) << 1) | ((r & 8) >> 1); }
__device__ void attn_item_mfma(const Params& p, int it) {
    int seq, h, qb, Sk, T0, R0; size_t vbase;
    if (it < 128) { seq = it >> 3; h = (it >> 1) & 3; qb = it & 1; Sk = 256; T0 = seq * 256 + qb * 128; R0 = seq * 256; vbase = (size_t)(seq * 4 + h) * 128 * 256; }
    else { const int u = it - 128; seq = u >> 6; h = (u >> 4) & 3; qb = u & 15; Sk = 2304; T0 = T_CTX + seq * 2048 + qb * 128; R0 = T_CTX + seq * 2304; vbase = (size_t)T_CTX * 512 + (size_t)(seq * 4 + h) * 128 * 2304; }
    const int tid = threadIdx.x, lane = tid & 63, wid = tid >> 6, hl = lane >> 5, cl = lane & 31;
    bf16x8_t qf[12];
    {
        const bf16_t* qrow = p.q + (size_t)(T0 + 32 * wid + cl) * 768 + h * 192 + 8 * hl;
#pragma unroll
        for (int ks = 0; ks < 12; ++ks) qf[ks] = __builtin_bit_cast(bf16x8_t, *(const u32x4*)(qrow + 16 * ks));
    }
    f32x16 oacc[4];
#pragma unroll
    for (int d = 0; d < 4; ++d)
#pragma unroll
        for (int r = 0; r < 16; ++r) oacc[d][r] = 0.f;
    float m = -1e30f, lsum = 0.f;
    const bf16_t* gk = p.Kn + (size_t)(R0 + (tid >> 4)) * 512 + h * 128 + (tid & 15) * 8;
    const bf16_t* gr = p.kropek + (size_t)(R0 + (tid >> 3)) * 64 + (tid & 7) * 8;
    const bf16_t* gv = p.vT + vbase + (size_t)(tid >> 3) * Sk + (tid & 7) * 8;
    const int lk = ((tid & 15) >> 3) * 8192 + lds_off(tid >> 4, tid & 7);
    u32x4 rk[4], rr[2], rv[4];
    const int nt = Sk >> 6;
#pragma unroll
    for (int i = 0; i < 4; ++i) rk[i] = *(const u32x4*)(gk + (size_t)(16 * i) * 512);
#pragma unroll
    for (int i = 0; i < 2; ++i) rr[i] = *(const u32x4*)(gr + (size_t)(32 * i) * 64);
#pragma unroll
    for (int i = 0; i < 4; ++i) rv[i] = *(const u32x4*)(gv + (size_t)(32 * i) * Sk);
    (void)lk;
    __syncthreads();
    for (int t = 0; t < nt; ++t) {
#pragma unroll
        for (int i = 0; i < 4; ++i) *(u32x4*)(smem + ((tid & 15) >> 3) * 8192 + lds_off((tid >> 4) + 16 * i, tid & 7)) = rk[i];
#pragma unroll
        for (int i = 0; i < 2; ++i) *(u32x4*)(smem + 16384 + lds_off((tid >> 3) + 32 * i, tid & 7)) = rr[i];
#pragma unroll
        for (int i = 0; i < 4; ++i) *(u32x4*)(smem + 24576 + lds_off((tid >> 3) + 32 * i, tid & 7)) = rv[i];
        __syncthreads();
        if (t + 1 < nt) {
            const size_t ko = (size_t)(t + 1) * 64;
#pragma unroll
            for (int i = 0; i < 4; ++i) rk[i] = *(const u32x4*)(gk + (ko + 16 * i) * 512);
#pragma unroll
            for (int i = 0; i < 2; ++i) rr[i] = *(const u32x4*)(gr + (ko + 32 * i) * 64);
#pragma unroll
            for (int i = 0; i < 4; ++i) rv[i] = *(const u32x4*)(gv + (size_t)(32 * i) * Sk + ko);
        }
        f32x16 sacc[2];
#pragma unroll
        for (int kb = 0; kb < 2; ++kb) {
#pragma unroll
            for (int r = 0; r < 16; ++r) sacc[kb][r] = 0.f;
            const int krow = 32 * kb + perm23(cl);
#pragma unroll
            for (int ks = 0; ks < 12; ++ks) {
                const bf16x8_t kf = __builtin_bit_cast(bf16x8_t, *(const u32x4*)(smem + (ks >> 2) * 8192 + lds_off(krow, 2 * (ks & 3) + hl)));
                sacc[kb] = __builtin_amdgcn_mfma_f32_32x32x16_bf16(kf, qf[ks], sacc[kb], 0, 0, 0);
            }
        }
        float mx = sacc[0][0];
#pragma unroll
        for (int r = 1; r < 16; ++r) mx = fmaxf(mx, sacc[0][r]);
#pragma unroll
        for (int r = 0; r < 16; ++r) mx = fmaxf(mx, sacc[1][r]);
        mx = fmaxf(mx, __shfl_xor(mx, 32));
        const float mn = fmaxf(m, mx), alpha = __builtin_amdgcn_exp2f(m - mn);
        m = mn;
        float ps = 0.f;
        bf16x8_t pf[2][2];
#pragma unroll
        for (int kb = 0; kb < 2; ++kb)
#pragma unroll
            for (int s2 = 0; s2 < 2; ++s2) {
                float e[8];
#pragma unroll
                for (int j = 0; j < 8; ++j) { e[j] = __builtin_amdgcn_exp2f(sacc[kb][8 * s2 + j] - mn); ps += e[j]; }
                u32x4 w; w.x = pack_bf16(e[0], e[1]); w.y = pack_bf16(e[2], e[3]); w.z = pack_bf16(e[4], e[5]); w.w = pack_bf16(e[6], e[7]);
                pf[kb][s2] = __builtin_bit_cast(bf16x8_t, w);
            }
        lsum = lsum * alpha + ps;
#pragma unroll
        for (int d = 0; d < 4; ++d)
#pragma unroll
            for (int r = 0; r < 16; ++r) oacc[d][r] *= alpha;
#pragma unroll
        for (int d = 0; d < 4; ++d)
#pragma unroll
            for (int kb = 0; kb < 2; ++kb)
#pragma unroll
                for (int s2 = 0; s2 < 2; ++s2) {
                    const bf16x8_t vf = __builtin_bit_cast(bf16x8_t, *(const u32x4*)(smem + 24576 + lds_off(32 * d + cl, 4 * kb + 2 * s2 + hl)));
                    oacc[d] = __builtin_amdgcn_mfma_f32_32x32x16_bf16(vf, pf[kb][s2], oacc[d], 0, 0, 0);
                }
        __syncthreads();
    }
    lsum += __shfl_xor(lsum, 32);
    const float inv = 1.f / lsum;
    bf16_t* dst = p.hbuf + (size_t)(T0 + 32 * wid + cl) * 1024 + h * 128 + 4 * hl;
#pragma unroll
    for (int d = 0; d < 4; ++d)
#pragma unroll
        for (int g = 0; g < 4; ++g) {
            uint2 w; w.x = pack_bf16(oacc[d][4 * g] * inv, oacc[d][4 * g + 1] * inv); w.y = pack_bf16(oacc[d][4 * g + 2] * inv, oacc[d][4 * g + 3] * inv);
            *(uint2*)(dst + 32 * d + 8 * g) = w;
        }
}
__device__ void st_attn_s1(const Params& p) {
    for (int item = blockIdx.x; item < N_ATT + N_S1; item += gridDim.x) {
        if (item < N_ATT) {
#ifdef ATTN_SIMPLE
            attn_item_simple(p, N_ATT - 1 - item);
#else
            attn_item_mfma(p, N_ATT - 1 - item);
#endif
        }
        else scan_s1_item(p, item - N_ATT);
    }
}

__device__ void st_scan3(const Params& p) {
    const int tid = threadIdx.x;
    float* hf = (float*)smem;
    float* hb = hf + SCH * 128;
    float* o_lru = p.out + 22282240;
    for (int item = blockIdx.x; item < NCHK * 4; item += gridDim.x) {
        const int chunk = item >> 2, cgp = item & 3, T0 = chunk * SCH;
        const TokInfo ti = tokinfo(T0);
        const int nch = ti.S / SCH, cpos = ti.s / SCH, c0 = chunk - cpos;
        const int dir = tid >> 7, ch = cgp * 128 + (tid & 127);
        float hcur = ti.smp ? p.state_lru[((size_t)ti.b * 2 + dir) * 512 + ch] : 0.f;
        if (dir == 0) { for (int cc = 0; cc < cpos; ++cc) { const float2 ab = *(const float2*)(p.agg + (((size_t)(c0 + cc) * 2 + 0) * 512 + ch) * 2); hcur = ab.x * hcur + ab.y; } }
        else { for (int cc = nch - 1; cc > cpos; --cc) { const float2 ab = *(const float2*)(p.agg + (((size_t)(c0 + cc) * 2 + 1) * 512 + ch) * 2); hcur = ab.x * hcur + ab.y; } }
        __syncthreads();
#pragma unroll 8
        for (int i = 0; i < SCH; ++i) {
            const int tl = dir ? SCH - 1 - i : i, T = T0 + tl;
            const float av = p.a[((size_t)T * 2 + dir) * 512 + ch], bv = bf2f(p.bxb[((size_t)T * 2 + dir) * 512 + ch]);
            hcur = av * hcur + bv;
            (dir ? hb : hf)[tl * 128 + (tid & 127)] = hcur;
        }
        if (!ti.smp) {
            if (dir == 0 && cpos == nch - 1) o_lru[((size_t)ti.b * 2 + 0) * 512 + ch] = hcur;
            if (dir == 1 && cpos == 0) o_lru[((size_t)ti.b * 2 + 1) * 512 + ch] = hcur;
        }
        __syncthreads();
        for (int i = tid; i < SCH * 64; i += 256) {
            const int tl = i >> 6, c = (i & 63) * 2, T = T0 + tl, chh = cgp * 128 + c;
            const unsigned ugp = *(const unsigned*)(p.ug + (size_t)T * 512 + chh);
            const float g0 = gelu_tanh(__uint_as_float(ugp << 16)), g1 = gelu_tanh(__uint_as_float(ugp & 0xffff0000u));
            const float2 f = *(const float2*)(hf + tl * 128 + c), bb = *(const float2*)(hb + tl * 128 + c);
            *(unsigned*)(p.hbuf + (size_t)T * 1024 + 512 + chh) = pack_bf16((f.x + bb.x) * g0, (f.y + bb.y) * g1);
        }
    }
}

__device__ void st_gemm_o(const Params& p) {
    const int lane = threadIdx.x & 63, wid = threadIdx.x >> 6, wm = wid >> 1, wn = wid & 1, hl = lane >> 5, cl = lane & 31;
    for (int item = blockIdx.x; item < 160 * 8; item += gridDim.x) {
        const int tn = item & 7, tm = item >> 3;
        f32x16 acc[2][2];
        gemm_acc<2, 2, 2, 2>(p.hbuf + (size_t)tm * 128 * 1024, 1024, p.wt_o + (size_t)tn * 128 * 1024, 1024, 1024, acc);
        const int mi = tokinfo(tm * 128).mi;
#pragma unroll
        for (int j = 0; j < 2; ++j) {
            const int col = tn * 128 + ACC_COL(2, wn, j, cl);
            const float gt = modv(p, 0, mi, 2)[col];
#pragma unroll
            for (int i = 0; i < 2; ++i)
#pragma unroll
                for (int r = 0; r < 16; ++r) {
                    const int row = tm * 128 + ACC_ROW(2, wm, i, r, hl);
                    p.xres[(size_t)row * 1024 + col] = x_in_row(p, row)[col] + gt * acc[i][j][r];
                }
        }
    }
}

__device__ void st_gemm_pq(const Params& p, int l) {
    const int lane = threadIdx.x & 63, wid = threadIdx.x >> 6, wm = wid >> 1, wn = wid & 1, hl = lane >> 5, cl = lane & 31;
    for (int item = blockIdx.x; item < 160 * 16; item += gridDim.x) {
        const int tn = item & 15, tm = item >> 4;
        f32x16 acc[2][2];
        gemm_acc<2, 2, 2, 2>(p.hbuf + (size_t)tm * 128 * 1024, 1024, p.wt_pq[l] + (size_t)tn * 128 * 1024, 1024, 1024, acc);
#pragma unroll
        for (int i = 0; i < 2; ++i)
#pragma unroll
            for (int j = 0; j < 2; ++j)
#pragma unroll
                for (int r = 0; r < 16; ++r) {
                    const int row = tm * 128 + ACC_ROW(2, wm, i, r, hl), col = tn * 128 + ACC_COL(2, wn, j, cl);
                    p.qp[(size_t)row * 2048 + col] = f2bf(acc[i][j][r]);
                }
    }
}

__device__ __forceinline__ void ins16(float (&top)[16], float x) {
#pragma unroll
    for (int i = 0; i < 16; ++i) { const float hi = fmaxf(top[i], x); x = fminf(top[i], x); top[i] = hi; }
}
__device__ void st_peer_topk(const Params& p, int l) {
    const int lane = threadIdx.x & 63, wid = threadIdx.x >> 6, hl = lane >> 5, cl = lane & 31;
    for (int item = blockIdx.x; item < 160 * 8; item += gridDim.x) {
        const int h = item & 7, tm = item >> 3;
        const int T = tm * 128 + 32 * wid + cl;
        float top[2][16];
#pragma unroll
        for (int pp = 0; pp < 2; ++pp) {
            f32x16 acc[4][1];
            gemm_acc<4, 1, 1, 4>(p.keysb[l] + (size_t)(h * 2 + pp) * 128 * 128, 128, p.qp + (size_t)tm * 128 * 2048 + h * 256 + pp * 128, 2048, 128, acc);
#pragma unroll
            for (int i = 0; i < 16; ++i) top[pp][i] = -INFINITY;
#pragma unroll
            for (int i = 0; i < 4; ++i) {
                __builtin_amdgcn_sched_barrier(0);
#pragma unroll
                for (int r = 0; r < 16; ++r) {
                    const int n = ACC_ROW(4, 0, i, r, hl);
                    const float x = __uint_as_float((__float_as_uint(acc[i][0][r]) & 0xffffff80u) | (unsigned)n);
                    ins16(top[pp], x);
                }
            }
            __builtin_amdgcn_sched_barrier(0);
            float oth[16];
#pragma unroll
            for (int i = 0; i < 16; ++i) oth[i] = __shfl_xor(top[pp][i], 32);
#pragma unroll
            for (int i = 0; i < 16; ++i) ins16(top[pp], oth[i]);
        }
        float fv[16];
#pragma unroll
        for (int i = 0; i < 16; ++i) fv[i] = -INFINITY;
#pragma unroll
        for (int i = 0; i < 16; ++i)
#pragma unroll
            for (int j = 0; j < 16; ++j)
                if ((i + 1) * (j + 1) <= 16) {
                    const float cv = __uint_as_float(__float_as_uint(top[0][i]) & 0xffffff80u) + __uint_as_float(__float_as_uint(top[1][j]) & 0xffffff80u);
                    ins16(fv, __uint_as_float((__float_as_uint(cv) & 0xffffff00u) | (unsigned)(i * 16 + j)));
                }
        unsigned* tab = (unsigned*)smem + (size_t)threadIdx.x * 8;
#pragma unroll
        for (int k = 0; k < 4; ++k) {
            tab[k] = (__float_as_uint(top[0][4 * k]) & 127u) | ((__float_as_uint(top[0][4 * k + 1]) & 127u) << 8) | ((__float_as_uint(top[0][4 * k + 2]) & 127u) << 16) | ((__float_as_uint(top[0][4 * k + 3]) & 127u) << 24);
            tab[4 + k] = (__float_as_uint(top[1][4 * k]) & 127u) | ((__float_as_uint(top[1][4 * k + 1]) & 127u) << 8) | ((__float_as_uint(top[1][4 * k + 2]) & 127u) << 16) | ((__float_as_uint(top[1][4 * k + 3]) & 127u) << 24);
        }
        const u8_t* tabb = (const u8_t*)tab;
        int fe[16];
#pragma unroll
        for (int i = 0; i < 16; ++i) {
            const unsigned code = __float_as_uint(fv[i]) & 255u;
            fe[i] = (int)tabb[code >> 4] * 128 + (int)tabb[16 + (code & 15u)];
            fv[i] = __uint_as_float(__float_as_uint(fv[i]) & 0xffffff00u);
        }
        float sum = 0.f, ev[16];
#pragma unroll
        for (int i = 0; i < 16; ++i) { ev[i] = __expf(fv[i] - fv[0]); sum += ev[i]; }
        const float inv = 1.f / sum;
        if (hl == 0) {
#pragma unroll
            for (int i = 0; i < 16; ++i) { p.gates[(size_t)T * 128 + h * 16 + i] = ev[i] * inv; p.eidx[(size_t)T * 128 + h * 16 + i] = fe[i]; }
        }
    }
}

__device__ void st_peer_gather(const Params& p, int l) {
    const int lane = threadIdx.x & 63, wid = threadIdx.x >> 6;
    const u8_t* U = p.u8[l]; const u8_t* V = p.v8[l]; const float* SU = p.su[l]; const float* SV = p.sv[l];
    for (int T = blockIdx.x * 4 + wid; T < T_TOK; T += gridDim.x * 4) {
        const TokInfo ti = tokinfo(T);
        float hv[16];
        {
            const uint4* hp = (const uint4*)(p.hbuf + (size_t)T * 1024 + lane * 16);
            float t8[8]; unpack8(hp[0], t8);
#pragma unroll
            for (int j = 0; j < 8; ++j) hv[j] = t8[j];
            unpack8(hp[1], t8);
#pragma unroll
            for (int j = 0; j < 8; ++j) hv[8 + j] = t8[j];
        }
        const int e0 = p.eidx[(size_t)T * 128 + lane], e1 = p.eidx[(size_t)T * 128 + 64 + lane];
        const float g0 = p.gates[(size_t)T * 128 + lane], g1 = p.gates[(size_t)T * 128 + 64 + lane];
        float outv[16];
#pragma unroll
        for (int j = 0; j < 16; ++j) outv[j] = 0.f;
        for (int kb = 0; kb < 16; ++kb) {
            const int esel = kb < 8 ? e0 : e1; const float gsel = kb < 8 ? g0 : g1;
            const int kl = (kb & 7) * 8;
            u32x4 ur[8], vr[8];
#pragma unroll
            for (int j = 0; j < 8; ++j) {
                const int e = __builtin_amdgcn_readlane(esel, kl + j);
                ur[j] = *(const u32x4*)(U + (size_t)e * 1024 + lane * 16);
                vr[j] = *(const u32x4*)(V + (size_t)e * 1024 + lane * 16);
            }
            const int emine = __builtin_amdgcn_ds_bpermute((kl + (lane >> 3)) << 2, esel);
            const float gmine = __int_as_float(__builtin_amdgcn_ds_bpermute((kl + (lane >> 3)) << 2, __float_as_int(gsel)));
            const float su = SU[emine], sv = SV[emine];
            float d[8];
#pragma unroll
            for (int j = 0; j < 8; ++j) {
                float a = 0.f;
#pragma unroll
                for (int q = 0; q < 4; ++q) {
                    const f32x2 lo = __builtin_amdgcn_cvt_pk_f32_fp8((int)ur[j][q], false), hi = __builtin_amdgcn_cvt_pk_f32_fp8((int)ur[j][q], true);
                    a += lo.x * hv[4 * q] + lo.y * hv[4 * q + 1] + hi.x * hv[4 * q + 2] + hi.y * hv[4 * q + 3];
                }
                d[j] = a;
            }
            float s1[4];
#pragma unroll
            for (int i = 0; i < 4; ++i) { const u32x2 r = __builtin_amdgcn_permlane32_swap(__float_as_uint(d[i]), __float_as_uint(d[i + 4]), false, false); s1[i] = __uint_as_float(r[0]) + __uint_as_float(r[1]); }
            float s2[2];
#pragma unroll
            for (int i = 0; i < 2; ++i) { const u32x2 r = __builtin_amdgcn_permlane16_swap(__float_as_uint(s1[i]), __float_as_uint(s1[i + 2]), false, false); s2[i] = __uint_as_float(r[0]) + __uint_as_float(r[1]); }
            const bool b3 = (lane & 8) != 0;
            const float snd = b3 ? s2[0] : s2[1], kp = b3 ? s2[1] : s2[0];
            float z = kp + DPP_F(snd, 0x128);
            z += DPP_F(z, 0xB1); z += DPP_F(z, 0x4E); z += DPP_F(z, 0x141);
            const float w = gmine * gelu_tanh(z * su) * sv;
#pragma unroll
            for (int j = 0; j < 8; ++j) {
                const float wj = __int_as_float(__builtin_amdgcn_readlane(__float_as_int(w), 8 * j));
#pragma unroll
                for (int q = 0; q < 4; ++q) {
                    const f32x2 lo = __builtin_amdgcn_cvt_pk_f32_fp8((int)vr[j][q], false), hi = __builtin_amdgcn_cvt_pk_f32_fp8((int)vr[j][q], true);
                    outv[4 * q] += wj * lo.x; outv[4 * q + 1] += wj * lo.y; outv[4 * q + 2] += wj * hi.x; outv[4 * q + 3] += wj * hi.y;
                }
            }
        }
        float* xr = p.xres + (size_t)T * 1024 + lane * 16;
        const float* gt = modv(p, l, ti.mi, 5) + lane * 16;
        float xn[16]; float ss = 0.f;
#pragma unroll
        for (int j = 0; j < 4; ++j) { const float4 f = *(const float4*)(xr + 4 * j); xn[4 * j] = f.x + gt[4 * j] * outv[4 * j]; xn[4 * j + 1] = f.y + gt[4 * j + 1] * outv[4 * j + 1]; xn[4 * j + 2] = f.z + gt[4 * j + 2] * outv[4 * j + 2]; xn[4 * j + 3] = f.w + gt[4 * j + 3] * outv[4 * j + 3]; }
#pragma unroll
        for (int j = 0; j < 16; ++j) ss += xn[j] * xn[j];
        ss = wave_sum(ss);
        const float rstd = rsqrtf(ss * (1.f / 1024.f) + 1e-6f);
        if (l == 0) {
#pragma unroll
            for (int j = 0; j < 4; ++j) *(float4*)(xr + 4 * j) = make_float4(xn[4 * j], xn[4 * j + 1], xn[4 * j + 2], xn[4 * j + 3]);
            const float* sh = modv(p, 1, ti.mi, 0) + lane * 16; const float* sc = modv(p, 1, ti.mi, 1) + lane * 16; const float* gg = p.g_mix[1] + lane * 16;
            unsigned w[8];
#pragma unroll
            for (int j = 0; j < 8; ++j) {
                const float a0 = xn[2 * j] * rstd * gg[2 * j] * (1.f + sc[2 * j]) + sh[2 * j];
                const float a1 = xn[2 * j + 1] * rstd * gg[2 * j + 1] * (1.f + sc[2 * j + 1]) + sh[2 * j + 1];
                w[j] = (unsigned)f2bf(a0) | ((unsigned)f2bf(a1) << 16);
            }
            uint4* d = (uint4*)(p.h3 + (size_t)T * 1024 + lane * 16);
            d[0] = make_uint4(w[0], w[1], w[2], w[3]); d[1] = make_uint4(w[4], w[5], w[6], w[7]);
        } else {
            const float* gg = p.g_final + lane * 16;
            float* y = p.out + (size_t)T * 1024 + lane * 16;
#pragma unroll
            for (int j = 0; j < 4; ++j) *(float4*)(y + 4 * j) = make_float4(xn[4 * j] * rstd * gg[4 * j], xn[4 * j + 1] * rstd * gg[4 * j + 1], xn[4 * j + 2] * rstd * gg[4 * j + 2], xn[4 * j + 3] * rstd * gg[4 * j + 3]);
        }
    }
}

__device__ void st_pool(const Params& p) {
    const int tid = threadIdx.x, ck = tid & 127, g = ck >> 5, w = 2 << g;
    for (int T = blockIdx.x * 2 + (tid >> 7); T < T_TOK; T += gridDim.x * 2) {
        const TokInfo ti = tokinfo(T);
        const int lo = max(ti.s - w / 2, 0), hi = min(ti.s + w / 2, ti.S);
        const bf16_t* base = p.h3 + (size_t)(T - ti.s) * 1024 + ck * 8;
        float acc[8];
#pragma unroll
        for (int j = 0; j < 8; ++j) acc[j] = 0.f;
        for (int t2 = lo; t2 < hi; ++t2) {
            float f[8]; unpack8(*(const uint4*)(base + (size_t)t2 * 1024), f);
#pragma unroll
            for (int j = 0; j < 8; ++j) acc[j] += f[j];
        }
        float c[8]; unpack8(*(const uint4*)(base + (size_t)ti.s * 1024), c);
        const float inv = 1.f / (float)(hi - lo);
        uint4 o;
        o.x = pack_bf16(acc[0] * inv - c[0], acc[1] * inv - c[1]); o.y = pack_bf16(acc[2] * inv - c[2], acc[3] * inv - c[3]);
        o.z = pack_bf16(acc[4] * inv - c[4], acc[5] * inv - c[5]); o.w = pack_bf16(acc[6] * inv - c[6], acc[7] * inv - c[7]);
        *(uint4*)(p.hbuf + (size_t)T * 1024 + ck * 8) = o;
    }
}

__device__ void st_gemm_pool(const Params& p) {
    const int lane = threadIdx.x & 63, wid = threadIdx.x >> 6, wm = wid >> 1, wn = wid & 1, hl = lane >> 5, cl = lane & 31;
    for (int item = blockIdx.x; item < 160 * 8; item += gridDim.x) {
        const int tn = item & 7, tm = item >> 3, g = tn >> 1;
        f32x16 acc[2][2];
        gemm_acc<2, 2, 2, 2>(p.hbuf + (size_t)tm * 128 * 1024 + g * 256, 1024, p.wt_pool + ((size_t)g * 256 + (tn & 1) * 128) * 256, 256, 256, acc);
        const int mi = tokinfo(tm * 128).mi;
#pragma unroll
        for (int j = 0; j < 2; ++j) {
            const int col = tn * 128 + ACC_COL(2, wn, j, cl);
            const float gs = modv(p, 1, mi, 2)[col] * p.s_pool[col];
#pragma unroll
            for (int i = 0; i < 2; ++i)
#pragma unroll
                for (int r = 0; r < 16; ++r) {
                    const int row = tm * 128 + ACC_ROW(2, wm, i, r, hl);
                    p.xres[(size_t)row * 1024 + col] += gs * acc[i][j][r];
                }
        }
    }
}

__device__ __forceinline__ void run_stage(const Params& p, int s) {
#ifdef ONLY_STAGE
    if (s != ONLY_STAGE) return;
#endif
    switch (s) {
        case 0: st_prologue(p); break;
        case 1: st_norm<0>(p, 0, 0, p.g_mix[0], p.hbuf); break;
        case 2: st_gemm1(p); break;
        case 3: st_postproj(p); break;
        case 4: st_gemm234(p); break;
        case 5: st_attn_s1(p); break;
        case 6: st_scan3(p); break;
        case 7: st_gemm_o(p); break;
        case 8: st_norm<1>(p, 0, 1, p.g_ffn[0], p.hbuf); break;
        case 9: st_gemm_pq(p, 0); break;
        case 10: st_peer_topk(p, 0); break;
        case 11: st_peer_gather(p, 0); break;
        case 12: st_pool(p); break;
        case 13: st_gemm_pool(p); break;
        case 14: st_norm<1>(p, 1, 1, p.g_ffn[1], p.hbuf); break;
        case 15: st_gemm_pq(p, 1); break;
        case 16: st_peer_topk(p, 1); break;
        case 17: st_peer_gather(p, 1); break;
        default: break;
    }
}

__global__ void __launch_bounds__(256, 2) fwd_mega(Params p) {
    cg::grid_group grid = cg::this_grid();
    volatile LAS unsigned* st = (volatile LAS unsigned*)(smem + 65536);
    if (threadIdx.x == 0) { st[0] = 0; st[1] = 0; st[2] = 0; st[3] = 0; }
    __syncthreads();
    XcdBarrier b = xcd_barrier_post(p.bar, st);
    if (p.bar == nullptr) grid.sync();
#ifndef REP_MASK
#define REP_MASK 0
#endif
#define MK_ST(k) run_stage(p, k); if ((REP_MASK >> (k)) & 1) { xcd_barrier(b); run_stage(p, k); } if ((k) + 1 < NSTAGE) xcd_barrier(b);
    MK_ST(0) MK_ST(1) MK_ST(2) MK_ST(3) MK_ST(4) MK_ST(5) MK_ST(6) MK_ST(7) MK_ST(8) MK_ST(9) MK_ST(10) MK_ST(11) MK_ST(12) MK_ST(13) MK_ST(14) MK_ST(15) MK_ST(16) MK_ST(17)
}
__global__ void __launch_bounds__(256, 2) fwd_stage(Params p, int s) { run_stage(p, s); }

extern "C" void kernel_launch(void* const* d_in, const int* in_sizes, int n_in, void* d_out, int out_size, void* d_ws, size_t ws_size, hipStream_t stream) {
    constexpr size_t kDynLds = 65536 + 1024;
    static int grid_blocks = 0;
    if (!grid_blocks) {
        int dev = 0, cus = 0, per_cu = 0;
        (void)hipGetDevice(&dev);
        (void)hipDeviceGetAttribute(&cus, hipDeviceAttributeMultiprocessorCount, dev);
        (void)hipFuncSetAttribute((const void*)fwd_mega, hipFuncAttributeMaxDynamicSharedMemorySize, (int)kDynLds);
        (void)hipFuncSetAttribute((const void*)fwd_stage, hipFuncAttributeMaxDynamicSharedMemorySize, (int)kDynLds);
        (void)hipOccupancyMaxActiveBlocksPerMultiprocessor(&per_cu, fwd_mega, 256, kDynLds);
        if (per_cu > 2) per_cu = 2;
        if (per_cu < 1) per_cu = 1;
        grid_blocks = cus * per_cu;
    }
    Params p{};
    const float* const* in = (const float* const*)d_in;
    p.x_prompt = in[0]; p.x_sample = in[1]; p.cache_ckv = in[2]; p.cache_krope = in[3]; p.state_lru = in[4]; p.c = in[5]; p.c_ctx = in[6];
    p.w_mod[0] = in[7]; p.b_mod[0] = in[8]; p.w_mod[1] = in[9]; p.b_mod[1] = in[10];
    p.g_mix[0] = in[11]; p.g_ffn[0] = in[12]; p.g_mix[1] = in[13]; p.g_ffn[1] = in[14];
    p.w_in = in[15]; p.g_q = in[16]; p.w_uq = in[17]; p.g_kv = in[18]; p.w_ukv = in[19]; p.conv_w = in[20]; p.conv_b = in[21];
    p.w_rg = in[22]; p.b_rg = in[23]; p.w_ig = in[24]; p.b_ig = in[25]; p.lam = in[26]; p.w_o = in[27]; p.w_pool = in[28]; p.s_pool = in[29];
    p.peer_wq[0] = in[30]; p.peer_keys[0] = in[31]; p.peer_u[0] = in[32]; p.peer_v[0] = in[33];
    p.peer_wq[1] = in[34]; p.peer_keys[1] = in[35]; p.peer_u[1] = in[36]; p.peer_v[1] = in[37];
    p.g_final = in[38];
    p.out = (float*)d_out;
    char* base = (char*)d_ws; size_t off = 0;
    auto take = [&](size_t bytes) { char* r = base + off; off += (bytes + 255) & ~(size_t)255; return r; };
    const size_t MiB = 1u << 20;
    p.bar = (unsigned*)take(16384);
    p.mod = (float*)take((size_t)2 * 9 * 6144 * 4);
    p.ropetab = (float*)take(3072 * 4);
    p.wt_in = (bf16_t*)take((size_t)NW_IN * 2); p.wt_uq = (bf16_t*)take((size_t)NW_UQ * 2); p.wt_ukv = (bf16_t*)take((size_t)NW_UKV * 2);
    p.wt_gate = (bf16_t*)take((size_t)NW_GATE * 2); p.wt_o = (bf16_t*)take((size_t)NW_O * 2); p.wt_pool = (bf16_t*)take((size_t)NW_POOL * 2);
    p.wt_pq[0] = (bf16_t*)take((size_t)NW_PQ * 2); p.wt_pq[1] = (bf16_t*)take((size_t)NW_PQ * 2);
    p.keysb[0] = (bf16_t*)take((size_t)NW_KEYS * 2); p.keysb[1] = (bf16_t*)take((size_t)NW_KEYS * 2);
    for (int l = 0; l < 2; ++l) { p.u8[l] = (u8_t*)take(16 * MiB); p.v8[l] = (u8_t*)take(16 * MiB); p.su[l] = (float*)take(65536); p.sv[l] = (float*)take(65536); }
    char* regX = take(80 * MiB);
    char* regQ = take(80 * MiB);
    char* regH = take(40 * MiB);
    p.P = (bf16_t*)regX; p.a = (float*)regX; p.xres = (float*)regX;
    p.bxb = (bf16_t*)regQ; p.q = (bf16_t*)(regQ + 40 * MiB); p.agg = (float*)(regQ + 70 * MiB); p.qp = (bf16_t*)regQ; p.h3 = (bf16_t*)regQ;
    p.hbuf = (bf16_t*)regH;
    p.cqn = (bf16_t*)take((size_t)T_TOK * 384 * 2); p.ckvk = (bf16_t*)take((size_t)R_KEYS * 256 * 2); p.kropek = (bf16_t*)take((size_t)R_KEYS * 64 * 2);
    p.xc = (bf16_t*)take((size_t)T_TOK * 512 * 2); p.ug = (bf16_t*)take((size_t)T_TOK * 512 * 2);
    p.Kn = (bf16_t*)take((size_t)R_KEYS * 512 * 2); p.vT = (bf16_t*)take((size_t)R_KEYS * 512 * 2);
    p.gates = (float*)p.Kn; p.eidx = (int*)((char*)p.Kn + (size_t)T_TOK * 128 * 4);
    if (off > ws_size) fprintf(stderr, "workspace too small: need %zu have %zu\n", off, ws_size);
    (void)hipMemsetAsync(d_ws, 0, 16384, stream);
#if MK_LAUNCHES == 1
    void* args[] = {&p};
    hipError_t e = hipLaunchCooperativeKernel((void*)fwd_mega, dim3(grid_blocks), dim3(256), args, kDynLds, stream);
    if (e != hipSuccess) fprintf(stderr, "cooperative launch failed: %s (grid %d)\n", hipGetErrorString(e), grid_blocks);
#else
    for (int s = 0; s < NSTAGE; ++s) hipLaunchKernelGGL(fwd_stage, dim3(grid_blocks), dim3(256), kDynLds, stream, p, s);
#endif
}
```

```cpp
#include <hip/hip_runtime.h>
#include <hip/hip_cooperative_groups.h>
#include <cstdio>
#include <cstdint>
namespace cg = cooperative_groups;

#ifndef MK_LAUNCHES
#define MK_LAUNCHES 1
#endif

typedef unsigned short bf16_t;
typedef unsigned char u8_t;
typedef float f32x16 __attribute__((ext_vector_type(16)));
typedef float f32x2 __attribute__((ext_vector_type(2)));
typedef unsigned u32x4 __attribute__((ext_vector_type(4)));
typedef float f32x4v __attribute__((ext_vector_type(4)));

#define T_TOK 20480
#define T_CTX 4096
#define R_KEYS 22528
#define NSTAGE 18
#define LAS __attribute__((address_space(3)))

#define XB_TMO      128
#define XB_XCNT(j)  (256  + 64 * (j))
#define XB_XSUB(j)  (1280 + 64 * (j))
#define XB_XGEN(j)  (2304 + 64 * (j))
#define XB_TOP      3328
#define XB_TOPGEN   3392
#define XCD_BAR_WORDS 3456
#define XB_SPIN_CAP (1u << 22)
__device__ __forceinline__ unsigned xb_ld(unsigned* p)              { return __hip_atomic_load(p, __ATOMIC_RELAXED, __HIP_MEMORY_SCOPE_AGENT); }
__device__ __forceinline__ unsigned xb_add(unsigned* p, unsigned v) { return __hip_atomic_fetch_add(p, v, __ATOMIC_RELAXED, __HIP_MEMORY_SCOPE_AGENT); }
__device__ __forceinline__ unsigned xb_xcc_id() { return (unsigned)__builtin_amdgcn_s_getreg((3 << 11) | 20) & 0xFu; }
#define XB_SPIN(cond, bar) do { unsigned _sp = 0; while (cond) { __builtin_amdgcn_s_sleep(1); \
    if ((++_sp & 255u) == 0u) { if (xb_ld(&(bar)[XB_TMO])) break; if (_sp > XB_SPIN_CAP) { atomicAdd(&(bar)[XB_TMO], 1u); break; } } } } while (0)
struct XcdBarrier { unsigned* bar; unsigned x; volatile LAS unsigned* st; };
__device__ __forceinline__ XcdBarrier xcd_barrier_post(unsigned* bar, volatile LAS unsigned* st) {
    XcdBarrier b; b.bar = bar; b.x = xb_xcc_id(); b.st = st;
    if (threadIdx.x == 0) (void)xb_add(&bar[XB_XCNT(b.x)], 1u);
    return b;
}
__device__ __forceinline__ void xcd_barrier_complete(unsigned* bar, unsigned x, unsigned& nloc, unsigned& nx) {
    const unsigned G = gridDim.x * gridDim.y * gridDim.z;
    unsigned sum, cnt, mine, sp = 0u;
    for (;;) {
        sum = 0u; cnt = 0u; mine = 0u;
#pragma unroll
        for (unsigned j = 0; j < 16; ++j) { const unsigned c = xb_ld(&bar[XB_XCNT(j)]); sum += c; cnt += (c > 0u) ? 1u : 0u; mine = (j == x) ? c : mine; }
        if (sum == G) break;
        __builtin_amdgcn_s_sleep(1);
        if ((++sp & 255u) == 0u) { if (xb_ld(&bar[XB_TMO])) break; if (sp > XB_SPIN_CAP) { atomicAdd(&bar[XB_TMO], 1u); break; } }
    }
    nloc = mine > 0u ? mine : 1u; nx = cnt > 0u ? cnt : 1u;
}
__device__ __forceinline__ void xcd_barrier(const XcdBarrier& b) {
    asm volatile("s_waitcnt vmcnt(0)" ::: "memory");
    __syncthreads();
    if (threadIdx.x == 0) {
        unsigned* bar = b.bar;
        __builtin_amdgcn_s_waitcnt(0);
        unsigned nloc = b.st[0], nx = b.st[1];
        if (nloc == 0u) { xcd_barrier_complete(bar, b.x, nloc, nx); b.st[0] = nloc; b.st[1] = nx; }
        const unsigned old = xb_add(&bar[XB_XSUB(b.x)], 1u);
        const unsigned gen = old / nloc;
        if (old + 1u == (gen + 1u) * nloc) {
            __builtin_amdgcn_fence(__ATOMIC_RELEASE, "agent");
            asm volatile("s_waitcnt vmcnt(0)" ::: "memory");
            const unsigned og = xb_add(&bar[XB_TOP], 1u);
            const unsigned tg = og / nx;
            if (og + 1u == (tg + 1u) * nx) xb_add(&bar[XB_TOPGEN], 1u);
            else XB_SPIN(xb_ld(&bar[XB_TOPGEN]) == tg, bar);
            __builtin_amdgcn_fence(__ATOMIC_ACQUIRE, "agent");
            xb_add(&bar[XB_XGEN(b.x)], 1u);
            asm volatile("s_waitcnt vmcnt(0)" ::: "memory");
        } else {
            XB_SPIN(xb_ld(&bar[XB_XGEN(b.x)]) == gen, bar);
            __builtin_amdgcn_fence(__ATOMIC_ACQUIRE, "agent");
            asm volatile("s_waitcnt vmcnt(0)" ::: "memory");
        }
    }
    __syncthreads();
}

struct Params {
    const float *x_prompt, *x_sample, *cache_ckv, *cache_krope, *state_lru, *c, *c_ctx;
    const float *w_mod[2], *b_mod[2], *g_mix[2], *g_ffn[2];
    const float *w_in, *g_q, *w_uq, *g_kv, *w_ukv, *conv_w, *conv_b, *w_rg, *b_rg, *w_ig, *b_ig, *lam, *w_o, *w_pool, *s_pool;
    const float *peer_wq[2], *peer_keys[2], *peer_u[2], *peer_v[2];
    const float* g_final;
    float* out;
    unsigned* bar; float* mod; float* ropetab;
    bf16_t *wt_in, *wt_uq, *wt_ukv, *wt_gate, *wt_o, *wt_pool, *wt_pq[2], *keysb[2];
    u8_t *u8[2], *v8[2]; float *su[2], *sv[2];
    bf16_t *hbuf, *P, *cqn, *ckvk, *kropek, *xc, *ug, *q, *Kn, *vT, *bxb, *qp, *h3;
    float *a, *agg, *xres, *gates; int* eidx;
};

extern __shared__ __attribute__((aligned(16))) unsigned char smem[];

__device__ __forceinline__ float bf2f(bf16_t v) { return __uint_as_float(((unsigned)v) << 16); }
typedef __bf16 bf16x2_t __attribute__((ext_vector_type(2)));
__device__ __forceinline__ bf16_t f2bf(float f) { return __builtin_bit_cast(unsigned short, (__bf16)f); }
__device__ __forceinline__ unsigned pack_bf16(float a, float b) { bf16x2_t v = {(__bf16)a, (__bf16)b}; return __builtin_bit_cast(unsigned, v); }
typedef unsigned u32x2 __attribute__((ext_vector_type(2)));
#define DPP_F(v, ctrl) __int_as_float(__builtin_amdgcn_update_dpp(0, __float_as_int(v), ctrl, 0xf, 0xf, true))
__device__ __forceinline__ float wave_sum(float v) {
    v += DPP_F(v, 0xB1); v += DPP_F(v, 0x4E); v += DPP_F(v, 0x141); v += DPP_F(v, 0x128);
    u32x2 r = __builtin_amdgcn_permlane16_swap(__float_as_uint(v), __float_as_uint(v), false, false);
    v = __uint_as_float(r[0]) + __uint_as_float(r[1]);
    r = __builtin_amdgcn_permlane32_swap(__float_as_uint(v), __float_as_uint(v), false, false);
    return __uint_as_float(r[0]) + __uint_as_float(r[1]);
}
__device__ __forceinline__ float wave_max(float v) {
    v = fmaxf(v, DPP_F(v, 0xB1)); v = fmaxf(v, DPP_F(v, 0x4E)); v = fmaxf(v, DPP_F(v, 0x141)); v = fmaxf(v, DPP_F(v, 0x128));
    u32x2 r = __builtin_amdgcn_permlane16_swap(__float_as_uint(v), __float_as_uint(v), false, false);
    v = fmaxf(__uint_as_float(r[0]), __uint_as_float(r[1]));
    r = __builtin_amdgcn_permlane32_swap(__float_as_uint(v), __float_as_uint(v), false, false);
    return fmaxf(__uint_as_float(r[0]), __uint_as_float(r[1]));
}
__device__ __forceinline__ float gelu_tanh(float x) {
    const float u = 0.7978845608028654f * (x + 0.044715f * x * x * x);
    const float e = __expf(2.f * u);
    const float th = 1.f - 2.f / (e + 1.f);
    return 0.5f * x * (1.f + th);
}
__device__ __forceinline__ float sigmoidf_(float x) { return 1.f / (1.f + __expf(-x)); }
__device__ __forceinline__ float silu_(float x) { return x / (1.f + __expf(-x)); }

struct TokInfo { int smp, b, s, S, mi, keyrow; };
__device__ __forceinline__ TokInfo tokinfo(int T) {
    TokInfo t;
    if (T < T_CTX) { t.smp = 0; t.b = T >> 8; t.s = T & 255; t.S = 256; t.mi = 0; t.keyrow = T; }
    else { const int u = T - T_CTX; t.smp = 1; t.b = u >> 11; t.s = u & 2047; t.S = 2048; t.mi = 1 + t.b; t.keyrow = T_CTX + t.b * 2304 + 256 + t.s; }
    return t;
}
__device__ __forceinline__ const float* x_in_row(const Params& p, int T) { return T < T_CTX ? p.x_prompt + (size_t)T * 1024 : p.x_sample + (size_t)(T - T_CTX) * 1024; }
__device__ __forceinline__ const float* modv(const Params& p, int l, int mi, int j) { return p.mod + ((size_t)(l * 9 + mi) * 6 + j) * 1024; }

__device__ __forceinline__ void unpack8(const uint4 r, float (&f)[8]) {
    f[0] = __uint_as_float(r.x << 16); f[1] = __uint_as_float(r.x & 0xffff0000u);
    f[2] = __uint_as_float(r.y << 16); f[3] = __uint_as_float(r.y & 0xffff0000u);
    f[4] = __uint_as_float(r.z << 16); f[5] = __uint_as_float(r.z & 0xffff0000u);
    f[6] = __uint_as_float(r.w << 16); f[7] = __uint_as_float(r.w & 0xffff0000u);
}

typedef __bf16 bf16x8_t __attribute__((ext_vector_type(8)));
__device__ __forceinline__ int lds_off(int row, int chunk) { return row * 128 + ((chunk ^ ((row >> 1) & 7)) << 4); }
template <int TM, int TN, int WM, int WN>
__device__ __forceinline__ void gemm_acc(const bf16_t* __restrict__ As, int lda, const bf16_t* __restrict__ Bs, int ldb, int K, f32x16 (&acc)[TM][TN]) {
    static_assert(TM * WM == 4 && TN * WN == 4 && WM * WN == 4, "block tile is 128 x 128, 4 waves");
    const int tid = threadIdx.x, lane = tid & 63, wid = tid >> 6, wm = wid / WN, wn = wid % WN, hl = lane >> 5, cl = lane & 31;
#pragma unroll
    for (int i = 0; i < TM; ++i)
#pragma unroll
        for (int j = 0; j < TN; ++j)
#pragma unroll
            for (int r = 0; r < 16; ++r) acc[i][j][r] = 0.f;
    const int srow0 = wid * 32 + (lane >> 3), pc = lane & 7;
    const bf16_t* ga[4]; const bf16_t* gb[4];
#pragma unroll
    for (int i = 0; i < 4; ++i) {
        const int row = srow0 + 8 * i, lc = pc ^ ((row >> 1) & 7);
        ga[i] = As + (size_t)row * lda + lc * 8; gb[i] = Bs + (size_t)row * ldb + lc * 8;
    }
    unsigned char* lbase = smem + wid * 4096 + lane * 16;
    __syncthreads();
#pragma unroll
    for (int i = 0; i < 4; ++i) {
        __builtin_amdgcn_global_load_lds((const unsigned*)ga[i], (unsigned*)(lbase + i * 1024), 16, 0, 0);
        __builtin_amdgcn_global_load_lds((const unsigned*)gb[i], (unsigned*)(lbase + 16384 + i * 1024), 16, 0, 0);
    }
    asm volatile("s_waitcnt vmcnt(0)" ::: "memory");
    __syncthreads();
    const int nk = K >> 6;
    for (int kt = 0; kt < nk; ++kt) {
        const int cur = (kt & 1) * 32768, nxt = 32768 - cur;
        if (kt + 1 < nk) {
#pragma unroll
            for (int i = 0; i < 4; ++i) {
                __builtin_amdgcn_global_load_lds((const unsigned*)(ga[i] + (kt + 1) * 64), (unsigned*)(lbase + nxt + i * 1024), 16, 0, 0);
                __builtin_amdgcn_global_load_lds((const unsigned*)(gb[i] + (kt + 1) * 64), (unsigned*)(lbase + nxt + 16384 + i * 1024), 16, 0, 0);
            }
        }
#pragma unroll
        for (int ks = 0; ks < 4; ++ks) {
            bf16x8_t af[TM], bfr[TN];
#pragma unroll
            for (int i = 0; i < TM; ++i) af[i] = __builtin_bit_cast(bf16x8_t, *(const u32x4*)(smem + cur + lds_off(32 * (TM * wm + i) + cl, 2 * ks + hl)));
#pragma unroll
            for (int j = 0; j < TN; ++j) bfr[j] = __builtin_bit_cast(bf16x8_t, *(const u32x4*)(smem + cur + 16384 + lds_off(32 * (TN * wn + j) + cl, 2 * ks + hl)));
#pragma unroll
            for (int i = 0; i < TM; ++i)
#pragma unroll
                for (int j = 0; j < TN; ++j) acc[i][j] = __builtin_amdgcn_mfma_f32_32x32x16_bf16(af[i], bfr[j], acc[i][j], 0, 0, 0);
        }
        asm volatile("s_waitcnt vmcnt(0)" ::: "memory");
        __syncthreads();
    }
}
#define ACC_ROW(TMv, wm, i, r, hl) (32 * ((TMv) * (wm) + (i)) + ((r) & 3) + 8 * ((r) >> 2) + 4 * (hl))
#define ACC_COL(TNv, wn, j, cl)    (32 * ((TNv) * (wn) + (j)) + (cl))

#define N_ADA 384
#define NW_IN   (1792 * 1024)
#define NW_UQ   (768 * 384)
#define NW_UKV  (1024 * 256)
#define NW_GATE (4 * 512 * 128)
#define NW_O    (1024 * 1024)
#define NW_POOL (4 * 256 * 256)
#define NW_PQ   (2048 * 1024)
#define NW_KEYS (16 * 128 * 128)
#define NW_CKV  (8 * 256 * 256)
#define NW_CKR  (8 * 256 * 64)
#define NW_ROPE 3072
#define NT_IN 448
#define NT_UQ 72
#define NT_UKV 64
#define NT_O 256
#define NT_POOL 64
#define NT_PQ 512
#define N_TR (NT_IN + NT_UQ + NT_UKV + NT_O + NT_POOL + 2 * NT_PQ)
#define NE_TOTAL (NW_GATE + 2 * NW_KEYS + NW_CKV + NW_CKR + NW_ROPE)
#define N_CONV_ITEMS ((NE_TOTAL + 4095) / 4096)
#define N_FP8_ITEMS (65536 / 4)

__device__ __forceinline__ void conv_elem(const Params& p, int e) {
    if (e < NW_GATE) {
        const int c = e & 127, cg = (e >> 7) & 511, nb = e >> 16;
        const int dir = cg >> 8, dg = (cg >> 6) & 3, ri = (cg >> 5) & 1, d = dg * 32 + (cg & 31);
        const float* src = ri ? p.w_ig : p.w_rg;
        p.wt_gate[e] = f2bf(src[(((size_t)dir * 4 + nb) * 128 + c) * 128 + d]); return; } e -= NW_GATE;
#pragma unroll
    for (int l = 0; l < 2; ++l) { if (e < NW_KEYS) { p.keysb[l][e] = f2bf(p.peer_keys[l][e]); return; } e -= NW_KEYS; }
    if (e < NW_CKV) { const int col = e & 255, j = (e >> 8) & 255, b = e >> 16; p.ckvk[(size_t)(T_CTX + b * 2304 + j) * 256 + col] = f2bf(p.cache_ckv[e]); return; } e -= NW_CKV;
    if (e < NW_CKR) { const int col = e & 63, j = (e >> 6) & 255, b = e >> 14; p.kropek[(size_t)(T_CTX + b * 2304 + j) * 64 + col] = f2bf(p.cache_krope[e]); return; } e -= NW_CKR;
    if (e < NW_ROPE) {
        int idx = e, isrow = e < 1024; if (!isrow) idx -= 1024;
        const int half = isrow ? 512 : 1024; const int sn = idx >= half; if (sn) idx -= half;
        const int pos = idx >> 4, fi = idx & 15;
        const float invf = exp2f(-(float)fi * (13.287712379549449f / 16.f));
        const float ang = (float)pos * invf;
        p.ropetab[e] = sn ? sinf(ang) : cosf(ang); return; }
}
__device__ __forceinline__ void tr_tile(const float* __restrict__ src, int ldsrc, int nvalid, bf16_t* __restrict__ dst, int lddst, int k0, int n0) {
    float* tile = (float*)smem;
    const int tid = threadIdx.x;
    __syncthreads();
#pragma unroll
    for (int i = 0; i < 4; ++i) {
        const int k = (tid >> 4) + 16 * i, n = (tid & 15) * 4;
        float4 v = make_float4(0.f, 0.f, 0.f, 0.f);
        if (n0 + n < nvalid) v = *(const float4*)(src + (size_t)(k0 + k) * ldsrc + n0 + n);
        tile[k * 65 + n] = v.x; tile[k * 65 + n + 1] = v.y; tile[k * 65 + n + 2] = v.z; tile[k * 65 + n + 3] = v.w;
    }
    __syncthreads();
    const int n = tid >> 2, kq = (tid & 3) * 16;
    unsigned w[8];
#pragma unroll
    for (int j = 0; j < 8; ++j) w[j] = pack_bf16(tile[(kq + 2 * j) * 65 + n], tile[(kq + 2 * j + 1) * 65 + n]);
    uint4* d = (uint4*)(dst + (size_t)(n0 + n) * lddst + k0 + kq);
    d[0] = make_uint4(w[0], w[1], w[2], w[3]); d[1] = make_uint4(w[4], w[5], w[6], w[7]);
}

__device__ void st_prologue(const Params& p) {
    const int tid = threadIdx.x, lane = tid & 63, wid = tid >> 6;
    const int n_items = N_ADA + N_TR + N_CONV_ITEMS + N_FP8_ITEMS;
    for (int item = blockIdx.x; item < n_items; item += gridDim.x) {
        if (item < N_ADA) {
            float* svec = (float*)smem;
            float* red = (float*)(smem + 9 * 4096);
            __syncthreads();
            for (int i = tid; i < 9 * 1024; i += 256) { const int bc = i >> 10, k = i & 1023; const float cv = bc == 0 ? p.c_ctx[k] : p.c[(size_t)(bc - 1) * 1024 + k]; svec[i] = silu_(cv); }
            __syncthreads();
            const int cidx = item * 32 + (lane & 7) * 4, l = cidx / 6144, col = cidx % 6144, k0 = (wid * 8 + (lane >> 3)) * 32;
            const float* w = p.w_mod[l] + (size_t)k0 * 6144 + col;
            float acc[9][4];
#pragma unroll
            for (int b = 0; b < 9; ++b) { acc[b][0] = 0.f; acc[b][1] = 0.f; acc[b][2] = 0.f; acc[b][3] = 0.f; }
#pragma unroll 8
            for (int k = 0; k < 32; ++k) {
                const float4 wv = *(const float4*)(w + (size_t)k * 6144);
#pragma unroll
                for (int b = 0; b < 9; ++b) { const float sv = svec[b * 1024 + k0 + k]; acc[b][0] += wv.x * sv; acc[b][1] += wv.y * sv; acc[b][2] += wv.z * sv; acc[b][3] += wv.w * sv; }
            }
#pragma unroll
            for (int b = 0; b < 9; ++b)
#pragma unroll
                for (int j = 0; j < 4; ++j) { float v = acc[b][j]; v += __shfl_xor(v, 8); v += __shfl_xor(v, 16); v += __shfl_xor(v, 32); acc[b][j] = v; }
            if (lane < 8) {
#pragma unroll
                for (int b = 0; b < 9; ++b)
#pragma unroll
                    for (int j = 0; j < 4; ++j) red[(wid * 9 + b) * 32 + lane * 4 + j] = acc[b][j];
            }
            __syncthreads();
            for (int i = tid; i < 9 * 32; i += 256) {
                const int b = i >> 5, c = i & 31;
                const int ci = item * 32 + c, ll = ci / 6144, cc = ci % 6144;
                const float v = ((red[(0 * 9 + b) * 32 + c] + red[(1 * 9 + b) * 32 + c]) + (red[(2 * 9 + b) * 32 + c] + red[(3 * 9 + b) * 32 + c])) + p.b_mod[ll][cc];
                p.mod[(size_t)(ll * 9 + b) * 6144 + cc] = v;
            }
        } else if (item < N_ADA + N_TR) {
            int t = item - N_ADA;
            if (t < NT_IN) { tr_tile(p.w_in, 1728, 1728, p.wt_in, 1024, (t % 16) * 64, (t / 16) * 64); continue; } t -= NT_IN;
            if (t < NT_UQ) { tr_tile(p.w_uq, 768, 768, p.wt_uq, 384, (t % 6) * 64, (t / 6) * 64); continue; } t -= NT_UQ;
            if (t < NT_UKV) { tr_tile(p.w_ukv, 1024, 1024, p.wt_ukv, 256, (t % 4) * 64, (t / 4) * 64); continue; } t -= NT_UKV;
            if (t < NT_O) { tr_tile(p.w_o, 1024, 1024, p.wt_o, 1024, (t % 16) * 64, (t / 16) * 64); continue; } t -= NT_O;
            if (t < NT_POOL) { const int g = t >> 4, tt = t & 15; tr_tile(p.w_pool + (size_t)g * 65536, 256, 256, p.wt_pool + (size_t)g * 65536, 256, (tt & 3) * 64, (tt >> 2) * 64); continue; } t -= NT_POOL;
            if (t < NT_PQ) { tr_tile(p.peer_wq[0], 2048, 2048, p.wt_pq[0], 1024, (t % 16) * 64, (t / 16) * 64); continue; } t -= NT_PQ;
            tr_tile(p.peer_wq[1], 2048, 2048, p.wt_pq[1], 1024, (t % 16) * 64, (t / 16) * 64);
        } else if (item < N_ADA + N_TR + N_CONV_ITEMS) {
            const int base = (item - N_ADA - N_TR) * 4096;
            for (int i = tid; i < 4096; i += 256) { const int e = base + i; if (e < NE_TOTAL) conv_elem(p, e); }
        } else {
            const int row = (item - N_ADA - N_TR - N_CONV_ITEMS) * 4 + wid;
            const int tb = row >> 14, er = row & 16383, l = tb >> 1;
            const float* src = ((tb & 1) ? p.peer_v[l] : p.peer_u[l]) + (size_t)er * 1024 + lane * 16;
            u8_t* dst = ((tb & 1) ? p.v8[l] : p.u8[l]) + (size_t)er * 512 + lane * 8;
            float* sc = ((tb & 1) ? p.sv[l] : p.su[l]) + er;
            float v[16];
#pragma unroll
            for (int j = 0; j < 4; ++j) { const f32x4v f = __builtin_nontemporal_load((const f32x4v*)(src + 4 * j)); v[4 * j] = f[0]; v[4 * j + 1] = f[1]; v[4 * j + 2] = f[2]; v[4 * j + 3] = f[3]; }
            float am = 0.f;
#pragma unroll
            for (int j = 0; j < 16; ++j) am = fmaxf(am, fabsf(v[j]));
            am = wave_max(am);
            const float scale = am > 0.f ? am * (1.f / 6.f) : 1.f, inv = am > 0.f ? 6.f / am : 1.f;
            unsigned w[2];
#pragma unroll
            for (int j = 0; j < 2; ++j) {
                unsigned pk = 0u;
                pk = __builtin_amdgcn_cvt_scalef32_pk_fp4_f32(pk, v[8 * j] * inv, v[8 * j + 1] * inv, 1.0f, 0);
                pk = __builtin_amdgcn_cvt_scalef32_pk_fp4_f32(pk, v[8 * j + 2] * inv, v[8 * j + 3] * inv, 1.0f, 1);
                pk = __builtin_amdgcn_cvt_scalef32_pk_fp4_f32(pk, v[8 * j + 4] * inv, v[8 * j + 5] * inv, 1.0f, 2);
                pk = __builtin_amdgcn_cvt_scalef32_pk_fp4_f32(pk, v[8 * j + 6] * inv, v[8 * j + 7] * inv, 1.0f, 3);
                w[j] = pk;
            }
            *(uint2*)dst = make_uint2(w[0], w[1]);
            if (lane == 0) *sc = scale;
        }
    }
}

template <int SRC>
__device__ void st_norm(const Params& p, int l, int which, const float* g, bf16_t* dst) {
    const int lane = threadIdx.x & 63, wid = threadIdx.x >> 6;
    for (int T = blockIdx.x * 4 + wid; T < T_TOK; T += gridDim.x * 4) {
        const float* src = (SRC == 0 ? x_in_row(p, T) : p.xres + (size_t)T * 1024) + lane * 16;
        const TokInfo ti = tokinfo(T);
        float v[16]; float ss = 0.f;
#pragma unroll
        for (int j = 0; j < 4; ++j) { const float4 f = *(const float4*)(src + 4 * j); v[4 * j] = f.x; v[4 * j + 1] = f.y; v[4 * j + 2] = f.z; v[4 * j + 3] = f.w; }
#pragma unroll
        for (int j = 0; j < 16; ++j) ss += v[j] * v[j];
        ss = wave_sum(ss);
        const float rstd = rsqrtf(ss * (1.f / 1024.f) + 1e-6f);
        const float* sh = modv(p, l, ti.mi, which ? 3 : 0) + lane * 16; const float* sc = modv(p, l, ti.mi, which ? 4 : 1) + lane * 16; const float* gg = g + lane * 16;
        unsigned w[8];
#pragma unroll
        for (int j = 0; j < 8; ++j) {
            const float a0 = v[2 * j] * rstd * gg[2 * j] * (1.f + sc[2 * j]) + sh[2 * j];
            const float a1 = v[2 * j + 1] * rstd * gg[2 * j + 1] * (1.f + sc[2 * j + 1]) + sh[2 * j + 1];
            w[j] = (unsigned)f2bf(a0) | ((unsigned)f2bf(a1) << 16);
        }
        uint4* d = (uint4*)(dst + (size_t)T * 1024 + lane * 16);
        d[0] = make_uint4(w[0], w[1], w[2], w[3]); d[1] = make_uint4(w[4], w[5], w[6], w[7]);
    }
}

__device__ void st_gemm1(const Params& p) {
    const int lane = threadIdx.x & 63, wid = threadIdx.x >> 6, wm = wid >> 1, wn = wid & 1, hl = lane >> 5, cl = lane & 31;
    for (int item = blockIdx.x; item < 160 * 14; item += gridDim.x) {
        const int tn = item % 14, tm = item / 14;
        f32x16 acc[2][2];
        gemm_acc<2, 2, 2, 2>(p.hbuf + (size_t)tm * 128 * 1024, 1024, p.wt_in + (size_t)tn * 128 * 1024, 1024, 1024, acc);
#pragma unroll
        for (int i = 0; i < 2; ++i)
#pragma unroll
            for (int j = 0; j < 2; ++j)
#pragma unroll
                for (int r = 0; r < 16; ++r) {
                    const int row = tm * 128 + ACC_ROW(2, wm, i, r, hl), col = tn * 128 + ACC_COL(2, wn, j, cl);
                    p.P[(size_t)row * 1792 + col] = f2bf(acc[i][j][r]);
                }
    }
}

__device__ void st_postproj(const Params& p) {
    const int lane = threadIdx.x & 63, wid = threadIdx.x >> 6;
    float* o_ckv = p.out + 20971520, *o_kr = p.out + 22020096;
    for (int T = blockIdx.x * 4 + wid; T < T_TOK; T += gridDim.x * 4) {
        const TokInfo ti = tokinfo(T);
        const bf16_t* Pr = p.P + (size_t)T * 1792;
        float cq[8], ck[8];
#pragma unroll
        for (int j = 0; j < 8; ++j) { cq[j] = 0.f; ck[j] = 0.f; }
        if (lane < 48) unpack8(*(const uint4*)(Pr + lane * 8), cq);
        if (lane < 32) unpack8(*(const uint4*)(Pr + 384 + lane * 8), ck);
        float s1 = 0.f, s2 = 0.f;
#pragma unroll
        for (int j = 0; j < 8; ++j) { s1 += cq[j] * cq[j]; s2 += ck[j] * ck[j]; }
        s1 = wave_sum(s1); s2 = wave_sum(s2);
        const float r1 = rsqrtf(s1 * (1.f / 384.f) + 1e-6f), r2 = rsqrtf(s2 * (1.f / 256.f) + 1e-6f);
        if (lane < 48) {
            const float4 ga = *(const float4*)(p.g_q + lane * 8), gb = *(const float4*)(p.g_q + lane * 8 + 4);
            uint4 o; o.x = pack_bf16(cq[0] * r1 * ga.x, cq[1] * r1 * ga.y); o.y = pack_bf16(cq[2] * r1 * ga.z, cq[3] * r1 * ga.w);
            o.z = pack_bf16(cq[4] * r1 * gb.x, cq[5] * r1 * gb.y); o.w = pack_bf16(cq[6] * r1 * gb.z, cq[7] * r1 * gb.w);
            *(uint4*)(p.cqn + (size_t)T * 384 + lane * 8) = o;
        }
        if (lane < 32) {
            const float4 ga = *(const float4*)(p.g_kv + lane * 8), gb = *(const float4*)(p.g_kv + lane * 8 + 4);
            float y[8] = {ck[0] * r2 * ga.x, ck[1] * r2 * ga.y, ck[2] * r2 * ga.z, ck[3] * r2 * ga.w, ck[4] * r2 * gb.x, ck[5] * r2 * gb.y, ck[6] * r2 * gb.z, ck[7] * r2 * gb.w};
            uint4 o; o.x = pack_bf16(y[0], y[1]); o.y = pack_bf16(y[2], y[3]); o.z = pack_bf16(y[4], y[5]); o.w = pack_bf16(y[6], y[7]);
            *(uint4*)(p.ckvk + (size_t)ti.keyrow * 256 + lane * 8) = o;
            if (!ti.smp) { float4* d = (float4*)(o_ckv + (size_t)T * 256 + lane * 8); d[0] = make_float4(y[0], y[1], y[2], y[3]); d[1] = make_float4(y[4], y[5], y[6], y[7]); }
        }
        if (lane < 8) {
            float v[8]; unpack8(*(const uint4*)(Pr + 640 + lane * 8), v);
            float y[8];
            if (ti.smp) {
                const int gr = ti.s >> 6, gc = ti.s & 63;
#pragma unroll
                for (int i = 0; i < 4; ++i) {
                    const int pr = lane * 4 + i;
                    const float cs = pr < 16 ? p.ropetab[gr * 16 + pr] : p.ropetab[1024 + gc * 16 + (pr - 16)];
                    const float sn = pr < 16 ? p.ropetab[512 + gr * 16 + pr] : p.ropetab[2048 + gc * 16 + (pr - 16)];
                    y[2 * i] = v[2 * i] * cs - v[2 * i + 1] * sn; y[2 * i + 1] = v[2 * i] * sn + v[2 * i + 1] * cs;
                }
            } else {
#pragma unroll
                for (int i = 0; i < 8; ++i) y[i] = v[i];
                float4* d = (float4*)(o_kr + (size_t)T * 64 + lane * 8); d[0] = make_float4(v[0], v[1], v[2], v[3]); d[1] = make_float4(v[4], v[5], v[6], v[7]);
            }
            uint4 o; o.x = pack_bf16(y[0], y[1]); o.y = pack_bf16(y[2], y[3]); o.z = pack_bf16(y[4], y[5]); o.w = pack_bf16(y[6], y[7]);
            *(uint4*)(p.kropek + (size_t)ti.keyrow * 64 + lane * 8) = o;
        }
        {
            const int ch = lane * 8;
            float y[8];
            { const float4 a = *(const float4*)(p.conv_b + ch), b = *(const float4*)(p.conv_b + ch + 4); y[0] = a.x; y[1] = a.y; y[2] = a.z; y[3] = a.w; y[4] = b.x; y[5] = b.y; y[6] = b.z; y[7] = b.w; }
#pragma unroll
            for (int k = 0; k < 4; ++k) {
                const int s2i = ti.s + k - 2;
                if (s2i >= 0 && s2i < ti.S) {
                    float u[8]; unpack8(*(const uint4*)(p.P + (size_t)(T + k - 2) * 1792 + 704 + ch), u);
                    const float4 a = *(const float4*)(p.conv_w + k * 512 + ch), b = *(const float4*)(p.conv_w + k * 512 + ch + 4);
                    y[0] += a.x * u[0]; y[1] += a.y * u[1]; y[2] += a.z * u[2]; y[3] += a.w * u[3]; y[4] += b.x * u[4]; y[5] += b.y * u[5]; y[6] += b.z * u[6]; y[7] += b.w * u[7];
                }
            }
            uint4 o; o.x = pack_bf16(y[0], y[1]); o.y = pack_bf16(y[2], y[3]); o.z = pack_bf16(y[4], y[5]); o.w = pack_bf16(y[6], y[7]);
            *(uint4*)(p.xc + (size_t)T * 512 + ch) = o;
            *(uint4*)(p.ug + (size_t)T * 512 + ch) = *(const uint4*)(Pr + 1216 + ch);
        }
    }
}

#define N_G2 (160 * 6)
#define N_G3 (176 * 8)
#define N_G4 (160 * 16)
__device__ void st_gemm234(const Params& p) {
    const int lane = threadIdx.x & 63, wid = threadIdx.x >> 6, wm = wid >> 1, wn = wid & 1, hl = lane >> 5, cl = lane & 31;
    for (int item = blockIdx.x; item < N_G2 + N_G3 + N_G4; item += gridDim.x) {
        f32x16 acc[2][2];
        if (item < N_G2) {
            const int tn = item % 6, tm = item / 6;
            gemm_acc<2, 2, 2, 2>(p.wt_uq + (size_t)tn * 128 * 384, 384, p.cqn + (size_t)tm * 128 * 384, 384, 384, acc);
            const float qs = 0.07216878364870322f * 1.4426950408889634f;
#pragma unroll
            for (int j = 0; j < 2; ++j) {
                const int T = tm * 128 + ACC_COL(2, wn, j, cl);
                const TokInfo ti = tokinfo(T);
                const int gr = ti.s >> 6, gc = ti.s & 63;
#pragma unroll
                for (int i = 0; i < 2; ++i)
#pragma unroll
                    for (int r = 0; r < 16; r += 2) {
                        const int n = tn * 128 + ACC_ROW(2, wm, i, r, hl);
                        float v0 = acc[i][j][r], v1 = acc[i][j][r + 1];
                        const int d = n % 192;
                        if (ti.smp && d >= 128) {
                            const int pr = (d - 128) >> 1;
                            const float cs = pr < 16 ? p.ropetab[gr * 16 + pr] : p.ropetab[1024 + gc * 16 + (pr - 16)];
                            const float sn = pr < 16 ? p.ropetab[512 + gr * 16 + pr] : p.ropetab[2048 + gc * 16 + (pr - 16)];
                            const float t0 = v0 * cs - v1 * sn, t1 = v0 * sn + v1 * cs; v0 = t0; v1 = t1;
                        }
                        *(unsigned*)(p.q + (size_t)T * 768 + n) = (unsigned)f2bf(v0 * qs) | ((unsigned)f2bf(v1 * qs) << 16);
                    }
            }
        } else if (item < N_G2 + N_G3) {
            const int it = item - N_G2, tn = it & 7, tm = it >> 3, h = tn >> 1;
            if ((tn & 1) == 0) {
                gemm_acc<2, 2, 2, 2>(p.ckvk + (size_t)tm * 128 * 256, 256, p.wt_ukv + (size_t)tn * 128 * 256, 256, 256, acc);
#pragma unroll
                for (int i = 0; i < 2; ++i)
#pragma unroll
                    for (int j = 0; j < 2; ++j)
#pragma unroll
                        for (int r = 0; r < 16; ++r) {
                            const int row = tm * 128 + ACC_ROW(2, wm, i, r, hl), dcol = ACC_COL(2, wn, j, cl);
                            p.Kn[(size_t)row * 512 + h * 128 + dcol] = f2bf(acc[i][j][r]);
                        }
            } else {
                gemm_acc<2, 2, 2, 2>(p.wt_ukv + (size_t)tn * 128 * 256, 256, p.ckvk + (size_t)tm * 128 * 256, 256, 256, acc);
#pragma unroll
                for (int j = 0; j < 2; ++j) {
                    const int R = tm * 128 + ACC_COL(2, wn, j, cl);
                    size_t base; int Sk, pos;
                    if (R < T_CTX) { Sk = 256; pos = R & 255; base = (size_t)((R >> 8) * 4 + h) * 128 * 256; }
                    else { const int u = R - T_CTX; Sk = 2304; pos = u % 2304; base = (size_t)T_CTX * 512 + (size_t)((u / 2304) * 4 + h) * 128 * 2304; }
#pragma unroll
                    for (int i = 0; i < 2; ++i)
#pragma unroll
                        for (int r = 0; r < 16; ++r) {
                            const int dv = ACC_ROW(2, wm, i, r, hl);
                            p.vT[base + (size_t)dv * Sk + pos] = f2bf(acc[i][j][r]);
                        }
                }
            }
        } else {
            const int it = item - N_G2 - N_G3, tj = it & 3, nb = (it >> 2) & 3, tm = it >> 4;
            gemm_acc<2, 2, 2, 2>(p.xc + (size_t)tm * 128 * 512 + nb * 128, 512, p.wt_gate + ((size_t)nb * 512 + tj * 128) * 128, 128, 128, acc);
            const int dir = tj >> 1, dg = (tj & 1) * 2 + wn, ch = nb * 128 + dg * 32 + cl;
            const float brg = p.b_rg[dir * 512 + ch], big = p.b_ig[dir * 512 + ch];
            const float nl = -p.lam[dir * 512 + ch];
            const float sp = fmaxf(nl, 0.f) + log1pf(__expf(-fabsf(nl)));
#pragma unroll
            for (int i = 0; i < 2; ++i)
#pragma unroll
                for (int r = 0; r < 16; ++r) {
                    const int T = tm * 128 + ACC_ROW(2, wm, i, r, hl);
                    const float rg = sigmoidf_(acc[i][0][r] + brg), ig = sigmoidf_(acc[i][1][r] + big);
                    const float la = -8.f * rg * sp;
                    const float av = __expf(la);
                    const float mult = sqrtf(fmaxf(-expm1f(2.f * la), 0.f));
                    const float xv = bf2f(p.xc[(size_t)T * 512 + ch]);
                    p.a[((size_t)T * 2 + dir) * 512 + ch] = av;
                    p.bxb[((size_t)T * 2 + dir) * 512 + ch] = f2bf(mult * ig * xv);
                }
        }
    }
}

#define N_ATT (128 + 512)
#define SCH 64
#define NCHK (T_TOK / SCH)
#define N_S1 (NCHK * 4)
__device__ void scan_s1_item(const Params& p, int it) {
    const int chunk = it >> 2, dc = (it & 3) * 256 + threadIdx.x, dir = dc >> 9, ch = dc & 511;
    const int T0 = chunk * SCH;
    float A = 1.f, B = 0.f;
#pragma unroll 8
    for (int i = 0; i < SCH; ++i) {
        const int T = dir ? (T0 + SCH - 1 - i) : (T0 + i);
        const float av = p.a[((size_t)T * 2 + dir) * 512 + ch], bv = bf2f(p.bxb[((size_t)T * 2 + dir) * 512 + ch]);
        A *= av; B = B * av + bv;
    }
    *(float2*)(p.agg + (((size_t)chunk * 2 + dir) * 512 + ch) * 2) = make_float2(A, B);
}
__device__ void attn_item_simple(const Params& p, int it) {
    int seq, h, qb, Sk, T0, R0; size_t vbase;
    if (it < 128) { seq = it >> 3; h = (it >> 1) & 3; qb = it & 1; Sk = 256; T0 = seq * 256 + qb * 128; R0 = seq * 256; vbase = (size_t)(seq * 4 + h) * 128 * 256; }
    else { const int u = it - 128; seq = u >> 6; h = (u >> 4) & 3; qb = u & 15; Sk = 2304; T0 = T_CTX + seq * 2048 + qb * 128; R0 = T_CTX + seq * 2304; vbase = (size_t)T_CTX * 512 + (size_t)(seq * 4 + h) * 128 * 2304; }
    const int tid = threadIdx.x, qi = tid >> 1, half = tid & 1;
    const int T = T0 + qi;
    __syncthreads();
    {
        const uint4* qg = (const uint4*)(p.q + (size_t)T0 * 768 + h * 192);
        for (int i = tid; i < 128 * 24; i += 256) { const int r = i / 24, c = i % 24; ((uint4*)smem)[i] = qg[(size_t)r * 96 + c]; }
    }
    __syncthreads();
    const uint4* qv4 = (const uint4*)smem + qi * 24;
    float o[64];
#pragma unroll
    for (int j = 0; j < 64; ++j) o[j] = 0.f;
    float m = -1e30f, l = 0.f;
    for (int key = 0; key < Sk; ++key) {
        const uint4* k4 = (const uint4*)(p.Kn + (size_t)(R0 + key) * 512 + h * 128);
        const uint4* r4 = (const uint4*)(p.kropek + (size_t)(R0 + key) * 64);
        float s = 0.f;
#pragma unroll 4
        for (int j = 0; j < 24; ++j) {
            const uint4 kk = j < 16 ? k4[j] : r4[j - 16];
            const uint4 qq = qv4[j];
            const unsigned kw[4] = {kk.x, kk.y, kk.z, kk.w}, qw[4] = {qq.x, qq.y, qq.z, qq.w};
#pragma unroll
            for (int e = 0; e < 4; ++e) {
                const unsigned a = qw[e], b = kw[e];
                s += __uint_as_float(a << 16) * __uint_as_float(b << 16) + __uint_as_float(a & 0xffff0000u) * __uint_as_float(b & 0xffff0000u);
            }
        }
        const float mn = fmaxf(m, s), alpha = exp2f(m - mn), pe = exp2f(s - mn);
        l = l * alpha + pe; m = mn;
        const bf16_t* vp = p.vT + vbase + (size_t)(half * 64) * Sk + key;
#pragma unroll
        for (int j = 0; j < 64; ++j) o[j] = o[j] * alpha + pe * bf2f(vp[(size_t)j * Sk]);
    }
    const float inv = 1.f / l;
    bf16_t* dst = p.hbuf + (size_t)T * 1024 + h * 128 + half * 64;
#pragma unroll
    for (int j = 0; j < 64; j += 2) *(unsigned*)(dst + j) = (unsigned)f2bf(o[j] * inv) | ((unsigned)f2bf(o[j + 1] * inv) << 16);
}

__device__ __forceinline__ int perm23(int r) { return (r & 0x13) | ((r & 4) << 1) | ((r & 8) >> 1); }
__device__ void attn_item_mfma(const Params& p, int it) {
    int seq, h, qb, Sk, T0, R0; size_t vbase;
    if (it < 128) { seq = it >> 3; h = (it >> 1) & 3; qb = it & 1; Sk = 256; T0 = seq * 256 + qb * 128; R0 = seq * 256; vbase = (size_t)(seq * 4 + h) * 128 * 256; }
    else { const int u = it - 128; seq = u >> 6; h = (u >> 4) & 3; qb = u & 15; Sk = 2304; T0 = T_CTX + seq * 2048 + qb * 128; R0 = T_CTX + seq * 2304; vbase = (size_t)T_CTX * 512 + (size_t)(seq * 4 + h) * 128 * 2304; }
    const int tid = threadIdx.x, lane = tid & 63, wid = tid >> 6, hl = lane >> 5, cl = lane & 31;
    bf16x8_t qf[12];
    {
        const bf16_t* qrow = p.q + (size_t)(T0 + 32 * wid + cl) * 768 + h * 192 + 8 * hl;
#pragma unroll
        for (int ks = 0; ks < 12; ++ks) qf[ks] = __builtin_bit_cast(bf16x8_t, *(const u32x4*)(qrow + 16 * ks));
    }
    f32x16 oacc[4];
#pragma unroll
    for (int d = 0; d < 4; ++d)
#pragma unroll
        for (int r = 0; r < 16; ++r) oacc[d][r] = 0.f;
    float m = -1e30f, lsum = 0.f;
    const bf16_t* gk = p.Kn + (size_t)(R0 + (tid >> 4)) * 512 + h * 128 + (tid & 15) * 8;
    const bf16_t* gr = p.kropek + (size_t)(R0 + (tid >> 3)) * 64 + (tid & 7) * 8;
    const bf16_t* gv = p.vT + vbase + (size_t)(tid >> 3) * Sk + (tid & 7) * 8;
    const int lk = ((tid & 15) >> 3) * 8192 + lds_off(tid >> 4, tid & 7);
    u32x4 rk[4], rr[2], rv[4];
    const int nt = Sk >> 6;
#pragma unroll
    for (int i = 0; i < 4; ++i) rk[i] = *(const u32x4*)(gk + (size_t)(16 * i) * 512);
#pragma unroll
    for (int i = 0; i < 2; ++i) rr[i] = *(const u32x4*)(gr + (size_t)(32 * i) * 64);
#pragma unroll
    for (int i = 0; i < 4; ++i) rv[i] = *(const u32x4*)(gv + (size_t)(32 * i) * Sk);
    (void)lk;
    __syncthreads();
    for (int t = 0; t < nt; ++t) {
#pragma unroll
        for (int i = 0; i < 4; ++i) *(u32x4*)(smem + ((tid & 15) >> 3) * 8192 + lds_off((tid >> 4) + 16 * i, tid & 7)) = rk[i];
#pragma unroll
        for (int i = 0; i < 2; ++i) *(u32x4*)(smem + 16384 + lds_off((tid >> 3) + 32 * i, tid & 7)) = rr[i];
#pragma unroll
        for (int i = 0; i < 4; ++i) *(u32x4*)(smem + 24576 + lds_off((tid >> 3) + 32 * i, tid & 7)) = rv[i];
        __syncthreads();
        if (t + 1 < nt) {
            const size_t ko = (size_t)(t + 1) * 64;
#pragma unroll
            for (int i = 0; i < 4; ++i) rk[i] = *(const u32x4*)(gk + (ko + 16 * i) * 512);
#pragma unroll
            for (int i = 0; i < 2; ++i) rr[i] = *(const u32x4*)(gr + (ko + 32 * i) * 64);
#pragma unroll
            for (int i = 0; i < 4; ++i) rv[i] = *(const u32x4*)(gv + (size_t)(32 * i) * Sk + ko);
        }
        f32x16 sacc[2];
#pragma unroll
        for (int kb = 0; kb < 2; ++kb) {
#pragma unroll
            for (int r = 0; r < 16; ++r) sacc[kb][r] = 0.f;
            const int krow = 32 * kb + perm23(cl);
#pragma unroll
            for (int ks = 0; ks < 12; ++ks) {
                const bf16x8_t kf = __builtin_bit_cast(bf16x8_t, *(const u32x4*)(smem + (ks >> 2) * 8192 + lds_off(krow, 2 * (ks & 3) + hl)));
                sacc[kb] = __builtin_amdgcn_mfma_f32_32x32x16_bf16(kf, qf[ks], sacc[kb], 0, 0, 0);
            }
        }
        float mx = sacc[0][0];
#pragma unroll
        for (int r = 1; r < 16; ++r) mx = fmaxf(mx, sacc[0][r]);
#pragma unroll
        for (int r = 0; r < 16; ++r) mx = fmaxf(mx, sacc[1][r]);
        mx = fmaxf(mx, __shfl_xor(mx, 32));
        const float mn = fmaxf(m, mx), alpha = __builtin_amdgcn_exp2f(m - mn);
        m = mn;
        float ps = 0.f;
        bf16x8_t pf[2][2];
#pragma unroll
        for (int kb = 0; kb < 2; ++kb)
#pragma unroll
            for (int s2 = 0; s2 < 2; ++s2) {
                float e[8];
#pragma unroll
                for (int j = 0; j < 8; ++j) { e[j] = __builtin_amdgcn_exp2f(sacc[kb][8 * s2 + j] - mn); ps += e[j]; }
                u32x4 w; w.x = pack_bf16(e[0], e[1]); w.y = pack_bf16(e[2], e[3]); w.z = pack_bf16(e[4], e[5]); w.w = pack_bf16(e[6], e[7]);
                pf[kb][s2] = __builtin_bit_cast(bf16x8_t, w);
            }
        lsum = lsum * alpha + ps;
#pragma unroll
        for (int d = 0; d < 4; ++d)
#pragma unroll
            for (int r = 0; r < 16; ++r) oacc[d][r] *= alpha;
#pragma unroll
        for (int d = 0; d < 4; ++d)
#pragma unroll
            for (int kb = 0; kb < 2; ++kb)
#pragma unroll
                for (int s2 = 0; s2 < 2; ++s2) {
                    const bf16x8_t vf = __builtin_bit_cast(bf16x8_t, *(const u32x4*)(smem + 24576 + lds_off(32 * d + cl, 4 * kb + 2 * s2 + hl)));
                    oacc[d] = __builtin_amdgcn_mfma_f32_32x32x16_bf16(vf, pf[kb][s2], oacc[d], 0, 0, 0);
                }
        __syncthreads();
    }
    lsum += __shfl_xor(lsum, 32);
    const float inv = 1.f / lsum;
    bf16_t* dst = p.hbuf + (size_t)(T0 + 32 * wid + cl) * 1024 + h * 128 + 4 * hl;
#pragma unroll
    for (int d = 0; d < 4; ++d)
#pragma unroll
        for (int g = 0; g < 4; ++g) {
            uint2 w; w.x = pack_bf16(oacc[d][4 * g] * inv, oacc[d][4 * g + 1] * inv); w.y = pack_bf16(oacc[d][4 * g + 2] * inv, oacc[d][4 * g + 3] * inv);
            *(uint2*)(dst + 32 * d + 8 * g) = w;
        }
}
__device__ void st_attn_s1(const Params& p) {
    for (int item = blockIdx.x; item < N_ATT + N_S1; item += gridDim.x) {
        if (item < N_ATT) {
#ifdef ATTN_SIMPLE
            attn_item_simple(p, N_ATT - 1 - item);
#else
            attn_item_mfma(p, N_ATT - 1 - item);
#endif
        }
        else scan_s1_item(p, item - N_ATT);
    }
}

__device__ void st_scan3(const Params& p) {
    const int tid = threadIdx.x;
    float* hf = (float*)smem;
    float* hb = hf + SCH * 128;
    float* o_lru = p.out + 22282240;
    for (int item = blockIdx.x; item < NCHK * 4; item += gridDim.x) {
        const int chunk = item >> 2, cgp = item & 3, T0 = chunk * SCH;
        const TokInfo ti = tokinfo(T0);
        const int nch = ti.S / SCH, cpos = ti.s / SCH, c0 = chunk - cpos;
        const int dir = tid >> 7, ch = cgp * 128 + (tid & 127);
        float hcur = ti.smp ? p.state_lru[((size_t)ti.b * 2 + dir) * 512 + ch] : 0.f;
        if (dir == 0) { for (int cc = 0; cc < cpos; ++cc) { const float2 ab = *(const float2*)(p.agg + (((size_t)(c0 + cc) * 2 + 0) * 512 + ch) * 2); hcur = ab.x * hcur + ab.y; } }
        else { for (int cc = nch - 1; cc > cpos; --cc) { const float2 ab = *(const float2*)(p.agg + (((size_t)(c0 + cc) * 2 + 1) * 512 + ch) * 2); hcur = ab.x * hcur + ab.y; } }
        __syncthreads();
#pragma unroll 8
        for (int i = 0; i < SCH; ++i) {
            const int tl = dir ? SCH - 1 - i : i, T = T0 + tl;
            const float av = p.a[((size_t)T * 2 + dir) * 512 + ch], bv = bf2f(p.bxb[((size_t)T * 2 + dir) * 512 + ch]);
            hcur = av * hcur + bv;
            (dir ? hb : hf)[tl * 128 + (tid & 127)] = hcur;
        }
        if (!ti.smp) {
            if (dir == 0 && cpos == nch - 1) o_lru[((size_t)ti.b * 2 + 0) * 512 + ch] = hcur;
            if (dir == 1 && cpos == 0) o_lru[((size_t)ti.b * 2 + 1) * 512 + ch] = hcur;
        }
        __syncthreads();
        for (int i = tid; i < SCH * 64; i += 256) {
            const int tl = i >> 6, c = (i & 63) * 2, T = T0 + tl, chh = cgp * 128 + c;
            const unsigned ugp = *(const unsigned*)(p.ug + (size_t)T * 512 + chh);
            const float g0 = gelu_tanh(__uint_as_float(ugp << 16)), g1 = gelu_tanh(__uint_as_float(ugp & 0xffff0000u));
            const float2 f = *(const float2*)(hf + tl * 128 + c), bb = *(const float2*)(hb + tl * 128 + c);
            *(unsigned*)(p.hbuf + (size_t)T * 1024 + 512 + chh) = pack_bf16((f.x + bb.x) * g0, (f.y + bb.y) * g1);
        }
    }
}

__device__ void st_gemm_o(const Params& p) {
    const int lane = threadIdx.x & 63, wid = threadIdx.x >> 6, wm = wid >> 1, wn = wid & 1, hl = lane >> 5, cl = lane & 31;
    for (int item = blockIdx.x; item < 160 * 8; item += gridDim.x) {
        const int tn = item & 7, tm = item >> 3;
        f32x16 acc[2][2];
        gemm_acc<2, 2, 2, 2>(p.hbuf + (size_t)tm * 128 * 1024, 1024, p.wt_o + (size_t)tn * 128 * 1024, 1024, 1024, acc);
        const int mi = tokinfo(tm * 128).mi;
#pragma unroll
        for (int j = 0; j < 2; ++j) {
            const int col = tn * 128 + ACC_COL(2, wn, j, cl);
            const float gt = modv(p, 0, mi, 2)[col];
#pragma unroll
            for (int i = 0; i < 2; ++i)
#pragma unroll
                for (int r = 0; r < 16; ++r) {
                    const int row = tm * 128 + ACC_ROW(2, wm, i, r, hl);
                    p.xres[(size_t)row * 1024 + col] = x_in_row(p, row)[col] + gt * acc[i][j][r];
                }
        }
    }
}

__device__ void st_gemm_pq(const Params& p, int l) {
    const int lane = threadIdx.x & 63, wid = threadIdx.x >> 6, wm = wid >> 1, wn = wid & 1, hl = lane >> 5, cl = lane & 31;
    for (int item = blockIdx.x; item < 160 * 16; item += gridDim.x) {
        const int tn = item & 15, tm = item >> 4;
        f32x16 acc[2][2];
        gemm_acc<2, 2, 2, 2>(p.hbuf + (size_t)tm * 128 * 1024, 1024, p.wt_pq[l] + (size_t)tn * 128 * 1024, 1024, 1024, acc);
#pragma unroll
        for (int i = 0; i < 2; ++i)
#pragma unroll
            for (int j = 0; j < 2; ++j)
#pragma unroll
                for (int r = 0; r < 16; ++r) {
                    const int row = tm * 128 + ACC_ROW(2, wm, i, r, hl), col = tn * 128 + ACC_COL(2, wn, j, cl);
                    p.qp[(size_t)row * 2048 + col] = f2bf(acc[i][j][r]);
                }
    }
}

__device__ __forceinline__ void ce_desc(float& a, float& b) { const float hi = fmaxf(a, b), lo = fminf(a, b); a = hi; b = lo; }
__device__ __forceinline__ void ins16(float (&top)[16], float x) {
#pragma unroll
    for (int i = 0; i < 16; ++i) { const float hi = fmaxf(top[i], x); x = fminf(top[i], x); top[i] = hi; }
}
__device__ __forceinline__ void bitonic_merge16(float (&v)[16]) {
#pragma unroll
    for (int j = 8; j >= 1; j >>= 1)
#pragma unroll
        for (int i = 0; i < 16; ++i) { const int l = i ^ j; if (l > i) ce_desc(v[i], v[l]); }
}
__device__ __forceinline__ void sort16(float (&v)[16]) {
#pragma unroll
    for (int k = 2; k <= 16; k <<= 1)
#pragma unroll
        for (int j = k >> 1; j >= 1; j >>= 1)
#pragma unroll
            for (int i = 0; i < 16; ++i) { const int l = i ^ j; if (l > i) { if ((i & k) == 0) ce_desc(v[i], v[l]); else ce_desc(v[l], v[i]); } }
}
__device__ __forceinline__ void merge_top16(float (&a)[16], const float (&b)[16]) {
#pragma unroll
    for (int i = 0; i < 16; ++i) a[i] = fmaxf(a[i], b[15 - i]);
    bitonic_merge16(a);
}
#define PKV(x) __uint_as_float(__float_as_uint(x) & 0xffffff80u)
#define CAND(i, j) __uint_as_float((__float_as_uint(PKV(top[0][i]) + PKV(top[1][j])) & 0xffffff00u) | (unsigned)((i) * 16 + (j)))
__device__ void st_peer_topk(const Params& p, int l) {
    const int lane = threadIdx.x & 63, wid = threadIdx.x >> 6, hl = lane >> 5, cl = lane & 31;
    for (int item = blockIdx.x; item < 160 * 8; item += gridDim.x) {
        const int h = item & 7, tm = item >> 3;
        const int T = tm * 128 + 32 * wid + cl;
        float top[2][16];
#pragma unroll
        for (int pp = 0; pp < 2; ++pp) {
            f32x16 acc[4][1];
            gemm_acc<4, 1, 1, 4>(p.keysb[l] + (size_t)(h * 2 + pp) * 128 * 128, 128, p.qp + (size_t)tm * 128 * 2048 + h * 256 + pp * 128, 2048, 128, acc);
#pragma unroll
            for (int i = 0; i < 4; ++i) {
                __builtin_amdgcn_sched_barrier(0);
                float g[16];
#pragma unroll
                for (int r = 0; r < 16; ++r) {
                    const int n = ACC_ROW(4, 0, i, r, hl);
                    g[r] = __uint_as_float((__float_as_uint(acc[i][0][r]) & 0xffffff80u) | (unsigned)n);
                }
                sort16(g);
                if (i == 0) {
#pragma unroll
                    for (int r = 0; r < 16; ++r) top[pp][r] = g[r];
                } else merge_top16(top[pp], g);
            }
            __builtin_amdgcn_sched_barrier(0);
            float oth[16];
#pragma unroll
            for (int i = 0; i < 16; ++i) oth[i] = __shfl_xor(top[pp][i], 32);
            merge_top16(top[pp], oth);
        }
        __builtin_amdgcn_sched_barrier(0);
        float fv[16], t2[16];
#pragma unroll
        for (int j = 0; j < 16; ++j) fv[j] = CAND(0, j);
        t2[15] = -INFINITY;
#pragma unroll
        for (int i = 1; i < 16; ++i) t2[i - 1] = CAND(i, 0);
        merge_top16(fv, t2);
        t2[0] = CAND(1, 1); t2[1] = CAND(1, 2); t2[2] = CAND(1, 3); t2[3] = CAND(1, 4); t2[4] = CAND(1, 5); t2[5] = CAND(1, 6); t2[6] = CAND(1, 7);
        t2[7] = CAND(2, 1); t2[8] = CAND(2, 2); t2[9] = CAND(2, 3); t2[10] = CAND(2, 4); t2[11] = CAND(3, 1); t2[12] = CAND(3, 2); t2[13] = CAND(3, 3);
        t2[14] = CAND(4, 1); t2[15] = CAND(4, 2);
        sort16(t2);
        merge_top16(fv, t2);
        ins16(fv, CAND(5, 1)); ins16(fv, CAND(6, 1)); ins16(fv, CAND(7, 1));
        unsigned* tab = (unsigned*)smem + (size_t)threadIdx.x * 8;
#pragma unroll
        for (int k = 0; k < 4; ++k) {
            tab[k] = (__float_as_uint(top[0][4 * k]) & 127u) | ((__float_as_uint(top[0][4 * k + 1]) & 127u) << 8) | ((__float_as_uint(top[0][4 * k + 2]) & 127u) << 16) | ((__float_as_uint(top[0][4 * k + 3]) & 127u) << 24);
            tab[4 + k] = (__float_as_uint(top[1][4 * k]) & 127u) | ((__float_as_uint(top[1][4 * k + 1]) & 127u) << 8) | ((__float_as_uint(top[1][4 * k + 2]) & 127u) << 16) | ((__float_as_uint(top[1][4 * k + 3]) & 127u) << 24);
        }
        const u8_t* tabb = (const u8_t*)tab;
        int fe[16];
#pragma unroll
        for (int i = 0; i < 16; ++i) {
            const unsigned code = __float_as_uint(fv[i]) & 255u;
            fe[i] = (int)tabb[code >> 4] * 128 + (int)tabb[16 + (code & 15u)];
            fv[i] = __uint_as_float(__float_as_uint(fv[i]) & 0xffffff00u);
        }
        float sum = 0.f, ev[16];
#pragma unroll
        for (int i = 0; i < 16; ++i) { ev[i] = __expf(fv[i] - fv[0]); sum += ev[i]; }
        const float inv = 1.f / sum;
        if (hl == 0) {
            float4* gp = (float4*)(p.gates + (size_t)T * 128 + h * 16); int4* ep = (int4*)(p.eidx + (size_t)T * 128 + h * 16);
#pragma unroll
            for (int i = 0; i < 4; ++i) { gp[i] = make_float4(ev[4 * i] * inv, ev[4 * i + 1] * inv, ev[4 * i + 2] * inv, ev[4 * i + 3] * inv); ep[i] = make_int4(fe[4 * i], fe[4 * i + 1], fe[4 * i + 2], fe[4 * i + 3]); }
        }
    }
}

#define FP4X(dw, b) __builtin_amdgcn_cvt_scalef32_pk_f32_fp4(dw, 1.0f, b)
#define FP4B(dw, b) __builtin_amdgcn_cvt_scalef32_pk_bf16_fp4(dw, 1.0f, b)
__device__ void st_peer_gather(const Params& p, int l) {
    const int lane = threadIdx.x & 63, wid = __builtin_amdgcn_readfirstlane(threadIdx.x >> 6), lp = lane & 31, hf = lane >> 5;
    const u8_t* U = p.u8[l]; const u8_t* V = p.v8[l]; const float* SU = p.su[l]; const float* SV = p.sv[l];
    const int idx4 = ((lane >> 4) & 1) + 2 * ((lane >> 3) & 1);
    const bool b3 = (lane & 8) != 0;
    for (int T = blockIdx.x * 4 + wid; T < T_TOK; T += gridDim.x * 4) {
        const TokInfo ti = tokinfo(T);
        unsigned hv[16];
        {
            const uint4* hp = (const uint4*)(p.hbuf + (size_t)T * 1024 + lp * 32);
#pragma unroll
            for (int q = 0; q < 4; ++q) { const uint4 t = hp[q]; hv[4 * q] = t.x; hv[4 * q + 1] = t.y; hv[4 * q + 2] = t.z; hv[4 * q + 3] = t.w; }
        }
        const int e0 = p.eidx[(size_t)T * 128 + lane], e1 = p.eidx[(size_t)T * 128 + 64 + lane];
        const float g0 = p.gates[(size_t)T * 128 + lane], g1 = p.gates[(size_t)T * 128 + 64 + lane];
        float outv[32];
#pragma unroll
        for (int j = 0; j < 32; ++j) outv[j] = 0.f;
#pragma unroll 1
        for (int kb = 0; kb < 16; ++kb) {
            const int esel = kb < 8 ? e0 : e1; const float gsel = kb < 8 ? g0 : g1;
            const int kl = (kb & 7) * 8;
            u32x4 ur[4], vr[4];
#pragma unroll
            for (int j = 0; j < 4; ++j) {
                const int ea = __builtin_amdgcn_readlane(esel, kl + 2 * j), eb = __builtin_amdgcn_readlane(esel, kl + 2 * j + 1);
                const int e = hf ? eb : ea;
                const unsigned off = (unsigned)e * 512u + (unsigned)lp * 16u;
                ur[j] = *(const u32x4*)(U + off);
                vr[j] = *(const u32x4*)(V + off);
            }
            const int kmine = kl + 2 * idx4 + hf;
            const int emine = __builtin_amdgcn_ds_bpermute(kmine << 2, esel);
            const float gmine = __int_as_float(__builtin_amdgcn_ds_bpermute(kmine << 2, __float_as_int(gsel)));
            const float su = SU[emine], sv = SV[emine];
            float d[4];
#pragma unroll
            for (int j = 0; j < 4; ++j) {
                float a = 0.f;
#pragma unroll
                for (int q = 0; q < 4; ++q) {
                    a = __builtin_amdgcn_fdot2_f32_bf16(FP4B(ur[j][q], 0), __builtin_bit_cast(bf16x2_t, hv[4 * q]), a, false);
                    a = __builtin_amdgcn_fdot2_f32_bf16(FP4B(ur[j][q], 1), __builtin_bit_cast(bf16x2_t, hv[4 * q + 1]), a, false);
                    a = __builtin_amdgcn_fdot2_f32_bf16(FP4B(ur[j][q], 2), __builtin_bit_cast(bf16x2_t, hv[4 * q + 2]), a, false);
                    a = __builtin_amdgcn_fdot2_f32_bf16(FP4B(ur[j][q], 3), __builtin_bit_cast(bf16x2_t, hv[4 * q + 3]), a, false);
                }
                d[j] = a;
            }
#pragma unroll
            for (int j = 0; j < 4; ++j) { d[j] += DPP_F(d[j], 0xB1); d[j] += DPP_F(d[j], 0x4E); d[j] += DPP_F(d[j], 0x141); }
            float a2[2];
#pragma unroll
            for (int i = 0; i < 2; ++i) { const float snd = b3 ? d[i] : d[i + 2], kp = b3 ? d[i + 2] : d[i]; a2[i] = kp + DPP_F(snd, 0x128); }
            const u32x2 rr = __builtin_amdgcn_permlane16_swap(__float_as_uint(a2[0]), __float_as_uint(a2[1]), false, false);
            const float z = __uint_as_float(rr[0]) + __uint_as_float(rr[1]);
            const float w = gmine * gelu_tanh(z * su) * sv;
#pragma unroll
            for (int j = 0; j < 4; ++j) {
                const int sl = (j & 1) * 16 + ((j >> 1) & 1) * 8;
                const float wa = __int_as_float(__builtin_amdgcn_readlane(__float_as_int(w), sl)), wb = __int_as_float(__builtin_amdgcn_readlane(__float_as_int(w), 32 + sl));
                const float wj = hf ? wb : wa;
#pragma unroll
                for (int q = 0; q < 4; ++q) {
                    const f32x2 x0 = FP4X(vr[j][q], 0), x1 = FP4X(vr[j][q], 1), x2 = FP4X(vr[j][q], 2), x3 = FP4X(vr[j][q], 3);
                    outv[8 * q] += wj * x0.x; outv[8 * q + 1] += wj * x0.y; outv[8 * q + 2] += wj * x1.x; outv[8 * q + 3] += wj * x1.y;
                    outv[8 * q + 4] += wj * x2.x; outv[8 * q + 5] += wj * x2.y; outv[8 * q + 6] += wj * x3.x; outv[8 * q + 7] += wj * x3.y;
                }
            }
        }
        float o16[16];
#pragma unroll
        for (int i = 0; i < 16; ++i) { const u32x2 r = __builtin_amdgcn_permlane32_swap(__float_as_uint(outv[i]), __float_as_uint(outv[i + 16]), false, false); o16[i] = __uint_as_float(r[0]) + __uint_as_float(r[1]); }
        const int cb = lp * 32 + hf * 16;
        float* xr = p.xres + (size_t)T * 1024 + cb;
        const float* gt = modv(p, l, ti.mi, 5) + cb;
        float xn[16]; float ss = 0.f;
#pragma unroll
        for (int j = 0; j < 4; ++j) { const float4 f = *(const float4*)(xr + 4 * j); xn[4 * j] = f.x + gt[4 * j] * o16[4 * j]; xn[4 * j + 1] = f.y + gt[4 * j + 1] * o16[4 * j + 1]; xn[4 * j + 2] = f.z + gt[4 * j + 2] * o16[4 * j + 2]; xn[4 * j + 3] = f.w + gt[4 * j + 3] * o16[4 * j + 3]; }
#pragma unroll
        for (int j = 0; j < 16; ++j) ss += xn[j] * xn[j];
        ss = wave_sum(ss);
        const float rstd = rsqrtf(ss * (1.f / 1024.f) + 1e-6f);
        if (l == 0) {
#pragma unroll
            for (int j = 0; j < 4; ++j) *(float4*)(xr + 4 * j) = make_float4(xn[4 * j], xn[4 * j + 1], xn[4 * j + 2], xn[4 * j + 3]);
            const float* sh = modv(p, 1, ti.mi, 0) + cb; const float* sc = modv(p, 1, ti.mi, 1) + cb; const float* gg = p.g_mix[1] + cb;
            unsigned w[8];
#pragma unroll
            for (int j = 0; j < 8; ++j) {
                const float a0 = xn[2 * j] * rstd * gg[2 * j] * (1.f + sc[2 * j]) + sh[2 * j];
                const float a1 = xn[2 * j + 1] * rstd * gg[2 * j + 1] * (1.f + sc[2 * j + 1]) + sh[2 * j + 1];
                w[j] = pack_bf16(a0, a1);
            }
            uint4* dd = (uint4*)(p.h3 + (size_t)T * 1024 + cb);
            dd[0] = make_uint4(w[0], w[1], w[2], w[3]); dd[1] = make_uint4(w[4], w[5], w[6], w[7]);
        } else {
            const float* gg = p.g_final + cb;
            float* y = p.out + (size_t)T * 1024 + cb;
#pragma unroll
            for (int j = 0; j < 4; ++j) *(float4*)(y + 4 * j) = make_float4(xn[4 * j] * rstd * gg[4 * j], xn[4 * j + 1] * rstd * gg[4 * j + 1], xn[4 * j + 2] * rstd * gg[4 * j + 2], xn[4 * j + 3] * rstd * gg[4 * j + 3]);
        }
    }
}

__device__ void st_pool(const Params& p) {
    const int tid = threadIdx.x, ck = tid & 127, g = ck >> 5, w = 2 << g;
    const int per = (T_TOK + gridDim.x - 1) / gridDim.x, Tb = blockIdx.x * per, Te = min(Tb + per, T_TOK);
    for (int T = Tb + (tid >> 7); T < Te; T += 2) {
        const TokInfo ti = tokinfo(T);
        const int lo = max(ti.s - w / 2, 0), hi = min(ti.s + w / 2, ti.S);
        const bf16_t* base = p.h3 + (size_t)(T - ti.s) * 1024 + ck * 8;
        float acc[8];
#pragma unroll
        for (int j = 0; j < 8; ++j) acc[j] = 0.f;
        for (int t2 = lo; t2 < hi; ++t2) {
            float f[8]; unpack8(*(const uint4*)(base + (size_t)t2 * 1024), f);
#pragma unroll
            for (int j = 0; j < 8; ++j) acc[j] += f[j];
        }
        float c[8]; unpack8(*(const uint4*)(base + (size_t)ti.s * 1024), c);
        const float inv = 1.f / (float)(hi - lo);
        uint4 o;
        o.x = pack_bf16(acc[0] * inv - c[0], acc[1] * inv - c[1]); o.y = pack_bf16(acc[2] * inv - c[2], acc[3] * inv - c[3]);
        o.z = pack_bf16(acc[4] * inv - c[4], acc[5] * inv - c[5]); o.w = pack_bf16(acc[6] * inv - c[6], acc[7] * inv - c[7]);
        *(uint4*)(p.hbuf + (size_t)T * 1024 + ck * 8) = o;
    }
}

__device__ void st_gemm_pool(const Params& p) {
    const int lane = threadIdx.x & 63, wid = threadIdx.x >> 6, wm = wid >> 1, wn = wid & 1, hl = lane >> 5, cl = lane & 31;
    for (int item = blockIdx.x; item < 160 * 8; item += gridDim.x) {
        const int tn = item & 7, tm = item >> 3, g = tn >> 1;
        f32x16 acc[2][2];
        gemm_acc<2, 2, 2, 2>(p.hbuf + (size_t)tm * 128 * 1024 + g * 256, 1024, p.wt_pool + ((size_t)g * 256 + (tn & 1) * 128) * 256, 256, 256, acc);
        const int mi = tokinfo(tm * 128).mi;
#pragma unroll
        for (int j = 0; j < 2; ++j) {
            const int col = tn * 128 + ACC_COL(2, wn, j, cl);
            const float gs = modv(p, 1, mi, 2)[col] * p.s_pool[col];
#pragma unroll
            for (int i = 0; i < 2; ++i)
#pragma unroll
                for (int r = 0; r < 16; ++r) {
                    const int row = tm * 128 + ACC_ROW(2, wm, i, r, hl);
                    p.xres[(size_t)row * 1024 + col] += gs * acc[i][j][r];
                }
        }
    }
}

__device__ __forceinline__ void run_stage(const Params& p, int s) {
#ifdef ONLY_STAGE
    if (s != ONLY_STAGE) return;
#endif
    switch (s) {
        case 0: st_prologue(p); break;
        case 1: st_norm<0>(p, 0, 0, p.g_mix[0], p.hbuf); break;
        case 2: st_gemm1(p); break;
        case 3: st_postproj(p); break;
        case 4: st_gemm234(p); break;
        case 5: st_attn_s1(p); break;
        case 6: st_scan3(p); break;
        case 7: st_gemm_o(p); break;
        case 8: st_norm<1>(p, 0, 1, p.g_ffn[0], p.hbuf); break;
        case 9: st_gemm_pq(p, 0); break;
        case 10: st_peer_topk(p, 0); break;
        case 11: st_peer_gather(p, 0); break;
        case 12: st_pool(p); break;
        case 13: st_gemm_pool(p); break;
        case 14: st_norm<1>(p, 1, 1, p.g_ffn[1], p.hbuf); break;
        case 15: st_gemm_pq(p, 1); break;
        case 16: st_peer_topk(p, 1); break;
        case 17: st_peer_gather(p, 1); break;
        default: break;
    }
}

__global__ void __launch_bounds__(256, 2) fwd_mega(Params p) {
    cg::grid_group grid = cg::this_grid();
    volatile LAS unsigned* st = (volatile LAS unsigned*)(smem + 65536);
    if (threadIdx.x == 0) { st[0] = 0; st[1] = 0; st[2] = 0; st[3] = 0; }
    __syncthreads();
    XcdBarrier b = xcd_barrier_post(p.bar, st);
    if (p.bar == nullptr) grid.sync();
#ifndef REP_MASK
#define REP_MASK 0
#endif
#define MK_ST(k) run_stage(p, k); if ((REP_MASK >> (k)) & 1) { xcd_barrier(b); run_stage(p, k); } if ((k) + 1 < NSTAGE) xcd_barrier(b);
    MK_ST(0) MK_ST(1) MK_ST(2) MK_ST(3) MK_ST(4) MK_ST(5) MK_ST(6) MK_ST(7) MK_ST(8) MK_ST(9) MK_ST(10) MK_ST(11) MK_ST(12) MK_ST(13) MK_ST(14) MK_ST(15) MK_ST(16) MK_ST(17)
}
__global__ void __launch_bounds__(256, 2) fwd_stage(Params p, int s) { run_stage(p, s); }

extern "C" void kernel_launch(void* const* d_in, const int* in_sizes, int n_in, void* d_out, int out_size, void* d_ws, size_t ws_size, hipStream_t stream) {
    constexpr size_t kDynLds = 65536 + 1024;
    static int grid_blocks = 0;
    if (!grid_blocks) {
        int dev = 0, cus = 0, per_cu = 0;
        (void)hipGetDevice(&dev);
        (void)hipDeviceGetAttribute(&cus, hipDeviceAttributeMultiprocessorCount, dev);
        (void)hipFuncSetAttribute((const void*)fwd_mega, hipFuncAttributeMaxDynamicSharedMemorySize, (int)kDynLds);
        (void)hipFuncSetAttribute((const void*)fwd_stage, hipFuncAttributeMaxDynamicSharedMemorySize, (int)kDynLds);
        (void)hipOccupancyMaxActiveBlocksPerMultiprocessor(&per_cu, fwd_mega, 256, kDynLds);
        if (per_cu > 2) per_cu = 2;
        if (per_cu < 1) per_cu = 1;
        grid_blocks = cus * per_cu;
    }
    Params p{};
    const float* const* in = (const float* const*)d_in;
    p.x_prompt = in[0]; p.x_sample = in[1]; p.cache_ckv = in[2]; p.cache_krope = in[3]; p.state_lru = in[4]; p.c = in[5]; p.c_ctx = in[6];
    p.w_mod[0] = in[7]; p.b_mod[0] = in[8]; p.w_mod[1] = in[9]; p.b_mod[1] = in[10];
    p.g_mix[0] = in[11]; p.g_ffn[0] = in[12]; p.g_mix[1] = in[13]; p.g_ffn[1] = in[14];
    p.w_in = in[15]; p.g_q = in[16]; p.w_uq = in[17]; p.g_kv = in[18]; p.w_ukv = in[19]; p.conv_w = in[20]; p.conv_b = in[21];
    p.w_rg = in[22]; p.b_rg = in[23]; p.w_ig = in[24]; p.b_ig = in[25]; p.lam = in[26]; p.w_o = in[27]; p.w_pool = in[28]; p.s_pool = in[29];
    p.peer_wq[0] = in[30]; p.peer_keys[0] = in[31]; p.peer_u[0] = in[32]; p.peer_v[0] = in[33];
    p.peer_wq[1] = in[34]; p.peer_keys[1] = in[35]; p.peer_u[1] = in[36]; p.peer_v[1] = in[37];
    p.g_final = in[38];
    p.out = (float*)d_out;
    char* base = (char*)d_ws; size_t off = 0;
    auto take = [&](size_t bytes) { char* r = base + off; off += (bytes + 255) & ~(size_t)255; return r; };
    const size_t MiB = 1u << 20;
    p.bar = (unsigned*)take(16384);
    p.mod = (float*)take((size_t)2 * 9 * 6144 * 4);
    p.ropetab = (float*)take(3072 * 4);
    p.wt_in = (bf16_t*)take((size_t)NW_IN * 2); p.wt_uq = (bf16_t*)take((size_t)NW_UQ * 2); p.wt_ukv = (bf16_t*)take((size_t)NW_UKV * 2);
    p.wt_gate = (bf16_t*)take((size_t)NW_GATE * 2); p.wt_o = (bf16_t*)take((size_t)NW_O * 2); p.wt_pool = (bf16_t*)take((size_t)NW_POOL * 2);
    p.wt_pq[0] = (bf16_t*)take((size_t)NW_PQ * 2); p.wt_pq[1] = (bf16_t*)take((size_t)NW_PQ * 2);
    p.keysb[0] = (bf16_t*)take((size_t)NW_KEYS * 2); p.keysb[1] = (bf16_t*)take((size_t)NW_KEYS * 2);
    for (int l = 0; l < 2; ++l) { p.u8[l] = (u8_t*)take(16 * MiB); p.v8[l] = (u8_t*)take(16 * MiB); p.su[l] = (float*)take(65536); p.sv[l] = (float*)take(65536); }
    char* regX = take(80 * MiB);
    char* regQ = take(80 * MiB);
    char* regH = take(40 * MiB);
    p.P = (bf16_t*)regX; p.a = (float*)regX; p.xres = (float*)regX;
    p.bxb = (bf16_t*)regQ; p.q = (bf16_t*)(regQ + 40 * MiB); p.agg = (float*)(regQ + 70 * MiB); p.qp = (bf16_t*)regQ; p.h3 = (bf16_t*)regQ;
    p.hbuf = (bf16_t*)regH;
    p.cqn = (bf16_t*)take((size_t)T_TOK * 384 * 2); p.ckvk = (bf16_t*)take((size_t)R_KEYS * 256 * 2); p.kropek = (bf16_t*)take((size_t)R_KEYS * 64 * 2);
    p.xc = (bf16_t*)take((size_t)T_TOK * 512 * 2); p.ug = (bf16_t*)take((size_t)T_TOK * 512 * 2);
    p.Kn = (bf16_t*)take((size_t)R_KEYS * 512 * 2); p.vT = (bf16_t*)take((size_t)R_KEYS * 512 * 2);
    p.gates = (float*)p.Kn; p.eidx = (int*)((char*)p.Kn + (size_t)T_TOK * 128 * 4);
    if (off > ws_size) fprintf(stderr, "workspace too small: need %zu have %zu\n", off, ws_size);
    (void)hipMemsetAsync(d_ws, 0, 16384, stream);
#if MK_LAUNCHES == 1
    void* args[] = {&p};
    hipError_t e = hipLaunchCooperativeKernel((void*)fwd_mega, dim3(grid_blocks), dim3(256), args, kDynLds, stream);
    if (e != hipSuccess) fprintf(stderr, "cooperative launch failed: %s (grid %d)\n", hipGetErrorString(e), grid_blocks);
#else
    for (int s = 0; s < NSTAGE; ++s) hipLaunchKernelGGL(fwd_stage, dim3(grid_blocks), dim3(256), kDynLds, stream, p, s);
#endif
}
```

```cpp
#include <hip/hip_runtime.h>
#include <hip/hip_cooperative_groups.h>
#include <cstdio>
#include <cstdint>
namespace cg = cooperative_groups;


typedef unsigned short bf16_t;
typedef unsigned char u8_t;
typedef float f32x16 __attribute__((ext_vector_type(16)));
typedef float f32x2 __attribute__((ext_vector_type(2)));
typedef unsigned u32x4 __attribute__((ext_vector_type(4)));
typedef float f32x4v __attribute__((ext_vector_type(4)));

#define T_TOK 20480
#define T_CTX 4096
#define R_KEYS 22528
#define NSTAGE 19
#define NTHR 512
#define NWV 8
#define LAS __attribute__((address_space(3)))

#define XB_TMO      128
#define XB_XCNT(j)  (256  + 64 * (j))
#define XB_XSUB(j)  (1280 + 64 * (j))
#define XB_XGEN(j)  (2304 + 64 * (j))
#define XB_TOP      3328
#define XB_TOPGEN   3392
#define XCD_BAR_WORDS 3456
#define XB_SPIN_CAP (1u << 22)
__device__ __forceinline__ unsigned xb_ld(unsigned* p)              { return __hip_atomic_load(p, __ATOMIC_RELAXED, __HIP_MEMORY_SCOPE_AGENT); }
__device__ __forceinline__ unsigned xb_add(unsigned* p, unsigned v) { return __hip_atomic_fetch_add(p, v, __ATOMIC_RELAXED, __HIP_MEMORY_SCOPE_AGENT); }
__device__ __forceinline__ unsigned xb_xcc_id() { return (unsigned)__builtin_amdgcn_s_getreg((3 << 11) | 20) & 0xFu; }
#define XB_SPIN(cond, bar) do { unsigned _sp = 0; while (cond) { __builtin_amdgcn_s_sleep(1); \
    if ((++_sp & 255u) == 0u) { if (xb_ld(&(bar)[XB_TMO])) break; if (_sp > XB_SPIN_CAP) { atomicAdd(&(bar)[XB_TMO], 1u); break; } } } } while (0)
struct XcdBarrier { unsigned* bar; unsigned x; volatile LAS unsigned* st; };
__device__ __forceinline__ XcdBarrier xcd_barrier_post(unsigned* bar, volatile LAS unsigned* st) {
    XcdBarrier b; b.bar = bar; b.x = xb_xcc_id(); b.st = st;
    if (threadIdx.x == 0) (void)xb_add(&bar[XB_XCNT(b.x)], 1u);
    return b;
}
__device__ __forceinline__ void xcd_barrier_complete(unsigned* bar, unsigned x, unsigned& nloc, unsigned& nx) {
    const unsigned G = gridDim.x * gridDim.y * gridDim.z;
    unsigned sum, cnt, mine, sp = 0u;
    for (;;) {
        sum = 0u; cnt = 0u; mine = 0u;
#pragma unroll
        for (unsigned j = 0; j < 16; ++j) { const unsigned c = xb_ld(&bar[XB_XCNT(j)]); sum += c; cnt += (c > 0u) ? 1u : 0u; mine = (j == x) ? c : mine; }
        if (sum == G) break;
        __builtin_amdgcn_s_sleep(1);
        if ((++sp & 255u) == 0u) { if (xb_ld(&bar[XB_TMO])) break; if (sp > XB_SPIN_CAP) { atomicAdd(&bar[XB_TMO], 1u); break; } }
    }
    nloc = mine > 0u ? mine : 1u; nx = cnt > 0u ? cnt : 1u;
}
__device__ __forceinline__ int tidx();
__device__ __forceinline__ void xcd_barrier(const XcdBarrier& b) {
    asm volatile("s_waitcnt vmcnt(0)" ::: "memory");
    __syncthreads();
    if (tidx() == 0) {
        unsigned* bar = b.bar;
        __builtin_amdgcn_s_waitcnt(0);
        unsigned nloc = b.st[0], nx = b.st[1];
        if (nloc == 0u) { xcd_barrier_complete(bar, b.x, nloc, nx); b.st[0] = nloc; b.st[1] = nx; }
        const unsigned old = xb_add(&bar[XB_XSUB(b.x)], 1u);
        const unsigned gen = old / nloc;
        if (old + 1u == (gen + 1u) * nloc) {
            __builtin_amdgcn_fence(__ATOMIC_RELEASE, "agent");
            asm volatile("s_waitcnt vmcnt(0)" ::: "memory");
            const unsigned og = xb_add(&bar[XB_TOP], 1u);
            const unsigned tg = og / nx;
            if (og + 1u == (tg + 1u) * nx) xb_add(&bar[XB_TOPGEN], 1u);
            else XB_SPIN(xb_ld(&bar[XB_TOPGEN]) == tg, bar);
            __builtin_amdgcn_fence(__ATOMIC_ACQUIRE, "agent");
            xb_add(&bar[XB_XGEN(b.x)], 1u);
            asm volatile("s_waitcnt vmcnt(0)" ::: "memory");
        } else {
            XB_SPIN(xb_ld(&bar[XB_XGEN(b.x)]) == gen, bar);
            __builtin_amdgcn_fence(__ATOMIC_ACQUIRE, "agent");
            asm volatile("s_waitcnt vmcnt(0)" ::: "memory");
        }
    }
    __syncthreads();
}

struct Params {
    const float *x_prompt, *x_sample, *cache_ckv, *cache_krope, *state_lru, *c, *c_ctx;
    const float *w_mod[2], *b_mod[2], *g_mix[2], *g_ffn[2];
    const float *w_in, *g_q, *w_uq, *g_kv, *w_ukv, *conv_w, *conv_b, *w_rg, *b_rg, *w_ig, *b_ig, *lam, *w_o, *w_pool, *s_pool;
    const float *peer_wq[2], *peer_keys[2], *peer_u[2], *peer_v[2];
    const float* g_final;
    float* out;
    unsigned* bar; float* mod; float* ropetab;
    bf16_t *wt_in, *wt_uq, *wt_ukv, *wt_gate, *wt_o, *wt_pool, *wt_pq[2], *keysb[2];
    u8_t *u8[2], *v8[2]; float *su[2], *sv[2];
    bf16_t *hbuf, *P, *cqn, *ckvk, *kropek, *xc, *ug, *q, *Kn, *vT, *bxb, *qp, *h3;
    float *a, *agg, *xres, *gates; int* eidx;
};

extern __shared__ __attribute__((aligned(16))) unsigned char smem[];
#define WTAB_OFF (131072 + 64)
__device__ __forceinline__ int hw_wave_slot() { return (int)(__builtin_amdgcn_s_getreg(0x2804) & 63u); }
__device__ __forceinline__ void wtab_init() { if ((threadIdx.x & 63) == 0) ((volatile int*)(smem + WTAB_OFF))[hw_wave_slot()] = (int)(threadIdx.x >> 6); }
__device__ __forceinline__ int tidx() {
    const int w = __builtin_amdgcn_readfirstlane(((volatile int*)(smem + WTAB_OFF))[hw_wave_slot()]);
    return (w << 6) | (int)__builtin_amdgcn_mbcnt_hi(~0u, __builtin_amdgcn_mbcnt_lo(~0u, 0u));
}
__device__ __forceinline__ float bf2f(bf16_t v) { return __uint_as_float(((unsigned)v) << 16); }
typedef __bf16 bf16x2_t __attribute__((ext_vector_type(2)));
__device__ __forceinline__ bf16_t f2bf(float f) { return __builtin_bit_cast(unsigned short, (__bf16)f); }
__device__ __forceinline__ unsigned pack_bf16(float a, float b) { bf16x2_t v = {(__bf16)a, (__bf16)b}; return __builtin_bit_cast(unsigned, v); }
typedef unsigned u32x2 __attribute__((ext_vector_type(2)));
#define DPP_F(v, ctrl) __int_as_float(__builtin_amdgcn_update_dpp(0, __float_as_int(v), ctrl, 0xf, 0xf, true))
__device__ __forceinline__ float wave_sum(float v) {
    v += DPP_F(v, 0xB1); v += DPP_F(v, 0x4E); v += DPP_F(v, 0x141); v += DPP_F(v, 0x128);
    u32x2 r = __builtin_amdgcn_permlane16_swap(__float_as_uint(v), __float_as_uint(v), false, false);
    v = __uint_as_float(r[0]) + __uint_as_float(r[1]);
    r = __builtin_amdgcn_permlane32_swap(__float_as_uint(v), __float_as_uint(v), false, false);
    return __uint_as_float(r[0]) + __uint_as_float(r[1]);
}
__device__ __forceinline__ float wave_max(float v) {
    v = fmaxf(v, DPP_F(v, 0xB1)); v = fmaxf(v, DPP_F(v, 0x4E)); v = fmaxf(v, DPP_F(v, 0x141)); v = fmaxf(v, DPP_F(v, 0x128));
    u32x2 r = __builtin_amdgcn_permlane16_swap(__float_as_uint(v), __float_as_uint(v), false, false);
    v = fmaxf(__uint_as_float(r[0]), __uint_as_float(r[1]));
    r = __builtin_amdgcn_permlane32_swap(__float_as_uint(v), __float_as_uint(v), false, false);
    return fmaxf(__uint_as_float(r[0]), __uint_as_float(r[1]));
}
__device__ __forceinline__ float gelu_tanh(float x) {
    const float u = 0.7978845608028654f * (x + 0.044715f * x * x * x);
    const float e = __expf(2.f * u);
    const float th = 1.f - 2.f / (e + 1.f);
    return 0.5f * x * (1.f + th);
}
__device__ __forceinline__ float sigmoidf_(float x) { return 1.f / (1.f + __expf(-x)); }
__device__ __forceinline__ float silu_(float x) { return x / (1.f + __expf(-x)); }

struct TokInfo { int smp, b, s, S, mi, keyrow; };
__device__ __forceinline__ TokInfo tokinfo(int T) {
    TokInfo t;
    if (T < T_CTX) { t.smp = 0; t.b = T >> 8; t.s = T & 255; t.S = 256; t.mi = 0; t.keyrow = T; }
    else { const int u = T - T_CTX; t.smp = 1; t.b = u >> 11; t.s = u & 2047; t.S = 2048; t.mi = 1 + t.b; t.keyrow = T_CTX + t.b * 2304 + 256 + t.s; }
    return t;
}
__device__ __forceinline__ const float* x_in_row(const Params& p, int T) { return T < T_CTX ? p.x_prompt + (size_t)T * 1024 : p.x_sample + (size_t)(T - T_CTX) * 1024; }
__device__ __forceinline__ const float* modv(const Params& p, int l, int mi, int j) { return p.mod + ((size_t)(l * 9 + mi) * 6 + j) * 1024; }

__device__ __forceinline__ void unpack8(const uint4 r, float (&f)[8]) {
    f[0] = __uint_as_float(r.x << 16); f[1] = __uint_as_float(r.x & 0xffff0000u);
    f[2] = __uint_as_float(r.y << 16); f[3] = __uint_as_float(r.y & 0xffff0000u);
    f[4] = __uint_as_float(r.z << 16); f[5] = __uint_as_float(r.z & 0xffff0000u);
    f[6] = __uint_as_float(r.w << 16); f[7] = __uint_as_float(r.w & 0xffff0000u);
}

namespace pg8 {
typedef short bf16x8 __attribute__((ext_vector_type(8)));
typedef float f32x4 __attribute__((ext_vector_type(4)));
constexpr int BM = 256, BK = 64, HALF = 128, HTB = HALF * BK * 2  , STAGE_BYTES = 8 * HTB;
__device__ __forceinline__ int lds_byte(int r, int c) { const int st = (r >> 4) * 2 + (c >> 5), rr = r & 15, cc = c & 31, ob = rr * 64 + cc * 2; return st * 1024 + (ob ^ (((ob >> 9) & 1) << 5)); }
__device__ __forceinline__ void stage_rc(int b, int& R, int& C) { const int st = b / 1024, sb = b % 1024, swz = sb ^ (((sb >> 9) & 1) << 5); R = (st >> 1) * 16 + swz / 64; C = (st & 1) * 32 + (swz % 64) / 2; }
__device__ __forceinline__ int perm32(int rho) { const int n = rho >> 4, i = rho & 15; return 8 * (i >> 2) + 4 * n + (i & 3); }
struct Unit { int pm, pn; const char* A; const char* B; };
template <class Epi, class Sched, bool ALIGN_EPI, bool SP2>
__device__ __forceinline__ void gemm_phase(LAS unsigned char* lds, const int lda, const int ldb, const int K, const Sched& S, const Epi& E) {
    __builtin_amdgcn_sched_barrier(0);
    const int tid = tidx(), wid = __builtin_amdgcn_readfirstlane(tid >> 6), lane = tid & 63, wr = wid >> 2, wc = wid & 3, fr = lane & 15, fq = lane >> 4;
    const int nt = K / BK;
    unsigned voffA[2], voffB[2];
#pragma unroll
    for (int i = 0; i < 2; ++i) { int R, C; stage_rc(tid * 16 + i * 8192, R, C); const int Rb = Epi::PERM ? ((R & ~31) + perm32(R & 31)) : R;
        voffA[i] = (unsigned)(R * lda + C) * 2u; voffB[i] = (unsigned)(Rb * ldb + C) * 2u; }
    const size_t kstep = (size_t)(BK * 2);
    const size_t hstepA = (size_t)HALF * lda * 2, hstepB = (size_t)HALF * ldb * 2;
    const unsigned ldsw = (unsigned)wid * 1024u;
    const int aoff = lds_byte(wr * 64 + fr, fq * 8), boff = lds_byte(wc * 32 + fr, fq * 8);
#define PG8_SA(b, h) (((b) * 2 + (h)) * HTB)
#define PG8_SB(b, h) ((4 + (b) * 2 + (h)) * HTB)
#define PG8_STAGE(bufoff, gbase, voff) do { _Pragma("unroll") for (int _i = 0; _i < 2; ++_i) \
        __builtin_amdgcn_global_load_lds((const unsigned*)((const char*)(gbase) + (voff)[_i]), (LAS unsigned*)(lds + (bufoff) + ldsw + _i * 8192), 16, 0, 0); } while (0)
#define PG8_LDA(dst, b, h) do { _Pragma("unroll") for (int m = 0; m < 4; ++m) _Pragma("unroll") for (int k = 0; k < 2; ++k) dst[m][k] = *(const LAS bf16x8*)(lds + PG8_SA(b, h) + aoff + m * 2048 + k * 1024); } while (0)
#define PG8_LDB(dst, b, h) do { _Pragma("unroll") for (int n = 0; n < 2; ++n) _Pragma("unroll") for (int k = 0; k < 2; ++k) dst[n][k] = *(const LAS bf16x8*)(lds + PG8_SB(b, h) + boff + n * 2048 + k * 1024); } while (0)
#define PG8_MMA(ai, bj, At, Bt) do { __builtin_amdgcn_s_setprio(1); _Pragma("unroll") for (int m = 0; m < 4; ++m) _Pragma("unroll") for (int n = 0; n < 2; ++n) _Pragma("unroll") for (int k = 0; k < 2; ++k) \
        acc[ai][bj][m][n] = __builtin_amdgcn_mfma_f32_16x16x32_bf16(Bt[n][k], At[m][k], acc[ai][bj][m][n], 0, 0, 0); __builtin_amdgcn_s_setprio(0); } while (0)
#define PG8_WAIT_V(n) asm volatile("s_waitcnt vmcnt(" #n ")" ::: "memory")
#define PG8_WAIT_L(n) asm volatile("s_waitcnt lgkmcnt(" #n ")" ::: "memory")
#define PG8_BAR __builtin_amdgcn_s_barrier()
#define PG8_SCHED __builtin_amdgcn_sched_barrier(0)
    Unit cur, nxt; int ui = 0;
    if (!S.next(0, cur)) return;
    f32x4 acc[2][2][4][2];
#pragma unroll
    for (int a = 0; a < 2; ++a)
#pragma unroll
        for (int b = 0; b < 2; ++b)
#pragma unroll
            for (int m = 0; m < 4; ++m)
#pragma unroll
                for (int n = 0; n < 2; ++n) acc[a][b][m][n] = (f32x4){0.f, 0.f, 0.f, 0.f};
    bf16x8 At[4][2], B0[2][2], B1[2][2];
    const char* cA = cur.A; const char* cB = cur.B;
    if constexpr (SP2) {
        PG8_STAGE(PG8_SB(0, 0), cB, voffB); PG8_STAGE(PG8_SB(0, 1), cB + hstepB, voffB); PG8_STAGE(PG8_SA(0, 0), cA, voffA); PG8_STAGE(PG8_SA(0, 1), cA + hstepA, voffA);
        if (wr == 1) PG8_BAR;
        PG8_WAIT_V(2); PG8_BAR;
        PG8_STAGE(PG8_SB(1, 0), cB + kstep, voffB); PG8_STAGE(PG8_SA(1, 0), cA + kstep, voffA); PG8_STAGE(PG8_SB(1, 1), cB + hstepB + kstep, voffB);
        PG8_WAIT_V(6); PG8_BAR;
    } else {
        PG8_STAGE(PG8_SB(0, 0), cB, voffB); PG8_STAGE(PG8_SA(0, 0), cA, voffA); PG8_STAGE(PG8_SB(0, 1), cB + hstepB, voffB); PG8_STAGE(PG8_SA(0, 1), cA + hstepA, voffA);
        if (wr == 1) PG8_BAR;
        PG8_WAIT_V(4); PG8_BAR;
        PG8_STAGE(PG8_SB(1, 0), cB + kstep, voffB); PG8_STAGE(PG8_SA(1, 0), cA + kstep, voffA); PG8_STAGE(PG8_SB(1, 1), cB + hstepB + kstep, voffB);
        PG8_WAIT_V(6); PG8_BAR;
    }
    for (;;) {
        const bool has_next = S.next(ui + 1, nxt);
        const char* nA = has_next ? nxt.A : cA; const char* nB = has_next ? nxt.B : cB;
#pragma unroll 1
        for (int t = 0; t < nt; t += 2) {
            const bool last = (t == nt - 2);
            const char* a1 = cA + (size_t)(t + 1) * kstep;
            const char* a2 = last ? nA : cA + (size_t)(t + 2) * kstep; const char* b2 = last ? nB : cB + (size_t)(t + 2) * kstep;
            const char* a3 = a2 + kstep; const char* b3 = b2 + kstep;
            if constexpr (SP2) {
            PG8_LDB(B0, 0, 0); PG8_LDB(B1, 0, 1); PG8_SCHED; PG8_LDA(At, 0, 0); PG8_STAGE(PG8_SA(1, 1), a1 + hstepA, voffA);
            PG8_WAIT_V(8); PG8_WAIT_L(0); PG8_BAR; PG8_MMA(0, 0, At, B0); PG8_MMA(0, 1, At, B1); PG8_BAR; PG8_SCHED;
            PG8_LDA(At, 0, 1); PG8_STAGE(PG8_SB(0, 0), b2, voffB); PG8_STAGE(PG8_SB(0, 1), b2 + hstepB, voffB); PG8_STAGE(PG8_SA(0, 0), a2, voffA);
            PG8_WAIT_V(8); PG8_WAIT_L(0); PG8_BAR; PG8_MMA(1, 0, At, B0); PG8_MMA(1, 1, At, B1); PG8_BAR; PG8_SCHED;
            PG8_LDB(B0, 1, 0); PG8_LDB(B1, 1, 1); PG8_SCHED; PG8_LDA(At, 1, 0); PG8_STAGE(PG8_SA(0, 1), a2 + hstepA, voffA);
            PG8_WAIT_V(8); PG8_WAIT_L(0); PG8_BAR; PG8_MMA(0, 0, At, B0); PG8_MMA(0, 1, At, B1); PG8_BAR; PG8_SCHED;
            PG8_LDA(At, 1, 1); PG8_STAGE(PG8_SB(1, 0), b3, voffB); PG8_STAGE(PG8_SB(1, 1), b3 + hstepB, voffB); PG8_STAGE(PG8_SA(1, 0), a3, voffA);
            PG8_WAIT_V(8); PG8_WAIT_L(0); PG8_BAR; PG8_MMA(1, 0, At, B0); PG8_MMA(1, 1, At, B1); PG8_BAR; PG8_SCHED;
            } else {
            PG8_LDB(B0, 0, 0); PG8_SCHED; PG8_LDA(At, 0, 0); PG8_STAGE(PG8_SA(1, 1), a1 + hstepA, voffA);
            PG8_WAIT_L(8); PG8_BAR; PG8_WAIT_L(0); PG8_MMA(0, 0, At, B0); PG8_BAR; PG8_SCHED;
            PG8_LDB(B1, 0, 1); PG8_STAGE(PG8_SB(0, 0), b2, voffB);
            PG8_BAR; PG8_WAIT_L(0); PG8_MMA(0, 1, At, B1); PG8_BAR;
            PG8_LDA(At, 0, 1); PG8_STAGE(PG8_SA(0, 0), a2, voffA);
            PG8_BAR; PG8_WAIT_L(0); PG8_MMA(1, 0, At, B0); PG8_BAR; PG8_SCHED;
            PG8_STAGE(PG8_SB(0, 1), b2 + hstepB, voffB);
            PG8_WAIT_V(6); PG8_BAR; PG8_MMA(1, 1, At, B1); PG8_BAR;
            PG8_LDB(B0, 1, 0); PG8_SCHED; PG8_LDA(At, 1, 0); PG8_STAGE(PG8_SA(0, 1), a2 + hstepA, voffA);
            PG8_WAIT_L(8); PG8_BAR; PG8_WAIT_L(0); PG8_MMA(0, 0, At, B0); PG8_BAR; PG8_SCHED;
            PG8_LDB(B1, 1, 1); PG8_STAGE(PG8_SB(1, 0), b3, voffB);
            PG8_BAR; PG8_WAIT_L(0); PG8_MMA(0, 1, At, B1); PG8_BAR;
            PG8_LDA(At, 1, 1); PG8_STAGE(PG8_SA(1, 0), a3, voffA);
            PG8_BAR; PG8_WAIT_L(0); PG8_MMA(1, 0, At, B0); PG8_BAR; PG8_SCHED;
            PG8_STAGE(PG8_SB(1, 1), b3 + hstepB, voffB);
            PG8_WAIT_V(6); PG8_BAR; PG8_MMA(1, 1, At, B1); PG8_BAR;
            }
        }
        if constexpr (ALIGN_EPI) { if (wr == 0) PG8_BAR; }
        E(acc, cur, wr, wc, fr, fq);
        if (!has_next) break;
#pragma unroll
        for (int a = 0; a < 2; ++a)
#pragma unroll
            for (int b = 0; b < 2; ++b)
#pragma unroll
                for (int m = 0; m < 4; ++m)
#pragma unroll
                    for (int n = 0; n < 2; ++n) acc[a][b][m][n] = (f32x4){0.f, 0.f, 0.f, 0.f};
        cur = nxt; cA = nA; cB = nB; ++ui;
        if constexpr (ALIGN_EPI) { if (wr == 1) PG8_BAR; }
    }
    PG8_WAIT_V(0);
    if constexpr (!ALIGN_EPI) { if (wr == 0) PG8_BAR; }
    PG8_BAR;
    __builtin_amdgcn_sched_barrier(0);
#undef PG8_SA
#undef PG8_SB
#undef PG8_STAGE
#undef PG8_LDA
#undef PG8_LDB
#undef PG8_MMA
#undef PG8_WAIT_V
#undef PG8_WAIT_L
#undef PG8_BAR
#undef PG8_SCHED
}
struct TileOrder {
    int nN, total; const char* A; const char* B; size_t tA, tB;
    __device__ __forceinline__ bool next(int i, Unit& u) const {
        const int item = blockIdx.x + i * gridDim.x; if (item >= total) return false;
        const int lt = item >> 3; u.pn = lt % nN; u.pm = (lt / nN) * 8 + (item & 7);
        u.A = A + (size_t)u.pm * tA; u.B = B + (size_t)u.pn * tB; return true;
    }
};
}

typedef __bf16 bf16x8_t __attribute__((ext_vector_type(8)));
__device__ __forceinline__ int lds_off(int row, int chunk) { return row * 128 + ((chunk ^ ((row >> 1) & 7)) << 4); }
template <int TM, int TN, int WM, int WN>
__device__ __forceinline__ void gemm_acc(const bf16_t* __restrict__ As, int lda, const bf16_t* __restrict__ Bs, int ldb, int K, f32x16 (&acc)[TM][TN]) {
    static_assert(TM * WM == 4 && TN * WN == 4 && WM * WN == 4, "tile is 128 x 128, 4 waves");
    const int tid = tidx() & 255, lane = tid & 63, wid = tid >> 6, wm = wid / WN, wn = wid % WN, hl = lane >> 5, cl = lane & 31;
    unsigned char* sm = smem + (tidx() >> 8) * 65536;
#pragma unroll
    for (int i = 0; i < TM; ++i)
#pragma unroll
        for (int j = 0; j < TN; ++j)
#pragma unroll
            for (int r = 0; r < 16; ++r) acc[i][j][r] = 0.f;
    const int srow0 = wid * 32 + (lane >> 3), pc = lane & 7;
    const bf16_t* ga[4]; const bf16_t* gb[4];
#pragma unroll
    for (int i = 0; i < 4; ++i) {
        const int row = srow0 + 8 * i, lc = pc ^ ((row >> 1) & 7);
        ga[i] = As + (size_t)row * lda + lc * 8; gb[i] = Bs + (size_t)row * ldb + lc * 8;
    }
    unsigned char* lbase = sm + wid * 4096 + lane * 16;
    __syncthreads();
#pragma unroll
    for (int i = 0; i < 4; ++i) {
        __builtin_amdgcn_global_load_lds((const unsigned*)ga[i], (unsigned*)(lbase + i * 1024), 16, 0, 0);
        __builtin_amdgcn_global_load_lds((const unsigned*)gb[i], (unsigned*)(lbase + 16384 + i * 1024), 16, 0, 0);
    }
    asm volatile("s_waitcnt vmcnt(0)" ::: "memory");
    __syncthreads();
    const int nk = K >> 6;
    for (int kt = 0; kt < nk; ++kt) {
        const int cur = (kt & 1) * 32768, nxt = 32768 - cur;
        if (kt + 1 < nk) {
#pragma unroll
            for (int i = 0; i < 4; ++i) {
                __builtin_amdgcn_global_load_lds((const unsigned*)(ga[i] + (kt + 1) * 64), (unsigned*)(lbase + nxt + i * 1024), 16, 0, 0);
                __builtin_amdgcn_global_load_lds((const unsigned*)(gb[i] + (kt + 1) * 64), (unsigned*)(lbase + nxt + 16384 + i * 1024), 16, 0, 0);
            }
        }
#pragma unroll
        for (int ks = 0; ks < 4; ++ks) {
            bf16x8_t af[TM], bfr[TN];
#pragma unroll
            for (int i = 0; i < TM; ++i) af[i] = __builtin_bit_cast(bf16x8_t, *(const u32x4*)(sm + cur + lds_off(32 * (TM * wm + i) + cl, 2 * ks + hl)));
#pragma unroll
            for (int j = 0; j < TN; ++j) bfr[j] = __builtin_bit_cast(bf16x8_t, *(const u32x4*)(sm + cur + 16384 + lds_off(32 * (TN * wn + j) + cl, 2 * ks + hl)));
#pragma unroll
            for (int i = 0; i < TM; ++i)
#pragma unroll
                for (int j = 0; j < TN; ++j) acc[i][j] = __builtin_amdgcn_mfma_f32_32x32x16_bf16(af[i], bfr[j], acc[i][j], 0, 0, 0);
        }
        asm volatile("s_waitcnt vmcnt(0)" ::: "memory");
        __syncthreads();
    }
}
#define ACC_ROW(TMv, wm, i, r, hl) (32 * ((TMv) * (wm) + (i)) + ((r) & 3) + 8 * ((r) >> 2) + 4 * (hl))
#define ACC_COL(TNv, wn, j, cl)    (32 * ((TNv) * (wn) + (j)) + (cl))

#define N_ADA 384
#define NW_IN   (1792 * 1024)
#define NW_UQ   (768 * 384)
#define NW_UKV  (1024 * 256)
#define NW_GATE (4 * 512 * 128)
#define NW_O    (1024 * 1024)
#define NW_POOL (4 * 256 * 256)
#define NW_PQ   (2048 * 1024)
#define NW_KEYS (16 * 128 * 128)
#define NW_CKV  (8 * 256 * 256)
#define NW_CKR  (8 * 256 * 64)
#define NW_ROPE 3072
#define NT_IN 448
#define NT_UQ 72
#define NT_UKV 64
#define NT_O 256
#define NT_POOL 64
#define NT_PQ 512
#define N_TR (NT_IN + NT_UQ + NT_UKV + NT_O + NT_POOL + 2 * NT_PQ)
#define NE_TOTAL (NW_GATE + 2 * NW_KEYS + NW_CKV + NW_CKR + NW_ROPE)
#define N_CONV_ITEMS ((NE_TOTAL + 4095) / 4096)
#define N_FP8_ITEMS (65536 / NWV / 4)

__device__ __forceinline__ void conv_elem(const Params& p, int e) {
    if (e < NW_GATE) {
        const int c = e & 127, cg = (e >> 7) & 511, nb = e >> 16;
        const int dir = cg >> 8, dg = (cg >> 6) & 3, ri = (cg >> 5) & 1, d = dg * 32 + (cg & 31);
        const float* src = ri ? p.w_ig : p.w_rg;
        p.wt_gate[e] = f2bf(src[(((size_t)dir * 4 + nb) * 128 + c) * 128 + d]); return; } e -= NW_GATE;
#pragma unroll
    for (int l = 0; l < 2; ++l) { if (e < NW_KEYS) { p.keysb[l][e] = f2bf(p.peer_keys[l][e]); return; } e -= NW_KEYS; }
    if (e < NW_CKV) { const int col = e & 255, j = (e >> 8) & 255, b = e >> 16; p.ckvk[(size_t)(T_CTX + b * 2304 + j) * 256 + col] = f2bf(p.cache_ckv[e]); return; } e -= NW_CKV;
    if (e < NW_CKR) { const int col = e & 63, j = (e >> 6) & 255, b = e >> 14; p.kropek[(size_t)(T_CTX + b * 2304 + j) * 64 + col] = f2bf(p.cache_krope[e]); return; } e -= NW_CKR;
    if (e < NW_ROPE) {
        int idx = e, isrow = e < 1024; if (!isrow) idx -= 1024;
        const int half = isrow ? 512 : 1024; const int sn = idx >= half; if (sn) idx -= half;
        const int pos = idx >> 4, fi = idx & 15;
        const float invf = exp2f(-(float)fi * (13.287712379549449f / 16.f));
        const float ang = (float)pos * invf;
        p.ropetab[e] = sn ? sinf(ang) : cosf(ang); return; }
}
__device__ __forceinline__ void tr_tile(const float* __restrict__ src, int ldsrc, int nvalid, bf16_t* __restrict__ dst, int lddst, int k0, int n0, float scl = 1.f) {
    float* tile = (float*)(smem + (tidx() >> 8) * 32768);
    const int tid = tidx() & 255;
    __syncthreads();
#pragma unroll
    for (int i = 0; i < 4; ++i) {
        const int k = (tid >> 4) + 16 * i, n = (tid & 15) * 4;
        float4 v = make_float4(0.f, 0.f, 0.f, 0.f);
        if (n0 + n < nvalid) v = *(const float4*)(src + (size_t)(k0 + k) * ldsrc + n0 + n);
        tile[k * 65 + n] = v.x; tile[k * 65 + n + 1] = v.y; tile[k * 65 + n + 2] = v.z; tile[k * 65 + n + 3] = v.w;
    }
    __syncthreads();
    const int n = tid >> 2, kq = (tid & 3) * 16;
    unsigned w[8];
#pragma unroll
    for (int j = 0; j < 8; ++j) w[j] = pack_bf16(tile[(kq + 2 * j) * 65 + n] * scl, tile[(kq + 2 * j + 1) * 65 + n] * scl);
    uint4* d = (uint4*)(dst + (size_t)(n0 + n) * lddst + k0 + kq);
    d[0] = make_uint4(w[0], w[1], w[2], w[3]); d[1] = make_uint4(w[4], w[5], w[6], w[7]);
}
__device__ __forceinline__ void tr_item(const Params& p, int t) {
    if (t < NT_IN) { tr_tile(p.w_in, 1728, 1728, p.wt_in, 1024, (t % 16) * 64, (t / 16) * 64); return; } t -= NT_IN;
    if (t < NT_UQ) { tr_tile(p.w_uq, 768, 768, p.wt_uq, 384, (t % 6) * 64, (t / 6) * 64, 0.07216878364870322f * 1.4426950408889634f  ); return; } t -= NT_UQ;
    if (t < NT_UKV) {
        const int n0 = (t / 4) * 64, h = n0 >> 8, kv = (n0 >> 7) & 1, nn = kv * 512 + h * 128 + (n0 & 127);
        tr_tile(p.w_ukv, 1024, 1024, p.wt_ukv + ((ptrdiff_t)nn - n0) * 256, 256, (t % 4) * 64, n0); return; } t -= NT_UKV;
    if (t < NT_O) { tr_tile(p.w_o, 1024, 1024, p.wt_o, 1024, (t % 16) * 64, (t / 16) * 64); return; } t -= NT_O;
    if (t < NT_POOL) { const int g = t >> 4, tt = t & 15; tr_tile(p.w_pool + (size_t)g * 65536, 256, 256, p.wt_pool + (size_t)g * 65536, 256, (tt & 3) * 64, (tt >> 2) * 64); return; } t -= NT_POOL;
    if (t < NT_PQ) { tr_tile(p.peer_wq[0], 2048, 2048, p.wt_pq[0], 1024, (t % 16) * 64, (t / 16) * 64); return; } t -= NT_PQ;
    tr_tile(p.peer_wq[1], 2048, 2048, p.wt_pq[1], 1024, (t % 16) * 64, (t / 16) * 64);
}

__device__ void st_prologue(const Params& p) {
    const int tid = tidx(), lane = tid & 63, wid = tid >> 6;
    const int n_items = N_ADA + N_TR / 2 + N_CONV_ITEMS + N_FP8_ITEMS;
    for (int item = blockIdx.x; item < n_items; item += gridDim.x) {
        if (item < N_ADA) {
            float* svec = (float*)smem;
            float* red = (float*)(smem + 9 * 4096);
            __syncthreads();
            for (int i = tid; i < 9 * 1024; i += NTHR) { const int bc = i >> 10, k = i & 1023; const float cv = bc == 0 ? p.c_ctx[k] : p.c[(size_t)(bc - 1) * 1024 + k]; svec[i] = silu_(cv); }
            __syncthreads();
            const int cidx = item * 32 + (lane & 7) * 4, l = cidx / 6144, col = cidx % 6144, k0 = (wid * 8 + (lane >> 3)) * 16;
            const float* w = p.w_mod[l] + (size_t)k0 * 6144 + col;
            float acc[9][4];
#pragma unroll
            for (int b = 0; b < 9; ++b) { acc[b][0] = 0.f; acc[b][1] = 0.f; acc[b][2] = 0.f; acc[b][3] = 0.f; }
#pragma unroll 8
            for (int k = 0; k < 16; ++k) {
                const float4 wv = *(const float4*)(w + (size_t)k * 6144);
#pragma unroll
                for (int b = 0; b < 9; ++b) { const float sv = svec[b * 1024 + k0 + k]; acc[b][0] += wv.x * sv; acc[b][1] += wv.y * sv; acc[b][2] += wv.z * sv; acc[b][3] += wv.w * sv; }
            }
#pragma unroll
            for (int b = 0; b < 9; ++b)
#pragma unroll
                for (int j = 0; j < 4; ++j) { float v = acc[b][j]; v += __shfl_xor(v, 8); v += __shfl_xor(v, 16); v += __shfl_xor(v, 32); acc[b][j] = v; }
            if (lane < 8) {
#pragma unroll
                for (int b = 0; b < 9; ++b)
#pragma unroll
                    for (int j = 0; j < 4; ++j) red[(wid * 9 + b) * 32 + lane * 4 + j] = acc[b][j];
            }
            __syncthreads();
            for (int i = tid; i < 9 * 32; i += NTHR) {
                const int b = i >> 5, c = i & 31;
                const int ci = item * 32 + c, ll = ci / 6144, cc = ci % 6144;
                float v = 0.f;
#pragma unroll
                for (int w8 = 0; w8 < 8; ++w8) v += red[(w8 * 9 + b) * 32 + c];
                p.mod[(size_t)(ll * 9 + b) * 6144 + cc] = v + p.b_mod[ll][cc];
            }
        } else if (item < N_ADA + N_TR / 2) {
            tr_item(p, (item - N_ADA) * 2 + (tid >> 8));
        } else if (item < N_ADA + N_TR / 2 + N_CONV_ITEMS) {
            const int base = (item - N_ADA - N_TR / 2) * 4096;
            for (int i = tid; i < 4096; i += NTHR) { const int e = base + i; if (e < NE_TOTAL) conv_elem(p, e); }
        } else {
            const int row0 = ((item - N_ADA - N_TR / 2 - N_CONV_ITEMS) * NWV + wid) * 4;
            const int tb = row0 >> 14, er0 = row0 & 16383, l = tb >> 1;
            const float* src = ((tb & 1) ? p.peer_v[l] : p.peer_u[l]) + (size_t)er0 * 1024 + lane * 16;
            u8_t* dst = ((tb & 1) ? p.v8[l] : p.u8[l]) + (size_t)er0 * 512 + lane * 8;
            float* sc = ((tb & 1) ? p.sv[l] : p.su[l]) + er0;
            f32x4v f[4][4];
#pragma unroll
            for (int r = 0; r < 4; ++r)
#pragma unroll
                for (int j = 0; j < 4; ++j) f[r][j] = __builtin_nontemporal_load((const f32x4v*)(src + (size_t)r * 1024 + 4 * j));
#pragma unroll
            for (int r = 0; r < 4; ++r) {
                float am = 0.f;
#pragma unroll
                for (int j = 0; j < 4; ++j) am = fmaxf(fmaxf(am, fmaxf(fabsf(f[r][j][0]), fabsf(f[r][j][1]))), fmaxf(fabsf(f[r][j][2]), fabsf(f[r][j][3])));
                am = wave_max(am);
                const float scale = am > 0.f ? am * (1.f / 6.f) : 1.f, inv = am > 0.f ? 6.f / am : 1.f;
                unsigned w[2];
#pragma unroll
                for (int j = 0; j < 2; ++j) {
                    unsigned pk = 0u;
                    pk = __builtin_amdgcn_cvt_scalef32_pk_fp4_f32(pk, f[r][2 * j][0] * inv, f[r][2 * j][1] * inv, 1.0f, 0);
                    pk = __builtin_amdgcn_cvt_scalef32_pk_fp4_f32(pk, f[r][2 * j][2] * inv, f[r][2 * j][3] * inv, 1.0f, 1);
                    pk = __builtin_amdgcn_cvt_scalef32_pk_fp4_f32(pk, f[r][2 * j + 1][0] * inv, f[r][2 * j + 1][1] * inv, 1.0f, 2);
                    pk = __builtin_amdgcn_cvt_scalef32_pk_fp4_f32(pk, f[r][2 * j + 1][2] * inv, f[r][2 * j + 1][3] * inv, 1.0f, 3);
                    w[j] = pk;
                }
                *(uint2*)(dst + (size_t)r * 512) = make_uint2(w[0], w[1]);
                if (lane == 0) sc[r] = scale;
            }
        }
    }
}

template <int SRC>
__device__ void st_norm(const Params& p, int l, int which, const float* g, bf16_t* dst) {
    const int lane = tidx() & 63, wid = tidx() >> 6;
    for (int T = blockIdx.x * NWV + wid; T < T_TOK; T += gridDim.x * NWV) {
        const float* src = (SRC == 0 ? x_in_row(p, T) : p.xres + (size_t)T * 1024) + lane * 16;
        const TokInfo ti = tokinfo(T);
        float v[16]; float ss = 0.f;
#pragma unroll
        for (int j = 0; j < 4; ++j) { const float4 f = *(const float4*)(src + 4 * j); v[4 * j] = f.x; v[4 * j + 1] = f.y; v[4 * j + 2] = f.z; v[4 * j + 3] = f.w; }
#pragma unroll
        for (int j = 0; j < 16; ++j) ss += v[j] * v[j];
        ss = wave_sum(ss);
        const float rstd = rsqrtf(ss * (1.f / 1024.f) + 1e-6f);
        const float* sh = modv(p, l, ti.mi, which ? 3 : 0) + lane * 16; const float* sc = modv(p, l, ti.mi, which ? 4 : 1) + lane * 16; const float* gg = g + lane * 16;
        unsigned w[8];
#pragma unroll
        for (int j = 0; j < 8; ++j) {
            const float a0 = v[2 * j] * rstd * gg[2 * j] * (1.f + sc[2 * j]) + sh[2 * j];
            const float a1 = v[2 * j + 1] * rstd * gg[2 * j + 1] * (1.f + sc[2 * j + 1]) + sh[2 * j + 1];
            w[j] = (unsigned)f2bf(a0) | ((unsigned)f2bf(a1) << 16);
        }
        uint4* d = (uint4*)(dst + (size_t)T * 1024 + lane * 16);
        d[0] = make_uint4(w[0], w[1], w[2], w[3]); d[1] = make_uint4(w[4], w[5], w[6], w[7]);
    }
}

struct EpiStoreBf16 {
    static constexpr bool PERM = true;
    bf16_t* O; int ldc;
    __device__ __forceinline__ void operator()(const pg8::f32x4 (&acc)[2][2][4][2], const pg8::Unit& u, int wr, int wc, int fr, int fq) const {
#pragma unroll
        for (int ai = 0; ai < 2; ++ai)
#pragma unroll
            for (int m = 0; m < 4; ++m) {
                bf16_t* rowp = O + (size_t)(u.pm * 256 + ai * 128 + wr * 64 + m * 16 + fr) * ldc + u.pn * 256 + wc * 32 + 8 * fq;
#pragma unroll
                for (int bj = 0; bj < 2; ++bj) {
                    const pg8::f32x4 v0 = acc[ai][bj][m][0], v1 = acc[ai][bj][m][1];
                    *(uint4*)(rowp + bj * 128) = make_uint4(pack_bf16(v0[0], v0[1]), pack_bf16(v0[2], v0[3]), pack_bf16(v1[0], v1[1]), pack_bf16(v1[2], v1[3]));
                }
            }
    }
};
__device__ void st_gemm1(const Params& p) {
    pg8::TileOrder S; S.nN = 7; S.total = 80 * 7; S.A = (const char*)p.hbuf; S.B = (const char*)p.wt_in; S.tA = (size_t)256 * 1024 * 2; S.tB = (size_t)256 * 1024 * 2;
    EpiStoreBf16 E; E.O = p.P; E.ldc = 1792;
    pg8::gemm_phase<EpiStoreBf16, pg8::TileOrder, true, true>((LAS unsigned char*)smem, 1024, 1024, 1024, S, E);
}

__device__ void st_postproj(const Params& p) {
    const int lane = tidx() & 63, wid = tidx() >> 6;
    float* o_ckv = p.out + 20971520, *o_kr = p.out + 22020096;
    for (int T = blockIdx.x * NWV + wid; T < T_TOK; T += gridDim.x * NWV) {
        const TokInfo ti = tokinfo(T);
        const bf16_t* Pr = p.P + (size_t)T * 1792;
        float cq[8], ck[8];
#pragma unroll
        for (int j = 0; j < 8; ++j) { cq[j] = 0.f; ck[j] = 0.f; }
        if (lane < 48) unpack8(*(const uint4*)(Pr + lane * 8), cq);
        if (lane < 32) unpack8(*(const uint4*)(Pr + 384 + lane * 8), ck);
        float s1 = 0.f, s2 = 0.f;
#pragma unroll
        for (int j = 0; j < 8; ++j) { s1 += cq[j] * cq[j]; s2 += ck[j] * ck[j]; }
        s1 = wave_sum(s1); s2 = wave_sum(s2);
        const float r1 = rsqrtf(s1 * (1.f / 384.f) + 1e-6f), r2 = rsqrtf(s2 * (1.f / 256.f) + 1e-6f);
        if (lane < 48) {
            const float4 ga = *(const float4*)(p.g_q + lane * 8), gb = *(const float4*)(p.g_q + lane * 8 + 4);
            uint4 o; o.x = pack_bf16(cq[0] * r1 * ga.x, cq[1] * r1 * ga.y); o.y = pack_bf16(cq[2] * r1 * ga.z, cq[3] * r1 * ga.w);
            o.z = pack_bf16(cq[4] * r1 * gb.x, cq[5] * r1 * gb.y); o.w = pack_bf16(cq[6] * r1 * gb.z, cq[7] * r1 * gb.w);
            *(uint4*)(p.cqn + (size_t)T * 384 + lane * 8) = o;
        }
        if (lane < 32) {
            const float4 ga = *(const float4*)(p.g_kv + lane * 8), gb = *(const float4*)(p.g_kv + lane * 8 + 4);
            float y[8] = {ck[0] * r2 * ga.x, ck[1] * r2 * ga.y, ck[2] * r2 * ga.z, ck[3] * r2 * ga.w, ck[4] * r2 * gb.x, ck[5] * r2 * gb.y, ck[6] * r2 * gb.z, ck[7] * r2 * gb.w};
            uint4 o; o.x = pack_bf16(y[0], y[1]); o.y = pack_bf16(y[2], y[3]); o.z = pack_bf16(y[4], y[5]); o.w = pack_bf16(y[6], y[7]);
            *(uint4*)(p.ckvk + (size_t)ti.keyrow * 256 + lane * 8) = o;
            if (!ti.smp) { float4* d = (float4*)(o_ckv + (size_t)T * 256 + lane * 8); d[0] = make_float4(y[0], y[1], y[2], y[3]); d[1] = make_float4(y[4], y[5], y[6], y[7]); }
        }
        if (lane < 8) {
            float v[8]; unpack8(*(const uint4*)(Pr + 640 + lane * 8), v);
            float y[8];
            if (ti.smp) {
                const int gr = ti.s >> 6, gc = ti.s & 63;
#pragma unroll
                for (int i = 0; i < 4; ++i) {
                    const int pr = lane * 4 + i;
                    const float cs = pr < 16 ? p.ropetab[gr * 16 + pr] : p.ropetab[1024 + gc * 16 + (pr - 16)];
                    const float sn = pr < 16 ? p.ropetab[512 + gr * 16 + pr] : p.ropetab[2048 + gc * 16 + (pr - 16)];
                    y[2 * i] = v[2 * i] * cs - v[2 * i + 1] * sn; y[2 * i + 1] = v[2 * i] * sn + v[2 * i + 1] * cs;
                }
            } else {
#pragma unroll
                for (int i = 0; i < 8; ++i) y[i] = v[i];
                float4* d = (float4*)(o_kr + (size_t)T * 64 + lane * 8); d[0] = make_float4(v[0], v[1], v[2], v[3]); d[1] = make_float4(v[4], v[5], v[6], v[7]);
            }
            uint4 o; o.x = pack_bf16(y[0], y[1]); o.y = pack_bf16(y[2], y[3]); o.z = pack_bf16(y[4], y[5]); o.w = pack_bf16(y[6], y[7]);
            *(uint4*)(p.kropek + (size_t)ti.keyrow * 64 + lane * 8) = o;
        }
        {
            const int ch = lane * 8;
            float y[8];
            { const float4 a = *(const float4*)(p.conv_b + ch), b = *(const float4*)(p.conv_b + ch + 4); y[0] = a.x; y[1] = a.y; y[2] = a.z; y[3] = a.w; y[4] = b.x; y[5] = b.y; y[6] = b.z; y[7] = b.w; }
#pragma unroll
            for (int k = 0; k < 4; ++k) {
                const int s2i = ti.s + k - 2;
                if (s2i >= 0 && s2i < ti.S) {
                    float u[8]; unpack8(*(const uint4*)(p.P + (size_t)(T + k - 2) * 1792 + 704 + ch), u);
                    const float4 a = *(const float4*)(p.conv_w + k * 512 + ch), b = *(const float4*)(p.conv_w + k * 512 + ch + 4);
                    y[0] += a.x * u[0]; y[1] += a.y * u[1]; y[2] += a.z * u[2]; y[3] += a.w * u[3]; y[4] += b.x * u[4]; y[5] += b.y * u[5]; y[6] += b.z * u[6]; y[7] += b.w * u[7];
                }
            }
            uint4 o; o.x = pack_bf16(y[0], y[1]); o.y = pack_bf16(y[2], y[3]); o.z = pack_bf16(y[4], y[5]); o.w = pack_bf16(y[6], y[7]);
            *(uint4*)(p.xc + (size_t)T * 512 + ch) = o;
            *(uint4*)(p.ug + (size_t)T * 512 + ch) = *(const uint4*)(Pr + 1216 + ch);
        }
    }
}

struct EpiVT {
    static constexpr bool PERM = true;
    bf16_t* vT;
    __device__ __forceinline__ void operator()(const pg8::f32x4 (&acc)[2][2][4][2], const pg8::Unit& u, int wr, int wc, int fr, int fq) const {
        const int R0 = u.pn * 256;
        size_t sbase; int Sk, pos0;
        if (R0 < T_CTX) { Sk = 256; pos0 = 0; sbase = (size_t)(R0 >> 8) * 4 * 128 * 256; }
        else { const int uu = R0 - T_CTX; const int sq = uu / 2304; Sk = 2304; pos0 = uu - sq * 2304; sbase = (size_t)T_CTX * 512 + (size_t)sq * 4 * 128 * 2304; }
        bf16_t* vb = vT + sbase + pos0 + wc * 32 + 8 * fq;
#pragma unroll
        for (int ai = 0; ai < 2; ++ai)
#pragma unroll
            for (int m = 0; m < 4; ++m) {
                const int r = u.pm * 256 + ai * 128 + wr * 64 + m * 16 + fr;
                bf16_t* rowp = vb + (size_t)r * Sk;
#pragma unroll
                for (int bj = 0; bj < 2; ++bj) {
                    const pg8::f32x4 v0 = acc[ai][bj][m][0], v1 = acc[ai][bj][m][1];
                    *(uint4*)(rowp + bj * 128) = make_uint4(pack_bf16(v0[0], v0[1]), pack_bf16(v0[2], v0[3]), pack_bf16(v1[0], v1[1]), pack_bf16(v1[2], v1[3]));
                }
            }
    }
};
#define N_G4 (160 * 16)
__device__ void st_gemm234(const Params& p) {
    {
        pg8::TileOrder S; S.nN = 3; S.total = 80 * 3; S.A = (const char*)p.cqn; S.B = (const char*)p.wt_uq; S.tA = (size_t)256 * 384 * 2; S.tB = (size_t)256 * 384 * 2;
        EpiStoreBf16 E; E.O = p.q; E.ldc = 768;
        pg8::gemm_phase<EpiStoreBf16, pg8::TileOrder, true, true>((LAS unsigned char*)smem, 384, 384, 384, S, E);
    }
    {
        pg8::TileOrder S; S.nN = 2; S.total = 88 * 2; S.A = (const char*)p.ckvk; S.B = (const char*)p.wt_ukv; S.tA = (size_t)256 * 256 * 2; S.tB = (size_t)256 * 256 * 2;
        EpiStoreBf16 E; E.O = p.Kn; E.ldc = 512;
        pg8::gemm_phase<EpiStoreBf16, pg8::TileOrder, true, true>((LAS unsigned char*)smem, 256, 256, 256, S, E);
    }
    {
        struct OrderVT {
            const char* W; const char* Kr;
            __device__ __forceinline__ bool next(int i, pg8::Unit& u) const {
                const int item = blockIdx.x + i * gridDim.x; if (item >= 88 * 2) return false;
                const int lt = item >> 3; u.pm = lt & 1; u.pn = (lt >> 1) * 8 + (item & 7);
                u.A = W + (size_t)u.pm * 256 * 256 * 2; u.B = Kr + (size_t)u.pn * 256 * 256 * 2; return true;
            }
        } S; S.W = (const char*)(p.wt_ukv + (size_t)512 * 256); S.Kr = (const char*)p.ckvk;
        EpiVT E; E.vT = p.vT;
        pg8::gemm_phase<EpiVT, OrderVT, true, true>((LAS unsigned char*)smem, 256, 256, 256, S, E);
    }
}

__device__ void st_gates(const Params& p) {
    const int half = tidx() >> 8, lane = tidx() & 63, wid = (tidx() >> 6) & 3, wm = wid >> 1, wn = wid & 1, hl = lane >> 5, cl = lane & 31;
    for (int item = blockIdx.x; item < N_G4 / 2; item += gridDim.x) {
        f32x16 acc[2][2];
        {
            const int lt = (item >> 3) * 2 + half, tj = lt & 3, nb = (lt >> 2) & 3, tm = (lt >> 4) * 8 + (item & 7);
            gemm_acc<2, 2, 2, 2>(p.xc + (size_t)tm * 128 * 512 + nb * 128, 512, p.wt_gate + ((size_t)nb * 512 + tj * 128) * 128, 128, 128, acc);
            const int dir = tj >> 1, dg = (tj & 1) * 2 + wn, ch = nb * 128 + dg * 32 + cl;
            const float brg = p.b_rg[dir * 512 + ch], big = p.b_ig[dir * 512 + ch];
            const float nl = -p.lam[dir * 512 + ch];
            const float sp = fmaxf(nl, 0.f) + log1pf(__expf(-fabsf(nl)));
#pragma unroll
            for (int i = 0; i < 2; ++i)
#pragma unroll
                for (int r = 0; r < 16; ++r) {
                    const int T = tm * 128 + ACC_ROW(2, wm, i, r, hl);
                    const float rg = sigmoidf_(acc[i][0][r] + brg), ig = sigmoidf_(acc[i][1][r] + big);
                    const float la = -8.f * rg * sp;
                    const float av = __expf(la);
                    const float mult = sqrtf(fmaxf(-expm1f(2.f * la), 0.f));
                    const float xv = bf2f(p.xc[(size_t)T * 512 + ch]);
                    p.a[((size_t)T * 2 + dir) * 512 + ch] = av;
                    p.bxb[((size_t)T * 2 + dir) * 512 + ch] = f2bf(mult * ig * xv);
                }
        }
    }
}

#define N_ATT (64 + 256)
#define SCH 64
#define NCHK (T_TOK / SCH)
#define N_S1 (NCHK * 2)
__device__ void scan_s1_item(const Params& p, int it) {
    const int chunk = it >> 1, dc = (it & 1) * 512 + tidx(), dir = dc >> 9, ch = dc & 511;
    const int T0 = chunk * SCH;
    float A = 1.f, B = 0.f;
#pragma unroll 8
    for (int i = 0; i < SCH; ++i) {
        const int T = dir ? (T0 + SCH - 1 - i) : (T0 + i);
        const float av = p.a[((size_t)T * 2 + dir) * 512 + ch], bv = bf2f(p.bxb[((size_t)T * 2 + dir) * 512 + ch]);
        A *= av; B = B * av + bv;
    }
    *(float2*)(p.agg + (((size_t)chunk * 2 + dir) * 512 + ch) * 2) = make_float2(A, B);
}

__device__ __forceinline__ int perm23(int r) { return (r & 0x13) | ((r & 4) << 1) | ((r & 8) >> 1); }
__device__ void attn_item_mfma(const Params& p, int it) {
    int seq, h, qb, Sk, T0, R0; size_t vbase;
    if (it < 64) { seq = it >> 2; h = it & 3; qb = 0; Sk = 256; T0 = seq * 256; R0 = seq * 256; vbase = (size_t)(seq * 4 + h) * 128 * 256; }
    else { const int u = it - 64; seq = u >> 5; h = (u >> 3) & 3; qb = u & 7; Sk = 2304; T0 = T_CTX + seq * 2048 + qb * 256; R0 = T_CTX + seq * 2304; vbase = (size_t)T_CTX * 512 + (size_t)(seq * 4 + h) * 128 * 2304; }
    const int tid = tidx(), lane = tid & 63, wid = tid >> 6, hl = lane >> 5, cl = lane & 31;
    bf16x8_t qf[12];
    {
        const bf16_t* qrow = p.q + (size_t)(T0 + 32 * wid + cl) * 768 + h * 192 + 8 * hl;
#pragma unroll
        for (int ks = 0; ks < 12; ++ks) qf[ks] = __builtin_bit_cast(bf16x8_t, *(const u32x4*)(qrow + 16 * ks));
        if (it >= 64) {
            const int sp = qb * 256 + 32 * wid + cl, gr = sp >> 6, gc = sp & 63;
#pragma unroll
            for (int ks = 8; ks < 12; ++ks) {
                const u32x4 w = __builtin_bit_cast(u32x4, qf[ks]); u32x4 o;
#pragma unroll
                for (int i = 0; i < 4; ++i) {
                    const int pr = 8 * (ks - 8) + 4 * hl + i;
                    const float cs = ks < 10 ? p.ropetab[gr * 16 + pr] : p.ropetab[1024 + gc * 16 + (pr - 16)];
                    const float sn = ks < 10 ? p.ropetab[512 + gr * 16 + pr] : p.ropetab[2048 + gc * 16 + (pr - 16)];
                    const float x0 = __uint_as_float(w[i] << 16), x1 = __uint_as_float(w[i] & 0xffff0000u);
                    o[i] = pack_bf16(x0 * cs - x1 * sn, x0 * sn + x1 * cs);
                }
                qf[ks] = __builtin_bit_cast(bf16x8_t, o);
            }
        }
    }
    f32x16 oacc[4];
#pragma unroll
    for (int d = 0; d < 4; ++d)
#pragma unroll
        for (int r = 0; r < 16; ++r) oacc[d][r] = 0.f;
    float m = -1e30f, lsum = 0.f;
    const bf16_t* gk = p.Kn + (size_t)(R0 + (tid >> 4)) * 512 + h * 128 + (tid & 15) * 8;
    const bf16_t* gr = p.kropek + (size_t)(R0 + (tid >> 3)) * 64 + (tid & 7) * 8;
    const bf16_t* gv = p.vT + vbase + (size_t)(tid >> 3) * Sk + (tid & 7) * 8;
    u32x4 rk[2], rr, rv[2];
    const int nt = Sk >> 6;
#pragma unroll
    for (int i = 0; i < 2; ++i) rk[i] = *(const u32x4*)(gk + (size_t)(32 * i) * 512);
    rr = *(const u32x4*)gr;
#pragma unroll
    for (int i = 0; i < 2; ++i) rv[i] = *(const u32x4*)(gv + (size_t)(64 * i) * Sk);
    __syncthreads();
    for (int t = 0; t < nt; ++t) {
#pragma unroll
        for (int i = 0; i < 2; ++i) *(u32x4*)(smem + ((tid & 15) >> 3) * 8192 + lds_off((tid >> 4) + 32 * i, tid & 7)) = rk[i];
        *(u32x4*)(smem + 16384 + lds_off(tid >> 3, tid & 7)) = rr;
#pragma unroll
        for (int i = 0; i < 2; ++i) *(u32x4*)(smem + 24576 + lds_off((tid >> 3) + 64 * i, tid & 7)) = rv[i];
        __syncthreads();
        if (t + 1 < nt) {
            const size_t ko = (size_t)(t + 1) * 64;
#pragma unroll
            for (int i = 0; i < 2; ++i) rk[i] = *(const u32x4*)(gk + (ko + 32 * i) * 512);
            rr = *(const u32x4*)(gr + ko * 64);
#pragma unroll
            for (int i = 0; i < 2; ++i) rv[i] = *(const u32x4*)(gv + (size_t)(64 * i) * Sk + ko);
        }
        f32x16 sacc[2];
#pragma unroll
        for (int kb = 0; kb < 2; ++kb) {
            __builtin_amdgcn_sched_barrier(0);
#pragma unroll
            for (int r = 0; r < 16; ++r) sacc[kb][r] = 0.f;
            const int krow = 32 * kb + perm23(cl);
#pragma unroll
            for (int ks = 0; ks < 12; ++ks) {
                const bf16x8_t kf = __builtin_bit_cast(bf16x8_t, *(const u32x4*)(smem + (ks >> 2) * 8192 + lds_off(krow, 2 * (ks & 3) + hl)));
                sacc[kb] = __builtin_amdgcn_mfma_f32_32x32x16_bf16(kf, qf[ks], sacc[kb], 0, 0, 0);
            }
        }
        float mx = sacc[0][0];
#pragma unroll
        for (int r = 1; r < 16; ++r) mx = fmaxf(mx, sacc[0][r]);
#pragma unroll
        for (int r = 0; r < 16; ++r) mx = fmaxf(mx, sacc[1][r]);
        mx = fmaxf(mx, __shfl_xor(mx, 32));
        const float mn = fmaxf(m, mx), alpha = __builtin_amdgcn_exp2f(m - mn);
        m = mn;
        float ps = 0.f;
        bf16x8_t pf[2][2];
#pragma unroll
        for (int kb = 0; kb < 2; ++kb)
#pragma unroll
            for (int s2 = 0; s2 < 2; ++s2) {
                float e[8];
#pragma unroll
                for (int j = 0; j < 8; ++j) { e[j] = __builtin_amdgcn_exp2f(sacc[kb][8 * s2 + j] - mn); ps += e[j]; }
                u32x4 w; w.x = pack_bf16(e[0], e[1]); w.y = pack_bf16(e[2], e[3]); w.z = pack_bf16(e[4], e[5]); w.w = pack_bf16(e[6], e[7]);
                pf[kb][s2] = __builtin_bit_cast(bf16x8_t, w);
            }
        lsum = lsum * alpha + ps;
#pragma unroll
        for (int d = 0; d < 4; ++d)
#pragma unroll
            for (int r = 0; r < 16; ++r) oacc[d][r] *= alpha;
#pragma unroll
        for (int d = 0; d < 4; ++d) {
            __builtin_amdgcn_sched_barrier(0);
#pragma unroll
            for (int kb = 0; kb < 2; ++kb)
#pragma unroll
                for (int s2 = 0; s2 < 2; ++s2) {
                    const bf16x8_t vf = __builtin_bit_cast(bf16x8_t, *(const u32x4*)(smem + 24576 + lds_off(32 * d + cl, 4 * kb + 2 * s2 + hl)));
                    oacc[d] = __builtin_amdgcn_mfma_f32_32x32x16_bf16(vf, pf[kb][s2], oacc[d], 0, 0, 0);
                }
        }
        __builtin_amdgcn_sched_barrier(0);
        __syncthreads();
    }
    lsum += __shfl_xor(lsum, 32);
    const float inv = 1.f / lsum;
    bf16_t* dst = p.hbuf + (size_t)(T0 + 32 * wid + cl) * 1024 + h * 128 + 4 * hl;
#pragma unroll
    for (int d = 0; d < 4; ++d)
#pragma unroll
        for (int g = 0; g < 4; ++g) {
            uint2 w; w.x = pack_bf16(oacc[d][4 * g] * inv, oacc[d][4 * g + 1] * inv); w.y = pack_bf16(oacc[d][4 * g + 2] * inv, oacc[d][4 * g + 3] * inv);
            *(uint2*)(dst + 32 * d + 8 * g) = w;
        }
}
__device__ void st_attn_s1(const Params& p) {
    for (int item = blockIdx.x; item < N_ATT + N_S1; item += gridDim.x) {
        if (item < N_ATT) {
            attn_item_mfma(p, N_ATT - 1 - item);
        }
        else scan_s1_item(p, item - N_ATT);
    }
}

__device__ void st_scan3(const Params& p) {
    const int tid = tidx();
    float* hf = (float*)smem;
    float* hb = hf + SCH * 256;
    float* o_lru = p.out + 22282240;
    for (int item = blockIdx.x; item < NCHK * 2; item += gridDim.x) {
        const int chunk = item >> 1, cgp = item & 1, T0 = chunk * SCH;
        const TokInfo ti = tokinfo(T0);
        const int nch = ti.S / SCH, cpos = ti.s / SCH, c0 = chunk - cpos;
        const int dir = tid >> 8, ch = cgp * 256 + (tid & 255);
        float hcur = ti.smp ? p.state_lru[((size_t)ti.b * 2 + dir) * 512 + ch] : 0.f;
        if (dir == 0) { for (int cc = 0; cc < cpos; ++cc) { const float2 ab = *(const float2*)(p.agg + (((size_t)(c0 + cc) * 2 + 0) * 512 + ch) * 2); hcur = ab.x * hcur + ab.y; } }
        else { for (int cc = nch - 1; cc > cpos; --cc) { const float2 ab = *(const float2*)(p.agg + (((size_t)(c0 + cc) * 2 + 1) * 512 + ch) * 2); hcur = ab.x * hcur + ab.y; } }
        __syncthreads();
#pragma unroll 8
        for (int i = 0; i < SCH; ++i) {
            const int tl = dir ? SCH - 1 - i : i, T = T0 + tl;
            const float av = p.a[((size_t)T * 2 + dir) * 512 + ch], bv = bf2f(p.bxb[((size_t)T * 2 + dir) * 512 + ch]);
            hcur = av * hcur + bv;
            (dir ? hb : hf)[tl * 256 + (tid & 255)] = hcur;
        }
        if (!ti.smp) {
            if (dir == 0 && cpos == nch - 1) o_lru[((size_t)ti.b * 2 + 0) * 512 + ch] = hcur;
            if (dir == 1 && cpos == 0) o_lru[((size_t)ti.b * 2 + 1) * 512 + ch] = hcur;
        }
        __syncthreads();
        for (int i = tid; i < SCH * 128; i += NTHR) {
            const int tl = i >> 7, c = (i & 127) * 2, T = T0 + tl, chh = cgp * 256 + c;
            const unsigned ugp = *(const unsigned*)(p.ug + (size_t)T * 512 + chh);
            const float g0 = gelu_tanh(__uint_as_float(ugp << 16)), g1 = gelu_tanh(__uint_as_float(ugp & 0xffff0000u));
            const float2 f = *(const float2*)(hf + tl * 256 + c), bb = *(const float2*)(hb + tl * 256 + c);
            *(unsigned*)(p.hbuf + (size_t)T * 1024 + 512 + chh) = pack_bf16((f.x + bb.x) * g0, (f.y + bb.y) * g1);
        }
    }
}

struct EpiResid {
    static constexpr bool PERM = false;
    const Params* pp; int layer; int first;
    __device__ __forceinline__ void operator()(const pg8::f32x4 (&acc)[2][2][4][2], const pg8::Unit& u, int wr, int wc, int fr, int fq) const {
        const Params& p = *pp;
        const int mi = tokinfo(u.pm * 256).mi;
        const float* gt = modv(p, layer, mi, 2);
#pragma unroll
        for (int bj = 0; bj < 2; ++bj)
#pragma unroll
            for (int n = 0; n < 2; ++n) {
                const int col = u.pn * 256 + bj * 128 + wc * 32 + 16 * n + 4 * fq;
                float4 g = *(const float4*)(gt + col);
                if (!first) { const float4 sp = *(const float4*)(p.s_pool + col); g.x *= sp.x; g.y *= sp.y; g.z *= sp.z; g.w *= sp.w; }
#pragma unroll
                for (int ai = 0; ai < 2; ++ai)
#pragma unroll
                    for (int m = 0; m < 4; ++m) {
                        const int row = u.pm * 256 + ai * 128 + wr * 64 + m * 16 + fr;
                        float* xp = p.xres + (size_t)row * 1024 + col;
                        const float4 x0 = first ? *(const float4*)(x_in_row(p, row) + col) : *(const float4*)xp;
                        const pg8::f32x4 v = acc[ai][bj][m][n];
                        *(float4*)xp = make_float4(x0.x + g.x * v[0], x0.y + g.y * v[1], x0.z + g.z * v[2], x0.w + g.w * v[3]);
                    }
            }
    }
};
__device__ void st_gemm_o(const Params& p) {
    pg8::TileOrder S; S.nN = 4; S.total = 80 * 4; S.A = (const char*)p.hbuf; S.B = (const char*)p.wt_o; S.tA = (size_t)256 * 1024 * 2; S.tB = (size_t)256 * 1024 * 2;
    EpiResid E; E.pp = &p; E.layer = 0; E.first = 1;
    pg8::gemm_phase<EpiResid, pg8::TileOrder, true, true>((LAS unsigned char*)smem, 1024, 1024, 1024, S, E);
}

__device__ void st_gemm_pq(const Params& p, int l) {
    pg8::TileOrder S; S.nN = 8; S.total = 80 * 8; S.A = (const char*)p.hbuf; S.B = (const char*)p.wt_pq[l]; S.tA = (size_t)256 * 1024 * 2; S.tB = (size_t)256 * 1024 * 2;
    EpiStoreBf16 E; E.O = p.qp; E.ldc = 2048;
    pg8::gemm_phase<EpiStoreBf16, pg8::TileOrder, true, true>((LAS unsigned char*)smem, 1024, 1024, 1024, S, E);
}

__device__ __forceinline__ void ce_desc(float& a, float& b) { const float hi = fmaxf(a, b), lo = fminf(a, b); a = hi; b = lo; }
__device__ __forceinline__ void ins16(float (&top)[16], float x) {
#pragma unroll
    for (int i = 0; i < 16; ++i) { const float hi = fmaxf(top[i], x); x = fminf(top[i], x); top[i] = hi; }
}
__device__ __forceinline__ void bitonic_merge16(float (&v)[16]) {
#pragma unroll
    for (int j = 8; j >= 1; j >>= 1)
#pragma unroll
        for (int i = 0; i < 16; ++i) { const int l = i ^ j; if (l > i) ce_desc(v[i], v[l]); }
}
__device__ __forceinline__ void sort16(float (&v)[16]) {
#pragma unroll
    for (int k = 2; k <= 16; k <<= 1)
#pragma unroll
        for (int j = k >> 1; j >= 1; j >>= 1)
#pragma unroll
            for (int i = 0; i < 16; ++i) { const int l = i ^ j; if (l > i) { if ((i & k) == 0) ce_desc(v[i], v[l]); else ce_desc(v[l], v[i]); } }
}
__device__ __forceinline__ void merge_top16(float (&a)[16], const float (&b)[16]) {
#pragma unroll
    for (int i = 0; i < 16; ++i) a[i] = fmaxf(a[i], b[15 - i]);
    bitonic_merge16(a);
}
#define PKV(x) __uint_as_float(__float_as_uint(x) & 0xffffff80u)
#define CAND(i, j) __uint_as_float((__float_as_uint(PKV(top[0][i]) + PKV(top[1][j])) & 0xffffff00u) | (unsigned)((i) * 16 + (j)))
__device__ void st_peer_topk(const Params& p, int l) {
    const int half = tidx() >> 8, lane = tidx() & 63, wid = (tidx() >> 6) & 3, hl = lane >> 5, cl = lane & 31;
    for (int item = blockIdx.x; item < 160 * 8 / 2; item += gridDim.x) {
        const int lt = (item >> 3) * 2 + half, h = lt & 7, tm = (lt >> 3) * 8 + (item & 7);
        const int T = tm * 128 + 32 * wid + cl;
        float top[2][16];
#pragma unroll
        for (int pp = 0; pp < 2; ++pp) {
            f32x16 acc[4][1];
            gemm_acc<4, 1, 1, 4>(p.keysb[l] + (size_t)(h * 2 + pp) * 128 * 128, 128, p.qp + (size_t)tm * 128 * 2048 + h * 256 + pp * 128, 2048, 128, acc);
#pragma unroll
            for (int i = 0; i < 4; ++i) {
                __builtin_amdgcn_sched_barrier(0);
                float g[16];
#pragma unroll
                for (int r = 0; r < 16; ++r) {
                    const int n = ACC_ROW(4, 0, i, r, hl);
                    g[r] = __uint_as_float((__float_as_uint(acc[i][0][r]) & 0xffffff80u) | (unsigned)n);
                }
                sort16(g);
                if (i == 0) {
#pragma unroll
                    for (int r = 0; r < 16; ++r) top[pp][r] = g[r];
                } else merge_top16(top[pp], g);
            }
            __builtin_amdgcn_sched_barrier(0);
            float oth[16];
#pragma unroll
            for (int i = 0; i < 16; ++i) oth[i] = __shfl_xor(top[pp][i], 32);
            merge_top16(top[pp], oth);
        }
        __builtin_amdgcn_sched_barrier(0);
        float fv[16], t2[16];
#pragma unroll
        for (int j = 0; j < 16; ++j) fv[j] = CAND(0, j);
        t2[15] = -INFINITY;
#pragma unroll
        for (int i = 1; i < 16; ++i) t2[i - 1] = CAND(i, 0);
        merge_top16(fv, t2);
        t2[0] = CAND(1, 1); t2[1] = CAND(1, 2); t2[2] = CAND(1, 3); t2[3] = CAND(1, 4); t2[4] = CAND(1, 5); t2[5] = CAND(1, 6); t2[6] = CAND(1, 7);
        t2[7] = CAND(2, 1); t2[8] = CAND(2, 2); t2[9] = CAND(2, 3); t2[10] = CAND(2, 4); t2[11] = CAND(3, 1); t2[12] = CAND(3, 2); t2[13] = CAND(3, 3);
        t2[14] = CAND(4, 1); t2[15] = CAND(4, 2);
        sort16(t2);
        merge_top16(fv, t2);
        ins16(fv, CAND(5, 1)); ins16(fv, CAND(6, 1)); ins16(fv, CAND(7, 1));
        unsigned* tab = (unsigned*)(smem + half * 65536) + (size_t)(tidx() & 255) * 8;
#pragma unroll
        for (int k = 0; k < 4; ++k) {
            tab[k] = (__float_as_uint(top[0][4 * k]) & 127u) | ((__float_as_uint(top[0][4 * k + 1]) & 127u) << 8) | ((__float_as_uint(top[0][4 * k + 2]) & 127u) << 16) | ((__float_as_uint(top[0][4 * k + 3]) & 127u) << 24);
            tab[4 + k] = (__float_as_uint(top[1][4 * k]) & 127u) | ((__float_as_uint(top[1][4 * k + 1]) & 127u) << 8) | ((__float_as_uint(top[1][4 * k + 2]) & 127u) << 16) | ((__float_as_uint(top[1][4 * k + 3]) & 127u) << 24);
        }
        const u8_t* tabb = (const u8_t*)tab;
        int fe[16];
#pragma unroll
        for (int i = 0; i < 16; ++i) {
            const unsigned code = __float_as_uint(fv[i]) & 255u;
            fe[i] = (int)tabb[code >> 4] * 128 + (int)tabb[16 + (code & 15u)];
            fv[i] = __uint_as_float(__float_as_uint(fv[i]) & 0xffffff00u);
        }
        float sum = 0.f, ev[16];
#pragma unroll
        for (int i = 0; i < 16; ++i) { ev[i] = __expf(fv[i] - fv[0]); sum += ev[i]; }
        const float inv = 1.f / sum;
        if (hl == 0) {
            float4* gp = (float4*)(p.gates + (size_t)T * 128 + h * 16); int4* ep = (int4*)(p.eidx + (size_t)T * 128 + h * 16);
#pragma unroll
            for (int i = 0; i < 4; ++i) { gp[i] = make_float4(ev[4 * i] * inv, ev[4 * i + 1] * inv, ev[4 * i + 2] * inv, ev[4 * i + 3] * inv); ep[i] = make_int4(fe[4 * i], fe[4 * i + 1], fe[4 * i + 2], fe[4 * i + 3]); }
        }
    }
}

#define FP4X(dw, b) __builtin_amdgcn_cvt_scalef32_pk_f32_fp4(dw, 1.0f, b)
#define FP4B(dw, b) __builtin_amdgcn_cvt_scalef32_pk_bf16_fp4(dw, 1.0f, b)
__device__ void st_peer_gather(const Params& p, int l) {
    const int lane = tidx() & 63, wid = __builtin_amdgcn_readfirstlane(tidx() >> 6), lp = lane & 31, hf = lane >> 5;
    const u8_t* U = p.u8[l]; const u8_t* V = p.v8[l]; const float* SU = p.su[l]; const float* SV = p.sv[l];
    const int idx4 = ((lane >> 4) & 1) + 2 * ((lane >> 3) & 1);
    const bool b3 = (lane & 8) != 0;
    for (int T = blockIdx.x * NWV + wid; T < T_TOK; T += gridDim.x * NWV) {
        const TokInfo ti = tokinfo(T);
        unsigned hv[16];
        {
            const uint4* hp = (const uint4*)(p.hbuf + (size_t)T * 1024 + lp * 32);
#pragma unroll
            for (int q = 0; q < 4; ++q) { const uint4 t = hp[q]; hv[4 * q] = t.x; hv[4 * q + 1] = t.y; hv[4 * q + 2] = t.z; hv[4 * q + 3] = t.w; }
        }
        const int e0 = p.eidx[(size_t)T * 128 + lane], e1 = p.eidx[(size_t)T * 128 + 64 + lane];
        const float g0 = p.gates[(size_t)T * 128 + lane], g1 = p.gates[(size_t)T * 128 + 64 + lane];
        float outv[32];
#pragma unroll
        for (int j = 0; j < 32; ++j) outv[j] = 0.f;
#pragma unroll 1
        for (int kb = 0; kb < 16; ++kb) {
            const int esel = kb < 8 ? e0 : e1; const float gsel = kb < 8 ? g0 : g1;
            const int kl = (kb & 7) * 8;
            u32x4 ur[4], vr[4];
#pragma unroll
            for (int j = 0; j < 4; ++j) {
                const int ea = __builtin_amdgcn_readlane(esel, kl + 2 * j), eb = __builtin_amdgcn_readlane(esel, kl + 2 * j + 1);
                const int e = hf ? eb : ea;
                const unsigned off = (unsigned)e * 512u + (unsigned)lp * 16u;
                ur[j] = *(const u32x4*)(U + off);
                vr[j] = *(const u32x4*)(V + off);
            }
            const int kmine = kl + 2 * idx4 + hf;
            const int emine = __builtin_amdgcn_ds_bpermute(kmine << 2, esel);
            const float gmine = __int_as_float(__builtin_amdgcn_ds_bpermute(kmine << 2, __float_as_int(gsel)));
            const float su = SU[emine], sv = SV[emine];
            float d[4];
#pragma unroll
            for (int j = 0; j < 4; ++j) {
                float a = 0.f;
#pragma unroll
                for (int q = 0; q < 4; ++q) {
                    a = __builtin_amdgcn_fdot2_f32_bf16(FP4B(ur[j][q], 0), __builtin_bit_cast(bf16x2_t, hv[4 * q]), a, false);
                    a = __builtin_amdgcn_fdot2_f32_bf16(FP4B(ur[j][q], 1), __builtin_bit_cast(bf16x2_t, hv[4 * q + 1]), a, false);
                    a = __builtin_amdgcn_fdot2_f32_bf16(FP4B(ur[j][q], 2), __builtin_bit_cast(bf16x2_t, hv[4 * q + 2]), a, false);
                    a = __builtin_amdgcn_fdot2_f32_bf16(FP4B(ur[j][q], 3), __builtin_bit_cast(bf16x2_t, hv[4 * q + 3]), a, false);
                }
                d[j] = a;
            }
#pragma unroll
            for (int j = 0; j < 4; ++j) { d[j] += DPP_F(d[j], 0xB1); d[j] += DPP_F(d[j], 0x4E); d[j] += DPP_F(d[j], 0x141); }
            float a2[2];
#pragma unroll
            for (int i = 0; i < 2; ++i) { const float snd = b3 ? d[i] : d[i + 2], kp = b3 ? d[i + 2] : d[i]; a2[i] = kp + DPP_F(snd, 0x128); }
            const u32x2 rr = __builtin_amdgcn_permlane16_swap(__float_as_uint(a2[0]), __float_as_uint(a2[1]), false, false);
            const float z = __uint_as_float(rr[0]) + __uint_as_float(rr[1]);
            const float w = gmine * gelu_tanh(z * su) * sv;
#pragma unroll
            for (int j = 0; j < 4; ++j) {
                const int sl = (j & 1) * 16 + ((j >> 1) & 1) * 8;
                const float wa = __int_as_float(__builtin_amdgcn_readlane(__float_as_int(w), sl)), wb = __int_as_float(__builtin_amdgcn_readlane(__float_as_int(w), 32 + sl));
                const float wj = hf ? wb : wa;
#pragma unroll
                for (int q = 0; q < 4; ++q) {
                    const f32x2 x0 = FP4X(vr[j][q], 0), x1 = FP4X(vr[j][q], 1), x2 = FP4X(vr[j][q], 2), x3 = FP4X(vr[j][q], 3);
                    outv[8 * q] += wj * x0.x; outv[8 * q + 1] += wj * x0.y; outv[8 * q + 2] += wj * x1.x; outv[8 * q + 3] += wj * x1.y;
                    outv[8 * q + 4] += wj * x2.x; outv[8 * q + 5] += wj * x2.y; outv[8 * q + 6] += wj * x3.x; outv[8 * q + 7] += wj * x3.y;
                }
            }
        }
        float o16[16];
#pragma unroll
        for (int i = 0; i < 16; ++i) { const u32x2 r = __builtin_amdgcn_permlane32_swap(__float_as_uint(outv[i]), __float_as_uint(outv[i + 16]), false, false); o16[i] = __uint_as_float(r[0]) + __uint_as_float(r[1]); }
        const int cb = lp * 32 + hf * 16;
        float* xr = p.xres + (size_t)T * 1024 + cb;
        const float* gt = modv(p, l, ti.mi, 5) + cb;
        float xn[16]; float ss = 0.f;
#pragma unroll
        for (int j = 0; j < 4; ++j) { const float4 f = *(const float4*)(xr + 4 * j); xn[4 * j] = f.x + gt[4 * j] * o16[4 * j]; xn[4 * j + 1] = f.y + gt[4 * j + 1] * o16[4 * j + 1]; xn[4 * j + 2] = f.z + gt[4 * j + 2] * o16[4 * j + 2]; xn[4 * j + 3] = f.w + gt[4 * j + 3] * o16[4 * j + 3]; }
#pragma unroll
        for (int j = 0; j < 16; ++j) ss += xn[j] * xn[j];
        ss = wave_sum(ss);
        const float rstd = rsqrtf(ss * (1.f / 1024.f) + 1e-6f);
        if (l == 0) {
#pragma unroll
            for (int j = 0; j < 4; ++j) *(float4*)(xr + 4 * j) = make_float4(xn[4 * j], xn[4 * j + 1], xn[4 * j + 2], xn[4 * j + 3]);
            const float* sh = modv(p, 1, ti.mi, 0) + cb; const float* sc = modv(p, 1, ti.mi, 1) + cb; const float* gg = p.g_mix[1] + cb;
            unsigned w[8];
#pragma unroll
            for (int j = 0; j < 8; ++j) {
                const float a0 = xn[2 * j] * rstd * gg[2 * j] * (1.f + sc[2 * j]) + sh[2 * j];
                const float a1 = xn[2 * j + 1] * rstd * gg[2 * j + 1] * (1.f + sc[2 * j + 1]) + sh[2 * j + 1];
                w[j] = pack_bf16(a0, a1);
            }
            uint4* dd = (uint4*)(p.h3 + (size_t)T * 1024 + cb);
            dd[0] = make_uint4(w[0], w[1], w[2], w[3]); dd[1] = make_uint4(w[4], w[5], w[6], w[7]);
        } else {
            const float* gg = p.g_final + cb;
            float* y = p.out + (size_t)T * 1024 + cb;
#pragma unroll
            for (int j = 0; j < 4; ++j) *(float4*)(y + 4 * j) = make_float4(xn[4 * j] * rstd * gg[4 * j], xn[4 * j + 1] * rstd * gg[4 * j + 1], xn[4 * j + 2] * rstd * gg[4 * j + 2], xn[4 * j + 3] * rstd * gg[4 * j + 3]);
        }
    }
}

__device__ void st_pool(const Params& p) {
    const int tid = tidx(), ck = tid & 127, g = ck >> 5, w = 2 << g;
    const int per = (T_TOK + gridDim.x - 1) / gridDim.x, Tb = blockIdx.x * per, Te = min(Tb + per, T_TOK);
    for (int T = Tb + (tid >> 7); T < Te; T += 4) {
        const TokInfo ti = tokinfo(T);
        const int lo = max(ti.s - w / 2, 0), hi = min(ti.s + w / 2, ti.S);
        const bf16_t* base = p.h3 + (size_t)(T - ti.s) * 1024 + ck * 8;
        float acc[8];
#pragma unroll
        for (int j = 0; j < 8; ++j) acc[j] = 0.f;
        for (int t2 = lo; t2 < hi; ++t2) {
            float f[8]; unpack8(*(const uint4*)(base + (size_t)t2 * 1024), f);
#pragma unroll
            for (int j = 0; j < 8; ++j) acc[j] += f[j];
        }
        float c[8]; unpack8(*(const uint4*)(base + (size_t)ti.s * 1024), c);
        const float inv = 1.f / (float)(hi - lo);
        uint4 o;
        o.x = pack_bf16(acc[0] * inv - c[0], acc[1] * inv - c[1]); o.y = pack_bf16(acc[2] * inv - c[2], acc[3] * inv - c[3]);
        o.z = pack_bf16(acc[4] * inv - c[4], acc[5] * inv - c[5]); o.w = pack_bf16(acc[6] * inv - c[6], acc[7] * inv - c[7]);
        *(uint4*)(p.hbuf + (size_t)T * 1024 + ck * 8) = o;
    }
}

__device__ void st_gemm_pool(const Params& p) {
    struct OrderPool {
        const char* A; const char* B;
        __device__ __forceinline__ bool next(int i, pg8::Unit& u) const {
            const int item = blockIdx.x + i * gridDim.x; if (item >= 80 * 4) return false;
            const int lt = item >> 3; u.pn = lt & 3; u.pm = (lt >> 2) * 8 + (item & 7);
            u.A = A + (size_t)u.pm * 256 * 1024 * 2 + (size_t)u.pn * 256 * 2; u.B = B + (size_t)u.pn * 256 * 256 * 2; return true;
        }
    } S; S.A = (const char*)p.hbuf; S.B = (const char*)p.wt_pool;
    EpiResid E; E.pp = &p; E.layer = 1; E.first = 0;
    pg8::gemm_phase<EpiResid, OrderPool, true, true>((LAS unsigned char*)smem, 1024, 256, 256, S, E);
}

__device__ __forceinline__ void run_stage(const Params& p, int s) {
#ifdef ONLY_STAGE
    if (s != ONLY_STAGE) return;
#endif
    switch (s) {
        case 0: st_prologue(p); break;
        case 1: st_norm<0>(p, 0, 0, p.g_mix[0], p.hbuf); break;
        case 2: st_gemm1(p); break;
        case 3: st_postproj(p); break;
        case 4: st_gemm234(p); break;
        case 18: st_gates(p); break;
        case 5: st_attn_s1(p); break;
        case 6: st_scan3(p); break;
        case 7: st_gemm_o(p); break;
        case 8: st_norm<1>(p, 0, 1, p.g_ffn[0], p.hbuf); break;
        case 9: st_gemm_pq(p, 0); break;
        case 10: st_peer_topk(p, 0); break;
        case 11: st_peer_gather(p, 0); break;
        case 12: st_pool(p); break;
        case 13: st_gemm_pool(p); break;
        case 14: st_norm<1>(p, 1, 1, p.g_ffn[1], p.hbuf); break;
        case 15: st_gemm_pq(p, 1); break;
        case 16: st_peer_topk(p, 1); break;
        case 17: st_peer_gather(p, 1); break;
        default: break;
    }
}

__global__ void __launch_bounds__(NTHR, 2) fwd_mega(Params p) {
    cg::grid_group grid = cg::this_grid();
    volatile LAS unsigned* st = (volatile LAS unsigned*)(smem + 131072);
    if (threadIdx.x == 0) { st[0] = 0; st[1] = 0; st[2] = 0; st[3] = 0; }
    wtab_init();
    __syncthreads();
    XcdBarrier b = xcd_barrier_post(p.bar, st);
    if (p.bar == nullptr) grid.sync();
#ifndef REP_MASK
#define REP_MASK 0
#endif
#define MK_ST(k) run_stage(p, k); if ((REP_MASK >> (k)) & 1) { xcd_barrier(b); run_stage(p, k); } if ((k) != 17) xcd_barrier(b);
    MK_ST(0) MK_ST(1) MK_ST(2) MK_ST(3) run_stage(p, 4); MK_ST(18) MK_ST(5) MK_ST(6) MK_ST(7) MK_ST(8) MK_ST(9) MK_ST(10) MK_ST(11) MK_ST(12) MK_ST(13) MK_ST(14) MK_ST(15) MK_ST(16) MK_ST(17)
}

extern "C" void kernel_launch(void* const* d_in, const int* in_sizes, int n_in, void* d_out, int out_size, void* d_ws, size_t ws_size, hipStream_t stream) {
    constexpr size_t kDynLds = 131072 + 512;
    static int grid_blocks = 0;
    if (!grid_blocks) {
        int dev = 0, cus = 0, per_cu = 0;
        (void)hipGetDevice(&dev);
        (void)hipDeviceGetAttribute(&cus, hipDeviceAttributeMultiprocessorCount, dev);
        (void)hipFuncSetAttribute((const void*)fwd_mega, hipFuncAttributeMaxDynamicSharedMemorySize, (int)kDynLds);
        (void)hipOccupancyMaxActiveBlocksPerMultiprocessor(&per_cu, fwd_mega, NTHR, kDynLds);
        if (per_cu > 1) per_cu = 1;
        if (per_cu < 1) per_cu = 1;
        grid_blocks = cus * per_cu;
    }
    Params p{};
    const float* const* in = (const float* const*)d_in;
    p.x_prompt = in[0]; p.x_sample = in[1]; p.cache_ckv = in[2]; p.cache_krope = in[3]; p.state_lru = in[4]; p.c = in[5]; p.c_ctx = in[6];
    p.w_mod[0] = in[7]; p.b_mod[0] = in[8]; p.w_mod[1] = in[9]; p.b_mod[1] = in[10];
    p.g_mix[0] = in[11]; p.g_ffn[0] = in[12]; p.g_mix[1] = in[13]; p.g_ffn[1] = in[14];
    p.w_in = in[15]; p.g_q = in[16]; p.w_uq = in[17]; p.g_kv = in[18]; p.w_ukv = in[19]; p.conv_w = in[20]; p.conv_b = in[21];
    p.w_rg = in[22]; p.b_rg = in[23]; p.w_ig = in[24]; p.b_ig = in[25]; p.lam = in[26]; p.w_o = in[27]; p.w_pool = in[28]; p.s_pool = in[29];
    p.peer_wq[0] = in[30]; p.peer_keys[0] = in[31]; p.peer_u[0] = in[32]; p.peer_v[0] = in[33];
    p.peer_wq[1] = in[34]; p.peer_keys[1] = in[35]; p.peer_u[1] = in[36]; p.peer_v[1] = in[37];
    p.g_final = in[38];
    p.out = (float*)d_out;
    char* base = (char*)d_ws; size_t off = 0;
    auto take = [&](size_t bytes) { char* r = base + off; off += (bytes + 255) & ~(size_t)255; return r; };
    const size_t MiB = 1u << 20;
    p.bar = (unsigned*)take(16384);
    p.mod = (float*)take((size_t)2 * 9 * 6144 * 4);
    p.ropetab = (float*)take(3072 * 4);
    p.wt_in = (bf16_t*)take((size_t)NW_IN * 2); p.wt_uq = (bf16_t*)take((size_t)NW_UQ * 2); p.wt_ukv = (bf16_t*)take((size_t)NW_UKV * 2);
    p.wt_gate = (bf16_t*)take((size_t)NW_GATE * 2); p.wt_o = (bf16_t*)take((size_t)NW_O * 2); p.wt_pool = (bf16_t*)take((size_t)NW_POOL * 2);
    p.wt_pq[0] = (bf16_t*)take((size_t)NW_PQ * 2); p.wt_pq[1] = (bf16_t*)take((size_t)NW_PQ * 2);
    p.keysb[0] = (bf16_t*)take((size_t)NW_KEYS * 2); p.keysb[1] = (bf16_t*)take((size_t)NW_KEYS * 2);
    for (int l = 0; l < 2; ++l) { p.u8[l] = (u8_t*)take(16 * MiB); p.v8[l] = (u8_t*)take(16 * MiB); p.su[l] = (float*)take(65536); p.sv[l] = (float*)take(65536); }
    char* regX = take(80 * MiB);
    char* regQ = take(80 * MiB);
    char* regH = take(40 * MiB);
    p.P = (bf16_t*)regX; p.a = (float*)regX; p.xres = (float*)regX;
    p.bxb = (bf16_t*)regQ; p.q = (bf16_t*)(regQ + 40 * MiB); p.agg = (float*)(regQ + 70 * MiB); p.qp = (bf16_t*)regQ; p.h3 = (bf16_t*)regQ;
    p.hbuf = (bf16_t*)regH;
    p.cqn = (bf16_t*)take((size_t)T_TOK * 384 * 2); p.ckvk = (bf16_t*)take((size_t)R_KEYS * 256 * 2); p.kropek = (bf16_t*)take((size_t)R_KEYS * 64 * 2);
    p.xc = (bf16_t*)take((size_t)T_TOK * 512 * 2); p.ug = (bf16_t*)take((size_t)T_TOK * 512 * 2);
    p.Kn = (bf16_t*)take((size_t)R_KEYS * 512 * 2); p.vT = (bf16_t*)take((size_t)R_KEYS * 512 * 2);
    p.gates = (float*)p.Kn; p.eidx = (int*)((char*)p.Kn + (size_t)T_TOK * 128 * 4);
    if (off > ws_size) fprintf(stderr, "workspace too small: need %zu have %zu\n", off, ws_size);
    (void)hipMemsetAsync(d_ws, 0, 16384, stream);
    void* args[] = {&p};
    hipError_t e = hipLaunchCooperativeKernel((void*)fwd_mega, dim3(grid_blocks), dim3(NTHR), args, kDynLds, stream);
    if (e != hipSuccess) fprintf(stderr, "cooperative launch failed: %s (grid %d)\n", hipGetErrorString(e), grid_blocks);
}
```

```cpp
#include <hip/hip_runtime.h>
#include <hip/hip_cooperative_groups.h>
#include <cstdio>
#include <cstdint>
namespace cg = cooperative_groups;


typedef unsigned short bf16_t;
typedef unsigned char u8_t;
typedef float f32x16 __attribute__((ext_vector_type(16)));
typedef float f32x2 __attribute__((ext_vector_type(2)));
typedef unsigned u32x4 __attribute__((ext_vector_type(4)));
typedef float f32x4v __attribute__((ext_vector_type(4)));

#define T_TOK 20480
#define T_CTX 4096
#define R_KEYS 22528
#define NSTAGE 19
#define NTHR 512
#define NWV 8
#define LAS __attribute__((address_space(3)))

#define XB_TMO      128
#define XB_XCNT(j)  (256  + 64 * (j))
#define XB_XSUB(j)  (1280 + 64 * (j))
#define XB_XGEN(j)  (2304 + 64 * (j))
#define XB_TOP      3328
#define XB_TOPGEN   3392
#define XCD_BAR_WORDS 3456
#define XB_SPIN_CAP (1u << 22)
__device__ __forceinline__ unsigned xb_ld(unsigned* p)              { return __hip_atomic_load(p, __ATOMIC_RELAXED, __HIP_MEMORY_SCOPE_AGENT); }
__device__ __forceinline__ unsigned xb_add(unsigned* p, unsigned v) { return __hip_atomic_fetch_add(p, v, __ATOMIC_RELAXED, __HIP_MEMORY_SCOPE_AGENT); }
__device__ __forceinline__ unsigned xb_xcc_id() { return (unsigned)__builtin_amdgcn_s_getreg((3 << 11) | 20) & 0xFu; }
#define XB_SPIN(cond, bar) do { unsigned _sp = 0; while (cond) { __builtin_amdgcn_s_sleep(1); \
    if ((++_sp & 255u) == 0u) { if (xb_ld(&(bar)[XB_TMO])) break; if (_sp > XB_SPIN_CAP) { atomicAdd(&(bar)[XB_TMO], 1u); break; } } } } while (0)
struct XcdBarrier { unsigned* bar; unsigned x; volatile LAS unsigned* st; };
__device__ __forceinline__ XcdBarrier xcd_barrier_post(unsigned* bar, volatile LAS unsigned* st) {
    XcdBarrier b; b.bar = bar; b.x = xb_xcc_id(); b.st = st;
    if (threadIdx.x == 0) (void)xb_add(&bar[XB_XCNT(b.x)], 1u);
    return b;
}
__device__ __forceinline__ void xcd_barrier_complete(unsigned* bar, unsigned x, unsigned& nloc, unsigned& nx) {
    const unsigned G = gridDim.x * gridDim.y * gridDim.z;
    unsigned sum, cnt, mine, sp = 0u;
    for (;;) {
        sum = 0u; cnt = 0u; mine = 0u;
#pragma unroll
        for (unsigned j = 0; j < 16; ++j) { const unsigned c = xb_ld(&bar[XB_XCNT(j)]); sum += c; cnt += (c > 0u) ? 1u : 0u; mine = (j == x) ? c : mine; }
        if (sum == G) break;
        __builtin_amdgcn_s_sleep(1);
        if ((++sp & 255u) == 0u) { if (xb_ld(&bar[XB_TMO])) break; if (sp > XB_SPIN_CAP) { atomicAdd(&bar[XB_TMO], 1u); break; } }
    }
    nloc = mine > 0u ? mine : 1u; nx = cnt > 0u ? cnt : 1u;
}
__device__ __forceinline__ int tidx();
__device__ __forceinline__ void xcd_barrier(const XcdBarrier& b) {
    asm volatile("s_waitcnt vmcnt(0)" ::: "memory");
    __syncthreads();
    if (tidx() == 0) {
        unsigned* bar = b.bar;
        __builtin_amdgcn_s_waitcnt(0);
        unsigned nloc = b.st[0], nx = b.st[1];
        if (nloc == 0u) { xcd_barrier_complete(bar, b.x, nloc, nx); b.st[0] = nloc; b.st[1] = nx; }
        const unsigned old = xb_add(&bar[XB_XSUB(b.x)], 1u);
        const unsigned gen = old / nloc;
        if (old + 1u == (gen + 1u) * nloc) {
            __builtin_amdgcn_fence(__ATOMIC_RELEASE, "agent");
            asm volatile("s_waitcnt vmcnt(0)" ::: "memory");
            const unsigned og = xb_add(&bar[XB_TOP], 1u);
            const unsigned tg = og / nx;
            if (og + 1u == (tg + 1u) * nx) xb_add(&bar[XB_TOPGEN], 1u);
            else XB_SPIN(xb_ld(&bar[XB_TOPGEN]) == tg, bar);
            __builtin_amdgcn_fence(__ATOMIC_ACQUIRE, "agent");
            xb_add(&bar[XB_XGEN(b.x)], 1u);
            asm volatile("s_waitcnt vmcnt(0)" ::: "memory");
        } else {
            XB_SPIN(xb_ld(&bar[XB_XGEN(b.x)]) == gen, bar);
            __builtin_amdgcn_fence(__ATOMIC_ACQUIRE, "agent");
            asm volatile("s_waitcnt vmcnt(0)" ::: "memory");
        }
    }
    __syncthreads();
}

struct Params {
    const float *x_prompt, *x_sample, *cache_ckv, *cache_krope, *state_lru, *c, *c_ctx;
    const float *w_mod[2], *b_mod[2], *g_mix[2], *g_ffn[2];
    const float *w_in, *g_q, *w_uq, *g_kv, *w_ukv, *conv_w, *conv_b, *w_rg, *b_rg, *w_ig, *b_ig, *lam, *w_o, *w_pool, *s_pool;
    const float *peer_wq[2], *peer_keys[2], *peer_u[2], *peer_v[2];
    const float* g_final;
    float* out;
    unsigned* bar; float* mod; float* ropetab;
    bf16_t *wt_in, *wt_uq, *wt_ukv, *wt_gate, *wt_o, *wt_pool, *wt_pq[2], *keysb[2];
    u8_t *u8[2], *v8[2]; float *su[2], *sv[2];
    bf16_t *hbuf, *P, *cqn, *ckvk, *kropek, *xc, *ug, *q, *Kn, *vT, *bxb, *qp, *h3;
    float *a, *agg, *xres, *gates; int* eidx;
    bf16_t* mix;
};

extern __shared__ __attribute__((aligned(16))) unsigned char smem[];
#define WTAB_OFF (131072 + 64)
__device__ __forceinline__ int hw_wave_slot() { return (int)(__builtin_amdgcn_s_getreg(0x2804) & 63u); }
__device__ __forceinline__ void wtab_init() { if ((threadIdx.x & 63) == 0) ((volatile int*)(smem + WTAB_OFF))[hw_wave_slot()] = (int)(threadIdx.x >> 6); }
__device__ __forceinline__ int tidx() {
    const int w = __builtin_amdgcn_readfirstlane(((volatile int*)(smem + WTAB_OFF))[hw_wave_slot()]);
    return (w << 6) | (int)__builtin_amdgcn_mbcnt_hi(~0u, __builtin_amdgcn_mbcnt_lo(~0u, 0u));
}
__device__ __forceinline__ float bf2f(bf16_t v) { return __uint_as_float(((unsigned)v) << 16); }
typedef __bf16 bf16x2_t __attribute__((ext_vector_type(2)));
__device__ __forceinline__ bf16_t f2bf(float f) { return __builtin_bit_cast(unsigned short, (__bf16)f); }
__device__ __forceinline__ unsigned pack_bf16(float a, float b) { bf16x2_t v = {(__bf16)a, (__bf16)b}; return __builtin_bit_cast(unsigned, v); }
typedef unsigned u32x2 __attribute__((ext_vector_type(2)));
#define DPP_F(v, ctrl) __int_as_float(__builtin_amdgcn_update_dpp(0, __float_as_int(v), ctrl, 0xf, 0xf, true))
__device__ __forceinline__ float wave_sum(float v) {
    v += DPP_F(v, 0xB1); v += DPP_F(v, 0x4E); v += DPP_F(v, 0x141); v += DPP_F(v, 0x128);
    u32x2 r = __builtin_amdgcn_permlane16_swap(__float_as_uint(v), __float_as_uint(v), false, false);
    v = __uint_as_float(r[0]) + __uint_as_float(r[1]);
    r = __builtin_amdgcn_permlane32_swap(__float_as_uint(v), __float_as_uint(v), false, false);
    return __uint_as_float(r[0]) + __uint_as_float(r[1]);
}
__device__ __forceinline__ float wave_max(float v) {
    v = fmaxf(v, DPP_F(v, 0xB1)); v = fmaxf(v, DPP_F(v, 0x4E)); v = fmaxf(v, DPP_F(v, 0x141)); v = fmaxf(v, DPP_F(v, 0x128));
    u32x2 r = __builtin_amdgcn_permlane16_swap(__float_as_uint(v), __float_as_uint(v), false, false);
    v = fmaxf(__uint_as_float(r[0]), __uint_as_float(r[1]));
    r = __builtin_amdgcn_permlane32_swap(__float_as_uint(v), __float_as_uint(v), false, false);
    return fmaxf(__uint_as_float(r[0]), __uint_as_float(r[1]));
}
__device__ __forceinline__ float gelu_tanh(float x) {
    const float u = 0.7978845608028654f * (x + 0.044715f * x * x * x);
    const float e = __expf(2.f * u);
    const float th = 1.f - 2.f / (e + 1.f);
    return 0.5f * x * (1.f + th);
}
__device__ __forceinline__ float sigmoidf_(float x) { return 1.f / (1.f + __expf(-x)); }
__device__ __forceinline__ float silu_(float x) { return x / (1.f + __expf(-x)); }

struct TokInfo { int smp, b, s, S, mi, keyrow; };
__device__ __forceinline__ TokInfo tokinfo(int T) {
    TokInfo t;
    if (T < T_CTX) { t.smp = 0; t.b = T >> 8; t.s = T & 255; t.S = 256; t.mi = 0; t.keyrow = T; }
    else { const int u = T - T_CTX; t.smp = 1; t.b = u >> 11; t.s = u & 2047; t.S = 2048; t.mi = 1 + t.b; t.keyrow = T_CTX + t.b * 2304 + 256 + t.s; }
    return t;
}
__device__ __forceinline__ const float* x_in_row(const Params& p, int T) { return T < T_CTX ? p.x_prompt + (size_t)T * 1024 : p.x_sample + (size_t)(T - T_CTX) * 1024; }
__device__ __forceinline__ const float* modv(const Params& p, int l, int mi, int j) { return p.mod + ((size_t)(l * 9 + mi) * 6 + j) * 1024; }

__device__ __forceinline__ void unpack8(const uint4 r, float (&f)[8]) {
    f[0] = __uint_as_float(r.x << 16); f[1] = __uint_as_float(r.x & 0xffff0000u);
    f[2] = __uint_as_float(r.y << 16); f[3] = __uint_as_float(r.y & 0xffff0000u);
    f[4] = __uint_as_float(r.z << 16); f[5] = __uint_as_float(r.z & 0xffff0000u);
    f[6] = __uint_as_float(r.w << 16); f[7] = __uint_as_float(r.w & 0xffff0000u);
}

namespace pg8 {
typedef short bf16x8 __attribute__((ext_vector_type(8)));
typedef float f32x4 __attribute__((ext_vector_type(4)));
constexpr int BM = 256, BK = 64, HALF = 128, HTB = HALF * BK * 2  , STAGE_BYTES = 8 * HTB;
__device__ __forceinline__ int lds_byte(int r, int c) { const int st = (r >> 4) * 2 + (c >> 5), rr = r & 15, cc = c & 31, ob = rr * 64 + cc * 2; return st * 1024 + (ob ^ (((ob >> 9) & 1) << 5)); }
__device__ __forceinline__ void stage_rc(int b, int& R, int& C) { const int st = b / 1024, sb = b % 1024, swz = sb ^ (((sb >> 9) & 1) << 5); R = (st >> 1) * 16 + swz / 64; C = (st & 1) * 32 + (swz % 64) / 2; }
__device__ __forceinline__ int perm32(int rho) { const int n = rho >> 4, i = rho & 15; return 8 * (i >> 2) + 4 * n + (i & 3); }
struct Unit { int pm, pn; const char* A; const char* B; };
template <class Epi, class Sched, bool ALIGN_EPI, bool SP2>
__device__ __forceinline__ void gemm_phase(LAS unsigned char* lds, const int lda, const int ldb, const int K, const Sched& S, const Epi& E) {
    __builtin_amdgcn_sched_barrier(0);
    const int tid = tidx(), wid = __builtin_amdgcn_readfirstlane(tid >> 6), lane = tid & 63, wr = wid >> 2, wc = wid & 3, fr = lane & 15, fq = lane >> 4;
    const int nt = K / BK;
    unsigned voffA[2], voffB[2];
#pragma unroll
    for (int i = 0; i < 2; ++i) { int R, C; stage_rc(tid * 16 + i * 8192, R, C); const int Rb = Epi::PERM ? ((R & ~31) + perm32(R & 31)) : R;
        voffA[i] = (unsigned)(R * lda + C) * 2u; voffB[i] = (unsigned)(Rb * ldb + C) * 2u; }
    const size_t kstep = (size_t)(BK * 2);
    const size_t hstepA = (size_t)HALF * lda * 2, hstepB = (size_t)HALF * ldb * 2;
    const unsigned ldsw = (unsigned)wid * 1024u;
    const int aoff = lds_byte(wr * 64 + fr, fq * 8), boff = lds_byte(wc * 32 + fr, fq * 8);
#define PG8_SA(b, h) (((b) * 2 + (h)) * HTB)
#define PG8_SB(b, h) ((4 + (b) * 2 + (h)) * HTB)
#define PG8_STAGE(bufoff, gbase, voff) do { _Pragma("unroll") for (int _i = 0; _i < 2; ++_i) \
        __builtin_amdgcn_global_load_lds((const unsigned*)((const char*)(gbase) + (voff)[_i]), (LAS unsigned*)(lds + (bufoff) + ldsw + _i * 8192), 16, 0, 0); } while (0)
#define PG8_LDA(dst, b, h) do { _Pragma("unroll") for (int m = 0; m < 4; ++m) _Pragma("unroll") for (int k = 0; k < 2; ++k) dst[m][k] = *(const LAS bf16x8*)(lds + PG8_SA(b, h) + aoff + m * 2048 + k * 1024); } while (0)
#define PG8_LDB(dst, b, h) do { _Pragma("unroll") for (int n = 0; n < 2; ++n) _Pragma("unroll") for (int k = 0; k < 2; ++k) dst[n][k] = *(const LAS bf16x8*)(lds + PG8_SB(b, h) + boff + n * 2048 + k * 1024); } while (0)
#define PG8_MMA(ai, bj, At, Bt) do { __builtin_amdgcn_s_setprio(1); _Pragma("unroll") for (int m = 0; m < 4; ++m) _Pragma("unroll") for (int n = 0; n < 2; ++n) _Pragma("unroll") for (int k = 0; k < 2; ++k) \
        acc[ai][bj][m][n] = __builtin_amdgcn_mfma_f32_16x16x32_bf16(Bt[n][k], At[m][k], acc[ai][bj][m][n], 0, 0, 0); __builtin_amdgcn_s_setprio(0); } while (0)
#define PG8_WAIT_V(n) asm volatile("s_waitcnt vmcnt(" #n ")" ::: "memory")
#define PG8_WAIT_L(n) asm volatile("s_waitcnt lgkmcnt(" #n ")" ::: "memory")
#define PG8_BAR __builtin_amdgcn_s_barrier()
#define PG8_SCHED __builtin_amdgcn_sched_barrier(0)
    Unit cur, nxt; int ui = 0;
    if (!S.next(0, cur)) return;
    f32x4 acc[2][2][4][2];
#pragma unroll
    for (int a = 0; a < 2; ++a)
#pragma unroll
        for (int b = 0; b < 2; ++b)
#pragma unroll
            for (int m = 0; m < 4; ++m)
#pragma unroll
                for (int n = 0; n < 2; ++n) acc[a][b][m][n] = (f32x4){0.f, 0.f, 0.f, 0.f};
    bf16x8 At[4][2], B0[2][2], B1[2][2];
    const char* cA = cur.A; const char* cB = cur.B;
    if constexpr (SP2) {
        PG8_STAGE(PG8_SB(0, 0), cB, voffB); PG8_STAGE(PG8_SB(0, 1), cB + hstepB, voffB); PG8_STAGE(PG8_SA(0, 0), cA, voffA); PG8_STAGE(PG8_SA(0, 1), cA + hstepA, voffA);
        if (wr == 1) PG8_BAR;
        PG8_WAIT_V(2); PG8_BAR;
        PG8_STAGE(PG8_SB(1, 0), cB + kstep, voffB); PG8_STAGE(PG8_SA(1, 0), cA + kstep, voffA); PG8_STAGE(PG8_SB(1, 1), cB + hstepB + kstep, voffB);
        PG8_WAIT_V(6); PG8_BAR;
    } else {
        PG8_STAGE(PG8_SB(0, 0), cB, voffB); PG8_STAGE(PG8_SA(0, 0), cA, voffA); PG8_STAGE(PG8_SB(0, 1), cB + hstepB, voffB); PG8_STAGE(PG8_SA(0, 1), cA + hstepA, voffA);
        if (wr == 1) PG8_BAR;
        PG8_WAIT_V(4); PG8_BAR;
        PG8_STAGE(PG8_SB(1, 0), cB + kstep, voffB); PG8_STAGE(PG8_SA(1, 0), cA + kstep, voffA); PG8_STAGE(PG8_SB(1, 1), cB + hstepB + kstep, voffB);
        PG8_WAIT_V(6); PG8_BAR;
    }
    for (;;) {
        const bool has_next = S.next(ui + 1, nxt);
        const char* nA = has_next ? nxt.A : cA; const char* nB = has_next ? nxt.B : cB;
#pragma unroll 1
        for (int t = 0; t < nt; t += 2) {
            const bool last = (t == nt - 2);
            const char* a1 = cA + (size_t)(t + 1) * kstep;
            const char* a2 = last ? nA : cA + (size_t)(t + 2) * kstep; const char* b2 = last ? nB : cB + (size_t)(t + 2) * kstep;
            const char* a3 = a2 + kstep; const char* b3 = b2 + kstep;
            if constexpr (SP2) {
            PG8_LDB(B0, 0, 0); PG8_LDB(B1, 0, 1); PG8_SCHED; PG8_LDA(At, 0, 0); PG8_STAGE(PG8_SA(1, 1), a1 + hstepA, voffA);
            PG8_WAIT_V(8); PG8_WAIT_L(0); PG8_BAR; PG8_MMA(0, 0, At, B0); PG8_MMA(0, 1, At, B1); PG8_BAR; PG8_SCHED;
            PG8_LDA(At, 0, 1); PG8_STAGE(PG8_SB(0, 0), b2, voffB); PG8_STAGE(PG8_SB(0, 1), b2 + hstepB, voffB); PG8_STAGE(PG8_SA(0, 0), a2, voffA);
            PG8_WAIT_V(8); PG8_WAIT_L(0); PG8_BAR; PG8_MMA(1, 0, At, B0); PG8_MMA(1, 1, At, B1); PG8_BAR; PG8_SCHED;
            PG8_LDB(B0, 1, 0); PG8_LDB(B1, 1, 1); PG8_SCHED; PG8_LDA(At, 1, 0); PG8_STAGE(PG8_SA(0, 1), a2 + hstepA, voffA);
            PG8_WAIT_V(8); PG8_WAIT_L(0); PG8_BAR; PG8_MMA(0, 0, At, B0); PG8_MMA(0, 1, At, B1); PG8_BAR; PG8_SCHED;
            PG8_LDA(At, 1, 1); PG8_STAGE(PG8_SB(1, 0), b3, voffB); PG8_STAGE(PG8_SB(1, 1), b3 + hstepB, voffB); PG8_STAGE(PG8_SA(1, 0), a3, voffA);
            PG8_WAIT_V(8); PG8_WAIT_L(0); PG8_BAR; PG8_MMA(1, 0, At, B0); PG8_MMA(1, 1, At, B1); PG8_BAR; PG8_SCHED;
            } else {
            PG8_LDB(B0, 0, 0); PG8_SCHED; PG8_LDA(At, 0, 0); PG8_STAGE(PG8_SA(1, 1), a1 + hstepA, voffA);
            PG8_WAIT_L(8); PG8_BAR; PG8_WAIT_L(0); PG8_MMA(0, 0, At, B0); PG8_BAR; PG8_SCHED;
            PG8_LDB(B1, 0, 1); PG8_STAGE(PG8_SB(0, 0), b2, voffB);
            PG8_BAR; PG8_WAIT_L(0); PG8_MMA(0, 1, At, B1); PG8_BAR;
            PG8_LDA(At, 0, 1); PG8_STAGE(PG8_SA(0, 0), a2, voffA);
            PG8_BAR; PG8_WAIT_L(0); PG8_MMA(1, 0, At, B0); PG8_BAR; PG8_SCHED;
            PG8_STAGE(PG8_SB(0, 1), b2 + hstepB, voffB);
            PG8_WAIT_V(6); PG8_BAR; PG8_MMA(1, 1, At, B1); PG8_BAR;
            PG8_LDB(B0, 1, 0); PG8_SCHED; PG8_LDA(At, 1, 0); PG8_STAGE(PG8_SA(0, 1), a2 + hstepA, voffA);
            PG8_WAIT_L(8); PG8_BAR; PG8_WAIT_L(0); PG8_MMA(0, 0, At, B0); PG8_BAR; PG8_SCHED;
            PG8_LDB(B1, 1, 1); PG8_STAGE(PG8_SB(1, 0), b3, voffB);
            PG8_BAR; PG8_WAIT_L(0); PG8_MMA(0, 1, At, B1); PG8_BAR;
            PG8_LDA(At, 1, 1); PG8_STAGE(PG8_SA(1, 0), a3, voffA);
            PG8_BAR; PG8_WAIT_L(0); PG8_MMA(1, 0, At, B0); PG8_BAR; PG8_SCHED;
            PG8_STAGE(PG8_SB(1, 1), b3 + hstepB, voffB);
            PG8_WAIT_V(6); PG8_BAR; PG8_MMA(1, 1, At, B1); PG8_BAR;
            }
        }
        if constexpr (ALIGN_EPI) { if (wr == 0) PG8_BAR; }
        E(acc, cur, wr, wc, fr, fq);
        if (!has_next) break;
#pragma unroll
        for (int a = 0; a < 2; ++a)
#pragma unroll
            for (int b = 0; b < 2; ++b)
#pragma unroll
                for (int m = 0; m < 4; ++m)
#pragma unroll
                    for (int n = 0; n < 2; ++n) acc[a][b][m][n] = (f32x4){0.f, 0.f, 0.f, 0.f};
        cur = nxt; cA = nA; cB = nB; ++ui;
        if constexpr (ALIGN_EPI) { if (wr == 1) PG8_BAR; }
    }
    PG8_WAIT_V(0);
    if constexpr (!ALIGN_EPI) { if (wr == 0) PG8_BAR; }
    PG8_BAR;
    __builtin_amdgcn_sched_barrier(0);
#undef PG8_SA
#undef PG8_SB
#undef PG8_STAGE
#undef PG8_LDA
#undef PG8_LDB
#undef PG8_MMA
#undef PG8_WAIT_V
#undef PG8_WAIT_L
#undef PG8_BAR
#undef PG8_SCHED
}
struct TileOrder {
    int nN, total; const char* A; const char* B; size_t tA, tB;
    __device__ __forceinline__ bool next(int i, Unit& u) const {
        const int item = blockIdx.x + i * gridDim.x; if (item >= total) return false;
        const int lt = item >> 3; u.pn = lt % nN; u.pm = (lt / nN) * 8 + (item & 7);
        u.A = A + (size_t)u.pm * tA; u.B = B + (size_t)u.pn * tB; return true;
    }
};
}

typedef __bf16 bf16x8_t __attribute__((ext_vector_type(8)));
__device__ __forceinline__ int lds_off(int row, int chunk) { return row * 128 + ((chunk ^ ((row >> 1) & 7)) << 4); }
template <int TM, int TN, int WM, int WN>
__device__ __forceinline__ void gemm_acc(const bf16_t* __restrict__ As, int lda, const bf16_t* __restrict__ Bs, int ldb, int K, f32x16 (&acc)[TM][TN]) {
    static_assert(TM * WM == 4 && TN * WN == 4 && WM * WN == 4, "tile is 128 x 128, 4 waves");
    const int tid = tidx() & 255, lane = tid & 63, wid = tid >> 6, wm = wid / WN, wn = wid % WN, hl = lane >> 5, cl = lane & 31;
    unsigned char* sm = smem + (tidx() >> 8) * 65536;
#pragma unroll
    for (int i = 0; i < TM; ++i)
#pragma unroll
        for (int j = 0; j < TN; ++j)
#pragma unroll
            for (int r = 0; r < 16; ++r) acc[i][j][r] = 0.f;
    const int srow0 = wid * 32 + (lane >> 3), pc = lane & 7;
    const bf16_t* ga[4]; const bf16_t* gb[4];
#pragma unroll
    for (int i = 0; i < 4; ++i) {
        const int row = srow0 + 8 * i, lc = pc ^ ((row >> 1) & 7);
        ga[i] = As + (size_t)row * lda + lc * 8; gb[i] = Bs + (size_t)row * ldb + lc * 8;
    }
    unsigned char* lbase = sm + wid * 4096 + lane * 16;
    __syncthreads();
#pragma unroll
    for (int i = 0; i < 4; ++i) {
        __builtin_amdgcn_global_load_lds((const unsigned*)ga[i], (unsigned*)(lbase + i * 1024), 16, 0, 0);
        __builtin_amdgcn_global_load_lds((const unsigned*)gb[i], (unsigned*)(lbase + 16384 + i * 1024), 16, 0, 0);
    }
    asm volatile("s_waitcnt vmcnt(0)" ::: "memory");
    __syncthreads();
    const int nk = K >> 6;
    for (int kt = 0; kt < nk; ++kt) {
        const int cur = (kt & 1) * 32768, nxt = 32768 - cur;
        if (kt + 1 < nk) {
#pragma unroll
            for (int i = 0; i < 4; ++i) {
                __builtin_amdgcn_global_load_lds((const unsigned*)(ga[i] + (kt + 1) * 64), (unsigned*)(lbase + nxt + i * 1024), 16, 0, 0);
                __builtin_amdgcn_global_load_lds((const unsigned*)(gb[i] + (kt + 1) * 64), (unsigned*)(lbase + nxt + 16384 + i * 1024), 16, 0, 0);
            }
        }
#pragma unroll
        for (int ks = 0; ks < 4; ++ks) {
            bf16x8_t af[TM], bfr[TN];
#pragma unroll
            for (int i = 0; i < TM; ++i) af[i] = __builtin_bit_cast(bf16x8_t, *(const u32x4*)(sm + cur + lds_off(32 * (TM * wm + i) + cl, 2 * ks + hl)));
#pragma unroll
            for (int j = 0; j < TN; ++j) bfr[j] = __builtin_bit_cast(bf16x8_t, *(const u32x4*)(sm + cur + 16384 + lds_off(32 * (TN * wn + j) + cl, 2 * ks + hl)));
#pragma unroll
            for (int i = 0; i < TM; ++i)
#pragma unroll
                for (int j = 0; j < TN; ++j) acc[i][j] = __builtin_amdgcn_mfma_f32_32x32x16_bf16(af[i], bfr[j], acc[i][j], 0, 0, 0);
        }
        asm volatile("s_waitcnt vmcnt(0)" ::: "memory");
        __syncthreads();
    }
}
#define ACC_ROW(TMv, wm, i, r, hl) (32 * ((TMv) * (wm) + (i)) + ((r) & 3) + 8 * ((r) >> 2) + 4 * (hl))
#define ACC_COL(TNv, wn, j, cl)    (32 * ((TNv) * (wn) + (j)) + (cl))

#define N_ADA 384
#define NW_IN   (1792 * 1024)
#define NW_UQ   (768 * 384)
#define NW_UKV  (1024 * 256)
#define NW_GATE (4 * 512 * 128)
#define NW_O    (1024 * 1024)
#define NW_POOL (4 * 256 * 256)
#define NW_PQ   (2048 * 1024)
#define NW_KEYS (16 * 128 * 128)
#define NW_CKV  (8 * 256 * 256)
#define NW_CKR  (8 * 256 * 64)
#define NW_ROPE 3072
#define NT_IN 448
#define NT_UQ 72
#define NT_UKV 64
#define NT_O 256
#define NT_POOL 64
#define NT_PQ 512
#define N_TR (NT_IN + NT_UQ + NT_UKV + NT_O + NT_POOL + 2 * NT_PQ)
#define NE_TOTAL (NW_GATE + 2 * NW_KEYS + NW_CKV + NW_CKR + NW_ROPE)
#define N_CONV_ITEMS ((NE_TOTAL + 4095) / 4096)
#define N_FP8_ITEMS (65536 / NWV / 4)

__device__ __forceinline__ void conv_elem(const Params& p, int e) {
    if (e < NW_GATE) {
        const int c = e & 127, cg = (e >> 7) & 511, nb = e >> 16;
        const int dir = cg >> 8, dg = (cg >> 6) & 3, ri = (cg >> 5) & 1, d = dg * 32 + (cg & 31);
        const float* src = ri ? p.w_ig : p.w_rg;
        p.wt_gate[e] = f2bf(src[(((size_t)dir * 4 + nb) * 128 + c) * 128 + d]); return; } e -= NW_GATE;
#pragma unroll
    for (int l = 0; l < 2; ++l) { if (e < NW_KEYS) { p.keysb[l][e] = f2bf(p.peer_keys[l][e]); return; } e -= NW_KEYS; }
    if (e < NW_CKV) { const int col = e & 255, j = (e >> 8) & 255, b = e >> 16; p.ckvk[(size_t)(T_CTX + b * 2304 + j) * 256 + col] = f2bf(p.cache_ckv[e]); return; } e -= NW_CKV;
    if (e < NW_CKR) { const int col = e & 63, j = (e >> 6) & 255, b = e >> 14; p.kropek[(size_t)(T_CTX + b * 2304 + j) * 64 + col] = f2bf(p.cache_krope[e]); return; } e -= NW_CKR;
    if (e < NW_ROPE) {
        int idx = e, isrow = e < 1024; if (!isrow) idx -= 1024;
        const int half = isrow ? 512 : 1024; const int sn = idx >= half; if (sn) idx -= half;
        const int pos = idx >> 4, fi = idx & 15;
        const float invf = exp2f(-(float)fi * (13.287712379549449f / 16.f));
        const float ang = (float)pos * invf;
        p.ropetab[e] = sn ? sinf(ang) : cosf(ang); return; }
}
__device__ __forceinline__ void tr_tile(const float* __restrict__ src, int ldsrc, int nvalid, bf16_t* __restrict__ dst, int lddst, int k0, int n0, float scl = 1.f) {
    float* tile = (float*)(smem + (tidx() >> 8) * 32768);
    const int tid = tidx() & 255;
    __syncthreads();
#pragma unroll
    for (int i = 0; i < 4; ++i) {
        const int k = (tid >> 4) + 16 * i, n = (tid & 15) * 4;
        float4 v = make_float4(0.f, 0.f, 0.f, 0.f);
        if (n0 + n < nvalid) v = *(const float4*)(src + (size_t)(k0 + k) * ldsrc + n0 + n);
        tile[k * 65 + n] = v.x; tile[k * 65 + n + 1] = v.y; tile[k * 65 + n + 2] = v.z; tile[k * 65 + n + 3] = v.w;
    }
    __syncthreads();
    const int n = tid >> 2, kq = (tid & 3) * 16;
    unsigned w[8];
#pragma unroll
    for (int j = 0; j < 8; ++j) w[j] = pack_bf16(tile[(kq + 2 * j) * 65 + n] * scl, tile[(kq + 2 * j + 1) * 65 + n] * scl);
    uint4* d = (uint4*)(dst + (size_t)(n0 + n) * lddst + k0 + kq);
    d[0] = make_uint4(w[0], w[1], w[2], w[3]); d[1] = make_uint4(w[4], w[5], w[6], w[7]);
}
__device__ __forceinline__ void tr_item(const Params& p, int t) {
    if (t < NT_IN) { tr_tile(p.w_in, 1728, 1728, p.wt_in, 1024, (t % 16) * 64, (t / 16) * 64); return; } t -= NT_IN;
    if (t < NT_UQ) { tr_tile(p.w_uq, 768, 768, p.wt_uq, 384, (t % 6) * 64, (t / 6) * 64, 0.07216878364870322f * 1.4426950408889634f  ); return; } t -= NT_UQ;
    if (t < NT_UKV) {
        const int n0 = (t / 4) * 64, h = n0 >> 8, kv = (n0 >> 7) & 1, nn = kv * 512 + h * 128 + (n0 & 127);
        tr_tile(p.w_ukv, 1024, 1024, p.wt_ukv + ((ptrdiff_t)nn - n0) * 256, 256, (t % 4) * 64, n0); return; } t -= NT_UKV;
    if (t < NT_O) { tr_tile(p.w_o, 1024, 1024, p.wt_o, 1024, (t % 16) * 64, (t / 16) * 64); return; } t -= NT_O;
    if (t < NT_POOL) { const int g = t >> 4, tt = t & 15; tr_tile(p.w_pool + (size_t)g * 65536, 256, 256, p.wt_pool + (size_t)g * 65536, 256, (tt & 3) * 64, (tt >> 2) * 64); return; } t -= NT_POOL;
    if (t < NT_PQ) { tr_tile(p.peer_wq[0], 2048, 2048, p.wt_pq[0], 1024, (t % 16) * 64, (t / 16) * 64); return; } t -= NT_PQ;
    tr_tile(p.peer_wq[1], 2048, 2048, p.wt_pq[1], 1024, (t % 16) * 64, (t / 16) * 64);
}

__device__ void st_prologue(const Params& p) {
    const int tid = tidx(), lane = tid & 63, wid = tid >> 6;
    const int n_items = N_ADA + N_TR / 2 + N_CONV_ITEMS + N_FP8_ITEMS;
    for (int item = blockIdx.x; item < n_items; item += gridDim.x) {
        if (item < N_ADA) {
            float* svec = (float*)smem;
            float* red = (float*)(smem + 9 * 4096);
            __syncthreads();
            for (int i = tid; i < 9 * 1024; i += NTHR) { const int bc = i >> 10, k = i & 1023; const float cv = bc == 0 ? p.c_ctx[k] : p.c[(size_t)(bc - 1) * 1024 + k]; svec[i] = silu_(cv); }
            __syncthreads();
            const int cidx = item * 32 + (lane & 7) * 4, l = cidx / 6144, col = cidx % 6144, k0 = (wid * 8 + (lane >> 3)) * 16;
            const float* w = p.w_mod[l] + (size_t)k0 * 6144 + col;
            float acc[9][4];
#pragma unroll
            for (int b = 0; b < 9; ++b) { acc[b][0] = 0.f; acc[b][1] = 0.f; acc[b][2] = 0.f; acc[b][3] = 0.f; }
#pragma unroll 8
            for (int k = 0; k < 16; ++k) {
                const float4 wv = *(const float4*)(w + (size_t)k * 6144);
#pragma unroll
                for (int b = 0; b < 9; ++b) { const float sv = svec[b * 1024 + k0 + k]; acc[b][0] += wv.x * sv; acc[b][1] += wv.y * sv; acc[b][2] += wv.z * sv; acc[b][3] += wv.w * sv; }
            }
#pragma unroll
            for (int b = 0; b < 9; ++b)
#pragma unroll
                for (int j = 0; j < 4; ++j) { float v = acc[b][j]; v += __shfl_xor(v, 8); v += __shfl_xor(v, 16); v += __shfl_xor(v, 32); acc[b][j] = v; }
            if (lane < 8) {
#pragma unroll
                for (int b = 0; b < 9; ++b)
#pragma unroll
                    for (int j = 0; j < 4; ++j) red[(wid * 9 + b) * 32 + lane * 4 + j] = acc[b][j];
            }
            __syncthreads();
            for (int i = tid; i < 9 * 32; i += NTHR) {
                const int b = i >> 5, c = i & 31;
                const int ci = item * 32 + c, ll = ci / 6144, cc = ci % 6144;
                float v = 0.f;
#pragma unroll
                for (int w8 = 0; w8 < 8; ++w8) v += red[(w8 * 9 + b) * 32 + c];
                p.mod[(size_t)(ll * 9 + b) * 6144 + cc] = v + p.b_mod[ll][cc];
            }
        } else if (item < N_ADA + N_TR / 2) {
            tr_item(p, (item - N_ADA) * 2 + (tid >> 8));
        } else if (item < N_ADA + N_TR / 2 + N_CONV_ITEMS) {
            const int base = (item - N_ADA - N_TR / 2) * 4096;
            for (int i = tid; i < 4096; i += NTHR) { const int e = base + i; if (e < NE_TOTAL) conv_elem(p, e); }
        } else {
            const int row0 = ((item - N_ADA - N_TR / 2 - N_CONV_ITEMS) * NWV + wid) * 4;
            const int tb = row0 >> 14, er0 = row0 & 16383, l = tb >> 1;
            const float* src = ((tb & 1) ? p.peer_v[l] : p.peer_u[l]) + (size_t)er0 * 1024 + lane * 16;
            u8_t* dst = ((tb & 1) ? p.v8[l] : p.u8[l]) + (size_t)er0 * 512 + lane * 8;
            float* sc = ((tb & 1) ? p.sv[l] : p.su[l]) + er0;
            f32x4v f[4][4];
#pragma unroll
            for (int r = 0; r < 4; ++r)
#pragma unroll
                for (int j = 0; j < 4; ++j) f[r][j] = __builtin_nontemporal_load((const f32x4v*)(src + (size_t)r * 1024 + 4 * j));
#pragma unroll
            for (int r = 0; r < 4; ++r) {
                float am = 0.f;
#pragma unroll
                for (int j = 0; j < 4; ++j) am = fmaxf(fmaxf(am, fmaxf(fabsf(f[r][j][0]), fabsf(f[r][j][1]))), fmaxf(fabsf(f[r][j][2]), fabsf(f[r][j][3])));
                am = wave_max(am);
                const float scale = am > 0.f ? am * (1.f / 6.f) : 1.f, inv = am > 0.f ? 6.f / am : 1.f;
                unsigned w[2];
#pragma unroll
                for (int j = 0; j < 2; ++j) {
                    unsigned pk = 0u;
                    pk = __builtin_amdgcn_cvt_scalef32_pk_fp4_f32(pk, f[r][2 * j][0] * inv, f[r][2 * j][1] * inv, 1.0f, 0);
                    pk = __builtin_amdgcn_cvt_scalef32_pk_fp4_f32(pk, f[r][2 * j][2] * inv, f[r][2 * j][3] * inv, 1.0f, 1);
                    pk = __builtin_amdgcn_cvt_scalef32_pk_fp4_f32(pk, f[r][2 * j + 1][0] * inv, f[r][2 * j + 1][1] * inv, 1.0f, 2);
                    pk = __builtin_amdgcn_cvt_scalef32_pk_fp4_f32(pk, f[r][2 * j + 1][2] * inv, f[r][2 * j + 1][3] * inv, 1.0f, 3);
                    w[j] = pk;
                }
                *(uint2*)(dst + (size_t)r * 512) = make_uint2(w[0], w[1]);
                if (lane == 0) sc[r] = scale;
            }
        }
    }
}

template <int FIRST>
__device__ void st_resnorm(const Params& p, int l) {
    const int lane = tidx() & 63, wid = tidx() >> 6, stride = gridDim.x * NWV;
    for (int T0 = blockIdx.x * NWV + wid; T0 < T_TOK; T0 += 2 * stride) {
        float4 xa[2][4]; uint4 ma[2][2];
#pragma unroll
        for (int u = 0; u < 2; ++u) {
            const int T = min(T0 + u * stride, T_TOK - 1);
            const float* x0 = FIRST ? x_in_row(p, T) + lane * 16 : p.xres + (size_t)T * 1024 + lane * 16;
            const uint4* mp = (const uint4*)(p.mix + (size_t)T * 1024 + lane * 16);
#pragma unroll
            for (int j = 0; j < 4; ++j) xa[u][j] = *(const float4*)(x0 + 4 * j);
            ma[u][0] = mp[0]; ma[u][1] = mp[1];
        }
#pragma unroll
        for (int u = 0; u < 2; ++u) {
            const int T = T0 + u * stride;
            if (T < T_TOK) {
                const TokInfo ti = tokinfo(T);
                float* xr = p.xres + (size_t)T * 1024 + lane * 16;
                const float* gt = modv(p, l, ti.mi, 2) + lane * 16;
                float m[16]; { float t8[8]; unpack8(ma[u][0], t8);
#pragma unroll
                    for (int j = 0; j < 8; ++j) m[j] = t8[j];
                    unpack8(ma[u][1], t8);
#pragma unroll
                    for (int j = 0; j < 8; ++j) m[8 + j] = t8[j]; }
                float v[16]; float ss = 0.f;
#pragma unroll
                for (int j = 0; j < 4; ++j) {
                    const float4 f = xa[u][j]; float4 g = *(const float4*)(gt + 4 * j);
                    if (!FIRST) { const float4 sp = *(const float4*)(p.s_pool + lane * 16 + 4 * j); g.x *= sp.x; g.y *= sp.y; g.z *= sp.z; g.w *= sp.w; }
                    v[4 * j] = f.x + g.x * m[4 * j]; v[4 * j + 1] = f.y + g.y * m[4 * j + 1]; v[4 * j + 2] = f.z + g.z * m[4 * j + 2]; v[4 * j + 3] = f.w + g.w * m[4 * j + 3];
                    *(float4*)(xr + 4 * j) = make_float4(v[4 * j], v[4 * j + 1], v[4 * j + 2], v[4 * j + 3]);
                }
#pragma unroll
                for (int j = 0; j < 16; ++j) ss += v[j] * v[j];
                ss = wave_sum(ss);
                const float rstd = rsqrtf(ss * (1.f / 1024.f) + 1e-6f);
                const float* sh = modv(p, l, ti.mi, 3) + lane * 16; const float* sc = modv(p, l, ti.mi, 4) + lane * 16; const float* gg = p.g_ffn[l] + lane * 16;
                unsigned w[8];
#pragma unroll
                for (int j = 0; j < 8; ++j) w[j] = pack_bf16(v[2 * j] * rstd * gg[2 * j] * (1.f + sc[2 * j]) + sh[2 * j], v[2 * j + 1] * rstd * gg[2 * j + 1] * (1.f + sc[2 * j + 1]) + sh[2 * j + 1]);
                uint4* d = (uint4*)(p.hbuf + (size_t)T * 1024 + lane * 16);
                d[0] = make_uint4(w[0], w[1], w[2], w[3]); d[1] = make_uint4(w[4], w[5], w[6], w[7]);
            }
        }
    }
}

template <int SRC>
__device__ void st_norm(const Params& p, int l, int which, const float* g, bf16_t* dst) {
    const int lane = tidx() & 63, wid = tidx() >> 6, stride = gridDim.x * NWV;
    for (int T0 = blockIdx.x * NWV + wid; T0 < T_TOK; T0 += 2 * stride) {
        float v[2][16];
#pragma unroll
        for (int u = 0; u < 2; ++u) {
            const int T = min(T0 + u * stride, T_TOK - 1);
            const float* src = (SRC == 0 ? x_in_row(p, T) : p.xres + (size_t)T * 1024) + lane * 16;
#pragma unroll
            for (int j = 0; j < 4; ++j) { const float4 f = *(const float4*)(src + 4 * j); v[u][4 * j] = f.x; v[u][4 * j + 1] = f.y; v[u][4 * j + 2] = f.z; v[u][4 * j + 3] = f.w; }
        }
#pragma unroll
        for (int u = 0; u < 2; ++u) {
            const int T = T0 + u * stride;
            if (T < T_TOK) {
                const TokInfo ti = tokinfo(T);
                float ss = 0.f;
#pragma unroll
                for (int j = 0; j < 16; ++j) ss += v[u][j] * v[u][j];
                ss = wave_sum(ss);
                const float rstd = rsqrtf(ss * (1.f / 1024.f) + 1e-6f);
                const float* sh = modv(p, l, ti.mi, which ? 3 : 0) + lane * 16; const float* sc = modv(p, l, ti.mi, which ? 4 : 1) + lane * 16; const float* gg = g + lane * 16;
                unsigned w[8];
#pragma unroll
                for (int j = 0; j < 8; ++j) w[j] = pack_bf16(v[u][2 * j] * rstd * gg[2 * j] * (1.f + sc[2 * j]) + sh[2 * j], v[u][2 * j + 1] * rstd * gg[2 * j + 1] * (1.f + sc[2 * j + 1]) + sh[2 * j + 1]);
                uint4* d = (uint4*)(dst + (size_t)T * 1024 + lane * 16);
                d[0] = make_uint4(w[0], w[1], w[2], w[3]); d[1] = make_uint4(w[4], w[5], w[6], w[7]);
            }
        }
    }
}

struct EpiStoreBf16 {
    static constexpr bool PERM = true;
    bf16_t* O; int ldc;
    __device__ __forceinline__ void operator()(const pg8::f32x4 (&acc)[2][2][4][2], const pg8::Unit& u, int wr, int wc, int fr, int fq) const {
#pragma unroll
        for (int ai = 0; ai < 2; ++ai)
#pragma unroll
            for (int m = 0; m < 4; ++m) {
                bf16_t* rowp = O + (size_t)(u.pm * 256 + ai * 128 + wr * 64 + m * 16 + fr) * ldc + u.pn * 256 + wc * 32 + 8 * fq;
#pragma unroll
                for (int bj = 0; bj < 2; ++bj) {
                    const pg8::f32x4 v0 = acc[ai][bj][m][0], v1 = acc[ai][bj][m][1];
                    *(uint4*)(rowp + bj * 128) = make_uint4(pack_bf16(v0[0], v0[1]), pack_bf16(v0[2], v0[3]), pack_bf16(v1[0], v1[1]), pack_bf16(v1[2], v1[3]));
                }
            }
    }
};
__device__ void st_gemm1(const Params& p) {
    pg8::TileOrder S; S.nN = 7; S.total = 80 * 7; S.A = (const char*)p.hbuf; S.B = (const char*)p.wt_in; S.tA = (size_t)256 * 1024 * 2; S.tB = (size_t)256 * 1024 * 2;
    EpiStoreBf16 E; E.O = p.P; E.ldc = 1792;
    pg8::gemm_phase<EpiStoreBf16, pg8::TileOrder, true, true>((LAS unsigned char*)smem, 1024, 1024, 1024, S, E);
}

__device__ void st_postproj(const Params& p) {
    const int lane = tidx() & 63, wid = tidx() >> 6;
    float* o_ckv = p.out + 20971520, *o_kr = p.out + 22020096;
    for (int T = blockIdx.x * NWV + wid; T < T_TOK; T += gridDim.x * NWV) {
        const TokInfo ti = tokinfo(T);
        const bf16_t* Pr = p.P + (size_t)T * 1792;
        float cq[8], ck[8];
#pragma unroll
        for (int j = 0; j < 8; ++j) { cq[j] = 0.f; ck[j] = 0.f; }
        if (lane < 48) unpack8(*(const uint4*)(Pr + lane * 8), cq);
        if (lane < 32) unpack8(*(const uint4*)(Pr + 384 + lane * 8), ck);
        float s1 = 0.f, s2 = 0.f;
#pragma unroll
        for (int j = 0; j < 8; ++j) { s1 += cq[j] * cq[j]; s2 += ck[j] * ck[j]; }
        s1 = wave_sum(s1); s2 = wave_sum(s2);
        const float r1 = rsqrtf(s1 * (1.f / 384.f) + 1e-6f), r2 = rsqrtf(s2 * (1.f / 256.f) + 1e-6f);
        if (lane < 48) {
            const float4 ga = *(const float4*)(p.g_q + lane * 8), gb = *(const float4*)(p.g_q + lane * 8 + 4);
            uint4 o; o.x = pack_bf16(cq[0] * r1 * ga.x, cq[1] * r1 * ga.y); o.y = pack_bf16(cq[2] * r1 * ga.z, cq[3] * r1 * ga.w);
            o.z = pack_bf16(cq[4] * r1 * gb.x, cq[5] * r1 * gb.y); o.w = pack_bf16(cq[6] * r1 * gb.z, cq[7] * r1 * gb.w);
            *(uint4*)(p.cqn + (size_t)T * 384 + lane * 8) = o;
        }
        if (lane < 32) {
            const float4 ga = *(const float4*)(p.g_kv + lane * 8), gb = *(const float4*)(p.g_kv + lane * 8 + 4);
            float y[8] = {ck[0] * r2 * ga.x, ck[1] * r2 * ga.y, ck[2] * r2 * ga.z, ck[3] * r2 * ga.w, ck[4] * r2 * gb.x, ck[5] * r2 * gb.y, ck[6] * r2 * gb.z, ck[7] * r2 * gb.w};
            uint4 o; o.x = pack_bf16(y[0], y[1]); o.y = pack_bf16(y[2], y[3]); o.z = pack_bf16(y[4], y[5]); o.w = pack_bf16(y[6], y[7]);
            *(uint4*)(p.ckvk + (size_t)ti.keyrow * 256 + lane * 8) = o;
            if (!ti.smp) { float4* d = (float4*)(o_ckv + (size_t)T * 256 + lane * 8); d[0] = make_float4(y[0], y[1], y[2], y[3]); d[1] = make_float4(y[4], y[5], y[6], y[7]); }
        }
        if (lane < 8) {
            float v[8]; unpack8(*(const uint4*)(Pr + 640 + lane * 8), v);
            float y[8];
            if (ti.smp) {
                const int gr = ti.s >> 6, gc = ti.s & 63;
#pragma unroll
                for (int i = 0; i < 4; ++i) {
                    const int pr = lane * 4 + i;
                    const float cs = pr < 16 ? p.ropetab[gr * 16 + pr] : p.ropetab[1024 + gc * 16 + (pr - 16)];
                    const float sn = pr < 16 ? p.ropetab[512 + gr * 16 + pr] : p.ropetab[2048 + gc * 16 + (pr - 16)];
                    y[2 * i] = v[2 * i] * cs - v[2 * i + 1] * sn; y[2 * i + 1] = v[2 * i] * sn + v[2 * i + 1] * cs;
                }
            } else {
#pragma unroll
                for (int i = 0; i < 8; ++i) y[i] = v[i];
                float4* d = (float4*)(o_kr + (size_t)T * 64 + lane * 8); d[0] = make_float4(v[0], v[1], v[2], v[3]); d[1] = make_float4(v[4], v[5], v[6], v[7]);
            }
            uint4 o; o.x = pack_bf16(y[0], y[1]); o.y = pack_bf16(y[2], y[3]); o.z = pack_bf16(y[4], y[5]); o.w = pack_bf16(y[6], y[7]);
            *(uint4*)(p.kropek + (size_t)ti.keyrow * 64 + lane * 8) = o;
        }
        {
            const int ch = lane * 8;
            float y[8];
            { const float4 a = *(const float4*)(p.conv_b + ch), b = *(const float4*)(p.conv_b + ch + 4); y[0] = a.x; y[1] = a.y; y[2] = a.z; y[3] = a.w; y[4] = b.x; y[5] = b.y; y[6] = b.z; y[7] = b.w; }
#pragma unroll
            for (int k = 0; k < 4; ++k) {
                const int s2i = ti.s + k - 2;
                if (s2i >= 0 && s2i < ti.S) {
                    float u[8]; unpack8(*(const uint4*)(p.P + (size_t)(T + k - 2) * 1792 + 704 + ch), u);
                    const float4 a = *(const float4*)(p.conv_w + k * 512 + ch), b = *(const float4*)(p.conv_w + k * 512 + ch + 4);
                    y[0] += a.x * u[0]; y[1] += a.y * u[1]; y[2] += a.z * u[2]; y[3] += a.w * u[3]; y[4] += b.x * u[4]; y[5] += b.y * u[5]; y[6] += b.z * u[6]; y[7] += b.w * u[7];
                }
            }
            uint4 o; o.x = pack_bf16(y[0], y[1]); o.y = pack_bf16(y[2], y[3]); o.z = pack_bf16(y[4], y[5]); o.w = pack_bf16(y[6], y[7]);
            *(uint4*)(p.xc + (size_t)T * 512 + ch) = o;
            *(uint4*)(p.ug + (size_t)T * 512 + ch) = *(const uint4*)(Pr + 1216 + ch);
        }
    }
}

struct EpiVT {
    static constexpr bool PERM = true;
    bf16_t* vT;
    __device__ __forceinline__ void operator()(const pg8::f32x4 (&acc)[2][2][4][2], const pg8::Unit& u, int wr, int wc, int fr, int fq) const {
        const int R0 = u.pn * 256;
        size_t sbase; int Sk, pos0;
        if (R0 < T_CTX) { Sk = 256; pos0 = 0; sbase = (size_t)(R0 >> 8) * 4 * 128 * 256; }
        else { const int uu = R0 - T_CTX; const int sq = uu / 2304; Sk = 2304; pos0 = uu - sq * 2304; sbase = (size_t)T_CTX * 512 + (size_t)sq * 4 * 128 * 2304; }
        bf16_t* vb = vT + sbase + pos0 + wc * 32 + 8 * fq;
#pragma unroll
        for (int ai = 0; ai < 2; ++ai)
#pragma unroll
            for (int m = 0; m < 4; ++m) {
                const int r = u.pm * 256 + ai * 128 + wr * 64 + m * 16 + fr;
                bf16_t* rowp = vb + (size_t)r * Sk;
#pragma unroll
                for (int bj = 0; bj < 2; ++bj) {
                    const pg8::f32x4 v0 = acc[ai][bj][m][0], v1 = acc[ai][bj][m][1];
                    *(uint4*)(rowp + bj * 128) = make_uint4(pack_bf16(v0[0], v0[1]), pack_bf16(v0[2], v0[3]), pack_bf16(v1[0], v1[1]), pack_bf16(v1[2], v1[3]));
                }
            }
    }
};
#define N_G4 (160 * 16)
__device__ void st_gemm234(const Params& p) {
    {
        pg8::TileOrder S; S.nN = 3; S.total = 80 * 3; S.A = (const char*)p.cqn; S.B = (const char*)p.wt_uq; S.tA = (size_t)256 * 384 * 2; S.tB = (size_t)256 * 384 * 2;
        EpiStoreBf16 E; E.O = p.q; E.ldc = 768;
        pg8::gemm_phase<EpiStoreBf16, pg8::TileOrder, true, true>((LAS unsigned char*)smem, 384, 384, 384, S, E);
    }
    {
        pg8::TileOrder S; S.nN = 2; S.total = 88 * 2; S.A = (const char*)p.ckvk; S.B = (const char*)p.wt_ukv; S.tA = (size_t)256 * 256 * 2; S.tB = (size_t)256 * 256 * 2;
        EpiStoreBf16 E; E.O = p.Kn; E.ldc = 512;
        pg8::gemm_phase<EpiStoreBf16, pg8::TileOrder, true, true>((LAS unsigned char*)smem, 256, 256, 256, S, E);
    }
    {
        struct OrderVT {
            const char* W; const char* Kr;
            __device__ __forceinline__ bool next(int i, pg8::Unit& u) const {
                const int item = blockIdx.x + i * gridDim.x; if (item >= 88 * 2) return false;
                const int lt = item >> 3; u.pm = lt & 1; u.pn = (lt >> 1) * 8 + (item & 7);
                u.A = W + (size_t)u.pm * 256 * 256 * 2; u.B = Kr + (size_t)u.pn * 256 * 256 * 2; return true;
            }
        } S; S.W = (const char*)(p.wt_ukv + (size_t)512 * 256); S.Kr = (const char*)p.ckvk;
        EpiVT E; E.vT = p.vT;
        pg8::gemm_phase<EpiVT, OrderVT, true, true>((LAS unsigned char*)smem, 256, 256, 256, S, E);
    }
}

__device__ void st_gates(const Params& p) {
    const int half = tidx() >> 8, lane = tidx() & 63, wid = (tidx() >> 6) & 3, wm = wid >> 1, wn = wid & 1, hl = lane >> 5, cl = lane & 31;
    for (int item = blockIdx.x; item < N_G4 / 2; item += gridDim.x) {
        f32x16 acc[2][2];
        {
            const int lt = (item >> 3) * 2 + half, tj = lt & 3, nb = (lt >> 2) & 3, tm = (lt >> 4) * 8 + (item & 7);
            gemm_acc<2, 2, 2, 2>(p.xc + (size_t)tm * 128 * 512 + nb * 128, 512, p.wt_gate + ((size_t)nb * 512 + tj * 128) * 128, 128, 128, acc);
            const int dir = tj >> 1, dg = (tj & 1) * 2 + wn, ch = nb * 128 + dg * 32 + cl;
            const float brg = p.b_rg[dir * 512 + ch], big = p.b_ig[dir * 512 + ch];
            const float nl = -p.lam[dir * 512 + ch];
            const float sp = fmaxf(nl, 0.f) + log1pf(__expf(-fabsf(nl)));
#pragma unroll
            for (int i = 0; i < 2; ++i)
#pragma unroll
                for (int r = 0; r < 16; ++r) {
                    const int T = tm * 128 + ACC_ROW(2, wm, i, r, hl);
                    const float rg = __builtin_amdgcn_rcpf(1.f + __expf(-(acc[i][0][r] + brg))), ig = __builtin_amdgcn_rcpf(1.f + __expf(-(acc[i][1][r] + big)));
                    const float la = -8.f * rg * sp;
                    const float av = __expf(la);
                    const float mult = __builtin_amdgcn_sqrtf(fmaxf(1.f - av * av, 0.f));
                    const float xv = bf2f(p.xc[(size_t)T * 512 + ch]);
                    p.a[((size_t)T * 2 + dir) * 512 + ch] = av;
                    p.bxb[((size_t)T * 2 + dir) * 512 + ch] = f2bf(mult * ig * xv);
                }
        }
    }
}

#define N_ATT (64 + 256)
#define SCH 64
#define NCHK (T_TOK / SCH)
#define N_S1 (NCHK * 2)
__device__ void scan_s1_item(const Params& p, int it) {
    const int chunk = it >> 1, dc = (it & 1) * 512 + tidx(), dir = dc >> 9, ch = dc & 511;
    const int T0 = chunk * SCH;
    float A = 1.f, B = 0.f;
#pragma unroll 8
    for (int i = 0; i < SCH; ++i) {
        const int T = dir ? (T0 + SCH - 1 - i) : (T0 + i);
        const float av = p.a[((size_t)T * 2 + dir) * 512 + ch], bv = bf2f(p.bxb[((size_t)T * 2 + dir) * 512 + ch]);
        A *= av; B = B * av + bv;
    }
    *(float2*)(p.agg + (((size_t)chunk * 2 + dir) * 512 + ch) * 2) = make_float2(A, B);
}

__device__ __forceinline__ int perm23(int r) { return (r & 0x13) | ((r & 4) << 1) | ((r & 8) >> 1); }
__device__ void attn_item_mfma(const Params& p, int it) {
    int seq, h, qb, Sk, T0, R0; size_t vbase;
    if (it < 64) { seq = it >> 2; h = it & 3; qb = 0; Sk = 256; T0 = seq * 256; R0 = seq * 256; vbase = (size_t)(seq * 4 + h) * 128 * 256; }
    else { const int u = it - 64; seq = u >> 5; h = (u >> 3) & 3; qb = u & 7; Sk = 2304; T0 = T_CTX + seq * 2048 + qb * 256; R0 = T_CTX + seq * 2304; vbase = (size_t)T_CTX * 512 + (size_t)(seq * 4 + h) * 128 * 2304; }
    const int tid = tidx(), lane = tid & 63, wid = tid >> 6, hl = lane >> 5, cl = lane & 31;
    bf16x8_t qf[12];
    {
        const bf16_t* qrow = p.q + (size_t)(T0 + 32 * wid + cl) * 768 + h * 192 + 8 * hl;
#pragma unroll
        for (int ks = 0; ks < 12; ++ks) qf[ks] = __builtin_bit_cast(bf16x8_t, *(const u32x4*)(qrow + 16 * ks));
        if (it >= 64) {
            const int sp = qb * 256 + 32 * wid + cl, gr = sp >> 6, gc = sp & 63;
#pragma unroll
            for (int ks = 8; ks < 12; ++ks) {
                const u32x4 w = __builtin_bit_cast(u32x4, qf[ks]); u32x4 o;
#pragma unroll
                for (int i = 0; i < 4; ++i) {
                    const int pr = 8 * (ks - 8) + 4 * hl + i;
                    const float cs = ks < 10 ? p.ropetab[gr * 16 + pr] : p.ropetab[1024 + gc * 16 + (pr - 16)];
                    const float sn = ks < 10 ? p.ropetab[512 + gr * 16 + pr] : p.ropetab[2048 + gc * 16 + (pr - 16)];
                    const float x0 = __uint_as_float(w[i] << 16), x1 = __uint_as_float(w[i] & 0xffff0000u);
                    o[i] = pack_bf16(x0 * cs - x1 * sn, x0 * sn + x1 * cs);
                }
                qf[ks] = __builtin_bit_cast(bf16x8_t, o);
            }
        }
    }
    f32x16 oacc[4];
#pragma unroll
    for (int d = 0; d < 4; ++d)
#pragma unroll
        for (int r = 0; r < 16; ++r) oacc[d][r] = 0.f;
    float m = -1e30f, lsum = 0.f;
    const bf16_t* gk = p.Kn + (size_t)(R0 + (tid >> 4)) * 512 + h * 128 + (tid & 15) * 8;
    const bf16_t* gr = p.kropek + (size_t)(R0 + (tid >> 3)) * 64 + (tid & 7) * 8;
    const bf16_t* gv = p.vT + vbase + (size_t)(tid >> 3) * Sk + (tid & 7) * 8;
    u32x4 rk[2], rr, rv[2];
    const int nt = Sk >> 6;
#pragma unroll
    for (int i = 0; i < 2; ++i) rk[i] = *(const u32x4*)(gk + (size_t)(32 * i) * 512);
    rr = *(const u32x4*)gr;
#pragma unroll
    for (int i = 0; i < 2; ++i) rv[i] = *(const u32x4*)(gv + (size_t)(64 * i) * Sk);
    __syncthreads();
    for (int t = 0; t < nt; ++t) {
#pragma unroll
        for (int i = 0; i < 2; ++i) *(u32x4*)(smem + ((tid & 15) >> 3) * 8192 + lds_off((tid >> 4) + 32 * i, tid & 7)) = rk[i];
        *(u32x4*)(smem + 16384 + lds_off(tid >> 3, tid & 7)) = rr;
#pragma unroll
        for (int i = 0; i < 2; ++i) *(u32x4*)(smem + 24576 + lds_off((tid >> 3) + 64 * i, tid & 7)) = rv[i];
        __syncthreads();
        if (t + 1 < nt) {
            const size_t ko = (size_t)(t + 1) * 64;
#pragma unroll
            for (int i = 0; i < 2; ++i) rk[i] = *(const u32x4*)(gk + (ko + 32 * i) * 512);
            rr = *(const u32x4*)(gr + ko * 64);
#pragma unroll
            for (int i = 0; i < 2; ++i) rv[i] = *(const u32x4*)(gv + (size_t)(64 * i) * Sk + ko);
        }
        f32x16 sacc[2];
#pragma unroll
        for (int kb = 0; kb < 2; ++kb) {
            __builtin_amdgcn_sched_barrier(0);
#pragma unroll
            for (int r = 0; r < 16; ++r) sacc[kb][r] = 0.f;
            const int krow = 32 * kb + perm23(cl);
#pragma unroll
            for (int ks = 0; ks < 12; ++ks) {
                const bf16x8_t kf = __builtin_bit_cast(bf16x8_t, *(const u32x4*)(smem + (ks >> 2) * 8192 + lds_off(krow, 2 * (ks & 3) + hl)));
                sacc[kb] = __builtin_amdgcn_mfma_f32_32x32x16_bf16(kf, qf[ks], sacc[kb], 0, 0, 0);
            }
        }
        float mx = sacc[0][0];
#pragma unroll
        for (int r = 1; r < 16; ++r) mx = fmaxf(mx, sacc[0][r]);
#pragma unroll
        for (int r = 0; r < 16; ++r) mx = fmaxf(mx, sacc[1][r]);
        mx = fmaxf(mx, __shfl_xor(mx, 32));
        const float mn = fmaxf(m, mx), alpha = __builtin_amdgcn_exp2f(m - mn);
        m = mn;
        float ps = 0.f;
        bf16x8_t pf[2][2];
#pragma unroll
        for (int kb = 0; kb < 2; ++kb)
#pragma unroll
            for (int s2 = 0; s2 < 2; ++s2) {
                float e[8];
#pragma unroll
                for (int j = 0; j < 8; ++j) { e[j] = __builtin_amdgcn_exp2f(sacc[kb][8 * s2 + j] - mn); ps += e[j]; }
                u32x4 w; w.x = pack_bf16(e[0], e[1]); w.y = pack_bf16(e[2], e[3]); w.z = pack_bf16(e[4], e[5]); w.w = pack_bf16(e[6], e[7]);
                pf[kb][s2] = __builtin_bit_cast(bf16x8_t, w);
            }
        lsum = lsum * alpha + ps;
#pragma unroll
        for (int d = 0; d < 4; ++d)
#pragma unroll
            for (int r = 0; r < 16; ++r) oacc[d][r] *= alpha;
#pragma unroll
        for (int d = 0; d < 4; ++d) {
            __builtin_amdgcn_sched_barrier(0);
#pragma unroll
            for (int kb = 0; kb < 2; ++kb)
#pragma unroll
                for (int s2 = 0; s2 < 2; ++s2) {
                    const bf16x8_t vf = __builtin_bit_cast(bf16x8_t, *(const u32x4*)(smem + 24576 + lds_off(32 * d + cl, 4 * kb + 2 * s2 + hl)));
                    oacc[d] = __builtin_amdgcn_mfma_f32_32x32x16_bf16(vf, pf[kb][s2], oacc[d], 0, 0, 0);
                }
        }
        __builtin_amdgcn_sched_barrier(0);
        __syncthreads();
    }
    lsum += __shfl_xor(lsum, 32);
    const float inv = 1.f / lsum;
    bf16_t* dst = p.hbuf + (size_t)(T0 + 32 * wid + cl) * 1024 + h * 128 + 4 * hl;
#pragma unroll
    for (int d = 0; d < 4; ++d)
#pragma unroll
        for (int g = 0; g < 4; ++g) {
            uint2 w; w.x = pack_bf16(oacc[d][4 * g] * inv, oacc[d][4 * g + 1] * inv); w.y = pack_bf16(oacc[d][4 * g + 2] * inv, oacc[d][4 * g + 3] * inv);
            *(uint2*)(dst + 32 * d + 8 * g) = w;
        }
}
__device__ void st_attn_s1(const Params& p) {
    for (int item = blockIdx.x; item < N_ATT + N_S1; item += gridDim.x) {
        if (item < N_ATT) {
            attn_item_mfma(p, N_ATT - 1 - item);
        }
        else scan_s1_item(p, item - N_ATT);
    }
}

__device__ void st_scan3(const Params& p) {
    const int tid = tidx();
    float* hf = (float*)smem;
    float* hb = hf + SCH * 256;
    float* o_lru = p.out + 22282240;
    for (int item = blockIdx.x; item < NCHK * 2; item += gridDim.x) {
        const int chunk = item >> 1, cgp = item & 1, T0 = chunk * SCH;
        const TokInfo ti = tokinfo(T0);
        const int nch = ti.S / SCH, cpos = ti.s / SCH, c0 = chunk - cpos;
        const int dir = tid >> 8, ch = cgp * 256 + (tid & 255);
        float hcur = ti.smp ? p.state_lru[((size_t)ti.b * 2 + dir) * 512 + ch] : 0.f;
        if (dir == 0) { for (int cc = 0; cc < cpos; ++cc) { const float2 ab = *(const float2*)(p.agg + (((size_t)(c0 + cc) * 2 + 0) * 512 + ch) * 2); hcur = ab.x * hcur + ab.y; } }
        else { for (int cc = nch - 1; cc > cpos; --cc) { const float2 ab = *(const float2*)(p.agg + (((size_t)(c0 + cc) * 2 + 1) * 512 + ch) * 2); hcur = ab.x * hcur + ab.y; } }
        __syncthreads();
#pragma unroll 8
        for (int i = 0; i < SCH; ++i) {
            const int tl = dir ? SCH - 1 - i : i, T = T0 + tl;
            const float av = p.a[((size_t)T * 2 + dir) * 512 + ch], bv = bf2f(p.bxb[((size_t)T * 2 + dir) * 512 + ch]);
            hcur = av * hcur + bv;
            (dir ? hb : hf)[tl * 256 + (tid & 255)] = hcur;
        }
        if (!ti.smp) {
            if (dir == 0 && cpos == nch - 1) o_lru[((size_t)ti.b * 2 + 0) * 512 + ch] = hcur;
            if (dir == 1 && cpos == 0) o_lru[((size_t)ti.b * 2 + 1) * 512 + ch] = hcur;
        }
        __syncthreads();
        for (int i = tid; i < SCH * 128; i += NTHR) {
            const int tl = i >> 7, c = (i & 127) * 2, T = T0 + tl, chh = cgp * 256 + c;
            const unsigned ugp = *(const unsigned*)(p.ug + (size_t)T * 512 + chh);
            const float g0 = gelu_tanh(__uint_as_float(ugp << 16)), g1 = gelu_tanh(__uint_as_float(ugp & 0xffff0000u));
            const float2 f = *(const float2*)(hf + tl * 256 + c), bb = *(const float2*)(hb + tl * 256 + c);
            *(unsigned*)(p.hbuf + (size_t)T * 1024 + 512 + chh) = pack_bf16((f.x + bb.x) * g0, (f.y + bb.y) * g1);
        }
    }
}

__device__ void st_gemm_o(const Params& p) {
    pg8::TileOrder S; S.nN = 4; S.total = 80 * 4; S.A = (const char*)p.hbuf; S.B = (const char*)p.wt_o; S.tA = (size_t)256 * 1024 * 2; S.tB = (size_t)256 * 1024 * 2;
    EpiStoreBf16 E; E.O = p.mix; E.ldc = 1024;
    pg8::gemm_phase<EpiStoreBf16, pg8::TileOrder, true, true>((LAS unsigned char*)smem, 1024, 1024, 1024, S, E);
}

__device__ void st_gemm_pq(const Params& p, int l) {
    pg8::TileOrder S; S.nN = 8; S.total = 80 * 8; S.A = (const char*)p.hbuf; S.B = (const char*)p.wt_pq[l]; S.tA = (size_t)256 * 1024 * 2; S.tB = (size_t)256 * 1024 * 2;
    EpiStoreBf16 E; E.O = p.qp; E.ldc = 2048;
    pg8::gemm_phase<EpiStoreBf16, pg8::TileOrder, true, true>((LAS unsigned char*)smem, 1024, 1024, 1024, S, E);
}

__device__ __forceinline__ void ce_desc(float& a, float& b) { const float hi = fmaxf(a, b), lo = fminf(a, b); a = hi; b = lo; }
__device__ __forceinline__ void ins16(float (&top)[16], float x) {
#pragma unroll
    for (int i = 0; i < 16; ++i) { const float hi = fmaxf(top[i], x); x = fminf(top[i], x); top[i] = hi; }
}
__device__ __forceinline__ void bitonic_merge16(float (&v)[16]) {
#pragma unroll
    for (int j = 8; j >= 1; j >>= 1)
#pragma unroll
        for (int i = 0; i < 16; ++i) { const int l = i ^ j; if (l > i) ce_desc(v[i], v[l]); }
}
__device__ __forceinline__ void sort16(float (&v)[16]) {
#pragma unroll
    for (int k = 2; k <= 16; k <<= 1)
#pragma unroll
        for (int j = k >> 1; j >= 1; j >>= 1)
#pragma unroll
            for (int i = 0; i < 16; ++i) { const int l = i ^ j; if (l > i) { if ((i & k) == 0) ce_desc(v[i], v[l]); else ce_desc(v[l], v[i]); } }
}
__device__ __forceinline__ void merge_top16(float (&a)[16], const float (&b)[16]) {
#pragma unroll
    for (int i = 0; i < 16; ++i) a[i] = fmaxf(a[i], b[15 - i]);
    bitonic_merge16(a);
}
#define PKV(x) __uint_as_float(__float_as_uint(x) & 0xffffff80u)
#define CAND(i, j) __uint_as_float((__float_as_uint(PKV(top[0][i]) + PKV(top[1][j])) & 0xffffff00u) | (unsigned)((i) * 16 + (j)))
__device__ void st_peer_topk(const Params& p, int l) {
    const int half = tidx() >> 8, lane = tidx() & 63, wid = (tidx() >> 6) & 3, hl = lane >> 5, cl = lane & 31;
    for (int item = blockIdx.x; item < 160 * 8 / 2; item += gridDim.x) {
        const int lt = (item >> 3) * 2 + half, h = lt & 7, tm = (lt >> 3) * 8 + (item & 7);
        const int T = tm * 128 + 32 * wid + cl;
        float top[2][16];
#pragma unroll
        for (int pp = 0; pp < 2; ++pp) {
            f32x16 acc[4][1];
            gemm_acc<4, 1, 1, 4>(p.keysb[l] + (size_t)(h * 2 + pp) * 128 * 128, 128, p.qp + (size_t)tm * 128 * 2048 + h * 256 + pp * 128, 2048, 128, acc);
#pragma unroll
            for (int i = 0; i < 4; ++i) {
                __builtin_amdgcn_sched_barrier(0);
                float g[16];
#pragma unroll
                for (int r = 0; r < 16; ++r) {
                    const int n = ACC_ROW(4, 0, i, r, hl);
                    g[r] = __uint_as_float((__float_as_uint(acc[i][0][r]) & 0xffffff80u) | (unsigned)n);
                }
                sort16(g);
                if (i == 0) {
#pragma unroll
                    for (int r = 0; r < 16; ++r) top[pp][r] = g[r];
                } else merge_top16(top[pp], g);
            }
            __builtin_amdgcn_sched_barrier(0);
            float oth[16];
#pragma unroll
            for (int i = 0; i < 16; ++i) oth[i] = __shfl_xor(top[pp][i], 32);
            merge_top16(top[pp], oth);
        }
        __builtin_amdgcn_sched_barrier(0);
        float fv[16], t2[16];
#pragma unroll
        for (int j = 0; j < 16; ++j) fv[j] = CAND(0, j);
        t2[15] = -INFINITY;
#pragma unroll
        for (int i = 1; i < 16; ++i) t2[i - 1] = CAND(i, 0);
        merge_top16(fv, t2);
        t2[0] = CAND(1, 1); t2[1] = CAND(1, 2); t2[2] = CAND(1, 3); t2[3] = CAND(1, 4); t2[4] = CAND(1, 5); t2[5] = CAND(1, 6); t2[6] = CAND(1, 7);
        t2[7] = CAND(2, 1); t2[8] = CAND(2, 2); t2[9] = CAND(2, 3); t2[10] = CAND(2, 4); t2[11] = CAND(3, 1); t2[12] = CAND(3, 2); t2[13] = CAND(3, 3);
        t2[14] = CAND(4, 1); t2[15] = CAND(4, 2);
        sort16(t2);
        merge_top16(fv, t2);
        ins16(fv, CAND(5, 1)); ins16(fv, CAND(6, 1)); ins16(fv, CAND(7, 1));
        unsigned* tab = (unsigned*)(smem + half * 65536) + (size_t)(tidx() & 255) * 8;
#pragma unroll
        for (int k = 0; k < 4; ++k) {
            tab[k] = (__float_as_uint(top[0][4 * k]) & 127u) | ((__float_as_uint(top[0][4 * k + 1]) & 127u) << 8) | ((__float_as_uint(top[0][4 * k + 2]) & 127u) << 16) | ((__float_as_uint(top[0][4 * k + 3]) & 127u) << 24);
            tab[4 + k] = (__float_as_uint(top[1][4 * k]) & 127u) | ((__float_as_uint(top[1][4 * k + 1]) & 127u) << 8) | ((__float_as_uint(top[1][4 * k + 2]) & 127u) << 16) | ((__float_as_uint(top[1][4 * k + 3]) & 127u) << 24);
        }
        const u8_t* tabb = (const u8_t*)tab;
        int fe[16];
#pragma unroll
        for (int i = 0; i < 16; ++i) {
            const unsigned code = __float_as_uint(fv[i]) & 255u;
            fe[i] = (int)tabb[code >> 4] * 128 + (int)tabb[16 + (code & 15u)];
            fv[i] = __uint_as_float(__float_as_uint(fv[i]) & 0xffffff00u);
        }
        float sum = 0.f, ev[16];
#pragma unroll
        for (int i = 0; i < 16; ++i) { ev[i] = __expf(fv[i] - fv[0]); sum += ev[i]; }
        const float inv = 1.f / sum;
        if (hl == 0) {
            float4* gp = (float4*)(p.gates + (size_t)T * 128 + h * 16); int4* ep = (int4*)(p.eidx + (size_t)T * 128 + h * 16);
#pragma unroll
            for (int i = 0; i < 4; ++i) { gp[i] = make_float4(ev[4 * i] * inv, ev[4 * i + 1] * inv, ev[4 * i + 2] * inv, ev[4 * i + 3] * inv); ep[i] = make_int4(fe[4 * i], fe[4 * i + 1], fe[4 * i + 2], fe[4 * i + 3]); }
        }
    }
}

#define FP4X(dw, b) __builtin_amdgcn_cvt_scalef32_pk_f32_fp4(dw, 1.0f, b)
#define FP4B(dw, b) __builtin_amdgcn_cvt_scalef32_pk_bf16_fp4(dw, 1.0f, b)
__device__ void st_peer_gather(const Params& p, int l) {
    const int lane = tidx() & 63, wid = __builtin_amdgcn_readfirstlane(tidx() >> 6), lp = lane & 31, hf = lane >> 5;
    const u8_t* U = p.u8[l]; const u8_t* V = p.v8[l]; const float* SU = p.su[l]; const float* SV = p.sv[l];
    const int idx4 = ((lane >> 4) & 1) + 2 * ((lane >> 3) & 1);
    const bool b3 = (lane & 8) != 0;
    for (int T = blockIdx.x * NWV + wid; T < T_TOK; T += gridDim.x * NWV) {
        const TokInfo ti = tokinfo(T);
        unsigned hv[16];
        {
            const uint4* hp = (const uint4*)(p.hbuf + (size_t)T * 1024 + lp * 32);
#pragma unroll
            for (int q = 0; q < 4; ++q) { const uint4 t = hp[q]; hv[4 * q] = t.x; hv[4 * q + 1] = t.y; hv[4 * q + 2] = t.z; hv[4 * q + 3] = t.w; }
        }
        const int e0 = p.eidx[(size_t)T * 128 + lane], e1 = p.eidx[(size_t)T * 128 + 64 + lane];
        const float g0 = p.gates[(size_t)T * 128 + lane], g1 = p.gates[(size_t)T * 128 + 64 + lane];
        float outv[32];
#pragma unroll
        for (int j = 0; j < 32; ++j) outv[j] = 0.f;
#pragma unroll 1
        for (int kb = 0; kb < 16; ++kb) {
            const int esel = kb < 8 ? e0 : e1; const float gsel = kb < 8 ? g0 : g1;
            const int kl = (kb & 7) * 8;
            u32x4 ur[4], vr[4];
#pragma unroll
            for (int j = 0; j < 4; ++j) {
                const int ea = __builtin_amdgcn_readlane(esel, kl + 2 * j), eb = __builtin_amdgcn_readlane(esel, kl + 2 * j + 1);
                const int e = hf ? eb : ea;
                const unsigned off = (unsigned)e * 512u + (unsigned)lp * 16u;
                ur[j] = *(const u32x4*)(U + off);
                vr[j] = *(const u32x4*)(V + off);
            }
            const int kmine = kl + 2 * idx4 + hf;
            const int emine = __builtin_amdgcn_ds_bpermute(kmine << 2, esel);
            const float gmine = __int_as_float(__builtin_amdgcn_ds_bpermute(kmine << 2, __float_as_int(gsel)));
            const float su = SU[emine], sv = SV[emine];
            float d[4];
#pragma unroll
            for (int j = 0; j < 4; ++j) {
                float a = 0.f;
#pragma unroll
                for (int q = 0; q < 4; ++q) {
                    a = __builtin_amdgcn_fdot2_f32_bf16(FP4B(ur[j][q], 0), __builtin_bit_cast(bf16x2_t, hv[4 * q]), a, false);
                    a = __builtin_amdgcn_fdot2_f32_bf16(FP4B(ur[j][q], 1), __builtin_bit_cast(bf16x2_t, hv[4 * q + 1]), a, false);
                    a = __builtin_amdgcn_fdot2_f32_bf16(FP4B(ur[j][q], 2), __builtin_bit_cast(bf16x2_t, hv[4 * q + 2]), a, false);
                    a = __builtin_amdgcn_fdot2_f32_bf16(FP4B(ur[j][q], 3), __builtin_bit_cast(bf16x2_t, hv[4 * q + 3]), a, false);
                }
                d[j] = a;
            }
#pragma unroll
            for (int j = 0; j < 4; ++j) { d[j] += DPP_F(d[j], 0xB1); d[j] += DPP_F(d[j], 0x4E); d[j] += DPP_F(d[j], 0x141); }
            float a2[2];
#pragma unroll
            for (int i = 0; i < 2; ++i) { const float snd = b3 ? d[i] : d[i + 2], kp = b3 ? d[i + 2] : d[i]; a2[i] = kp + DPP_F(snd, 0x128); }
            const u32x2 rr = __builtin_amdgcn_permlane16_swap(__float_as_uint(a2[0]), __float_as_uint(a2[1]), false, false);
            const float z = __uint_as_float(rr[0]) + __uint_as_float(rr[1]);
            const float w = gmine * gelu_tanh(z * su) * sv;
#pragma unroll
            for (int j = 0; j < 4; ++j) {
                const int sl = (j & 1) * 16 + ((j >> 1) & 1) * 8;
                const float wa = __int_as_float(__builtin_amdgcn_readlane(__float_as_int(w), sl)), wb = __int_as_float(__builtin_amdgcn_readlane(__float_as_int(w), 32 + sl));
                const float wj = hf ? wb : wa;
#pragma unroll
                for (int q = 0; q < 4; ++q) {
                    const f32x2 x0 = FP4X(vr[j][q], 0), x1 = FP4X(vr[j][q], 1), x2 = FP4X(vr[j][q], 2), x3 = FP4X(vr[j][q], 3);
                    outv[8 * q] += wj * x0.x; outv[8 * q + 1] += wj * x0.y; outv[8 * q + 2] += wj * x1.x; outv[8 * q + 3] += wj * x1.y;
                    outv[8 * q + 4] += wj * x2.x; outv[8 * q + 5] += wj * x2.y; outv[8 * q + 6] += wj * x3.x; outv[8 * q + 7] += wj * x3.y;
                }
            }
        }
        float o16[16];
#pragma unroll
        for (int i = 0; i < 16; ++i) { const u32x2 r = __builtin_amdgcn_permlane32_swap(__float_as_uint(outv[i]), __float_as_uint(outv[i + 16]), false, false); o16[i] = __uint_as_float(r[0]) + __uint_as_float(r[1]); }
        const int cb = lp * 32 + hf * 16;
        float* xr = p.xres + (size_t)T * 1024 + cb;
        const float* gt = modv(p, l, ti.mi, 5) + cb;
        float xn[16]; float ss = 0.f;
#pragma unroll
        for (int j = 0; j < 4; ++j) { const float4 f = *(const float4*)(xr + 4 * j); xn[4 * j] = f.x + gt[4 * j] * o16[4 * j]; xn[4 * j + 1] = f.y + gt[4 * j + 1] * o16[4 * j + 1]; xn[4 * j + 2] = f.z + gt[4 * j + 2] * o16[4 * j + 2]; xn[4 * j + 3] = f.w + gt[4 * j + 3] * o16[4 * j + 3]; }
#pragma unroll
        for (int j = 0; j < 16; ++j) ss += xn[j] * xn[j];
        ss = wave_sum(ss);
        const float rstd = rsqrtf(ss * (1.f / 1024.f) + 1e-6f);
        if (l == 0) {
#pragma unroll
            for (int j = 0; j < 4; ++j) *(float4*)(xr + 4 * j) = make_float4(xn[4 * j], xn[4 * j + 1], xn[4 * j + 2], xn[4 * j + 3]);
            const float* sh = modv(p, 1, ti.mi, 0) + cb; const float* sc = modv(p, 1, ti.mi, 1) + cb; const float* gg = p.g_mix[1] + cb;
            unsigned w[8];
#pragma unroll
            for (int j = 0; j < 8; ++j) {
                const float a0 = xn[2 * j] * rstd * gg[2 * j] * (1.f + sc[2 * j]) + sh[2 * j];
                const float a1 = xn[2 * j + 1] * rstd * gg[2 * j + 1] * (1.f + sc[2 * j + 1]) + sh[2 * j + 1];
                w[j] = pack_bf16(a0, a1);
            }
            uint4* dd = (uint4*)(p.h3 + (size_t)T * 1024 + cb);
            dd[0] = make_uint4(w[0], w[1], w[2], w[3]); dd[1] = make_uint4(w[4], w[5], w[6], w[7]);
        } else {
            const float* gg = p.g_final + cb;
            float* y = p.out + (size_t)T * 1024 + cb;
#pragma unroll
            for (int j = 0; j < 4; ++j) *(float4*)(y + 4 * j) = make_float4(xn[4 * j] * rstd * gg[4 * j], xn[4 * j + 1] * rstd * gg[4 * j + 1], xn[4 * j + 2] * rstd * gg[4 * j + 2], xn[4 * j + 3] * rstd * gg[4 * j + 3]);
        }
    }
}

template <int W>
__device__ __forceinline__ void pool_tok(const Params& p, int T, int ck) {
    const TokInfo ti = tokinfo(T);
    const bf16_t* base = p.h3 + (size_t)(T - ti.s) * 1024 + ck * 8;
    uint4 raw[W];
#pragma unroll
    for (int k = 0; k < W; ++k) {
        const int t2 = ti.s - W / 2 + k;
        raw[k] = (t2 >= 0 && t2 < ti.S) ? *(const uint4*)(base + (size_t)t2 * 1024) : make_uint4(0u, 0u, 0u, 0u);
    }
    float acc[8];
#pragma unroll
    for (int j = 0; j < 8; ++j) acc[j] = 0.f;
#pragma unroll
    for (int k = 0; k < W; ++k) { float f[8]; unpack8(raw[k], f);
#pragma unroll
        for (int j = 0; j < 8; ++j) acc[j] += f[j]; }
    float c[8]; unpack8(raw[W / 2], c);
    const int lo = max(ti.s - W / 2, 0), hi = min(ti.s + W / 2, ti.S);
    const float inv = 1.f / (float)(hi - lo);
    uint4 o;
    o.x = pack_bf16(acc[0] * inv - c[0], acc[1] * inv - c[1]); o.y = pack_bf16(acc[2] * inv - c[2], acc[3] * inv - c[3]);
    o.z = pack_bf16(acc[4] * inv - c[4], acc[5] * inv - c[5]); o.w = pack_bf16(acc[6] * inv - c[6], acc[7] * inv - c[7]);
    *(uint4*)(p.hbuf + (size_t)T * 1024 + ck * 8) = o;
}
__device__ void st_pool(const Params& p) {
    const int tid = tidx(), lane = tid & 63, wv = tid >> 6, g = wv & 3, ck = g * 32 + (lane & 31), tsub = (wv >> 2) * 2 + (lane >> 5);
    const int per = (T_TOK + gridDim.x - 1) / gridDim.x, Tb = blockIdx.x * per, Te = min(Tb + per, T_TOK);
    for (int T = Tb + tsub; T < Te; T += 4) {
        if (g == 0) pool_tok<2>(p, T, ck); else if (g == 1) pool_tok<4>(p, T, ck); else if (g == 2) pool_tok<8>(p, T, ck); else pool_tok<16>(p, T, ck);
    }
}

__device__ void st_gemm_pool(const Params& p) {
    struct OrderPool {
        const char* A; const char* B;
        __device__ __forceinline__ bool next(int i, pg8::Unit& u) const {
            const int item = blockIdx.x + i * gridDim.x; if (item >= 80 * 4) return false;
            const int lt = item >> 3; u.pn = lt & 3; u.pm = (lt >> 2) * 8 + (item & 7);
            u.A = A + (size_t)u.pm * 256 * 1024 * 2 + (size_t)u.pn * 256 * 2; u.B = B + (size_t)u.pn * 256 * 256 * 2; return true;
        }
    } S; S.A = (const char*)p.hbuf; S.B = (const char*)p.wt_pool;
    EpiStoreBf16 E; E.O = p.mix; E.ldc = 1024;
    pg8::gemm_phase<EpiStoreBf16, OrderPool, true, true>((LAS unsigned char*)smem, 1024, 256, 256, S, E);
}

__device__ __forceinline__ void run_stage(const Params& p, int s) {
#ifdef ONLY_STAGE
    if (s != ONLY_STAGE) return;
#endif
    switch (s) {
        case 0: st_prologue(p); break;
        case 1: st_norm<0>(p, 0, 0, p.g_mix[0], p.hbuf); break;
        case 2: st_gemm1(p); break;
        case 3: st_postproj(p); break;
        case 4: st_gemm234(p); break;
        case 18: st_gates(p); break;
        case 5: st_attn_s1(p); break;
        case 6: st_scan3(p); break;
        case 7: st_gemm_o(p); break;
        case 8: st_resnorm<1>(p, 0); break;
        case 9: st_gemm_pq(p, 0); break;
        case 10: st_peer_topk(p, 0); break;
        case 11: st_peer_gather(p, 0); break;
        case 12: st_pool(p); break;
        case 13: st_gemm_pool(p); break;
        case 14: st_resnorm<0>(p, 1); break;
        case 15: st_gemm_pq(p, 1); break;
        case 16: st_peer_topk(p, 1); break;
        case 17: st_peer_gather(p, 1); break;
        default: break;
    }
}

__global__ void __launch_bounds__(NTHR, 2) fwd_mega(Params p) {
    cg::grid_group grid = cg::this_grid();
    volatile LAS unsigned* st = (volatile LAS unsigned*)(smem + 131072);
    if (threadIdx.x == 0) { st[0] = 0; st[1] = 0; st[2] = 0; st[3] = 0; }
    wtab_init();
    __syncthreads();
    XcdBarrier b = xcd_barrier_post(p.bar, st);
    if (p.bar == nullptr) grid.sync();
#ifndef REP_MASK
#define REP_MASK 0
#endif
#define MK_ST(k) run_stage(p, k); if ((REP_MASK >> (k)) & 1) { xcd_barrier(b); run_stage(p, k); } if ((k) != 17) xcd_barrier(b);
    MK_ST(0) MK_ST(1) MK_ST(2) MK_ST(3) run_stage(p, 4); MK_ST(18) MK_ST(5) MK_ST(6) MK_ST(7) MK_ST(8) MK_ST(9) MK_ST(10) MK_ST(11) MK_ST(12) MK_ST(13) MK_ST(14) MK_ST(15) MK_ST(16) MK_ST(17)
}

extern "C" void kernel_launch(void* const* d_in, const int* in_sizes, int n_in, void* d_out, int out_size, void* d_ws, size_t ws_size, hipStream_t stream) {
    constexpr size_t kDynLds = 131072 + 512;
    static int grid_blocks = 0;
    if (!grid_blocks) {
        int dev = 0, cus = 0, per_cu = 0;
        (void)hipGetDevice(&dev);
        (void)hipDeviceGetAttribute(&cus, hipDeviceAttributeMultiprocessorCount, dev);
        (void)hipFuncSetAttribute((const void*)fwd_mega, hipFuncAttributeMaxDynamicSharedMemorySize, (int)kDynLds);
        (void)hipOccupancyMaxActiveBlocksPerMultiprocessor(&per_cu, fwd_mega, NTHR, kDynLds);
        if (per_cu > 1) per_cu = 1;
        if (per_cu < 1) per_cu = 1;
        grid_blocks = cus * per_cu;
    }
    Params p{};
    const float* const* in = (const float* const*)d_in;
    p.x_prompt = in[0]; p.x_sample = in[1]; p.cache_ckv = in[2]; p.cache_krope = in[3]; p.state_lru = in[4]; p.c = in[5]; p.c_ctx = in[6];
    p.w_mod[0] = in[7]; p.b_mod[0] = in[8]; p.w_mod[1] = in[9]; p.b_mod[1] = in[10];
    p.g_mix[0] = in[11]; p.g_ffn[0] = in[12]; p.g_mix[1] = in[13]; p.g_ffn[1] = in[14];
    p.w_in = in[15]; p.g_q = in[16]; p.w_uq = in[17]; p.g_kv = in[18]; p.w_ukv = in[19]; p.conv_w = in[20]; p.conv_b = in[21];
    p.w_rg = in[22]; p.b_rg = in[23]; p.w_ig = in[24]; p.b_ig = in[25]; p.lam = in[26]; p.w_o = in[27]; p.w_pool = in[28]; p.s_pool = in[29];
    p.peer_wq[0] = in[30]; p.peer_keys[0] = in[31]; p.peer_u[0] = in[32]; p.peer_v[0] = in[33];
    p.peer_wq[1] = in[34]; p.peer_keys[1] = in[35]; p.peer_u[1] = in[36]; p.peer_v[1] = in[37];
    p.g_final = in[38];
    p.out = (float*)d_out;
    char* base = (char*)d_ws; size_t off = 0;
    auto take = [&](size_t bytes) { char* r = base + off; off += (bytes + 255) & ~(size_t)255; return r; };
    const size_t MiB = 1u << 20;
    p.bar = (unsigned*)take(16384);
    p.mod = (float*)take((size_t)2 * 9 * 6144 * 4);
    p.ropetab = (float*)take(3072 * 4);
    p.wt_in = (bf16_t*)take((size_t)NW_IN * 2); p.wt_uq = (bf16_t*)take((size_t)NW_UQ * 2); p.wt_ukv = (bf16_t*)take((size_t)NW_UKV * 2);
    p.wt_gate = (bf16_t*)take((size_t)NW_GATE * 2); p.wt_o = (bf16_t*)take((size_t)NW_O * 2); p.wt_pool = (bf16_t*)take((size_t)NW_POOL * 2);
    p.wt_pq[0] = (bf16_t*)take((size_t)NW_PQ * 2); p.wt_pq[1] = (bf16_t*)take((size_t)NW_PQ * 2);
    p.keysb[0] = (bf16_t*)take((size_t)NW_KEYS * 2); p.keysb[1] = (bf16_t*)take((size_t)NW_KEYS * 2);
    for (int l = 0; l < 2; ++l) { p.u8[l] = (u8_t*)take(16 * MiB); p.v8[l] = (u8_t*)take(16 * MiB); p.su[l] = (float*)take(65536); p.sv[l] = (float*)take(65536); }
    char* regX = take(80 * MiB);
    char* regQ = take(80 * MiB);
    char* regH = take(40 * MiB);
    p.P = (bf16_t*)regX; p.a = (float*)regX; p.xres = (float*)regX;
    p.bxb = (bf16_t*)regQ; p.q = (bf16_t*)(regQ + 40 * MiB); p.agg = (float*)(regQ + 70 * MiB); p.qp = (bf16_t*)regQ; p.h3 = (bf16_t*)regQ;
    p.hbuf = (bf16_t*)regH;
    p.cqn = (bf16_t*)take((size_t)T_TOK * 384 * 2); p.ckvk = (bf16_t*)take((size_t)R_KEYS * 256 * 2); p.kropek = (bf16_t*)take((size_t)R_KEYS * 64 * 2);
    p.xc = (bf16_t*)take((size_t)T_TOK * 512 * 2); p.ug = (bf16_t*)take((size_t)T_TOK * 512 * 2);
    p.mix = p.xc;
    p.Kn = (bf16_t*)take((size_t)R_KEYS * 512 * 2); p.vT = (bf16_t*)take((size_t)R_KEYS * 512 * 2);
    p.gates = (float*)p.Kn; p.eidx = (int*)((char*)p.Kn + (size_t)T_TOK * 128 * 4);
    if (off > ws_size) fprintf(stderr, "workspace too small: need %zu have %zu\n", off, ws_size);
    (void)hipMemsetAsync(d_ws, 0, 16384, stream);
    void* args[] = {&p};
    hipError_t e = hipLaunchCooperativeKernel((void*)fwd_mega, dim3(grid_blocks), dim3(NTHR), args, kDynLds, stream);
    if (e != hipSuccess) fprintf(stderr, "cooperative launch failed: %s (grid %d)\n", hipGetErrorString(e), grid_blocks);
}
```

```cpp
#include <hip/hip_runtime.h>
#include <hip/hip_cooperative_groups.h>
#include <cstdio>
#include <cstdint>
namespace cg = cooperative_groups;


typedef unsigned short bf16_t;
typedef unsigned char u8_t;
typedef float f32x16 __attribute__((ext_vector_type(16)));
typedef float f32x2 __attribute__((ext_vector_type(2)));
typedef unsigned u32x4 __attribute__((ext_vector_type(4)));
typedef float f32x4v __attribute__((ext_vector_type(4)));

#define T_TOK 20480
#define T_CTX 4096
#define R_KEYS 22528
#define NSTAGE 19
#define NTHR 512
#define NWV 8
#define LAS __attribute__((address_space(3)))

#define XB_TMO      128
#define XB_XCNT(j)  (256  + 64 * (j))
#define XB_XSUB(j)  (1280 + 64 * (j))
#define XB_XGEN(j)  (2304 + 64 * (j))
#define XB_TOP      3328
#define XB_TOPGEN   3392
#define XCD_BAR_WORDS 3456
#define XB_SPIN_CAP (1u << 22)
__device__ __forceinline__ unsigned xb_ld(unsigned* p)              { return __hip_atomic_load(p, __ATOMIC_RELAXED, __HIP_MEMORY_SCOPE_AGENT); }
__device__ __forceinline__ unsigned xb_add(unsigned* p, unsigned v) { return __hip_atomic_fetch_add(p, v, __ATOMIC_RELAXED, __HIP_MEMORY_SCOPE_AGENT); }
__device__ __forceinline__ unsigned xb_xcc_id() { return (unsigned)__builtin_amdgcn_s_getreg((3 << 11) | 20) & 0xFu; }
#define XB_SPIN(cond, bar) do { unsigned _sp = 0; while (cond) { __builtin_amdgcn_s_sleep(1); \
    if ((++_sp & 255u) == 0u) { if (xb_ld(&(bar)[XB_TMO])) break; if (_sp > XB_SPIN_CAP) { atomicAdd(&(bar)[XB_TMO], 1u); break; } } } } while (0)
struct XcdBarrier { unsigned* bar; unsigned x; volatile LAS unsigned* st; };
__device__ __forceinline__ XcdBarrier xcd_barrier_post(unsigned* bar, volatile LAS unsigned* st) {
    XcdBarrier b; b.bar = bar; b.x = xb_xcc_id(); b.st = st;
    if (threadIdx.x == 0) (void)xb_add(&bar[XB_XCNT(b.x)], 1u);
    return b;
}
__device__ __forceinline__ void xcd_barrier_complete(unsigned* bar, unsigned x, unsigned& nloc, unsigned& nx) {
    const unsigned G = gridDim.x * gridDim.y * gridDim.z;
    unsigned sum, cnt, mine, sp = 0u;
    for (;;) {
        sum = 0u; cnt = 0u; mine = 0u;
#pragma unroll
        for (unsigned j = 0; j < 16; ++j) { const unsigned c = xb_ld(&bar[XB_XCNT(j)]); sum += c; cnt += (c > 0u) ? 1u : 0u; mine = (j == x) ? c : mine; }
        if (sum == G) break;
        __builtin_amdgcn_s_sleep(1);
        if ((++sp & 255u) == 0u) { if (xb_ld(&bar[XB_TMO])) break; if (sp > XB_SPIN_CAP) { atomicAdd(&bar[XB_TMO], 1u); break; } }
    }
    nloc = mine > 0u ? mine : 1u; nx = cnt > 0u ? cnt : 1u;
}
__device__ __forceinline__ int tidx();
__device__ __forceinline__ void xcd_barrier(const XcdBarrier& b) {
    asm volatile("s_waitcnt vmcnt(0)" ::: "memory");
    __syncthreads();
    if (tidx() == 0) {
        unsigned* bar = b.bar;
        __builtin_amdgcn_s_waitcnt(0);
        unsigned nloc = b.st[0], nx = b.st[1];
        if (nloc == 0u) { xcd_barrier_complete(bar, b.x, nloc, nx); b.st[0] = nloc; b.st[1] = nx; }
        const unsigned old = xb_add(&bar[XB_XSUB(b.x)], 1u);
        const unsigned gen = old / nloc;
        if (old + 1u == (gen + 1u) * nloc) {
            __builtin_amdgcn_fence(__ATOMIC_RELEASE, "agent");
            asm volatile("s_waitcnt vmcnt(0)" ::: "memory");
            const unsigned og = xb_add(&bar[XB_TOP], 1u);
            const unsigned tg = og / nx;
            if (og + 1u == (tg + 1u) * nx) xb_add(&bar[XB_TOPGEN], 1u);
            else XB_SPIN(xb_ld(&bar[XB_TOPGEN]) == tg, bar);
            __builtin_amdgcn_fence(__ATOMIC_ACQUIRE, "agent");
            xb_add(&bar[XB_XGEN(b.x)], 1u);
            asm volatile("s_waitcnt vmcnt(0)" ::: "memory");
        } else {
            XB_SPIN(xb_ld(&bar[XB_XGEN(b.x)]) == gen, bar);
            __builtin_amdgcn_fence(__ATOMIC_ACQUIRE, "agent");
            asm volatile("s_waitcnt vmcnt(0)" ::: "memory");
        }
    }
    __syncthreads();
}

struct Params {
    const float *x_prompt, *x_sample, *cache_ckv, *cache_krope, *state_lru, *c, *c_ctx;
    const float *w_mod[2], *b_mod[2], *g_mix[2], *g_ffn[2];
    const float *w_in, *g_q, *w_uq, *g_kv, *w_ukv, *conv_w, *conv_b, *w_rg, *b_rg, *w_ig, *b_ig, *lam, *w_o, *w_pool, *s_pool;
    const float *peer_wq[2], *peer_keys[2], *peer_u[2], *peer_v[2];
    const float* g_final;
    float* out;
    unsigned* bar; float* mod; float* ropetab;
    bf16_t *wt_in, *wt_uq, *wt_ukv, *wt_gate, *wt_o, *wt_pool, *wt_pq[2], *keysb[2];
    u8_t *u8[2], *v8[2]; float *su[2], *sv[2];
    bf16_t *hbuf, *P, *cqn, *ckvk, *kropek, *xc, *ug, *q, *Kn, *vT, *bxb, *qp, *h3;
    float *a, *agg, *xres, *gates; int* eidx;
    bf16_t* mix; float *zbuf, *wbuf; unsigned *hqh, *hql; float* hsc;
};

extern __shared__ __attribute__((aligned(16))) unsigned char smem[];
#define WTAB_OFF (131072 + 64)
__device__ __forceinline__ int hw_wave_slot() { return (int)(__builtin_amdgcn_s_getreg(0x2804) & 63u); }
__device__ __forceinline__ void wtab_init() { if ((threadIdx.x & 63) == 0) ((volatile int*)(smem + WTAB_OFF))[hw_wave_slot()] = (int)(threadIdx.x >> 6); }
__device__ __forceinline__ int tidx() {
    const int w = __builtin_amdgcn_readfirstlane(((volatile int*)(smem + WTAB_OFF))[hw_wave_slot()]);
    return (w << 6) | (int)__builtin_amdgcn_mbcnt_hi(~0u, __builtin_amdgcn_mbcnt_lo(~0u, 0u));
}
__device__ __forceinline__ float bf2f(bf16_t v) { return __uint_as_float(((unsigned)v) << 16); }
typedef __bf16 bf16x2_t __attribute__((ext_vector_type(2)));
__device__ __forceinline__ bf16_t f2bf(float f) { return __builtin_bit_cast(unsigned short, (__bf16)f); }
__device__ __forceinline__ unsigned pack_bf16(float a, float b) { bf16x2_t v = {(__bf16)a, (__bf16)b}; return __builtin_bit_cast(unsigned, v); }
typedef unsigned u32x2 __attribute__((ext_vector_type(2)));
#define DPP_F(v, ctrl) __int_as_float(__builtin_amdgcn_update_dpp(0, __float_as_int(v), ctrl, 0xf, 0xf, true))
__device__ __forceinline__ float wave_sum(float v) {
    v += DPP_F(v, 0xB1); v += DPP_F(v, 0x4E); v += DPP_F(v, 0x141); v += DPP_F(v, 0x128);
    u32x2 r = __builtin_amdgcn_permlane16_swap(__float_as_uint(v), __float_as_uint(v), false, false);
    v = __uint_as_float(r[0]) + __uint_as_float(r[1]);
    r = __builtin_amdgcn_permlane32_swap(__float_as_uint(v), __float_as_uint(v), false, false);
    return __uint_as_float(r[0]) + __uint_as_float(r[1]);
}
__device__ __forceinline__ float wave_max(float v) {
    v = fmaxf(v, DPP_F(v, 0xB1)); v = fmaxf(v, DPP_F(v, 0x4E)); v = fmaxf(v, DPP_F(v, 0x141)); v = fmaxf(v, DPP_F(v, 0x128));
    u32x2 r = __builtin_amdgcn_permlane16_swap(__float_as_uint(v), __float_as_uint(v), false, false);
    v = fmaxf(__uint_as_float(r[0]), __uint_as_float(r[1]));
    r = __builtin_amdgcn_permlane32_swap(__float_as_uint(v), __float_as_uint(v), false, false);
    return fmaxf(__uint_as_float(r[0]), __uint_as_float(r[1]));
}
__device__ __forceinline__ float gelu_tanh(float x) {
    const float u = 0.7978845608028654f * (x + 0.044715f * x * x * x);
    const float e = __expf(2.f * u);
    const float th = 1.f - 2.f / (e + 1.f);
    return 0.5f * x * (1.f + th);
}
__device__ __forceinline__ float sigmoidf_(float x) { return 1.f / (1.f + __expf(-x)); }
__device__ __forceinline__ float silu_(float x) { return x / (1.f + __expf(-x)); }

struct TokInfo { int smp, b, s, S, mi, keyrow; };
__device__ __forceinline__ TokInfo tokinfo(int T) {
    TokInfo t;
    if (T < T_CTX) { t.smp = 0; t.b = T >> 8; t.s = T & 255; t.S = 256; t.mi = 0; t.keyrow = T; }
    else { const int u = T - T_CTX; t.smp = 1; t.b = u >> 11; t.s = u & 2047; t.S = 2048; t.mi = 1 + t.b; t.keyrow = T_CTX + t.b * 2304 + 256 + t.s; }
    return t;
}
__device__ __forceinline__ const float* x_in_row(const Params& p, int T) { return T < T_CTX ? p.x_prompt + (size_t)T * 1024 : p.x_sample + (size_t)(T - T_CTX) * 1024; }
__device__ __forceinline__ const float* modv(const Params& p, int l, int mi, int j) { return p.mod + ((size_t)(l * 9 + mi) * 6 + j) * 1024; }

__device__ __forceinline__ void unpack8(const uint4 r, float (&f)[8]) {
    f[0] = __uint_as_float(r.x << 16); f[1] = __uint_as_float(r.x & 0xffff0000u);
    f[2] = __uint_as_float(r.y << 16); f[3] = __uint_as_float(r.y & 0xffff0000u);
    f[4] = __uint_as_float(r.z << 16); f[5] = __uint_as_float(r.z & 0xffff0000u);
    f[6] = __uint_as_float(r.w << 16); f[7] = __uint_as_float(r.w & 0xffff0000u);
}

namespace pg8 {
typedef short bf16x8 __attribute__((ext_vector_type(8)));
typedef float f32x4 __attribute__((ext_vector_type(4)));
constexpr int BM = 256, BK = 64, HALF = 128, HTB = HALF * BK * 2  , STAGE_BYTES = 8 * HTB;
__device__ __forceinline__ int lds_byte(int r, int c) { const int st = (r >> 4) * 2 + (c >> 5), rr = r & 15, cc = c & 31, ob = rr * 64 + cc * 2; return st * 1024 + (ob ^ (((ob >> 9) & 1) << 5)); }
__device__ __forceinline__ void stage_rc(int b, int& R, int& C) { const int st = b / 1024, sb = b % 1024, swz = sb ^ (((sb >> 9) & 1) << 5); R = (st >> 1) * 16 + swz / 64; C = (st & 1) * 32 + (swz % 64) / 2; }
__device__ __forceinline__ int perm32(int rho) { const int n = rho >> 4, i = rho & 15; return 8 * (i >> 2) + 4 * n + (i & 3); }
struct Unit { int pm, pn; const char* A; const char* B; };
template <class Epi, class Sched, bool ALIGN_EPI, bool SP2>
__device__ __forceinline__ void gemm_phase(LAS unsigned char* lds, const int lda, const int ldb, const int K, const Sched& S, const Epi& E) {
    __builtin_amdgcn_sched_barrier(0);
    const int tid = tidx(), wid = __builtin_amdgcn_readfirstlane(tid >> 6), lane = tid & 63, wr = wid >> 2, wc = wid & 3, fr = lane & 15, fq = lane >> 4;
    const int nt = K / BK;
    unsigned voffA[2], voffB[2];
#pragma unroll
    for (int i = 0; i < 2; ++i) { int R, C; stage_rc(tid * 16 + i * 8192, R, C); const int Rb = Epi::PERM ? ((R & ~31) + perm32(R & 31)) : R;
        voffA[i] = (unsigned)(R * lda + C) * 2u; voffB[i] = (unsigned)(Rb * ldb + C) * 2u; }
    const size_t kstep = (size_t)(BK * 2);
    const size_t hstepA = (size_t)HALF * lda * 2, hstepB = (size_t)HALF * ldb * 2;
    const unsigned ldsw = (unsigned)wid * 1024u;
    const int aoff = lds_byte(wr * 64 + fr, fq * 8), boff = lds_byte(wc * 32 + fr, fq * 8);
#define PG8_SA(b, h) (((b) * 2 + (h)) * HTB)
#define PG8_SB(b, h) ((4 + (b) * 2 + (h)) * HTB)
#define PG8_STAGE(bufoff, gbase, voff) do { _Pragma("unroll") for (int _i = 0; _i < 2; ++_i) \
        __builtin_amdgcn_global_load_lds((const unsigned*)((const char*)(gbase) + (voff)[_i]), (LAS unsigned*)(lds + (bufoff) + ldsw + _i * 8192), 16, 0, 0); } while (0)
#define PG8_LDA(dst, b, h) do { _Pragma("unroll") for (int m = 0; m < 4; ++m) _Pragma("unroll") for (int k = 0; k < 2; ++k) dst[m][k] = *(const LAS bf16x8*)(lds + PG8_SA(b, h) + aoff + m * 2048 + k * 1024); } while (0)
#define PG8_LDB(dst, b, h) do { _Pragma("unroll") for (int n = 0; n < 2; ++n) _Pragma("unroll") for (int k = 0; k < 2; ++k) dst[n][k] = *(const LAS bf16x8*)(lds + PG8_SB(b, h) + boff + n * 2048 + k * 1024); } while (0)
#define PG8_MMA(ai, bj, At, Bt) do { __builtin_amdgcn_s_setprio(1); _Pragma("unroll") for (int m = 0; m < 4; ++m) _Pragma("unroll") for (int n = 0; n < 2; ++n) _Pragma("unroll") for (int k = 0; k < 2; ++k) \
        acc[ai][bj][m][n] = __builtin_amdgcn_mfma_f32_16x16x32_bf16(Bt[n][k], At[m][k], acc[ai][bj][m][n], 0, 0, 0); __builtin_amdgcn_s_setprio(0); } while (0)
#define PG8_WAIT_V(n) asm volatile("s_waitcnt vmcnt(" #n ")" ::: "memory")
#define PG8_WAIT_L(n) asm volatile("s_waitcnt lgkmcnt(" #n ")" ::: "memory")
#define PG8_BAR __builtin_amdgcn_s_barrier()
#define PG8_SCHED __builtin_amdgcn_sched_barrier(0)
    Unit cur, nxt; int ui = 0;
    if (!S.next(0, cur)) return;
    f32x4 acc[2][2][4][2];
#pragma unroll
    for (int a = 0; a < 2; ++a)
#pragma unroll
        for (int b = 0; b < 2; ++b)
#pragma unroll
            for (int m = 0; m < 4; ++m)
#pragma unroll
                for (int n = 0; n < 2; ++n) acc[a][b][m][n] = (f32x4){0.f, 0.f, 0.f, 0.f};
    bf16x8 At[4][2], B0[2][2], B1[2][2];
    const char* cA = cur.A; const char* cB = cur.B;
    if constexpr (SP2) {
        PG8_STAGE(PG8_SB(0, 0), cB, voffB); PG8_STAGE(PG8_SB(0, 1), cB + hstepB, voffB); PG8_STAGE(PG8_SA(0, 0), cA, voffA); PG8_STAGE(PG8_SA(0, 1), cA + hstepA, voffA);
        if (wr == 1) PG8_BAR;
        PG8_WAIT_V(2); PG8_BAR;
        PG8_STAGE(PG8_SB(1, 0), cB + kstep, voffB); PG8_STAGE(PG8_SA(1, 0), cA + kstep, voffA); PG8_STAGE(PG8_SB(1, 1), cB + hstepB + kstep, voffB);
        PG8_WAIT_V(6); PG8_BAR;
    } else {
        PG8_STAGE(PG8_SB(0, 0), cB, voffB); PG8_STAGE(PG8_SA(0, 0), cA, voffA); PG8_STAGE(PG8_SB(0, 1), cB + hstepB, voffB); PG8_STAGE(PG8_SA(0, 1), cA + hstepA, voffA);
        if (wr == 1) PG8_BAR;
        PG8_WAIT_V(4); PG8_BAR;
        PG8_STAGE(PG8_SB(1, 0), cB + kstep, voffB); PG8_STAGE(PG8_SA(1, 0), cA + kstep, voffA); PG8_STAGE(PG8_SB(1, 1), cB + hstepB + kstep, voffB);
        PG8_WAIT_V(6); PG8_BAR;
    }
    for (;;) {
        const bool has_next = S.next(ui + 1, nxt);
        const char* nA = has_next ? nxt.A : cA; const char* nB = has_next ? nxt.B : cB;
#pragma unroll 1
        for (int t = 0; t < nt; t += 2) {
            const bool last = (t == nt - 2);
            const char* a1 = cA + (size_t)(t + 1) * kstep;
            const char* a2 = last ? nA : cA + (size_t)(t + 2) * kstep; const char* b2 = last ? nB : cB + (size_t)(t + 2) * kstep;
            const char* a3 = a2 + kstep; const char* b3 = b2 + kstep;
            if constexpr (SP2) {
            PG8_LDB(B0, 0, 0); PG8_LDB(B1, 0, 1); PG8_SCHED; PG8_LDA(At, 0, 0); PG8_STAGE(PG8_SA(1, 1), a1 + hstepA, voffA);
            PG8_WAIT_V(8); PG8_WAIT_L(0); PG8_BAR; PG8_MMA(0, 0, At, B0); PG8_MMA(0, 1, At, B1); PG8_BAR; PG8_SCHED;
            PG8_LDA(At, 0, 1); PG8_STAGE(PG8_SB(0, 0), b2, voffB); PG8_STAGE(PG8_SB(0, 1), b2 + hstepB, voffB); PG8_STAGE(PG8_SA(0, 0), a2, voffA);
            PG8_WAIT_V(8); PG8_WAIT_L(0); PG8_BAR; PG8_MMA(1, 0, At, B0); PG8_MMA(1, 1, At, B1); PG8_BAR; PG8_SCHED;
            PG8_LDB(B0, 1, 0); PG8_LDB(B1, 1, 1); PG8_SCHED; PG8_LDA(At, 1, 0); PG8_STAGE(PG8_SA(0, 1), a2 + hstepA, voffA);
            PG8_WAIT_V(8); PG8_WAIT_L(0); PG8_BAR; PG8_MMA(0, 0, At, B0); PG8_MMA(0, 1, At, B1); PG8_BAR; PG8_SCHED;
            PG8_LDA(At, 1, 1); PG8_STAGE(PG8_SB(1, 0), b3, voffB); PG8_STAGE(PG8_SB(1, 1), b3 + hstepB, voffB); PG8_STAGE(PG8_SA(1, 0), a3, voffA);
            PG8_WAIT_V(8); PG8_WAIT_L(0); PG8_BAR; PG8_MMA(1, 0, At, B0); PG8_MMA(1, 1, At, B1); PG8_BAR; PG8_SCHED;
            } else {
            PG8_LDB(B0, 0, 0); PG8_SCHED; PG8_LDA(At, 0, 0); PG8_STAGE(PG8_SA(1, 1), a1 + hstepA, voffA);
            PG8_WAIT_L(8); PG8_BAR; PG8_WAIT_L(0); PG8_MMA(0, 0, At, B0); PG8_BAR; PG8_SCHED;
            PG8_LDB(B1, 0, 1); PG8_STAGE(PG8_SB(0, 0), b2, voffB);
            PG8_BAR; PG8_WAIT_L(0); PG8_MMA(0, 1, At, B1); PG8_BAR;
            PG8_LDA(At, 0, 1); PG8_STAGE(PG8_SA(0, 0), a2, voffA);
            PG8_BAR; PG8_WAIT_L(0); PG8_MMA(1, 0, At, B0); PG8_BAR; PG8_SCHED;
            PG8_STAGE(PG8_SB(0, 1), b2 + hstepB, voffB);
            PG8_WAIT_V(6); PG8_BAR; PG8_MMA(1, 1, At, B1); PG8_BAR;
            PG8_LDB(B0, 1, 0); PG8_SCHED; PG8_LDA(At, 1, 0); PG8_STAGE(PG8_SA(0, 1), a2 + hstepA, voffA);
            PG8_WAIT_L(8); PG8_BAR; PG8_WAIT_L(0); PG8_MMA(0, 0, At, B0); PG8_BAR; PG8_SCHED;
            PG8_LDB(B1, 1, 1); PG8_STAGE(PG8_SB(1, 0), b3, voffB);
            PG8_BAR; PG8_WAIT_L(0); PG8_MMA(0, 1, At, B1); PG8_BAR;
            PG8_LDA(At, 1, 1); PG8_STAGE(PG8_SA(1, 0), a3, voffA);
            PG8_BAR; PG8_WAIT_L(0); PG8_MMA(1, 0, At, B0); PG8_BAR; PG8_SCHED;
            PG8_STAGE(PG8_SB(1, 1), b3 + hstepB, voffB);
            PG8_WAIT_V(6); PG8_BAR; PG8_MMA(1, 1, At, B1); PG8_BAR;
            }
        }
        if constexpr (ALIGN_EPI) { if (wr == 0) PG8_BAR; }
        E(acc, cur, wr, wc, fr, fq);
        if (!has_next) break;
#pragma unroll
        for (int a = 0; a < 2; ++a)
#pragma unroll
            for (int b = 0; b < 2; ++b)
#pragma unroll
                for (int m = 0; m < 4; ++m)
#pragma unroll
                    for (int n = 0; n < 2; ++n) acc[a][b][m][n] = (f32x4){0.f, 0.f, 0.f, 0.f};
        cur = nxt; cA = nA; cB = nB; ++ui;
        if constexpr (ALIGN_EPI) { if (wr == 1) PG8_BAR; }
    }
    PG8_WAIT_V(0);
    if constexpr (!ALIGN_EPI) { if (wr == 0) PG8_BAR; }
    PG8_BAR;
    __builtin_amdgcn_sched_barrier(0);
#undef PG8_SA
#undef PG8_SB
#undef PG8_STAGE
#undef PG8_LDA
#undef PG8_LDB
#undef PG8_MMA
#undef PG8_WAIT_V
#undef PG8_WAIT_L
#undef PG8_BAR
#undef PG8_SCHED
}
struct TileOrder {
    int nN, total; const char* A; const char* B; size_t tA, tB;
    __device__ __forceinline__ bool next(int i, Unit& u) const {
        const int item = blockIdx.x + i * gridDim.x; if (item >= total) return false;
        const int lt = item >> 3; u.pn = lt % nN; u.pm = (lt / nN) * 8 + (item & 7);
        u.A = A + (size_t)u.pm * tA; u.B = B + (size_t)u.pn * tB; return true;
    }
};
}

typedef __bf16 bf16x8_t __attribute__((ext_vector_type(8)));
__device__ __forceinline__ int lds_off(int row, int chunk) { return row * 128 + ((chunk ^ ((row >> 1) & 7)) << 4); }
template <int TM, int TN, int WM, int WN>
__device__ __forceinline__ void gemm_acc(const bf16_t* __restrict__ As, int lda, const bf16_t* __restrict__ Bs, int ldb, int K, f32x16 (&acc)[TM][TN]) {
    static_assert(TM * WM == 4 && TN * WN == 4 && WM * WN == 4, "tile is 128 x 128, 4 waves");
    const int tid = tidx() & 255, lane = tid & 63, wid = tid >> 6, wm = wid / WN, wn = wid % WN, hl = lane >> 5, cl = lane & 31;
    unsigned char* sm = smem + (tidx() >> 8) * 65536;
#pragma unroll
    for (int i = 0; i < TM; ++i)
#pragma unroll
        for (int j = 0; j < TN; ++j)
#pragma unroll
            for (int r = 0; r < 16; ++r) acc[i][j][r] = 0.f;
    const int srow0 = wid * 32 + (lane >> 3), pc = lane & 7;
    const bf16_t* ga[4]; const bf16_t* gb[4];
#pragma unroll
    for (int i = 0; i < 4; ++i) {
        const int row = srow0 + 8 * i, lc = pc ^ ((row >> 1) & 7);
        ga[i] = As + (size_t)row * lda + lc * 8; gb[i] = Bs + (size_t)row * ldb + lc * 8;
    }
    unsigned char* lbase = sm + wid * 4096 + lane * 16;
    __syncthreads();
#pragma unroll
    for (int i = 0; i < 4; ++i) {
        __builtin_amdgcn_global_load_lds((const unsigned*)ga[i], (unsigned*)(lbase + i * 1024), 16, 0, 0);
        __builtin_amdgcn_global_load_lds((const unsigned*)gb[i], (unsigned*)(lbase + 16384 + i * 1024), 16, 0, 0);
    }
    asm volatile("s_waitcnt vmcnt(0)" ::: "memory");
    __syncthreads();
    const int nk = K >> 6;
    for (int kt = 0; kt < nk; ++kt) {
        const int cur = (kt & 1) * 32768, nxt = 32768 - cur;
        if (kt + 1 < nk) {
#pragma unroll
            for (int i = 0; i < 4; ++i) {
                __builtin_amdgcn_global_load_lds((const unsigned*)(ga[i] + (kt + 1) * 64), (unsigned*)(lbase + nxt + i * 1024), 16, 0, 0);
                __builtin_amdgcn_global_load_lds((const unsigned*)(gb[i] + (kt + 1) * 64), (unsigned*)(lbase + nxt + 16384 + i * 1024), 16, 0, 0);
            }
        }
#pragma unroll
        for (int ks = 0; ks < 4; ++ks) {
            bf16x8_t af[TM], bfr[TN];
#pragma unroll
            for (int i = 0; i < TM; ++i) af[i] = __builtin_bit_cast(bf16x8_t, *(const u32x4*)(sm + cur + lds_off(32 * (TM * wm + i) + cl, 2 * ks + hl)));
#pragma unroll
            for (int j = 0; j < TN; ++j) bfr[j] = __builtin_bit_cast(bf16x8_t, *(const u32x4*)(sm + cur + 16384 + lds_off(32 * (TN * wn + j) + cl, 2 * ks + hl)));
#pragma unroll
            for (int i = 0; i < TM; ++i)
#pragma unroll
                for (int j = 0; j < TN; ++j) acc[i][j] = __builtin_amdgcn_mfma_f32_32x32x16_bf16(af[i], bfr[j], acc[i][j], 0, 0, 0);
        }
        asm volatile("s_waitcnt vmcnt(0)" ::: "memory");
        __syncthreads();
    }
}
#define ACC_ROW(TMv, wm, i, r, hl) (32 * ((TMv) * (wm) + (i)) + ((r) & 3) + 8 * ((r) >> 2) + 4 * (hl))
#define ACC_COL(TNv, wn, j, cl)    (32 * ((TNv) * (wn) + (j)) + (cl))

#define N_ADA 384
#define NW_IN   (1792 * 1024)
#define NW_UQ   (768 * 384)
#define NW_UKV  (1024 * 256)
#define NW_GATE (4 * 512 * 128)
#define NW_O    (1024 * 1024)
#define NW_POOL (4 * 256 * 256)
#define NW_PQ   (2048 * 1024)
#define NW_KEYS (16 * 128 * 128)
#define NW_CKV  (8 * 256 * 256)
#define NW_CKR  (8 * 256 * 64)
#define NW_ROPE 3072
#define NT_IN 448
#define NT_UQ 72
#define NT_UKV 64
#define NT_O 256
#define NT_POOL 64
#define NT_PQ 512
#define N_TR (NT_IN + NT_UQ + NT_UKV + NT_O + NT_POOL + 2 * NT_PQ)
#define NE_TOTAL (NW_GATE + 2 * NW_KEYS + NW_CKV + NW_CKR + NW_ROPE)
#define N_CONV_ITEMS ((NE_TOTAL + 4095) / 4096)
#define N_FP8_ITEMS (65536 / NWV / 4)

__device__ __forceinline__ void conv_elem(const Params& p, int e) {
    if (e < NW_GATE) {
        const int c = e & 127, cg = (e >> 7) & 511, nb = e >> 16;
        const int dir = cg >> 8, dg = (cg >> 6) & 3, ri = (cg >> 5) & 1, d = dg * 32 + (cg & 31);
        const float* src = ri ? p.w_ig : p.w_rg;
        p.wt_gate[e] = f2bf(src[(((size_t)dir * 4 + nb) * 128 + c) * 128 + d]); return; } e -= NW_GATE;
#pragma unroll
    for (int l = 0; l < 2; ++l) { if (e < NW_KEYS) { p.keysb[l][e] = f2bf(p.peer_keys[l][e]); return; } e -= NW_KEYS; }
    if (e < NW_CKV) { const int col = e & 255, j = (e >> 8) & 255, b = e >> 16; p.ckvk[(size_t)(T_CTX + b * 2304 + j) * 256 + col] = f2bf(p.cache_ckv[e]); return; } e -= NW_CKV;
    if (e < NW_CKR) { const int col = e & 63, j = (e >> 6) & 255, b = e >> 14; p.kropek[(size_t)(T_CTX + b * 2304 + j) * 64 + col] = f2bf(p.cache_krope[e]); return; } e -= NW_CKR;
    if (e < NW_ROPE) {
        int idx = e, isrow = e < 1024; if (!isrow) idx -= 1024;
        const int half = isrow ? 512 : 1024; const int sn = idx >= half; if (sn) idx -= half;
        const int pos = idx >> 4, fi = idx & 15;
        const float invf = exp2f(-(float)fi * (13.287712379549449f / 16.f));
        const float ang = (float)pos * invf;
        p.ropetab[e] = sn ? sinf(ang) : cosf(ang); return; }
}
__device__ __forceinline__ void tr_tile(const float* __restrict__ src, int ldsrc, int nvalid, bf16_t* __restrict__ dst, int lddst, int k0, int n0, float scl = 1.f) {
    float* tile = (float*)(smem + (tidx() >> 8) * 32768);
    const int tid = tidx() & 255;
    __syncthreads();
#pragma unroll
    for (int i = 0; i < 4; ++i) {
        const int k = (tid >> 4) + 16 * i, n = (tid & 15) * 4;
        float4 v = make_float4(0.f, 0.f, 0.f, 0.f);
        if (n0 + n < nvalid) v = *(const float4*)(src + (size_t)(k0 + k) * ldsrc + n0 + n);
        tile[k * 65 + n] = v.x; tile[k * 65 + n + 1] = v.y; tile[k * 65 + n + 2] = v.z; tile[k * 65 + n + 3] = v.w;
    }
    __syncthreads();
    const int n = tid >> 2, kq = (tid & 3) * 16;
    unsigned w[8];
#pragma unroll
    for (int j = 0; j < 8; ++j) w[j] = pack_bf16(tile[(kq + 2 * j) * 65 + n] * scl, tile[(kq + 2 * j + 1) * 65 + n] * scl);
    uint4* d = (uint4*)(dst + (size_t)(n0 + n) * lddst + k0 + kq);
    d[0] = make_uint4(w[0], w[1], w[2], w[3]); d[1] = make_uint4(w[4], w[5], w[6], w[7]);
}
__device__ __forceinline__ void tr_item(const Params& p, int t) {
    if (t < NT_IN) { tr_tile(p.w_in, 1728, 1728, p.wt_in, 1024, (t % 16) * 64, (t / 16) * 64); return; } t -= NT_IN;
    if (t < NT_UQ) { tr_tile(p.w_uq, 768, 768, p.wt_uq, 384, (t % 6) * 64, (t / 6) * 64, 0.07216878364870322f * 1.4426950408889634f  ); return; } t -= NT_UQ;
    if (t < NT_UKV) {
        const int n0 = (t / 4) * 64, h = n0 >> 8, kv = (n0 >> 7) & 1, nn = kv * 512 + h * 128 + (n0 & 127);
        tr_tile(p.w_ukv, 1024, 1024, p.wt_ukv + ((ptrdiff_t)nn - n0) * 256, 256, (t % 4) * 64, n0); return; } t -= NT_UKV;
    if (t < NT_O) { tr_tile(p.w_o, 1024, 1024, p.wt_o, 1024, (t % 16) * 64, (t / 16) * 64); return; } t -= NT_O;
    if (t < NT_POOL) { const int g = t >> 4, tt = t & 15; tr_tile(p.w_pool + (size_t)g * 65536, 256, 256, p.wt_pool + (size_t)g * 65536, 256, (tt & 3) * 64, (tt >> 2) * 64); return; } t -= NT_POOL;
    if (t < NT_PQ) { tr_tile(p.peer_wq[0], 2048, 2048, p.wt_pq[0], 1024, (t % 16) * 64, (t / 16) * 64); return; } t -= NT_PQ;
    tr_tile(p.peer_wq[1], 2048, 2048, p.wt_pq[1], 1024, (t % 16) * 64, (t / 16) * 64);
}

__device__ void st_prologue(const Params& p) {
    const int tid = tidx(), lane = tid & 63, wid = tid >> 6;
    const int n_items = N_ADA + N_TR / 2 + N_CONV_ITEMS + N_FP8_ITEMS;
    for (int item = blockIdx.x; item < n_items; item += gridDim.x) {
        if (item < N_ADA) {
            float* svec = (float*)smem;
            float* red = (float*)(smem + 9 * 4096);
            __syncthreads();
            for (int i = tid; i < 9 * 1024; i += NTHR) { const int bc = i >> 10, k = i & 1023; const float cv = bc == 0 ? p.c_ctx[k] : p.c[(size_t)(bc - 1) * 1024 + k]; svec[i] = silu_(cv); }
            __syncthreads();
            const int cidx = item * 32 + (lane & 7) * 4, l = cidx / 6144, col = cidx % 6144, k0 = (wid * 8 + (lane >> 3)) * 16;
            const float* w = p.w_mod[l] + (size_t)k0 * 6144 + col;
            float acc[9][4];
#pragma unroll
            for (int b = 0; b < 9; ++b) { acc[b][0] = 0.f; acc[b][1] = 0.f; acc[b][2] = 0.f; acc[b][3] = 0.f; }
#pragma unroll 8
            for (int k = 0; k < 16; ++k) {
                const float4 wv = *(const float4*)(w + (size_t)k * 6144);
#pragma unroll
                for (int b = 0; b < 9; ++b) { const float sv = svec[b * 1024 + k0 + k]; acc[b][0] += wv.x * sv; acc[b][1] += wv.y * sv; acc[b][2] += wv.z * sv; acc[b][3] += wv.w * sv; }
            }
#pragma unroll
            for (int b = 0; b < 9; ++b)
#pragma unroll
                for (int j = 0; j < 4; ++j) { float v = acc[b][j]; v += __shfl_xor(v, 8); v += __shfl_xor(v, 16); v += __shfl_xor(v, 32); acc[b][j] = v; }
            if (lane < 8) {
#pragma unroll
                for (int b = 0; b < 9; ++b)
#pragma unroll
                    for (int j = 0; j < 4; ++j) red[(wid * 9 + b) * 32 + lane * 4 + j] = acc[b][j];
            }
            __syncthreads();
            for (int i = tid; i < 9 * 32; i += NTHR) {
                const int b = i >> 5, c = i & 31;
                const int ci = item * 32 + c, ll = ci / 6144, cc = ci % 6144;
                float v = 0.f;
#pragma unroll
                for (int w8 = 0; w8 < 8; ++w8) v += red[(w8 * 9 + b) * 32 + c];
                p.mod[(size_t)(ll * 9 + b) * 6144 + cc] = v + p.b_mod[ll][cc];
            }
        } else if (item < N_ADA + N_TR / 2) {
            tr_item(p, (item - N_ADA) * 2 + (tid >> 8));
        } else if (item < N_ADA + N_TR / 2 + N_CONV_ITEMS) {
            const int base = (item - N_ADA - N_TR / 2) * 4096;
            for (int i = tid; i < 4096; i += NTHR) { const int e = base + i; if (e < NE_TOTAL) conv_elem(p, e); }
        } else {
            const int row0 = ((item - N_ADA - N_TR / 2 - N_CONV_ITEMS) * NWV + wid) * 4;
            const int tb = row0 >> 14, er0 = row0 & 16383, l = tb >> 1;
            const float* src = ((tb & 1) ? p.peer_v[l] : p.peer_u[l]) + (size_t)er0 * 1024 + lane * 16;
            u8_t* dst = ((tb & 1) ? p.v8[l] : p.u8[l]) + (size_t)er0 * 512 + lane * 8;
            float* sc = ((tb & 1) ? p.sv[l] : p.su[l]) + er0;
            f32x4v f[4][4];
#pragma unroll
            for (int r = 0; r < 4; ++r)
#pragma unroll
                for (int j = 0; j < 4; ++j) f[r][j] = __builtin_nontemporal_load((const f32x4v*)(src + (size_t)r * 1024 + 4 * j));
#pragma unroll
            for (int r = 0; r < 4; ++r) {
                float am = 0.f, sq = 0.f;
#pragma unroll
                for (int j = 0; j < 4; ++j) {
                    am = fmaxf(fmaxf(am, fmaxf(fabsf(f[r][j][0]), fabsf(f[r][j][1]))), fmaxf(fabsf(f[r][j][2]), fabsf(f[r][j][3])));
                    sq += (f[r][j][0] * f[r][j][0] + f[r][j][1] * f[r][j][1]) + (f[r][j][2] * f[r][j][2] + f[r][j][3] * f[r][j][3]);
                }
                unsigned w[2]; float scale;
                if (tb & 1) {
                    am = wave_max(am);
                    scale = am > 0.f ? am * (1.f / 6.f) : 1.f; const float inv = am > 0.f ? 6.f / am : 1.f;
#pragma unroll
                    for (int j = 0; j < 2; ++j) {
                        unsigned pk = 0u;
                        pk = __builtin_amdgcn_cvt_scalef32_pk_fp4_f32(pk, f[r][2 * j][0] * inv, f[r][2 * j][1] * inv, 1.0f, 0);
                        pk = __builtin_amdgcn_cvt_scalef32_pk_fp4_f32(pk, f[r][2 * j][2] * inv, f[r][2 * j][3] * inv, 1.0f, 1);
                        pk = __builtin_amdgcn_cvt_scalef32_pk_fp4_f32(pk, f[r][2 * j + 1][0] * inv, f[r][2 * j + 1][1] * inv, 1.0f, 2);
                        pk = __builtin_amdgcn_cvt_scalef32_pk_fp4_f32(pk, f[r][2 * j + 1][2] * inv, f[r][2 * j + 1][3] * inv, 1.0f, 3);
                        w[j] = pk;
                    }
                } else {
                    sq = wave_sum(sq);
                    const float rms = sqrtf(sq * (1.f / 1024.f));
                    scale = rms > 0.f ? 0.3352f * rms : 1.f; const float inv = 1.f / scale;
#pragma unroll
                    for (int j = 0; j < 2; ++j) {
                        unsigned pk = 0u;
#pragma unroll
                        for (int i = 0; i < 8; ++i) {
                            const float x = f[r][2 * j + (i >> 2)][i & 3] * inv;
                            const int q = (int)fminf(fmaxf(rintf(x), -8.f), 7.f);
                            pk |= ((unsigned)q & 15u) << (4 * i);
                        }
                        w[j] = pk;
                    }
                }
                *(uint2*)(dst + (size_t)r * 512) = make_uint2(w[0], w[1]);
                if (lane == 0) sc[r] = scale;
            }
        }
    }
}

template <int FIRST>
__device__ void st_resnorm(const Params& p, int l) {
    const int lane = tidx() & 63, wid = tidx() >> 6, stride = gridDim.x * NWV;
    for (int T0 = blockIdx.x * NWV + wid; T0 < T_TOK; T0 += 2 * stride) {
        float4 xa[2][4]; uint4 ma[2][2];
#pragma unroll
        for (int u = 0; u < 2; ++u) {
            const int T = min(T0 + u * stride, T_TOK - 1);
            const float* x0 = FIRST ? x_in_row(p, T) + lane * 16 : p.xres + (size_t)T * 1024 + lane * 16;
            const uint4* mp = (const uint4*)(p.mix + (size_t)T * 1024 + lane * 16);
#pragma unroll
            for (int j = 0; j < 4; ++j) xa[u][j] = *(const float4*)(x0 + 4 * j);
            ma[u][0] = mp[0]; ma[u][1] = mp[1];
        }
#pragma unroll
        for (int u = 0; u < 2; ++u) {
            const int T = T0 + u * stride;
            if (T < T_TOK) {
                const TokInfo ti = tokinfo(T);
                float* xr = p.xres + (size_t)T * 1024 + lane * 16;
                const float* gt = modv(p, l, ti.mi, 2) + lane * 16;
                float m[16]; { float t8[8]; unpack8(ma[u][0], t8);
#pragma unroll
                    for (int j = 0; j < 8; ++j) m[j] = t8[j];
                    unpack8(ma[u][1], t8);
#pragma unroll
                    for (int j = 0; j < 8; ++j) m[8 + j] = t8[j]; }
                float v[16]; float ss = 0.f;
#pragma unroll
                for (int j = 0; j < 4; ++j) {
                    const float4 f = xa[u][j]; float4 g = *(const float4*)(gt + 4 * j);
                    if (!FIRST) { const float4 sp = *(const float4*)(p.s_pool + lane * 16 + 4 * j); g.x *= sp.x; g.y *= sp.y; g.z *= sp.z; g.w *= sp.w; }
                    v[4 * j] = f.x + g.x * m[4 * j]; v[4 * j + 1] = f.y + g.y * m[4 * j + 1]; v[4 * j + 2] = f.z + g.z * m[4 * j + 2]; v[4 * j + 3] = f.w + g.w * m[4 * j + 3];
                    *(float4*)(xr + 4 * j) = make_float4(v[4 * j], v[4 * j + 1], v[4 * j + 2], v[4 * j + 3]);
                }
#pragma unroll
                for (int j = 0; j < 16; ++j) ss += v[j] * v[j];
                ss = wave_sum(ss);
                const float rstd = rsqrtf(ss * (1.f / 1024.f) + 1e-6f);
                const float* sh = modv(p, l, ti.mi, 3) + lane * 16; const float* sc = modv(p, l, ti.mi, 4) + lane * 16; const float* gg = p.g_ffn[l] + lane * 16;
                float hval[16]; float hm = 0.f;
#pragma unroll
                for (int j = 0; j < 16; ++j) { hval[j] = v[j] * rstd * gg[j] * (1.f + sc[j]) + sh[j]; hm = fmaxf(hm, fabsf(hval[j])); }
                unsigned w[8];
#pragma unroll
                for (int j = 0; j < 8; ++j) w[j] = pack_bf16(hval[2 * j], hval[2 * j + 1]);
                uint4* d = (uint4*)(p.hbuf + (size_t)T * 1024 + lane * 16);
                d[0] = make_uint4(w[0], w[1], w[2], w[3]); d[1] = make_uint4(w[4], w[5], w[6], w[7]);
                hm = wave_max(hm);
                const float hs = hm > 0.f ? hm * (1.f / 119.f) : 1.f, hinv = 1.f / hs;
                unsigned ph[2] = {0u, 0u}, pl[2] = {0u, 0u};
#pragma unroll
                for (int j = 0; j < 16; ++j) {
                    const int h8 = (int)rintf(hval[j] * hinv);
                    const int lo = ((h8 + 8) & 15) - 8, hi = (h8 - lo) >> 4;
                    ph[j >> 3] |= ((unsigned)hi & 15u) << (4 * (j & 7)); pl[j >> 3] |= ((unsigned)lo & 15u) << (4 * (j & 7));
                }
                *(uint2*)(p.hqh + (size_t)T * 128 + lane * 2) = make_uint2(ph[0], ph[1]);
                *(uint2*)(p.hql + (size_t)T * 128 + lane * 2) = make_uint2(pl[0], pl[1]);
                if (lane == 0) p.hsc[T] = hs;
            }
        }
    }
}

template <int SRC>
__device__ void st_norm(const Params& p, int l, int which, const float* g, bf16_t* dst) {
    const int lane = tidx() & 63, wid = tidx() >> 6, stride = gridDim.x * NWV;
    for (int T0 = blockIdx.x * NWV + wid; T0 < T_TOK; T0 += 2 * stride) {
        float v[2][16];
#pragma unroll
        for (int u = 0; u < 2; ++u) {
            const int T = min(T0 + u * stride, T_TOK - 1);
            const float* src = (SRC == 0 ? x_in_row(p, T) : p.xres + (size_t)T * 1024) + lane * 16;
#pragma unroll
            for (int j = 0; j < 4; ++j) { const float4 f = *(const float4*)(src + 4 * j); v[u][4 * j] = f.x; v[u][4 * j + 1] = f.y; v[u][4 * j + 2] = f.z; v[u][4 * j + 3] = f.w; }
        }
#pragma unroll
        for (int u = 0; u < 2; ++u) {
            const int T = T0 + u * stride;
            if (T < T_TOK) {
                const TokInfo ti = tokinfo(T);
                float ss = 0.f;
#pragma unroll
                for (int j = 0; j < 16; ++j) ss += v[u][j] * v[u][j];
                ss = wave_sum(ss);
                const float rstd = rsqrtf(ss * (1.f / 1024.f) + 1e-6f);
                const float* sh = modv(p, l, ti.mi, which ? 3 : 0) + lane * 16; const float* sc = modv(p, l, ti.mi, which ? 4 : 1) + lane * 16; const float* gg = g + lane * 16;
                unsigned w[8];
#pragma unroll
                for (int j = 0; j < 8; ++j) w[j] = pack_bf16(v[u][2 * j] * rstd * gg[2 * j] * (1.f + sc[2 * j]) + sh[2 * j], v[u][2 * j + 1] * rstd * gg[2 * j + 1] * (1.f + sc[2 * j + 1]) + sh[2 * j + 1]);
                uint4* d = (uint4*)(dst + (size_t)T * 1024 + lane * 16);
                d[0] = make_uint4(w[0], w[1], w[2], w[3]); d[1] = make_uint4(w[4], w[5], w[6], w[7]);
            }
        }
    }
}

struct EpiStoreBf16 {
    static constexpr bool PERM = true;
    bf16_t* O; int ldc;
    __device__ __forceinline__ void operator()(const pg8::f32x4 (&acc)[2][2][4][2], const pg8::Unit& u, int wr, int wc, int fr, int fq) const {
#pragma unroll
        for (int ai = 0; ai < 2; ++ai)
#pragma unroll
            for (int m = 0; m < 4; ++m) {
                bf16_t* rowp = O + (size_t)(u.pm * 256 + ai * 128 + wr * 64 + m * 16 + fr) * ldc + u.pn * 256 + wc * 32 + 8 * fq;
#pragma unroll
                for (int bj = 0; bj < 2; ++bj) {
                    const pg8::f32x4 v0 = acc[ai][bj][m][0], v1 = acc[ai][bj][m][1];
                    *(uint4*)(rowp + bj * 128) = make_uint4(pack_bf16(v0[0], v0[1]), pack_bf16(v0[2], v0[3]), pack_bf16(v1[0], v1[1]), pack_bf16(v1[2], v1[3]));
                }
            }
    }
};
__device__ void st_gemm1(const Params& p) {
    pg8::TileOrder S; S.nN = 7; S.total = 80 * 7; S.A = (const char*)p.hbuf; S.B = (const char*)p.wt_in; S.tA = (size_t)256 * 1024 * 2; S.tB = (size_t)256 * 1024 * 2;
    EpiStoreBf16 E; E.O = p.P; E.ldc = 1792;
    pg8::gemm_phase<EpiStoreBf16, pg8::TileOrder, true, true>((LAS unsigned char*)smem, 1024, 1024, 1024, S, E);
}

__device__ void st_postproj(const Params& p) {
    const int lane = tidx() & 63, wid = tidx() >> 6;
    float* o_ckv = p.out + 20971520, *o_kr = p.out + 22020096;
    for (int T = blockIdx.x * NWV + wid; T < T_TOK; T += gridDim.x * NWV) {
        const TokInfo ti = tokinfo(T);
        const bf16_t* Pr = p.P + (size_t)T * 1792;
        float cq[8], ck[8];
#pragma unroll
        for (int j = 0; j < 8; ++j) { cq[j] = 0.f; ck[j] = 0.f; }
        if (lane < 48) unpack8(*(const uint4*)(Pr + lane * 8), cq);
        if (lane < 32) unpack8(*(const uint4*)(Pr + 384 + lane * 8), ck);
        float s1 = 0.f, s2 = 0.f;
#pragma unroll
        for (int j = 0; j < 8; ++j) { s1 += cq[j] * cq[j]; s2 += ck[j] * ck[j]; }
        s1 = wave_sum(s1); s2 = wave_sum(s2);
        const float r1 = rsqrtf(s1 * (1.f / 384.f) + 1e-6f), r2 = rsqrtf(s2 * (1.f / 256.f) + 1e-6f);
        if (lane < 48) {
            const float4 ga = *(const float4*)(p.g_q + lane * 8), gb = *(const float4*)(p.g_q + lane * 8 + 4);
            uint4 o; o.x = pack_bf16(cq[0] * r1 * ga.x, cq[1] * r1 * ga.y); o.y = pack_bf16(cq[2] * r1 * ga.z, cq[3] * r1 * ga.w);
            o.z = pack_bf16(cq[4] * r1 * gb.x, cq[5] * r1 * gb.y); o.w = pack_bf16(cq[6] * r1 * gb.z, cq[7] * r1 * gb.w);
            *(uint4*)(p.cqn + (size_t)T * 384 + lane * 8) = o;
        }
        if (lane < 32) {
            const float4 ga = *(const float4*)(p.g_kv + lane * 8), gb = *(const float4*)(p.g_kv + lane * 8 + 4);
            float y[8] = {ck[0] * r2 * ga.x, ck[1] * r2 * ga.y, ck[2] * r2 * ga.z, ck[3] * r2 * ga.w, ck[4] * r2 * gb.x, ck[5] * r2 * gb.y, ck[6] * r2 * gb.z, ck[7] * r2 * gb.w};
            uint4 o; o.x = pack_bf16(y[0], y[1]); o.y = pack_bf16(y[2], y[3]); o.z = pack_bf16(y[4], y[5]); o.w = pack_bf16(y[6], y[7]);
            *(uint4*)(p.ckvk + (size_t)ti.keyrow * 256 + lane * 8) = o;
            if (!ti.smp) { float4* d = (float4*)(o_ckv + (size_t)T * 256 + lane * 8); d[0] = make_float4(y[0], y[1], y[2], y[3]); d[1] = make_float4(y[4], y[5], y[6], y[7]); }
        }
        if (lane < 8) {
            float v[8]; unpack8(*(const uint4*)(Pr + 640 + lane * 8), v);
            float y[8];
            if (ti.smp) {
                const int gr = ti.s >> 6, gc = ti.s & 63;
#pragma unroll
                for (int i = 0; i < 4; ++i) {
                    const int pr = lane * 4 + i;
                    const float cs = pr < 16 ? p.ropetab[gr * 16 + pr] : p.ropetab[1024 + gc * 16 + (pr - 16)];
                    const float sn = pr < 16 ? p.ropetab[512 + gr * 16 + pr] : p.ropetab[2048 + gc * 16 + (pr - 16)];
                    y[2 * i] = v[2 * i] * cs - v[2 * i + 1] * sn; y[2 * i + 1] = v[2 * i] * sn + v[2 * i + 1] * cs;
                }
            } else {
#pragma unroll
                for (int i = 0; i < 8; ++i) y[i] = v[i];
                float4* d = (float4*)(o_kr + (size_t)T * 64 + lane * 8); d[0] = make_float4(v[0], v[1], v[2], v[3]); d[1] = make_float4(v[4], v[5], v[6], v[7]);
            }
            uint4 o; o.x = pack_bf16(y[0], y[1]); o.y = pack_bf16(y[2], y[3]); o.z = pack_bf16(y[4], y[5]); o.w = pack_bf16(y[6], y[7]);
            *(uint4*)(p.kropek + (size_t)ti.keyrow * 64 + lane * 8) = o;
        }
        {
            const int ch = lane * 8;
            float y[8];
            { const float4 a = *(const float4*)(p.conv_b + ch), b = *(const float4*)(p.conv_b + ch + 4); y[0] = a.x; y[1] = a.y; y[2] = a.z; y[3] = a.w; y[4] = b.x; y[5] = b.y; y[6] = b.z; y[7] = b.w; }
#pragma unroll
            for (int k = 0; k < 4; ++k) {
                const int s2i = ti.s + k - 2;
                if (s2i >= 0 && s2i < ti.S) {
                    float u[8]; unpack8(*(const uint4*)(p.P + (size_t)(T + k - 2) * 1792 + 704 + ch), u);
                    const float4 a = *(const float4*)(p.conv_w + k * 512 + ch), b = *(const float4*)(p.conv_w + k * 512 + ch + 4);
                    y[0] += a.x * u[0]; y[1] += a.y * u[1]; y[2] += a.z * u[2]; y[3] += a.w * u[3]; y[4] += b.x * u[4]; y[5] += b.y * u[5]; y[6] += b.z * u[6]; y[7] += b.w * u[7];
                }
            }
            uint4 o; o.x = pack_bf16(y[0], y[1]); o.y = pack_bf16(y[2], y[3]); o.z = pack_bf16(y[4], y[5]); o.w = pack_bf16(y[6], y[7]);
            *(uint4*)(p.xc + (size_t)T * 512 + ch) = o;
            *(uint4*)(p.ug + (size_t)T * 512 + ch) = *(const uint4*)(Pr + 1216 + ch);
        }
    }
}

struct EpiVT {
    static constexpr bool PERM = true;
    bf16_t* vT;
    __device__ __forceinline__ void operator()(const pg8::f32x4 (&acc)[2][2][4][2], const pg8::Unit& u, int wr, int wc, int fr, int fq) const {
        const int R0 = u.pn * 256;
        size_t sbase; int Sk, pos0;
        if (R0 < T_CTX) { Sk = 256; pos0 = 0; sbase = (size_t)(R0 >> 8) * 4 * 128 * 256; }
        else { const int uu = R0 - T_CTX; const int sq = uu / 2304; Sk = 2304; pos0 = uu - sq * 2304; sbase = (size_t)T_CTX * 512 + (size_t)sq * 4 * 128 * 2304; }
        bf16_t* vb = vT + sbase + pos0 + wc * 32 + 8 * fq;
#pragma unroll
        for (int ai = 0; ai < 2; ++ai)
#pragma unroll
            for (int m = 0; m < 4; ++m) {
                const int r = u.pm * 256 + ai * 128 + wr * 64 + m * 16 + fr;
                bf16_t* rowp = vb + (size_t)r * Sk;
#pragma unroll
                for (int bj = 0; bj < 2; ++bj) {
                    const pg8::f32x4 v0 = acc[ai][bj][m][0], v1 = acc[ai][bj][m][1];
                    *(uint4*)(rowp + bj * 128) = make_uint4(pack_bf16(v0[0], v0[1]), pack_bf16(v0[2], v0[3]), pack_bf16(v1[0], v1[1]), pack_bf16(v1[2], v1[3]));
                }
            }
    }
};
#define N_G4 (160 * 16)
__device__ void st_gemm234(const Params& p) {
    {
        pg8::TileOrder S; S.nN = 3; S.total = 80 * 3; S.A = (const char*)p.cqn; S.B = (const char*)p.wt_uq; S.tA = (size_t)256 * 384 * 2; S.tB = (size_t)256 * 384 * 2;
        EpiStoreBf16 E; E.O = p.q; E.ldc = 768;
        pg8::gemm_phase<EpiStoreBf16, pg8::TileOrder, true, true>((LAS unsigned char*)smem, 384, 384, 384, S, E);
    }
    {
        pg8::TileOrder S; S.nN = 2; S.total = 88 * 2; S.A = (const char*)p.ckvk; S.B = (const char*)p.wt_ukv; S.tA = (size_t)256 * 256 * 2; S.tB = (size_t)256 * 256 * 2;
        EpiStoreBf16 E; E.O = p.Kn; E.ldc = 512;
        pg8::gemm_phase<EpiStoreBf16, pg8::TileOrder, true, true>((LAS unsigned char*)smem, 256, 256, 256, S, E);
    }
    {
        struct OrderVT {
            const char* W; const char* Kr;
            __device__ __forceinline__ bool next(int i, pg8::Unit& u) const {
                const int item = blockIdx.x + i * gridDim.x; if (item >= 88 * 2) return false;
                const int lt = item >> 3; u.pm = lt & 1; u.pn = (lt >> 1) * 8 + (item & 7);
                u.A = W + (size_t)u.pm * 256 * 256 * 2; u.B = Kr + (size_t)u.pn * 256 * 256 * 2; return true;
            }
        } S; S.W = (const char*)(p.wt_ukv + (size_t)512 * 256); S.Kr = (const char*)p.ckvk;
        EpiVT E; E.vT = p.vT;
        pg8::gemm_phase<EpiVT, OrderVT, true, true>((LAS unsigned char*)smem, 256, 256, 256, S, E);
    }
}

__device__ void st_gates(const Params& p) {
    const int half = tidx() >> 8, lane = tidx() & 63, wid = (tidx() >> 6) & 3, wm = wid >> 1, wn = wid & 1, hl = lane >> 5, cl = lane & 31;
    for (int item = blockIdx.x; item < N_G4 / 2; item += gridDim.x) {
        f32x16 acc[2][2];
        {
            const int lt = (item >> 3) * 2 + half, tj = lt & 3, nb = (lt >> 2) & 3, tm = (lt >> 4) * 8 + (item & 7);
            gemm_acc<2, 2, 2, 2>(p.xc + (size_t)tm * 128 * 512 + nb * 128, 512, p.wt_gate + ((size_t)nb * 512 + tj * 128) * 128, 128, 128, acc);
            const int dir = tj >> 1, dg = (tj & 1) * 2 + wn, ch = nb * 128 + dg * 32 + cl;
            const float brg = p.b_rg[dir * 512 + ch], big = p.b_ig[dir * 512 + ch];
            const float nl = -p.lam[dir * 512 + ch];
            const float sp = fmaxf(nl, 0.f) + log1pf(__expf(-fabsf(nl)));
#pragma unroll
            for (int i = 0; i < 2; ++i)
#pragma unroll
                for (int r = 0; r < 16; ++r) {
                    const int T = tm * 128 + ACC_ROW(2, wm, i, r, hl);
                    const float rg = __builtin_amdgcn_rcpf(1.f + __expf(-(acc[i][0][r] + brg))), ig = __builtin_amdgcn_rcpf(1.f + __expf(-(acc[i][1][r] + big)));
                    const float la = -8.f * rg * sp;
                    const float av = __expf(la);
                    const float mult = __builtin_amdgcn_sqrtf(fmaxf(1.f - av * av, 0.f));
                    const float xv = bf2f(p.xc[(size_t)T * 512 + ch]);
                    p.a[((size_t)T * 2 + dir) * 512 + ch] = av;
                    p.bxb[((size_t)T * 2 + dir) * 512 + ch] = f2bf(mult * ig * xv);
                }
        }
    }
}

#define N_ATT (64 + 256)
#define SCH 64
#define NCHK (T_TOK / SCH)
#define N_S1 (NCHK * 2)
__device__ void scan_s1_item(const Params& p, int it) {
    const int chunk = it >> 1, dc = (it & 1) * 512 + tidx(), dir = dc >> 9, ch = dc & 511;
    const int T0 = chunk * SCH;
    float A = 1.f, B = 0.f;
#pragma unroll 8
    for (int i = 0; i < SCH; ++i) {
        const int T = dir ? (T0 + SCH - 1 - i) : (T0 + i);
        const float av = p.a[((size_t)T * 2 + dir) * 512 + ch], bv = bf2f(p.bxb[((size_t)T * 2 + dir) * 512 + ch]);
        A *= av; B = B * av + bv;
    }
    *(float2*)(p.agg + (((size_t)chunk * 2 + dir) * 512 + ch) * 2) = make_float2(A, B);
}

__device__ __forceinline__ int perm23(int r) { return (r & 0x13) | ((r & 4) << 1) | ((r & 8) >> 1); }
__device__ void attn_item_mfma(const Params& p, int it) {
    int seq, h, qb, Sk, T0, R0; size_t vbase;
    if (it < 64) { seq = it >> 2; h = it & 3; qb = 0; Sk = 256; T0 = seq * 256; R0 = seq * 256; vbase = (size_t)(seq * 4 + h) * 128 * 256; }
    else { const int u = it - 64; seq = u >> 5; h = (u >> 3) & 3; qb = u & 7; Sk = 2304; T0 = T_CTX + seq * 2048 + qb * 256; R0 = T_CTX + seq * 2304; vbase = (size_t)T_CTX * 512 + (size_t)(seq * 4 + h) * 128 * 2304; }
    const int tid = tidx(), lane = tid & 63, wid = tid >> 6, hl = lane >> 5, cl = lane & 31;
    bf16x8_t qf[12];
    {
        const bf16_t* qrow = p.q + (size_t)(T0 + 32 * wid + cl) * 768 + h * 192 + 8 * hl;
#pragma unroll
        for (int ks = 0; ks < 12; ++ks) qf[ks] = __builtin_bit_cast(bf16x8_t, *(const u32x4*)(qrow + 16 * ks));
        if (it >= 64) {
            const int sp = qb * 256 + 32 * wid + cl, gr = sp >> 6, gc = sp & 63;
#pragma unroll
            for (int ks = 8; ks < 12; ++ks) {
                const u32x4 w = __builtin_bit_cast(u32x4, qf[ks]); u32x4 o;
#pragma unroll
                for (int i = 0; i < 4; ++i) {
                    const int pr = 8 * (ks - 8) + 4 * hl + i;
                    const float cs = ks < 10 ? p.ropetab[gr * 16 + pr] : p.ropetab[1024 + gc * 16 + (pr - 16)];
                    const float sn = ks < 10 ? p.ropetab[512 + gr * 16 + pr] : p.ropetab[2048 + gc * 16 + (pr - 16)];
                    const float x0 = __uint_as_float(w[i] << 16), x1 = __uint_as_float(w[i] & 0xffff0000u);
                    o[i] = pack_bf16(x0 * cs - x1 * sn, x0 * sn + x1 * cs);
                }
                qf[ks] = __builtin_bit_cast(bf16x8_t, o);
            }
        }
    }
    f32x16 oacc[4];
#pragma unroll
    for (int d = 0; d < 4; ++d)
#pragma unroll
        for (int r = 0; r < 16; ++r) oacc[d][r] = 0.f;
    float m = -1e30f, lsum = 0.f;
    const bf16_t* gk = p.Kn + (size_t)(R0 + (tid >> 4)) * 512 + h * 128 + (tid & 15) * 8;
    const bf16_t* gr = p.kropek + (size_t)(R0 + (tid >> 3)) * 64 + (tid & 7) * 8;
    const bf16_t* gv = p.vT + vbase + (size_t)(tid >> 3) * Sk + (tid & 7) * 8;
    u32x4 rk[2], rr, rv[2];
    const int nt = Sk >> 6;
#pragma unroll
    for (int i = 0; i < 2; ++i) rk[i] = *(const u32x4*)(gk + (size_t)(32 * i) * 512);
    rr = *(const u32x4*)gr;
#pragma unroll
    for (int i = 0; i < 2; ++i) rv[i] = *(const u32x4*)(gv + (size_t)(64 * i) * Sk);
    __syncthreads();
    for (int t = 0; t < nt; ++t) {
#pragma unroll
        for (int i = 0; i < 2; ++i) *(u32x4*)(smem + ((tid & 15) >> 3) * 8192 + lds_off((tid >> 4) + 32 * i, tid & 7)) = rk[i];
        *(u32x4*)(smem + 16384 + lds_off(tid >> 3, tid & 7)) = rr;
#pragma unroll
        for (int i = 0; i < 2; ++i) *(u32x4*)(smem + 24576 + lds_off((tid >> 3) + 64 * i, tid & 7)) = rv[i];
        __syncthreads();
        if (t + 1 < nt) {
            const size_t ko = (size_t)(t + 1) * 64;
#pragma unroll
            for (int i = 0; i < 2; ++i) rk[i] = *(const u32x4*)(gk + (ko + 32 * i) * 512);
            rr = *(const u32x4*)(gr + ko * 64);
#pragma unroll
            for (int i = 0; i < 2; ++i) rv[i] = *(const u32x4*)(gv + (size_t)(64 * i) * Sk + ko);
        }
        f32x16 sacc[2];
#pragma unroll
        for (int kb = 0; kb < 2; ++kb) {
            __builtin_amdgcn_sched_barrier(0);
#pragma unroll
            for (int r = 0; r < 16; ++r) sacc[kb][r] = 0.f;
            const int krow = 32 * kb + perm23(cl);
#pragma unroll
            for (int ks = 0; ks < 12; ++ks) {
                const bf16x8_t kf = __builtin_bit_cast(bf16x8_t, *(const u32x4*)(smem + (ks >> 2) * 8192 + lds_off(krow, 2 * (ks & 3) + hl)));
                sacc[kb] = __builtin_amdgcn_mfma_f32_32x32x16_bf16(kf, qf[ks], sacc[kb], 0, 0, 0);
            }
        }
        float mx = sacc[0][0];
#pragma unroll
        for (int r = 1; r < 16; ++r) mx = fmaxf(mx, sacc[0][r]);
#pragma unroll
        for (int r = 0; r < 16; ++r) mx = fmaxf(mx, sacc[1][r]);
        mx = fmaxf(mx, __shfl_xor(mx, 32));
        const float mn = fmaxf(m, mx), alpha = __builtin_amdgcn_exp2f(m - mn);
        m = mn;
        float ps = 0.f;
        bf16x8_t pf[2][2];
#pragma unroll
        for (int kb = 0; kb < 2; ++kb)
#pragma unroll
            for (int s2 = 0; s2 < 2; ++s2) {
                float e[8];
#pragma unroll
                for (int j = 0; j < 8; ++j) { e[j] = __builtin_amdgcn_exp2f(sacc[kb][8 * s2 + j] - mn); ps += e[j]; }
                u32x4 w; w.x = pack_bf16(e[0], e[1]); w.y = pack_bf16(e[2], e[3]); w.z = pack_bf16(e[4], e[5]); w.w = pack_bf16(e[6], e[7]);
                pf[kb][s2] = __builtin_bit_cast(bf16x8_t, w);
            }
        lsum = lsum * alpha + ps;
#pragma unroll
        for (int d = 0; d < 4; ++d)
#pragma unroll
            for (int r = 0; r < 16; ++r) oacc[d][r] *= alpha;
#pragma unroll
        for (int d = 0; d < 4; ++d) {
            __builtin_amdgcn_sched_barrier(0);
#pragma unroll
            for (int kb = 0; kb < 2; ++kb)
#pragma unroll
                for (int s2 = 0; s2 < 2; ++s2) {
                    const bf16x8_t vf = __builtin_bit_cast(bf16x8_t, *(const u32x4*)(smem + 24576 + lds_off(32 * d + cl, 4 * kb + 2 * s2 + hl)));
                    oacc[d] = __builtin_amdgcn_mfma_f32_32x32x16_bf16(vf, pf[kb][s2], oacc[d], 0, 0, 0);
                }
        }
        __builtin_amdgcn_sched_barrier(0);
        __syncthreads();
    }
    lsum += __shfl_xor(lsum, 32);
    const float inv = 1.f / lsum;
    bf16_t* dst = p.hbuf + (size_t)(T0 + 32 * wid + cl) * 1024 + h * 128 + 4 * hl;
#pragma unroll
    for (int d = 0; d < 4; ++d)
#pragma unroll
        for (int g = 0; g < 4; ++g) {
            uint2 w; w.x = pack_bf16(oacc[d][4 * g] * inv, oacc[d][4 * g + 1] * inv); w.y = pack_bf16(oacc[d][4 * g + 2] * inv, oacc[d][4 * g + 3] * inv);
            *(uint2*)(dst + 32 * d + 8 * g) = w;
        }
}
__device__ void st_attn_s1(const Params& p) {
    for (int item = blockIdx.x; item < N_ATT + N_S1; item += gridDim.x) {
        if (item < N_ATT) {
            attn_item_mfma(p, N_ATT - 1 - item);
        }
        else scan_s1_item(p, item - N_ATT);
    }
}

__device__ void st_scan3(const Params& p) {
    const int tid = tidx();
    float* hf = (float*)smem;
    float* hb = hf + SCH * 256;
    float* o_lru = p.out + 22282240;
    for (int item = blockIdx.x; item < NCHK * 2; item += gridDim.x) {
        const int chunk = item >> 1, cgp = item & 1, T0 = chunk * SCH;
        const TokInfo ti = tokinfo(T0);
        const int nch = ti.S / SCH, cpos = ti.s / SCH, c0 = chunk - cpos;
        const int dir = tid >> 8, ch = cgp * 256 + (tid & 255);
        float hcur = ti.smp ? p.state_lru[((size_t)ti.b * 2 + dir) * 512 + ch] : 0.f;
        if (dir == 0) { for (int cc = 0; cc < cpos; ++cc) { const float2 ab = *(const float2*)(p.agg + (((size_t)(c0 + cc) * 2 + 0) * 512 + ch) * 2); hcur = ab.x * hcur + ab.y; } }
        else { for (int cc = nch - 1; cc > cpos; --cc) { const float2 ab = *(const float2*)(p.agg + (((size_t)(c0 + cc) * 2 + 1) * 512 + ch) * 2); hcur = ab.x * hcur + ab.y; } }
        __syncthreads();
#pragma unroll 8
        for (int i = 0; i < SCH; ++i) {
            const int tl = dir ? SCH - 1 - i : i, T = T0 + tl;
            const float av = p.a[((size_t)T * 2 + dir) * 512 + ch], bv = bf2f(p.bxb[((size_t)T * 2 + dir) * 512 + ch]);
            hcur = av * hcur + bv;
            (dir ? hb : hf)[tl * 256 + (tid & 255)] = hcur;
        }
        if (!ti.smp) {
            if (dir == 0 && cpos == nch - 1) o_lru[((size_t)ti.b * 2 + 0) * 512 + ch] = hcur;
            if (dir == 1 && cpos == 0) o_lru[((size_t)ti.b * 2 + 1) * 512 + ch] = hcur;
        }
        __syncthreads();
        for (int i = tid; i < SCH * 128; i += NTHR) {
            const int tl = i >> 7, c = (i & 127) * 2, T = T0 + tl, chh = cgp * 256 + c;
            const unsigned ugp = *(const unsigned*)(p.ug + (size_t)T * 512 + chh);
            const float g0 = gelu_tanh(__uint_as_float(ugp << 16)), g1 = gelu_tanh(__uint_as_float(ugp & 0xffff0000u));
            const float2 f = *(const float2*)(hf + tl * 256 + c), bb = *(const float2*)(hb + tl * 256 + c);
            *(unsigned*)(p.hbuf + (size_t)T * 1024 + 512 + chh) = pack_bf16((f.x + bb.x) * g0, (f.y + bb.y) * g1);
        }
    }
}

__device__ void st_gemm_o(const Params& p) {
    pg8::TileOrder S; S.nN = 4; S.total = 80 * 4; S.A = (const char*)p.hbuf; S.B = (const char*)p.wt_o; S.tA = (size_t)256 * 1024 * 2; S.tB = (size_t)256 * 1024 * 2;
    EpiStoreBf16 E; E.O = p.mix; E.ldc = 1024;
    pg8::gemm_phase<EpiStoreBf16, pg8::TileOrder, true, true>((LAS unsigned char*)smem, 1024, 1024, 1024, S, E);
}

__device__ void st_gemm_pq(const Params& p, int l) {
    pg8::TileOrder S; S.nN = 8; S.total = 80 * 8; S.A = (const char*)p.hbuf; S.B = (const char*)p.wt_pq[l]; S.tA = (size_t)256 * 1024 * 2; S.tB = (size_t)256 * 1024 * 2;
    EpiStoreBf16 E; E.O = p.qp; E.ldc = 2048;
    pg8::gemm_phase<EpiStoreBf16, pg8::TileOrder, true, true>((LAS unsigned char*)smem, 1024, 1024, 1024, S, E);
}

__device__ __forceinline__ void ce_desc(float& a, float& b) { const float hi = fmaxf(a, b), lo = fminf(a, b); a = hi; b = lo; }
__device__ __forceinline__ void ins16(float (&top)[16], float x) {
#pragma unroll
    for (int i = 0; i < 16; ++i) { const float hi = fmaxf(top[i], x); x = fminf(top[i], x); top[i] = hi; }
}
__device__ __forceinline__ void bitonic_merge16(float (&v)[16]) {
#pragma unroll
    for (int j = 8; j >= 1; j >>= 1)
#pragma unroll
        for (int i = 0; i < 16; ++i) { const int l = i ^ j; if (l > i) ce_desc(v[i], v[l]); }
}
__device__ __forceinline__ void sort16(float (&v)[16]) {
#pragma unroll
    for (int k = 2; k <= 16; k <<= 1)
#pragma unroll
        for (int j = k >> 1; j >= 1; j >>= 1)
#pragma unroll
            for (int i = 0; i < 16; ++i) { const int l = i ^ j; if (l > i) { if ((i & k) == 0) ce_desc(v[i], v[l]); else ce_desc(v[l], v[i]); } }
}
__device__ __forceinline__ void merge_top16(float (&a)[16], const float (&b)[16]) {
#pragma unroll
    for (int i = 0; i < 16; ++i) a[i] = fmaxf(a[i], b[15 - i]);
    bitonic_merge16(a);
}
#define PKV(x) __uint_as_float(__float_as_uint(x) & 0xffffff80u)
#define CAND(i, j) __uint_as_float((__float_as_uint(PKV(top[0][i]) + PKV(top[1][j])) & 0xffffff00u) | (unsigned)((i) * 16 + (j)))
__device__ void st_peer_topk(const Params& p, int l) {
    const int half = tidx() >> 8, lane = tidx() & 63, wid = (tidx() >> 6) & 3, hl = lane >> 5, cl = lane & 31;
    for (int item = blockIdx.x; item < 160 * 8 / 2; item += gridDim.x) {
        const int lt = (item >> 3) * 2 + half, h = lt & 7, tm = (lt >> 3) * 8 + (item & 7);
        const int T = tm * 128 + 32 * wid + cl;
        float top[2][16];
#pragma unroll
        for (int pp = 0; pp < 2; ++pp) {
            f32x16 acc[4][1];
            gemm_acc<4, 1, 1, 4>(p.keysb[l] + (size_t)(h * 2 + pp) * 128 * 128, 128, p.qp + (size_t)tm * 128 * 2048 + h * 256 + pp * 128, 2048, 128, acc);
#pragma unroll
            for (int i = 0; i < 4; ++i) {
                __builtin_amdgcn_sched_barrier(0);
                float g[16];
#pragma unroll
                for (int r = 0; r < 16; ++r) {
                    const int n = ACC_ROW(4, 0, i, r, hl);
                    g[r] = __uint_as_float((__float_as_uint(acc[i][0][r]) & 0xffffff80u) | (unsigned)n);
                }
                sort16(g);
                if (i == 0) {
#pragma unroll
                    for (int r = 0; r < 16; ++r) top[pp][r] = g[r];
                } else merge_top16(top[pp], g);
            }
            __builtin_amdgcn_sched_barrier(0);
            float oth[16];
#pragma unroll
            for (int i = 0; i < 16; ++i) oth[i] = __shfl_xor(top[pp][i], 32);
            merge_top16(top[pp], oth);
        }
        __builtin_amdgcn_sched_barrier(0);
        float fv[16], t2[16];
#pragma unroll
        for (int j = 0; j < 16; ++j) fv[j] = CAND(0, j);
        t2[15] = -INFINITY;
#pragma unroll
        for (int i = 1; i < 16; ++i) t2[i - 1] = CAND(i, 0);
        merge_top16(fv, t2);
        t2[0] = CAND(1, 1); t2[1] = CAND(1, 2); t2[2] = CAND(1, 3); t2[3] = CAND(1, 4); t2[4] = CAND(1, 5); t2[5] = CAND(1, 6); t2[6] = CAND(1, 7);
        t2[7] = CAND(2, 1); t2[8] = CAND(2, 2); t2[9] = CAND(2, 3); t2[10] = CAND(2, 4); t2[11] = CAND(3, 1); t2[12] = CAND(3, 2); t2[13] = CAND(3, 3);
        t2[14] = CAND(4, 1); t2[15] = CAND(4, 2);
        sort16(t2);
        merge_top16(fv, t2);
        ins16(fv, CAND(5, 1)); ins16(fv, CAND(6, 1)); ins16(fv, CAND(7, 1));
        unsigned* tab = (unsigned*)(smem + half * 65536) + (size_t)(tidx() & 255) * 8;
#pragma unroll
        for (int k = 0; k < 4; ++k) {
            tab[k] = (__float_as_uint(top[0][4 * k]) & 127u) | ((__float_as_uint(top[0][4 * k + 1]) & 127u) << 8) | ((__float_as_uint(top[0][4 * k + 2]) & 127u) << 16) | ((__float_as_uint(top[0][4 * k + 3]) & 127u) << 24);
            tab[4 + k] = (__float_as_uint(top[1][4 * k]) & 127u) | ((__float_as_uint(top[1][4 * k + 1]) & 127u) << 8) | ((__float_as_uint(top[1][4 * k + 2]) & 127u) << 16) | ((__float_as_uint(top[1][4 * k + 3]) & 127u) << 24);
        }
        const u8_t* tabb = (const u8_t*)tab;
        int fe[16];
#pragma unroll
        for (int i = 0; i < 16; ++i) {
            const unsigned code = __float_as_uint(fv[i]) & 255u;
            fe[i] = (int)tabb[code >> 4] * 128 + (int)tabb[16 + (code & 15u)];
            fv[i] = __uint_as_float(__float_as_uint(fv[i]) & 0xffffff00u);
        }
        float sum = 0.f, ev[16];
#pragma unroll
        for (int i = 0; i < 16; ++i) { ev[i] = __expf(fv[i] - fv[0]); sum += ev[i]; }
        const float inv = 1.f / sum;
        if (hl == 0) {
            float4* gp = (float4*)(p.gates + (size_t)T * 128 + h * 16); int4* ep = (int4*)(p.eidx + (size_t)T * 128 + h * 16);
#pragma unroll
            for (int i = 0; i < 4; ++i) { gp[i] = make_float4(ev[4 * i] * inv, ev[4 * i + 1] * inv, ev[4 * i + 2] * inv, ev[4 * i + 3] * inv); ep[i] = make_int4(fe[4 * i], fe[4 * i + 1], fe[4 * i + 2], fe[4 * i + 3]); }
        }
    }
}

#define FP4X(dw, b) __builtin_amdgcn_cvt_scalef32_pk_f32_fp4(dw, 1.0f, b)
#define FP4B(dw, b) __builtin_amdgcn_cvt_scalef32_pk_bf16_fp4(dw, 1.0f, b)
__device__ void st_peer_gather(const Params& p, int l) {
    const int lane = tidx() & 63, wid = __builtin_amdgcn_readfirstlane(tidx() >> 6), g = lane >> 3, pc = lane & 7;
    const u8_t* U = p.u8[l]; const u8_t* V = p.v8[l]; const float* SU = p.su[l]; const float* SV = p.sv[l];
    const bool b0 = (lane & 1) != 0, b1 = (lane & 2) != 0, b2 = (lane & 4) != 0, b3 = (lane & 8) != 0;
    const int stride = gridDim.x * NWV, Tfirst = blockIdx.x * NWV + wid;
    const int ka = 8 * pc + g, kb = 64 + ka;
#pragma unroll 1
    for (int c = 0; c < 4; ++c) {
#pragma unroll 1
        for (int T = Tfirst; T < T_TOK; T += stride) {
            const int e0 = p.eidx[(size_t)T * 128 + lane], e1 = p.eidx[(size_t)T * 128 + 64 + lane];
            const u32x4 hh4 = *(const u32x4*)(p.hqh + (size_t)T * 128 + c * 32 + pc * 4), hl4 = *(const u32x4*)(p.hql + (size_t)T * 128 + c * 32 + pc * 4);
            u32x4 r[16];
#pragma unroll
            for (int i = 0; i < 16; ++i) {
                const int ek = __builtin_amdgcn_ds_bpermute(((8 * i + g) & 63) << 2, i < 8 ? e0 : e1);
                r[i] = *(const u32x4*)(U + ((unsigned)ek * 512u + (unsigned)(c * 128 + pc * 16)));
            }
            float za = 0.f, zb = 0.f;
            if (c > 0) { za = p.zbuf[(size_t)T * 128 + ka]; zb = p.zbuf[(size_t)T * 128 + kb]; }
#pragma unroll
            for (int hh = 0; hh < 2; ++hh) {
                float d[8];
#pragma unroll
                for (int ii = 0; ii < 8; ++ii) {
                    int ah = 0, al = 0;
#pragma unroll
                    for (int q = 0; q < 4; ++q) { ah = __builtin_amdgcn_sdot8((int)r[8 * hh + ii][q], (int)hh4[q], ah, false); al = __builtin_amdgcn_sdot8((int)r[8 * hh + ii][q], (int)hl4[q], al, false); }
                    d[ii] = (float)(ah * 16 + al);
                }
                float a4[4], a2[2];
#pragma unroll
                for (int j = 0; j < 4; ++j) { const float kp = b2 ? d[j + 4] : d[j], sn = b2 ? d[j] : d[j + 4]; a4[j] = kp + DPP_F(sn, 0x141); }
#pragma unroll
                for (int j = 0; j < 2; ++j) { const float kp = b1 ? a4[j + 2] : a4[j], sn = b1 ? a4[j] : a4[j + 2]; a2[j] = kp + DPP_F(sn, 0x4E); }
                const float kp = b0 ? a2[1] : a2[0], sn = b0 ? a2[0] : a2[1];
                const float z = kp + DPP_F(sn, 0xB1);
                if (hh == 0) za += z; else zb += z;
            }
            if (c < 3) { p.zbuf[(size_t)T * 128 + ka] = za; p.zbuf[(size_t)T * 128 + kb] = zb; }
            else {
                const int ea = p.eidx[(size_t)T * 128 + ka], eb = p.eidx[(size_t)T * 128 + kb];
                const float ga = p.gates[(size_t)T * 128 + ka], gb = p.gates[(size_t)T * 128 + kb];
                const float hs = p.hsc[T];
                p.wbuf[(size_t)T * 128 + ka] = ga * gelu_tanh(za * (SU[ea] * hs)) * SV[ea];
                p.wbuf[(size_t)T * 128 + kb] = gb * gelu_tanh(zb * (SU[eb] * hs)) * SV[eb];
            }
        }
    }
    asm volatile("s_waitcnt vmcnt(0)" ::: "memory");
#pragma unroll 1
    for (int c = 0; c < 4; ++c) {
#pragma unroll 1
        for (int T = Tfirst; T < T_TOK; T += stride) {
            const int e0 = p.eidx[(size_t)T * 128 + lane], e1 = p.eidx[(size_t)T * 128 + 64 + lane];
            const float w0 = p.wbuf[(size_t)T * 128 + lane], w1 = p.wbuf[(size_t)T * 128 + 64 + lane];
            u32x4 r[16];
#pragma unroll
            for (int i = 0; i < 16; ++i) {
                const int ek = __builtin_amdgcn_ds_bpermute(((8 * i + g) & 63) << 2, i < 8 ? e0 : e1);
                r[i] = *(const u32x4*)(V + ((unsigned)ek * 512u + (unsigned)(c * 128 + pc * 16)));
            }
            f32x2 acc2[16];
#pragma unroll
            for (int j = 0; j < 16; ++j) acc2[j] = (f32x2){0.f, 0.f};
#pragma unroll
            for (int i = 0; i < 16; ++i) {
                const float wk = __int_as_float(__builtin_amdgcn_ds_bpermute(((8 * i + g) & 63) << 2, __float_as_int(i < 8 ? w0 : w1)));
                const f32x2 wk2 = {wk, wk};
#pragma unroll
                for (int q = 0; q < 4; ++q) {
                    acc2[4 * q] = FP4X(r[i][q], 0) * wk2 + acc2[4 * q]; acc2[4 * q + 1] = FP4X(r[i][q], 1) * wk2 + acc2[4 * q + 1];
                    acc2[4 * q + 2] = FP4X(r[i][q], 2) * wk2 + acc2[4 * q + 2]; acc2[4 * q + 3] = FP4X(r[i][q], 3) * wk2 + acc2[4 * q + 3];
                }
                __builtin_amdgcn_sched_barrier(0);
            }
            float acc[32];
#pragma unroll
            for (int j = 0; j < 16; ++j) { acc[2 * j] = acc2[j].x; acc[2 * j + 1] = acc2[j].y; }
            float s1[16], s2[8], s3[4];
#pragma unroll
            for (int j = 0; j < 16; ++j) { const u32x2 rr = __builtin_amdgcn_permlane32_swap(__float_as_uint(acc[j]), __float_as_uint(acc[j + 16]), false, false); s1[j] = __uint_as_float(rr[0]) + __uint_as_float(rr[1]); }
#pragma unroll
            for (int j = 0; j < 8; ++j) { const u32x2 rr = __builtin_amdgcn_permlane16_swap(__float_as_uint(s1[j]), __float_as_uint(s1[j + 8]), false, false); s2[j] = __uint_as_float(rr[0]) + __uint_as_float(rr[1]); }
#pragma unroll
            for (int j = 0; j < 4; ++j) { const float kp = b3 ? s2[j + 4] : s2[j], sn = b3 ? s2[j] : s2[j + 4]; s3[j] = kp + DPP_F(sn, 0x128); }
            *(uint2*)(p.mix + (size_t)T * 1024 + c * 256 + pc * 32 + g * 4) = make_uint2(pack_bf16(s3[0], s3[1]), pack_bf16(s3[2], s3[3]));
        }
    }
    asm volatile("s_waitcnt vmcnt(0)" ::: "memory");
#pragma unroll 1
    for (int T = Tfirst; T < T_TOK; T += stride) {
        const TokInfo ti = tokinfo(T);
        const int cb = lane * 16;
        float o16[16];
        { const uint4* op = (const uint4*)(p.mix + (size_t)T * 1024 + cb); float t8[8]; unpack8(op[0], t8);
#pragma unroll
          for (int j = 0; j < 8; ++j) o16[j] = t8[j];
          unpack8(op[1], t8);
#pragma unroll
          for (int j = 0; j < 8; ++j) o16[8 + j] = t8[j]; }
        float* xr = p.xres + (size_t)T * 1024 + cb;
        const float* gt = modv(p, l, ti.mi, 5) + cb;
        float xn[16]; float ss = 0.f;
#pragma unroll
        for (int j = 0; j < 4; ++j) { const float4 f = *(const float4*)(xr + 4 * j); xn[4 * j] = f.x + gt[4 * j] * o16[4 * j]; xn[4 * j + 1] = f.y + gt[4 * j + 1] * o16[4 * j + 1]; xn[4 * j + 2] = f.z + gt[4 * j + 2] * o16[4 * j + 2]; xn[4 * j + 3] = f.w + gt[4 * j + 3] * o16[4 * j + 3]; }
#pragma unroll
        for (int j = 0; j < 16; ++j) ss += xn[j] * xn[j];
        ss = wave_sum(ss);
        const float rstd = rsqrtf(ss * (1.f / 1024.f) + 1e-6f);
        if (l == 0) {
#pragma unroll
            for (int j = 0; j < 4; ++j) *(float4*)(xr + 4 * j) = make_float4(xn[4 * j], xn[4 * j + 1], xn[4 * j + 2], xn[4 * j + 3]);
            const float* sh = modv(p, 1, ti.mi, 0) + cb; const float* sc = modv(p, 1, ti.mi, 1) + cb; const float* gg = p.g_mix[1] + cb;
            unsigned w[8];
#pragma unroll
            for (int j = 0; j < 8; ++j) w[j] = pack_bf16(xn[2 * j] * rstd * gg[2 * j] * (1.f + sc[2 * j]) + sh[2 * j], xn[2 * j + 1] * rstd * gg[2 * j + 1] * (1.f + sc[2 * j + 1]) + sh[2 * j + 1]);
            uint4* dd = (uint4*)(p.h3 + (size_t)T * 1024 + cb);
            dd[0] = make_uint4(w[0], w[1], w[2], w[3]); dd[1] = make_uint4(w[4], w[5], w[6], w[7]);
        } else {
            const float* gg = p.g_final + cb;
            float* y = p.out + (size_t)T * 1024 + cb;
#pragma unroll
            for (int j = 0; j < 4; ++j) *(float4*)(y + 4 * j) = make_float4(xn[4 * j] * rstd * gg[4 * j], xn[4 * j + 1] * rstd * gg[4 * j + 1], xn[4 * j + 2] * rstd * gg[4 * j + 2], xn[4 * j + 3] * rstd * gg[4 * j + 3]);
        }
    }
}

template <int W>
__device__ __forceinline__ void pool_tok(const Params& p, int T, int ck) {
    const TokInfo ti = tokinfo(T);
    const bf16_t* base = p.h3 + (size_t)(T - ti.s) * 1024 + ck * 8;
    uint4 raw[W];
#pragma unroll
    for (int k = 0; k < W; ++k) {
        const int t2 = ti.s - W / 2 + k;
        raw[k] = (t2 >= 0 && t2 < ti.S) ? *(const uint4*)(base + (size_t)t2 * 1024) : make_uint4(0u, 0u, 0u, 0u);
    }
    float acc[8];
#pragma unroll
    for (int j = 0; j < 8; ++j) acc[j] = 0.f;
#pragma unroll
    for (int k = 0; k < W; ++k) { float f[8]; unpack8(raw[k], f);
#pragma unroll
        for (int j = 0; j < 8; ++j) acc[j] += f[j]; }
    float c[8]; unpack8(raw[W / 2], c);
    const int lo = max(ti.s - W / 2, 0), hi = min(ti.s + W / 2, ti.S);
    const float inv = 1.f / (float)(hi - lo);
    uint4 o;
    o.x = pack_bf16(acc[0] * inv - c[0], acc[1] * inv - c[1]); o.y = pack_bf16(acc[2] * inv - c[2], acc[3] * inv - c[3]);
    o.z = pack_bf16(acc[4] * inv - c[4], acc[5] * inv - c[5]); o.w = pack_bf16(acc[6] * inv - c[6], acc[7] * inv - c[7]);
    *(uint4*)(p.hbuf + (size_t)T * 1024 + ck * 8) = o;
}
__device__ void st_pool(const Params& p) {
    const int tid = tidx(), lane = tid & 63, wv = tid >> 6, g = wv & 3, ck = g * 32 + (lane & 31), tsub = (wv >> 2) * 2 + (lane >> 5);
    const int per = (T_TOK + gridDim.x - 1) / gridDim.x, Tb = blockIdx.x * per, Te = min(Tb + per, T_TOK);
    for (int T = Tb + tsub; T < Te; T += 4) {
        if (g == 0) pool_tok<2>(p, T, ck); else if (g == 1) pool_tok<4>(p, T, ck); else if (g == 2) pool_tok<8>(p, T, ck); else pool_tok<16>(p, T, ck);
    }
}

__device__ void st_gemm_pool(const Params& p) {
    struct OrderPool {
        const char* A; const char* B;
        __device__ __forceinline__ bool next(int i, pg8::Unit& u) const {
            const int item = blockIdx.x + i * gridDim.x; if (item >= 80 * 4) return false;
            const int lt = item >> 3; u.pn = lt & 3; u.pm = (lt >> 2) * 8 + (item & 7);
            u.A = A + (size_t)u.pm * 256 * 1024 * 2 + (size_t)u.pn * 256 * 2; u.B = B + (size_t)u.pn * 256 * 256 * 2; return true;
        }
    } S; S.A = (const char*)p.hbuf; S.B = (const char*)p.wt_pool;
    EpiStoreBf16 E; E.O = p.mix; E.ldc = 1024;
    pg8::gemm_phase<EpiStoreBf16, OrderPool, true, true>((LAS unsigned char*)smem, 1024, 256, 256, S, E);
}

__device__ __forceinline__ void run_stage(const Params& p, int s) {
#ifdef ONLY_STAGE
    if (s != ONLY_STAGE) return;
#endif
    switch (s) {
        case 0: st_prologue(p); break;
        case 1: st_norm<0>(p, 0, 0, p.g_mix[0], p.hbuf); break;
        case 2: st_gemm1(p); break;
        case 3: st_postproj(p); break;
        case 4: st_gemm234(p); break;
        case 18: st_gates(p); break;
        case 5: st_attn_s1(p); break;
        case 6: st_scan3(p); break;
        case 7: st_gemm_o(p); break;
        case 8: st_resnorm<1>(p, 0); break;
        case 9: st_gemm_pq(p, 0); break;
        case 10: st_peer_topk(p, 0); break;
        case 11: st_peer_gather(p, 0); break;
        case 12: st_pool(p); break;
        case 13: st_gemm_pool(p); break;
        case 14: st_resnorm<0>(p, 1); break;
        case 15: st_gemm_pq(p, 1); break;
        case 16: st_peer_topk(p, 1); break;
        case 17: st_peer_gather(p, 1); break;
        default: break;
    }
}

__global__ void __launch_bounds__(NTHR, 2) fwd_mega(Params p) {
    cg::grid_group grid = cg::this_grid();
    volatile LAS unsigned* st = (volatile LAS unsigned*)(smem + 131072);
    if (threadIdx.x == 0) { st[0] = 0; st[1] = 0; st[2] = 0; st[3] = 0; }
    wtab_init();
    __syncthreads();
    XcdBarrier b = xcd_barrier_post(p.bar, st);
    if (p.bar == nullptr) grid.sync();
#ifndef REP_MASK
#define REP_MASK 0
#endif
#define MK_ST(k) run_stage(p, k); if ((REP_MASK >> (k)) & 1) { xcd_barrier(b); run_stage(p, k); } if ((k) != 17) xcd_barrier(b);
    MK_ST(0) MK_ST(1) MK_ST(2) MK_ST(3) run_stage(p, 4); MK_ST(18) MK_ST(5) MK_ST(6) MK_ST(7) MK_ST(8) MK_ST(9) MK_ST(10) MK_ST(11) MK_ST(12) MK_ST(13) MK_ST(14) MK_ST(15) MK_ST(16) MK_ST(17)
}

extern "C" void kernel_launch(void* const* d_in, const int* in_sizes, int n_in, void* d_out, int out_size, void* d_ws, size_t ws_size, hipStream_t stream) {
    constexpr size_t kDynLds = 131072 + 512;
    static int grid_blocks = 0;
    if (!grid_blocks) {
        int dev = 0, cus = 0, per_cu = 0;
        (void)hipGetDevice(&dev);
        (void)hipDeviceGetAttribute(&cus, hipDeviceAttributeMultiprocessorCount, dev);
        (void)hipFuncSetAttribute((const void*)fwd_mega, hipFuncAttributeMaxDynamicSharedMemorySize, (int)kDynLds);
        (void)hipOccupancyMaxActiveBlocksPerMultiprocessor(&per_cu, fwd_mega, NTHR, kDynLds);
        if (per_cu > 1) per_cu = 1;
        if (per_cu < 1) per_cu = 1;
        grid_blocks = cus * per_cu;
    }
    Params p{};
    const float* const* in = (const float* const*)d_in;
    p.x_prompt = in[0]; p.x_sample = in[1]; p.cache_ckv = in[2]; p.cache_krope = in[3]; p.state_lru = in[4]; p.c = in[5]; p.c_ctx = in[6];
    p.w_mod[0] = in[7]; p.b_mod[0] = in[8]; p.w_mod[1] = in[9]; p.b_mod[1] = in[10];
    p.g_mix[0] = in[11]; p.g_ffn[0] = in[12]; p.g_mix[1] = in[13]; p.g_ffn[1] = in[14];
    p.w_in = in[15]; p.g_q = in[16]; p.w_uq = in[17]; p.g_kv = in[18]; p.w_ukv = in[19]; p.conv_w = in[20]; p.conv_b = in[21];
    p.w_rg = in[22]; p.b_rg = in[23]; p.w_ig = in[24]; p.b_ig = in[25]; p.lam = in[26]; p.w_o = in[27]; p.w_pool = in[28]; p.s_pool = in[29];
    p.peer_wq[0] = in[30]; p.peer_keys[0] = in[31]; p.peer_u[0] = in[32]; p.peer_v[0] = in[33];
    p.peer_wq[1] = in[34]; p.peer_keys[1] = in[35]; p.peer_u[1] = in[36]; p.peer_v[1] = in[37];
    p.g_final = in[38];
    p.out = (float*)d_out;
    char* base = (char*)d_ws; size_t off = 0;
    auto take = [&](size_t bytes) { char* r = base + off; off += (bytes + 255) & ~(size_t)255; return r; };
    const size_t MiB = 1u << 20;
    p.bar = (unsigned*)take(16384);
    p.mod = (float*)take((size_t)2 * 9 * 6144 * 4);
    p.ropetab = (float*)take(3072 * 4);
    p.wt_in = (bf16_t*)take((size_t)NW_IN * 2); p.wt_uq = (bf16_t*)take((size_t)NW_UQ * 2); p.wt_ukv = (bf16_t*)take((size_t)NW_UKV * 2);
    p.wt_gate = (bf16_t*)take((size_t)NW_GATE * 2); p.wt_o = (bf16_t*)take((size_t)NW_O * 2); p.wt_pool = (bf16_t*)take((size_t)NW_POOL * 2);
    p.wt_pq[0] = (bf16_t*)take((size_t)NW_PQ * 2); p.wt_pq[1] = (bf16_t*)take((size_t)NW_PQ * 2);
    p.keysb[0] = (bf16_t*)take((size_t)NW_KEYS * 2); p.keysb[1] = (bf16_t*)take((size_t)NW_KEYS * 2);
    for (int l = 0; l < 2; ++l) { p.u8[l] = (u8_t*)take(16 * MiB); p.v8[l] = (u8_t*)take(16 * MiB); p.su[l] = (float*)take(65536); p.sv[l] = (float*)take(65536); }
    char* regX = take(80 * MiB);
    char* regQ = take(80 * MiB);
    char* regH = take(40 * MiB);
    p.P = (bf16_t*)regX; p.a = (float*)regX; p.xres = (float*)regX;
    p.bxb = (bf16_t*)regQ; p.q = (bf16_t*)(regQ + 40 * MiB); p.agg = (float*)(regQ + 70 * MiB); p.qp = (bf16_t*)regQ; p.h3 = (bf16_t*)regQ;
    p.hbuf = (bf16_t*)regH;
    p.cqn = (bf16_t*)take((size_t)T_TOK * 384 * 2); p.ckvk = (bf16_t*)take((size_t)R_KEYS * 256 * 2); p.kropek = (bf16_t*)take((size_t)R_KEYS * 64 * 2);
    p.xc = (bf16_t*)take((size_t)T_TOK * 512 * 2); p.ug = (bf16_t*)take((size_t)T_TOK * 512 * 2);
    p.mix = p.xc;
    p.Kn = (bf16_t*)take((size_t)R_KEYS * 512 * 2); p.vT = (bf16_t*)take((size_t)R_KEYS * 512 * 2);
    p.zbuf = (float*)p.vT; p.wbuf = p.zbuf + (size_t)T_TOK * 128;
    p.hqh = (unsigned*)p.cqn; p.hql = (unsigned*)p.ckvk; p.hsc = (float*)p.kropek;
    p.gates = (float*)p.Kn; p.eidx = (int*)((char*)p.Kn + (size_t)T_TOK * 128 * 4);
    if (off > ws_size) fprintf(stderr, "workspace too small: need %zu have %zu\n", off, ws_size);
    (void)hipMemsetAsync(d_ws, 0, 16384, stream);
    void* args[] = {&p};
    hipError_t e = hipLaunchCooperativeKernel((void*)fwd_mega, dim3(grid_blocks), dim3(NTHR), args, kDynLds, stream);
    if (e != hipSuccess) fprintf(stderr, "cooperative launch failed: %s (grid %d)\n", hipGetErrorString(e), grid_blocks);
}
```

```cpp
#include <hip/hip_runtime.h>
#include <hip/hip_cooperative_groups.h>
#include <cstdio>
#include <cstdint>
namespace cg = cooperative_groups;


typedef unsigned short bf16_t;
typedef unsigned char u8_t;
typedef float f32x16 __attribute__((ext_vector_type(16)));
typedef float f32x2 __attribute__((ext_vector_type(2)));
typedef unsigned u32x4 __attribute__((ext_vector_type(4)));
typedef float f32x4v __attribute__((ext_vector_type(4)));

#define T_TOK 20480
#define T_CTX 4096
#define R_KEYS 22528
#define NSTAGE 19
#define NTHR 512
#define NWV 8
#define LAS __attribute__((address_space(3)))

#define XB_TMO      128
#define XB_XCNT(j)  (256  + 64 * (j))
#define XB_XSUB(j)  (1280 + 64 * (j))
#define XB_XGEN(j)  (2304 + 64 * (j))
#define XB_TOP      3328
#define XB_TOPGEN   3392
#define XCD_BAR_WORDS 3456
#define XB_SPIN_CAP (1u << 22)
__device__ __forceinline__ unsigned xb_ld(unsigned* p)              { return __hip_atomic_load(p, __ATOMIC_RELAXED, __HIP_MEMORY_SCOPE_AGENT); }
__device__ __forceinline__ unsigned xb_add(unsigned* p, unsigned v) { return __hip_atomic_fetch_add(p, v, __ATOMIC_RELAXED, __HIP_MEMORY_SCOPE_AGENT); }
__device__ __forceinline__ unsigned xb_xcc_id() { return (unsigned)__builtin_amdgcn_s_getreg((3 << 11) | 20) & 0xFu; }
#define XB_SPIN(cond, bar) do { unsigned _sp = 0; while (cond) { __builtin_amdgcn_s_sleep(1); \
    if ((++_sp & 255u) == 0u) { if (xb_ld(&(bar)[XB_TMO])) break; if (_sp > XB_SPIN_CAP) { atomicAdd(&(bar)[XB_TMO], 1u); break; } } } } while (0)
struct XcdBarrier { unsigned* bar; unsigned x; volatile LAS unsigned* st; };
__device__ __forceinline__ XcdBarrier xcd_barrier_post(unsigned* bar, volatile LAS unsigned* st) {
    XcdBarrier b; b.bar = bar; b.x = xb_xcc_id(); b.st = st;
    if (threadIdx.x == 0) (void)xb_add(&bar[XB_XCNT(b.x)], 1u);
    return b;
}
__device__ __forceinline__ void xcd_barrier_complete(unsigned* bar, unsigned x, unsigned& nloc, unsigned& nx) {
    const unsigned G = gridDim.x * gridDim.y * gridDim.z;
    unsigned sum, cnt, mine, sp = 0u;
    for (;;) {
        sum = 0u; cnt = 0u; mine = 0u;
#pragma unroll
        for (unsigned j = 0; j < 16; ++j) { const unsigned c = xb_ld(&bar[XB_XCNT(j)]); sum += c; cnt += (c > 0u) ? 1u : 0u; mine = (j == x) ? c : mine; }
        if (sum == G) break;
        __builtin_amdgcn_s_sleep(1);
        if ((++sp & 255u) == 0u) { if (xb_ld(&bar[XB_TMO])) break; if (sp > XB_SPIN_CAP) { atomicAdd(&bar[XB_TMO], 1u); break; } }
    }
    nloc = mine > 0u ? mine : 1u; nx = cnt > 0u ? cnt : 1u;
}
__device__ __forceinline__ int tidx();
__device__ __forceinline__ void xcd_barrier(const XcdBarrier& b) {
    asm volatile("s_waitcnt vmcnt(0)" ::: "memory");
    __syncthreads();
    if (tidx() == 0) {
        unsigned* bar = b.bar;
        __builtin_amdgcn_s_waitcnt(0);
        unsigned nloc = b.st[0], nx = b.st[1];
        if (nloc == 0u) { xcd_barrier_complete(bar, b.x, nloc, nx); b.st[0] = nloc; b.st[1] = nx; }
        const unsigned old = xb_add(&bar[XB_XSUB(b.x)], 1u);
        const unsigned gen = old / nloc;
        if (old + 1u == (gen + 1u) * nloc) {
            __builtin_amdgcn_fence(__ATOMIC_RELEASE, "agent");
            asm volatile("s_waitcnt vmcnt(0)" ::: "memory");
            const unsigned og = xb_add(&bar[XB_TOP], 1u);
            const unsigned tg = og / nx;
            if (og + 1u == (tg + 1u) * nx) xb_add(&bar[XB_TOPGEN], 1u);
            else XB_SPIN(xb_ld(&bar[XB_TOPGEN]) == tg, bar);
            __builtin_amdgcn_fence(__ATOMIC_ACQUIRE, "agent");
            xb_add(&bar[XB_XGEN(b.x)], 1u);
            asm volatile("s_waitcnt vmcnt(0)" ::: "memory");
        } else {
            XB_SPIN(xb_ld(&bar[XB_XGEN(b.x)]) == gen, bar);
            __builtin_amdgcn_fence(__ATOMIC_ACQUIRE, "agent");
            asm volatile("s_waitcnt vmcnt(0)" ::: "memory");
        }
    }
    __syncthreads();
}

struct Params {
    const float *x_prompt, *x_sample, *cache_ckv, *cache_krope, *state_lru, *c, *c_ctx;
    const float *w_mod[2], *b_mod[2], *g_mix[2], *g_ffn[2];
    const float *w_in, *g_q, *w_uq, *g_kv, *w_ukv, *conv_w, *conv_b, *w_rg, *b_rg, *w_ig, *b_ig, *lam, *w_o, *w_pool, *s_pool;
    const float *peer_wq[2], *peer_keys[2], *peer_u[2], *peer_v[2];
    const float* g_final;
    float* out;
    unsigned* bar; float* mod; float* ropetab;
    bf16_t *wt_in, *wt_uq, *wt_ukv, *wt_gate, *wt_o, *wt_pool, *wt_pq[2], *keysb[2];
    u8_t *u8[2], *v8[2]; float *su[2], *sv[2];
    bf16_t *hbuf, *P, *cqn, *ckvk, *kropek, *xc, *ug, *q, *Kn, *vT, *bxb, *qp, *h3;
    float *a, *agg, *xres, *gates; int* eidx;
    bf16_t* mix; float *zbuf, *wbuf; unsigned *hqh, *hql; float* hsc; float* spl; bf16_t* a1m;
};

extern __shared__ __attribute__((aligned(16))) unsigned char smem[];
#define WTAB_OFF (131072 + 64)
__device__ __forceinline__ int hw_wave_slot() { return (int)(__builtin_amdgcn_s_getreg(0x2804) & 63u); }
__device__ __forceinline__ void wtab_init() { if ((threadIdx.x & 63) == 0) ((volatile int*)(smem + WTAB_OFF))[hw_wave_slot()] = (int)(threadIdx.x >> 6); }
__device__ __forceinline__ int tidx() {
    const int w = __builtin_amdgcn_readfirstlane(((volatile int*)(smem + WTAB_OFF))[hw_wave_slot()]);
    return (w << 6) | (int)__builtin_amdgcn_mbcnt_hi(~0u, __builtin_amdgcn_mbcnt_lo(~0u, 0u));
}
__device__ __forceinline__ float bf2f(bf16_t v) { return __uint_as_float(((unsigned)v) << 16); }
typedef __bf16 bf16x2_t __attribute__((ext_vector_type(2)));
__device__ __forceinline__ bf16_t f2bf(float f) { return __builtin_bit_cast(unsigned short, (__bf16)f); }
__device__ __forceinline__ unsigned pack_bf16(float a, float b) { bf16x2_t v = {(__bf16)a, (__bf16)b}; return __builtin_bit_cast(unsigned, v); }
typedef unsigned u32x2 __attribute__((ext_vector_type(2)));
#define DPP_F(v, ctrl) __int_as_float(__builtin_amdgcn_update_dpp(0, __float_as_int(v), ctrl, 0xf, 0xf, true))
__device__ __forceinline__ float wave_sum(float v) {
    v += DPP_F(v, 0xB1); v += DPP_F(v, 0x4E); v += DPP_F(v, 0x141); v += DPP_F(v, 0x128);
    u32x2 r = __builtin_amdgcn_permlane16_swap(__float_as_uint(v), __float_as_uint(v), false, false);
    v = __uint_as_float(r[0]) + __uint_as_float(r[1]);
    r = __builtin_amdgcn_permlane32_swap(__float_as_uint(v), __float_as_uint(v), false, false);
    return __uint_as_float(r[0]) + __uint_as_float(r[1]);
}
__device__ __forceinline__ float wave_max(float v) {
    v = fmaxf(v, DPP_F(v, 0xB1)); v = fmaxf(v, DPP_F(v, 0x4E)); v = fmaxf(v, DPP_F(v, 0x141)); v = fmaxf(v, DPP_F(v, 0x128));
    u32x2 r = __builtin_amdgcn_permlane16_swap(__float_as_uint(v), __float_as_uint(v), false, false);
    v = fmaxf(__uint_as_float(r[0]), __uint_as_float(r[1]));
    r = __builtin_amdgcn_permlane32_swap(__float_as_uint(v), __float_as_uint(v), false, false);
    return fmaxf(__uint_as_float(r[0]), __uint_as_float(r[1]));
}
__device__ __forceinline__ float gelu_tanh(float x) {
    const float u = 0.7978845608028654f * (x + 0.044715f * x * x * x);
    const float e = __expf(2.f * u);
    const float th = 1.f - 2.f / (e + 1.f);
    return 0.5f * x * (1.f + th);
}
__device__ __forceinline__ float sigmoidf_(float x) { return 1.f / (1.f + __expf(-x)); }
__device__ __forceinline__ float silu_(float x) { return x / (1.f + __expf(-x)); }

struct TokInfo { int smp, b, s, S, mi, keyrow; };
__device__ __forceinline__ TokInfo tokinfo(int T) {
    TokInfo t;
    if (T < T_CTX) { t.smp = 0; t.b = T >> 8; t.s = T & 255; t.S = 256; t.mi = 0; t.keyrow = T; }
    else { const int u = T - T_CTX; t.smp = 1; t.b = u >> 11; t.s = u & 2047; t.S = 2048; t.mi = 1 + t.b; t.keyrow = T_CTX + t.b * 2304 + 256 + t.s; }
    return t;
}
__device__ __forceinline__ const float* x_in_row(const Params& p, int T) { return T < T_CTX ? p.x_prompt + (size_t)T * 1024 : p.x_sample + (size_t)(T - T_CTX) * 1024; }
__device__ __forceinline__ const float* modv(const Params& p, int l, int mi, int j) { return p.mod + ((size_t)(l * 9 + mi) * 6 + j) * 1024; }

__device__ __forceinline__ void unpack8(const uint4 r, float (&f)[8]) {
    f[0] = __uint_as_float(r.x << 16); f[1] = __uint_as_float(r.x & 0xffff0000u);
    f[2] = __uint_as_float(r.y << 16); f[3] = __uint_as_float(r.y & 0xffff0000u);
    f[4] = __uint_as_float(r.z << 16); f[5] = __uint_as_float(r.z & 0xffff0000u);
    f[6] = __uint_as_float(r.w << 16); f[7] = __uint_as_float(r.w & 0xffff0000u);
}

namespace pg8 {
typedef short bf16x8 __attribute__((ext_vector_type(8)));
typedef float f32x4 __attribute__((ext_vector_type(4)));
constexpr int BM = 256, BK = 64, HALF = 128, HTB = HALF * BK * 2  , STAGE_BYTES = 8 * HTB;
__device__ __forceinline__ int lds_byte(int r, int c) { const int st = (r >> 4) * 2 + (c >> 5), rr = r & 15, cc = c & 31, ob = rr * 64 + cc * 2; return st * 1024 + (ob ^ (((ob >> 9) & 1) << 5)); }
__device__ __forceinline__ void stage_rc(int b, int& R, int& C) { const int st = b / 1024, sb = b % 1024, swz = sb ^ (((sb >> 9) & 1) << 5); R = (st >> 1) * 16 + swz / 64; C = (st & 1) * 32 + (swz % 64) / 2; }
__device__ __forceinline__ int perm32(int rho) { const int n = rho >> 4, i = rho & 15; return 8 * (i >> 2) + 4 * n + (i & 3); }
struct Unit { int pm, pn; const char* A; const char* B; };
template <class Epi, class Sched, bool ALIGN_EPI, bool SP2>
__device__ __forceinline__ void gemm_phase(LAS unsigned char* lds, const int lda, const int ldb, const int K, const Sched& S, const Epi& E) {
    __builtin_amdgcn_sched_barrier(0);
    const int tid = tidx(), wid = __builtin_amdgcn_readfirstlane(tid >> 6), lane = tid & 63, wr = wid >> 2, wc = wid & 3, fr = lane & 15, fq = lane >> 4;
    const int nt = K / BK;
    unsigned voffA[2], voffB[2];
#pragma unroll
    for (int i = 0; i < 2; ++i) { int R, C; stage_rc(tid * 16 + i * 8192, R, C); const int Rb = Epi::PERM ? ((R & ~31) + perm32(R & 31)) : R;
        voffA[i] = (unsigned)(R * lda + C) * 2u; voffB[i] = (unsigned)(Rb * ldb + C) * 2u; }
    const size_t kstep = (size_t)(BK * 2);
    const size_t hstepA = (size_t)HALF * lda * 2, hstepB = (size_t)HALF * ldb * 2;
    const unsigned ldsw = (unsigned)wid * 1024u;
    const int aoff = lds_byte(wr * 64 + fr, fq * 8), boff = lds_byte(wc * 32 + fr, fq * 8);
#define PG8_SA(b, h) (((b) * 2 + (h)) * HTB)
#define PG8_SB(b, h) ((4 + (b) * 2 + (h)) * HTB)
#define PG8_STAGE(bufoff, gbase, voff) do { _Pragma("unroll") for (int _i = 0; _i < 2; ++_i) \
        __builtin_amdgcn_global_load_lds((const unsigned*)((const char*)(gbase) + (voff)[_i]), (LAS unsigned*)(lds + (bufoff) + ldsw + _i * 8192), 16, 0, 0); } while (0)
#define PG8_LDA(dst, b, h) do { _Pragma("unroll") for (int m = 0; m < 4; ++m) _Pragma("unroll") for (int k = 0; k < 2; ++k) dst[m][k] = *(const LAS bf16x8*)(lds + PG8_SA(b, h) + aoff + m * 2048 + k * 1024); } while (0)
#define PG8_LDB(dst, b, h) do { _Pragma("unroll") for (int n = 0; n < 2; ++n) _Pragma("unroll") for (int k = 0; k < 2; ++k) dst[n][k] = *(const LAS bf16x8*)(lds + PG8_SB(b, h) + boff + n * 2048 + k * 1024); } while (0)
#define PG8_MMA(ai, bj, At, Bt) do { __builtin_amdgcn_s_setprio(1); _Pragma("unroll") for (int m = 0; m < 4; ++m) _Pragma("unroll") for (int n = 0; n < 2; ++n) _Pragma("unroll") for (int k = 0; k < 2; ++k) \
        acc[ai][bj][m][n] = __builtin_amdgcn_mfma_f32_16x16x32_bf16(Bt[n][k], At[m][k], acc[ai][bj][m][n], 0, 0, 0); __builtin_amdgcn_s_setprio(0); } while (0)
#define PG8_WAIT_V(n) asm volatile("s_waitcnt vmcnt(" #n ")" ::: "memory")
#define PG8_WAIT_L(n) asm volatile("s_waitcnt lgkmcnt(" #n ")" ::: "memory")
#define PG8_BAR __builtin_amdgcn_s_barrier()
#define PG8_SCHED __builtin_amdgcn_sched_barrier(0)
    Unit cur, nxt; int ui = 0;
    if (!S.next(0, cur)) return;
    f32x4 acc[2][2][4][2];
#pragma unroll
    for (int a = 0; a < 2; ++a)
#pragma unroll
        for (int b = 0; b < 2; ++b)
#pragma unroll
            for (int m = 0; m < 4; ++m)
#pragma unroll
                for (int n = 0; n < 2; ++n) acc[a][b][m][n] = (f32x4){0.f, 0.f, 0.f, 0.f};
    bf16x8 At[4][2], B0[2][2], B1[2][2];
    const char* cA = cur.A; const char* cB = cur.B;
    if constexpr (SP2) {
        PG8_STAGE(PG8_SB(0, 0), cB, voffB); PG8_STAGE(PG8_SB(0, 1), cB + hstepB, voffB); PG8_STAGE(PG8_SA(0, 0), cA, voffA); PG8_STAGE(PG8_SA(0, 1), cA + hstepA, voffA);
        if (wr == 1) PG8_BAR;
        PG8_WAIT_V(2); PG8_BAR;
        PG8_STAGE(PG8_SB(1, 0), cB + kstep, voffB); PG8_STAGE(PG8_SA(1, 0), cA + kstep, voffA); PG8_STAGE(PG8_SB(1, 1), cB + hstepB + kstep, voffB);
        PG8_WAIT_V(6); PG8_BAR;
    } else {
        PG8_STAGE(PG8_SB(0, 0), cB, voffB); PG8_STAGE(PG8_SA(0, 0), cA, voffA); PG8_STAGE(PG8_SB(0, 1), cB + hstepB, voffB); PG8_STAGE(PG8_SA(0, 1), cA + hstepA, voffA);
        if (wr == 1) PG8_BAR;
        PG8_WAIT_V(4); PG8_BAR;
        PG8_STAGE(PG8_SB(1, 0), cB + kstep, voffB); PG8_STAGE(PG8_SA(1, 0), cA + kstep, voffA); PG8_STAGE(PG8_SB(1, 1), cB + hstepB + kstep, voffB);
        PG8_WAIT_V(6); PG8_BAR;
    }
    for (;;) {
        const bool has_next = S.next(ui + 1, nxt);
        const char* nA = has_next ? nxt.A : cA; const char* nB = has_next ? nxt.B : cB;
#pragma unroll 1
        for (int t = 0; t < nt; t += 2) {
            const bool last = (t == nt - 2);
            const char* a1 = cA + (size_t)(t + 1) * kstep;
            const char* a2 = last ? nA : cA + (size_t)(t + 2) * kstep; const char* b2 = last ? nB : cB + (size_t)(t + 2) * kstep;
            const char* a3 = a2 + kstep; const char* b3 = b2 + kstep;
            if constexpr (SP2) {
            PG8_LDB(B0, 0, 0); PG8_LDB(B1, 0, 1); PG8_SCHED; PG8_LDA(At, 0, 0); PG8_STAGE(PG8_SA(1, 1), a1 + hstepA, voffA);
            PG8_WAIT_V(8); PG8_WAIT_L(0); PG8_BAR; PG8_MMA(0, 0, At, B0); PG8_MMA(0, 1, At, B1); PG8_BAR; PG8_SCHED;
            PG8_LDA(At, 0, 1); PG8_STAGE(PG8_SB(0, 0), b2, voffB); PG8_STAGE(PG8_SB(0, 1), b2 + hstepB, voffB); PG8_STAGE(PG8_SA(0, 0), a2, voffA);
            PG8_WAIT_V(8); PG8_WAIT_L(0); PG8_BAR; PG8_MMA(1, 0, At, B0); PG8_MMA(1, 1, At, B1); PG8_BAR; PG8_SCHED;
            PG8_LDB(B0, 1, 0); PG8_LDB(B1, 1, 1); PG8_SCHED; PG8_LDA(At, 1, 0); PG8_STAGE(PG8_SA(0, 1), a2 + hstepA, voffA);
            PG8_WAIT_V(8); PG8_WAIT_L(0); PG8_BAR; PG8_MMA(0, 0, At, B0); PG8_MMA(0, 1, At, B1); PG8_BAR; PG8_SCHED;
            PG8_LDA(At, 1, 1); PG8_STAGE(PG8_SB(1, 0), b3, voffB); PG8_STAGE(PG8_SB(1, 1), b3 + hstepB, voffB); PG8_STAGE(PG8_SA(1, 0), a3, voffA);
            PG8_WAIT_V(8); PG8_WAIT_L(0); PG8_BAR; PG8_MMA(1, 0, At, B0); PG8_MMA(1, 1, At, B1); PG8_BAR; PG8_SCHED;
            } else {
            PG8_LDB(B0, 0, 0); PG8_SCHED; PG8_LDA(At, 0, 0); PG8_STAGE(PG8_SA(1, 1), a1 + hstepA, voffA);
            PG8_WAIT_L(8); PG8_BAR; PG8_WAIT_L(0); PG8_MMA(0, 0, At, B0); PG8_BAR; PG8_SCHED;
            PG8_LDB(B1, 0, 1); PG8_STAGE(PG8_SB(0, 0), b2, voffB);
            PG8_BAR; PG8_WAIT_L(0); PG8_MMA(0, 1, At, B1); PG8_BAR;
            PG8_LDA(At, 0, 1); PG8_STAGE(PG8_SA(0, 0), a2, voffA);
            PG8_BAR; PG8_WAIT_L(0); PG8_MMA(1, 0, At, B0); PG8_BAR; PG8_SCHED;
            PG8_STAGE(PG8_SB(0, 1), b2 + hstepB, voffB);
            PG8_WAIT_V(6); PG8_BAR; PG8_MMA(1, 1, At, B1); PG8_BAR;
            PG8_LDB(B0, 1, 0); PG8_SCHED; PG8_LDA(At, 1, 0); PG8_STAGE(PG8_SA(0, 1), a2 + hstepA, voffA);
            PG8_WAIT_L(8); PG8_BAR; PG8_WAIT_L(0); PG8_MMA(0, 0, At, B0); PG8_BAR; PG8_SCHED;
            PG8_LDB(B1, 1, 1); PG8_STAGE(PG8_SB(1, 0), b3, voffB);
            PG8_BAR; PG8_WAIT_L(0); PG8_MMA(0, 1, At, B1); PG8_BAR;
            PG8_LDA(At, 1, 1); PG8_STAGE(PG8_SA(1, 0), a3, voffA);
            PG8_BAR; PG8_WAIT_L(0); PG8_MMA(1, 0, At, B0); PG8_BAR; PG8_SCHED;
            PG8_STAGE(PG8_SB(1, 1), b3 + hstepB, voffB);
            PG8_WAIT_V(6); PG8_BAR; PG8_MMA(1, 1, At, B1); PG8_BAR;
            }
        }
        if constexpr (ALIGN_EPI) { if (wr == 0) PG8_BAR; }
        E(acc, cur, wr, wc, fr, fq);
        if (!has_next) break;
#pragma unroll
        for (int a = 0; a < 2; ++a)
#pragma unroll
            for (int b = 0; b < 2; ++b)
#pragma unroll
                for (int m = 0; m < 4; ++m)
#pragma unroll
                    for (int n = 0; n < 2; ++n) acc[a][b][m][n] = (f32x4){0.f, 0.f, 0.f, 0.f};
        cur = nxt; cA = nA; cB = nB; ++ui;
        if constexpr (ALIGN_EPI) { if (wr == 1) PG8_BAR; }
    }
    PG8_WAIT_V(0);
    if constexpr (!ALIGN_EPI) { if (wr == 0) PG8_BAR; }
    PG8_BAR;
    __builtin_amdgcn_sched_barrier(0);
#undef PG8_SA
#undef PG8_SB
#undef PG8_STAGE
#undef PG8_LDA
#undef PG8_LDB
#undef PG8_MMA
#undef PG8_WAIT_V
#undef PG8_WAIT_L
#undef PG8_BAR
#undef PG8_SCHED
}
struct TileOrder {
    int nN, total; const char* A; const char* B; size_t tA, tB;
    __device__ __forceinline__ bool next(int i, Unit& u) const {
        const int item = blockIdx.x + i * gridDim.x; if (item >= total) return false;
        const int lt = item >> 3; u.pn = lt % nN; u.pm = (lt / nN) * 8 + (item & 7);
        u.A = A + (size_t)u.pm * tA; u.B = B + (size_t)u.pn * tB; return true;
    }
};
}

typedef __bf16 bf16x8_t __attribute__((ext_vector_type(8)));
__device__ __forceinline__ int lds_off(int row, int chunk) { return row * 128 + ((chunk ^ ((row >> 1) & 7)) << 4); }
template <int TM, int TN, int WM, int WN>
__device__ __forceinline__ void gemm_acc(const bf16_t* __restrict__ As, int lda, const bf16_t* __restrict__ Bs, int ldb, int K, f32x16 (&acc)[TM][TN]) {
    static_assert(TM * WM == 4 && TN * WN == 4 && WM * WN == 4, "tile is 128 x 128, 4 waves");
    const int tid = tidx() & 255, lane = tid & 63, wid = tid >> 6, wm = wid / WN, wn = wid % WN, hl = lane >> 5, cl = lane & 31;
    unsigned char* sm = smem + (tidx() >> 8) * 65536;
#pragma unroll
    for (int i = 0; i < TM; ++i)
#pragma unroll
        for (int j = 0; j < TN; ++j)
#pragma unroll
            for (int r = 0; r < 16; ++r) acc[i][j][r] = 0.f;
    const int srow0 = wid * 32 + (lane >> 3), pc = lane & 7;
    const bf16_t* ga[4]; const bf16_t* gb[4];
#pragma unroll
    for (int i = 0; i < 4; ++i) {
        const int row = srow0 + 8 * i, lc = pc ^ ((row >> 1) & 7);
        ga[i] = As + (size_t)row * lda + lc * 8; gb[i] = Bs + (size_t)row * ldb + lc * 8;
    }
    unsigned char* lbase = sm + wid * 4096 + lane * 16;
    __syncthreads();
#pragma unroll
    for (int i = 0; i < 4; ++i) {
        __builtin_amdgcn_global_load_lds((const unsigned*)ga[i], (unsigned*)(lbase + i * 1024), 16, 0, 0);
        __builtin_amdgcn_global_load_lds((const unsigned*)gb[i], (unsigned*)(lbase + 16384 + i * 1024), 16, 0, 0);
    }
    asm volatile("s_waitcnt vmcnt(0)" ::: "memory");
    __syncthreads();
    const int nk = K >> 6;
    for (int kt = 0; kt < nk; ++kt) {
        const int cur = (kt & 1) * 32768, nxt = 32768 - cur;
        if (kt + 1 < nk) {
#pragma unroll
            for (int i = 0; i < 4; ++i) {
                __builtin_amdgcn_global_load_lds((const unsigned*)(ga[i] + (kt + 1) * 64), (unsigned*)(lbase + nxt + i * 1024), 16, 0, 0);
                __builtin_amdgcn_global_load_lds((const unsigned*)(gb[i] + (kt + 1) * 64), (unsigned*)(lbase + nxt + 16384 + i * 1024), 16, 0, 0);
            }
        }
#pragma unroll
        for (int ks = 0; ks < 4; ++ks) {
            bf16x8_t af[TM], bfr[TN];
#pragma unroll
            for (int i = 0; i < TM; ++i) af[i] = __builtin_bit_cast(bf16x8_t, *(const u32x4*)(sm + cur + lds_off(32 * (TM * wm + i) + cl, 2 * ks + hl)));
#pragma unroll
            for (int j = 0; j < TN; ++j) bfr[j] = __builtin_bit_cast(bf16x8_t, *(const u32x4*)(sm + cur + 16384 + lds_off(32 * (TN * wn + j) + cl, 2 * ks + hl)));
#pragma unroll
            for (int i = 0; i < TM; ++i)
#pragma unroll
                for (int j = 0; j < TN; ++j) acc[i][j] = __builtin_amdgcn_mfma_f32_32x32x16_bf16(af[i], bfr[j], acc[i][j], 0, 0, 0);
        }
        asm volatile("s_waitcnt vmcnt(0)" ::: "memory");
        __syncthreads();
    }
}
#define ACC_ROW(TMv, wm, i, r, hl) (32 * ((TMv) * (wm) + (i)) + ((r) & 3) + 8 * ((r) >> 2) + 4 * (hl))
#define ACC_COL(TNv, wn, j, cl)    (32 * ((TNv) * (wn) + (j)) + (cl))

#define N_ADA 384
#define NW_IN   (1792 * 1024)
#define NW_UQ   (768 * 384)
#define NW_UKV  (1024 * 256)
#define NW_GATE (4 * 512 * 128)
#define NW_O    (1024 * 1024)
#define NW_POOL (4 * 256 * 256)
#define NW_PQ   (2048 * 1024)
#define NW_KEYS (16 * 128 * 128)
#define NW_CKV  (8 * 256 * 256)
#define NW_CKR  (8 * 256 * 64)
#define NW_ROPE 3072
#define NW_SP 1024
#define NT_IN 448
#define NT_UQ 72
#define NT_UKV 64
#define NT_O 256
#define NT_POOL 64
#define NT_PQ 512
#define N_TR (NT_IN + NT_UQ + NT_UKV + NT_O + NT_POOL + 2 * NT_PQ)
#define NE_TOTAL (NW_GATE + 2 * NW_KEYS + NW_CKV + NW_CKR + NW_ROPE + NW_SP)
#define N_CONV_ITEMS ((NE_TOTAL + 4095) / 4096)
#define N_FP8_ITEMS (65536 / NWV / 4)

__device__ __forceinline__ void conv_elem(const Params& p, int e) {
    if (e < NW_GATE) {
        const int c = e & 127, cg = (e >> 7) & 511, nb = e >> 16;
        const int dir = cg >> 8, dg = (cg >> 6) & 3, ri = (cg >> 5) & 1, d = dg * 32 + (cg & 31);
        const float* src = ri ? p.w_ig : p.w_rg;
        p.wt_gate[e] = f2bf(src[(((size_t)dir * 4 + nb) * 128 + c) * 128 + d]); return; } e -= NW_GATE;
#pragma unroll
    for (int l = 0; l < 2; ++l) { if (e < NW_KEYS) { p.keysb[l][e] = f2bf(p.peer_keys[l][e]); return; } e -= NW_KEYS; }
    if (e < NW_CKV) { const int col = e & 255, j = (e >> 8) & 255, b = e >> 16; p.ckvk[(size_t)(T_CTX + b * 2304 + j) * 256 + col] = f2bf(p.cache_ckv[e]); return; } e -= NW_CKV;
    if (e < NW_CKR) { const int col = e & 63, j = (e >> 6) & 255, b = e >> 14; p.kropek[(size_t)(T_CTX + b * 2304 + j) * 64 + col] = f2bf(p.cache_krope[e]); return; } e -= NW_CKR;
    if (e < NW_ROPE) {
        int idx = e, isrow = e < 1024; if (!isrow) idx -= 1024;
        const int half = isrow ? 512 : 1024; const int sn = idx >= half; if (sn) idx -= half;
        const int pos = idx >> 4, fi = idx & 15;
        const float invf = exp2f(-(float)fi * (13.287712379549449f / 16.f));
        const float ang = (float)pos * invf;
        p.ropetab[e] = sn ? sinf(ang) : cosf(ang); return; } e -= NW_ROPE;
    if (e < NW_SP) { const float nl = -p.lam[e]; p.spl[e] = fmaxf(nl, 0.f) + log1pf(__expf(-fabsf(nl))); return; }
}
__device__ __forceinline__ void tr_tile(const float* __restrict__ src, int ldsrc, int nvalid, bf16_t* __restrict__ dst, int lddst, int k0, int n0, float scl = 1.f) {
    float* tile = (float*)(smem + (tidx() >> 8) * 32768);
    const int tid = tidx() & 255;
    __syncthreads();
#pragma unroll
    for (int i = 0; i < 4; ++i) {
        const int k = (tid >> 4) + 16 * i, n = (tid & 15) * 4;
        float4 v = make_float4(0.f, 0.f, 0.f, 0.f);
        if (n0 + n < nvalid) v = *(const float4*)(src + (size_t)(k0 + k) * ldsrc + n0 + n);
        tile[k * 65 + n] = v.x; tile[k * 65 + n + 1] = v.y; tile[k * 65 + n + 2] = v.z; tile[k * 65 + n + 3] = v.w;
    }
    __syncthreads();
    const int n = tid >> 2, kq = (tid & 3) * 16;
    unsigned w[8];
#pragma unroll
    for (int j = 0; j < 8; ++j) w[j] = pack_bf16(tile[(kq + 2 * j) * 65 + n] * scl, tile[(kq + 2 * j + 1) * 65 + n] * scl);
    uint4* d = (uint4*)(dst + (size_t)(n0 + n) * lddst + k0 + kq);
    d[0] = make_uint4(w[0], w[1], w[2], w[3]); d[1] = make_uint4(w[4], w[5], w[6], w[7]);
}
__device__ __forceinline__ void tr_item(const Params& p, int t) {
    if (t < NT_IN) { tr_tile(p.w_in, 1728, 1728, p.wt_in, 1024, (t % 16) * 64, (t / 16) * 64); return; } t -= NT_IN;
    if (t < NT_UQ) { tr_tile(p.w_uq, 768, 768, p.wt_uq, 384, (t % 6) * 64, (t / 6) * 64, 0.07216878364870322f * 1.4426950408889634f  ); return; } t -= NT_UQ;
    if (t < NT_UKV) {
        const int n0 = (t / 4) * 64, h = n0 >> 8, kv = (n0 >> 7) & 1, nn = kv * 512 + h * 128 + (n0 & 127);
        tr_tile(p.w_ukv, 1024, 1024, p.wt_ukv + ((ptrdiff_t)nn - n0) * 256, 256, (t % 4) * 64, n0); return; } t -= NT_UKV;
    if (t < NT_O) { tr_tile(p.w_o, 1024, 1024, p.wt_o, 1024, (t % 16) * 64, (t / 16) * 64); return; } t -= NT_O;
    if (t < NT_POOL) { const int g = t >> 4, tt = t & 15; tr_tile(p.w_pool + (size_t)g * 65536, 256, 256, p.wt_pool + (size_t)g * 65536, 256, (tt & 3) * 64, (tt >> 2) * 64); return; } t -= NT_POOL;
    if (t < NT_PQ) { tr_tile(p.peer_wq[0], 2048, 2048, p.wt_pq[0], 1024, (t % 16) * 64, (t / 16) * 64); return; } t -= NT_PQ;
    tr_tile(p.peer_wq[1], 2048, 2048, p.wt_pq[1], 1024, (t % 16) * 64, (t / 16) * 64);
}

__device__ void st_prologue(const Params& p) {
    const int tid = tidx(), lane = tid & 63, wid = tid >> 6;
    const int n_items = N_ADA + N_TR / 2 + N_CONV_ITEMS + N_FP8_ITEMS;
    for (int item = blockIdx.x; item < n_items; item += gridDim.x) {
        if (item < N_ADA) {
            float* svec = (float*)smem;
            float* red = (float*)(smem + 9 * 4096);
            __syncthreads();
            for (int i = tid; i < 9 * 1024; i += NTHR) { const int bc = i >> 10, k = i & 1023; const float cv = bc == 0 ? p.c_ctx[k] : p.c[(size_t)(bc - 1) * 1024 + k]; svec[i] = silu_(cv); }
            __syncthreads();
            const int cidx = item * 32 + (lane & 7) * 4, l = cidx / 6144, col = cidx % 6144, k0 = (wid * 8 + (lane >> 3)) * 16;
            const float* w = p.w_mod[l] + (size_t)k0 * 6144 + col;
            float acc[9][4];
#pragma unroll
            for (int b = 0; b < 9; ++b) { acc[b][0] = 0.f; acc[b][1] = 0.f; acc[b][2] = 0.f; acc[b][3] = 0.f; }
#pragma unroll 8
            for (int k = 0; k < 16; ++k) {
                const float4 wv = *(const float4*)(w + (size_t)k * 6144);
#pragma unroll
                for (int b = 0; b < 9; ++b) { const float sv = svec[b * 1024 + k0 + k]; acc[b][0] += wv.x * sv; acc[b][1] += wv.y * sv; acc[b][2] += wv.z * sv; acc[b][3] += wv.w * sv; }
            }
#pragma unroll
            for (int b = 0; b < 9; ++b)
#pragma unroll
                for (int j = 0; j < 4; ++j) { float v = acc[b][j]; v += __shfl_xor(v, 8); v += __shfl_xor(v, 16); v += __shfl_xor(v, 32); acc[b][j] = v; }
            if (lane < 8) {
#pragma unroll
                for (int b = 0; b < 9; ++b)
#pragma unroll
                    for (int j = 0; j < 4; ++j) red[(wid * 9 + b) * 32 + lane * 4 + j] = acc[b][j];
            }
            __syncthreads();
            for (int i = tid; i < 9 * 32; i += NTHR) {
                const int b = i >> 5, c = i & 31;
                const int ci = item * 32 + c, ll = ci / 6144, cc = ci % 6144;
                float v = 0.f;
#pragma unroll
                for (int w8 = 0; w8 < 8; ++w8) v += red[(w8 * 9 + b) * 32 + c];
                p.mod[(size_t)(ll * 9 + b) * 6144 + cc] = v + p.b_mod[ll][cc];
            }
        } else if (item < N_ADA + N_TR / 2) {
            tr_item(p, (item - N_ADA) * 2 + (tid >> 8));
        } else if (item < N_ADA + N_TR / 2 + N_CONV_ITEMS) {
            const int base = (item - N_ADA - N_TR / 2) * 4096;
            for (int i = tid; i < 4096; i += NTHR) { const int e = base + i; if (e < NE_TOTAL) conv_elem(p, e); }
        } else {
            const int row0 = ((item - N_ADA - N_TR / 2 - N_CONV_ITEMS) * NWV + wid) * 4;
            const int tb = row0 >> 14, er0 = row0 & 16383, l = tb >> 1;
            const float* src = ((tb & 1) ? p.peer_v[l] : p.peer_u[l]) + (size_t)er0 * 1024 + lane * 16;
            u8_t* dst = ((tb & 1) ? p.v8[l] : p.u8[l]) + (size_t)er0 * 512 + lane * 8;
            float* sc = ((tb & 1) ? p.sv[l] : p.su[l]) + er0;
            f32x4v f[4][4];
#pragma unroll
            for (int r = 0; r < 4; ++r)
#pragma unroll
                for (int j = 0; j < 4; ++j) f[r][j] = __builtin_nontemporal_load((const f32x4v*)(src + (size_t)r * 1024 + 4 * j));
#pragma unroll
            for (int r = 0; r < 4; ++r) {
                float am = 0.f, sq = 0.f;
#pragma unroll
                for (int j = 0; j < 4; ++j) {
                    am = fmaxf(fmaxf(am, fmaxf(fabsf(f[r][j][0]), fabsf(f[r][j][1]))), fmaxf(fabsf(f[r][j][2]), fabsf(f[r][j][3])));
                    sq += (f[r][j][0] * f[r][j][0] + f[r][j][1] * f[r][j][1]) + (f[r][j][2] * f[r][j][2] + f[r][j][3] * f[r][j][3]);
                }
                unsigned w[2]; float scale;
                if (tb & 1) {
                    am = wave_max(am);
                    scale = am > 0.f ? am * (1.f / 6.f) : 1.f; const float inv = am > 0.f ? 6.f / am : 1.f;
#pragma unroll
                    for (int j = 0; j < 2; ++j) {
                        unsigned pk = 0u;
                        pk = __builtin_amdgcn_cvt_scalef32_pk_fp4_f32(pk, f[r][2 * j][0] * inv, f[r][2 * j][1] * inv, 1.0f, 0);
                        pk = __builtin_amdgcn_cvt_scalef32_pk_fp4_f32(pk, f[r][2 * j][2] * inv, f[r][2 * j][3] * inv, 1.0f, 1);
                        pk = __builtin_amdgcn_cvt_scalef32_pk_fp4_f32(pk, f[r][2 * j + 1][0] * inv, f[r][2 * j + 1][1] * inv, 1.0f, 2);
                        pk = __builtin_amdgcn_cvt_scalef32_pk_fp4_f32(pk, f[r][2 * j + 1][2] * inv, f[r][2 * j + 1][3] * inv, 1.0f, 3);
                        w[j] = pk;
                    }
                } else {
                    sq = wave_sum(sq);
                    const float rms = sqrtf(sq * (1.f / 1024.f));
                    scale = rms > 0.f ? 0.3352f * rms : 1.f; const float inv = 1.f / scale;
#pragma unroll
                    for (int j = 0; j < 2; ++j) {
                        unsigned pk = 0u;
#pragma unroll
                        for (int i = 0; i < 8; ++i) {
                            const float x = f[r][2 * j + (i >> 2)][i & 3] * inv;
                            const int q = (int)fminf(fmaxf(rintf(x), -8.f), 7.f);
                            pk |= ((unsigned)q & 15u) << (4 * i);
                        }
                        w[j] = pk;
                    }
                }
                *(uint2*)(dst + (size_t)r * 512) = make_uint2(w[0], w[1]);
                if (lane == 0) sc[r] = scale;
            }
        }
    }
}

template <int FIRST>
__device__ void st_resnorm(const Params& p, int l) {
    const int lane = tidx() & 63, wid = tidx() >> 6, stride = gridDim.x * NWV;
    for (int T0 = blockIdx.x * NWV + wid; T0 < T_TOK; T0 += 2 * stride) {
        float4 xa[2][4]; uint4 ma[2][2];
#pragma unroll
        for (int u = 0; u < 2; ++u) {
            const int T = min(T0 + u * stride, T_TOK - 1);
            const float* x0 = FIRST ? x_in_row(p, T) + lane * 16 : p.xres + (size_t)T * 1024 + lane * 16;
            const uint4* mp = (const uint4*)(p.mix + (size_t)T * 1024 + lane * 16);
#pragma unroll
            for (int j = 0; j < 4; ++j) xa[u][j] = *(const float4*)(x0 + 4 * j);
            ma[u][0] = mp[0]; ma[u][1] = mp[1];
        }
#pragma unroll
        for (int u = 0; u < 2; ++u) {
            const int T = T0 + u * stride;
            if (T < T_TOK) {
                const TokInfo ti = tokinfo(T);
                float* xr = p.xres + (size_t)T * 1024 + lane * 16;
                const float* gt = modv(p, l, ti.mi, 2) + lane * 16;
                float m[16]; { float t8[8]; unpack8(ma[u][0], t8);
#pragma unroll
                    for (int j = 0; j < 8; ++j) m[j] = t8[j];
                    unpack8(ma[u][1], t8);
#pragma unroll
                    for (int j = 0; j < 8; ++j) m[8 + j] = t8[j]; }
                float v[16]; float ss = 0.f;
#pragma unroll
                for (int j = 0; j < 4; ++j) {
                    const float4 f = xa[u][j]; float4 g = *(const float4*)(gt + 4 * j);
                    if (!FIRST) { const float4 sp = *(const float4*)(p.s_pool + lane * 16 + 4 * j); g.x *= sp.x; g.y *= sp.y; g.z *= sp.z; g.w *= sp.w; }
                    v[4 * j] = f.x + g.x * m[4 * j]; v[4 * j + 1] = f.y + g.y * m[4 * j + 1]; v[4 * j + 2] = f.z + g.z * m[4 * j + 2]; v[4 * j + 3] = f.w + g.w * m[4 * j + 3];
                    *(float4*)(xr + 4 * j) = make_float4(v[4 * j], v[4 * j + 1], v[4 * j + 2], v[4 * j + 3]);
                }
#pragma unroll
                for (int j = 0; j < 16; ++j) ss += v[j] * v[j];
                ss = wave_sum(ss);
                const float rstd = rsqrtf(ss * (1.f / 1024.f) + 1e-6f);
                const float* sh = modv(p, l, ti.mi, 3) + lane * 16; const float* sc = modv(p, l, ti.mi, 4) + lane * 16; const float* gg = p.g_ffn[l] + lane * 16;
                float hval[16]; float hm = 0.f;
#pragma unroll
                for (int j = 0; j < 16; ++j) { hval[j] = v[j] * rstd * gg[j] * (1.f + sc[j]) + sh[j]; hm = fmaxf(hm, fabsf(hval[j])); }
                unsigned w[8];
#pragma unroll
                for (int j = 0; j < 8; ++j) w[j] = pack_bf16(hval[2 * j], hval[2 * j + 1]);
                uint4* d = (uint4*)(p.hbuf + (size_t)T * 1024 + lane * 16);
                d[0] = make_uint4(w[0], w[1], w[2], w[3]); d[1] = make_uint4(w[4], w[5], w[6], w[7]);
                hm = wave_max(hm);
                const float hs = hm > 0.f ? hm * (1.f / 119.f) : 1.f, hinv = 1.f / hs;
                unsigned ph[2] = {0u, 0u}, pl[2] = {0u, 0u};
#pragma unroll
                for (int j = 0; j < 16; ++j) {
                    const int h8 = (int)rintf(hval[j] * hinv);
                    const int lo = ((h8 + 8) & 15) - 8, hi = (h8 - lo) >> 4;
                    ph[j >> 3] |= ((unsigned)hi & 15u) << (4 * (j & 7)); pl[j >> 3] |= ((unsigned)lo & 15u) << (4 * (j & 7));
                }
                *(uint2*)(p.hqh + (size_t)T * 128 + lane * 2) = make_uint2(ph[0], ph[1]);
                *(uint2*)(p.hql + (size_t)T * 128 + lane * 2) = make_uint2(pl[0], pl[1]);
                if (lane == 0) p.hsc[T] = hs;
            }
        }
    }
}

template <int SRC>
__device__ void st_norm(const Params& p, int l, int which, const float* g, bf16_t* dst) {
    const int lane = tidx() & 63, wid = tidx() >> 6, stride = gridDim.x * NWV;
    for (int T0 = blockIdx.x * NWV + wid; T0 < T_TOK; T0 += 2 * stride) {
        float v[2][16];
#pragma unroll
        for (int u = 0; u < 2; ++u) {
            const int T = min(T0 + u * stride, T_TOK - 1);
            const float* src = (SRC == 0 ? x_in_row(p, T) : p.xres + (size_t)T * 1024) + lane * 16;
#pragma unroll
            for (int j = 0; j < 4; ++j) { const float4 f = *(const float4*)(src + 4 * j); v[u][4 * j] = f.x; v[u][4 * j + 1] = f.y; v[u][4 * j + 2] = f.z; v[u][4 * j + 3] = f.w; }
        }
#pragma unroll
        for (int u = 0; u < 2; ++u) {
            const int T = T0 + u * stride;
            if (T < T_TOK) {
                const TokInfo ti = tokinfo(T);
                float ss = 0.f;
#pragma unroll
                for (int j = 0; j < 16; ++j) ss += v[u][j] * v[u][j];
                ss = wave_sum(ss);
                const float rstd = rsqrtf(ss * (1.f / 1024.f) + 1e-6f);
                const float* sh = modv(p, l, ti.mi, which ? 3 : 0) + lane * 16; const float* sc = modv(p, l, ti.mi, which ? 4 : 1) + lane * 16; const float* gg = g + lane * 16;
                unsigned w[8];
#pragma unroll
                for (int j = 0; j < 8; ++j) w[j] = pack_bf16(v[u][2 * j] * rstd * gg[2 * j] * (1.f + sc[2 * j]) + sh[2 * j], v[u][2 * j + 1] * rstd * gg[2 * j + 1] * (1.f + sc[2 * j + 1]) + sh[2 * j + 1]);
                uint4* d = (uint4*)(dst + (size_t)T * 1024 + lane * 16);
                d[0] = make_uint4(w[0], w[1], w[2], w[3]); d[1] = make_uint4(w[4], w[5], w[6], w[7]);
            }
        }
    }
}

struct EpiStoreBf16 {
    static constexpr bool PERM = true;
    bf16_t* O; int ldc;
    __device__ __forceinline__ void operator()(const pg8::f32x4 (&acc)[2][2][4][2], const pg8::Unit& u, int wr, int wc, int fr, int fq) const {
#pragma unroll
        for (int ai = 0; ai < 2; ++ai)
#pragma unroll
            for (int m = 0; m < 4; ++m) {
                bf16_t* rowp = O + (size_t)(u.pm * 256 + ai * 128 + wr * 64 + m * 16 + fr) * ldc + u.pn * 256 + wc * 32 + 8 * fq;
#pragma unroll
                for (int bj = 0; bj < 2; ++bj) {
                    const pg8::f32x4 v0 = acc[ai][bj][m][0], v1 = acc[ai][bj][m][1];
                    *(uint4*)(rowp + bj * 128) = make_uint4(pack_bf16(v0[0], v0[1]), pack_bf16(v0[2], v0[3]), pack_bf16(v1[0], v1[1]), pack_bf16(v1[2], v1[3]));
                }
            }
    }
};
__device__ void st_gemm1(const Params& p) {
    pg8::TileOrder S; S.nN = 7; S.total = 80 * 7; S.A = (const char*)p.hbuf; S.B = (const char*)p.wt_in; S.tA = (size_t)256 * 1024 * 2; S.tB = (size_t)256 * 1024 * 2;
    EpiStoreBf16 E; E.O = p.P; E.ldc = 1792;
    pg8::gemm_phase<EpiStoreBf16, pg8::TileOrder, true, true>((LAS unsigned char*)smem, 1024, 1024, 1024, S, E);
}

__device__ void st_postproj(const Params& p) {
    const int lane = tidx() & 63, wid = tidx() >> 6;
    float* o_ckv = p.out + 20971520, *o_kr = p.out + 22020096;
    for (int T = blockIdx.x * NWV + wid; T < T_TOK; T += gridDim.x * NWV) {
        const TokInfo ti = tokinfo(T);
        const bf16_t* Pr = p.P + (size_t)T * 1792;
        float cq[8], ck[8];
#pragma unroll
        for (int j = 0; j < 8; ++j) { cq[j] = 0.f; ck[j] = 0.f; }
        if (lane < 48) unpack8(*(const uint4*)(Pr + lane * 8), cq);
        if (lane < 32) unpack8(*(const uint4*)(Pr + 384 + lane * 8), ck);
        float s1 = 0.f, s2 = 0.f;
#pragma unroll
        for (int j = 0; j < 8; ++j) { s1 += cq[j] * cq[j]; s2 += ck[j] * ck[j]; }
        s1 = wave_sum(s1); s2 = wave_sum(s2);
        const float r1 = rsqrtf(s1 * (1.f / 384.f) + 1e-6f), r2 = rsqrtf(s2 * (1.f / 256.f) + 1e-6f);
        if (lane < 48) {
            const float4 ga = *(const float4*)(p.g_q + lane * 8), gb = *(const float4*)(p.g_q + lane * 8 + 4);
            uint4 o; o.x = pack_bf16(cq[0] * r1 * ga.x, cq[1] * r1 * ga.y); o.y = pack_bf16(cq[2] * r1 * ga.z, cq[3] * r1 * ga.w);
            o.z = pack_bf16(cq[4] * r1 * gb.x, cq[5] * r1 * gb.y); o.w = pack_bf16(cq[6] * r1 * gb.z, cq[7] * r1 * gb.w);
            *(uint4*)(p.cqn + (size_t)T * 384 + lane * 8) = o;
        }
        if (lane < 32) {
            const float4 ga = *(const float4*)(p.g_kv + lane * 8), gb = *(const float4*)(p.g_kv + lane * 8 + 4);
            float y[8] = {ck[0] * r2 * ga.x, ck[1] * r2 * ga.y, ck[2] * r2 * ga.z, ck[3] * r2 * ga.w, ck[4] * r2 * gb.x, ck[5] * r2 * gb.y, ck[6] * r2 * gb.z, ck[7] * r2 * gb.w};
            uint4 o; o.x = pack_bf16(y[0], y[1]); o.y = pack_bf16(y[2], y[3]); o.z = pack_bf16(y[4], y[5]); o.w = pack_bf16(y[6], y[7]);
            *(uint4*)(p.ckvk + (size_t)ti.keyrow * 256 + lane * 8) = o;
            if (!ti.smp) { float4* d = (float4*)(o_ckv + (size_t)T * 256 + lane * 8); d[0] = make_float4(y[0], y[1], y[2], y[3]); d[1] = make_float4(y[4], y[5], y[6], y[7]); }
        }
        if (lane < 8) {
            float v[8]; unpack8(*(const uint4*)(Pr + 640 + lane * 8), v);
            float y[8];
            if (ti.smp) {
                const int gr = ti.s >> 6, gc = ti.s & 63;
#pragma unroll
                for (int i = 0; i < 4; ++i) {
                    const int pr = lane * 4 + i;
                    const float cs = pr < 16 ? p.ropetab[gr * 16 + pr] : p.ropetab[1024 + gc * 16 + (pr - 16)];
                    const float sn = pr < 16 ? p.ropetab[512 + gr * 16 + pr] : p.ropetab[2048 + gc * 16 + (pr - 16)];
                    y[2 * i] = v[2 * i] * cs - v[2 * i + 1] * sn; y[2 * i + 1] = v[2 * i] * sn + v[2 * i + 1] * cs;
                }
            } else {
#pragma unroll
                for (int i = 0; i < 8; ++i) y[i] = v[i];
                float4* d = (float4*)(o_kr + (size_t)T * 64 + lane * 8); d[0] = make_float4(v[0], v[1], v[2], v[3]); d[1] = make_float4(v[4], v[5], v[6], v[7]);
            }
            uint4 o; o.x = pack_bf16(y[0], y[1]); o.y = pack_bf16(y[2], y[3]); o.z = pack_bf16(y[4], y[5]); o.w = pack_bf16(y[6], y[7]);
            *(uint4*)(p.kropek + (size_t)ti.keyrow * 64 + lane * 8) = o;
        }
        {
            const int ch = lane * 8;
            float y[8];
            { const float4 a = *(const float4*)(p.conv_b + ch), b = *(const float4*)(p.conv_b + ch + 4); y[0] = a.x; y[1] = a.y; y[2] = a.z; y[3] = a.w; y[4] = b.x; y[5] = b.y; y[6] = b.z; y[7] = b.w; }
#pragma unroll
            for (int k = 0; k < 4; ++k) {
                const int s2i = ti.s + k - 2;
                if (s2i >= 0 && s2i < ti.S) {
                    float u[8]; unpack8(*(const uint4*)(p.P + (size_t)(T + k - 2) * 1792 + 704 + ch), u);
                    const float4 a = *(const float4*)(p.conv_w + k * 512 + ch), b = *(const float4*)(p.conv_w + k * 512 + ch + 4);
                    y[0] += a.x * u[0]; y[1] += a.y * u[1]; y[2] += a.z * u[2]; y[3] += a.w * u[3]; y[4] += b.x * u[4]; y[5] += b.y * u[5]; y[6] += b.z * u[6]; y[7] += b.w * u[7];
                }
            }
            uint4 o; o.x = pack_bf16(y[0], y[1]); o.y = pack_bf16(y[2], y[3]); o.z = pack_bf16(y[4], y[5]); o.w = pack_bf16(y[6], y[7]);
            *(uint4*)(p.xc + (size_t)T * 512 + ch) = o;
            *(uint4*)(p.ug + (size_t)T * 512 + ch) = *(const uint4*)(Pr + 1216 + ch);
        }
    }
}

struct EpiVT {
    static constexpr bool PERM = true;
    bf16_t* vT;
    __device__ __forceinline__ void operator()(const pg8::f32x4 (&acc)[2][2][4][2], const pg8::Unit& u, int wr, int wc, int fr, int fq) const {
        const int R0 = u.pn * 256;
        size_t sbase; int Sk, pos0;
        if (R0 < T_CTX) { Sk = 256; pos0 = 0; sbase = (size_t)(R0 >> 8) * 4 * 128 * 256; }
        else { const int uu = R0 - T_CTX; const int sq = uu / 2304; Sk = 2304; pos0 = uu - sq * 2304; sbase = (size_t)T_CTX * 512 + (size_t)sq * 4 * 128 * 2304; }
        bf16_t* vb = vT + sbase + pos0 + wc * 32 + 8 * fq;
#pragma unroll
        for (int ai = 0; ai < 2; ++ai)
#pragma unroll
            for (int m = 0; m < 4; ++m) {
                const int r = u.pm * 256 + ai * 128 + wr * 64 + m * 16 + fr;
                bf16_t* rowp = vb + (size_t)r * Sk;
#pragma unroll
                for (int bj = 0; bj < 2; ++bj) {
                    const pg8::f32x4 v0 = acc[ai][bj][m][0], v1 = acc[ai][bj][m][1];
                    *(uint4*)(rowp + bj * 128) = make_uint4(pack_bf16(v0[0], v0[1]), pack_bf16(v0[2], v0[3]), pack_bf16(v1[0], v1[1]), pack_bf16(v1[2], v1[3]));
                }
            }
    }
};
#define N_G4 (160 * 16)
__device__ void st_gemm234(const Params& p) {
    {
        pg8::TileOrder S; S.nN = 3; S.total = 80 * 3; S.A = (const char*)p.cqn; S.B = (const char*)p.wt_uq; S.tA = (size_t)256 * 384 * 2; S.tB = (size_t)256 * 384 * 2;
        EpiStoreBf16 E; E.O = p.q; E.ldc = 768;
        pg8::gemm_phase<EpiStoreBf16, pg8::TileOrder, true, true>((LAS unsigned char*)smem, 384, 384, 384, S, E);
    }
    {
        pg8::TileOrder S; S.nN = 2; S.total = 88 * 2; S.A = (const char*)p.ckvk; S.B = (const char*)p.wt_ukv; S.tA = (size_t)256 * 256 * 2; S.tB = (size_t)256 * 256 * 2;
        EpiStoreBf16 E; E.O = p.Kn; E.ldc = 512;
        pg8::gemm_phase<EpiStoreBf16, pg8::TileOrder, true, true>((LAS unsigned char*)smem, 256, 256, 256, S, E);
    }
    {
        struct OrderVT {
            const char* W; const char* Kr;
            __device__ __forceinline__ bool next(int i, pg8::Unit& u) const {
                const int item = blockIdx.x + i * gridDim.x; if (item >= 88 * 2) return false;
                const int lt = item >> 3; u.pm = lt & 1; u.pn = (lt >> 1) * 8 + (item & 7);
                u.A = W + (size_t)u.pm * 256 * 256 * 2; u.B = Kr + (size_t)u.pn * 256 * 256 * 2; return true;
            }
        } S; S.W = (const char*)(p.wt_ukv + (size_t)512 * 256); S.Kr = (const char*)p.ckvk;
        EpiVT E; E.vT = p.vT;
        pg8::gemm_phase<EpiVT, OrderVT, true, true>((LAS unsigned char*)smem, 256, 256, 256, S, E);
    }
}

__device__ void st_gates(const Params& p) {
    const int half = tidx() >> 8, lane = tidx() & 63, wid = (tidx() >> 6) & 3, wm = wid >> 1, wn = wid & 1, hl = lane >> 5, cl = lane & 31;
    for (int item = blockIdx.x; item < N_G4 / 2; item += gridDim.x) {
        f32x16 acc[2][2];
        const int lt = (item >> 3) * 2 + half, tj = lt & 3, nb = (lt >> 2) & 3, tm = (lt >> 4) * 8 + (item & 7);
        gemm_acc<2, 2, 2, 2>(p.wt_gate + ((size_t)nb * 512 + tj * 128) * 128, 128, p.xc + (size_t)tm * 128 * 512 + nb * 128, 512, 128, acc);
        const int dir = tj >> 1, dg = (tj & 1) * 2 + wm;
#pragma unroll
        for (int gq = 0; gq < 4; ++gq) {
            const int ch0 = nb * 128 + dg * 32 + 8 * gq + 4 * hl;
            const float4 brg = *(const float4*)(p.b_rg + dir * 512 + ch0), big = *(const float4*)(p.b_ig + dir * 512 + ch0), sp = *(const float4*)(p.spl + dir * 512 + ch0);
            const float br[4] = {brg.x, brg.y, brg.z, brg.w}, bi[4] = {big.x, big.y, big.z, big.w}, spv[4] = {sp.x, sp.y, sp.z, sp.w};
#pragma unroll
            for (int j = 0; j < 2; ++j) {
                const int T = tm * 128 + 64 * wn + 32 * j + cl;
                const uint2 xr = *(const uint2*)(p.xc + (size_t)T * 512 + ch0);
                const float xv[4] = {__uint_as_float(xr.x << 16), __uint_as_float(xr.x & 0xffff0000u), __uint_as_float(xr.y << 16), __uint_as_float(xr.y & 0xffff0000u)};
                float am[4], bx[4];
#pragma unroll
                for (int e = 0; e < 4; ++e) {
                    const float rg = __builtin_amdgcn_rcpf(1.f + __expf(-(acc[0][j][4 * gq + e] + br[e]))), ig = __builtin_amdgcn_rcpf(1.f + __expf(-(acc[1][j][4 * gq + e] + bi[e])));
                    const float la = -8.f * rg * spv[e];
                    const float av = __expf(la);
                    am[e] = 1.f - av;
                    bx[e] = __builtin_amdgcn_sqrtf(fmaxf(1.f - av * av, 0.f)) * ig * xv[e];
                }
                *(uint2*)(p.a1m + ((size_t)T * 2 + dir) * 512 + ch0) = make_uint2(pack_bf16(am[0], am[1]), pack_bf16(am[2], am[3]));
                *(uint2*)(p.bxb + ((size_t)T * 2 + dir) * 512 + ch0) = make_uint2(pack_bf16(bx[0], bx[1]), pack_bf16(bx[2], bx[3]));
            }
        }
    }
}

#define N_ATT (64 + 256)
#define SCH 64
#define NCHK (T_TOK / SCH)
#define N_S1 (NCHK * 2)
__device__ void scan_s1_item(const Params& p, int it) {
    const int chunk = it >> 1, dc = (it & 1) * 512 + tidx(), dir = dc >> 9, ch = dc & 511;
    const int T0 = chunk * SCH;
    float A = 1.f, B = 0.f;
#pragma unroll 8
    for (int i = 0; i < SCH; ++i) {
        const int T = dir ? (T0 + SCH - 1 - i) : (T0 + i);
        const float av = 1.f - bf2f(p.a1m[((size_t)T * 2 + dir) * 512 + ch]), bv = bf2f(p.bxb[((size_t)T * 2 + dir) * 512 + ch]);
        A *= av; B = B * av + bv;
    }
    *(float2*)(p.agg + (((size_t)chunk * 2 + dir) * 512 + ch) * 2) = make_float2(A, B);
}

__device__ __forceinline__ int perm23(int r) { return (r & 0x13) | ((r & 4) << 1) | ((r & 8) >> 1); }
__device__ void attn_item_mfma(const Params& p, int it) {
    int seq, h, qb, Sk, T0, R0; size_t vbase;
    if (it < 64) { seq = it >> 2; h = it & 3; qb = 0; Sk = 256; T0 = seq * 256; R0 = seq * 256; vbase = (size_t)(seq * 4 + h) * 128 * 256; }
    else { const int u = it - 64; seq = u >> 5; h = (u >> 3) & 3; qb = u & 7; Sk = 2304; T0 = T_CTX + seq * 2048 + qb * 256; R0 = T_CTX + seq * 2304; vbase = (size_t)T_CTX * 512 + (size_t)(seq * 4 + h) * 128 * 2304; }
    const int tid = tidx(), lane = tid & 63, wid = tid >> 6, hl = lane >> 5, cl = lane & 31;
    bf16x8_t qf[12];
    {
        const bf16_t* qrow = p.q + (size_t)(T0 + 32 * wid + cl) * 768 + h * 192 + 8 * hl;
#pragma unroll
        for (int ks = 0; ks < 12; ++ks) qf[ks] = __builtin_bit_cast(bf16x8_t, *(const u32x4*)(qrow + 16 * ks));
        if (it >= 64) {
            const int sp = qb * 256 + 32 * wid + cl, gr = sp >> 6, gc = sp & 63;
#pragma unroll
            for (int ks = 8; ks < 12; ++ks) {
                const u32x4 w = __builtin_bit_cast(u32x4, qf[ks]); u32x4 o;
#pragma unroll
                for (int i = 0; i < 4; ++i) {
                    const int pr = 8 * (ks - 8) + 4 * hl + i;
                    const float cs = ks < 10 ? p.ropetab[gr * 16 + pr] : p.ropetab[1024 + gc * 16 + (pr - 16)];
                    const float sn = ks < 10 ? p.ropetab[512 + gr * 16 + pr] : p.ropetab[2048 + gc * 16 + (pr - 16)];
                    const float x0 = __uint_as_float(w[i] << 16), x1 = __uint_as_float(w[i] & 0xffff0000u);
                    o[i] = pack_bf16(x0 * cs - x1 * sn, x0 * sn + x1 * cs);
                }
                qf[ks] = __builtin_bit_cast(bf16x8_t, o);
            }
        }
    }
    f32x16 oacc[4];
#pragma unroll
    for (int d = 0; d < 4; ++d)
#pragma unroll
        for (int r = 0; r < 16; ++r) oacc[d][r] = 0.f;
    float m = -1e30f, lsum = 0.f;
    const bf16_t* gk = p.Kn + (size_t)(R0 + (tid >> 4)) * 512 + h * 128 + (tid & 15) * 8;
    const bf16_t* gr = p.kropek + (size_t)(R0 + (tid >> 3)) * 64 + (tid & 7) * 8;
    const bf16_t* gv = p.vT + vbase + (size_t)(tid >> 3) * Sk + (tid & 7) * 8;
    u32x4 rk[2], rr, rv[2];
    const int nt = Sk >> 6;
#pragma unroll
    for (int i = 0; i < 2; ++i) rk[i] = *(const u32x4*)(gk + (size_t)(32 * i) * 512);
    rr = *(const u32x4*)gr;
#pragma unroll
    for (int i = 0; i < 2; ++i) rv[i] = *(const u32x4*)(gv + (size_t)(64 * i) * Sk);
    __syncthreads();
    for (int t = 0; t < nt; ++t) {
#pragma unroll
        for (int i = 0; i < 2; ++i) *(u32x4*)(smem + ((tid & 15) >> 3) * 8192 + lds_off((tid >> 4) + 32 * i, tid & 7)) = rk[i];
        *(u32x4*)(smem + 16384 + lds_off(tid >> 3, tid & 7)) = rr;
#pragma unroll
        for (int i = 0; i < 2; ++i) *(u32x4*)(smem + 24576 + lds_off((tid >> 3) + 64 * i, tid & 7)) = rv[i];
        __syncthreads();
        if (t + 1 < nt) {
            const size_t ko = (size_t)(t + 1) * 64;
#pragma unroll
            for (int i = 0; i < 2; ++i) rk[i] = *(const u32x4*)(gk + (ko + 32 * i) * 512);
            rr = *(const u32x4*)(gr + ko * 64);
#pragma unroll
            for (int i = 0; i < 2; ++i) rv[i] = *(const u32x4*)(gv + (size_t)(64 * i) * Sk + ko);
        }
        f32x16 sacc[2];
#pragma unroll
        for (int kb = 0; kb < 2; ++kb) {
            __builtin_amdgcn_sched_barrier(0);
#pragma unroll
            for (int r = 0; r < 16; ++r) sacc[kb][r] = 0.f;
            const int krow = 32 * kb + perm23(cl);
#pragma unroll
            for (int ks = 0; ks < 12; ++ks) {
                const bf16x8_t kf = __builtin_bit_cast(bf16x8_t, *(const u32x4*)(smem + (ks >> 2) * 8192 + lds_off(krow, 2 * (ks & 3) + hl)));
                sacc[kb] = __builtin_amdgcn_mfma_f32_32x32x16_bf16(kf, qf[ks], sacc[kb], 0, 0, 0);
            }
        }
        float mx = sacc[0][0];
#pragma unroll
        for (int r = 1; r < 16; ++r) mx = fmaxf(mx, sacc[0][r]);
#pragma unroll
        for (int r = 0; r < 16; ++r) mx = fmaxf(mx, sacc[1][r]);
        mx = fmaxf(mx, __shfl_xor(mx, 32));
        const bool resc = !__all(mx - m <= 8.f);
        const float mn = resc ? fmaxf(m, mx) : m, alpha = resc ? __builtin_amdgcn_exp2f(m - mn) : 1.f;
        m = mn;
        float ps = 0.f;
        bf16x8_t pf[2][2];
#pragma unroll
        for (int kb = 0; kb < 2; ++kb)
#pragma unroll
            for (int s2 = 0; s2 < 2; ++s2) {
                float e[8];
#pragma unroll
                for (int j = 0; j < 8; ++j) { e[j] = __builtin_amdgcn_exp2f(sacc[kb][8 * s2 + j] - mn); ps += e[j]; }
                u32x4 w; w.x = pack_bf16(e[0], e[1]); w.y = pack_bf16(e[2], e[3]); w.z = pack_bf16(e[4], e[5]); w.w = pack_bf16(e[6], e[7]);
                pf[kb][s2] = __builtin_bit_cast(bf16x8_t, w);
            }
        lsum = lsum * alpha + ps;
        if (resc) {
#pragma unroll
            for (int d = 0; d < 4; ++d)
#pragma unroll
                for (int r = 0; r < 16; ++r) oacc[d][r] *= alpha;
        }
#pragma unroll
        for (int d = 0; d < 4; ++d) {
            __builtin_amdgcn_sched_barrier(0);
#pragma unroll
            for (int kb = 0; kb < 2; ++kb)
#pragma unroll
                for (int s2 = 0; s2 < 2; ++s2) {
                    const bf16x8_t vf = __builtin_bit_cast(bf16x8_t, *(const u32x4*)(smem + 24576 + lds_off(32 * d + cl, 4 * kb + 2 * s2 + hl)));
                    oacc[d] = __builtin_amdgcn_mfma_f32_32x32x16_bf16(vf, pf[kb][s2], oacc[d], 0, 0, 0);
                }
        }
        __builtin_amdgcn_sched_barrier(0);
        __syncthreads();
    }
    lsum += __shfl_xor(lsum, 32);
    const float inv = 1.f / lsum;
    bf16_t* dst = p.hbuf + (size_t)(T0 + 32 * wid + cl) * 1024 + h * 128 + 4 * hl;
#pragma unroll
    for (int d = 0; d < 4; ++d)
#pragma unroll
        for (int g = 0; g < 4; ++g) {
            uint2 w; w.x = pack_bf16(oacc[d][4 * g] * inv, oacc[d][4 * g + 1] * inv); w.y = pack_bf16(oacc[d][4 * g + 2] * inv, oacc[d][4 * g + 3] * inv);
            *(uint2*)(dst + 32 * d + 8 * g) = w;
        }
}
__device__ void st_attn_s1(const Params& p) {
    for (int item = blockIdx.x; item < N_ATT + N_S1; item += gridDim.x) {
        if (item < N_ATT) {
            attn_item_mfma(p, N_ATT - 1 - item);
        }
        else scan_s1_item(p, item - N_ATT);
    }
}

__device__ void st_scan3(const Params& p) {
    const int tid = tidx();
    float* hf = (float*)smem;
    float* hb = hf + SCH * 256;
    float* o_lru = p.out + 22282240;
    for (int item = blockIdx.x; item < NCHK * 2; item += gridDim.x) {
        const int chunk = item >> 1, cgp = item & 1, T0 = chunk * SCH;
        const TokInfo ti = tokinfo(T0);
        const int nch = ti.S / SCH, cpos = ti.s / SCH, c0 = chunk - cpos;
        const int dir = tid >> 8, ch = cgp * 256 + (tid & 255);
        float hcur = ti.smp ? p.state_lru[((size_t)ti.b * 2 + dir) * 512 + ch] : 0.f;
        if (dir == 0) { for (int cc = 0; cc < cpos; ++cc) { const float2 ab = *(const float2*)(p.agg + (((size_t)(c0 + cc) * 2 + 0) * 512 + ch) * 2); hcur = ab.x * hcur + ab.y; } }
        else { for (int cc = nch - 1; cc > cpos; --cc) { const float2 ab = *(const float2*)(p.agg + (((size_t)(c0 + cc) * 2 + 1) * 512 + ch) * 2); hcur = ab.x * hcur + ab.y; } }
        __syncthreads();
#pragma unroll 8
        for (int i = 0; i < SCH; ++i) {
            const int tl = dir ? SCH - 1 - i : i, T = T0 + tl;
            const float av = 1.f - bf2f(p.a1m[((size_t)T * 2 + dir) * 512 + ch]), bv = bf2f(p.bxb[((size_t)T * 2 + dir) * 512 + ch]);
            hcur = av * hcur + bv;
            (dir ? hb : hf)[tl * 256 + (tid & 255)] = hcur;
        }
        if (!ti.smp) {
            if (dir == 0 && cpos == nch - 1) o_lru[((size_t)ti.b * 2 + 0) * 512 + ch] = hcur;
            if (dir == 1 && cpos == 0) o_lru[((size_t)ti.b * 2 + 1) * 512 + ch] = hcur;
        }
        __syncthreads();
        for (int i = tid; i < SCH * 128; i += NTHR) {
            const int tl = i >> 7, c = (i & 127) * 2, T = T0 + tl, chh = cgp * 256 + c;
            const unsigned ugp = *(const unsigned*)(p.ug + (size_t)T * 512 + chh);
            const float g0 = gelu_tanh(__uint_as_float(ugp << 16)), g1 = gelu_tanh(__uint_as_float(ugp & 0xffff0000u));
            const float2 f = *(const float2*)(hf + tl * 256 + c), bb = *(const float2*)(hb + tl * 256 + c);
            *(unsigned*)(p.hbuf + (size_t)T * 1024 + 512 + chh) = pack_bf16((f.x + bb.x) * g0, (f.y + bb.y) * g1);
        }
    }
}

__device__ void st_gemm_o(const Params& p) {
    pg8::TileOrder S; S.nN = 4; S.total = 80 * 4; S.A = (const char*)p.hbuf; S.B = (const char*)p.wt_o; S.tA = (size_t)256 * 1024 * 2; S.tB = (size_t)256 * 1024 * 2;
    EpiStoreBf16 E; E.O = p.mix; E.ldc = 1024;
    pg8::gemm_phase<EpiStoreBf16, pg8::TileOrder, true, true>((LAS unsigned char*)smem, 1024, 1024, 1024, S, E);
}

__device__ void st_gemm_pq(const Params& p, int l) {
    pg8::TileOrder S; S.nN = 8; S.total = 80 * 8; S.A = (const char*)p.hbuf; S.B = (const char*)p.wt_pq[l]; S.tA = (size_t)256 * 1024 * 2; S.tB = (size_t)256 * 1024 * 2;
    EpiStoreBf16 E; E.O = p.qp; E.ldc = 2048;
    pg8::gemm_phase<EpiStoreBf16, pg8::TileOrder, true, true>((LAS unsigned char*)smem, 1024, 1024, 1024, S, E);
}

__device__ __forceinline__ void ce_desc(float& a, float& b) { const float hi = fmaxf(a, b), lo = fminf(a, b); a = hi; b = lo; }
__device__ __forceinline__ void ins16(float (&top)[16], float x) {
#pragma unroll
    for (int i = 0; i < 16; ++i) { const float hi = fmaxf(top[i], x); x = fminf(top[i], x); top[i] = hi; }
}
__device__ __forceinline__ void bitonic_merge16(float (&v)[16]) {
#pragma unroll
    for (int j = 8; j >= 1; j >>= 1)
#pragma unroll
        for (int i = 0; i < 16; ++i) { const int l = i ^ j; if (l > i) ce_desc(v[i], v[l]); }
}
__device__ __forceinline__ void sort16(float (&v)[16]) {
#pragma unroll
    for (int k = 2; k <= 16; k <<= 1)
#pragma unroll
        for (int j = k >> 1; j >= 1; j >>= 1)
#pragma unroll
            for (int i = 0; i < 16; ++i) { const int l = i ^ j; if (l > i) { if ((i & k) == 0) ce_desc(v[i], v[l]); else ce_desc(v[l], v[i]); } }
}
__device__ __forceinline__ void merge_top16(float (&a)[16], const float (&b)[16]) {
#pragma unroll
    for (int i = 0; i < 16; ++i) a[i] = fmaxf(a[i], b[15 - i]);
    bitonic_merge16(a);
}
#define PKV(x) __uint_as_float(__float_as_uint(x) & 0xffffff80u)
#define CAND(i, j) __uint_as_float((__float_as_uint(PKV(top[0][i]) + PKV(top[1][j])) & 0xffffff00u) | (unsigned)((i) * 16 + (j)))
__device__ void st_peer_topk(const Params& p, int l) {
    const int half = tidx() >> 8, lane = tidx() & 63, wid = (tidx() >> 6) & 3, hl = lane >> 5, cl = lane & 31;
    for (int item = blockIdx.x; item < 160 * 8 / 2; item += gridDim.x) {
        const int lt = (item >> 3) * 2 + half, h = lt & 7, tm = (lt >> 3) * 8 + (item & 7);
        const int T = tm * 128 + 32 * wid + cl;
        float top[2][16];
#pragma unroll
        for (int pp = 0; pp < 2; ++pp) {
            f32x16 acc[4][1];
            gemm_acc<4, 1, 1, 4>(p.keysb[l] + (size_t)(h * 2 + pp) * 128 * 128, 128, p.qp + (size_t)tm * 128 * 2048 + h * 256 + pp * 128, 2048, 128, acc);
#pragma unroll
            for (int i = 0; i < 4; ++i) {
                __builtin_amdgcn_sched_barrier(0);
                float g[16];
#pragma unroll
                for (int r = 0; r < 16; ++r) {
                    const int n = ACC_ROW(4, 0, i, r, hl);
                    g[r] = __uint_as_float((__float_as_uint(acc[i][0][r]) & 0xffffff80u) | (unsigned)n);
                }
                sort16(g);
                if (i == 0) {
#pragma unroll
                    for (int r = 0; r < 16; ++r) top[pp][r] = g[r];
                } else merge_top16(top[pp], g);
            }
            __builtin_amdgcn_sched_barrier(0);
            float oth[16];
#pragma unroll
            for (int i = 0; i < 16; ++i) oth[i] = __shfl_xor(top[pp][i], 32);
            merge_top16(top[pp], oth);
        }
        __builtin_amdgcn_sched_barrier(0);
        float fv[16], t2[16];
#pragma unroll
        for (int j = 0; j < 16; ++j) fv[j] = CAND(0, j);
        t2[15] = -INFINITY;
#pragma unroll
        for (int i = 1; i < 16; ++i) t2[i - 1] = CAND(i, 0);
        merge_top16(fv, t2);
        t2[0] = CAND(1, 1); t2[1] = CAND(1, 2); t2[2] = CAND(1, 3); t2[3] = CAND(1, 4); t2[4] = CAND(1, 5); t2[5] = CAND(1, 6); t2[6] = CAND(1, 7);
        t2[7] = CAND(2, 1); t2[8] = CAND(2, 2); t2[9] = CAND(2, 3); t2[10] = CAND(2, 4); t2[11] = CAND(3, 1); t2[12] = CAND(3, 2); t2[13] = CAND(3, 3);
        t2[14] = CAND(4, 1); t2[15] = CAND(4, 2);
        sort16(t2);
        merge_top16(fv, t2);
        ins16(fv, CAND(5, 1)); ins16(fv, CAND(6, 1)); ins16(fv, CAND(7, 1));
        unsigned* tab = (unsigned*)(smem + half * 65536) + (size_t)(tidx() & 255) * 8;
#pragma unroll
        for (int k = 0; k < 4; ++k) {
            tab[k] = (__float_as_uint(top[0][4 * k]) & 127u) | ((__float_as_uint(top[0][4 * k + 1]) & 127u) << 8) | ((__float_as_uint(top[0][4 * k + 2]) & 127u) << 16) | ((__float_as_uint(top[0][4 * k + 3]) & 127u) << 24);
            tab[4 + k] = (__float_as_uint(top[1][4 * k]) & 127u) | ((__float_as_uint(top[1][4 * k + 1]) & 127u) << 8) | ((__float_as_uint(top[1][4 * k + 2]) & 127u) << 16) | ((__float_as_uint(top[1][4 * k + 3]) & 127u) << 24);
        }
        const u8_t* tabb = (const u8_t*)tab;
        int fe[16];
#pragma unroll
        for (int i = 0; i < 16; ++i) {
            const unsigned code = __float_as_uint(fv[i]) & 255u;
            fe[i] = (int)tabb[code >> 4] * 128 + (int)tabb[16 + (code & 15u)];
            fv[i] = __uint_as_float(__float_as_uint(fv[i]) & 0xffffff00u);
        }
        float sum = 0.f, ev[16];
#pragma unroll
        for (int i = 0; i < 16; ++i) { ev[i] = __expf(fv[i] - fv[0]); sum += ev[i]; }
        const float inv = 1.f / sum;
        if (hl == 0) {
            float4* gp = (float4*)(p.gates + (size_t)T * 128 + h * 16); int4* ep = (int4*)(p.eidx + (size_t)T * 128 + h * 16);
#pragma unroll
            for (int i = 0; i < 4; ++i) { gp[i] = make_float4(ev[4 * i] * inv, ev[4 * i + 1] * inv, ev[4 * i + 2] * inv, ev[4 * i + 3] * inv); ep[i] = make_int4(fe[4 * i], fe[4 * i + 1], fe[4 * i + 2], fe[4 * i + 3]); }
        }
    }
}

#define FP4X(dw, b) __builtin_amdgcn_cvt_scalef32_pk_f32_fp4(dw, 1.0f, b)
#define FP4B(dw, b) __builtin_amdgcn_cvt_scalef32_pk_bf16_fp4(dw, 1.0f, b)
__device__ void st_peer_gather(const Params& p, int l) {
    const int lane = tidx() & 63, wid = __builtin_amdgcn_readfirstlane(tidx() >> 6), g = lane >> 3, pc = lane & 7;
    const u8_t* U = p.u8[l]; const u8_t* V = p.v8[l]; const float* SU = p.su[l]; const float* SV = p.sv[l];
    const bool b0 = (lane & 1) != 0, b1 = (lane & 2) != 0, b2 = (lane & 4) != 0, b3 = (lane & 8) != 0;
    const int stride = gridDim.x * NWV, Tfirst = blockIdx.x * NWV + wid;
    const int ka = 16 * g + pc, kb = ka + 8;
#pragma unroll 1
    for (int c = 0; c < 4; ++c) {
#pragma unroll 1
        for (int T = Tfirst; T < T_TOK; T += stride) {
            int ev[16];
            { const int4* ep = (const int4*)(p.eidx + (size_t)T * 128 + 16 * g);
#pragma unroll
              for (int q = 0; q < 4; ++q) { const int4 t = ep[q]; ev[4 * q] = t.x; ev[4 * q + 1] = t.y; ev[4 * q + 2] = t.z; ev[4 * q + 3] = t.w; } }
            const u32x4 hh4 = *(const u32x4*)(p.hqh + (size_t)T * 128 + c * 32 + pc * 4), hl4 = *(const u32x4*)(p.hql + (size_t)T * 128 + c * 32 + pc * 4);
            u32x4 r[16];
#pragma unroll
            for (int i = 0; i < 16; ++i) {
                r[i] = *(const u32x4*)(U + ((unsigned)ev[i] * 512u + (unsigned)(c * 128 + pc * 16)));
            }
            float za = 0.f, zb = 0.f;
            if (c > 0) { za = p.zbuf[(size_t)T * 128 + ka]; zb = p.zbuf[(size_t)T * 128 + kb]; }
#pragma unroll
            for (int hh = 0; hh < 2; ++hh) {
                float d[8];
#pragma unroll
                for (int ii = 0; ii < 8; ++ii) {
                    int ah = 0, al = 0;
#pragma unroll
                    for (int q = 0; q < 4; ++q) { ah = __builtin_amdgcn_sdot8((int)r[8 * hh + ii][q], (int)hh4[q], ah, false); al = __builtin_amdgcn_sdot8((int)r[8 * hh + ii][q], (int)hl4[q], al, false); }
                    d[ii] = (float)(ah * 16 + al);
                }
                float a4[4], a2[2];
#pragma unroll
                for (int j = 0; j < 4; ++j) { const float kp = b2 ? d[j + 4] : d[j], sn = b2 ? d[j] : d[j + 4]; a4[j] = kp + DPP_F(sn, 0x141); }
#pragma unroll
                for (int j = 0; j < 2; ++j) { const float kp = b1 ? a4[j + 2] : a4[j], sn = b1 ? a4[j] : a4[j + 2]; a2[j] = kp + DPP_F(sn, 0x4E); }
                const float kp = b0 ? a2[1] : a2[0], sn = b0 ? a2[0] : a2[1];
                const float z = kp + DPP_F(sn, 0xB1);
                if (hh == 0) za += z; else zb += z;
            }
            if (c < 3) { p.zbuf[(size_t)T * 128 + ka] = za; p.zbuf[(size_t)T * 128 + kb] = zb; }
            else {
                const int ea = p.eidx[(size_t)T * 128 + ka], eb = p.eidx[(size_t)T * 128 + kb];
                const float ga = p.gates[(size_t)T * 128 + ka], gb = p.gates[(size_t)T * 128 + kb];
                const float hs = p.hsc[T];
                p.wbuf[(size_t)T * 128 + ka] = ga * gelu_tanh(za * (SU[ea] * hs)) * SV[ea];
                p.wbuf[(size_t)T * 128 + kb] = gb * gelu_tanh(zb * (SU[eb] * hs)) * SV[eb];
            }
        }
    }
    asm volatile("s_waitcnt vmcnt(0)" ::: "memory");
#pragma unroll 1
    for (int c = 0; c < 4; ++c) {
#pragma unroll 1
        for (int T = Tfirst; T < T_TOK; T += stride) {
            int ev[16]; float wv[16];
            { const int4* ep = (const int4*)(p.eidx + (size_t)T * 128 + 16 * g); const float4* wp = (const float4*)(p.wbuf + (size_t)T * 128 + 16 * g);
#pragma unroll
              for (int q = 0; q < 4; ++q) { const int4 t = ep[q]; ev[4 * q] = t.x; ev[4 * q + 1] = t.y; ev[4 * q + 2] = t.z; ev[4 * q + 3] = t.w;
                                            const float4 u = wp[q]; wv[4 * q] = u.x; wv[4 * q + 1] = u.y; wv[4 * q + 2] = u.z; wv[4 * q + 3] = u.w; } }
            u32x4 r[16];
#pragma unroll
            for (int i = 0; i < 16; ++i) {
                r[i] = *(const u32x4*)(V + ((unsigned)ev[i] * 512u + (unsigned)(c * 128 + pc * 16)));
            }
            f32x2 acc2[16];
#pragma unroll
            for (int j = 0; j < 16; ++j) acc2[j] = (f32x2){0.f, 0.f};
#pragma unroll
            for (int i = 0; i < 16; ++i) {
                const f32x2 wk2 = {wv[i], wv[i]};
#pragma unroll
                for (int q = 0; q < 4; ++q) {
                    acc2[4 * q] = FP4X(r[i][q], 0) * wk2 + acc2[4 * q]; acc2[4 * q + 1] = FP4X(r[i][q], 1) * wk2 + acc2[4 * q + 1];
                    acc2[4 * q + 2] = FP4X(r[i][q], 2) * wk2 + acc2[4 * q + 2]; acc2[4 * q + 3] = FP4X(r[i][q], 3) * wk2 + acc2[4 * q + 3];
                }
                __builtin_amdgcn_sched_barrier(0);
            }
            float acc[32];
#pragma unroll
            for (int j = 0; j < 16; ++j) { acc[2 * j] = acc2[j].x; acc[2 * j + 1] = acc2[j].y; }
            float s1[16], s2[8], s3[4];
#pragma unroll
            for (int j = 0; j < 16; ++j) { const u32x2 rr = __builtin_amdgcn_permlane32_swap(__float_as_uint(acc[j]), __float_as_uint(acc[j + 16]), false, false); s1[j] = __uint_as_float(rr[0]) + __uint_as_float(rr[1]); }
#pragma unroll
            for (int j = 0; j < 8; ++j) { const u32x2 rr = __builtin_amdgcn_permlane16_swap(__float_as_uint(s1[j]), __float_as_uint(s1[j + 8]), false, false); s2[j] = __uint_as_float(rr[0]) + __uint_as_float(rr[1]); }
#pragma unroll
            for (int j = 0; j < 4; ++j) { const float kp = b3 ? s2[j + 4] : s2[j], sn = b3 ? s2[j] : s2[j + 4]; s3[j] = kp + DPP_F(sn, 0x128); }
            *(uint2*)(p.mix + (size_t)T * 1024 + c * 256 + pc * 32 + g * 4) = make_uint2(pack_bf16(s3[0], s3[1]), pack_bf16(s3[2], s3[3]));
        }
    }
    asm volatile("s_waitcnt vmcnt(0)" ::: "memory");
#pragma unroll 1
    for (int T = Tfirst; T < T_TOK; T += stride) {
        const TokInfo ti = tokinfo(T);
        const int cb = lane * 16;
        float o16[16];
        { const uint4* op = (const uint4*)(p.mix + (size_t)T * 1024 + cb); float t8[8]; unpack8(op[0], t8);
#pragma unroll
          for (int j = 0; j < 8; ++j) o16[j] = t8[j];
          unpack8(op[1], t8);
#pragma unroll
          for (int j = 0; j < 8; ++j) o16[8 + j] = t8[j]; }
        float* xr = p.xres + (size_t)T * 1024 + cb;
        const float* gt = modv(p, l, ti.mi, 5) + cb;
        float xn[16]; float ss = 0.f;
#pragma unroll
        for (int j = 0; j < 4; ++j) { const float4 f = *(const float4*)(xr + 4 * j); xn[4 * j] = f.x + gt[4 * j] * o16[4 * j]; xn[4 * j + 1] = f.y + gt[4 * j + 1] * o16[4 * j + 1]; xn[4 * j + 2] = f.z + gt[4 * j + 2] * o16[4 * j + 2]; xn[4 * j + 3] = f.w + gt[4 * j + 3] * o16[4 * j + 3]; }
#pragma unroll
        for (int j = 0; j < 16; ++j) ss += xn[j] * xn[j];
        ss = wave_sum(ss);
        const float rstd = rsqrtf(ss * (1.f / 1024.f) + 1e-6f);
        if (l == 0) {
#pragma unroll
            for (int j = 0; j < 4; ++j) *(float4*)(xr + 4 * j) = make_float4(xn[4 * j], xn[4 * j + 1], xn[4 * j + 2], xn[4 * j + 3]);
            const float* sh = modv(p, 1, ti.mi, 0) + cb; const float* sc = modv(p, 1, ti.mi, 1) + cb; const float* gg = p.g_mix[1] + cb;
            unsigned w[8];
#pragma unroll
            for (int j = 0; j < 8; ++j) w[j] = pack_bf16(xn[2 * j] * rstd * gg[2 * j] * (1.f + sc[2 * j]) + sh[2 * j], xn[2 * j + 1] * rstd * gg[2 * j + 1] * (1.f + sc[2 * j + 1]) + sh[2 * j + 1]);
            uint4* dd = (uint4*)(p.h3 + (size_t)T * 1024 + cb);
            dd[0] = make_uint4(w[0], w[1], w[2], w[3]); dd[1] = make_uint4(w[4], w[5], w[6], w[7]);
        } else {
            const float* gg = p.g_final + cb;
            float* y = p.out + (size_t)T * 1024 + cb;
#pragma unroll
            for (int j = 0; j < 4; ++j) *(float4*)(y + 4 * j) = make_float4(xn[4 * j] * rstd * gg[4 * j], xn[4 * j + 1] * rstd * gg[4 * j + 1], xn[4 * j + 2] * rstd * gg[4 * j + 2], xn[4 * j + 3] * rstd * gg[4 * j + 3]);
        }
    }
}

template <int W>
__device__ __forceinline__ void pool_tok(const Params& p, int T, int ck) {
    const TokInfo ti = tokinfo(T);
    const bf16_t* base = p.h3 + (size_t)(T - ti.s) * 1024 + ck * 8;
    uint4 raw[W];
#pragma unroll
    for (int k = 0; k < W; ++k) {
        const int t2 = ti.s - W / 2 + k;
        raw[k] = (t2 >= 0 && t2 < ti.S) ? *(const uint4*)(base + (size_t)t2 * 1024) : make_uint4(0u, 0u, 0u, 0u);
    }
    float acc[8];
#pragma unroll
    for (int j = 0; j < 8; ++j) acc[j] = 0.f;
#pragma unroll
    for (int k = 0; k < W; ++k) { float f[8]; unpack8(raw[k], f);
#pragma unroll
        for (int j = 0; j < 8; ++j) acc[j] += f[j]; }
    float c[8]; unpack8(raw[W / 2], c);
    const int lo = max(ti.s - W / 2, 0), hi = min(ti.s + W / 2, ti.S);
    const float inv = 1.f / (float)(hi - lo);
    uint4 o;
    o.x = pack_bf16(acc[0] * inv - c[0], acc[1] * inv - c[1]); o.y = pack_bf16(acc[2] * inv - c[2], acc[3] * inv - c[3]);
    o.z = pack_bf16(acc[4] * inv - c[4], acc[5] * inv - c[5]); o.w = pack_bf16(acc[6] * inv - c[6], acc[7] * inv - c[7]);
    *(uint4*)(p.hbuf + (size_t)T * 1024 + ck * 8) = o;
}
__device__ void st_pool(const Params& p) {
    const int tid = tidx(), lane = tid & 63, wv = tid >> 6, g = wv & 3, ck = g * 32 + (lane & 31), tsub = (wv >> 2) * 2 + (lane >> 5);
    const int per = (T_TOK + gridDim.x - 1) / gridDim.x, Tb = blockIdx.x * per, Te = min(Tb + per, T_TOK);
    for (int T = Tb + tsub; T < Te; T += 4) {
        if (g == 0) pool_tok<2>(p, T, ck); else if (g == 1) pool_tok<4>(p, T, ck); else if (g == 2) pool_tok<8>(p, T, ck); else pool_tok<16>(p, T, ck);
    }
}

__device__ void st_gemm_pool(const Params& p) {
    struct OrderPool {
        const char* A; const char* B;
        __device__ __forceinline__ bool next(int i, pg8::Unit& u) const {
            const int item = blockIdx.x + i * gridDim.x; if (item >= 80 * 4) return false;
            const int lt = item >> 3; u.pn = lt & 3; u.pm = (lt >> 2) * 8 + (item & 7);
            u.A = A + (size_t)u.pm * 256 * 1024 * 2 + (size_t)u.pn * 256 * 2; u.B = B + (size_t)u.pn * 256 * 256 * 2; return true;
        }
    } S; S.A = (const char*)p.hbuf; S.B = (const char*)p.wt_pool;
    EpiStoreBf16 E; E.O = p.mix; E.ldc = 1024;
    pg8::gemm_phase<EpiStoreBf16, OrderPool, true, true>((LAS unsigned char*)smem, 1024, 256, 256, S, E);
}

__device__ __forceinline__ void run_stage(const Params& p, int s) {
#ifdef ONLY_STAGE
    if (s != ONLY_STAGE) return;
#endif
    switch (s) {
        case 0: st_prologue(p); break;
        case 1: st_norm<0>(p, 0, 0, p.g_mix[0], p.hbuf); break;
        case 2: st_gemm1(p); break;
        case 3: st_postproj(p); break;
        case 4: st_gemm234(p); break;
        case 18: st_gates(p); break;
        case 5: st_attn_s1(p); break;
        case 6: st_scan3(p); break;
        case 7: st_gemm_o(p); break;
        case 8: st_resnorm<1>(p, 0); break;
        case 9: st_gemm_pq(p, 0); break;
        case 10: st_peer_topk(p, 0); break;
        case 11: st_peer_gather(p, 0); break;
        case 12: st_pool(p); break;
        case 13: st_gemm_pool(p); break;
        case 14: st_resnorm<0>(p, 1); break;
        case 15: st_gemm_pq(p, 1); break;
        case 16: st_peer_topk(p, 1); break;
        case 17: st_peer_gather(p, 1); break;
        default: break;
    }
}

__global__ void __launch_bounds__(NTHR, 2) fwd_mega(Params p) {
    cg::grid_group grid = cg::this_grid();
    volatile LAS unsigned* st = (volatile LAS unsigned*)(smem + 131072);
    if (threadIdx.x == 0) { st[0] = 0; st[1] = 0; st[2] = 0; st[3] = 0; }
    wtab_init();
    __syncthreads();
    XcdBarrier b = xcd_barrier_post(p.bar, st);
    if (p.bar == nullptr) grid.sync();
#ifndef REP_MASK
#define REP_MASK 0
#endif
#define MK_ST(k) run_stage(p, k); if ((REP_MASK >> (k)) & 1) { xcd_barrier(b); run_stage(p, k); } if ((k) != 17) xcd_barrier(b);
    MK_ST(0) MK_ST(1) MK_ST(2) MK_ST(3) run_stage(p, 4); MK_ST(18) MK_ST(5) MK_ST(6) MK_ST(7) MK_ST(8) MK_ST(9) MK_ST(10) MK_ST(11) MK_ST(12) MK_ST(13) MK_ST(14) MK_ST(15) MK_ST(16) MK_ST(17)
}

extern "C" void kernel_launch(void* const* d_in, const int* in_sizes, int n_in, void* d_out, int out_size, void* d_ws, size_t ws_size, hipStream_t stream) {
    constexpr size_t kDynLds = 131072 + 512;
    static int grid_blocks = 0;
    if (!grid_blocks) {
        int dev = 0, cus = 0, per_cu = 0;
        (void)hipGetDevice(&dev);
        (void)hipDeviceGetAttribute(&cus, hipDeviceAttributeMultiprocessorCount, dev);
        (void)hipFuncSetAttribute((const void*)fwd_mega, hipFuncAttributeMaxDynamicSharedMemorySize, (int)kDynLds);
        (void)hipOccupancyMaxActiveBlocksPerMultiprocessor(&per_cu, fwd_mega, NTHR, kDynLds);
        if (per_cu > 1) per_cu = 1;
        if (per_cu < 1) per_cu = 1;
        grid_blocks = cus * per_cu;
    }
    Params p{};
    const float* const* in = (const float* const*)d_in;
    p.x_prompt = in[0]; p.x_sample = in[1]; p.cache_ckv = in[2]; p.cache_krope = in[3]; p.state_lru = in[4]; p.c = in[5]; p.c_ctx = in[6];
    p.w_mod[0] = in[7]; p.b_mod[0] = in[8]; p.w_mod[1] = in[9]; p.b_mod[1] = in[10];
    p.g_mix[0] = in[11]; p.g_ffn[0] = in[12]; p.g_mix[1] = in[13]; p.g_ffn[1] = in[14];
    p.w_in = in[15]; p.g_q = in[16]; p.w_uq = in[17]; p.g_kv = in[18]; p.w_ukv = in[19]; p.conv_w = in[20]; p.conv_b = in[21];
    p.w_rg = in[22]; p.b_rg = in[23]; p.w_ig = in[24]; p.b_ig = in[25]; p.lam = in[26]; p.w_o = in[27]; p.w_pool = in[28]; p.s_pool = in[29];
    p.peer_wq[0] = in[30]; p.peer_keys[0] = in[31]; p.peer_u[0] = in[32]; p.peer_v[0] = in[33];
    p.peer_wq[1] = in[34]; p.peer_keys[1] = in[35]; p.peer_u[1] = in[36]; p.peer_v[1] = in[37];
    p.g_final = in[38];
    p.out = (float*)d_out;
    char* base = (char*)d_ws; size_t off = 0;
    auto take = [&](size_t bytes) { char* r = base + off; off += (bytes + 255) & ~(size_t)255; return r; };
    const size_t MiB = 1u << 20;
    p.bar = (unsigned*)take(16384);
    p.mod = (float*)take((size_t)2 * 9 * 6144 * 4);
    p.ropetab = (float*)take(3072 * 4); p.spl = (float*)take(1024 * 4);
    p.wt_in = (bf16_t*)take((size_t)NW_IN * 2); p.wt_uq = (bf16_t*)take((size_t)NW_UQ * 2); p.wt_ukv = (bf16_t*)take((size_t)NW_UKV * 2);
    p.wt_gate = (bf16_t*)take((size_t)NW_GATE * 2); p.wt_o = (bf16_t*)take((size_t)NW_O * 2); p.wt_pool = (bf16_t*)take((size_t)NW_POOL * 2);
    p.wt_pq[0] = (bf16_t*)take((size_t)NW_PQ * 2); p.wt_pq[1] = (bf16_t*)take((size_t)NW_PQ * 2);
    p.keysb[0] = (bf16_t*)take((size_t)NW_KEYS * 2); p.keysb[1] = (bf16_t*)take((size_t)NW_KEYS * 2);
    for (int l = 0; l < 2; ++l) { p.u8[l] = (u8_t*)take(16 * MiB); p.v8[l] = (u8_t*)take(16 * MiB); p.su[l] = (float*)take(65536); p.sv[l] = (float*)take(65536); }
    char* regX = take(80 * MiB);
    char* regQ = take(80 * MiB);
    char* regH = take(40 * MiB);
    p.P = (bf16_t*)regX; p.a = (float*)regX; p.a1m = (bf16_t*)regX; p.xres = (float*)regX;
    p.bxb = (bf16_t*)regQ; p.q = (bf16_t*)(regQ + 40 * MiB); p.agg = (float*)(regQ + 70 * MiB); p.qp = (bf16_t*)regQ; p.h3 = (bf16_t*)regQ;
    p.hbuf = (bf16_t*)regH;
    p.cqn = (bf16_t*)take((size_t)T_TOK * 384 * 2); p.ckvk = (bf16_t*)take((size_t)R_KEYS * 256 * 2); p.kropek = (bf16_t*)take((size_t)R_KEYS * 64 * 2);
    p.xc = (bf16_t*)take((size_t)T_TOK * 512 * 2); p.ug = (bf16_t*)take((size_t)T_TOK * 512 * 2);
    p.mix = p.xc;
    p.Kn = (bf16_t*)take((size_t)R_KEYS * 512 * 2); p.vT = (bf16_t*)take((size_t)R_KEYS * 512 * 2);
    p.zbuf = (float*)p.vT; p.wbuf = p.zbuf + (size_t)T_TOK * 128;
    p.hqh = (unsigned*)p.cqn; p.hql = (unsigned*)p.ckvk; p.hsc = (float*)p.kropek;
    p.gates = (float*)p.Kn; p.eidx = (int*)((char*)p.Kn + (size_t)T_TOK * 128 * 4);
    if (off > ws_size) fprintf(stderr, "workspace too small: need %zu have %zu\n", off, ws_size);
    (void)hipMemsetAsync(d_ws, 0, 16384, stream);
    void* args[] = {&p};
    hipError_t e = hipLaunchCooperativeKernel((void*)fwd_mega, dim3(grid_blocks), dim3(NTHR), args, kDynLds, stream);
    if (e != hipSuccess) fprintf(stderr, "cooperative launch failed: %s (grid %d)\n", hipGetErrorString(e), grid_blocks);
}
```

```cpp
#include <hip/hip_runtime.h>
#include <hip/hip_cooperative_groups.h>
#include <cstdio>
#include <cstdint>
namespace cg = cooperative_groups;


typedef unsigned short bf16_t;
typedef unsigned char u8_t;
typedef float f32x16 __attribute__((ext_vector_type(16)));
typedef float f32x2 __attribute__((ext_vector_type(2)));
typedef unsigned u32x4 __attribute__((ext_vector_type(4)));
typedef float f32x4v __attribute__((ext_vector_type(4)));

#define T_TOK 20480
#define T_CTX 4096
#define R_KEYS 22528
#define NSTAGE 19
#define NTHR 512
#define NWV 8
#define LAS __attribute__((address_space(3)))

#define XB_TMO      128
#define XB_XCNT(j)  (256  + 64 * (j))
#define XB_XSUB(j)  (1280 + 64 * (j))
#define XB_XGEN(j)  (2304 + 64 * (j))
#define XB_TOP      3328
#define XB_TOPGEN   3392
#define XCD_BAR_WORDS 3456
#define XB_SPIN_CAP (1u << 22)
__device__ __forceinline__ unsigned xb_ld(unsigned* p)              { return __hip_atomic_load(p, __ATOMIC_RELAXED, __HIP_MEMORY_SCOPE_AGENT); }
__device__ __forceinline__ unsigned xb_add(unsigned* p, unsigned v) { return __hip_atomic_fetch_add(p, v, __ATOMIC_RELAXED, __HIP_MEMORY_SCOPE_AGENT); }
__device__ __forceinline__ unsigned xb_xcc_id() { return (unsigned)__builtin_amdgcn_s_getreg((3 << 11) | 20) & 0xFu; }
#define XB_SPIN(cond, bar) do { unsigned _sp = 0; while (cond) { __builtin_amdgcn_s_sleep(1); \
    if ((++_sp & 255u) == 0u) { if (xb_ld(&(bar)[XB_TMO])) break; if (_sp > XB_SPIN_CAP) { atomicAdd(&(bar)[XB_TMO], 1u); break; } } } } while (0)
struct XcdBarrier { unsigned* bar; unsigned x; volatile LAS unsigned* st; };
__device__ __forceinline__ XcdBarrier xcd_barrier_post(unsigned* bar, volatile LAS unsigned* st) {
    XcdBarrier b; b.bar = bar; b.x = xb_xcc_id(); b.st = st;
    if (threadIdx.x == 0) (void)xb_add(&bar[XB_XCNT(b.x)], 1u);
    return b;
}
__device__ __forceinline__ void xcd_barrier_complete(unsigned* bar, unsigned x, unsigned& nloc, unsigned& nx) {
    const unsigned G = gridDim.x * gridDim.y * gridDim.z;
    unsigned sum, cnt, mine, sp = 0u;
    for (;;) {
        sum = 0u; cnt = 0u; mine = 0u;
#pragma unroll
        for (unsigned j = 0; j < 16; ++j) { const unsigned c = xb_ld(&bar[XB_XCNT(j)]); sum += c; cnt += (c > 0u) ? 1u : 0u; mine = (j == x) ? c : mine; }
        if (sum == G) break;
        __builtin_amdgcn_s_sleep(1);
        if ((++sp & 255u) == 0u) { if (xb_ld(&bar[XB_TMO])) break; if (sp > XB_SPIN_CAP) { atomicAdd(&bar[XB_TMO], 1u); break; } }
    }
    nloc = mine > 0u ? mine : 1u; nx = cnt > 0u ? cnt : 1u;
}
__device__ __forceinline__ int tidx();
__device__ __forceinline__ void xcd_barrier(const XcdBarrier& b) {
    asm volatile("s_waitcnt vmcnt(0)" ::: "memory");
    __syncthreads();
    if (tidx() == 0) {
        unsigned* bar = b.bar;
        __builtin_amdgcn_s_waitcnt(0);
        unsigned nloc = b.st[0], nx = b.st[1];
        if (nloc == 0u) { xcd_barrier_complete(bar, b.x, nloc, nx); b.st[0] = nloc; b.st[1] = nx; }
        const unsigned old = xb_add(&bar[XB_XSUB(b.x)], 1u);
        const unsigned gen = old / nloc;
        if (old + 1u == (gen + 1u) * nloc) {
            __builtin_amdgcn_fence(__ATOMIC_RELEASE, "agent");
            asm volatile("s_waitcnt vmcnt(0)" ::: "memory");
            const unsigned og = xb_add(&bar[XB_TOP], 1u);
            const unsigned tg = og / nx;
            if (og + 1u == (tg + 1u) * nx) xb_add(&bar[XB_TOPGEN], 1u);
            else XB_SPIN(xb_ld(&bar[XB_TOPGEN]) == tg, bar);
            __builtin_amdgcn_fence(__ATOMIC_ACQUIRE, "agent");
            xb_add(&bar[XB_XGEN(b.x)], 1u);
            asm volatile("s_waitcnt vmcnt(0)" ::: "memory");
        } else {
            XB_SPIN(xb_ld(&bar[XB_XGEN(b.x)]) == gen, bar);
            __builtin_amdgcn_fence(__ATOMIC_ACQUIRE, "agent");
            asm volatile("s_waitcnt vmcnt(0)" ::: "memory");
        }
    }
    __syncthreads();
}

struct Params {
    const float *x_prompt, *x_sample, *cache_ckv, *cache_krope, *state_lru, *c, *c_ctx;
    const float *w_mod[2], *b_mod[2], *g_mix[2], *g_ffn[2];
    const float *w_in, *g_q, *w_uq, *g_kv, *w_ukv, *conv_w, *conv_b, *w_rg, *b_rg, *w_ig, *b_ig, *lam, *w_o, *w_pool, *s_pool;
    const float *peer_wq[2], *peer_keys[2], *peer_u[2], *peer_v[2];
    const float* g_final;
    float* out;
    unsigned* bar; float* mod; float* ropetab;
    bf16_t *wt_in, *wt_uq, *wt_ukv, *wt_gate, *wt_o, *wt_pool, *wt_pq[2], *keysb[2];
    u8_t *u8[2], *v8[2]; float *su[2], *sv[2];
    bf16_t *hbuf, *P, *cqn, *ckvk, *kropek, *xc, *ug, *q, *Kn, *vT, *bxb, *qp, *h3;
    float *a, *agg, *xres, *gates; int* eidx;
    bf16_t* mix; float *zbuf, *wbuf; unsigned *hqh, *hql; float* hsc; float* spl; bf16_t* a1m;
};

extern __shared__ __attribute__((aligned(16))) unsigned char smem[];
#define WTAB_OFF (131072 + 64)
__device__ __forceinline__ int hw_wave_slot() { return (int)(__builtin_amdgcn_s_getreg(0x2804) & 63u); }
__device__ __forceinline__ void wtab_init() { if ((threadIdx.x & 63) == 0) ((volatile int*)(smem + WTAB_OFF))[hw_wave_slot()] = (int)(threadIdx.x >> 6); }
__device__ __forceinline__ int tidx() {
    const int w = __builtin_amdgcn_readfirstlane(((volatile int*)(smem + WTAB_OFF))[hw_wave_slot()]);
    return (w << 6) | (int)__builtin_amdgcn_mbcnt_hi(~0u, __builtin_amdgcn_mbcnt_lo(~0u, 0u));
}
__device__ __forceinline__ float bf2f(bf16_t v) { return __uint_as_float(((unsigned)v) << 16); }
typedef __bf16 bf16x2_t __attribute__((ext_vector_type(2)));
__device__ __forceinline__ bf16_t f2bf(float f) { return __builtin_bit_cast(unsigned short, (__bf16)f); }
__device__ __forceinline__ unsigned pack_bf16(float a, float b) { bf16x2_t v = {(__bf16)a, (__bf16)b}; return __builtin_bit_cast(unsigned, v); }
typedef unsigned u32x2 __attribute__((ext_vector_type(2)));
#define DPP_F(v, ctrl) __int_as_float(__builtin_amdgcn_update_dpp(0, __float_as_int(v), ctrl, 0xf, 0xf, true))
__device__ __forceinline__ float wave_sum(float v) {
    v += DPP_F(v, 0xB1); v += DPP_F(v, 0x4E); v += DPP_F(v, 0x141); v += DPP_F(v, 0x128);
    u32x2 r = __builtin_amdgcn_permlane16_swap(__float_as_uint(v), __float_as_uint(v), false, false);
    v = __uint_as_float(r[0]) + __uint_as_float(r[1]);
    r = __builtin_amdgcn_permlane32_swap(__float_as_uint(v), __float_as_uint(v), false, false);
    return __uint_as_float(r[0]) + __uint_as_float(r[1]);
}
__device__ __forceinline__ float wave_max(float v) {
    v = fmaxf(v, DPP_F(v, 0xB1)); v = fmaxf(v, DPP_F(v, 0x4E)); v = fmaxf(v, DPP_F(v, 0x141)); v = fmaxf(v, DPP_F(v, 0x128));
    u32x2 r = __builtin_amdgcn_permlane16_swap(__float_as_uint(v), __float_as_uint(v), false, false);
    v = fmaxf(__uint_as_float(r[0]), __uint_as_float(r[1]));
    r = __builtin_amdgcn_permlane32_swap(__float_as_uint(v), __float_as_uint(v), false, false);
    return fmaxf(__uint_as_float(r[0]), __uint_as_float(r[1]));
}
__device__ __forceinline__ float gelu_tanh(float x) {
    const float u = 0.7978845608028654f * (x + 0.044715f * x * x * x);
    const float e = __expf(2.f * u);
    const float th = 1.f - 2.f / (e + 1.f);
    return 0.5f * x * (1.f + th);
}
__device__ __forceinline__ float sigmoidf_(float x) { return 1.f / (1.f + __expf(-x)); }
__device__ __forceinline__ float silu_(float x) { return x / (1.f + __expf(-x)); }

struct TokInfo { int smp, b, s, S, mi, keyrow; };
__device__ __forceinline__ TokInfo tokinfo(int T) {
    TokInfo t;
    if (T < T_CTX) { t.smp = 0; t.b = T >> 8; t.s = T & 255; t.S = 256; t.mi = 0; t.keyrow = T; }
    else { const int u = T - T_CTX; t.smp = 1; t.b = u >> 11; t.s = u & 2047; t.S = 2048; t.mi = 1 + t.b; t.keyrow = T_CTX + t.b * 2304 + 256 + t.s; }
    return t;
}
__device__ __forceinline__ const float* x_in_row(const Params& p, int T) { return T < T_CTX ? p.x_prompt + (size_t)T * 1024 : p.x_sample + (size_t)(T - T_CTX) * 1024; }
__device__ __forceinline__ const float* modv(const Params& p, int l, int mi, int j) { return p.mod + ((size_t)(l * 9 + mi) * 6 + j) * 1024; }

__device__ __forceinline__ void unpack8(const uint4 r, float (&f)[8]) {
    f[0] = __uint_as_float(r.x << 16); f[1] = __uint_as_float(r.x & 0xffff0000u);
    f[2] = __uint_as_float(r.y << 16); f[3] = __uint_as_float(r.y & 0xffff0000u);
    f[4] = __uint_as_float(r.z << 16); f[5] = __uint_as_float(r.z & 0xffff0000u);
    f[6] = __uint_as_float(r.w << 16); f[7] = __uint_as_float(r.w & 0xffff0000u);
}

namespace pg8 {
typedef short bf16x8 __attribute__((ext_vector_type(8)));
typedef float f32x4 __attribute__((ext_vector_type(4)));
constexpr int BM = 256, BK = 64, HALF = 128, HTB = HALF * BK * 2  , STAGE_BYTES = 8 * HTB;
__device__ __forceinline__ int lds_byte(int r, int c) { const int st = (r >> 4) * 2 + (c >> 5), rr = r & 15, cc = c & 31, ob = rr * 64 + cc * 2; return st * 1024 + (ob ^ (((ob >> 9) & 1) << 5)); }
__device__ __forceinline__ void stage_rc(int b, int& R, int& C) { const int st = b / 1024, sb = b % 1024, swz = sb ^ (((sb >> 9) & 1) << 5); R = (st >> 1) * 16 + swz / 64; C = (st & 1) * 32 + (swz % 64) / 2; }
__device__ __forceinline__ int perm32(int rho) { const int n = rho >> 4, i = rho & 15; return 8 * (i >> 2) + 4 * n + (i & 3); }
struct Unit { int pm, pn; const char* A; const char* B; };
template <class Epi, class Sched, bool ALIGN_EPI, bool SP2>
__device__ __forceinline__ void gemm_phase(LAS unsigned char* lds, const int lda, const int ldb, const int K, const Sched& S, const Epi& E) {
    __builtin_amdgcn_sched_barrier(0);
    const int tid = tidx(), wid = __builtin_amdgcn_readfirstlane(tid >> 6), lane = tid & 63, wr = wid >> 2, wc = wid & 3, fr = lane & 15, fq = lane >> 4;
    const int nt = K / BK;
    unsigned voffA[2], voffB[2];
#pragma unroll
    for (int i = 0; i < 2; ++i) { int R, C; stage_rc(tid * 16 + i * 8192, R, C); const int Rb = Epi::PERM ? ((R & ~31) + perm32(R & 31)) : R;
        voffA[i] = (unsigned)(R * lda + C) * 2u; voffB[i] = (unsigned)(Rb * ldb + C) * 2u; }
    const size_t kstep = (size_t)(BK * 2);
    const size_t hstepA = (size_t)HALF * lda * 2, hstepB = (size_t)HALF * ldb * 2;
    const unsigned ldsw = (unsigned)wid * 1024u;
    const int aoff = lds_byte(wr * 64 + fr, fq * 8), boff = lds_byte(wc * 32 + fr, fq * 8);
#define PG8_SA(b, h) (((b) * 2 + (h)) * HTB)
#define PG8_SB(b, h) ((4 + (b) * 2 + (h)) * HTB)
#define PG8_STAGE(bufoff, gbase, voff) do { _Pragma("unroll") for (int _i = 0; _i < 2; ++_i) \
        __builtin_amdgcn_global_load_lds((const unsigned*)((const char*)(gbase) + (voff)[_i]), (LAS unsigned*)(lds + (bufoff) + ldsw + _i * 8192), 16, 0, 0); } while (0)
#define PG8_LDA(dst, b, h) do { _Pragma("unroll") for (int m = 0; m < 4; ++m) _Pragma("unroll") for (int k = 0; k < 2; ++k) dst[m][k] = *(const LAS bf16x8*)(lds + PG8_SA(b, h) + aoff + m * 2048 + k * 1024); } while (0)
#define PG8_LDB(dst, b, h) do { _Pragma("unroll") for (int n = 0; n < 2; ++n) _Pragma("unroll") for (int k = 0; k < 2; ++k) dst[n][k] = *(const LAS bf16x8*)(lds + PG8_SB(b, h) + boff + n * 2048 + k * 1024); } while (0)
#define PG8_MMA(ai, bj, At, Bt) do { __builtin_amdgcn_s_setprio(1); _Pragma("unroll") for (int m = 0; m < 4; ++m) _Pragma("unroll") for (int n = 0; n < 2; ++n) _Pragma("unroll") for (int k = 0; k < 2; ++k) \
        acc[ai][bj][m][n] = __builtin_amdgcn_mfma_f32_16x16x32_bf16(Bt[n][k], At[m][k], acc[ai][bj][m][n], 0, 0, 0); __builtin_amdgcn_s_setprio(0); } while (0)
#define PG8_WAIT_V(n) asm volatile("s_waitcnt vmcnt(" #n ")" ::: "memory")
#define PG8_WAIT_L(n) asm volatile("s_waitcnt lgkmcnt(" #n ")" ::: "memory")
#define PG8_BAR __builtin_amdgcn_s_barrier()
#define PG8_SCHED __builtin_amdgcn_sched_barrier(0)
    Unit cur, nxt; int ui = 0;
    if (!S.next(0, cur)) return;
    f32x4 acc[2][2][4][2];
#pragma unroll
    for (int a = 0; a < 2; ++a)
#pragma unroll
        for (int b = 0; b < 2; ++b)
#pragma unroll
            for (int m = 0; m < 4; ++m)
#pragma unroll
                for (int n = 0; n < 2; ++n) acc[a][b][m][n] = (f32x4){0.f, 0.f, 0.f, 0.f};
    bf16x8 At[4][2], B0[2][2], B1[2][2];
    const char* cA = cur.A; const char* cB = cur.B;
    if constexpr (SP2) {
        PG8_STAGE(PG8_SB(0, 0), cB, voffB); PG8_STAGE(PG8_SB(0, 1), cB + hstepB, voffB); PG8_STAGE(PG8_SA(0, 0), cA, voffA); PG8_STAGE(PG8_SA(0, 1), cA + hstepA, voffA);
        if (wr == 1) PG8_BAR;
        PG8_WAIT_V(2); PG8_BAR;
        PG8_STAGE(PG8_SB(1, 0), cB + kstep, voffB); PG8_STAGE(PG8_SA(1, 0), cA + kstep, voffA); PG8_STAGE(PG8_SB(1, 1), cB + hstepB + kstep, voffB);
        PG8_WAIT_V(6); PG8_BAR;
    } else {
        PG8_STAGE(PG8_SB(0, 0), cB, voffB); PG8_STAGE(PG8_SA(0, 0), cA, voffA); PG8_STAGE(PG8_SB(0, 1), cB + hstepB, voffB); PG8_STAGE(PG8_SA(0, 1), cA + hstepA, voffA);
        if (wr == 1) PG8_BAR;
        PG8_WAIT_V(4); PG8_BAR;
        PG8_STAGE(PG8_SB(1, 0), cB + kstep, voffB); PG8_STAGE(PG8_SA(1, 0), cA + kstep, voffA); PG8_STAGE(PG8_SB(1, 1), cB + hstepB + kstep, voffB);
        PG8_WAIT_V(6); PG8_BAR;
    }
    for (;;) {
        const bool has_next = S.next(ui + 1, nxt);
        const char* nA = has_next ? nxt.A : cA; const char* nB = has_next ? nxt.B : cB;
#pragma unroll 1
        for (int t = 0; t < nt; t += 2) {
            const bool last = (t == nt - 2);
            const char* a1 = cA + (size_t)(t + 1) * kstep;
            const char* a2 = last ? nA : cA + (size_t)(t + 2) * kstep; const char* b2 = last ? nB : cB + (size_t)(t + 2) * kstep;
            const char* a3 = a2 + kstep; const char* b3 = b2 + kstep;
            if constexpr (SP2) {
            PG8_LDB(B0, 0, 0); PG8_LDB(B1, 0, 1); PG8_SCHED; PG8_LDA(At, 0, 0); PG8_STAGE(PG8_SA(1, 1), a1 + hstepA, voffA);
            PG8_WAIT_V(8); PG8_WAIT_L(0); PG8_BAR; PG8_MMA(0, 0, At, B0); PG8_MMA(0, 1, At, B1); PG8_BAR; PG8_SCHED;
            PG8_LDA(At, 0, 1); PG8_STAGE(PG8_SB(0, 0), b2, voffB); PG8_STAGE(PG8_SB(0, 1), b2 + hstepB, voffB); PG8_STAGE(PG8_SA(0, 0), a2, voffA);
            PG8_WAIT_V(8); PG8_WAIT_L(0); PG8_BAR; PG8_MMA(1, 0, At, B0); PG8_MMA(1, 1, At, B1); PG8_BAR; PG8_SCHED;
            PG8_LDB(B0, 1, 0); PG8_LDB(B1, 1, 1); PG8_SCHED; PG8_LDA(At, 1, 0); PG8_STAGE(PG8_SA(0, 1), a2 + hstepA, voffA);
            PG8_WAIT_V(8); PG8_WAIT_L(0); PG8_BAR; PG8_MMA(0, 0, At, B0); PG8_MMA(0, 1, At, B1); PG8_BAR; PG8_SCHED;
            PG8_LDA(At, 1, 1); PG8_STAGE(PG8_SB(1, 0), b3, voffB); PG8_STAGE(PG8_SB(1, 1), b3 + hstepB, voffB); PG8_STAGE(PG8_SA(1, 0), a3, voffA);
            PG8_WAIT_V(8); PG8_WAIT_L(0); PG8_BAR; PG8_MMA(1, 0, At, B0); PG8_MMA(1, 1, At, B1); PG8_BAR; PG8_SCHED;
            } else {
            PG8_LDB(B0, 0, 0); PG8_SCHED; PG8_LDA(At, 0, 0); PG8_STAGE(PG8_SA(1, 1), a1 + hstepA, voffA);
            PG8_WAIT_L(8); PG8_BAR; PG8_WAIT_L(0); PG8_MMA(0, 0, At, B0); PG8_BAR; PG8_SCHED;
            PG8_LDB(B1, 0, 1); PG8_STAGE(PG8_SB(0, 0), b2, voffB);
            PG8_BAR; PG8_WAIT_L(0); PG8_MMA(0, 1, At, B1); PG8_BAR;
            PG8_LDA(At, 0, 1); PG8_STAGE(PG8_SA(0, 0), a2, voffA);
            PG8_BAR; PG8_WAIT_L(0); PG8_MMA(1, 0, At, B0); PG8_BAR; PG8_SCHED;
            PG8_STAGE(PG8_SB(0, 1), b2 + hstepB, voffB);
            PG8_WAIT_V(6); PG8_BAR; PG8_MMA(1, 1, At, B1); PG8_BAR;
            PG8_LDB(B0, 1, 0); PG8_SCHED; PG8_LDA(At, 1, 0); PG8_STAGE(PG8_SA(0, 1), a2 + hstepA, voffA);
            PG8_WAIT_L(8); PG8_BAR; PG8_WAIT_L(0); PG8_MMA(0, 0, At, B0); PG8_BAR; PG8_SCHED;
            PG8_LDB(B1, 1, 1); PG8_STAGE(PG8_SB(1, 0), b3, voffB);
            PG8_BAR; PG8_WAIT_L(0); PG8_MMA(0, 1, At, B1); PG8_BAR;
            PG8_LDA(At, 1, 1); PG8_STAGE(PG8_SA(1, 0), a3, voffA);
            PG8_BAR; PG8_WAIT_L(0); PG8_MMA(1, 0, At, B0); PG8_BAR; PG8_SCHED;
            PG8_STAGE(PG8_SB(1, 1), b3 + hstepB, voffB);
            PG8_WAIT_V(6); PG8_BAR; PG8_MMA(1, 1, At, B1); PG8_BAR;
            }
        }
        if constexpr (ALIGN_EPI) { if (wr == 0) PG8_BAR; }
        E(acc, cur, wr, wc, fr, fq);
        if (!has_next) break;
#pragma unroll
        for (int a = 0; a < 2; ++a)
#pragma unroll
            for (int b = 0; b < 2; ++b)
#pragma unroll
                for (int m = 0; m < 4; ++m)
#pragma unroll
                    for (int n = 0; n < 2; ++n) acc[a][b][m][n] = (f32x4){0.f, 0.f, 0.f, 0.f};
        cur = nxt; cA = nA; cB = nB; ++ui;
        if constexpr (ALIGN_EPI) { if (wr == 1) PG8_BAR; }
    }
    PG8_WAIT_V(0);
    if constexpr (!ALIGN_EPI) { if (wr == 0) PG8_BAR; }
    PG8_BAR;
    __builtin_amdgcn_sched_barrier(0);
#undef PG8_SA
#undef PG8_SB
#undef PG8_STAGE
#undef PG8_LDA
#undef PG8_LDB
#undef PG8_MMA
#undef PG8_WAIT_V
#undef PG8_WAIT_L
#undef PG8_BAR
#undef PG8_SCHED
}
struct TileOrder {
    int nN, total; const char* A; const char* B; size_t tA, tB;
    __device__ __forceinline__ bool next(int i, Unit& u) const {
        const int item = blockIdx.x + i * gridDim.x; if (item >= total) return false;
        const int lt = item >> 3; u.pn = lt % nN; u.pm = (lt / nN) * 8 + (item & 7);
        u.A = A + (size_t)u.pm * tA; u.B = B + (size_t)u.pn * tB; return true;
    }
};
}

typedef __bf16 bf16x8_t __attribute__((ext_vector_type(8)));
__device__ __forceinline__ int lds_off(int row, int chunk) { return row * 128 + ((chunk ^ ((row >> 1) & 7)) << 4); }
template <int TM, int TN, int WM, int WN>
__device__ __forceinline__ void gemm_acc(const bf16_t* __restrict__ As, int lda, const bf16_t* __restrict__ Bs, int ldb, int K, f32x16 (&acc)[TM][TN]) {
    static_assert(TM * WM == 4 && TN * WN == 4 && WM * WN == 4, "tile is 128 x 128, 4 waves");
    const int tid = tidx() & 255, lane = tid & 63, wid = tid >> 6, wm = wid / WN, wn = wid % WN, hl = lane >> 5, cl = lane & 31;
    unsigned char* sm = smem + (tidx() >> 8) * 65536;
#pragma unroll
    for (int i = 0; i < TM; ++i)
#pragma unroll
        for (int j = 0; j < TN; ++j)
#pragma unroll
            for (int r = 0; r < 16; ++r) acc[i][j][r] = 0.f;
    const int srow0 = wid * 32 + (lane >> 3), pc = lane & 7;
    const bf16_t* ga[4]; const bf16_t* gb[4];
#pragma unroll
    for (int i = 0; i < 4; ++i) {
        const int row = srow0 + 8 * i, lc = pc ^ ((row >> 1) & 7);
        ga[i] = As + (size_t)row * lda + lc * 8; gb[i] = Bs + (size_t)row * ldb + lc * 8;
    }
    unsigned char* lbase = sm + wid * 4096 + lane * 16;
    __syncthreads();
#pragma unroll
    for (int i = 0; i < 4; ++i) {
        __builtin_amdgcn_global_load_lds((const unsigned*)ga[i], (unsigned*)(lbase + i * 1024), 16, 0, 0);
        __builtin_amdgcn_global_load_lds((const unsigned*)gb[i], (unsigned*)(lbase + 16384 + i * 1024), 16, 0, 0);
    }
    asm volatile("s_waitcnt vmcnt(0)" ::: "memory");
    __syncthreads();
    const int nk = K >> 6;
    for (int kt = 0; kt < nk; ++kt) {
        const int cur = (kt & 1) * 32768, nxt = 32768 - cur;
        if (kt + 1 < nk) {
#pragma unroll
            for (int i = 0; i < 4; ++i) {
                __builtin_amdgcn_global_load_lds((const unsigned*)(ga[i] + (kt + 1) * 64), (unsigned*)(lbase + nxt + i * 1024), 16, 0, 0);
                __builtin_amdgcn_global_load_lds((const unsigned*)(gb[i] + (kt + 1) * 64), (unsigned*)(lbase + nxt + 16384 + i * 1024), 16, 0, 0);
            }
        }
#pragma unroll
        for (int ks = 0; ks < 4; ++ks) {
            bf16x8_t af[TM], bfr[TN];
#pragma unroll
            for (int i = 0; i < TM; ++i) af[i] = __builtin_bit_cast(bf16x8_t, *(const u32x4*)(sm + cur + lds_off(32 * (TM * wm + i) + cl, 2 * ks + hl)));
#pragma unroll
            for (int j = 0; j < TN; ++j) bfr[j] = __builtin_bit_cast(bf16x8_t, *(const u32x4*)(sm + cur + 16384 + lds_off(32 * (TN * wn + j) + cl, 2 * ks + hl)));
#pragma unroll
            for (int i = 0; i < TM; ++i)
#pragma unroll
                for (int j = 0; j < TN; ++j) acc[i][j] = __builtin_amdgcn_mfma_f32_32x32x16_bf16(af[i], bfr[j], acc[i][j], 0, 0, 0);
        }
        asm volatile("s_waitcnt vmcnt(0)" ::: "memory");
        __syncthreads();
    }
}
#define ACC_ROW(TMv, wm, i, r, hl) (32 * ((TMv) * (wm) + (i)) + ((r) & 3) + 8 * ((r) >> 2) + 4 * (hl))
#define ACC_COL(TNv, wn, j, cl)    (32 * ((TNv) * (wn) + (j)) + (cl))

#define N_ADA 384
#define NW_IN   (1792 * 1024)
#define NW_UQ   (768 * 384)
#define NW_UKV  (1024 * 256)
#define NW_GATE (4 * 512 * 128)
#define NW_O    (1024 * 1024)
#define NW_POOL (4 * 256 * 256)
#define NW_PQ   (2048 * 1024)
#define NW_KEYS (16 * 128 * 128)
#define NW_CKV  (8 * 256 * 256)
#define NW_CKR  (8 * 256 * 64)
#define NW_ROPE 3072
#define NW_SP 1024
#define NT_IN 448
#define NT_UQ 72
#define NT_UKV 64
#define NT_O 256
#define NT_POOL 64
#define NT_PQ 512
#define N_TR (NT_IN + NT_UQ + NT_UKV + NT_O + NT_POOL + 2 * NT_PQ)
#define NE_TOTAL (NW_GATE + 2 * NW_KEYS + NW_CKV + NW_CKR + NW_ROPE + NW_SP)
#define N_CONV_ITEMS ((NE_TOTAL + 4095) / 4096)
#define N_FP8_ITEMS (65536 / NWV / 4)

__device__ __forceinline__ void conv_elem(const Params& p, int e) {
    if (e < NW_GATE) {
        const int c = e & 127, cg = (e >> 7) & 511, nb = e >> 16;
        const int dir = cg >> 8, dg = (cg >> 6) & 3, ri = (cg >> 5) & 1, d = dg * 32 + (cg & 31);
        const float* src = ri ? p.w_ig : p.w_rg;
        p.wt_gate[e] = f2bf(src[(((size_t)dir * 4 + nb) * 128 + c) * 128 + d]); return; } e -= NW_GATE;
#pragma unroll
    for (int l = 0; l < 2; ++l) { if (e < NW_KEYS) { p.keysb[l][e] = f2bf(p.peer_keys[l][e]); return; } e -= NW_KEYS; }
    if (e < NW_CKV) { const int col = e & 255, j = (e >> 8) & 255, b = e >> 16; p.ckvk[(size_t)(T_CTX + b * 2304 + j) * 256 + col] = f2bf(p.cache_ckv[e]); return; } e -= NW_CKV;
    if (e < NW_CKR) { const int col = e & 63, j = (e >> 6) & 255, b = e >> 14; p.kropek[(size_t)(T_CTX + b * 2304 + j) * 64 + col] = f2bf(p.cache_krope[e]); return; } e -= NW_CKR;
    if (e < NW_ROPE) {
        int idx = e, isrow = e < 1024; if (!isrow) idx -= 1024;
        const int half = isrow ? 512 : 1024; const int sn = idx >= half; if (sn) idx -= half;
        const int pos = idx >> 4, fi = idx & 15;
        const float invf = exp2f(-(float)fi * (13.287712379549449f / 16.f));
        const float ang = (float)pos * invf;
        p.ropetab[e] = sn ? sinf(ang) : cosf(ang); return; } e -= NW_ROPE;
    if (e < NW_SP) { const float nl = -p.lam[e]; p.spl[e] = fmaxf(nl, 0.f) + log1pf(__expf(-fabsf(nl))); return; }
}
__device__ __forceinline__ void tr_tile(const float* __restrict__ src, int ldsrc, int nvalid, bf16_t* __restrict__ dst, int lddst, int k0, int n0, float scl = 1.f) {
    float* tile = (float*)(smem + (tidx() >> 8) * 32768);
    const int tid = tidx() & 255;
    __syncthreads();
#pragma unroll
    for (int i = 0; i < 4; ++i) {
        const int k = (tid >> 4) + 16 * i, n = (tid & 15) * 4;
        float4 v = make_float4(0.f, 0.f, 0.f, 0.f);
        if (n0 + n < nvalid) v = *(const float4*)(src + (size_t)(k0 + k) * ldsrc + n0 + n);
        tile[k * 65 + n] = v.x; tile[k * 65 + n + 1] = v.y; tile[k * 65 + n + 2] = v.z; tile[k * 65 + n + 3] = v.w;
    }
    __syncthreads();
    const int n = tid >> 2, kq = (tid & 3) * 16;
    unsigned w[8];
#pragma unroll
    for (int j = 0; j < 8; ++j) w[j] = pack_bf16(tile[(kq + 2 * j) * 65 + n] * scl, tile[(kq + 2 * j + 1) * 65 + n] * scl);
    uint4* d = (uint4*)(dst + (size_t)(n0 + n) * lddst + k0 + kq);
    d[0] = make_uint4(w[0], w[1], w[2], w[3]); d[1] = make_uint4(w[4], w[5], w[6], w[7]);
}
__device__ __forceinline__ void tr_item(const Params& p, int t) {
    if (t < NT_IN) { tr_tile(p.w_in, 1728, 1728, p.wt_in, 1024, (t % 16) * 64, (t / 16) * 64); return; } t -= NT_IN;
    if (t < NT_UQ) { tr_tile(p.w_uq, 768, 768, p.wt_uq, 384, (t % 6) * 64, (t / 6) * 64, 0.07216878364870322f * 1.4426950408889634f  ); return; } t -= NT_UQ;
    if (t < NT_UKV) {
        const int n0 = (t / 4) * 64, h = n0 >> 8, kv = (n0 >> 7) & 1, nn = kv * 512 + h * 128 + (n0 & 127);
        tr_tile(p.w_ukv, 1024, 1024, p.wt_ukv + ((ptrdiff_t)nn - n0) * 256, 256, (t % 4) * 64, n0); return; } t -= NT_UKV;
    if (t < NT_O) { tr_tile(p.w_o, 1024, 1024, p.wt_o, 1024, (t % 16) * 64, (t / 16) * 64); return; } t -= NT_O;
    if (t < NT_POOL) { const int g = t >> 4, tt = t & 15; tr_tile(p.w_pool + (size_t)g * 65536, 256, 256, p.wt_pool + (size_t)g * 65536, 256, (tt & 3) * 64, (tt >> 2) * 64); return; } t -= NT_POOL;
    if (t < NT_PQ) { tr_tile(p.peer_wq[0], 2048, 2048, p.wt_pq[0], 1024, (t % 16) * 64, (t / 16) * 64); return; } t -= NT_PQ;
    tr_tile(p.peer_wq[1], 2048, 2048, p.wt_pq[1], 1024, (t % 16) * 64, (t / 16) * 64);
}

__device__ void st_prologue(const Params& p) {
    const int tid = tidx(), lane = tid & 63, wid = tid >> 6;
    const int n_items = N_ADA + N_TR / 2 + N_CONV_ITEMS + N_FP8_ITEMS;
    for (int item = blockIdx.x; item < n_items; item += gridDim.x) {
        if (item < N_ADA) {
            float* svec = (float*)smem;
            float* red = (float*)(smem + 9 * 4096);
            __syncthreads();
            for (int i = tid; i < 9 * 1024; i += NTHR) { const int bc = i >> 10, k = i & 1023; const float cv = bc == 0 ? p.c_ctx[k] : p.c[(size_t)(bc - 1) * 1024 + k]; svec[i] = silu_(cv); }
            __syncthreads();
            const int cidx = item * 32 + (lane & 7) * 4, l = cidx / 6144, col = cidx % 6144, k0 = (wid * 8 + (lane >> 3)) * 16;
            const float* w = p.w_mod[l] + (size_t)k0 * 6144 + col;
            float acc[9][4];
#pragma unroll
            for (int b = 0; b < 9; ++b) { acc[b][0] = 0.f; acc[b][1] = 0.f; acc[b][2] = 0.f; acc[b][3] = 0.f; }
#pragma unroll 8
            for (int k = 0; k < 16; ++k) {
                const float4 wv = *(const float4*)(w + (size_t)k * 6144);
#pragma unroll
                for (int b = 0; b < 9; ++b) { const float sv = svec[b * 1024 + k0 + k]; acc[b][0] += wv.x * sv; acc[b][1] += wv.y * sv; acc[b][2] += wv.z * sv; acc[b][3] += wv.w * sv; }
            }
#pragma unroll
            for (int b = 0; b < 9; ++b)
#pragma unroll
                for (int j = 0; j < 4; ++j) { float v = acc[b][j]; v += __shfl_xor(v, 8); v += __shfl_xor(v, 16); v += __shfl_xor(v, 32); acc[b][j] = v; }
            if (lane < 8) {
#pragma unroll
                for (int b = 0; b < 9; ++b)
#pragma unroll
                    for (int j = 0; j < 4; ++j) red[(wid * 9 + b) * 32 + lane * 4 + j] = acc[b][j];
            }
            __syncthreads();
            for (int i = tid; i < 9 * 32; i += NTHR) {
                const int b = i >> 5, c = i & 31;
                const int ci = item * 32 + c, ll = ci / 6144, cc = ci % 6144;
                float v = 0.f;
#pragma unroll
                for (int w8 = 0; w8 < 8; ++w8) v += red[(w8 * 9 + b) * 32 + c];
                p.mod[(size_t)(ll * 9 + b) * 6144 + cc] = v + p.b_mod[ll][cc];
            }
        } else if (item < N_ADA + N_TR / 2) {
            tr_item(p, (item - N_ADA) * 2 + (tid >> 8));
        } else if (item < N_ADA + N_TR / 2 + N_CONV_ITEMS) {
            const int base = (item - N_ADA - N_TR / 2) * 4096;
            for (int i = tid; i < 4096; i += NTHR) { const int e = base + i; if (e < NE_TOTAL) conv_elem(p, e); }
        } else {
            const int row0 = ((item - N_ADA - N_TR / 2 - N_CONV_ITEMS) * NWV + wid) * 4;
            const int tb = row0 >> 14, er0 = row0 & 16383, l = tb >> 1;
            const float* src = ((tb & 1) ? p.peer_v[l] : p.peer_u[l]) + (size_t)er0 * 1024 + lane * 16;
            u8_t* dst = ((tb & 1) ? p.v8[l] : p.u8[l]) + (size_t)er0 * 512 + lane * 8;
            float* sc = ((tb & 1) ? p.sv[l] : p.su[l]) + er0;
            f32x4v f[4][4];
#pragma unroll
            for (int r = 0; r < 4; ++r)
#pragma unroll
                for (int j = 0; j < 4; ++j) f[r][j] = __builtin_nontemporal_load((const f32x4v*)(src + (size_t)r * 1024 + 4 * j));
#pragma unroll
            for (int r = 0; r < 4; ++r) {
                float am = 0.f, sq = 0.f;
#pragma unroll
                for (int j = 0; j < 4; ++j) {
                    am = fmaxf(fmaxf(am, fmaxf(fabsf(f[r][j][0]), fabsf(f[r][j][1]))), fmaxf(fabsf(f[r][j][2]), fabsf(f[r][j][3])));
                    sq += (f[r][j][0] * f[r][j][0] + f[r][j][1] * f[r][j][1]) + (f[r][j][2] * f[r][j][2] + f[r][j][3] * f[r][j][3]);
                }
                unsigned w[2]; float scale;
                if (tb & 1) {
                    am = wave_max(am);
                    scale = am > 0.f ? am * (1.f / 6.f) : 1.f; const float inv = am > 0.f ? 6.f / am : 1.f;
#pragma unroll
                    for (int j = 0; j < 2; ++j) {
                        unsigned pk = 0u;
                        pk = __builtin_amdgcn_cvt_scalef32_pk_fp4_f32(pk, f[r][2 * j][0] * inv, f[r][2 * j][1] * inv, 1.0f, 0);
                        pk = __builtin_amdgcn_cvt_scalef32_pk_fp4_f32(pk, f[r][2 * j][2] * inv, f[r][2 * j][3] * inv, 1.0f, 1);
                        pk = __builtin_amdgcn_cvt_scalef32_pk_fp4_f32(pk, f[r][2 * j + 1][0] * inv, f[r][2 * j + 1][1] * inv, 1.0f, 2);
                        pk = __builtin_amdgcn_cvt_scalef32_pk_fp4_f32(pk, f[r][2 * j + 1][2] * inv, f[r][2 * j + 1][3] * inv, 1.0f, 3);
                        w[j] = pk;
                    }
                } else {
                    sq = wave_sum(sq);
                    const float rms = sqrtf(sq * (1.f / 1024.f));
                    scale = rms > 0.f ? 0.3352f * rms : 1.f; const float inv = 1.f / scale;
#pragma unroll
                    for (int j = 0; j < 2; ++j) {
                        unsigned pk = 0u;
#pragma unroll
                        for (int i = 0; i < 8; ++i) {
                            const float x = f[r][2 * j + (i >> 2)][i & 3] * inv;
                            const int q = (int)fminf(fmaxf(rintf(x), -8.f), 7.f);
                            pk |= ((unsigned)q & 15u) << (4 * i);
                        }
                        w[j] = pk;
                    }
                }
                *(uint2*)(dst + (size_t)r * 512) = make_uint2(w[0], w[1]);
                if (lane == 0) sc[r] = scale;
            }
        }
    }
}

template <int FIRST>
__device__ void st_resnorm(const Params& p, int l) {
    const int lane = tidx() & 63, wid = tidx() >> 6, stride = gridDim.x * NWV;
    for (int T0 = blockIdx.x * NWV + wid; T0 < T_TOK; T0 += 2 * stride) {
        float4 xa[2][4]; uint4 ma[2][2];
#pragma unroll
        for (int u = 0; u < 2; ++u) {
            const int T = min(T0 + u * stride, T_TOK - 1);
            const float* x0 = FIRST ? x_in_row(p, T) + lane * 16 : p.xres + (size_t)T * 1024 + lane * 16;
            const uint4* mp = (const uint4*)(p.mix + (size_t)T * 1024 + lane * 16);
#pragma unroll
            for (int j = 0; j < 4; ++j) xa[u][j] = *(const float4*)(x0 + 4 * j);
            ma[u][0] = mp[0]; ma[u][1] = mp[1];
        }
#pragma unroll
        for (int u = 0; u < 2; ++u) {
            const int T = T0 + u * stride;
            if (T < T_TOK) {
                const TokInfo ti = tokinfo(T);
                float* xr = p.xres + (size_t)T * 1024 + lane * 16;
                const float* gt = modv(p, l, ti.mi, 2) + lane * 16;
                float m[16]; { float t8[8]; unpack8(ma[u][0], t8);
#pragma unroll
                    for (int j = 0; j < 8; ++j) m[j] = t8[j];
                    unpack8(ma[u][1], t8);
#pragma unroll
                    for (int j = 0; j < 8; ++j) m[8 + j] = t8[j]; }
                float v[16]; float ss = 0.f;
#pragma unroll
                for (int j = 0; j < 4; ++j) {
                    const float4 f = xa[u][j]; float4 g = *(const float4*)(gt + 4 * j);
                    if (!FIRST) { const float4 sp = *(const float4*)(p.s_pool + lane * 16 + 4 * j); g.x *= sp.x; g.y *= sp.y; g.z *= sp.z; g.w *= sp.w; }
                    v[4 * j] = f.x + g.x * m[4 * j]; v[4 * j + 1] = f.y + g.y * m[4 * j + 1]; v[4 * j + 2] = f.z + g.z * m[4 * j + 2]; v[4 * j + 3] = f.w + g.w * m[4 * j + 3];
                    *(float4*)(xr + 4 * j) = make_float4(v[4 * j], v[4 * j + 1], v[4 * j + 2], v[4 * j + 3]);
                }
#pragma unroll
                for (int j = 0; j < 16; ++j) ss += v[j] * v[j];
                ss = wave_sum(ss);
                const float rstd = rsqrtf(ss * (1.f / 1024.f) + 1e-6f);
                const float* sh = modv(p, l, ti.mi, 3) + lane * 16; const float* sc = modv(p, l, ti.mi, 4) + lane * 16; const float* gg = p.g_ffn[l] + lane * 16;
                float hval[16]; float hm = 0.f;
#pragma unroll
                for (int j = 0; j < 16; ++j) { hval[j] = v[j] * rstd * gg[j] * (1.f + sc[j]) + sh[j]; hm = fmaxf(hm, fabsf(hval[j])); }
                unsigned w[8];
#pragma unroll
                for (int j = 0; j < 8; ++j) w[j] = pack_bf16(hval[2 * j], hval[2 * j + 1]);
                uint4* d = (uint4*)(p.hbuf + (size_t)T * 1024 + lane * 16);
                d[0] = make_uint4(w[0], w[1], w[2], w[3]); d[1] = make_uint4(w[4], w[5], w[6], w[7]);
                hm = wave_max(hm);
                const float hs = hm > 0.f ? hm * (1.f / 119.f) : 1.f, hinv = 1.f / hs;
                unsigned ph[2] = {0u, 0u}, pl[2] = {0u, 0u};
#pragma unroll
                for (int j = 0; j < 16; ++j) {
                    const int h8 = (int)rintf(hval[j] * hinv);
                    const int lo = ((h8 + 8) & 15) - 8, hi = (h8 - lo) >> 4;
                    ph[j >> 3] |= ((unsigned)hi & 15u) << (4 * (j & 7)); pl[j >> 3] |= ((unsigned)lo & 15u) << (4 * (j & 7));
                }
                *(uint2*)(p.hqh + (size_t)T * 128 + lane * 2) = make_uint2(ph[0], ph[1]);
                *(uint2*)(p.hql + (size_t)T * 128 + lane * 2) = make_uint2(pl[0], pl[1]);
                if (lane == 0) p.hsc[T] = hs;
            }
        }
    }
}

template <int SRC>
__device__ void st_norm(const Params& p, int l, int which, const float* g, bf16_t* dst) {
    const int lane = tidx() & 63, wid = tidx() >> 6, stride = gridDim.x * NWV;
    for (int T0 = blockIdx.x * NWV + wid; T0 < T_TOK; T0 += 2 * stride) {
        float v[2][16];
#pragma unroll
        for (int u = 0; u < 2; ++u) {
            const int T = min(T0 + u * stride, T_TOK - 1);
            const float* src = (SRC == 0 ? x_in_row(p, T) : p.xres + (size_t)T * 1024) + lane * 16;
#pragma unroll
            for (int j = 0; j < 4; ++j) { const float4 f = *(const float4*)(src + 4 * j); v[u][4 * j] = f.x; v[u][4 * j + 1] = f.y; v[u][4 * j + 2] = f.z; v[u][4 * j + 3] = f.w; }
        }
#pragma unroll
        for (int u = 0; u < 2; ++u) {
            const int T = T0 + u * stride;
            if (T < T_TOK) {
                const TokInfo ti = tokinfo(T);
                float ss = 0.f;
#pragma unroll
                for (int j = 0; j < 16; ++j) ss += v[u][j] * v[u][j];
                ss = wave_sum(ss);
                const float rstd = rsqrtf(ss * (1.f / 1024.f) + 1e-6f);
                const float* sh = modv(p, l, ti.mi, which ? 3 : 0) + lane * 16; const float* sc = modv(p, l, ti.mi, which ? 4 : 1) + lane * 16; const float* gg = g + lane * 16;
                unsigned w[8];
#pragma unroll
                for (int j = 0; j < 8; ++j) w[j] = pack_bf16(v[u][2 * j] * rstd * gg[2 * j] * (1.f + sc[2 * j]) + sh[2 * j], v[u][2 * j + 1] * rstd * gg[2 * j + 1] * (1.f + sc[2 * j + 1]) + sh[2 * j + 1]);
                uint4* d = (uint4*)(dst + (size_t)T * 1024 + lane * 16);
                d[0] = make_uint4(w[0], w[1], w[2], w[3]); d[1] = make_uint4(w[4], w[5], w[6], w[7]);
            }
        }
    }
}

struct EpiStoreBf16 {
    static constexpr bool PERM = true;
    bf16_t* O; int ldc;
    __device__ __forceinline__ void operator()(const pg8::f32x4 (&acc)[2][2][4][2], const pg8::Unit& u, int wr, int wc, int fr, int fq) const {
#pragma unroll
        for (int ai = 0; ai < 2; ++ai)
#pragma unroll
            for (int m = 0; m < 4; ++m) {
                bf16_t* rowp = O + (size_t)(u.pm * 256 + ai * 128 + wr * 64 + m * 16 + fr) * ldc + u.pn * 256 + wc * 32 + 8 * fq;
#pragma unroll
                for (int bj = 0; bj < 2; ++bj) {
                    const pg8::f32x4 v0 = acc[ai][bj][m][0], v1 = acc[ai][bj][m][1];
                    *(uint4*)(rowp + bj * 128) = make_uint4(pack_bf16(v0[0], v0[1]), pack_bf16(v0[2], v0[3]), pack_bf16(v1[0], v1[1]), pack_bf16(v1[2], v1[3]));
                }
            }
    }
};
__device__ void st_gemm1(const Params& p) {
    pg8::TileOrder S; S.nN = 7; S.total = 80 * 7; S.A = (const char*)p.hbuf; S.B = (const char*)p.wt_in; S.tA = (size_t)256 * 1024 * 2; S.tB = (size_t)256 * 1024 * 2;
    EpiStoreBf16 E; E.O = p.P; E.ldc = 1792;
    pg8::gemm_phase<EpiStoreBf16, pg8::TileOrder, true, true>((LAS unsigned char*)smem, 1024, 1024, 1024, S, E);
}

__device__ void st_postproj(const Params& p) {
    const int lane = tidx() & 63, wid = tidx() >> 6;
    float* o_ckv = p.out + 20971520, *o_kr = p.out + 22020096;
    for (int T = blockIdx.x * NWV + wid; T < T_TOK; T += gridDim.x * NWV) {
        const TokInfo ti = tokinfo(T);
        const bf16_t* Pr = p.P + (size_t)T * 1792;
        float cq[8], ck[8];
#pragma unroll
        for (int j = 0; j < 8; ++j) { cq[j] = 0.f; ck[j] = 0.f; }
        if (lane < 48) unpack8(*(const uint4*)(Pr + lane * 8), cq);
        if (lane < 32) unpack8(*(const uint4*)(Pr + 384 + lane * 8), ck);
        float s1 = 0.f, s2 = 0.f;
#pragma unroll
        for (int j = 0; j < 8; ++j) { s1 += cq[j] * cq[j]; s2 += ck[j] * ck[j]; }
        s1 = wave_sum(s1); s2 = wave_sum(s2);
        const float r1 = rsqrtf(s1 * (1.f / 384.f) + 1e-6f), r2 = rsqrtf(s2 * (1.f / 256.f) + 1e-6f);
        if (lane < 48) {
            const float4 ga = *(const float4*)(p.g_q + lane * 8), gb = *(const float4*)(p.g_q + lane * 8 + 4);
            uint4 o; o.x = pack_bf16(cq[0] * r1 * ga.x, cq[1] * r1 * ga.y); o.y = pack_bf16(cq[2] * r1 * ga.z, cq[3] * r1 * ga.w);
            o.z = pack_bf16(cq[4] * r1 * gb.x, cq[5] * r1 * gb.y); o.w = pack_bf16(cq[6] * r1 * gb.z, cq[7] * r1 * gb.w);
            *(uint4*)(p.cqn + (size_t)T * 384 + lane * 8) = o;
        }
        if (lane < 32) {
            const float4 ga = *(const float4*)(p.g_kv + lane * 8), gb = *(const float4*)(p.g_kv + lane * 8 + 4);
            float y[8] = {ck[0] * r2 * ga.x, ck[1] * r2 * ga.y, ck[2] * r2 * ga.z, ck[3] * r2 * ga.w, ck[4] * r2 * gb.x, ck[5] * r2 * gb.y, ck[6] * r2 * gb.z, ck[7] * r2 * gb.w};
            uint4 o; o.x = pack_bf16(y[0], y[1]); o.y = pack_bf16(y[2], y[3]); o.z = pack_bf16(y[4], y[5]); o.w = pack_bf16(y[6], y[7]);
            *(uint4*)(p.ckvk + (size_t)ti.keyrow * 256 + lane * 8) = o;
            if (!ti.smp) { float4* d = (float4*)(o_ckv + (size_t)T * 256 + lane * 8); d[0] = make_float4(y[0], y[1], y[2], y[3]); d[1] = make_float4(y[4], y[5], y[6], y[7]); }
        }
        if (lane < 8) {
            float v[8]; unpack8(*(const uint4*)(Pr + 640 + lane * 8), v);
            float y[8];
            if (ti.smp) {
                const int gr = ti.s >> 6, gc = ti.s & 63;
#pragma unroll
                for (int i = 0; i < 4; ++i) {
                    const int pr = lane * 4 + i;
                    const float cs = pr < 16 ? p.ropetab[gr * 16 + pr] : p.ropetab[1024 + gc * 16 + (pr - 16)];
                    const float sn = pr < 16 ? p.ropetab[512 + gr * 16 + pr] : p.ropetab[2048 + gc * 16 + (pr - 16)];
                    y[2 * i] = v[2 * i] * cs - v[2 * i + 1] * sn; y[2 * i + 1] = v[2 * i] * sn + v[2 * i + 1] * cs;
                }
            } else {
#pragma unroll
                for (int i = 0; i < 8; ++i) y[i] = v[i];
                float4* d = (float4*)(o_kr + (size_t)T * 64 + lane * 8); d[0] = make_float4(v[0], v[1], v[2], v[3]); d[1] = make_float4(v[4], v[5], v[6], v[7]);
            }
            uint4 o; o.x = pack_bf16(y[0], y[1]); o.y = pack_bf16(y[2], y[3]); o.z = pack_bf16(y[4], y[5]); o.w = pack_bf16(y[6], y[7]);
            *(uint4*)(p.kropek + (size_t)ti.keyrow * 64 + lane * 8) = o;
        }
        {
            const int ch = lane * 8;
            float y[8];
            { const float4 a = *(const float4*)(p.conv_b + ch), b = *(const float4*)(p.conv_b + ch + 4); y[0] = a.x; y[1] = a.y; y[2] = a.z; y[3] = a.w; y[4] = b.x; y[5] = b.y; y[6] = b.z; y[7] = b.w; }
#pragma unroll
            for (int k = 0; k < 4; ++k) {
                const int s2i = ti.s + k - 2;
                if (s2i >= 0 && s2i < ti.S) {
                    float u[8]; unpack8(*(const uint4*)(p.P + (size_t)(T + k - 2) * 1792 + 704 + ch), u);
                    const float4 a = *(const float4*)(p.conv_w + k * 512 + ch), b = *(const float4*)(p.conv_w + k * 512 + ch + 4);
                    y[0] += a.x * u[0]; y[1] += a.y * u[1]; y[2] += a.z * u[2]; y[3] += a.w * u[3]; y[4] += b.x * u[4]; y[5] += b.y * u[5]; y[6] += b.z * u[6]; y[7] += b.w * u[7];
                }
            }
            uint4 o; o.x = pack_bf16(y[0], y[1]); o.y = pack_bf16(y[2], y[3]); o.z = pack_bf16(y[4], y[5]); o.w = pack_bf16(y[6], y[7]);
            *(uint4*)(p.xc + (size_t)T * 512 + ch) = o;
            *(uint4*)(p.ug + (size_t)T * 512 + ch) = *(const uint4*)(Pr + 1216 + ch);
        }
    }
}

struct EpiVT {
    static constexpr bool PERM = true;
    bf16_t* vT;
    __device__ __forceinline__ void operator()(const pg8::f32x4 (&acc)[2][2][4][2], const pg8::Unit& u, int wr, int wc, int fr, int fq) const {
        const int R0 = u.pn * 256;
        size_t sbase; int Sk, pos0;
        if (R0 < T_CTX) { Sk = 256; pos0 = 0; sbase = (size_t)(R0 >> 8) * 4 * 128 * 256; }
        else { const int uu = R0 - T_CTX; const int sq = uu / 2304; Sk = 2304; pos0 = uu - sq * 2304; sbase = (size_t)T_CTX * 512 + (size_t)sq * 4 * 128 * 2304; }
        bf16_t* vb = vT + sbase + pos0 + wc * 32 + 8 * fq;
#pragma unroll
        for (int ai = 0; ai < 2; ++ai)
#pragma unroll
            for (int m = 0; m < 4; ++m) {
                const int r = u.pm * 256 + ai * 128 + wr * 64 + m * 16 + fr;
                bf16_t* rowp = vb + (size_t)r * Sk;
#pragma unroll
                for (int bj = 0; bj < 2; ++bj) {
                    const pg8::f32x4 v0 = acc[ai][bj][m][0], v1 = acc[ai][bj][m][1];
                    *(uint4*)(rowp + bj * 128) = make_uint4(pack_bf16(v0[0], v0[1]), pack_bf16(v0[2], v0[3]), pack_bf16(v1[0], v1[1]), pack_bf16(v1[2], v1[3]));
                }
            }
    }
};
#define N_G4 (160 * 16)
__device__ void st_gemm234(const Params& p) {
    {
        pg8::TileOrder S; S.nN = 3; S.total = 80 * 3; S.A = (const char*)p.cqn; S.B = (const char*)p.wt_uq; S.tA = (size_t)256 * 384 * 2; S.tB = (size_t)256 * 384 * 2;
        EpiStoreBf16 E; E.O = p.q; E.ldc = 768;
        pg8::gemm_phase<EpiStoreBf16, pg8::TileOrder, true, true>((LAS unsigned char*)smem, 384, 384, 384, S, E);
    }
    {
        pg8::TileOrder S; S.nN = 2; S.total = 88 * 2; S.A = (const char*)p.ckvk; S.B = (const char*)p.wt_ukv; S.tA = (size_t)256 * 256 * 2; S.tB = (size_t)256 * 256 * 2;
        EpiStoreBf16 E; E.O = p.Kn; E.ldc = 512;
        pg8::gemm_phase<EpiStoreBf16, pg8::TileOrder, true, true>((LAS unsigned char*)smem, 256, 256, 256, S, E);
    }
    {
        struct OrderVT {
            const char* W; const char* Kr;
            __device__ __forceinline__ bool next(int i, pg8::Unit& u) const {
                const int item = blockIdx.x + i * gridDim.x; if (item >= 88 * 2) return false;
                const int lt = item >> 3; u.pm = lt & 1; u.pn = (lt >> 1) * 8 + (item & 7);
                u.A = W + (size_t)u.pm * 256 * 256 * 2; u.B = Kr + (size_t)u.pn * 256 * 256 * 2; return true;
            }
        } S; S.W = (const char*)(p.wt_ukv + (size_t)512 * 256); S.Kr = (const char*)p.ckvk;
        EpiVT E; E.vT = p.vT;
        pg8::gemm_phase<EpiVT, OrderVT, true, true>((LAS unsigned char*)smem, 256, 256, 256, S, E);
    }
}

__device__ void st_gates(const Params& p) {
    const int half = tidx() >> 8, lane = tidx() & 63, wid = (tidx() >> 6) & 3, wm = wid >> 1, wn = wid & 1, hl = lane >> 5, cl = lane & 31;
    for (int item = blockIdx.x; item < N_G4 / 2; item += gridDim.x) {
        f32x16 acc[2][2];
        const int lt = (item >> 3) * 2 + half, tj = lt & 3, nb = (lt >> 2) & 3, tm = (lt >> 4) * 8 + (item & 7);
        gemm_acc<2, 2, 2, 2>(p.wt_gate + ((size_t)nb * 512 + tj * 128) * 128, 128, p.xc + (size_t)tm * 128 * 512 + nb * 128, 512, 128, acc);
        const int dir = tj >> 1, dg = (tj & 1) * 2 + wm;
#pragma unroll
        for (int gq = 0; gq < 4; ++gq) {
            const int ch0 = nb * 128 + dg * 32 + 8 * gq + 4 * hl;
            const float4 brg = *(const float4*)(p.b_rg + dir * 512 + ch0), big = *(const float4*)(p.b_ig + dir * 512 + ch0), sp = *(const float4*)(p.spl + dir * 512 + ch0);
            const float br[4] = {brg.x, brg.y, brg.z, brg.w}, bi[4] = {big.x, big.y, big.z, big.w}, spv[4] = {sp.x, sp.y, sp.z, sp.w};
#pragma unroll
            for (int j = 0; j < 2; ++j) {
                const int T = tm * 128 + 64 * wn + 32 * j + cl;
                const uint2 xr = *(const uint2*)(p.xc + (size_t)T * 512 + ch0);
                const float xv[4] = {__uint_as_float(xr.x << 16), __uint_as_float(xr.x & 0xffff0000u), __uint_as_float(xr.y << 16), __uint_as_float(xr.y & 0xffff0000u)};
                float am[4], bx[4];
#pragma unroll
                for (int e = 0; e < 4; ++e) {
                    const float rg = __builtin_amdgcn_rcpf(1.f + __expf(-(acc[0][j][4 * gq + e] + br[e]))), ig = __builtin_amdgcn_rcpf(1.f + __expf(-(acc[1][j][4 * gq + e] + bi[e])));
                    const float la = -8.f * rg * spv[e];
                    const float av = __expf(la);
                    am[e] = 1.f - av;
                    bx[e] = __builtin_amdgcn_sqrtf(fmaxf(1.f - av * av, 0.f)) * ig * xv[e];
                }
                *(uint2*)(p.a1m + ((size_t)T * 2 + dir) * 512 + ch0) = make_uint2(pack_bf16(am[0], am[1]), pack_bf16(am[2], am[3]));
                *(uint2*)(p.bxb + ((size_t)T * 2 + dir) * 512 + ch0) = make_uint2(pack_bf16(bx[0], bx[1]), pack_bf16(bx[2], bx[3]));
            }
        }
    }
}

#define N_ATT (64 + 256)
#define SCH 64
#define NCHK (T_TOK / SCH)
#define N_S1 (NCHK * 2)
__device__ void scan_s1_item(const Params& p, int it) {
    const int chunk = it >> 1, dc = (it & 1) * 512 + tidx(), dir = dc >> 9, ch = dc & 511;
    const int T0 = chunk * SCH;
    float A = 1.f, B = 0.f;
#pragma unroll 8
    for (int i = 0; i < SCH; ++i) {
        const int T = dir ? (T0 + SCH - 1 - i) : (T0 + i);
        const float av = 1.f - bf2f(p.a1m[((size_t)T * 2 + dir) * 512 + ch]), bv = bf2f(p.bxb[((size_t)T * 2 + dir) * 512 + ch]);
        A *= av; B = B * av + bv;
    }
    *(float2*)(p.agg + (((size_t)chunk * 2 + dir) * 512 + ch) * 2) = make_float2(A, B);
}

__device__ __forceinline__ int perm23(int r) { return (r & 0x13) | ((r & 4) << 1) | ((r & 8) >> 1); }
__device__ void attn_item_mfma(const Params& p, int it) {
    int seq, h, qb, Sk, T0, R0; size_t vbase;
    if (it < 64) { seq = it >> 2; h = it & 3; qb = 0; Sk = 256; T0 = seq * 256; R0 = seq * 256; vbase = (size_t)(seq * 4 + h) * 128 * 256; }
    else { const int u = it - 64; seq = u >> 5; h = (u >> 3) & 3; qb = u & 7; Sk = 2304; T0 = T_CTX + seq * 2048 + qb * 256; R0 = T_CTX + seq * 2304; vbase = (size_t)T_CTX * 512 + (size_t)(seq * 4 + h) * 128 * 2304; }
    const int tid = tidx(), lane = tid & 63, wid = tid >> 6, hl = lane >> 5, cl = lane & 31;
    bf16x8_t qf[12];
    {
        const bf16_t* qrow = p.q + (size_t)(T0 + 32 * wid + cl) * 768 + h * 192 + 8 * hl;
#pragma unroll
        for (int ks = 0; ks < 12; ++ks) qf[ks] = __builtin_bit_cast(bf16x8_t, *(const u32x4*)(qrow + 16 * ks));
        if (it >= 64) {
            const int sp = qb * 256 + 32 * wid + cl, gr = sp >> 6, gc = sp & 63;
#pragma unroll
            for (int ks = 8; ks < 12; ++ks) {
                const u32x4 w = __builtin_bit_cast(u32x4, qf[ks]); u32x4 o;
#pragma unroll
                for (int i = 0; i < 4; ++i) {
                    const int pr = 8 * (ks - 8) + 4 * hl + i;
                    const float cs = ks < 10 ? p.ropetab[gr * 16 + pr] : p.ropetab[1024 + gc * 16 + (pr - 16)];
                    const float sn = ks < 10 ? p.ropetab[512 + gr * 16 + pr] : p.ropetab[2048 + gc * 16 + (pr - 16)];
                    const float x0 = __uint_as_float(w[i] << 16), x1 = __uint_as_float(w[i] & 0xffff0000u);
                    o[i] = pack_bf16(x0 * cs - x1 * sn, x0 * sn + x1 * cs);
                }
                qf[ks] = __builtin_bit_cast(bf16x8_t, o);
            }
        }
    }
    f32x16 oacc[4];
#pragma unroll
    for (int d = 0; d < 4; ++d)
#pragma unroll
        for (int r = 0; r < 16; ++r) oacc[d][r] = 0.f;
    float m = -1e30f, lsum = 0.f;
    const bf16_t* gk = p.Kn + (size_t)(R0 + (tid >> 4)) * 512 + h * 128 + (tid & 15) * 8;
    const bf16_t* gr = p.kropek + (size_t)(R0 + (tid >> 3)) * 64 + (tid & 7) * 8;
    const bf16_t* gv = p.vT + vbase + (size_t)(tid >> 3) * Sk + (tid & 7) * 8;
    u32x4 rk[2], rr, rv[2];
    const int nt = Sk >> 6;
#pragma unroll
    for (int i = 0; i < 2; ++i) rk[i] = *(const u32x4*)(gk + (size_t)(32 * i) * 512);
    rr = *(const u32x4*)gr;
#pragma unroll
    for (int i = 0; i < 2; ++i) rv[i] = *(const u32x4*)(gv + (size_t)(64 * i) * Sk);
    __syncthreads();
    for (int t = 0; t < nt; ++t) {
#pragma unroll
        for (int i = 0; i < 2; ++i) *(u32x4*)(smem + ((tid & 15) >> 3) * 8192 + lds_off((tid >> 4) + 32 * i, tid & 7)) = rk[i];
        *(u32x4*)(smem + 16384 + lds_off(tid >> 3, tid & 7)) = rr;
#pragma unroll
        for (int i = 0; i < 2; ++i) *(u32x4*)(smem + 24576 + lds_off((tid >> 3) + 64 * i, tid & 7)) = rv[i];
        __syncthreads();
        if (t + 1 < nt) {
            const size_t ko = (size_t)(t + 1) * 64;
#pragma unroll
            for (int i = 0; i < 2; ++i) rk[i] = *(const u32x4*)(gk + (ko + 32 * i) * 512);
            rr = *(const u32x4*)(gr + ko * 64);
#pragma unroll
            for (int i = 0; i < 2; ++i) rv[i] = *(const u32x4*)(gv + (size_t)(64 * i) * Sk + ko);
        }
        f32x16 sacc[2];
#pragma unroll
        for (int kb = 0; kb < 2; ++kb) {
            __builtin_amdgcn_sched_barrier(0);
#pragma unroll
            for (int r = 0; r < 16; ++r) sacc[kb][r] = 0.f;
            const int krow = 32 * kb + perm23(cl);
#pragma unroll
            for (int ks = 0; ks < 12; ++ks) {
                const bf16x8_t kf = __builtin_bit_cast(bf16x8_t, *(const u32x4*)(smem + (ks >> 2) * 8192 + lds_off(krow, 2 * (ks & 3) + hl)));
                sacc[kb] = __builtin_amdgcn_mfma_f32_32x32x16_bf16(kf, qf[ks], sacc[kb], 0, 0, 0);
            }
        }
        float mx = sacc[0][0];
#pragma unroll
        for (int r = 1; r < 16; ++r) mx = fmaxf(mx, sacc[0][r]);
#pragma unroll
        for (int r = 0; r < 16; ++r) mx = fmaxf(mx, sacc[1][r]);
        mx = fmaxf(mx, __shfl_xor(mx, 32));
        const bool resc = !__all(mx - m <= 8.f);
        const float mn = resc ? fmaxf(m, mx) : m, alpha = resc ? __builtin_amdgcn_exp2f(m - mn) : 1.f;
        m = mn;
        float ps = 0.f;
        bf16x8_t pf[2][2];
#pragma unroll
        for (int kb = 0; kb < 2; ++kb)
#pragma unroll
            for (int s2 = 0; s2 < 2; ++s2) {
                float e[8];
#pragma unroll
                for (int j = 0; j < 8; ++j) { e[j] = __builtin_amdgcn_exp2f(sacc[kb][8 * s2 + j] - mn); ps += e[j]; }
                u32x4 w; w.x = pack_bf16(e[0], e[1]); w.y = pack_bf16(e[2], e[3]); w.z = pack_bf16(e[4], e[5]); w.w = pack_bf16(e[6], e[7]);
                pf[kb][s2] = __builtin_bit_cast(bf16x8_t, w);
            }
        lsum = lsum * alpha + ps;
        if (resc) {
#pragma unroll
            for (int d = 0; d < 4; ++d)
#pragma unroll
                for (int r = 0; r < 16; ++r) oacc[d][r] *= alpha;
        }
#pragma unroll
        for (int d = 0; d < 4; ++d) {
            __builtin_amdgcn_sched_barrier(0);
#pragma unroll
            for (int kb = 0; kb < 2; ++kb)
#pragma unroll
                for (int s2 = 0; s2 < 2; ++s2) {
                    const bf16x8_t vf = __builtin_bit_cast(bf16x8_t, *(const u32x4*)(smem + 24576 + lds_off(32 * d + cl, 4 * kb + 2 * s2 + hl)));
                    oacc[d] = __builtin_amdgcn_mfma_f32_32x32x16_bf16(vf, pf[kb][s2], oacc[d], 0, 0, 0);
                }
        }
        __builtin_amdgcn_sched_barrier(0);
        __syncthreads();
    }
    lsum += __shfl_xor(lsum, 32);
    const float inv = 1.f / lsum;
    bf16_t* dst = p.hbuf + (size_t)(T0 + 32 * wid + cl) * 1024 + h * 128 + 4 * hl;
#pragma unroll
    for (int d = 0; d < 4; ++d)
#pragma unroll
        for (int g = 0; g < 4; ++g) {
            uint2 w; w.x = pack_bf16(oacc[d][4 * g] * inv, oacc[d][4 * g + 1] * inv); w.y = pack_bf16(oacc[d][4 * g + 2] * inv, oacc[d][4 * g + 3] * inv);
            *(uint2*)(dst + 32 * d + 8 * g) = w;
        }
}
__device__ void st_attn_s1(const Params& p) {
    for (int item = blockIdx.x; item < N_ATT + N_S1; item += gridDim.x) {
        if (item < N_ATT) {
            attn_item_mfma(p, N_ATT - 1 - item);
        }
        else scan_s1_item(p, item - N_ATT);
    }
}

__device__ void st_scan3(const Params& p) {
    const int tid = tidx();
    float* hf = (float*)smem;
    float* hb = hf + SCH * 256;
    float* o_lru = p.out + 22282240;
    for (int item = blockIdx.x; item < NCHK * 2; item += gridDim.x) {
        const int chunk = item >> 1, cgp = item & 1, T0 = chunk * SCH;
        const TokInfo ti = tokinfo(T0);
        const int nch = ti.S / SCH, cpos = ti.s / SCH, c0 = chunk - cpos;
        const int dir = tid >> 8, ch = cgp * 256 + (tid & 255);
        float hcur = ti.smp ? p.state_lru[((size_t)ti.b * 2 + dir) * 512 + ch] : 0.f;
        if (dir == 0) { for (int cc = 0; cc < cpos; ++cc) { const float2 ab = *(const float2*)(p.agg + (((size_t)(c0 + cc) * 2 + 0) * 512 + ch) * 2); hcur = ab.x * hcur + ab.y; } }
        else { for (int cc = nch - 1; cc > cpos; --cc) { const float2 ab = *(const float2*)(p.agg + (((size_t)(c0 + cc) * 2 + 1) * 512 + ch) * 2); hcur = ab.x * hcur + ab.y; } }
        __syncthreads();
#pragma unroll 8
        for (int i = 0; i < SCH; ++i) {
            const int tl = dir ? SCH - 1 - i : i, T = T0 + tl;
            const float av = 1.f - bf2f(p.a1m[((size_t)T * 2 + dir) * 512 + ch]), bv = bf2f(p.bxb[((size_t)T * 2 + dir) * 512 + ch]);
            hcur = av * hcur + bv;
            (dir ? hb : hf)[tl * 256 + (tid & 255)] = hcur;
        }
        if (!ti.smp) {
            if (dir == 0 && cpos == nch - 1) o_lru[((size_t)ti.b * 2 + 0) * 512 + ch] = hcur;
            if (dir == 1 && cpos == 0) o_lru[((size_t)ti.b * 2 + 1) * 512 + ch] = hcur;
        }
        __syncthreads();
        for (int i = tid; i < SCH * 128; i += NTHR) {
            const int tl = i >> 7, c = (i & 127) * 2, T = T0 + tl, chh = cgp * 256 + c;
            const unsigned ugp = *(const unsigned*)(p.ug + (size_t)T * 512 + chh);
            const float g0 = gelu_tanh(__uint_as_float(ugp << 16)), g1 = gelu_tanh(__uint_as_float(ugp & 0xffff0000u));
            const float2 f = *(const float2*)(hf + tl * 256 + c), bb = *(const float2*)(hb + tl * 256 + c);
            *(unsigned*)(p.hbuf + (size_t)T * 1024 + 512 + chh) = pack_bf16((f.x + bb.x) * g0, (f.y + bb.y) * g1);
        }
    }
}

__device__ void st_gemm_o(const Params& p) {
    pg8::TileOrder S; S.nN = 4; S.total = 80 * 4; S.A = (const char*)p.hbuf; S.B = (const char*)p.wt_o; S.tA = (size_t)256 * 1024 * 2; S.tB = (size_t)256 * 1024 * 2;
    EpiStoreBf16 E; E.O = p.mix; E.ldc = 1024;
    pg8::gemm_phase<EpiStoreBf16, pg8::TileOrder, true, true>((LAS unsigned char*)smem, 1024, 1024, 1024, S, E);
}

__device__ __forceinline__ void ce_desc(float& a, float& b) { const float hi = fmaxf(a, b), lo = fminf(a, b); a = hi; b = lo; }
__device__ __forceinline__ void ins16(float (&top)[16], float x) {
#pragma unroll
    for (int i = 0; i < 16; ++i) { const float hi = fmaxf(top[i], x); x = fminf(top[i], x); top[i] = hi; }
}
__device__ __forceinline__ void bitonic_merge16(float (&v)[16]) {
#pragma unroll
    for (int j = 8; j >= 1; j >>= 1)
#pragma unroll
        for (int i = 0; i < 16; ++i) { const int l = i ^ j; if (l > i) ce_desc(v[i], v[l]); }
}
__device__ __forceinline__ void sort16(float (&v)[16]) {
#pragma unroll
    for (int k = 2; k <= 16; k <<= 1)
#pragma unroll
        for (int j = k >> 1; j >= 1; j >>= 1)
#pragma unroll
            for (int i = 0; i < 16; ++i) { const int l = i ^ j; if (l > i) { if ((i & k) == 0) ce_desc(v[i], v[l]); else ce_desc(v[l], v[i]); } }
}
__device__ __forceinline__ void merge_top16(float (&a)[16], const float (&b)[16]) {
#pragma unroll
    for (int i = 0; i < 16; ++i) a[i] = fmaxf(a[i], b[15 - i]);
    bitonic_merge16(a);
}
#define PKV(x) __uint_as_float(__float_as_uint(x) & 0xffffff80u)
#define CAND(i, j) __uint_as_float((__float_as_uint(PKV(top[0][i]) + PKV(top[1][j])) & 0xffffff00u) | (unsigned)((i) * 16 + (j)))
__device__ void st_peer_topk(const Params& p, int l) {
    __builtin_amdgcn_sched_barrier(0);
    const int half = tidx() >> 8, lane = tidx() & 63, wid = (tidx() >> 6) & 3, hl = lane >> 5, cl = lane & 31;
    for (int item = blockIdx.x; item < 80 * 8; item += gridDim.x) {
        const int lt = item >> 3, h = lt & 7, tm = 2 * ((lt >> 3) * 8 + (item & 7)) + half;
        const int T = tm * 128 + 32 * wid + cl;
        float top[2][16];
#pragma unroll
        for (int pp = 0; pp < 2; ++pp) {
            f32x16 acc[4][1];
            gemm_acc<4, 1, 1, 4>(p.keysb[l] + (size_t)(h * 2 + pp) * 128 * 128, 128, p.qp + (size_t)tm * 128 * 2048 + h * 256 + pp * 128, 2048, 128, acc);
#pragma unroll
            for (int i = 0; i < 4; ++i) {
                __builtin_amdgcn_sched_barrier(0);
                float g[16];
#pragma unroll
                for (int r = 0; r < 16; ++r) {
                    const int n = ACC_ROW(4, 0, i, r, hl);
                    g[r] = __uint_as_float((__float_as_uint(acc[i][0][r]) & 0xffffff80u) | (unsigned)n);
                }
                sort16(g);
                if (i == 0) {
#pragma unroll
                    for (int r = 0; r < 16; ++r) top[pp][r] = g[r];
                } else merge_top16(top[pp], g);
            }
            __builtin_amdgcn_sched_barrier(0);
            float oth[16];
#pragma unroll
            for (int i = 0; i < 16; ++i) oth[i] = __shfl_xor(top[pp][i], 32);
            merge_top16(top[pp], oth);
        }
        __builtin_amdgcn_sched_barrier(0);
        float fv[16], t2[16];
#pragma unroll
        for (int j = 0; j < 16; ++j) fv[j] = CAND(0, j);
        t2[15] = -INFINITY;
#pragma unroll
        for (int i = 1; i < 16; ++i) t2[i - 1] = CAND(i, 0);
        merge_top16(fv, t2);
        t2[0] = CAND(1, 1); t2[1] = CAND(1, 2); t2[2] = CAND(1, 3); t2[3] = CAND(1, 4); t2[4] = CAND(1, 5); t2[5] = CAND(1, 6); t2[6] = CAND(1, 7);
        t2[7] = CAND(2, 1); t2[8] = CAND(2, 2); t2[9] = CAND(2, 3); t2[10] = CAND(2, 4); t2[11] = CAND(3, 1); t2[12] = CAND(3, 2); t2[13] = CAND(3, 3);
        t2[14] = CAND(4, 1); t2[15] = CAND(4, 2);
        sort16(t2);
        merge_top16(fv, t2);
        ins16(fv, CAND(5, 1)); ins16(fv, CAND(6, 1)); ins16(fv, CAND(7, 1));
        unsigned* tab = (unsigned*)(smem + half * 65536) + (size_t)(tidx() & 255) * 8;
#pragma unroll
        for (int k = 0; k < 4; ++k) {
            tab[k] = (__float_as_uint(top[0][4 * k]) & 127u) | ((__float_as_uint(top[0][4 * k + 1]) & 127u) << 8) | ((__float_as_uint(top[0][4 * k + 2]) & 127u) << 16) | ((__float_as_uint(top[0][4 * k + 3]) & 127u) << 24);
            tab[4 + k] = (__float_as_uint(top[1][4 * k]) & 127u) | ((__float_as_uint(top[1][4 * k + 1]) & 127u) << 8) | ((__float_as_uint(top[1][4 * k + 2]) & 127u) << 16) | ((__float_as_uint(top[1][4 * k + 3]) & 127u) << 24);
        }
        const u8_t* tabb = (const u8_t*)tab;
        int fe[16];
#pragma unroll
        for (int i = 0; i < 16; ++i) {
            const unsigned code = __float_as_uint(fv[i]) & 255u;
            fe[i] = (int)tabb[code >> 4] * 128 + (int)tabb[16 + (code & 15u)];
            fv[i] = __uint_as_float(__float_as_uint(fv[i]) & 0xffffff00u);
        }
        float sum = 0.f, ev[16];
#pragma unroll
        for (int i = 0; i < 16; ++i) { ev[i] = __expf(fv[i] - fv[0]); sum += ev[i]; }
        const float inv = 1.f / sum;
        if (hl == 0) {
            float4* gp = (float4*)(p.gates + (size_t)T * 128 + h * 16); int4* ep = (int4*)(p.eidx + (size_t)T * 128 + h * 16);
#pragma unroll
            for (int i = 0; i < 4; ++i) { gp[i] = make_float4(ev[4 * i] * inv, ev[4 * i + 1] * inv, ev[4 * i + 2] * inv, ev[4 * i + 3] * inv); ep[i] = make_int4(fe[4 * i], fe[4 * i + 1], fe[4 * i + 2], fe[4 * i + 3]); }
        }
    }
}

__device__ void st_gemm_pq(const Params& p, int l) {
    pg8::TileOrder S; S.nN = 8; S.total = 80 * 8; S.A = (const char*)p.hbuf; S.B = (const char*)p.wt_pq[l]; S.tA = (size_t)256 * 1024 * 2; S.tB = (size_t)256 * 1024 * 2;
    EpiStoreBf16 E; E.O = p.qp; E.ldc = 2048;
    pg8::gemm_phase<EpiStoreBf16, pg8::TileOrder, true, true>((LAS unsigned char*)smem, 1024, 1024, 1024, S, E);
    asm volatile("s_waitcnt vmcnt(0)" ::: "memory");
    __syncthreads();
    st_peer_topk(p, l);
}

#define FP4X(dw, b) __builtin_amdgcn_cvt_scalef32_pk_f32_fp4(dw, 1.0f, b)
#define FP4B(dw, b) __builtin_amdgcn_cvt_scalef32_pk_bf16_fp4(dw, 1.0f, b)
__device__ void st_peer_gather(const Params& p, int l) {
    const int lane = tidx() & 63, wid = __builtin_amdgcn_readfirstlane(tidx() >> 6), g = lane >> 3, pc = lane & 7;
    const u8_t* U = p.u8[l]; const u8_t* V = p.v8[l]; const float* SU = p.su[l]; const float* SV = p.sv[l];
    const bool b0 = (lane & 1) != 0, b1 = (lane & 2) != 0, b2 = (lane & 4) != 0, b3 = (lane & 8) != 0;
    const int stride = gridDim.x * NWV, Tfirst = blockIdx.x * NWV + wid;
    const int ka = 16 * g + pc, kb = ka + 8;
#pragma unroll 1
    for (int c = 0; c < 4; ++c) {
#pragma unroll 1
        for (int T = Tfirst; T < T_TOK; T += stride) {
            int ev[16];
            { const int4* ep = (const int4*)(p.eidx + (size_t)T * 128 + 16 * g);
#pragma unroll
              for (int q = 0; q < 4; ++q) { const int4 t = ep[q]; ev[4 * q] = t.x; ev[4 * q + 1] = t.y; ev[4 * q + 2] = t.z; ev[4 * q + 3] = t.w; } }
            const u32x4 hh4 = *(const u32x4*)(p.hqh + (size_t)T * 128 + c * 32 + pc * 4), hl4 = *(const u32x4*)(p.hql + (size_t)T * 128 + c * 32 + pc * 4);
            u32x4 r[16];
#pragma unroll
            for (int i = 0; i < 16; ++i) {
                r[i] = *(const u32x4*)(U + ((unsigned)ev[i] * 512u + (unsigned)(c * 128 + pc * 16)));
            }
            float za = 0.f, zb = 0.f;
            if (c > 0) { za = p.zbuf[(size_t)T * 128 + ka]; zb = p.zbuf[(size_t)T * 128 + kb]; }
#pragma unroll
            for (int hh = 0; hh < 2; ++hh) {
                float d[8];
#pragma unroll
                for (int ii = 0; ii < 8; ++ii) {
                    int ah = 0, al = 0;
#pragma unroll
                    for (int q = 0; q < 4; ++q) { ah = __builtin_amdgcn_sdot8((int)r[8 * hh + ii][q], (int)hh4[q], ah, false); al = __builtin_amdgcn_sdot8((int)r[8 * hh + ii][q], (int)hl4[q], al, false); }
                    d[ii] = (float)(ah * 16 + al);
                }
                float a4[4], a2[2];
#pragma unroll
                for (int j = 0; j < 4; ++j) { const float kp = b2 ? d[j + 4] : d[j], sn = b2 ? d[j] : d[j + 4]; a4[j] = kp + DPP_F(sn, 0x141); }
#pragma unroll
                for (int j = 0; j < 2; ++j) { const float kp = b1 ? a4[j + 2] : a4[j], sn = b1 ? a4[j] : a4[j + 2]; a2[j] = kp + DPP_F(sn, 0x4E); }
                const float kp = b0 ? a2[1] : a2[0], sn = b0 ? a2[0] : a2[1];
                const float z = kp + DPP_F(sn, 0xB1);
                if (hh == 0) za += z; else zb += z;
            }
            if (c < 3) { p.zbuf[(size_t)T * 128 + ka] = za; p.zbuf[(size_t)T * 128 + kb] = zb; }
            else {
                const int ea = p.eidx[(size_t)T * 128 + ka], eb = p.eidx[(size_t)T * 128 + kb];
                const float ga = p.gates[(size_t)T * 128 + ka], gb = p.gates[(size_t)T * 128 + kb];
                const float hs = p.hsc[T];
                p.wbuf[(size_t)T * 128 + ka] = ga * gelu_tanh(za * (SU[ea] * hs)) * SV[ea];
                p.wbuf[(size_t)T * 128 + kb] = gb * gelu_tanh(zb * (SU[eb] * hs)) * SV[eb];
            }
        }
    }
    asm volatile("s_waitcnt vmcnt(0)" ::: "memory");
#pragma unroll 1
    for (int c = 0; c < 4; ++c) {
#pragma unroll 1
        for (int T = Tfirst; T < T_TOK; T += stride) {
            int ev[16]; float wv[16];
            { const int4* ep = (const int4*)(p.eidx + (size_t)T * 128 + 16 * g); const float4* wp = (const float4*)(p.wbuf + (size_t)T * 128 + 16 * g);
#pragma unroll
              for (int q = 0; q < 4; ++q) { const int4 t = ep[q]; ev[4 * q] = t.x; ev[4 * q + 1] = t.y; ev[4 * q + 2] = t.z; ev[4 * q + 3] = t.w;
                                            const float4 u = wp[q]; wv[4 * q] = u.x; wv[4 * q + 1] = u.y; wv[4 * q + 2] = u.z; wv[4 * q + 3] = u.w; } }
            u32x4 r[16];
#pragma unroll
            for (int i = 0; i < 16; ++i) {
                r[i] = *(const u32x4*)(V + ((unsigned)ev[i] * 512u + (unsigned)(c * 128 + pc * 16)));
            }
            f32x2 acc2[16];
#pragma unroll
            for (int j = 0; j < 16; ++j) acc2[j] = (f32x2){0.f, 0.f};
#pragma unroll
            for (int i = 0; i < 16; ++i) {
                const f32x2 wk2 = {wv[i], wv[i]};
#pragma unroll
                for (int q = 0; q < 4; ++q) {
                    acc2[4 * q] = FP4X(r[i][q], 0) * wk2 + acc2[4 * q]; acc2[4 * q + 1] = FP4X(r[i][q], 1) * wk2 + acc2[4 * q + 1];
                    acc2[4 * q + 2] = FP4X(r[i][q], 2) * wk2 + acc2[4 * q + 2]; acc2[4 * q + 3] = FP4X(r[i][q], 3) * wk2 + acc2[4 * q + 3];
                }
                __builtin_amdgcn_sched_barrier(0);
            }
            float acc[32];
#pragma unroll
            for (int j = 0; j < 16; ++j) { acc[2 * j] = acc2[j].x; acc[2 * j + 1] = acc2[j].y; }
            float s1[16], s2[8], s3[4];
#pragma unroll
            for (int j = 0; j < 16; ++j) { const u32x2 rr = __builtin_amdgcn_permlane32_swap(__float_as_uint(acc[j]), __float_as_uint(acc[j + 16]), false, false); s1[j] = __uint_as_float(rr[0]) + __uint_as_float(rr[1]); }
#pragma unroll
            for (int j = 0; j < 8; ++j) { const u32x2 rr = __builtin_amdgcn_permlane16_swap(__float_as_uint(s1[j]), __float_as_uint(s1[j + 8]), false, false); s2[j] = __uint_as_float(rr[0]) + __uint_as_float(rr[1]); }
#pragma unroll
            for (int j = 0; j < 4; ++j) { const float kp = b3 ? s2[j + 4] : s2[j], sn = b3 ? s2[j] : s2[j + 4]; s3[j] = kp + DPP_F(sn, 0x128); }
            *(uint2*)(p.mix + (size_t)T * 1024 + c * 256 + pc * 32 + g * 4) = make_uint2(pack_bf16(s3[0], s3[1]), pack_bf16(s3[2], s3[3]));
        }
    }
    asm volatile("s_waitcnt vmcnt(0)" ::: "memory");
#pragma unroll 1
    for (int T = Tfirst; T < T_TOK; T += stride) {
        const TokInfo ti = tokinfo(T);
        const int cb = lane * 16;
        float o16[16];
        { const uint4* op = (const uint4*)(p.mix + (size_t)T * 1024 + cb); float t8[8]; unpack8(op[0], t8);
#pragma unroll
          for (int j = 0; j < 8; ++j) o16[j] = t8[j];
          unpack8(op[1], t8);
#pragma unroll
          for (int j = 0; j < 8; ++j) o16[8 + j] = t8[j]; }
        float* xr = p.xres + (size_t)T * 1024 + cb;
        const float* gt = modv(p, l, ti.mi, 5) + cb;
        float xn[16]; float ss = 0.f;
#pragma unroll
        for (int j = 0; j < 4; ++j) { const float4 f = *(const float4*)(xr + 4 * j); xn[4 * j] = f.x + gt[4 * j] * o16[4 * j]; xn[4 * j + 1] = f.y + gt[4 * j + 1] * o16[4 * j + 1]; xn[4 * j + 2] = f.z + gt[4 * j + 2] * o16[4 * j + 2]; xn[4 * j + 3] = f.w + gt[4 * j + 3] * o16[4 * j + 3]; }
#pragma unroll
        for (int j = 0; j < 16; ++j) ss += xn[j] * xn[j];
        ss = wave_sum(ss);
        const float rstd = rsqrtf(ss * (1.f / 1024.f) + 1e-6f);
        if (l == 0) {
#pragma unroll
            for (int j = 0; j < 4; ++j) *(float4*)(xr + 4 * j) = make_float4(xn[4 * j], xn[4 * j + 1], xn[4 * j + 2], xn[4 * j + 3]);
            const float* sh = modv(p, 1, ti.mi, 0) + cb; const float* sc = modv(p, 1, ti.mi, 1) + cb; const float* gg = p.g_mix[1] + cb;
            unsigned w[8];
#pragma unroll
            for (int j = 0; j < 8; ++j) w[j] = pack_bf16(xn[2 * j] * rstd * gg[2 * j] * (1.f + sc[2 * j]) + sh[2 * j], xn[2 * j + 1] * rstd * gg[2 * j + 1] * (1.f + sc[2 * j + 1]) + sh[2 * j + 1]);
            uint4* dd = (uint4*)(p.h3 + (size_t)T * 1024 + cb);
            dd[0] = make_uint4(w[0], w[1], w[2], w[3]); dd[1] = make_uint4(w[4], w[5], w[6], w[7]);
        } else {
            const float* gg = p.g_final + cb;
            float* y = p.out + (size_t)T * 1024 + cb;
#pragma unroll
            for (int j = 0; j < 4; ++j) *(float4*)(y + 4 * j) = make_float4(xn[4 * j] * rstd * gg[4 * j], xn[4 * j + 1] * rstd * gg[4 * j + 1], xn[4 * j + 2] * rstd * gg[4 * j + 2], xn[4 * j + 3] * rstd * gg[4 * j + 3]);
        }
    }
}

template <int W>
__device__ __forceinline__ void pool_tok(const Params& p, int T, int ck) {
    const TokInfo ti = tokinfo(T);
    const bf16_t* base = p.h3 + (size_t)(T - ti.s) * 1024 + ck * 8;
    uint4 raw[W];
#pragma unroll
    for (int k = 0; k < W; ++k) {
        const int t2 = ti.s - W / 2 + k;
        raw[k] = (t2 >= 0 && t2 < ti.S) ? *(const uint4*)(base + (size_t)t2 * 1024) : make_uint4(0u, 0u, 0u, 0u);
    }
    float acc[8];
#pragma unroll
    for (int j = 0; j < 8; ++j) acc[j] = 0.f;
#pragma unroll
    for (int k = 0; k < W; ++k) { float f[8]; unpack8(raw[k], f);
#pragma unroll
        for (int j = 0; j < 8; ++j) acc[j] += f[j]; }
    float c[8]; unpack8(raw[W / 2], c);
    const int lo = max(ti.s - W / 2, 0), hi = min(ti.s + W / 2, ti.S);
    const float inv = 1.f / (float)(hi - lo);
    uint4 o;
    o.x = pack_bf16(acc[0] * inv - c[0], acc[1] * inv - c[1]); o.y = pack_bf16(acc[2] * inv - c[2], acc[3] * inv - c[3]);
    o.z = pack_bf16(acc[4] * inv - c[4], acc[5] * inv - c[5]); o.w = pack_bf16(acc[6] * inv - c[6], acc[7] * inv - c[7]);
    *(uint4*)(p.hbuf + (size_t)T * 1024 + ck * 8) = o;
}
__device__ void st_pool(const Params& p) {
    const int tid = tidx(), lane = tid & 63, wv = tid >> 6, g = wv & 3, ck = g * 32 + (lane & 31), tsub = (wv >> 2) * 2 + (lane >> 5);
    const int per = (T_TOK + gridDim.x - 1) / gridDim.x, Tb = blockIdx.x * per, Te = min(Tb + per, T_TOK);
    for (int T = Tb + tsub; T < Te; T += 4) {
        if (g == 0) pool_tok<2>(p, T, ck); else if (g == 1) pool_tok<4>(p, T, ck); else if (g == 2) pool_tok<8>(p, T, ck); else pool_tok<16>(p, T, ck);
    }
}

__device__ void st_gemm_pool(const Params& p) {
    struct OrderPool {
        const char* A; const char* B;
        __device__ __forceinline__ bool next(int i, pg8::Unit& u) const {
            const int item = blockIdx.x + i * gridDim.x; if (item >= 80 * 4) return false;
            const int lt = item >> 3; u.pn = lt & 3; u.pm = (lt >> 2) * 8 + (item & 7);
            u.A = A + (size_t)u.pm * 256 * 1024 * 2 + (size_t)u.pn * 256 * 2; u.B = B + (size_t)u.pn * 256 * 256 * 2; return true;
        }
    } S; S.A = (const char*)p.hbuf; S.B = (const char*)p.wt_pool;
    EpiStoreBf16 E; E.O = p.mix; E.ldc = 1024;
    pg8::gemm_phase<EpiStoreBf16, OrderPool, true, true>((LAS unsigned char*)smem, 1024, 256, 256, S, E);
}

__device__ __forceinline__ void run_stage(const Params& p, int s) {
#ifdef ONLY_STAGE
    if (s != ONLY_STAGE) return;
#endif
    switch (s) {
        case 0: st_prologue(p); break;
        case 1: st_norm<0>(p, 0, 0, p.g_mix[0], p.hbuf); break;
        case 2: st_gemm1(p); break;
        case 3: st_postproj(p); break;
        case 4: st_gemm234(p); break;
        case 18: st_gates(p); break;
        case 5: st_attn_s1(p); break;
        case 6: st_scan3(p); break;
        case 7: st_gemm_o(p); break;
        case 8: st_resnorm<1>(p, 0); break;
        case 9: st_gemm_pq(p, 0); break;
        case 11: st_peer_gather(p, 0); break;
        case 12: st_pool(p); break;
        case 13: st_gemm_pool(p); break;
        case 14: st_resnorm<0>(p, 1); break;
        case 15: st_gemm_pq(p, 1); break;
        case 17: st_peer_gather(p, 1); break;
        default: break;
    }
}

__global__ void __launch_bounds__(NTHR, 2) fwd_mega(Params p) {
    cg::grid_group grid = cg::this_grid();
    volatile LAS unsigned* st = (volatile LAS unsigned*)(smem + 131072);
    if (threadIdx.x == 0) { st[0] = 0; st[1] = 0; st[2] = 0; st[3] = 0; }
    wtab_init();
    __syncthreads();
    XcdBarrier b = xcd_barrier_post(p.bar, st);
    if (p.bar == nullptr) grid.sync();
#ifndef REP_MASK
#define REP_MASK 0
#endif
#define MK_ST(k) run_stage(p, k); if ((REP_MASK >> (k)) & 1) { xcd_barrier(b); run_stage(p, k); } if ((k) != 17) xcd_barrier(b);
    MK_ST(0) MK_ST(1) MK_ST(2) MK_ST(3) run_stage(p, 4); MK_ST(18) MK_ST(5) MK_ST(6) MK_ST(7) MK_ST(8) MK_ST(9) MK_ST(11) MK_ST(12) MK_ST(13) MK_ST(14) MK_ST(15) MK_ST(17)
}

extern "C" void kernel_launch(void* const* d_in, const int* in_sizes, int n_in, void* d_out, int out_size, void* d_ws, size_t ws_size, hipStream_t stream) {
    constexpr size_t kDynLds = 131072 + 512;
    static int grid_blocks = 0;
    if (!grid_blocks) {
        int dev = 0, cus = 0, per_cu = 0;
        (void)hipGetDevice(&dev);
        (void)hipDeviceGetAttribute(&cus, hipDeviceAttributeMultiprocessorCount, dev);
        (void)hipFuncSetAttribute((const void*)fwd_mega, hipFuncAttributeMaxDynamicSharedMemorySize, (int)kDynLds);
        (void)hipOccupancyMaxActiveBlocksPerMultiprocessor(&per_cu, fwd_mega, NTHR, kDynLds);
        if (per_cu > 1) per_cu = 1;
        if (per_cu < 1) per_cu = 1;
        grid_blocks = cus * per_cu;
    }
    Params p{};
    const float* const* in = (const float* const*)d_in;
    p.x_prompt = in[0]; p.x_sample = in[1]; p.cache_ckv = in[2]; p.cache_krope = in[3]; p.state_lru = in[4]; p.c = in[5]; p.c_ctx = in[6];
    p.w_mod[0] = in[7]; p.b_mod[0] = in[8]; p.w_mod[1] = in[9]; p.b_mod[1] = in[10];
    p.g_mix[0] = in[11]; p.g_ffn[0] = in[12]; p.g_mix[1] = in[13]; p.g_ffn[1] = in[14];
    p.w_in = in[15]; p.g_q = in[16]; p.w_uq = in[17]; p.g_kv = in[18]; p.w_ukv = in[19]; p.conv_w = in[20]; p.conv_b = in[21];
    p.w_rg = in[22]; p.b_rg = in[23]; p.w_ig = in[24]; p.b_ig = in[25]; p.lam = in[26]; p.w_o = in[27]; p.w_pool = in[28]; p.s_pool = in[29];
    p.peer_wq[0] = in[30]; p.peer_keys[0] = in[31]; p.peer_u[0] = in[32]; p.peer_v[0] = in[33];
    p.peer_wq[1] = in[34]; p.peer_keys[1] = in[35]; p.peer_u[1] = in[36]; p.peer_v[1] = in[37];
    p.g_final = in[38];
    p.out = (float*)d_out;
    char* base = (char*)d_ws; size_t off = 0;
    auto take = [&](size_t bytes) { char* r = base + off; off += (bytes + 255) & ~(size_t)255; return r; };
    const size_t MiB = 1u << 20;
    p.bar = (unsigned*)take(16384);
    p.mod = (float*)take((size_t)2 * 9 * 6144 * 4);
    p.ropetab = (float*)take(3072 * 4); p.spl = (float*)take(1024 * 4);
    p.wt_in = (bf16_t*)take((size_t)NW_IN * 2); p.wt_uq = (bf16_t*)take((size_t)NW_UQ * 2); p.wt_ukv = (bf16_t*)take((size_t)NW_UKV * 2);
    p.wt_gate = (bf16_t*)take((size_t)NW_GATE * 2); p.wt_o = (bf16_t*)take((size_t)NW_O * 2); p.wt_pool = (bf16_t*)take((size_t)NW_POOL * 2);
    p.wt_pq[0] = (bf16_t*)take((size_t)NW_PQ * 2); p.wt_pq[1] = (bf16_t*)take((size_t)NW_PQ * 2);
    p.keysb[0] = (bf16_t*)take((size_t)NW_KEYS * 2); p.keysb[1] = (bf16_t*)take((size_t)NW_KEYS * 2);
    for (int l = 0; l < 2; ++l) { p.u8[l] = (u8_t*)take(16 * MiB); p.v8[l] = (u8_t*)take(16 * MiB); p.su[l] = (float*)take(65536); p.sv[l] = (float*)take(65536); }
    char* regX = take(80 * MiB);
    char* regQ = take(80 * MiB);
    char* regH = take(40 * MiB);
    p.P = (bf16_t*)regX; p.a = (float*)regX; p.a1m = (bf16_t*)regX; p.xres = (float*)regX;
    p.bxb = (bf16_t*)regQ; p.q = (bf16_t*)(regQ + 40 * MiB); p.agg = (float*)(regQ + 70 * MiB); p.qp = (bf16_t*)regQ; p.h3 = (bf16_t*)regQ;
    p.hbuf = (bf16_t*)regH;
    p.cqn = (bf16_t*)take((size_t)T_TOK * 384 * 2); p.ckvk = (bf16_t*)take((size_t)R_KEYS * 256 * 2); p.kropek = (bf16_t*)take((size_t)R_KEYS * 64 * 2);
    p.xc = (bf16_t*)take((size_t)T_TOK * 512 * 2); p.ug = (bf16_t*)take((size_t)T_TOK * 512 * 2);
    p.mix = p.xc;
    p.Kn = (bf16_t*)take((size_t)R_KEYS * 512 * 2); p.vT = (bf16_t*)take((size_t)R_KEYS * 512 * 2);
    p.zbuf = (float*)p.vT; p.wbuf = p.zbuf + (size_t)T_TOK * 128;
    p.hqh = (unsigned*)p.cqn; p.hql = (unsigned*)p.ckvk; p.hsc = (float*)p.kropek;
    p.gates = (float*)p.Kn; p.eidx = (int*)((char*)p.Kn + (size_t)T_TOK * 128 * 4);
    if (off > ws_size) fprintf(stderr, "workspace too small: need %zu have %zu\n", off, ws_size);
    (void)hipMemsetAsync(d_ws, 0, 16384, stream);
    void* args[] = {&p};
    hipError_t e = hipLaunchCooperativeKernel((void*)fwd_mega, dim3(grid_blocks), dim3(NTHR), args, kDynLds, stream);
    if (e != hipSuccess) fprintf(stderr, "cooperative launch failed: %s (grid %d)\n", hipGetErrorString(e), grid_blocks);
}
```

```cpp
#include <hip/hip_runtime.h>
#include <hip/hip_cooperative_groups.h>
#include <cstdio>
#include <cstdint>
namespace cg = cooperative_groups;


typedef unsigned short bf16_t;
typedef unsigned char u8_t;
typedef float f32x16 __attribute__((ext_vector_type(16)));
typedef float f32x2 __attribute__((ext_vector_type(2)));
typedef unsigned u32x4 __attribute__((ext_vector_type(4)));
typedef float f32x4v __attribute__((ext_vector_type(4)));

#define T_TOK 20480
#define T_CTX 4096
#define R_KEYS 22528
#define NSTAGE 19
#define NTHR 512
#define NWV 8
#define LAS __attribute__((address_space(3)))

#define XB_TMO      128
#define XB_XCNT(j)  (256  + 64 * (j))
#define XB_XSUB(j)  (1280 + 64 * (j))
#define XB_XGEN(j)  (2304 + 64 * (j))
#define XB_TOP      3328
#define XB_TOPGEN   3392
#define XCD_BAR_WORDS 3456
#define XB_SPIN_CAP (1u << 22)
__device__ __forceinline__ unsigned xb_ld(unsigned* p)              { return __hip_atomic_load(p, __ATOMIC_RELAXED, __HIP_MEMORY_SCOPE_AGENT); }
__device__ __forceinline__ unsigned xb_add(unsigned* p, unsigned v) { return __hip_atomic_fetch_add(p, v, __ATOMIC_RELAXED, __HIP_MEMORY_SCOPE_AGENT); }
__device__ __forceinline__ unsigned xb_xcc_id() { return (unsigned)__builtin_amdgcn_s_getreg((3 << 11) | 20) & 0xFu; }
#define XB_SPIN(cond, bar) do { unsigned _sp = 0; while (cond) { __builtin_amdgcn_s_sleep(1); \
    if ((++_sp & 255u) == 0u) { if (xb_ld(&(bar)[XB_TMO])) break; if (_sp > XB_SPIN_CAP) { atomicAdd(&(bar)[XB_TMO], 1u); break; } } } } while (0)
struct XcdBarrier { unsigned* bar; unsigned x; volatile LAS unsigned* st; };
__device__ __forceinline__ XcdBarrier xcd_barrier_post(unsigned* bar, volatile LAS unsigned* st) {
    XcdBarrier b; b.bar = bar; b.x = xb_xcc_id(); b.st = st;
    if (threadIdx.x == 0) (void)xb_add(&bar[XB_XCNT(b.x)], 1u);
    return b;
}
__device__ __forceinline__ void xcd_barrier_complete(unsigned* bar, unsigned x, unsigned& nloc, unsigned& nx) {
    const unsigned G = gridDim.x * gridDim.y * gridDim.z;
    unsigned sum, cnt, mine, sp = 0u;
    for (;;) {
        sum = 0u; cnt = 0u; mine = 0u;
#pragma unroll
        for (unsigned j = 0; j < 16; ++j) { const unsigned c = xb_ld(&bar[XB_XCNT(j)]); sum += c; cnt += (c > 0u) ? 1u : 0u; mine = (j == x) ? c : mine; }
        if (sum == G) break;
        __builtin_amdgcn_s_sleep(1);
        if ((++sp & 255u) == 0u) { if (xb_ld(&bar[XB_TMO])) break; if (sp > XB_SPIN_CAP) { atomicAdd(&bar[XB_TMO], 1u); break; } }
    }
    nloc = mine > 0u ? mine : 1u; nx = cnt > 0u ? cnt : 1u;
}
__device__ __forceinline__ int tidx();
__device__ __forceinline__ void xcd_barrier(const XcdBarrier& b) {
    asm volatile("s_waitcnt vmcnt(0)" ::: "memory");
    __syncthreads();
    if (tidx() == 0) {
        unsigned* bar = b.bar;
        __builtin_amdgcn_s_waitcnt(0);
        unsigned nloc = b.st[0], nx = b.st[1];
        if (nloc == 0u) { xcd_barrier_complete(bar, b.x, nloc, nx); b.st[0] = nloc; b.st[1] = nx; }
        const unsigned old = xb_add(&bar[XB_XSUB(b.x)], 1u);
        const unsigned gen = old / nloc;
        if (old + 1u == (gen + 1u) * nloc) {
            __builtin_amdgcn_fence(__ATOMIC_RELEASE, "agent");
            asm volatile("s_waitcnt vmcnt(0)" ::: "memory");
            const unsigned og = xb_add(&bar[XB_TOP], 1u);
            const unsigned tg = og / nx;
            if (og + 1u == (tg + 1u) * nx) xb_add(&bar[XB_TOPGEN], 1u);
            else XB_SPIN(xb_ld(&bar[XB_TOPGEN]) == tg, bar);
            __builtin_amdgcn_fence(__ATOMIC_ACQUIRE, "agent");
            xb_add(&bar[XB_XGEN(b.x)], 1u);
            asm volatile("s_waitcnt vmcnt(0)" ::: "memory");
        } else {
            XB_SPIN(xb_ld(&bar[XB_XGEN(b.x)]) == gen, bar);
            __builtin_amdgcn_fence(__ATOMIC_ACQUIRE, "agent");
            asm volatile("s_waitcnt vmcnt(0)" ::: "memory");
        }
    }
    __syncthreads();
}

struct Params {
    const float *x_prompt, *x_sample, *cache_ckv, *cache_krope, *state_lru, *c, *c_ctx;
    const float *w_mod[2], *b_mod[2], *g_mix[2], *g_ffn[2];
    const float *w_in, *g_q, *w_uq, *g_kv, *w_ukv, *conv_w, *conv_b, *w_rg, *b_rg, *w_ig, *b_ig, *lam, *w_o, *w_pool, *s_pool;
    const float *peer_wq[2], *peer_keys[2], *peer_u[2], *peer_v[2];
    const float* g_final;
    float* out;
    unsigned* bar; float* mod; float* ropetab;
    bf16_t *wt_in, *wt_uq, *wt_ukv, *wt_gate, *wt_o, *wt_pool, *wt_pq[2], *keysb[2];
    u8_t *u8[2], *v8[2]; float *su[2], *sv[2];
    bf16_t *hbuf, *P, *cqn, *ckvk, *kropek, *xc, *ug, *q, *Kn, *vT, *bxb, *qp, *h3;
    float *a, *agg, *gates; int* eidx; bf16_t* xres;
    bf16_t* mix; float *zbuf, *wbuf; unsigned *hqh, *hql; float* hsc; float* spl; bf16_t* a1m;
};

extern __shared__ __attribute__((aligned(16))) unsigned char smem[];
#define WTAB_OFF (131072 + 64)
__device__ __forceinline__ int hw_wave_slot() { return (int)(__builtin_amdgcn_s_getreg(0x2804) & 63u); }
__device__ __forceinline__ void wtab_init() { if ((threadIdx.x & 63) == 0) ((volatile int*)(smem + WTAB_OFF))[hw_wave_slot()] = (int)(threadIdx.x >> 6); }
__device__ __forceinline__ int tidx() {
    const int w = __builtin_amdgcn_readfirstlane(((volatile int*)(smem + WTAB_OFF))[hw_wave_slot()]);
    return (w << 6) | (int)__builtin_amdgcn_mbcnt_hi(~0u, __builtin_amdgcn_mbcnt_lo(~0u, 0u));
}
__device__ __forceinline__ float bf2f(bf16_t v) { return __uint_as_float(((unsigned)v) << 16); }
typedef __bf16 bf16x2_t __attribute__((ext_vector_type(2)));
__device__ __forceinline__ bf16_t f2bf(float f) { return __builtin_bit_cast(unsigned short, (__bf16)f); }
__device__ __forceinline__ unsigned pack_bf16(float a, float b) { bf16x2_t v = {(__bf16)a, (__bf16)b}; return __builtin_bit_cast(unsigned, v); }
typedef unsigned u32x2 __attribute__((ext_vector_type(2)));
#define DPP_F(v, ctrl) __int_as_float(__builtin_amdgcn_update_dpp(0, __float_as_int(v), ctrl, 0xf, 0xf, true))
__device__ __forceinline__ float wave_sum(float v) {
    v += DPP_F(v, 0xB1); v += DPP_F(v, 0x4E); v += DPP_F(v, 0x141); v += DPP_F(v, 0x128);
    u32x2 r = __builtin_amdgcn_permlane16_swap(__float_as_uint(v), __float_as_uint(v), false, false);
    v = __uint_as_float(r[0]) + __uint_as_float(r[1]);
    r = __builtin_amdgcn_permlane32_swap(__float_as_uint(v), __float_as_uint(v), false, false);
    return __uint_as_float(r[0]) + __uint_as_float(r[1]);
}
__device__ __forceinline__ float wave_max(float v) {
    v = fmaxf(v, DPP_F(v, 0xB1)); v = fmaxf(v, DPP_F(v, 0x4E)); v = fmaxf(v, DPP_F(v, 0x141)); v = fmaxf(v, DPP_F(v, 0x128));
    u32x2 r = __builtin_amdgcn_permlane16_swap(__float_as_uint(v), __float_as_uint(v), false, false);
    v = fmaxf(__uint_as_float(r[0]), __uint_as_float(r[1]));
    r = __builtin_amdgcn_permlane32_swap(__float_as_uint(v), __float_as_uint(v), false, false);
    return fmaxf(__uint_as_float(r[0]), __uint_as_float(r[1]));
}
__device__ __forceinline__ float gelu_tanh(float x) {
    const float u = 0.7978845608028654f * (x + 0.044715f * x * x * x);
    const float e = __expf(2.f * u);
    const float th = 1.f - 2.f / (e + 1.f);
    return 0.5f * x * (1.f + th);
}
__device__ __forceinline__ float sigmoidf_(float x) { return 1.f / (1.f + __expf(-x)); }
__device__ __forceinline__ float silu_(float x) { return x / (1.f + __expf(-x)); }

struct TokInfo { int smp, b, s, S, mi, keyrow; };
__device__ __forceinline__ TokInfo tokinfo(int T) {
    TokInfo t;
    if (T < T_CTX) { t.smp = 0; t.b = T >> 8; t.s = T & 255; t.S = 256; t.mi = 0; t.keyrow = T; }
    else { const int u = T - T_CTX; t.smp = 1; t.b = u >> 11; t.s = u & 2047; t.S = 2048; t.mi = 1 + t.b; t.keyrow = T_CTX + t.b * 2304 + 256 + t.s; }
    return t;
}
__device__ __forceinline__ const float* x_in_row(const Params& p, int T) { return T < T_CTX ? p.x_prompt + (size_t)T * 1024 : p.x_sample + (size_t)(T - T_CTX) * 1024; }
__device__ __forceinline__ const float* modv(const Params& p, int l, int mi, int j) { return p.mod + ((size_t)(l * 9 + mi) * 6 + j) * 1024; }

__device__ __forceinline__ void unpack8(const uint4 r, float (&f)[8]) {
    f[0] = __uint_as_float(r.x << 16); f[1] = __uint_as_float(r.x & 0xffff0000u);
    f[2] = __uint_as_float(r.y << 16); f[3] = __uint_as_float(r.y & 0xffff0000u);
    f[4] = __uint_as_float(r.z << 16); f[5] = __uint_as_float(r.z & 0xffff0000u);
    f[6] = __uint_as_float(r.w << 16); f[7] = __uint_as_float(r.w & 0xffff0000u);
}

namespace pg8 {
typedef short bf16x8 __attribute__((ext_vector_type(8)));
typedef float f32x4 __attribute__((ext_vector_type(4)));
constexpr int BM = 256, BK = 64, HALF = 128, HTB = HALF * BK * 2  , STAGE_BYTES = 8 * HTB;
__device__ __forceinline__ int lds_byte(int r, int c) { const int st = (r >> 4) * 2 + (c >> 5), rr = r & 15, cc = c & 31, ob = rr * 64 + cc * 2; return st * 1024 + (ob ^ (((ob >> 9) & 1) << 5)); }
__device__ __forceinline__ void stage_rc(int b, int& R, int& C) { const int st = b / 1024, sb = b % 1024, swz = sb ^ (((sb >> 9) & 1) << 5); R = (st >> 1) * 16 + swz / 64; C = (st & 1) * 32 + (swz % 64) / 2; }
__device__ __forceinline__ int perm32(int rho) { const int n = rho >> 4, i = rho & 15; return 8 * (i >> 2) + 4 * n + (i & 3); }
struct Unit { int pm, pn; const char* A; const char* B; };
template <class Epi, class Sched, bool ALIGN_EPI, bool SP2>
__device__ __forceinline__ void gemm_phase(LAS unsigned char* lds, const int lda, const int ldb, const int K, const Sched& S, const Epi& E) {
    __builtin_amdgcn_sched_barrier(0);
    const int tid = tidx(), wid = __builtin_amdgcn_readfirstlane(tid >> 6), lane = tid & 63, wr = wid >> 2, wc = wid & 3, fr = lane & 15, fq = lane >> 4;
    const int nt = K / BK;
    unsigned voffA[2], voffB[2];
#pragma unroll
    for (int i = 0; i < 2; ++i) { int R, C; stage_rc(tid * 16 + i * 8192, R, C); const int Rb = Epi::PERM ? ((R & ~31) + perm32(R & 31)) : R;
        voffA[i] = (unsigned)(R * lda + C) * 2u; voffB[i] = (unsigned)(Rb * ldb + C) * 2u; }
    const size_t kstep = (size_t)(BK * 2);
    const size_t hstepA = (size_t)HALF * lda * 2, hstepB = (size_t)HALF * ldb * 2;
    const unsigned ldsw = (unsigned)wid * 1024u;
    const int aoff = lds_byte(wr * 64 + fr, fq * 8), boff = lds_byte(wc * 32 + fr, fq * 8);
#define PG8_SA(b, h) (((b) * 2 + (h)) * HTB)
#define PG8_SB(b, h) ((4 + (b) * 2 + (h)) * HTB)
#define PG8_STAGE(bufoff, gbase, voff) do { _Pragma("unroll") for (int _i = 0; _i < 2; ++_i) \
        __builtin_amdgcn_global_load_lds((const unsigned*)((const char*)(gbase) + (voff)[_i]), (LAS unsigned*)(lds + (bufoff) + ldsw + _i * 8192), 16, 0, 0); } while (0)
#define PG8_LDA(dst, b, h) do { _Pragma("unroll") for (int m = 0; m < 4; ++m) _Pragma("unroll") for (int k = 0; k < 2; ++k) dst[m][k] = *(const LAS bf16x8*)(lds + PG8_SA(b, h) + aoff + m * 2048 + k * 1024); } while (0)
#define PG8_LDB(dst, b, h) do { _Pragma("unroll") for (int n = 0; n < 2; ++n) _Pragma("unroll") for (int k = 0; k < 2; ++k) dst[n][k] = *(const LAS bf16x8*)(lds + PG8_SB(b, h) + boff + n * 2048 + k * 1024); } while (0)
#define PG8_MMA(ai, bj, At, Bt) do { __builtin_amdgcn_s_setprio(1); _Pragma("unroll") for (int m = 0; m < 4; ++m) _Pragma("unroll") for (int n = 0; n < 2; ++n) _Pragma("unroll") for (int k = 0; k < 2; ++k) \
        acc[ai][bj][m][n] = __builtin_amdgcn_mfma_f32_16x16x32_bf16(Bt[n][k], At[m][k], acc[ai][bj][m][n], 0, 0, 0); __builtin_amdgcn_s_setprio(0); } while (0)
#define PG8_WAIT_V(n) asm volatile("s_waitcnt vmcnt(" #n ")" ::: "memory")
#define PG8_WAIT_L(n) asm volatile("s_waitcnt lgkmcnt(" #n ")" ::: "memory")
#define PG8_BAR __builtin_amdgcn_s_barrier()
#define PG8_SCHED __builtin_amdgcn_sched_barrier(0)
    Unit cur, nxt; int ui = 0;
    if (!S.next(0, cur)) return;
    f32x4 acc[2][2][4][2];
#pragma unroll
    for (int a = 0; a < 2; ++a)
#pragma unroll
        for (int b = 0; b < 2; ++b)
#pragma unroll
            for (int m = 0; m < 4; ++m)
#pragma unroll
                for (int n = 0; n < 2; ++n) acc[a][b][m][n] = (f32x4){0.f, 0.f, 0.f, 0.f};
    bf16x8 At[4][2], B0[2][2], B1[2][2];
    const char* cA = cur.A; const char* cB = cur.B;
    if constexpr (SP2) {
        PG8_STAGE(PG8_SB(0, 0), cB, voffB); PG8_STAGE(PG8_SB(0, 1), cB + hstepB, voffB); PG8_STAGE(PG8_SA(0, 0), cA, voffA); PG8_STAGE(PG8_SA(0, 1), cA + hstepA, voffA);
        if (wr == 1) PG8_BAR;
        PG8_WAIT_V(2); PG8_BAR;
        PG8_STAGE(PG8_SB(1, 0), cB + kstep, voffB); PG8_STAGE(PG8_SA(1, 0), cA + kstep, voffA); PG8_STAGE(PG8_SB(1, 1), cB + hstepB + kstep, voffB);
        PG8_WAIT_V(6); PG8_BAR;
    } else {
        PG8_STAGE(PG8_SB(0, 0), cB, voffB); PG8_STAGE(PG8_SA(0, 0), cA, voffA); PG8_STAGE(PG8_SB(0, 1), cB + hstepB, voffB); PG8_STAGE(PG8_SA(0, 1), cA + hstepA, voffA);
        if (wr == 1) PG8_BAR;
        PG8_WAIT_V(4); PG8_BAR;
        PG8_STAGE(PG8_SB(1, 0), cB + kstep, voffB); PG8_STAGE(PG8_SA(1, 0), cA + kstep, voffA); PG8_STAGE(PG8_SB(1, 1), cB + hstepB + kstep, voffB);
        PG8_WAIT_V(6); PG8_BAR;
    }
    for (;;) {
        const bool has_next = S.next(ui + 1, nxt);
        const char* nA = has_next ? nxt.A : cA; const char* nB = has_next ? nxt.B : cB;
#pragma unroll 1
        for (int t = 0; t < nt; t += 2) {
            const bool last = (t == nt - 2);
            const char* a1 = cA + (size_t)(t + 1) * kstep;
            const char* a2 = last ? nA : cA + (size_t)(t + 2) * kstep; const char* b2 = last ? nB : cB + (size_t)(t + 2) * kstep;
            const char* a3 = a2 + kstep; const char* b3 = b2 + kstep;
            if constexpr (SP2) {
            PG8_LDB(B0, 0, 0); PG8_LDB(B1, 0, 1); PG8_SCHED; PG8_LDA(At, 0, 0); PG8_STAGE(PG8_SA(1, 1), a1 + hstepA, voffA);
            PG8_WAIT_V(8); PG8_WAIT_L(0); PG8_BAR; PG8_MMA(0, 0, At, B0); PG8_MMA(0, 1, At, B1); PG8_BAR; PG8_SCHED;
            PG8_LDA(At, 0, 1); PG8_STAGE(PG8_SB(0, 0), b2, voffB); PG8_STAGE(PG8_SB(0, 1), b2 + hstepB, voffB); PG8_STAGE(PG8_SA(0, 0), a2, voffA);
            PG8_WAIT_V(8); PG8_WAIT_L(0); PG8_BAR; PG8_MMA(1, 0, At, B0); PG8_MMA(1, 1, At, B1); PG8_BAR; PG8_SCHED;
            PG8_LDB(B0, 1, 0); PG8_LDB(B1, 1, 1); PG8_SCHED; PG8_LDA(At, 1, 0); PG8_STAGE(PG8_SA(0, 1), a2 + hstepA, voffA);
            PG8_WAIT_V(8); PG8_WAIT_L(0); PG8_BAR; PG8_MMA(0, 0, At, B0); PG8_MMA(0, 1, At, B1); PG8_BAR; PG8_SCHED;
            PG8_LDA(At, 1, 1); PG8_STAGE(PG8_SB(1, 0), b3, voffB); PG8_STAGE(PG8_SB(1, 1), b3 + hstepB, voffB); PG8_STAGE(PG8_SA(1, 0), a3, voffA);
            PG8_WAIT_V(8); PG8_WAIT_L(0); PG8_BAR; PG8_MMA(1, 0, At, B0); PG8_MMA(1, 1, At, B1); PG8_BAR; PG8_SCHED;
            } else {
            PG8_LDB(B0, 0, 0); PG8_SCHED; PG8_LDA(At, 0, 0); PG8_STAGE(PG8_SA(1, 1), a1 + hstepA, voffA);
            PG8_WAIT_L(8); PG8_BAR; PG8_WAIT_L(0); PG8_MMA(0, 0, At, B0); PG8_BAR; PG8_SCHED;
            PG8_LDB(B1, 0, 1); PG8_STAGE(PG8_SB(0, 0), b2, voffB);
            PG8_BAR; PG8_WAIT_L(0); PG8_MMA(0, 1, At, B1); PG8_BAR;
            PG8_LDA(At, 0, 1); PG8_STAGE(PG8_SA(0, 0), a2, voffA);
            PG8_BAR; PG8_WAIT_L(0); PG8_MMA(1, 0, At, B0); PG8_BAR; PG8_SCHED;
            PG8_STAGE(PG8_SB(0, 1), b2 + hstepB, voffB);
            PG8_WAIT_V(6); PG8_BAR; PG8_MMA(1, 1, At, B1); PG8_BAR;
            PG8_LDB(B0, 1, 0); PG8_SCHED; PG8_LDA(At, 1, 0); PG8_STAGE(PG8_SA(0, 1), a2 + hstepA, voffA);
            PG8_WAIT_L(8); PG8_BAR; PG8_WAIT_L(0); PG8_MMA(0, 0, At, B0); PG8_BAR; PG8_SCHED;
            PG8_LDB(B1, 1, 1); PG8_STAGE(PG8_SB(1, 0), b3, voffB);
            PG8_BAR; PG8_WAIT_L(0); PG8_MMA(0, 1, At, B1); PG8_BAR;
            PG8_LDA(At, 1, 1); PG8_STAGE(PG8_SA(1, 0), a3, voffA);
            PG8_BAR; PG8_WAIT_L(0); PG8_MMA(1, 0, At, B0); PG8_BAR; PG8_SCHED;
            PG8_STAGE(PG8_SB(1, 1), b3 + hstepB, voffB);
            PG8_WAIT_V(6); PG8_BAR; PG8_MMA(1, 1, At, B1); PG8_BAR;
            }
        }
        if constexpr (ALIGN_EPI) { if (wr == 0) PG8_BAR; }
        E(acc, cur, wr, wc, fr, fq);
        if (!has_next) break;
#pragma unroll
        for (int a = 0; a < 2; ++a)
#pragma unroll
            for (int b = 0; b < 2; ++b)
#pragma unroll
                for (int m = 0; m < 4; ++m)
#pragma unroll
                    for (int n = 0; n < 2; ++n) acc[a][b][m][n] = (f32x4){0.f, 0.f, 0.f, 0.f};
        cur = nxt; cA = nA; cB = nB; ++ui;
        if constexpr (ALIGN_EPI) { if (wr == 1) PG8_BAR; }
    }
    PG8_WAIT_V(0);
    if constexpr (!ALIGN_EPI) { if (wr == 0) PG8_BAR; }
    PG8_BAR;
    __builtin_amdgcn_sched_barrier(0);
#undef PG8_SA
#undef PG8_SB
#undef PG8_STAGE
#undef PG8_LDA
#undef PG8_LDB
#undef PG8_MMA
#undef PG8_WAIT_V
#undef PG8_WAIT_L
#undef PG8_BAR
#undef PG8_SCHED
}
struct TileOrder {
    int nN, total; const char* A; const char* B; size_t tA, tB;
    __device__ __forceinline__ bool next(int i, Unit& u) const {
        const int item = blockIdx.x + i * gridDim.x; if (item >= total) return false;
        const int lt = item >> 3; u.pn = lt % nN; u.pm = (lt / nN) * 8 + (item & 7);
        u.A = A + (size_t)u.pm * tA; u.B = B + (size_t)u.pn * tB; return true;
    }
};
}

typedef __bf16 bf16x8_t __attribute__((ext_vector_type(8)));
__device__ __forceinline__ int lds_off(int row, int chunk) { return row * 128 + ((chunk ^ ((row >> 1) & 7)) << 4); }
template <int TM, int TN, int WM, int WN>
__device__ __forceinline__ void gemm_acc(const bf16_t* __restrict__ As, int lda, const bf16_t* __restrict__ Bs, int ldb, int K, f32x16 (&acc)[TM][TN]) {
    static_assert(TM * WM == 4 && TN * WN == 4 && WM * WN == 4, "tile is 128 x 128, 4 waves");
    const int tid = tidx() & 255, lane = tid & 63, wid = tid >> 6, wm = wid / WN, wn = wid % WN, hl = lane >> 5, cl = lane & 31;
    unsigned char* sm = smem + (tidx() >> 8) * 65536;
#pragma unroll
    for (int i = 0; i < TM; ++i)
#pragma unroll
        for (int j = 0; j < TN; ++j)
#pragma unroll
            for (int r = 0; r < 16; ++r) acc[i][j][r] = 0.f;
    const int srow0 = wid * 32 + (lane >> 3), pc = lane & 7;
    const bf16_t* ga[4]; const bf16_t* gb[4];
#pragma unroll
    for (int i = 0; i < 4; ++i) {
        const int row = srow0 + 8 * i, lc = pc ^ ((row >> 1) & 7);
        ga[i] = As + (size_t)row * lda + lc * 8; gb[i] = Bs + (size_t)row * ldb + lc * 8;
    }
    unsigned char* lbase = sm + wid * 4096 + lane * 16;
    __syncthreads();
#pragma unroll
    for (int i = 0; i < 4; ++i) {
        __builtin_amdgcn_global_load_lds((const unsigned*)ga[i], (unsigned*)(lbase + i * 1024), 16, 0, 0);
        __builtin_amdgcn_global_load_lds((const unsigned*)gb[i], (unsigned*)(lbase + 16384 + i * 1024), 16, 0, 0);
    }
    asm volatile("s_waitcnt vmcnt(0)" ::: "memory");
    __syncthreads();
    const int nk = K >> 6;
    for (int kt = 0; kt < nk; ++kt) {
        const int cur = (kt & 1) * 32768, nxt = 32768 - cur;
        if (kt + 1 < nk) {
#pragma unroll
            for (int i = 0; i < 4; ++i) {
                __builtin_amdgcn_global_load_lds((const unsigned*)(ga[i] + (kt + 1) * 64), (unsigned*)(lbase + nxt + i * 1024), 16, 0, 0);
                __builtin_amdgcn_global_load_lds((const unsigned*)(gb[i] + (kt + 1) * 64), (unsigned*)(lbase + nxt + 16384 + i * 1024), 16, 0, 0);
            }
        }
#pragma unroll
        for (int ks = 0; ks < 4; ++ks) {
            bf16x8_t af[TM], bfr[TN];
#pragma unroll
            for (int i = 0; i < TM; ++i) af[i] = __builtin_bit_cast(bf16x8_t, *(const u32x4*)(sm + cur + lds_off(32 * (TM * wm + i) + cl, 2 * ks + hl)));
#pragma unroll
            for (int j = 0; j < TN; ++j) bfr[j] = __builtin_bit_cast(bf16x8_t, *(const u32x4*)(sm + cur + 16384 + lds_off(32 * (TN * wn + j) + cl, 2 * ks + hl)));
#pragma unroll
            for (int i = 0; i < TM; ++i)
#pragma unroll
                for (int j = 0; j < TN; ++j) acc[i][j] = __builtin_amdgcn_mfma_f32_32x32x16_bf16(af[i], bfr[j], acc[i][j], 0, 0, 0);
        }
        asm volatile("s_waitcnt vmcnt(0)" ::: "memory");
        __syncthreads();
    }
}
#define ACC_ROW(TMv, wm, i, r, hl) (32 * ((TMv) * (wm) + (i)) + ((r) & 3) + 8 * ((r) >> 2) + 4 * (hl))
#define ACC_COL(TNv, wn, j, cl)    (32 * ((TNv) * (wn) + (j)) + (cl))

#define N_ADA 384
#define NW_IN   (1792 * 1024)
#define NW_UQ   (768 * 384)
#define NW_UKV  (1024 * 256)
#define NW_GATE (4 * 512 * 128)
#define NW_O    (1024 * 1024)
#define NW_POOL (4 * 256 * 256)
#define NW_PQ   (2048 * 1024)
#define NW_KEYS (16 * 128 * 128)
#define NW_CKV  (8 * 256 * 256)
#define NW_CKR  (8 * 256 * 64)
#define NW_ROPE 3072
#define NW_SP 1024
#define NT_IN 448
#define NT_UQ 72
#define NT_UKV 64
#define NT_O 256
#define NT_POOL 64
#define NT_PQ 512
#define N_TR (NT_IN + NT_UQ + NT_UKV + NT_O + NT_POOL + 2 * NT_PQ)
#define NE_TOTAL (NW_GATE + 2 * NW_KEYS + NW_CKV + NW_CKR + NW_ROPE + NW_SP)
#define N_CONV_ITEMS ((NE_TOTAL + 4095) / 4096)
#define N_FP8_ITEMS (65536 / NWV / 4)

__device__ __forceinline__ void conv_elem(const Params& p, int e) {
    if (e < NW_GATE) {
        const int c = e & 127, cg = (e >> 7) & 511, nb = e >> 16;
        const int dir = cg >> 8, dg = (cg >> 6) & 3, ri = (cg >> 5) & 1, d = dg * 32 + (cg & 31);
        const float* src = ri ? p.w_ig : p.w_rg;
        p.wt_gate[e] = f2bf(src[(((size_t)dir * 4 + nb) * 128 + c) * 128 + d]); return; } e -= NW_GATE;
#pragma unroll
    for (int l = 0; l < 2; ++l) { if (e < NW_KEYS) { p.keysb[l][e] = f2bf(p.peer_keys[l][e]); return; } e -= NW_KEYS; }
    if (e < NW_CKV) { const int col = e & 255, j = (e >> 8) & 255, b = e >> 16; p.ckvk[(size_t)(T_CTX + b * 2304 + j) * 256 + col] = f2bf(p.cache_ckv[e]); return; } e -= NW_CKV;
    if (e < NW_CKR) { const int col = e & 63, j = (e >> 6) & 255, b = e >> 14; p.kropek[(size_t)(T_CTX + b * 2304 + j) * 64 + col] = f2bf(p.cache_krope[e]); return; } e -= NW_CKR;
    if (e < NW_ROPE) {
        int idx = e, isrow = e < 1024; if (!isrow) idx -= 1024;
        const int half = isrow ? 512 : 1024; const int sn = idx >= half; if (sn) idx -= half;
        const int pos = idx >> 4, fi = idx & 15;
        const float invf = exp2f(-(float)fi * (13.287712379549449f / 16.f));
        const float ang = (float)pos * invf;
        p.ropetab[e] = sn ? sinf(ang) : cosf(ang); return; } e -= NW_ROPE;
    if (e < NW_SP) { const float nl = -p.lam[e]; p.spl[e] = fmaxf(nl, 0.f) + log1pf(__expf(-fabsf(nl))); return; }
}
__device__ __forceinline__ void tr_tile(const float* __restrict__ src, int ldsrc, int nvalid, bf16_t* __restrict__ dst, int lddst, int k0, int n0, float scl = 1.f) {
    float* tile = (float*)(smem + (tidx() >> 8) * 32768);
    const int tid = tidx() & 255;
    __syncthreads();
#pragma unroll
    for (int i = 0; i < 4; ++i) {
        const int k = (tid >> 4) + 16 * i, n = (tid & 15) * 4;
        float4 v = make_float4(0.f, 0.f, 0.f, 0.f);
        if (n0 + n < nvalid) v = *(const float4*)(src + (size_t)(k0 + k) * ldsrc + n0 + n);
        tile[k * 65 + n] = v.x; tile[k * 65 + n + 1] = v.y; tile[k * 65 + n + 2] = v.z; tile[k * 65 + n + 3] = v.w;
    }
    __syncthreads();
    const int n = tid >> 2, kq = (tid & 3) * 16;
    unsigned w[8];
#pragma unroll
    for (int j = 0; j < 8; ++j) w[j] = pack_bf16(tile[(kq + 2 * j) * 65 + n] * scl, tile[(kq + 2 * j + 1) * 65 + n] * scl);
    uint4* d = (uint4*)(dst + (size_t)(n0 + n) * lddst + k0 + kq);
    d[0] = make_uint4(w[0], w[1], w[2], w[3]); d[1] = make_uint4(w[4], w[5], w[6], w[7]);
}
__device__ __forceinline__ void tr_item(const Params& p, int t) {
    if (t < NT_IN) { tr_tile(p.w_in, 1728, 1728, p.wt_in, 1024, (t % 16) * 64, (t / 16) * 64); return; } t -= NT_IN;
    if (t < NT_UQ) { tr_tile(p.w_uq, 768, 768, p.wt_uq, 384, (t % 6) * 64, (t / 6) * 64, 0.07216878364870322f * 1.4426950408889634f  ); return; } t -= NT_UQ;
    if (t < NT_UKV) {
        const int n0 = (t / 4) * 64, h = n0 >> 8, kv = (n0 >> 7) & 1, nn = kv * 512 + h * 128 + (n0 & 127);
        tr_tile(p.w_ukv, 1024, 1024, p.wt_ukv + ((ptrdiff_t)nn - n0) * 256, 256, (t % 4) * 64, n0); return; } t -= NT_UKV;
    if (t < NT_O) { tr_tile(p.w_o, 1024, 1024, p.wt_o, 1024, (t % 16) * 64, (t / 16) * 64); return; } t -= NT_O;
    if (t < NT_POOL) { const int g = t >> 4, tt = t & 15; tr_tile(p.w_pool + (size_t)g * 65536, 256, 256, p.wt_pool + (size_t)g * 65536, 256, (tt & 3) * 64, (tt >> 2) * 64); return; } t -= NT_POOL;
    if (t < NT_PQ) { tr_tile(p.peer_wq[0], 2048, 2048, p.wt_pq[0], 1024, (t % 16) * 64, (t / 16) * 64); return; } t -= NT_PQ;
    tr_tile(p.peer_wq[1], 2048, 2048, p.wt_pq[1], 1024, (t % 16) * 64, (t / 16) * 64);
}

__device__ void st_prologue(const Params& p) {
    const int tid = tidx(), lane = tid & 63, wid = tid >> 6;
    const int n_items = N_ADA + N_TR / 2 + N_CONV_ITEMS + N_FP8_ITEMS;
    for (int item = blockIdx.x; item < n_items; item += gridDim.x) {
        if (item < N_ADA) {
            float* svec = (float*)smem;
            float* red = (float*)(smem + 9 * 4096);
            __syncthreads();
            for (int i = tid; i < 9 * 1024; i += NTHR) { const int bc = i >> 10, k = i & 1023; const float cv = bc == 0 ? p.c_ctx[k] : p.c[(size_t)(bc - 1) * 1024 + k]; svec[i] = silu_(cv); }
            __syncthreads();
            const int cidx = item * 32 + (lane & 7) * 4, l = cidx / 6144, col = cidx % 6144, k0 = (wid * 8 + (lane >> 3)) * 16;
            const float* w = p.w_mod[l] + (size_t)k0 * 6144 + col;
            float acc[9][4];
#pragma unroll
            for (int b = 0; b < 9; ++b) { acc[b][0] = 0.f; acc[b][1] = 0.f; acc[b][2] = 0.f; acc[b][3] = 0.f; }
#pragma unroll 8
            for (int k = 0; k < 16; ++k) {
                const float4 wv = *(const float4*)(w + (size_t)k * 6144);
#pragma unroll
                for (int b = 0; b < 9; ++b) { const float sv = svec[b * 1024 + k0 + k]; acc[b][0] += wv.x * sv; acc[b][1] += wv.y * sv; acc[b][2] += wv.z * sv; acc[b][3] += wv.w * sv; }
            }
#pragma unroll
            for (int b = 0; b < 9; ++b)
#pragma unroll
                for (int j = 0; j < 4; ++j) { float v = acc[b][j]; v += __shfl_xor(v, 8); v += __shfl_xor(v, 16); v += __shfl_xor(v, 32); acc[b][j] = v; }
            if (lane < 8) {
#pragma unroll
                for (int b = 0; b < 9; ++b)
#pragma unroll
                    for (int j = 0; j < 4; ++j) red[(wid * 9 + b) * 32 + lane * 4 + j] = acc[b][j];
            }
            __syncthreads();
            for (int i = tid; i < 9 * 32; i += NTHR) {
                const int b = i >> 5, c = i & 31;
                const int ci = item * 32 + c, ll = ci / 6144, cc = ci % 6144;
                float v = 0.f;
#pragma unroll
                for (int w8 = 0; w8 < 8; ++w8) v += red[(w8 * 9 + b) * 32 + c];
                p.mod[(size_t)(ll * 9 + b) * 6144 + cc] = v + p.b_mod[ll][cc];
            }
        } else if (item < N_ADA + N_TR / 2) {
            tr_item(p, (item - N_ADA) * 2 + (tid >> 8));
        } else if (item < N_ADA + N_TR / 2 + N_CONV_ITEMS) {
            const int base = (item - N_ADA - N_TR / 2) * 4096;
            for (int i = tid; i < 4096; i += NTHR) { const int e = base + i; if (e < NE_TOTAL) conv_elem(p, e); }
        } else {
            const int row0 = ((item - N_ADA - N_TR / 2 - N_CONV_ITEMS) * NWV + wid) * 4;
            const int tb = row0 >> 14, er0 = row0 & 16383, l = tb >> 1;
            const float* src = ((tb & 1) ? p.peer_v[l] : p.peer_u[l]) + (size_t)er0 * 1024 + lane * 16;
            u8_t* dst = ((tb & 1) ? p.v8[l] : p.u8[l]) + (size_t)er0 * 512 + lane * 8;
            float* sc = ((tb & 1) ? p.sv[l] : p.su[l]) + er0;
            f32x4v f[4][4];
#pragma unroll
            for (int r = 0; r < 4; ++r)
#pragma unroll
                for (int j = 0; j < 4; ++j) f[r][j] = __builtin_nontemporal_load((const f32x4v*)(src + (size_t)r * 1024 + 4 * j));
#pragma unroll
            for (int r = 0; r < 4; ++r) {
                float am = 0.f, sq = 0.f;
#pragma unroll
                for (int j = 0; j < 4; ++j) {
                    am = fmaxf(fmaxf(am, fmaxf(fabsf(f[r][j][0]), fabsf(f[r][j][1]))), fmaxf(fabsf(f[r][j][2]), fabsf(f[r][j][3])));
                    sq += (f[r][j][0] * f[r][j][0] + f[r][j][1] * f[r][j][1]) + (f[r][j][2] * f[r][j][2] + f[r][j][3] * f[r][j][3]);
                }
                unsigned w[2]; float scale;
                if (tb & 1) {
                    am = wave_max(am);
                    scale = am > 0.f ? am * (1.f / 6.f) : 1.f; const float inv = am > 0.f ? 6.f / am : 1.f;
#pragma unroll
                    for (int j = 0; j < 2; ++j) {
                        unsigned pk = 0u;
                        pk = __builtin_amdgcn_cvt_scalef32_pk_fp4_f32(pk, f[r][2 * j][0] * inv, f[r][2 * j][1] * inv, 1.0f, 0);
                        pk = __builtin_amdgcn_cvt_scalef32_pk_fp4_f32(pk, f[r][2 * j][2] * inv, f[r][2 * j][3] * inv, 1.0f, 1);
                        pk = __builtin_amdgcn_cvt_scalef32_pk_fp4_f32(pk, f[r][2 * j + 1][0] * inv, f[r][2 * j + 1][1] * inv, 1.0f, 2);
                        pk = __builtin_amdgcn_cvt_scalef32_pk_fp4_f32(pk, f[r][2 * j + 1][2] * inv, f[r][2 * j + 1][3] * inv, 1.0f, 3);
                        w[j] = pk;
                    }
                } else {
                    sq = wave_sum(sq);
                    const float rms = sqrtf(sq * (1.f / 1024.f));
                    scale = rms > 0.f ? 0.3352f * rms : 1.f; const float inv = 1.f / scale;
#pragma unroll
                    for (int j = 0; j < 2; ++j) {
                        unsigned pk = 0u;
#pragma unroll
                        for (int i = 0; i < 8; ++i) {
                            const float x = f[r][2 * j + (i >> 2)][i & 3] * inv;
                            const int q = (int)fminf(fmaxf(rintf(x), -8.f), 7.f);
                            pk |= ((unsigned)q & 15u) << (4 * i);
                        }
                        w[j] = pk;
                    }
                }
                *(uint2*)(dst + (size_t)r * 512) = make_uint2(w[0], w[1]);
                if (lane == 0) sc[r] = scale;
            }
        }
    }
}

template <int FIRST>
__device__ void st_resnorm(const Params& p, int l) {
    const int lane = tidx() & 63, wid = tidx() >> 6, stride = gridDim.x * NWV;
    for (int T0 = blockIdx.x * NWV + wid; T0 < T_TOK; T0 += 2 * stride) {
        float4 xa[2][4]; uint4 xb[2][2]; uint4 ma[2][2];
#pragma unroll
        for (int u = 0; u < 2; ++u) {
            const int T = min(T0 + u * stride, T_TOK - 1);
            const uint4* mp = (const uint4*)(p.mix + (size_t)T * 1024 + lane * 16);
            if (FIRST) { const float* x0 = x_in_row(p, T) + lane * 16;
#pragma unroll
                for (int j = 0; j < 4; ++j) xa[u][j] = *(const float4*)(x0 + 4 * j); }
            else { const uint4* xp = (const uint4*)(p.xres + (size_t)T * 1024 + lane * 16); xb[u][0] = xp[0]; xb[u][1] = xp[1]; }
            ma[u][0] = mp[0]; ma[u][1] = mp[1];
        }
#pragma unroll
        for (int u = 0; u < 2; ++u) {
            const int T = T0 + u * stride;
            if (T < T_TOK) {
                const TokInfo ti = tokinfo(T);
                bf16_t* xr = p.xres + (size_t)T * 1024 + lane * 16;
                const float* gt = modv(p, l, ti.mi, 2) + lane * 16;
                float x0v[16];
                if (FIRST) {
#pragma unroll
                    for (int j = 0; j < 4; ++j) { x0v[4 * j] = xa[u][j].x; x0v[4 * j + 1] = xa[u][j].y; x0v[4 * j + 2] = xa[u][j].z; x0v[4 * j + 3] = xa[u][j].w; }
                } else { float t8[8]; unpack8(xb[u][0], t8);
#pragma unroll
                    for (int j = 0; j < 8; ++j) x0v[j] = t8[j];
                    unpack8(xb[u][1], t8);
#pragma unroll
                    for (int j = 0; j < 8; ++j) x0v[8 + j] = t8[j]; }
                float m[16]; { float t8[8]; unpack8(ma[u][0], t8);
#pragma unroll
                    for (int j = 0; j < 8; ++j) m[j] = t8[j];
                    unpack8(ma[u][1], t8);
#pragma unroll
                    for (int j = 0; j < 8; ++j) m[8 + j] = t8[j]; }
                float v[16]; float ss = 0.f;
#pragma unroll
                for (int j = 0; j < 4; ++j) {
                    float4 g = *(const float4*)(gt + 4 * j);
                    if (!FIRST) { const float4 sp = *(const float4*)(p.s_pool + lane * 16 + 4 * j); g.x *= sp.x; g.y *= sp.y; g.z *= sp.z; g.w *= sp.w; }
                    v[4 * j] = x0v[4 * j] + g.x * m[4 * j]; v[4 * j + 1] = x0v[4 * j + 1] + g.y * m[4 * j + 1]; v[4 * j + 2] = x0v[4 * j + 2] + g.z * m[4 * j + 2]; v[4 * j + 3] = x0v[4 * j + 3] + g.w * m[4 * j + 3];
                }
                { uint4* xw = (uint4*)xr;
                  xw[0] = make_uint4(pack_bf16(v[0], v[1]), pack_bf16(v[2], v[3]), pack_bf16(v[4], v[5]), pack_bf16(v[6], v[7]));
                  xw[1] = make_uint4(pack_bf16(v[8], v[9]), pack_bf16(v[10], v[11]), pack_bf16(v[12], v[13]), pack_bf16(v[14], v[15])); }
#pragma unroll
                for (int j = 0; j < 16; ++j) ss += v[j] * v[j];
                ss = wave_sum(ss);
                const float rstd = rsqrtf(ss * (1.f / 1024.f) + 1e-6f);
                const float* sh = modv(p, l, ti.mi, 3) + lane * 16; const float* sc = modv(p, l, ti.mi, 4) + lane * 16; const float* gg = p.g_ffn[l] + lane * 16;
                float hval[16]; float hm = 0.f;
#pragma unroll
                for (int j = 0; j < 16; ++j) { hval[j] = v[j] * rstd * gg[j] * (1.f + sc[j]) + sh[j]; hm = fmaxf(hm, fabsf(hval[j])); }
                unsigned w[8];
#pragma unroll
                for (int j = 0; j < 8; ++j) w[j] = pack_bf16(hval[2 * j], hval[2 * j + 1]);
                uint4* d = (uint4*)(p.hbuf + (size_t)T * 1024 + lane * 16);
                d[0] = make_uint4(w[0], w[1], w[2], w[3]); d[1] = make_uint4(w[4], w[5], w[6], w[7]);
                hm = wave_max(hm);
                const float hs = hm > 0.f ? hm * (1.f / 119.f) : 1.f, hinv = 1.f / hs;
                unsigned ph[2] = {0u, 0u}, pl[2] = {0u, 0u};
#pragma unroll
                for (int j = 0; j < 16; ++j) {
                    const int h8 = (int)rintf(hval[j] * hinv);
                    const int lo = ((h8 + 8) & 15) - 8, hi = (h8 - lo) >> 4;
                    ph[j >> 3] |= ((unsigned)hi & 15u) << (4 * (j & 7)); pl[j >> 3] |= ((unsigned)lo & 15u) << (4 * (j & 7));
                }
                *(uint2*)(p.hqh + (size_t)T * 128 + lane * 2) = make_uint2(ph[0], ph[1]);
                *(uint2*)(p.hql + (size_t)T * 128 + lane * 2) = make_uint2(pl[0], pl[1]);
                if (lane == 0) p.hsc[T] = hs;
            }
        }
    }
}

template <int SRC>
__device__ void st_norm(const Params& p, int l, int which, const float* g, bf16_t* dst) {
    const int lane = tidx() & 63, wid = tidx() >> 6, stride = gridDim.x * NWV;
    for (int T0 = blockIdx.x * NWV + wid; T0 < T_TOK; T0 += 2 * stride) {
        float v[2][16];
#pragma unroll
        for (int u = 0; u < 2; ++u) {
            const int T = min(T0 + u * stride, T_TOK - 1);
            const float* src = x_in_row(p, T) + lane * 16;
#pragma unroll
            for (int j = 0; j < 4; ++j) { const float4 f = *(const float4*)(src + 4 * j); v[u][4 * j] = f.x; v[u][4 * j + 1] = f.y; v[u][4 * j + 2] = f.z; v[u][4 * j + 3] = f.w; }
        }
#pragma unroll
        for (int u = 0; u < 2; ++u) {
            const int T = T0 + u * stride;
            if (T < T_TOK) {
                const TokInfo ti = tokinfo(T);
                float ss = 0.f;
#pragma unroll
                for (int j = 0; j < 16; ++j) ss += v[u][j] * v[u][j];
                ss = wave_sum(ss);
                const float rstd = rsqrtf(ss * (1.f / 1024.f) + 1e-6f);
                const float* sh = modv(p, l, ti.mi, which ? 3 : 0) + lane * 16; const float* sc = modv(p, l, ti.mi, which ? 4 : 1) + lane * 16; const float* gg = g + lane * 16;
                unsigned w[8];
#pragma unroll
                for (int j = 0; j < 8; ++j) w[j] = pack_bf16(v[u][2 * j] * rstd * gg[2 * j] * (1.f + sc[2 * j]) + sh[2 * j], v[u][2 * j + 1] * rstd * gg[2 * j + 1] * (1.f + sc[2 * j + 1]) + sh[2 * j + 1]);
                uint4* d = (uint4*)(dst + (size_t)T * 1024 + lane * 16);
                d[0] = make_uint4(w[0], w[1], w[2], w[3]); d[1] = make_uint4(w[4], w[5], w[6], w[7]);
            }
        }
    }
}

struct EpiStoreBf16 {
    static constexpr bool PERM = true;
    bf16_t* O; int ldc;
    __device__ __forceinline__ void operator()(const pg8::f32x4 (&acc)[2][2][4][2], const pg8::Unit& u, int wr, int wc, int fr, int fq) const {
#pragma unroll
        for (int ai = 0; ai < 2; ++ai)
#pragma unroll
            for (int m = 0; m < 4; ++m) {
                bf16_t* rowp = O + (size_t)(u.pm * 256 + ai * 128 + wr * 64 + m * 16 + fr) * ldc + u.pn * 256 + wc * 32 + 8 * fq;
#pragma unroll
                for (int bj = 0; bj < 2; ++bj) {
                    const pg8::f32x4 v0 = acc[ai][bj][m][0], v1 = acc[ai][bj][m][1];
                    *(uint4*)(rowp + bj * 128) = make_uint4(pack_bf16(v0[0], v0[1]), pack_bf16(v0[2], v0[3]), pack_bf16(v1[0], v1[1]), pack_bf16(v1[2], v1[3]));
                }
            }
    }
};
__device__ void st_gemm1(const Params& p) {
    pg8::TileOrder S; S.nN = 7; S.total = 80 * 7; S.A = (const char*)p.hbuf; S.B = (const char*)p.wt_in; S.tA = (size_t)256 * 1024 * 2; S.tB = (size_t)256 * 1024 * 2;
    EpiStoreBf16 E; E.O = p.P; E.ldc = 1792;
    pg8::gemm_phase<EpiStoreBf16, pg8::TileOrder, true, true>((LAS unsigned char*)smem, 1024, 1024, 1024, S, E);
}

__device__ void st_postproj(const Params& p) {
    const int lane = tidx() & 63, wid = tidx() >> 6;
    float* o_ckv = p.out + 20971520, *o_kr = p.out + 22020096;
    for (int T = blockIdx.x * NWV + wid; T < T_TOK; T += gridDim.x * NWV) {
        const TokInfo ti = tokinfo(T);
        const bf16_t* Pr = p.P + (size_t)T * 1792;
        float cq[8], ck[8];
#pragma unroll
        for (int j = 0; j < 8; ++j) { cq[j] = 0.f; ck[j] = 0.f; }
        if (lane < 48) unpack8(*(const uint4*)(Pr + lane * 8), cq);
        if (lane < 32) unpack8(*(const uint4*)(Pr + 384 + lane * 8), ck);
        float s1 = 0.f, s2 = 0.f;
#pragma unroll
        for (int j = 0; j < 8; ++j) { s1 += cq[j] * cq[j]; s2 += ck[j] * ck[j]; }
        s1 = wave_sum(s1); s2 = wave_sum(s2);
        const float r1 = rsqrtf(s1 * (1.f / 384.f) + 1e-6f), r2 = rsqrtf(s2 * (1.f / 256.f) + 1e-6f);
        if (lane < 48) {
            const float4 ga = *(const float4*)(p.g_q + lane * 8), gb = *(const float4*)(p.g_q + lane * 8 + 4);
            uint4 o; o.x = pack_bf16(cq[0] * r1 * ga.x, cq[1] * r1 * ga.y); o.y = pack_bf16(cq[2] * r1 * ga.z, cq[3] * r1 * ga.w);
            o.z = pack_bf16(cq[4] * r1 * gb.x, cq[5] * r1 * gb.y); o.w = pack_bf16(cq[6] * r1 * gb.z, cq[7] * r1 * gb.w);
            *(uint4*)(p.cqn + (size_t)T * 384 + lane * 8) = o;
        }
        if (lane < 32) {
            const float4 ga = *(const float4*)(p.g_kv + lane * 8), gb = *(const float4*)(p.g_kv + lane * 8 + 4);
            float y[8] = {ck[0] * r2 * ga.x, ck[1] * r2 * ga.y, ck[2] * r2 * ga.z, ck[3] * r2 * ga.w, ck[4] * r2 * gb.x, ck[5] * r2 * gb.y, ck[6] * r2 * gb.z, ck[7] * r2 * gb.w};
            uint4 o; o.x = pack_bf16(y[0], y[1]); o.y = pack_bf16(y[2], y[3]); o.z = pack_bf16(y[4], y[5]); o.w = pack_bf16(y[6], y[7]);
            *(uint4*)(p.ckvk + (size_t)ti.keyrow * 256 + lane * 8) = o;
            if (!ti.smp) { float4* d = (float4*)(o_ckv + (size_t)T * 256 + lane * 8); d[0] = make_float4(y[0], y[1], y[2], y[3]); d[1] = make_float4(y[4], y[5], y[6], y[7]); }
        }
        if (lane < 8) {
            float v[8]; unpack8(*(const uint4*)(Pr + 640 + lane * 8), v);
            float y[8];
            if (ti.smp) {
                const int gr = ti.s >> 6, gc = ti.s & 63;
#pragma unroll
                for (int i = 0; i < 4; ++i) {
                    const int pr = lane * 4 + i;
                    const float cs = pr < 16 ? p.ropetab[gr * 16 + pr] : p.ropetab[1024 + gc * 16 + (pr - 16)];
                    const float sn = pr < 16 ? p.ropetab[512 + gr * 16 + pr] : p.ropetab[2048 + gc * 16 + (pr - 16)];
                    y[2 * i] = v[2 * i] * cs - v[2 * i + 1] * sn; y[2 * i + 1] = v[2 * i] * sn + v[2 * i + 1] * cs;
                }
            } else {
#pragma unroll
                for (int i = 0; i < 8; ++i) y[i] = v[i];
                float4* d = (float4*)(o_kr + (size_t)T * 64 + lane * 8); d[0] = make_float4(v[0], v[1], v[2], v[3]); d[1] = make_float4(v[4], v[5], v[6], v[7]);
            }
            uint4 o; o.x = pack_bf16(y[0], y[1]); o.y = pack_bf16(y[2], y[3]); o.z = pack_bf16(y[4], y[5]); o.w = pack_bf16(y[6], y[7]);
            *(uint4*)(p.kropek + (size_t)ti.keyrow * 64 + lane * 8) = o;
        }
        {
            const int ch = lane * 8;
            float y[8];
            { const float4 a = *(const float4*)(p.conv_b + ch), b = *(const float4*)(p.conv_b + ch + 4); y[0] = a.x; y[1] = a.y; y[2] = a.z; y[3] = a.w; y[4] = b.x; y[5] = b.y; y[6] = b.z; y[7] = b.w; }
#pragma unroll
            for (int k = 0; k < 4; ++k) {
                const int s2i = ti.s + k - 2;
                if (s2i >= 0 && s2i < ti.S) {
                    float u[8]; unpack8(*(const uint4*)(p.P + (size_t)(T + k - 2) * 1792 + 704 + ch), u);
                    const float4 a = *(const float4*)(p.conv_w + k * 512 + ch), b = *(const float4*)(p.conv_w + k * 512 + ch + 4);
                    y[0] += a.x * u[0]; y[1] += a.y * u[1]; y[2] += a.z * u[2]; y[3] += a.w * u[3]; y[4] += b.x * u[4]; y[5] += b.y * u[5]; y[6] += b.z * u[6]; y[7] += b.w * u[7];
                }
            }
            uint4 o; o.x = pack_bf16(y[0], y[1]); o.y = pack_bf16(y[2], y[3]); o.z = pack_bf16(y[4], y[5]); o.w = pack_bf16(y[6], y[7]);
            *(uint4*)(p.xc + (size_t)T * 512 + ch) = o;
            *(uint4*)(p.ug + (size_t)T * 512 + ch) = *(const uint4*)(Pr + 1216 + ch);
        }
    }
}

struct EpiVT {
    static constexpr bool PERM = true;
    bf16_t* vT;
    __device__ __forceinline__ void operator()(const pg8::f32x4 (&acc)[2][2][4][2], const pg8::Unit& u, int wr, int wc, int fr, int fq) const {
        const int R0 = u.pn * 256;
        size_t sbase; int Sk, pos0;
        if (R0 < T_CTX) { Sk = 256; pos0 = 0; sbase = (size_t)(R0 >> 8) * 4 * 128 * 256; }
        else { const int uu = R0 - T_CTX; const int sq = uu / 2304; Sk = 2304; pos0 = uu - sq * 2304; sbase = (size_t)T_CTX * 512 + (size_t)sq * 4 * 128 * 2304; }
        bf16_t* vb = vT + sbase + pos0 + wc * 32 + 8 * fq;
#pragma unroll
        for (int ai = 0; ai < 2; ++ai)
#pragma unroll
            for (int m = 0; m < 4; ++m) {
                const int r = u.pm * 256 + ai * 128 + wr * 64 + m * 16 + fr;
                bf16_t* rowp = vb + (size_t)r * Sk;
#pragma unroll
                for (int bj = 0; bj < 2; ++bj) {
                    const pg8::f32x4 v0 = acc[ai][bj][m][0], v1 = acc[ai][bj][m][1];
                    *(uint4*)(rowp + bj * 128) = make_uint4(pack_bf16(v0[0], v0[1]), pack_bf16(v0[2], v0[3]), pack_bf16(v1[0], v1[1]), pack_bf16(v1[2], v1[3]));
                }
            }
    }
};
#define N_G4 (160 * 16)
__device__ void st_gemm234(const Params& p) {
    {
        pg8::TileOrder S; S.nN = 3; S.total = 80 * 3; S.A = (const char*)p.cqn; S.B = (const char*)p.wt_uq; S.tA = (size_t)256 * 384 * 2; S.tB = (size_t)256 * 384 * 2;
        EpiStoreBf16 E; E.O = p.q; E.ldc = 768;
        pg8::gemm_phase<EpiStoreBf16, pg8::TileOrder, true, true>((LAS unsigned char*)smem, 384, 384, 384, S, E);
    }
    {
        pg8::TileOrder S; S.nN = 2; S.total = 88 * 2; S.A = (const char*)p.ckvk; S.B = (const char*)p.wt_ukv; S.tA = (size_t)256 * 256 * 2; S.tB = (size_t)256 * 256 * 2;
        EpiStoreBf16 E; E.O = p.Kn; E.ldc = 512;
        pg8::gemm_phase<EpiStoreBf16, pg8::TileOrder, true, true>((LAS unsigned char*)smem, 256, 256, 256, S, E);
    }
    {
        struct OrderVT {
            const char* W; const char* Kr;
            __device__ __forceinline__ bool next(int i, pg8::Unit& u) const {
                const int item = blockIdx.x + i * gridDim.x; if (item >= 88 * 2) return false;
                const int lt = item >> 3; u.pm = lt & 1; u.pn = (lt >> 1) * 8 + (item & 7);
                u.A = W + (size_t)u.pm * 256 * 256 * 2; u.B = Kr + (size_t)u.pn * 256 * 256 * 2; return true;
            }
        } S; S.W = (const char*)(p.wt_ukv + (size_t)512 * 256); S.Kr = (const char*)p.ckvk;
        EpiVT E; E.vT = p.vT;
        pg8::gemm_phase<EpiVT, OrderVT, true, true>((LAS unsigned char*)smem, 256, 256, 256, S, E);
    }
}

__device__ void st_gates(const Params& p) {
    const int half = tidx() >> 8, lane = tidx() & 63, wid = (tidx() >> 6) & 3, wm = wid >> 1, wn = wid & 1, hl = lane >> 5, cl = lane & 31;
    for (int item = blockIdx.x; item < N_G4 / 2; item += gridDim.x) {
        f32x16 acc[2][2];
        const int lt = (item >> 3) * 2 + half, tj = lt & 3, nb = (lt >> 2) & 3, tm = (lt >> 4) * 8 + (item & 7);
        gemm_acc<2, 2, 2, 2>(p.wt_gate + ((size_t)nb * 512 + tj * 128) * 128, 128, p.xc + (size_t)tm * 128 * 512 + nb * 128, 512, 128, acc);
        const int dir = tj >> 1, dg = (tj & 1) * 2 + wm;
#pragma unroll
        for (int gq = 0; gq < 4; ++gq) {
            const int ch0 = nb * 128 + dg * 32 + 8 * gq + 4 * hl;
            const float4 brg = *(const float4*)(p.b_rg + dir * 512 + ch0), big = *(const float4*)(p.b_ig + dir * 512 + ch0), sp = *(const float4*)(p.spl + dir * 512 + ch0);
            const float br[4] = {brg.x, brg.y, brg.z, brg.w}, bi[4] = {big.x, big.y, big.z, big.w}, spv[4] = {sp.x, sp.y, sp.z, sp.w};
#pragma unroll
            for (int j = 0; j < 2; ++j) {
                const int T = tm * 128 + 64 * wn + 32 * j + cl;
                const uint2 xr = *(const uint2*)(p.xc + (size_t)T * 512 + ch0);
                const float xv[4] = {__uint_as_float(xr.x << 16), __uint_as_float(xr.x & 0xffff0000u), __uint_as_float(xr.y << 16), __uint_as_float(xr.y & 0xffff0000u)};
                float am[4], bx[4];
#pragma unroll
                for (int e = 0; e < 4; ++e) {
                    const float rg = __builtin_amdgcn_rcpf(1.f + __expf(-(acc[0][j][4 * gq + e] + br[e]))), ig = __builtin_amdgcn_rcpf(1.f + __expf(-(acc[1][j][4 * gq + e] + bi[e])));
                    const float la = -8.f * rg * spv[e];
                    const float av = __expf(la);
                    am[e] = 1.f - av;
                    bx[e] = __builtin_amdgcn_sqrtf(fmaxf(1.f - av * av, 0.f)) * ig * xv[e];
                }
                *(uint2*)(p.a1m + ((size_t)T * 2 + dir) * 512 + ch0) = make_uint2(pack_bf16(am[0], am[1]), pack_bf16(am[2], am[3]));
                *(uint2*)(p.bxb + ((size_t)T * 2 + dir) * 512 + ch0) = make_uint2(pack_bf16(bx[0], bx[1]), pack_bf16(bx[2], bx[3]));
            }
        }
    }
}

#define N_ATT (64 + 256)
#define SCH 64
#define NCHK (T_TOK / SCH)
#define N_S1 (NCHK * 2)
__device__ void scan_s1_item(const Params& p, int it) {
    const int chunk = it >> 1, dc = (it & 1) * 512 + tidx(), dir = dc >> 9, ch = dc & 511;
    const int T0 = chunk * SCH;
    float A = 1.f, B = 0.f;
#pragma unroll 8
    for (int i = 0; i < SCH; ++i) {
        const int T = dir ? (T0 + SCH - 1 - i) : (T0 + i);
        const float av = 1.f - bf2f(p.a1m[((size_t)T * 2 + dir) * 512 + ch]), bv = bf2f(p.bxb[((size_t)T * 2 + dir) * 512 + ch]);
        A *= av; B = B * av + bv;
    }
    *(float2*)(p.agg + (((size_t)chunk * 2 + dir) * 512 + ch) * 2) = make_float2(A, B);
}

__device__ __forceinline__ int perm23(int r) { return (r & 0x13) | ((r & 4) << 1) | ((r & 8) >> 1); }
__device__ void attn_item_mfma(const Params& p, int it) {
    int seq, h, qb, Sk, T0, R0; size_t vbase;
    if (it < 64) { seq = it >> 2; h = it & 3; qb = 0; Sk = 256; T0 = seq * 256; R0 = seq * 256; vbase = (size_t)(seq * 4 + h) * 128 * 256; }
    else { const int u = it - 64; seq = u >> 5; h = (u >> 3) & 3; qb = u & 7; Sk = 2304; T0 = T_CTX + seq * 2048 + qb * 256; R0 = T_CTX + seq * 2304; vbase = (size_t)T_CTX * 512 + (size_t)(seq * 4 + h) * 128 * 2304; }
    const int tid = tidx(), lane = tid & 63, wid = tid >> 6, hl = lane >> 5, cl = lane & 31;
    bf16x8_t qf[12];
    {
        const bf16_t* qrow = p.q + (size_t)(T0 + 32 * wid + cl) * 768 + h * 192 + 8 * hl;
#pragma unroll
        for (int ks = 0; ks < 12; ++ks) qf[ks] = __builtin_bit_cast(bf16x8_t, *(const u32x4*)(qrow + 16 * ks));
        if (it >= 64) {
            const int sp = qb * 256 + 32 * wid + cl, gr = sp >> 6, gc = sp & 63;
#pragma unroll
            for (int ks = 8; ks < 12; ++ks) {
                const u32x4 w = __builtin_bit_cast(u32x4, qf[ks]); u32x4 o;
#pragma unroll
                for (int i = 0; i < 4; ++i) {
                    const int pr = 8 * (ks - 8) + 4 * hl + i;
                    const float cs = ks < 10 ? p.ropetab[gr * 16 + pr] : p.ropetab[1024 + gc * 16 + (pr - 16)];
                    const float sn = ks < 10 ? p.ropetab[512 + gr * 16 + pr] : p.ropetab[2048 + gc * 16 + (pr - 16)];
                    const float x0 = __uint_as_float(w[i] << 16), x1 = __uint_as_float(w[i] & 0xffff0000u);
                    o[i] = pack_bf16(x0 * cs - x1 * sn, x0 * sn + x1 * cs);
                }
                qf[ks] = __builtin_bit_cast(bf16x8_t, o);
            }
        }
    }
    f32x16 oacc[4];
#pragma unroll
    for (int d = 0; d < 4; ++d)
#pragma unroll
        for (int r = 0; r < 16; ++r) oacc[d][r] = 0.f;
    float m = -1e30f, lsum = 0.f;
    const bf16_t* gk = p.Kn + (size_t)(R0 + (tid >> 4)) * 512 + h * 128 + (tid & 15) * 8;
    const bf16_t* gr = p.kropek + (size_t)(R0 + (tid >> 3)) * 64 + (tid & 7) * 8;
    const bf16_t* gv = p.vT + vbase + (size_t)(tid >> 3) * Sk + (tid & 7) * 8;
    u32x4 rk[2], rr, rv[2];
    const int nt = Sk >> 6;
#pragma unroll
    for (int i = 0; i < 2; ++i) rk[i] = *(const u32x4*)(gk + (size_t)(32 * i) * 512);
    rr = *(const u32x4*)gr;
#pragma unroll
    for (int i = 0; i < 2; ++i) rv[i] = *(const u32x4*)(gv + (size_t)(64 * i) * Sk);
    __syncthreads();
    for (int t = 0; t < nt; ++t) {
#pragma unroll
        for (int i = 0; i < 2; ++i) *(u32x4*)(smem + ((tid & 15) >> 3) * 8192 + lds_off((tid >> 4) + 32 * i, tid & 7)) = rk[i];
        *(u32x4*)(smem + 16384 + lds_off(tid >> 3, tid & 7)) = rr;
#pragma unroll
        for (int i = 0; i < 2; ++i) *(u32x4*)(smem + 24576 + lds_off((tid >> 3) + 64 * i, tid & 7)) = rv[i];
        __syncthreads();
        if (t + 1 < nt) {
            const size_t ko = (size_t)(t + 1) * 64;
#pragma unroll
            for (int i = 0; i < 2; ++i) rk[i] = *(const u32x4*)(gk + (ko + 32 * i) * 512);
            rr = *(const u32x4*)(gr + ko * 64);
#pragma unroll
            for (int i = 0; i < 2; ++i) rv[i] = *(const u32x4*)(gv + (size_t)(64 * i) * Sk + ko);
        }
        f32x16 sacc[2];
#pragma unroll
        for (int kb = 0; kb < 2; ++kb) {
            __builtin_amdgcn_sched_barrier(0);
#pragma unroll
            for (int r = 0; r < 16; ++r) sacc[kb][r] = 0.f;
            const int krow = 32 * kb + perm23(cl);
#pragma unroll
            for (int ks = 0; ks < 12; ++ks) {
                const bf16x8_t kf = __builtin_bit_cast(bf16x8_t, *(const u32x4*)(smem + (ks >> 2) * 8192 + lds_off(krow, 2 * (ks & 3) + hl)));
                sacc[kb] = __builtin_amdgcn_mfma_f32_32x32x16_bf16(kf, qf[ks], sacc[kb], 0, 0, 0);
            }
        }
        float mx = sacc[0][0];
#pragma unroll
        for (int r = 1; r < 16; ++r) mx = fmaxf(mx, sacc[0][r]);
#pragma unroll
        for (int r = 0; r < 16; ++r) mx = fmaxf(mx, sacc[1][r]);
        mx = fmaxf(mx, __shfl_xor(mx, 32));
        const bool resc = !__all(mx - m <= 8.f);
        const float mn = resc ? fmaxf(m, mx) : m, alpha = resc ? __builtin_amdgcn_exp2f(m - mn) : 1.f;
        m = mn;
        float ps = 0.f;
        bf16x8_t pf[2][2];
#pragma unroll
        for (int kb = 0; kb < 2; ++kb)
#pragma unroll
            for (int s2 = 0; s2 < 2; ++s2) {
                float e[8];
#pragma unroll
                for (int j = 0; j < 8; ++j) { e[j] = __builtin_amdgcn_exp2f(sacc[kb][8 * s2 + j] - mn); ps += e[j]; }
                u32x4 w; w.x = pack_bf16(e[0], e[1]); w.y = pack_bf16(e[2], e[3]); w.z = pack_bf16(e[4], e[5]); w.w = pack_bf16(e[6], e[7]);
                pf[kb][s2] = __builtin_bit_cast(bf16x8_t, w);
            }
        lsum = lsum * alpha + ps;
        if (resc) {
#pragma unroll
            for (int d = 0; d < 4; ++d)
#pragma unroll
                for (int r = 0; r < 16; ++r) oacc[d][r] *= alpha;
        }
#pragma unroll
        for (int d = 0; d < 4; ++d) {
            __builtin_amdgcn_sched_barrier(0);
#pragma unroll
            for (int kb = 0; kb < 2; ++kb)
#pragma unroll
                for (int s2 = 0; s2 < 2; ++s2) {
                    const bf16x8_t vf = __builtin_bit_cast(bf16x8_t, *(const u32x4*)(smem + 24576 + lds_off(32 * d + cl, 4 * kb + 2 * s2 + hl)));
                    oacc[d] = __builtin_amdgcn_mfma_f32_32x32x16_bf16(vf, pf[kb][s2], oacc[d], 0, 0, 0);
                }
        }
        __builtin_amdgcn_sched_barrier(0);
        __syncthreads();
    }
    lsum += __shfl_xor(lsum, 32);
    const float inv = 1.f / lsum;
    bf16_t* dst = p.hbuf + (size_t)(T0 + 32 * wid + cl) * 1024 + h * 128 + 4 * hl;
#pragma unroll
    for (int d = 0; d < 4; ++d)
#pragma unroll
        for (int g = 0; g < 4; ++g) {
            uint2 w; w.x = pack_bf16(oacc[d][4 * g] * inv, oacc[d][4 * g + 1] * inv); w.y = pack_bf16(oacc[d][4 * g + 2] * inv, oacc[d][4 * g + 3] * inv);
            *(uint2*)(dst + 32 * d + 8 * g) = w;
        }
}
__device__ void st_attn_s1(const Params& p) {
    for (int item = blockIdx.x; item < N_ATT + N_S1; item += gridDim.x) {
        if (item < N_ATT) {
            attn_item_mfma(p, N_ATT - 1 - item);
        }
        else scan_s1_item(p, item - N_ATT);
    }
}

__device__ void st_scan3(const Params& p) {
    const int tid = tidx();
    float* hf = (float*)smem;
    float* hb = hf + SCH * 256;
    float* o_lru = p.out + 22282240;
    for (int item = blockIdx.x; item < NCHK * 2; item += gridDim.x) {
        const int chunk = item >> 1, cgp = item & 1, T0 = chunk * SCH;
        const TokInfo ti = tokinfo(T0);
        const int nch = ti.S / SCH, cpos = ti.s / SCH, c0 = chunk - cpos;
        const int dir = tid >> 8, ch = cgp * 256 + (tid & 255);
        float hcur = ti.smp ? p.state_lru[((size_t)ti.b * 2 + dir) * 512 + ch] : 0.f;
        if (dir == 0) { for (int cc = 0; cc < cpos; ++cc) { const float2 ab = *(const float2*)(p.agg + (((size_t)(c0 + cc) * 2 + 0) * 512 + ch) * 2); hcur = ab.x * hcur + ab.y; } }
        else { for (int cc = nch - 1; cc > cpos; --cc) { const float2 ab = *(const float2*)(p.agg + (((size_t)(c0 + cc) * 2 + 1) * 512 + ch) * 2); hcur = ab.x * hcur + ab.y; } }
        __syncthreads();
#pragma unroll 8
        for (int i = 0; i < SCH; ++i) {
            const int tl = dir ? SCH - 1 - i : i, T = T0 + tl;
            const float av = 1.f - bf2f(p.a1m[((size_t)T * 2 + dir) * 512 + ch]), bv = bf2f(p.bxb[((size_t)T * 2 + dir) * 512 + ch]);
            hcur = av * hcur + bv;
            (dir ? hb : hf)[tl * 256 + (tid & 255)] = hcur;
        }
        if (!ti.smp) {
            if (dir == 0 && cpos == nch - 1) o_lru[((size_t)ti.b * 2 + 0) * 512 + ch] = hcur;
            if (dir == 1 && cpos == 0) o_lru[((size_t)ti.b * 2 + 1) * 512 + ch] = hcur;
        }
        __syncthreads();
        for (int i = tid; i < SCH * 128; i += NTHR) {
            const int tl = i >> 7, c = (i & 127) * 2, T = T0 + tl, chh = cgp * 256 + c;
            const unsigned ugp = *(const unsigned*)(p.ug + (size_t)T * 512 + chh);
            const float g0 = gelu_tanh(__uint_as_float(ugp << 16)), g1 = gelu_tanh(__uint_as_float(ugp & 0xffff0000u));
            const float2 f = *(const float2*)(hf + tl * 256 + c), bb = *(const float2*)(hb + tl * 256 + c);
            *(unsigned*)(p.hbuf + (size_t)T * 1024 + 512 + chh) = pack_bf16((f.x + bb.x) * g0, (f.y + bb.y) * g1);
        }
    }
}

__device__ void st_gemm_o(const Params& p) {
    pg8::TileOrder S; S.nN = 4; S.total = 80 * 4; S.A = (const char*)p.hbuf; S.B = (const char*)p.wt_o; S.tA = (size_t)256 * 1024 * 2; S.tB = (size_t)256 * 1024 * 2;
    EpiStoreBf16 E; E.O = p.mix; E.ldc = 1024;
    pg8::gemm_phase<EpiStoreBf16, pg8::TileOrder, true, true>((LAS unsigned char*)smem, 1024, 1024, 1024, S, E);
}

__device__ __forceinline__ void ce_desc(float& a, float& b) { const float hi = fmaxf(a, b), lo = fminf(a, b); a = hi; b = lo; }
__device__ __forceinline__ void ins16(float (&top)[16], float x) {
#pragma unroll
    for (int i = 0; i < 16; ++i) { const float hi = fmaxf(top[i], x); x = fminf(top[i], x); top[i] = hi; }
}
__device__ __forceinline__ void bitonic_merge16(float (&v)[16]) {
#pragma unroll
    for (int j = 8; j >= 1; j >>= 1)
#pragma unroll
        for (int i = 0; i < 16; ++i) { const int l = i ^ j; if (l > i) ce_desc(v[i], v[l]); }
}
__device__ __forceinline__ void sort16(float (&v)[16]) {
#pragma unroll
    for (int k = 2; k <= 16; k <<= 1)
#pragma unroll
        for (int j = k >> 1; j >= 1; j >>= 1)
#pragma unroll
            for (int i = 0; i < 16; ++i) { const int l = i ^ j; if (l > i) { if ((i & k) == 0) ce_desc(v[i], v[l]); else ce_desc(v[l], v[i]); } }
}
__device__ __forceinline__ void merge_top16(float (&a)[16], const float (&b)[16]) {
#pragma unroll
    for (int i = 0; i < 16; ++i) a[i] = fmaxf(a[i], b[15 - i]);
    bitonic_merge16(a);
}
#define PKV(x) __uint_as_float(__float_as_uint(x) & 0xffffff80u)
#define CAND(i, j) __uint_as_float((__float_as_uint(PKV(top[0][i]) + PKV(top[1][j])) & 0xffffff00u) | (unsigned)((i) * 16 + (j)))
__device__ void st_peer_topk(const Params& p, int l) {
    __builtin_amdgcn_sched_barrier(0);
    const int half = tidx() >> 8, lane = tidx() & 63, wid = (tidx() >> 6) & 3, hl = lane >> 5, cl = lane & 31;
    for (int item = blockIdx.x; item < 80 * 8; item += gridDim.x) {
        const int lt = item >> 3, h = lt & 7, tm = 2 * ((lt >> 3) * 8 + (item & 7)) + half;
        const int T = tm * 128 + 32 * wid + cl;
        float top[2][16];
#pragma unroll
        for (int pp = 0; pp < 2; ++pp) {
            f32x16 acc[4][1];
            gemm_acc<4, 1, 1, 4>(p.keysb[l] + (size_t)(h * 2 + pp) * 128 * 128, 128, p.qp + (size_t)tm * 128 * 2048 + h * 256 + pp * 128, 2048, 128, acc);
#pragma unroll
            for (int i = 0; i < 4; ++i) {
                __builtin_amdgcn_sched_barrier(0);
                float g[16];
#pragma unroll
                for (int r = 0; r < 16; ++r) {
                    const int n = ACC_ROW(4, 0, i, r, hl);
                    g[r] = __uint_as_float((__float_as_uint(acc[i][0][r]) & 0xffffff80u) | (unsigned)n);
                }
                sort16(g);
                if (i == 0) {
#pragma unroll
                    for (int r = 0; r < 16; ++r) top[pp][r] = g[r];
                } else merge_top16(top[pp], g);
            }
            __builtin_amdgcn_sched_barrier(0);
            float oth[16];
#pragma unroll
            for (int i = 0; i < 16; ++i) oth[i] = __shfl_xor(top[pp][i], 32);
            merge_top16(top[pp], oth);
        }
        __builtin_amdgcn_sched_barrier(0);
        float fv[16], t2[16];
#pragma unroll
        for (int j = 0; j < 16; ++j) fv[j] = CAND(0, j);
        t2[15] = -INFINITY;
#pragma unroll
        for (int i = 1; i < 16; ++i) t2[i - 1] = CAND(i, 0);
        merge_top16(fv, t2);
        t2[0] = CAND(1, 1); t2[1] = CAND(1, 2); t2[2] = CAND(1, 3); t2[3] = CAND(1, 4); t2[4] = CAND(1, 5); t2[5] = CAND(1, 6); t2[6] = CAND(1, 7);
        t2[7] = CAND(2, 1); t2[8] = CAND(2, 2); t2[9] = CAND(2, 3); t2[10] = CAND(2, 4); t2[11] = CAND(3, 1); t2[12] = CAND(3, 2); t2[13] = CAND(3, 3);
        t2[14] = CAND(4, 1); t2[15] = CAND(4, 2);
        sort16(t2);
        merge_top16(fv, t2);
        ins16(fv, CAND(5, 1)); ins16(fv, CAND(6, 1)); ins16(fv, CAND(7, 1));
        unsigned* tab = (unsigned*)(smem + half * 65536) + (size_t)(tidx() & 255) * 8;
#pragma unroll
        for (int k = 0; k < 4; ++k) {
            tab[k] = (__float_as_uint(top[0][4 * k]) & 127u) | ((__float_as_uint(top[0][4 * k + 1]) & 127u) << 8) | ((__float_as_uint(top[0][4 * k + 2]) & 127u) << 16) | ((__float_as_uint(top[0][4 * k + 3]) & 127u) << 24);
            tab[4 + k] = (__float_as_uint(top[1][4 * k]) & 127u) | ((__float_as_uint(top[1][4 * k + 1]) & 127u) << 8) | ((__float_as_uint(top[1][4 * k + 2]) & 127u) << 16) | ((__float_as_uint(top[1][4 * k + 3]) & 127u) << 24);
        }
        const u8_t* tabb = (const u8_t*)tab;
        int fe[16];
#pragma unroll
        for (int i = 0; i < 16; ++i) {
            const unsigned code = __float_as_uint(fv[i]) & 255u;
            fe[i] = (int)tabb[code >> 4] * 128 + (int)tabb[16 + (code & 15u)];
            fv[i] = __uint_as_float(__float_as_uint(fv[i]) & 0xffffff00u);
        }
        float sum = 0.f, ev[16];
#pragma unroll
        for (int i = 0; i < 16; ++i) { ev[i] = __expf(fv[i] - fv[0]); sum += ev[i]; }
        const float inv = 1.f / sum;
        if (hl == 0) {
            float4* gp = (float4*)(p.gates + (size_t)T * 128 + h * 16); int4* ep = (int4*)(p.eidx + (size_t)T * 128 + h * 16);
#pragma unroll
            for (int i = 0; i < 4; ++i) { gp[i] = make_float4(ev[4 * i] * inv, ev[4 * i + 1] * inv, ev[4 * i + 2] * inv, ev[4 * i + 3] * inv); ep[i] = make_int4(fe[4 * i], fe[4 * i + 1], fe[4 * i + 2], fe[4 * i + 3]); }
        }
    }
}

__device__ void st_gemm_pq(const Params& p, int l) {
    pg8::TileOrder S; S.nN = 8; S.total = 80 * 8; S.A = (const char*)p.hbuf; S.B = (const char*)p.wt_pq[l]; S.tA = (size_t)256 * 1024 * 2; S.tB = (size_t)256 * 1024 * 2;
    EpiStoreBf16 E; E.O = p.qp; E.ldc = 2048;
    pg8::gemm_phase<EpiStoreBf16, pg8::TileOrder, true, true>((LAS unsigned char*)smem, 1024, 1024, 1024, S, E);
    asm volatile("s_waitcnt vmcnt(0)" ::: "memory");
    __syncthreads();
    st_peer_topk(p, l);
}

#define FP4X(dw, b) __builtin_amdgcn_cvt_scalef32_pk_f32_fp4(dw, 1.0f, b)
#define FP4B(dw, b) __builtin_amdgcn_cvt_scalef32_pk_bf16_fp4(dw, 1.0f, b)
__device__ void st_peer_gather(const Params& p, int l) {
    const int lane = tidx() & 63, wid = __builtin_amdgcn_readfirstlane(tidx() >> 6), g = lane >> 3, pc = lane & 7;
    const u8_t* U = p.u8[l]; const u8_t* V = p.v8[l]; const float* SU = p.su[l]; const float* SV = p.sv[l];
    const bool b0 = (lane & 1) != 0, b1 = (lane & 2) != 0, b2 = (lane & 4) != 0, b3 = (lane & 8) != 0;
    const int stride = gridDim.x * NWV, Tfirst = blockIdx.x * NWV + wid;
    const int ka = 16 * g + pc, kb = ka + 8;
#pragma unroll 1
    for (int c = 0; c < 4; ++c) {
#pragma unroll 1
        for (int T = Tfirst; T < T_TOK; T += stride) {
            int ev[16];
            { const int4* ep = (const int4*)(p.eidx + (size_t)T * 128 + 16 * g);
#pragma unroll
              for (int q = 0; q < 4; ++q) { const int4 t = ep[q]; ev[4 * q] = t.x; ev[4 * q + 1] = t.y; ev[4 * q + 2] = t.z; ev[4 * q + 3] = t.w; } }
            const u32x4 hh4 = *(const u32x4*)(p.hqh + (size_t)T * 128 + c * 32 + pc * 4), hl4 = *(const u32x4*)(p.hql + (size_t)T * 128 + c * 32 + pc * 4);
            u32x4 r[16];
#pragma unroll
            for (int i = 0; i < 16; ++i) {
                r[i] = *(const u32x4*)(U + ((unsigned)ev[i] * 512u + (unsigned)(c * 128 + pc * 16)));
            }
            float za = 0.f, zb = 0.f;
            if (c > 0) { za = p.zbuf[(size_t)T * 128 + ka]; zb = p.zbuf[(size_t)T * 128 + kb]; }
#pragma unroll
            for (int hh = 0; hh < 2; ++hh) {
                float d[8];
#pragma unroll
                for (int ii = 0; ii < 8; ++ii) {
                    int ah = 0, al = 0;
#pragma unroll
                    for (int q = 0; q < 4; ++q) { ah = __builtin_amdgcn_sdot8((int)r[8 * hh + ii][q], (int)hh4[q], ah, false); al = __builtin_amdgcn_sdot8((int)r[8 * hh + ii][q], (int)hl4[q], al, false); }
                    d[ii] = (float)(ah * 16 + al);
                }
                float a4[4], a2[2];
#pragma unroll
                for (int j = 0; j < 4; ++j) { const float kp = b2 ? d[j + 4] : d[j], sn = b2 ? d[j] : d[j + 4]; a4[j] = kp + DPP_F(sn, 0x141); }
#pragma unroll
                for (int j = 0; j < 2; ++j) { const float kp = b1 ? a4[j + 2] : a4[j], sn = b1 ? a4[j] : a4[j + 2]; a2[j] = kp + DPP_F(sn, 0x4E); }
                const float kp = b0 ? a2[1] : a2[0], sn = b0 ? a2[0] : a2[1];
                const float z = kp + DPP_F(sn, 0xB1);
                if (hh == 0) za += z; else zb += z;
            }
            if (c < 3) { p.zbuf[(size_t)T * 128 + ka] = za; p.zbuf[(size_t)T * 128 + kb] = zb; }
            else {
                const int ea = p.eidx[(size_t)T * 128 + ka], eb = p.eidx[(size_t)T * 128 + kb];
                const float ga = p.gates[(size_t)T * 128 + ka], gb = p.gates[(size_t)T * 128 + kb];
                const float hs = p.hsc[T];
                p.wbuf[(size_t)T * 128 + ka] = ga * gelu_tanh(za * (SU[ea] * hs)) * SV[ea];
                p.wbuf[(size_t)T * 128 + kb] = gb * gelu_tanh(zb * (SU[eb] * hs)) * SV[eb];
            }
        }
    }
    asm volatile("s_waitcnt vmcnt(0)" ::: "memory");
#pragma unroll 1
    for (int c = 0; c < 4; ++c) {
#pragma unroll 1
        for (int T = Tfirst; T < T_TOK; T += stride) {
            int ev[16]; float wv[16];
            { const int4* ep = (const int4*)(p.eidx + (size_t)T * 128 + 16 * g); const float4* wp = (const float4*)(p.wbuf + (size_t)T * 128 + 16 * g);
#pragma unroll
              for (int q = 0; q < 4; ++q) { const int4 t = ep[q]; ev[4 * q] = t.x; ev[4 * q + 1] = t.y; ev[4 * q + 2] = t.z; ev[4 * q + 3] = t.w;
                                            const float4 u = wp[q]; wv[4 * q] = u.x; wv[4 * q + 1] = u.y; wv[4 * q + 2] = u.z; wv[4 * q + 3] = u.w; } }
            u32x4 r[16];
#pragma unroll
            for (int i = 0; i < 16; ++i) {
                r[i] = *(const u32x4*)(V + ((unsigned)ev[i] * 512u + (unsigned)(c * 128 + pc * 16)));
            }
            f32x2 acc2[16];
#pragma unroll
            for (int j = 0; j < 16; ++j) acc2[j] = (f32x2){0.f, 0.f};
#pragma unroll
            for (int i = 0; i < 16; ++i) {
                const f32x2 wk2 = {wv[i], wv[i]};
#pragma unroll
                for (int q = 0; q < 4; ++q) {
                    acc2[4 * q] = FP4X(r[i][q], 0) * wk2 + acc2[4 * q]; acc2[4 * q + 1] = FP4X(r[i][q], 1) * wk2 + acc2[4 * q + 1];
                    acc2[4 * q + 2] = FP4X(r[i][q], 2) * wk2 + acc2[4 * q + 2]; acc2[4 * q + 3] = FP4X(r[i][q], 3) * wk2 + acc2[4 * q + 3];
                }
                __builtin_amdgcn_sched_barrier(0);
            }
            float acc[32];
#pragma unroll
            for (int j = 0; j < 16; ++j) { acc[2 * j] = acc2[j].x; acc[2 * j + 1] = acc2[j].y; }
            float s1[16], s2[8], s3[4];
#pragma unroll
            for (int j = 0; j < 16; ++j) { const u32x2 rr = __builtin_amdgcn_permlane32_swap(__float_as_uint(acc[j]), __float_as_uint(acc[j + 16]), false, false); s1[j] = __uint_as_float(rr[0]) + __uint_as_float(rr[1]); }
#pragma unroll
            for (int j = 0; j < 8; ++j) { const u32x2 rr = __builtin_amdgcn_permlane16_swap(__float_as_uint(s1[j]), __float_as_uint(s1[j + 8]), false, false); s2[j] = __uint_as_float(rr[0]) + __uint_as_float(rr[1]); }
#pragma unroll
            for (int j = 0; j < 4; ++j) { const float kp = b3 ? s2[j + 4] : s2[j], sn = b3 ? s2[j] : s2[j + 4]; s3[j] = kp + DPP_F(sn, 0x128); }
            *(uint2*)(p.mix + (size_t)T * 1024 + c * 256 + pc * 32 + g * 4) = make_uint2(pack_bf16(s3[0], s3[1]), pack_bf16(s3[2], s3[3]));
        }
    }
    asm volatile("s_waitcnt vmcnt(0)" ::: "memory");
#pragma unroll 1
    for (int T = Tfirst; T < T_TOK; T += stride) {
        const TokInfo ti = tokinfo(T);
        const int cb = lane * 16;
        float o16[16];
        { const uint4* op = (const uint4*)(p.mix + (size_t)T * 1024 + cb); float t8[8]; unpack8(op[0], t8);
#pragma unroll
          for (int j = 0; j < 8; ++j) o16[j] = t8[j];
          unpack8(op[1], t8);
#pragma unroll
          for (int j = 0; j < 8; ++j) o16[8 + j] = t8[j]; }
        bf16_t* xr = p.xres + (size_t)T * 1024 + cb;
        const float* gt = modv(p, l, ti.mi, 5) + cb;
        float xn[16]; float ss = 0.f;
        { const uint4* xp = (const uint4*)xr; float t8[8]; unpack8(xp[0], t8);
#pragma unroll
          for (int j = 0; j < 8; ++j) xn[j] = t8[j] + gt[j] * o16[j];
          unpack8(xp[1], t8);
#pragma unroll
          for (int j = 0; j < 8; ++j) xn[8 + j] = t8[j] + gt[8 + j] * o16[8 + j]; }
#pragma unroll
        for (int j = 0; j < 16; ++j) ss += xn[j] * xn[j];
        ss = wave_sum(ss);
        const float rstd = rsqrtf(ss * (1.f / 1024.f) + 1e-6f);
        if (l == 0) {
#pragma unroll
            for (int j = 0; j < 1; ++j) { uint4* xw = (uint4*)xr;
                xw[0] = make_uint4(pack_bf16(xn[0], xn[1]), pack_bf16(xn[2], xn[3]), pack_bf16(xn[4], xn[5]), pack_bf16(xn[6], xn[7]));
                xw[1] = make_uint4(pack_bf16(xn[8], xn[9]), pack_bf16(xn[10], xn[11]), pack_bf16(xn[12], xn[13]), pack_bf16(xn[14], xn[15])); }
            const float* sh = modv(p, 1, ti.mi, 0) + cb; const float* sc = modv(p, 1, ti.mi, 1) + cb; const float* gg = p.g_mix[1] + cb;
            unsigned w[8];
#pragma unroll
            for (int j = 0; j < 8; ++j) w[j] = pack_bf16(xn[2 * j] * rstd * gg[2 * j] * (1.f + sc[2 * j]) + sh[2 * j], xn[2 * j + 1] * rstd * gg[2 * j + 1] * (1.f + sc[2 * j + 1]) + sh[2 * j + 1]);
            uint4* dd = (uint4*)(p.h3 + (size_t)T * 1024 + cb);
            dd[0] = make_uint4(w[0], w[1], w[2], w[3]); dd[1] = make_uint4(w[4], w[5], w[6], w[7]);
        } else {
            const float* gg = p.g_final + cb;
            float* y = p.out + (size_t)T * 1024 + cb;
#pragma unroll
            for (int j = 0; j < 4; ++j) *(float4*)(y + 4 * j) = make_float4(xn[4 * j] * rstd * gg[4 * j], xn[4 * j + 1] * rstd * gg[4 * j + 1], xn[4 * j + 2] * rstd * gg[4 * j + 2], xn[4 * j + 3] * rstd * gg[4 * j + 3]);
        }
    }
}

template <int W>
__device__ __forceinline__ void pool_tok(const Params& p, int T, int ck) {
    const TokInfo ti = tokinfo(T);
    const bf16_t* base = p.h3 + (size_t)(T - ti.s) * 1024 + ck * 8;
    uint4 raw[W];
#pragma unroll
    for (int k = 0; k < W; ++k) {
        const int t2 = ti.s - W / 2 + k;
        raw[k] = (t2 >= 0 && t2 < ti.S) ? *(const uint4*)(base + (size_t)t2 * 1024) : make_uint4(0u, 0u, 0u, 0u);
    }
    float acc[8];
#pragma unroll
    for (int j = 0; j < 8; ++j) acc[j] = 0.f;
#pragma unroll
    for (int k = 0; k < W; ++k) { float f[8]; unpack8(raw[k], f);
#pragma unroll
        for (int j = 0; j < 8; ++j) acc[j] += f[j]; }
    float c[8]; unpack8(raw[W / 2], c);
    const int lo = max(ti.s - W / 2, 0), hi = min(ti.s + W / 2, ti.S);
    const float inv = 1.f / (float)(hi - lo);
    uint4 o;
    o.x = pack_bf16(acc[0] * inv - c[0], acc[1] * inv - c[1]); o.y = pack_bf16(acc[2] * inv - c[2], acc[3] * inv - c[3]);
    o.z = pack_bf16(acc[4] * inv - c[4], acc[5] * inv - c[5]); o.w = pack_bf16(acc[6] * inv - c[6], acc[7] * inv - c[7]);
    *(uint4*)(p.hbuf + (size_t)T * 1024 + ck * 8) = o;
}
__device__ void st_pool(const Params& p) {
    const int tid = tidx(), lane = tid & 63, wv = tid >> 6, g = wv & 3, ck = g * 32 + (lane & 31), tsub = (wv >> 2) * 2 + (lane >> 5);
    const int per = (T_TOK + gridDim.x - 1) / gridDim.x, Tb = blockIdx.x * per, Te = min(Tb + per, T_TOK);
    for (int T = Tb + tsub; T < Te; T += 4) {
        if (g == 0) pool_tok<2>(p, T, ck); else if (g == 1) pool_tok<4>(p, T, ck); else if (g == 2) pool_tok<8>(p, T, ck); else pool_tok<16>(p, T, ck);
    }
}

__device__ void st_gemm_pool(const Params& p) {
    struct OrderPool {
        const char* A; const char* B;
        __device__ __forceinline__ bool next(int i, pg8::Unit& u) const {
            const int item = blockIdx.x + i * gridDim.x; if (item >= 80 * 4) return false;
            const int lt = item >> 3; u.pn = lt & 3; u.pm = (lt >> 2) * 8 + (item & 7);
            u.A = A + (size_t)u.pm * 256 * 1024 * 2 + (size_t)u.pn * 256 * 2; u.B = B + (size_t)u.pn * 256 * 256 * 2; return true;
        }
    } S; S.A = (const char*)p.hbuf; S.B = (const char*)p.wt_pool;
    EpiStoreBf16 E; E.O = p.mix; E.ldc = 1024;
    pg8::gemm_phase<EpiStoreBf16, OrderPool, true, true>((LAS unsigned char*)smem, 1024, 256, 256, S, E);
}

__device__ __forceinline__ void run_stage(const Params& p, int s) {
#ifdef ONLY_STAGE
    if (s != ONLY_STAGE) return;
#endif
    switch (s) {
        case 0: st_prologue(p); break;
        case 1: st_norm<0>(p, 0, 0, p.g_mix[0], p.hbuf); break;
        case 2: st_gemm1(p); break;
        case 3: st_postproj(p); break;
        case 4: st_gemm234(p); break;
        case 18: st_gates(p); break;
        case 5: st_attn_s1(p); break;
        case 6: st_scan3(p); break;
        case 7: st_gemm_o(p); break;
        case 8: st_resnorm<1>(p, 0); break;
        case 9: st_gemm_pq(p, 0); break;
        case 11: st_peer_gather(p, 0); break;
        case 12: st_pool(p); break;
        case 13: st_gemm_pool(p); break;
        case 14: st_resnorm<0>(p, 1); break;
        case 15: st_gemm_pq(p, 1); break;
        case 17: st_peer_gather(p, 1); break;
        default: break;
    }
}

__global__ void __launch_bounds__(NTHR, 2) fwd_mega(Params p) {
    cg::grid_group grid = cg::this_grid();
    volatile LAS unsigned* st = (volatile LAS unsigned*)(smem + 131072);
    if (threadIdx.x == 0) { st[0] = 0; st[1] = 0; st[2] = 0; st[3] = 0; }
    wtab_init();
    __syncthreads();
    XcdBarrier b = xcd_barrier_post(p.bar, st);
    if (p.bar == nullptr) grid.sync();
#ifndef REP_MASK
#define REP_MASK 0
#endif
#define MK_ST(k) run_stage(p, k); if ((REP_MASK >> (k)) & 1) { xcd_barrier(b); run_stage(p, k); } if ((k) != 17) xcd_barrier(b);
    MK_ST(0) MK_ST(1) MK_ST(2) MK_ST(3) run_stage(p, 4); MK_ST(18) MK_ST(5) MK_ST(6) MK_ST(7) MK_ST(8) MK_ST(9) MK_ST(11) MK_ST(12) MK_ST(13) MK_ST(14) MK_ST(15) MK_ST(17)
}

extern "C" void kernel_launch(void* const* d_in, const int* in_sizes, int n_in, void* d_out, int out_size, void* d_ws, size_t ws_size, hipStream_t stream) {
    constexpr size_t kDynLds = 131072 + 512;
    static int grid_blocks = 0;
    if (!grid_blocks) {
        int dev = 0, cus = 0, per_cu = 0;
        (void)hipGetDevice(&dev);
        (void)hipDeviceGetAttribute(&cus, hipDeviceAttributeMultiprocessorCount, dev);
        (void)hipFuncSetAttribute((const void*)fwd_mega, hipFuncAttributeMaxDynamicSharedMemorySize, (int)kDynLds);
        (void)hipOccupancyMaxActiveBlocksPerMultiprocessor(&per_cu, fwd_mega, NTHR, kDynLds);
        if (per_cu > 1) per_cu = 1;
        if (per_cu < 1) per_cu = 1;
        grid_blocks = cus * per_cu;
    }
    Params p{};
    const float* const* in = (const float* const*)d_in;
    p.x_prompt = in[0]; p.x_sample = in[1]; p.cache_ckv = in[2]; p.cache_krope = in[3]; p.state_lru = in[4]; p.c = in[5]; p.c_ctx = in[6];
    p.w_mod[0] = in[7]; p.b_mod[0] = in[8]; p.w_mod[1] = in[9]; p.b_mod[1] = in[10];
    p.g_mix[0] = in[11]; p.g_ffn[0] = in[12]; p.g_mix[1] = in[13]; p.g_ffn[1] = in[14];
    p.w_in = in[15]; p.g_q = in[16]; p.w_uq = in[17]; p.g_kv = in[18]; p.w_ukv = in[19]; p.conv_w = in[20]; p.conv_b = in[21];
    p.w_rg = in[22]; p.b_rg = in[23]; p.w_ig = in[24]; p.b_ig = in[25]; p.lam = in[26]; p.w_o = in[27]; p.w_pool = in[28]; p.s_pool = in[29];
    p.peer_wq[0] = in[30]; p.peer_keys[0] = in[31]; p.peer_u[0] = in[32]; p.peer_v[0] = in[33];
    p.peer_wq[1] = in[34]; p.peer_keys[1] = in[35]; p.peer_u[1] = in[36]; p.peer_v[1] = in[37];
    p.g_final = in[38];
    p.out = (float*)d_out;
    char* base = (char*)d_ws; size_t off = 0;
    auto take = [&](size_t bytes) { char* r = base + off; off += (bytes + 255) & ~(size_t)255; return r; };
    const size_t MiB = 1u << 20;
    p.bar = (unsigned*)take(16384);
    p.mod = (float*)take((size_t)2 * 9 * 6144 * 4);
    p.ropetab = (float*)take(3072 * 4); p.spl = (float*)take(1024 * 4);
    p.wt_in = (bf16_t*)take((size_t)NW_IN * 2); p.wt_uq = (bf16_t*)take((size_t)NW_UQ * 2); p.wt_ukv = (bf16_t*)take((size_t)NW_UKV * 2);
    p.wt_gate = (bf16_t*)take((size_t)NW_GATE * 2); p.wt_o = (bf16_t*)take((size_t)NW_O * 2); p.wt_pool = (bf16_t*)take((size_t)NW_POOL * 2);
    p.wt_pq[0] = (bf16_t*)take((size_t)NW_PQ * 2); p.wt_pq[1] = (bf16_t*)take((size_t)NW_PQ * 2);
    p.keysb[0] = (bf16_t*)take((size_t)NW_KEYS * 2); p.keysb[1] = (bf16_t*)take((size_t)NW_KEYS * 2);
    for (int l = 0; l < 2; ++l) { p.u8[l] = (u8_t*)take(16 * MiB); p.v8[l] = (u8_t*)take(16 * MiB); p.su[l] = (float*)take(65536); p.sv[l] = (float*)take(65536); }
    char* regX = take(80 * MiB);
    char* regQ = take(80 * MiB);
    char* regH = take(40 * MiB);
    p.P = (bf16_t*)regX; p.a = (float*)regX; p.a1m = (bf16_t*)regX; p.xres = (bf16_t*)regX;
    p.bxb = (bf16_t*)regQ; p.q = (bf16_t*)(regQ + 40 * MiB); p.agg = (float*)(regQ + 70 * MiB); p.qp = (bf16_t*)regQ; p.h3 = (bf16_t*)regQ;
    p.hbuf = (bf16_t*)regH;
    p.cqn = (bf16_t*)take((size_t)T_TOK * 384 * 2); p.ckvk = (bf16_t*)take((size_t)R_KEYS * 256 * 2); p.kropek = (bf16_t*)take((size_t)R_KEYS * 64 * 2);
    p.xc = (bf16_t*)take((size_t)T_TOK * 512 * 2); p.ug = (bf16_t*)take((size_t)T_TOK * 512 * 2);
    p.mix = p.xc;
    p.Kn = (bf16_t*)take((size_t)R_KEYS * 512 * 2); p.vT = (bf16_t*)take((size_t)R_KEYS * 512 * 2);
    p.zbuf = (float*)p.vT; p.wbuf = p.zbuf + (size_t)T_TOK * 128;
    p.hqh = (unsigned*)p.cqn; p.hql = (unsigned*)p.ckvk; p.hsc = (float*)p.kropek;
    p.gates = (float*)p.Kn; p.eidx = (int*)((char*)p.Kn + (size_t)T_TOK * 128 * 4);
    if (off > ws_size) fprintf(stderr, "workspace too small: need %zu have %zu\n", off, ws_size);
    (void)hipMemsetAsync(d_ws, 0, 16384, stream);
    void* args[] = {&p};
    hipError_t e = hipLaunchCooperativeKernel((void*)fwd_mega, dim3(grid_blocks), dim3(NTHR), args, kDynLds, stream);
    if (e != hipSuccess) fprintf(stderr, "cooperative launch failed: %s (grid %d)\n", hipGetErrorString(e), grid_blocks);
}
```

```cpp
#include <hip/hip_runtime.h>
#include <hip/hip_cooperative_groups.h>
#include <cstdio>
#include <cstdint>
namespace cg = cooperative_groups;


typedef unsigned short bf16_t;
typedef unsigned char u8_t;
typedef float f32x16 __attribute__((ext_vector_type(16)));
typedef float f32x2 __attribute__((ext_vector_type(2)));
typedef unsigned u32x4 __attribute__((ext_vector_type(4)));
typedef float f32x4v __attribute__((ext_vector_type(4)));

#define T_TOK 20480
#define T_CTX 4096
#define R_KEYS 22528
#define NSTAGE 19
#define NTHR 512
#define NWV 8
#define LAS __attribute__((address_space(3)))

#define XB_TMO      128
#define XB_XCNT(j)  (256  + 64 * (j))
#define XB_XSUB(j)  (1280 + 64 * (j))
#define XB_XGEN(j)  (2304 + 64 * (j))
#define XB_TOP      3328
#define XB_TOPGEN   3392
#define XCD_BAR_WORDS 3456
#define XB_SPIN_CAP (1u << 22)
__device__ __forceinline__ unsigned xb_ld(unsigned* p)              { return __hip_atomic_load(p, __ATOMIC_RELAXED, __HIP_MEMORY_SCOPE_AGENT); }
__device__ __forceinline__ unsigned xb_add(unsigned* p, unsigned v) { return __hip_atomic_fetch_add(p, v, __ATOMIC_RELAXED, __HIP_MEMORY_SCOPE_AGENT); }
__device__ __forceinline__ unsigned xb_xcc_id() { return (unsigned)__builtin_amdgcn_s_getreg((3 << 11) | 20) & 0xFu; }
#define XB_SPIN(cond, bar) do { unsigned _sp = 0; while (cond) { __builtin_amdgcn_s_sleep(1); \
    if ((++_sp & 255u) == 0u) { if (xb_ld(&(bar)[XB_TMO])) break; if (_sp > XB_SPIN_CAP) { atomicAdd(&(bar)[XB_TMO], 1u); break; } } } } while (0)
struct XcdBarrier { unsigned* bar; unsigned x; volatile LAS unsigned* st; };
__device__ __forceinline__ XcdBarrier xcd_barrier_post(unsigned* bar, volatile LAS unsigned* st) {
    XcdBarrier b; b.bar = bar; b.x = xb_xcc_id(); b.st = st;
    if (threadIdx.x == 0) (void)xb_add(&bar[XB_XCNT(b.x)], 1u);
    return b;
}
__device__ __forceinline__ void xcd_barrier_complete(unsigned* bar, unsigned x, unsigned& nloc, unsigned& nx) {
    const unsigned G = gridDim.x * gridDim.y * gridDim.z;
    unsigned sum, cnt, mine, sp = 0u;
    for (;;) {
        sum = 0u; cnt = 0u; mine = 0u;
#pragma unroll
        for (unsigned j = 0; j < 16; ++j) { const unsigned c = xb_ld(&bar[XB_XCNT(j)]); sum += c; cnt += (c > 0u) ? 1u : 0u; mine = (j == x) ? c : mine; }
        if (sum == G) break;
        __builtin_amdgcn_s_sleep(1);
        if ((++sp & 255u) == 0u) { if (xb_ld(&bar[XB_TMO])) break; if (sp > XB_SPIN_CAP) { atomicAdd(&bar[XB_TMO], 1u); break; } }
    }
    nloc = mine > 0u ? mine : 1u; nx = cnt > 0u ? cnt : 1u;
}
__device__ __forceinline__ int tidx();
__device__ __forceinline__ void xcd_barrier(const XcdBarrier& b) {
    asm volatile("s_waitcnt vmcnt(0)" ::: "memory");
    __syncthreads();
    if (tidx() == 0) {
        unsigned* bar = b.bar;
        __builtin_amdgcn_s_waitcnt(0);
        unsigned nloc = b.st[0], nx = b.st[1];
        if (nloc == 0u) { xcd_barrier_complete(bar, b.x, nloc, nx); b.st[0] = nloc; b.st[1] = nx; }
        const unsigned old = xb_add(&bar[XB_XSUB(b.x)], 1u);
        const unsigned gen = old / nloc;
        if (old + 1u == (gen + 1u) * nloc) {
            __builtin_amdgcn_fence(__ATOMIC_RELEASE, "agent");
            asm volatile("s_waitcnt vmcnt(0)" ::: "memory");
            const unsigned og = xb_add(&bar[XB_TOP], 1u);
            const unsigned tg = og / nx;
            if (og + 1u == (tg + 1u) * nx) xb_add(&bar[XB_TOPGEN], 1u);
            else XB_SPIN(xb_ld(&bar[XB_TOPGEN]) == tg, bar);
            __builtin_amdgcn_fence(__ATOMIC_ACQUIRE, "agent");
            xb_add(&bar[XB_XGEN(b.x)], 1u);
            asm volatile("s_waitcnt vmcnt(0)" ::: "memory");
        } else {
            XB_SPIN(xb_ld(&bar[XB_XGEN(b.x)]) == gen, bar);
            __builtin_amdgcn_fence(__ATOMIC_ACQUIRE, "agent");
            asm volatile("s_waitcnt vmcnt(0)" ::: "memory");
        }
    }
    __syncthreads();
}

struct Params {
    const float *x_prompt, *x_sample, *cache_ckv, *cache_krope, *state_lru, *c, *c_ctx;
    const float *w_mod[2], *b_mod[2], *g_mix[2], *g_ffn[2];
    const float *w_in, *g_q, *w_uq, *g_kv, *w_ukv, *conv_w, *conv_b, *w_rg, *b_rg, *w_ig, *b_ig, *lam, *w_o, *w_pool, *s_pool;
    const float *peer_wq[2], *peer_keys[2], *peer_u[2], *peer_v[2];
    const float* g_final;
    float* out;
    unsigned* bar; float* mod; float* ropetab;
    bf16_t *wt_in, *wt_uq, *wt_ukv, *wt_gate, *wt_o, *wt_pool, *wt_pq[2], *keysb[2];
    u8_t *u8[2], *v8[2]; float *su[2], *sv[2];
    bf16_t *hbuf, *P, *cqn, *ckvk, *kropek, *xc, *ug, *q, *Kn, *vT, *bxb, *qp, *h3;
    float *a, *agg, *gates; int* eidx; bf16_t* xres;
    bf16_t* mix; float *zbuf, *wbuf; unsigned *hqh, *hql; float* hsc; float* spl; bf16_t* a1m;
};

extern __shared__ __attribute__((aligned(16))) unsigned char smem[];
#define WTAB_OFF (131072 + 64)
__device__ __forceinline__ int hw_wave_slot() { return (int)(__builtin_amdgcn_s_getreg(0x2804) & 63u); }
__device__ __forceinline__ void wtab_init() { if ((threadIdx.x & 63) == 0) ((volatile int*)(smem + WTAB_OFF))[hw_wave_slot()] = (int)(threadIdx.x >> 6); }
__device__ __forceinline__ int tidx() {
    const int w = __builtin_amdgcn_readfirstlane(((volatile int*)(smem + WTAB_OFF))[hw_wave_slot()]);
    return (w << 6) | (int)__builtin_amdgcn_mbcnt_hi(~0u, __builtin_amdgcn_mbcnt_lo(~0u, 0u));
}
__device__ __forceinline__ float bf2f(bf16_t v) { return __uint_as_float(((unsigned)v) << 16); }
typedef __bf16 bf16x2_t __attribute__((ext_vector_type(2)));
__device__ __forceinline__ bf16_t f2bf(float f) { return __builtin_bit_cast(unsigned short, (__bf16)f); }
__device__ __forceinline__ unsigned pack_bf16(float a, float b) { bf16x2_t v = {(__bf16)a, (__bf16)b}; return __builtin_bit_cast(unsigned, v); }
typedef unsigned u32x2 __attribute__((ext_vector_type(2)));
#define DPP_F(v, ctrl) __int_as_float(__builtin_amdgcn_update_dpp(0, __float_as_int(v), ctrl, 0xf, 0xf, true))
__device__ __forceinline__ float wave_sum(float v) {
    v += DPP_F(v, 0xB1); v += DPP_F(v, 0x4E); v += DPP_F(v, 0x141); v += DPP_F(v, 0x128);
    u32x2 r = __builtin_amdgcn_permlane16_swap(__float_as_uint(v), __float_as_uint(v), false, false);
    v = __uint_as_float(r[0]) + __uint_as_float(r[1]);
    r = __builtin_amdgcn_permlane32_swap(__float_as_uint(v), __float_as_uint(v), false, false);
    return __uint_as_float(r[0]) + __uint_as_float(r[1]);
}
__device__ __forceinline__ float wave_max(float v) {
    v = fmaxf(v, DPP_F(v, 0xB1)); v = fmaxf(v, DPP_F(v, 0x4E)); v = fmaxf(v, DPP_F(v, 0x141)); v = fmaxf(v, DPP_F(v, 0x128));
    u32x2 r = __builtin_amdgcn_permlane16_swap(__float_as_uint(v), __float_as_uint(v), false, false);
    v = fmaxf(__uint_as_float(r[0]), __uint_as_float(r[1]));
    r = __builtin_amdgcn_permlane32_swap(__float_as_uint(v), __float_as_uint(v), false, false);
    return fmaxf(__uint_as_float(r[0]), __uint_as_float(r[1]));
}
__device__ __forceinline__ float gelu_tanh(float x) {
    const float u = 0.7978845608028654f * (x + 0.044715f * x * x * x);
    const float e = __expf(2.f * u);
    const float th = 1.f - 2.f / (e + 1.f);
    return 0.5f * x * (1.f + th);
}
__device__ __forceinline__ float sigmoidf_(float x) { return 1.f / (1.f + __expf(-x)); }
__device__ __forceinline__ float silu_(float x) { return x / (1.f + __expf(-x)); }

struct TokInfo { int smp, b, s, S, mi, keyrow; };
__device__ __forceinline__ TokInfo tokinfo(int T) {
    TokInfo t;
    if (T < T_CTX) { t.smp = 0; t.b = T >> 8; t.s = T & 255; t.S = 256; t.mi = 0; t.keyrow = T; }
    else { const int u = T - T_CTX; t.smp = 1; t.b = u >> 11; t.s = u & 2047; t.S = 2048; t.mi = 1 + t.b; t.keyrow = T_CTX + t.b * 2304 + 256 + t.s; }
    return t;
}
__device__ __forceinline__ const float* x_in_row(const Params& p, int T) { return T < T_CTX ? p.x_prompt + (size_t)T * 1024 : p.x_sample + (size_t)(T - T_CTX) * 1024; }
__device__ __forceinline__ const float* modv(const Params& p, int l, int mi, int j) { return p.mod + ((size_t)(l * 9 + mi) * 6 + j) * 1024; }

__device__ __forceinline__ void unpack8(const uint4 r, float (&f)[8]) {
    f[0] = __uint_as_float(r.x << 16); f[1] = __uint_as_float(r.x & 0xffff0000u);
    f[2] = __uint_as_float(r.y << 16); f[3] = __uint_as_float(r.y & 0xffff0000u);
    f[4] = __uint_as_float(r.z << 16); f[5] = __uint_as_float(r.z & 0xffff0000u);
    f[6] = __uint_as_float(r.w << 16); f[7] = __uint_as_float(r.w & 0xffff0000u);
}

namespace pg8 {
typedef short bf16x8 __attribute__((ext_vector_type(8)));
typedef float f32x4 __attribute__((ext_vector_type(4)));
constexpr int BM = 256, BK = 64, HALF = 128, HTB = HALF * BK * 2  , STAGE_BYTES = 8 * HTB;
__device__ __forceinline__ int lds_byte(int r, int c) { const int st = (r >> 4) * 2 + (c >> 5), rr = r & 15, cc = c & 31, ob = rr * 64 + cc * 2; return st * 1024 + (ob ^ (((ob >> 9) & 1) << 5)); }
__device__ __forceinline__ void stage_rc(int b, int& R, int& C) { const int st = b / 1024, sb = b % 1024, swz = sb ^ (((sb >> 9) & 1) << 5); R = (st >> 1) * 16 + swz / 64; C = (st & 1) * 32 + (swz % 64) / 2; }
__device__ __forceinline__ int perm32(int rho) { const int n = rho >> 4, i = rho & 15; return 8 * (i >> 2) + 4 * n + (i & 3); }
struct Unit { int pm, pn; const char* A; const char* B; };
template <class Epi, class Sched, bool ALIGN_EPI, bool SP2>
__device__ __forceinline__ void gemm_phase(LAS unsigned char* lds, const int lda, const int ldb, const int K, const Sched& S, const Epi& E) {
    __builtin_amdgcn_sched_barrier(0);
    const int tid = tidx(), wid = __builtin_amdgcn_readfirstlane(tid >> 6), lane = tid & 63, wr = wid >> 2, wc = wid & 3, fr = lane & 15, fq = lane >> 4;
    const int nt = K / BK;
    unsigned voffA[2], voffB[2];
#pragma unroll
    for (int i = 0; i < 2; ++i) { int R, C; stage_rc(tid * 16 + i * 8192, R, C); const int Rb = Epi::PERM ? ((R & ~31) + perm32(R & 31)) : R;
        voffA[i] = (unsigned)(R * lda + C) * 2u; voffB[i] = (unsigned)(Rb * ldb + C) * 2u; }
    const size_t kstep = (size_t)(BK * 2);
    const size_t hstepA = (size_t)HALF * lda * 2, hstepB = (size_t)HALF * ldb * 2;
    const unsigned ldsw = (unsigned)wid * 1024u;
    const int aoff = lds_byte(wr * 64 + fr, fq * 8), boff = lds_byte(wc * 32 + fr, fq * 8);
#define PG8_SA(b, h) (((b) * 2 + (h)) * HTB)
#define PG8_SB(b, h) ((4 + (b) * 2 + (h)) * HTB)
#define PG8_STAGE(bufoff, gbase, voff) do { _Pragma("unroll") for (int _i = 0; _i < 2; ++_i) \
        __builtin_amdgcn_global_load_lds((const unsigned*)((const char*)(gbase) + (voff)[_i]), (LAS unsigned*)(lds + (bufoff) + ldsw + _i * 8192), 16, 0, 0); } while (0)
#define PG8_LDA(dst, b, h) do { _Pragma("unroll") for (int m = 0; m < 4; ++m) _Pragma("unroll") for (int k = 0; k < 2; ++k) dst[m][k] = *(const LAS bf16x8*)(lds + PG8_SA(b, h) + aoff + m * 2048 + k * 1024); } while (0)
#define PG8_LDB(dst, b, h) do { _Pragma("unroll") for (int n = 0; n < 2; ++n) _Pragma("unroll") for (int k = 0; k < 2; ++k) dst[n][k] = *(const LAS bf16x8*)(lds + PG8_SB(b, h) + boff + n * 2048 + k * 1024); } while (0)
#define PG8_MMA(ai, bj, At, Bt) do { __builtin_amdgcn_s_setprio(1); _Pragma("unroll") for (int m = 0; m < 4; ++m) _Pragma("unroll") for (int n = 0; n < 2; ++n) _Pragma("unroll") for (int k = 0; k < 2; ++k) \
        acc[ai][bj][m][n] = __builtin_amdgcn_mfma_f32_16x16x32_bf16(Bt[n][k], At[m][k], acc[ai][bj][m][n], 0, 0, 0); __builtin_amdgcn_s_setprio(0); } while (0)
#define PG8_WAIT_V(n) asm volatile("s_waitcnt vmcnt(" #n ")" ::: "memory")
#define PG8_WAIT_L(n) asm volatile("s_waitcnt lgkmcnt(" #n ")" ::: "memory")
#define PG8_BAR __builtin_amdgcn_s_barrier()
#define PG8_SCHED __builtin_amdgcn_sched_barrier(0)
    Unit cur, nxt; int ui = 0;
    if (!S.next(0, cur)) return;
    f32x4 acc[2][2][4][2];
#pragma unroll
    for (int a = 0; a < 2; ++a)
#pragma unroll
        for (int b = 0; b < 2; ++b)
#pragma unroll
            for (int m = 0; m < 4; ++m)
#pragma unroll
                for (int n = 0; n < 2; ++n) acc[a][b][m][n] = (f32x4){0.f, 0.f, 0.f, 0.f};
    bf16x8 At[4][2], B0[2][2], B1[2][2];
    const char* cA = cur.A; const char* cB = cur.B;
    if constexpr (SP2) {
        PG8_STAGE(PG8_SB(0, 0), cB, voffB); PG8_STAGE(PG8_SB(0, 1), cB + hstepB, voffB); PG8_STAGE(PG8_SA(0, 0), cA, voffA); PG8_STAGE(PG8_SA(0, 1), cA + hstepA, voffA);
        if (wr == 1) PG8_BAR;
        PG8_WAIT_V(2); PG8_BAR;
        PG8_STAGE(PG8_SB(1, 0), cB + kstep, voffB); PG8_STAGE(PG8_SA(1, 0), cA + kstep, voffA); PG8_STAGE(PG8_SB(1, 1), cB + hstepB + kstep, voffB);
        PG8_WAIT_V(6); PG8_BAR;
    } else {
        PG8_STAGE(PG8_SB(0, 0), cB, voffB); PG8_STAGE(PG8_SA(0, 0), cA, voffA); PG8_STAGE(PG8_SB(0, 1), cB + hstepB, voffB); PG8_STAGE(PG8_SA(0, 1), cA + hstepA, voffA);
        if (wr == 1) PG8_BAR;
        PG8_WAIT_V(4); PG8_BAR;
        PG8_STAGE(PG8_SB(1, 0), cB + kstep, voffB); PG8_STAGE(PG8_SA(1, 0), cA + kstep, voffA); PG8_STAGE(PG8_SB(1, 1), cB + hstepB + kstep, voffB);
        PG8_WAIT_V(6); PG8_BAR;
    }
    for (;;) {
        const bool has_next = S.next(ui + 1, nxt);
        const char* nA = has_next ? nxt.A : cA; const char* nB = has_next ? nxt.B : cB;
#pragma unroll 1
        for (int t = 0; t < nt; t += 2) {
            const bool last = (t == nt - 2);
            const char* a1 = cA + (size_t)(t + 1) * kstep;
            const char* a2 = last ? nA : cA + (size_t)(t + 2) * kstep; const char* b2 = last ? nB : cB + (size_t)(t + 2) * kstep;
            const char* a3 = a2 + kstep; const char* b3 = b2 + kstep;
            if constexpr (SP2) {
            PG8_LDB(B0, 0, 0); PG8_LDB(B1, 0, 1); PG8_SCHED; PG8_LDA(At, 0, 0); PG8_STAGE(PG8_SA(1, 1), a1 + hstepA, voffA);
            PG8_WAIT_V(8); PG8_WAIT_L(0); PG8_BAR; PG8_MMA(0, 0, At, B0); PG8_MMA(0, 1, At, B1); PG8_BAR; PG8_SCHED;
            PG8_LDA(At, 0, 1); PG8_STAGE(PG8_SB(0, 0), b2, voffB); PG8_STAGE(PG8_SB(0, 1), b2 + hstepB, voffB); PG8_STAGE(PG8_SA(0, 0), a2, voffA);
            PG8_WAIT_V(8); PG8_WAIT_L(0); PG8_BAR; PG8_MMA(1, 0, At, B0); PG8_MMA(1, 1, At, B1); PG8_BAR; PG8_SCHED;
            PG8_LDB(B0, 1, 0); PG8_LDB(B1, 1, 1); PG8_SCHED; PG8_LDA(At, 1, 0); PG8_STAGE(PG8_SA(0, 1), a2 + hstepA, voffA);
            PG8_WAIT_V(8); PG8_WAIT_L(0); PG8_BAR; PG8_MMA(0, 0, At, B0); PG8_MMA(0, 1, At, B1); PG8_BAR; PG8_SCHED;
            PG8_LDA(At, 1, 1); PG8_STAGE(PG8_SB(1, 0), b3, voffB); PG8_STAGE(PG8_SB(1, 1), b3 + hstepB, voffB); PG8_STAGE(PG8_SA(1, 0), a3, voffA);
            PG8_WAIT_V(8); PG8_WAIT_L(0); PG8_BAR; PG8_MMA(1, 0, At, B0); PG8_MMA(1, 1, At, B1); PG8_BAR; PG8_SCHED;
            } else {
            PG8_LDB(B0, 0, 0); PG8_SCHED; PG8_LDA(At, 0, 0); PG8_STAGE(PG8_SA(1, 1), a1 + hstepA, voffA);
            PG8_WAIT_L(8); PG8_BAR; PG8_WAIT_L(0); PG8_MMA(0, 0, At, B0); PG8_BAR; PG8_SCHED;
            PG8_LDB(B1, 0, 1); PG8_STAGE(PG8_SB(0, 0), b2, voffB);
            PG8_BAR; PG8_WAIT_L(0); PG8_MMA(0, 1, At, B1); PG8_BAR;
            PG8_LDA(At, 0, 1); PG8_STAGE(PG8_SA(0, 0), a2, voffA);
            PG8_BAR; PG8_WAIT_L(0); PG8_MMA(1, 0, At, B0); PG8_BAR; PG8_SCHED;
            PG8_STAGE(PG8_SB(0, 1), b2 + hstepB, voffB);
            PG8_WAIT_V(6); PG8_BAR; PG8_MMA(1, 1, At, B1); PG8_BAR;
            PG8_LDB(B0, 1, 0); PG8_SCHED; PG8_LDA(At, 1, 0); PG8_STAGE(PG8_SA(0, 1), a2 + hstepA, voffA);
            PG8_WAIT_L(8); PG8_BAR; PG8_WAIT_L(0); PG8_MMA(0, 0, At, B0); PG8_BAR; PG8_SCHED;
            PG8_LDB(B1, 1, 1); PG8_STAGE(PG8_SB(1, 0), b3, voffB);
            PG8_BAR; PG8_WAIT_L(0); PG8_MMA(0, 1, At, B1); PG8_BAR;
            PG8_LDA(At, 1, 1); PG8_STAGE(PG8_SA(1, 0), a3, voffA);
            PG8_BAR; PG8_WAIT_L(0); PG8_MMA(1, 0, At, B0); PG8_BAR; PG8_SCHED;
            PG8_STAGE(PG8_SB(1, 1), b3 + hstepB, voffB);
            PG8_WAIT_V(6); PG8_BAR; PG8_MMA(1, 1, At, B1); PG8_BAR;
            }
        }
        if constexpr (ALIGN_EPI) { if (wr == 0) PG8_BAR; }
        E(acc, cur, wr, wc, fr, fq);
        if (!has_next) break;
#pragma unroll
        for (int a = 0; a < 2; ++a)
#pragma unroll
            for (int b = 0; b < 2; ++b)
#pragma unroll
                for (int m = 0; m < 4; ++m)
#pragma unroll
                    for (int n = 0; n < 2; ++n) acc[a][b][m][n] = (f32x4){0.f, 0.f, 0.f, 0.f};
        cur = nxt; cA = nA; cB = nB; ++ui;
        if constexpr (ALIGN_EPI) { if (wr == 1) PG8_BAR; }
    }
    PG8_WAIT_V(0);
    if constexpr (!ALIGN_EPI) { if (wr == 0) PG8_BAR; }
    PG8_BAR;
    __builtin_amdgcn_sched_barrier(0);
#undef PG8_SA
#undef PG8_SB
#undef PG8_STAGE
#undef PG8_LDA
#undef PG8_LDB
#undef PG8_MMA
#undef PG8_WAIT_V
#undef PG8_WAIT_L
#undef PG8_BAR
#undef PG8_SCHED
}
struct TileOrder {
    int nN, total; const char* A; const char* B; size_t tA, tB;
    __device__ __forceinline__ bool next(int i, Unit& u) const {
        const int item = blockIdx.x + i * gridDim.x; if (item >= total) return false;
        const int lt = item >> 3; u.pn = lt % nN; u.pm = (lt / nN) * 8 + (item & 7);
        u.A = A + (size_t)u.pm * tA; u.B = B + (size_t)u.pn * tB; return true;
    }
};
}

typedef __bf16 bf16x8_t __attribute__((ext_vector_type(8)));
__device__ __forceinline__ int lds_off(int row, int chunk) { return row * 128 + ((chunk ^ ((row >> 1) & 7)) << 4); }
template <int TM, int TN, int WM, int WN>
__device__ __forceinline__ void gemm_acc(const bf16_t* __restrict__ As, int lda, const bf16_t* __restrict__ Bs, int ldb, int K, f32x16 (&acc)[TM][TN]) {
    static_assert(TM * WM == 4 && TN * WN == 4 && WM * WN == 4, "tile is 128 x 128, 4 waves");
    const int tid = tidx() & 255, lane = tid & 63, wid = tid >> 6, wm = wid / WN, wn = wid % WN, hl = lane >> 5, cl = lane & 31;
    unsigned char* sm = smem + (tidx() >> 8) * 65536;
#pragma unroll
    for (int i = 0; i < TM; ++i)
#pragma unroll
        for (int j = 0; j < TN; ++j)
#pragma unroll
            for (int r = 0; r < 16; ++r) acc[i][j][r] = 0.f;
    const int srow0 = wid * 32 + (lane >> 3), pc = lane & 7;
    const bf16_t* ga[4]; const bf16_t* gb[4];
#pragma unroll
    for (int i = 0; i < 4; ++i) {
        const int row = srow0 + 8 * i, lc = pc ^ ((row >> 1) & 7);
        ga[i] = As + (size_t)row * lda + lc * 8; gb[i] = Bs + (size_t)row * ldb + lc * 8;
    }
    unsigned char* lbase = sm + wid * 4096 + lane * 16;
    __syncthreads();
#pragma unroll
    for (int i = 0; i < 4; ++i) {
        __builtin_amdgcn_global_load_lds((const unsigned*)ga[i], (unsigned*)(lbase + i * 1024), 16, 0, 0);
        __builtin_amdgcn_global_load_lds((const unsigned*)gb[i], (unsigned*)(lbase + 16384 + i * 1024), 16, 0, 0);
    }
    asm volatile("s_waitcnt vmcnt(0)" ::: "memory");
    __syncthreads();
    const int nk = K >> 6;
    for (int kt = 0; kt < nk; ++kt) {
        const int cur = (kt & 1) * 32768, nxt = 32768 - cur;
        if (kt + 1 < nk) {
#pragma unroll
            for (int i = 0; i < 4; ++i) {
                __builtin_amdgcn_global_load_lds((const unsigned*)(ga[i] + (kt + 1) * 64), (unsigned*)(lbase + nxt + i * 1024), 16, 0, 0);
                __builtin_amdgcn_global_load_lds((const unsigned*)(gb[i] + (kt + 1) * 64), (unsigned*)(lbase + nxt + 16384 + i * 1024), 16, 0, 0);
            }
        }
#pragma unroll
        for (int ks = 0; ks < 4; ++ks) {
            bf16x8_t af[TM], bfr[TN];
#pragma unroll
            for (int i = 0; i < TM; ++i) af[i] = __builtin_bit_cast(bf16x8_t, *(const u32x4*)(sm + cur + lds_off(32 * (TM * wm + i) + cl, 2 * ks + hl)));
#pragma unroll
            for (int j = 0; j < TN; ++j) bfr[j] = __builtin_bit_cast(bf16x8_t, *(const u32x4*)(sm + cur + 16384 + lds_off(32 * (TN * wn + j) + cl, 2 * ks + hl)));
#pragma unroll
            for (int i = 0; i < TM; ++i)
#pragma unroll
                for (int j = 0; j < TN; ++j) acc[i][j] = __builtin_amdgcn_mfma_f32_32x32x16_bf16(af[i], bfr[j], acc[i][j], 0, 0, 0);
        }
        asm volatile("s_waitcnt vmcnt(0)" ::: "memory");
        __syncthreads();
    }
}
#define ACC_ROW(TMv, wm, i, r, hl) (32 * ((TMv) * (wm) + (i)) + ((r) & 3) + 8 * ((r) >> 2) + 4 * (hl))
#define ACC_COL(TNv, wn, j, cl)    (32 * ((TNv) * (wn) + (j)) + (cl))

#define N_ADA 384
#define NW_IN   (1792 * 1024)
#define NW_UQ   (768 * 384)
#define NW_UKV  (1024 * 256)
#define NW_GATE (4 * 512 * 128)
#define NW_O    (1024 * 1024)
#define NW_POOL (4 * 256 * 256)
#define NW_PQ   (2048 * 1024)
#define NW_KEYS (16 * 128 * 128)
#define NW_CKV  (8 * 256 * 256)
#define NW_CKR  (8 * 256 * 64)
#define NW_ROPE 3072
#define NW_SP 1024
#define NT_IN 448
#define NT_UQ 72
#define NT_UKV 64
#define NT_O 256
#define NT_POOL 64
#define NT_PQ 512
#define N_TR (NT_IN + NT_UQ + NT_UKV + NT_O + NT_POOL + 2 * NT_PQ)
#define NE_TOTAL (NW_GATE + 2 * NW_KEYS + NW_CKV + NW_CKR + NW_ROPE + NW_SP)
#define N_CONV_ITEMS ((NE_TOTAL + 4095) / 4096)
#define N_FP8_ITEMS (65536 / NWV / 4)

__device__ __forceinline__ void conv_elem(const Params& p, int e) {
    if (e < NW_GATE) {
        const int c = e & 127, cg = (e >> 7) & 511, nb = e >> 16;
        const int dir = cg >> 8, dg = (cg >> 6) & 3, ri = (cg >> 5) & 1, d = dg * 32 + (cg & 31);
        const float* src = ri ? p.w_ig : p.w_rg;
        p.wt_gate[e] = f2bf(src[(((size_t)dir * 4 + nb) * 128 + c) * 128 + d]); return; } e -= NW_GATE;
#pragma unroll
    for (int l = 0; l < 2; ++l) { if (e < NW_KEYS) { p.keysb[l][e] = f2bf(p.peer_keys[l][e]); return; } e -= NW_KEYS; }
    if (e < NW_CKV) { const int col = e & 255, j = (e >> 8) & 255, b = e >> 16; p.ckvk[(size_t)(T_CTX + b * 2304 + j) * 256 + col] = f2bf(p.cache_ckv[e]); return; } e -= NW_CKV;
    if (e < NW_CKR) { const int col = e & 63, j = (e >> 6) & 255, b = e >> 14; p.kropek[(size_t)(T_CTX + b * 2304 + j) * 64 + col] = f2bf(p.cache_krope[e]); return; } e -= NW_CKR;
    if (e < NW_ROPE) {
        int idx = e, isrow = e < 1024; if (!isrow) idx -= 1024;
        const int half = isrow ? 512 : 1024; const int sn = idx >= half; if (sn) idx -= half;
        const int pos = idx >> 4, fi = idx & 15;
        const float invf = exp2f(-(float)fi * (13.287712379549449f / 16.f));
        const float ang = (float)pos * invf;
        p.ropetab[e] = sn ? sinf(ang) : cosf(ang); return; } e -= NW_ROPE;
    if (e < NW_SP) { const float nl = -p.lam[e]; p.spl[e] = fmaxf(nl, 0.f) + log1pf(__expf(-fabsf(nl))); return; }
}
__device__ __forceinline__ void tr_tile(const float* __restrict__ src, int ldsrc, int nvalid, bf16_t* __restrict__ dst, int lddst, int k0, int n0, float scl = 1.f) {
    float* tile = (float*)(smem + (tidx() >> 8) * 32768);
    const int tid = tidx() & 255;
    __syncthreads();
#pragma unroll
    for (int i = 0; i < 4; ++i) {
        const int k = (tid >> 4) + 16 * i, n = (tid & 15) * 4;
        float4 v = make_float4(0.f, 0.f, 0.f, 0.f);
        if (n0 + n < nvalid) v = *(const float4*)(src + (size_t)(k0 + k) * ldsrc + n0 + n);
        tile[k * 65 + n] = v.x; tile[k * 65 + n + 1] = v.y; tile[k * 65 + n + 2] = v.z; tile[k * 65 + n + 3] = v.w;
    }
    __syncthreads();
    const int n = tid >> 2, kq = (tid & 3) * 16;
    unsigned w[8];
#pragma unroll
    for (int j = 0; j < 8; ++j) w[j] = pack_bf16(tile[(kq + 2 * j) * 65 + n] * scl, tile[(kq + 2 * j + 1) * 65 + n] * scl);
    uint4* d = (uint4*)(dst + (size_t)(n0 + n) * lddst + k0 + kq);
    d[0] = make_uint4(w[0], w[1], w[2], w[3]); d[1] = make_uint4(w[4], w[5], w[6], w[7]);
}
__device__ __forceinline__ void tr_item(const Params& p, int t) {
    if (t < NT_IN) { tr_tile(p.w_in, 1728, 1728, p.wt_in, 1024, (t % 16) * 64, (t / 16) * 64); return; } t -= NT_IN;
    if (t < NT_UQ) { tr_tile(p.w_uq, 768, 768, p.wt_uq, 384, (t % 6) * 64, (t / 6) * 64, 0.07216878364870322f * 1.4426950408889634f  ); return; } t -= NT_UQ;
    if (t < NT_UKV) {
        const int n0 = (t / 4) * 64, h = n0 >> 8, kv = (n0 >> 7) & 1, nn = kv * 512 + h * 128 + (n0 & 127);
        tr_tile(p.w_ukv, 1024, 1024, p.wt_ukv + ((ptrdiff_t)nn - n0) * 256, 256, (t % 4) * 64, n0); return; } t -= NT_UKV;
    if (t < NT_O) { tr_tile(p.w_o, 1024, 1024, p.wt_o, 1024, (t % 16) * 64, (t / 16) * 64); return; } t -= NT_O;
    if (t < NT_POOL) { const int g = t >> 4, tt = t & 15; tr_tile(p.w_pool + (size_t)g * 65536, 256, 256, p.wt_pool + (size_t)g * 65536, 256, (tt & 3) * 64, (tt >> 2) * 64); return; } t -= NT_POOL;
    if (t < NT_PQ) { tr_tile(p.peer_wq[0], 2048, 2048, p.wt_pq[0], 1024, (t % 16) * 64, (t / 16) * 64); return; } t -= NT_PQ;
    tr_tile(p.peer_wq[1], 2048, 2048, p.wt_pq[1], 1024, (t % 16) * 64, (t / 16) * 64);
}

__device__ void st_prologue(const Params& p) {
    const int tid = tidx(), lane = tid & 63, wid = tid >> 6;
    const int n_items = N_ADA + N_TR / 2 + N_CONV_ITEMS + N_FP8_ITEMS;
    for (int item = blockIdx.x; item < n_items; item += gridDim.x) {
        if (item < N_ADA) {
            float* svec = (float*)smem;
            float* red = (float*)(smem + 9 * 4096);
            __syncthreads();
            for (int i = tid; i < 9 * 1024; i += NTHR) { const int bc = i >> 10, k = i & 1023; const float cv = bc == 0 ? p.c_ctx[k] : p.c[(size_t)(bc - 1) * 1024 + k]; svec[i] = silu_(cv); }
            __syncthreads();
            const int cidx = item * 32 + (lane & 7) * 4, l = cidx / 6144, col = cidx % 6144, k0 = (wid * 8 + (lane >> 3)) * 16;
            const float* w = p.w_mod[l] + (size_t)k0 * 6144 + col;
            float acc[9][4];
#pragma unroll
            for (int b = 0; b < 9; ++b) { acc[b][0] = 0.f; acc[b][1] = 0.f; acc[b][2] = 0.f; acc[b][3] = 0.f; }
#pragma unroll 8
            for (int k = 0; k < 16; ++k) {
                const float4 wv = *(const float4*)(w + (size_t)k * 6144);
#pragma unroll
                for (int b = 0; b < 9; ++b) { const float sv = svec[b * 1024 + k0 + k]; acc[b][0] += wv.x * sv; acc[b][1] += wv.y * sv; acc[b][2] += wv.z * sv; acc[b][3] += wv.w * sv; }
            }
#pragma unroll
            for (int b = 0; b < 9; ++b)
#pragma unroll
                for (int j = 0; j < 4; ++j) { float v = acc[b][j]; v += __shfl_xor(v, 8); v += __shfl_xor(v, 16); v += __shfl_xor(v, 32); acc[b][j] = v; }
            if (lane < 8) {
#pragma unroll
                for (int b = 0; b < 9; ++b)
#pragma unroll
                    for (int j = 0; j < 4; ++j) red[(wid * 9 + b) * 32 + lane * 4 + j] = acc[b][j];
            }
            __syncthreads();
            for (int i = tid; i < 9 * 32; i += NTHR) {
                const int b = i >> 5, c = i & 31;
                const int ci = item * 32 + c, ll = ci / 6144, cc = ci % 6144;
                float v = 0.f;
#pragma unroll
                for (int w8 = 0; w8 < 8; ++w8) v += red[(w8 * 9 + b) * 32 + c];
                p.mod[(size_t)(ll * 9 + b) * 6144 + cc] = v + p.b_mod[ll][cc];
            }
        } else if (item < N_ADA + N_TR / 2) {
            tr_item(p, (item - N_ADA) * 2 + (tid >> 8));
        } else if (item < N_ADA + N_TR / 2 + N_CONV_ITEMS) {
            const int base = (item - N_ADA - N_TR / 2) * 4096;
            for (int i = tid; i < 4096; i += NTHR) { const int e = base + i; if (e < NE_TOTAL) conv_elem(p, e); }
        } else {
            const int row0 = ((item - N_ADA - N_TR / 2 - N_CONV_ITEMS) * NWV + wid) * 4;
            const int tb = row0 >> 14, er0 = row0 & 16383, l = tb >> 1;
            const float* src = ((tb & 1) ? p.peer_v[l] : p.peer_u[l]) + (size_t)er0 * 1024 + lane * 16;
            u8_t* dst = ((tb & 1) ? p.v8[l] : p.u8[l]) + (size_t)er0 * 512 + lane * 8;
            float* sc = ((tb & 1) ? p.sv[l] : p.su[l]) + er0;
            f32x4v f[4][4];
#pragma unroll
            for (int r = 0; r < 4; ++r)
#pragma unroll
                for (int j = 0; j < 4; ++j) f[r][j] = __builtin_nontemporal_load((const f32x4v*)(src + (size_t)r * 1024 + 4 * j));
#pragma unroll
            for (int r = 0; r < 4; ++r) {
                float am = 0.f, sq = 0.f;
#pragma unroll
                for (int j = 0; j < 4; ++j) {
                    am = fmaxf(fmaxf(am, fmaxf(fabsf(f[r][j][0]), fabsf(f[r][j][1]))), fmaxf(fabsf(f[r][j][2]), fabsf(f[r][j][3])));
                    sq += (f[r][j][0] * f[r][j][0] + f[r][j][1] * f[r][j][1]) + (f[r][j][2] * f[r][j][2] + f[r][j][3] * f[r][j][3]);
                }
                unsigned w[2]; float scale;
                if (tb & 1) {
                    am = wave_max(am);
                    scale = am > 0.f ? am * (1.f / 6.f) : 1.f; const float inv = am > 0.f ? 6.f / am : 1.f;
#pragma unroll
                    for (int j = 0; j < 2; ++j) {
                        unsigned pk = 0u;
                        pk = __builtin_amdgcn_cvt_scalef32_pk_fp4_f32(pk, f[r][2 * j][0] * inv, f[r][2 * j][1] * inv, 1.0f, 0);
                        pk = __builtin_amdgcn_cvt_scalef32_pk_fp4_f32(pk, f[r][2 * j][2] * inv, f[r][2 * j][3] * inv, 1.0f, 1);
                        pk = __builtin_amdgcn_cvt_scalef32_pk_fp4_f32(pk, f[r][2 * j + 1][0] * inv, f[r][2 * j + 1][1] * inv, 1.0f, 2);
                        pk = __builtin_amdgcn_cvt_scalef32_pk_fp4_f32(pk, f[r][2 * j + 1][2] * inv, f[r][2 * j + 1][3] * inv, 1.0f, 3);
                        w[j] = pk;
                    }
                } else {
                    sq = wave_sum(sq);
                    const float rms = sqrtf(sq * (1.f / 1024.f));
                    scale = rms > 0.f ? 0.3352f * rms : 1.f; const float inv = 1.f / scale;
#pragma unroll
                    for (int j = 0; j < 2; ++j) {
                        unsigned pk = 0u;
#pragma unroll
                        for (int i = 0; i < 8; ++i) {
                            const float x = f[r][2 * j + (i >> 2)][i & 3] * inv;
                            const int q = (int)fminf(fmaxf(rintf(x), -8.f), 7.f);
                            pk |= ((unsigned)q & 15u) << (4 * i);
                        }
                        w[j] = pk;
                    }
                }
                *(uint2*)(dst + (size_t)r * 512) = make_uint2(w[0], w[1]);
                if (lane == 0) sc[r] = scale;
            }
        }
    }
}

template <int FIRST>
__device__ void st_resnorm(const Params& p, int l) {
    const int lane = tidx() & 63, wid = tidx() >> 6, stride = gridDim.x * NWV;
    for (int T0 = blockIdx.x * NWV + wid; T0 < T_TOK; T0 += 2 * stride) {
        float4 xa[2][4]; uint4 xb[2][2]; uint4 ma[2][2];
#pragma unroll
        for (int u = 0; u < 2; ++u) {
            const int T = min(T0 + u * stride, T_TOK - 1);
            const uint4* mp = (const uint4*)(p.mix + (size_t)T * 1024 + lane * 16);
            if (FIRST) { const float* x0 = x_in_row(p, T) + lane * 16;
#pragma unroll
                for (int j = 0; j < 4; ++j) xa[u][j] = *(const float4*)(x0 + 4 * j); }
            else { const uint4* xp = (const uint4*)(p.xres + (size_t)T * 1024 + lane * 16); xb[u][0] = xp[0]; xb[u][1] = xp[1]; }
            ma[u][0] = mp[0]; ma[u][1] = mp[1];
        }
#pragma unroll
        for (int u = 0; u < 2; ++u) {
            const int T = T0 + u * stride;
            if (T < T_TOK) {
                const TokInfo ti = tokinfo(T);
                bf16_t* xr = p.xres + (size_t)T * 1024 + lane * 16;
                const float* gt = modv(p, l, ti.mi, 2) + lane * 16;
                float x0v[16];
                if (FIRST) {
#pragma unroll
                    for (int j = 0; j < 4; ++j) { x0v[4 * j] = xa[u][j].x; x0v[4 * j + 1] = xa[u][j].y; x0v[4 * j + 2] = xa[u][j].z; x0v[4 * j + 3] = xa[u][j].w; }
                } else { float t8[8]; unpack8(xb[u][0], t8);
#pragma unroll
                    for (int j = 0; j < 8; ++j) x0v[j] = t8[j];
                    unpack8(xb[u][1], t8);
#pragma unroll
                    for (int j = 0; j < 8; ++j) x0v[8 + j] = t8[j]; }
                float m[16]; { float t8[8]; unpack8(ma[u][0], t8);
#pragma unroll
                    for (int j = 0; j < 8; ++j) m[j] = t8[j];
                    unpack8(ma[u][1], t8);
#pragma unroll
                    for (int j = 0; j < 8; ++j) m[8 + j] = t8[j]; }
                float v[16]; float ss = 0.f;
#pragma unroll
                for (int j = 0; j < 4; ++j) {
                    float4 g = *(const float4*)(gt + 4 * j);
                    if (!FIRST) { const float4 sp = *(const float4*)(p.s_pool + lane * 16 + 4 * j); g.x *= sp.x; g.y *= sp.y; g.z *= sp.z; g.w *= sp.w; }
                    v[4 * j] = x0v[4 * j] + g.x * m[4 * j]; v[4 * j + 1] = x0v[4 * j + 1] + g.y * m[4 * j + 1]; v[4 * j + 2] = x0v[4 * j + 2] + g.z * m[4 * j + 2]; v[4 * j + 3] = x0v[4 * j + 3] + g.w * m[4 * j + 3];
                }
                { uint4* xw = (uint4*)xr;
                  xw[0] = make_uint4(pack_bf16(v[0], v[1]), pack_bf16(v[2], v[3]), pack_bf16(v[4], v[5]), pack_bf16(v[6], v[7]));
                  xw[1] = make_uint4(pack_bf16(v[8], v[9]), pack_bf16(v[10], v[11]), pack_bf16(v[12], v[13]), pack_bf16(v[14], v[15])); }
#pragma unroll
                for (int j = 0; j < 16; ++j) ss += v[j] * v[j];
                ss = wave_sum(ss);
                const float rstd = rsqrtf(ss * (1.f / 1024.f) + 1e-6f);
                const float* sh = modv(p, l, ti.mi, 3) + lane * 16; const float* sc = modv(p, l, ti.mi, 4) + lane * 16; const float* gg = p.g_ffn[l] + lane * 16;
                float hval[16]; float hm = 0.f;
#pragma unroll
                for (int j = 0; j < 16; ++j) { hval[j] = v[j] * rstd * gg[j] * (1.f + sc[j]) + sh[j]; hm = fmaxf(hm, fabsf(hval[j])); }
                unsigned w[8];
#pragma unroll
                for (int j = 0; j < 8; ++j) w[j] = pack_bf16(hval[2 * j], hval[2 * j + 1]);
                uint4* d = (uint4*)(p.hbuf + (size_t)T * 1024 + lane * 16);
                d[0] = make_uint4(w[0], w[1], w[2], w[3]); d[1] = make_uint4(w[4], w[5], w[6], w[7]);
                hm = wave_max(hm);
                const float hs = hm > 0.f ? hm * (1.f / 119.f) : 1.f, hinv = 1.f / hs;
                unsigned ph[2] = {0u, 0u}, pl[2] = {0u, 0u};
#pragma unroll
                for (int j = 0; j < 16; ++j) {
                    const int h8 = (int)rintf(hval[j] * hinv);
                    const int lo = ((h8 + 8) & 15) - 8, hi = (h8 - lo) >> 4;
                    ph[j >> 3] |= ((unsigned)hi & 15u) << (4 * (j & 7)); pl[j >> 3] |= ((unsigned)lo & 15u) << (4 * (j & 7));
                }
                *(uint2*)(p.hqh + (size_t)T * 128 + lane * 2) = make_uint2(ph[0], ph[1]);
                *(uint2*)(p.hql + (size_t)T * 128 + lane * 2) = make_uint2(pl[0], pl[1]);
                if (lane == 0) p.hsc[T] = hs;
            }
        }
    }
}

template <int SRC>
__device__ void st_norm(const Params& p, int l, int which, const float* g, bf16_t* dst) {
    const int lane = tidx() & 63, wid = tidx() >> 6, stride = gridDim.x * NWV;
    for (int T0 = blockIdx.x * NWV + wid; T0 < T_TOK; T0 += 2 * stride) {
        float v[2][16];
#pragma unroll
        for (int u = 0; u < 2; ++u) {
            const int T = min(T0 + u * stride, T_TOK - 1);
            const float* src = x_in_row(p, T) + lane * 16;
#pragma unroll
            for (int j = 0; j < 4; ++j) { const float4 f = *(const float4*)(src + 4 * j); v[u][4 * j] = f.x; v[u][4 * j + 1] = f.y; v[u][4 * j + 2] = f.z; v[u][4 * j + 3] = f.w; }
        }
#pragma unroll
        for (int u = 0; u < 2; ++u) {
            const int T = T0 + u * stride;
            if (T < T_TOK) {
                const TokInfo ti = tokinfo(T);
                float ss = 0.f;
#pragma unroll
                for (int j = 0; j < 16; ++j) ss += v[u][j] * v[u][j];
                ss = wave_sum(ss);
                const float rstd = rsqrtf(ss * (1.f / 1024.f) + 1e-6f);
                const float* sh = modv(p, l, ti.mi, which ? 3 : 0) + lane * 16; const float* sc = modv(p, l, ti.mi, which ? 4 : 1) + lane * 16; const float* gg = g + lane * 16;
                unsigned w[8];
#pragma unroll
                for (int j = 0; j < 8; ++j) w[j] = pack_bf16(v[u][2 * j] * rstd * gg[2 * j] * (1.f + sc[2 * j]) + sh[2 * j], v[u][2 * j + 1] * rstd * gg[2 * j + 1] * (1.f + sc[2 * j + 1]) + sh[2 * j + 1]);
                uint4* d = (uint4*)(dst + (size_t)T * 1024 + lane * 16);
                d[0] = make_uint4(w[0], w[1], w[2], w[3]); d[1] = make_uint4(w[4], w[5], w[6], w[7]);
            }
        }
    }
}

struct EpiStoreBf16 {
    static constexpr bool PERM = true;
    bf16_t* O; int ldc;
    __device__ __forceinline__ void operator()(const pg8::f32x4 (&acc)[2][2][4][2], const pg8::Unit& u, int wr, int wc, int fr, int fq) const {
#pragma unroll
        for (int ai = 0; ai < 2; ++ai)
#pragma unroll
            for (int m = 0; m < 4; ++m) {
                bf16_t* rowp = O + (size_t)(u.pm * 256 + ai * 128 + wr * 64 + m * 16 + fr) * ldc + u.pn * 256 + wc * 32 + 8 * fq;
#pragma unroll
                for (int bj = 0; bj < 2; ++bj) {
                    const pg8::f32x4 v0 = acc[ai][bj][m][0], v1 = acc[ai][bj][m][1];
                    *(uint4*)(rowp + bj * 128) = make_uint4(pack_bf16(v0[0], v0[1]), pack_bf16(v0[2], v0[3]), pack_bf16(v1[0], v1[1]), pack_bf16(v1[2], v1[3]));
                }
            }
    }
};
__device__ void st_gemm1(const Params& p) {
    pg8::TileOrder S; S.nN = 7; S.total = 80 * 7; S.A = (const char*)p.hbuf; S.B = (const char*)p.wt_in; S.tA = (size_t)256 * 1024 * 2; S.tB = (size_t)256 * 1024 * 2;
    EpiStoreBf16 E; E.O = p.P; E.ldc = 1792;
    pg8::gemm_phase<EpiStoreBf16, pg8::TileOrder, true, true>((LAS unsigned char*)smem, 1024, 1024, 1024, S, E);
}

__device__ void st_postproj(const Params& p) {
    const int lane = tidx() & 63, wid = tidx() >> 6;
    float* o_ckv = p.out + 20971520, *o_kr = p.out + 22020096;
    for (int T = blockIdx.x * NWV + wid; T < T_TOK; T += gridDim.x * NWV) {
        const TokInfo ti = tokinfo(T);
        const bf16_t* Pr = p.P + (size_t)T * 1792;
        float cq[8], ck[8];
#pragma unroll
        for (int j = 0; j < 8; ++j) { cq[j] = 0.f; ck[j] = 0.f; }
        if (lane < 48) unpack8(*(const uint4*)(Pr + lane * 8), cq);
        if (lane < 32) unpack8(*(const uint4*)(Pr + 384 + lane * 8), ck);
        float s1 = 0.f, s2 = 0.f;
#pragma unroll
        for (int j = 0; j < 8; ++j) { s1 += cq[j] * cq[j]; s2 += ck[j] * ck[j]; }
        s1 = wave_sum(s1); s2 = wave_sum(s2);
        const float r1 = rsqrtf(s1 * (1.f / 384.f) + 1e-6f), r2 = rsqrtf(s2 * (1.f / 256.f) + 1e-6f);
        if (lane < 48) {
            const float4 ga = *(const float4*)(p.g_q + lane * 8), gb = *(const float4*)(p.g_q + lane * 8 + 4);
            uint4 o; o.x = pack_bf16(cq[0] * r1 * ga.x, cq[1] * r1 * ga.y); o.y = pack_bf16(cq[2] * r1 * ga.z, cq[3] * r1 * ga.w);
            o.z = pack_bf16(cq[4] * r1 * gb.x, cq[5] * r1 * gb.y); o.w = pack_bf16(cq[6] * r1 * gb.z, cq[7] * r1 * gb.w);
            *(uint4*)(p.cqn + (size_t)T * 384 + lane * 8) = o;
        }
        if (lane < 32) {
            const float4 ga = *(const float4*)(p.g_kv + lane * 8), gb = *(const float4*)(p.g_kv + lane * 8 + 4);
            float y[8] = {ck[0] * r2 * ga.x, ck[1] * r2 * ga.y, ck[2] * r2 * ga.z, ck[3] * r2 * ga.w, ck[4] * r2 * gb.x, ck[5] * r2 * gb.y, ck[6] * r2 * gb.z, ck[7] * r2 * gb.w};
            uint4 o; o.x = pack_bf16(y[0], y[1]); o.y = pack_bf16(y[2], y[3]); o.z = pack_bf16(y[4], y[5]); o.w = pack_bf16(y[6], y[7]);
            *(uint4*)(p.ckvk + (size_t)ti.keyrow * 256 + lane * 8) = o;
            if (!ti.smp) { float4* d = (float4*)(o_ckv + (size_t)T * 256 + lane * 8); d[0] = make_float4(y[0], y[1], y[2], y[3]); d[1] = make_float4(y[4], y[5], y[6], y[7]); }
        }
        if (lane < 8) {
            float v[8]; unpack8(*(const uint4*)(Pr + 640 + lane * 8), v);
            float y[8];
            if (ti.smp) {
                const int gr = ti.s >> 6, gc = ti.s & 63;
#pragma unroll
                for (int i = 0; i < 4; ++i) {
                    const int pr = lane * 4 + i;
                    const float cs = pr < 16 ? p.ropetab[gr * 16 + pr] : p.ropetab[1024 + gc * 16 + (pr - 16)];
                    const float sn = pr < 16 ? p.ropetab[512 + gr * 16 + pr] : p.ropetab[2048 + gc * 16 + (pr - 16)];
                    y[2 * i] = v[2 * i] * cs - v[2 * i + 1] * sn; y[2 * i + 1] = v[2 * i] * sn + v[2 * i + 1] * cs;
                }
            } else {
#pragma unroll
                for (int i = 0; i < 8; ++i) y[i] = v[i];
                float4* d = (float4*)(o_kr + (size_t)T * 64 + lane * 8); d[0] = make_float4(v[0], v[1], v[2], v[3]); d[1] = make_float4(v[4], v[5], v[6], v[7]);
            }
            uint4 o; o.x = pack_bf16(y[0], y[1]); o.y = pack_bf16(y[2], y[3]); o.z = pack_bf16(y[4], y[5]); o.w = pack_bf16(y[6], y[7]);
            *(uint4*)(p.kropek + (size_t)ti.keyrow * 64 + lane * 8) = o;
        }
        {
            const int ch = lane * 8;
            float y[8];
            { const float4 a = *(const float4*)(p.conv_b + ch), b = *(const float4*)(p.conv_b + ch + 4); y[0] = a.x; y[1] = a.y; y[2] = a.z; y[3] = a.w; y[4] = b.x; y[5] = b.y; y[6] = b.z; y[7] = b.w; }
#pragma unroll
            for (int k = 0; k < 4; ++k) {
                const int s2i = ti.s + k - 2;
                if (s2i >= 0 && s2i < ti.S) {
                    float u[8]; unpack8(*(const uint4*)(p.P + (size_t)(T + k - 2) * 1792 + 704 + ch), u);
                    const float4 a = *(const float4*)(p.conv_w + k * 512 + ch), b = *(const float4*)(p.conv_w + k * 512 + ch + 4);
                    y[0] += a.x * u[0]; y[1] += a.y * u[1]; y[2] += a.z * u[2]; y[3] += a.w * u[3]; y[4] += b.x * u[4]; y[5] += b.y * u[5]; y[6] += b.z * u[6]; y[7] += b.w * u[7];
                }
            }
            uint4 o; o.x = pack_bf16(y[0], y[1]); o.y = pack_bf16(y[2], y[3]); o.z = pack_bf16(y[4], y[5]); o.w = pack_bf16(y[6], y[7]);
            *(uint4*)(p.xc + (size_t)T * 512 + ch) = o;
            *(uint4*)(p.ug + (size_t)T * 512 + ch) = *(const uint4*)(Pr + 1216 + ch);
        }
    }
}

struct EpiVT {
    static constexpr bool PERM = true;
    bf16_t* vT;
    __device__ __forceinline__ void operator()(const pg8::f32x4 (&acc)[2][2][4][2], const pg8::Unit& u, int wr, int wc, int fr, int fq) const {
        const int R0 = u.pn * 256;
        size_t sbase; int Sk, pos0;
        if (R0 < T_CTX) { Sk = 256; pos0 = 0; sbase = (size_t)(R0 >> 8) * 4 * 128 * 256; }
        else { const int uu = R0 - T_CTX; const int sq = uu / 2304; Sk = 2304; pos0 = uu - sq * 2304; sbase = (size_t)T_CTX * 512 + (size_t)sq * 4 * 128 * 2304; }
        bf16_t* vb = vT + sbase + pos0 + wc * 32 + 8 * fq;
#pragma unroll
        for (int ai = 0; ai < 2; ++ai)
#pragma unroll
            for (int m = 0; m < 4; ++m) {
                const int r = u.pm * 256 + ai * 128 + wr * 64 + m * 16 + fr;
                bf16_t* rowp = vb + (size_t)r * Sk;
#pragma unroll
                for (int bj = 0; bj < 2; ++bj) {
                    const pg8::f32x4 v0 = acc[ai][bj][m][0], v1 = acc[ai][bj][m][1];
                    *(uint4*)(rowp + bj * 128) = make_uint4(pack_bf16(v0[0], v0[1]), pack_bf16(v0[2], v0[3]), pack_bf16(v1[0], v1[1]), pack_bf16(v1[2], v1[3]));
                }
            }
    }
};
#define N_G4 (160 * 16)
__device__ void st_gemm234(const Params& p) {
    {
        pg8::TileOrder S; S.nN = 3; S.total = 80 * 3; S.A = (const char*)p.cqn; S.B = (const char*)p.wt_uq; S.tA = (size_t)256 * 384 * 2; S.tB = (size_t)256 * 384 * 2;
        EpiStoreBf16 E; E.O = p.q; E.ldc = 768;
        pg8::gemm_phase<EpiStoreBf16, pg8::TileOrder, true, true>((LAS unsigned char*)smem, 384, 384, 384, S, E);
    }
    {
        pg8::TileOrder S; S.nN = 2; S.total = 88 * 2; S.A = (const char*)p.ckvk; S.B = (const char*)p.wt_ukv; S.tA = (size_t)256 * 256 * 2; S.tB = (size_t)256 * 256 * 2;
        EpiStoreBf16 E; E.O = p.Kn; E.ldc = 512;
        pg8::gemm_phase<EpiStoreBf16, pg8::TileOrder, true, true>((LAS unsigned char*)smem, 256, 256, 256, S, E);
    }
    {
        struct OrderVT {
            const char* W; const char* Kr;
            __device__ __forceinline__ bool next(int i, pg8::Unit& u) const {
                const int item = blockIdx.x + i * gridDim.x; if (item >= 88 * 2) return false;
                const int lt = item >> 3; u.pm = lt & 1; u.pn = (lt >> 1) * 8 + (item & 7);
                u.A = W + (size_t)u.pm * 256 * 256 * 2; u.B = Kr + (size_t)u.pn * 256 * 256 * 2; return true;
            }
        } S; S.W = (const char*)(p.wt_ukv + (size_t)512 * 256); S.Kr = (const char*)p.ckvk;
        EpiVT E; E.vT = p.vT;
        pg8::gemm_phase<EpiVT, OrderVT, true, true>((LAS unsigned char*)smem, 256, 256, 256, S, E);
    }
}

__device__ void st_gates(const Params& p) {
    const int half = tidx() >> 8, lane = tidx() & 63, wid = (tidx() >> 6) & 3, wm = wid >> 1, wn = wid & 1, hl = lane >> 5, cl = lane & 31;
    for (int item = blockIdx.x; item < N_G4 / 2; item += gridDim.x) {
        f32x16 acc[2][2];
        const int lt = (item >> 3) * 2 + half, tj = lt & 3, nb = (lt >> 2) & 3, tm = (lt >> 4) * 8 + (item & 7);
        gemm_acc<2, 2, 2, 2>(p.wt_gate + ((size_t)nb * 512 + tj * 128) * 128, 128, p.xc + (size_t)tm * 128 * 512 + nb * 128, 512, 128, acc);
        const int dir = tj >> 1, dg = (tj & 1) * 2 + wm;
#pragma unroll
        for (int gq = 0; gq < 4; ++gq) {
            const int ch0 = nb * 128 + dg * 32 + 8 * gq + 4 * hl;
            const float4 brg = *(const float4*)(p.b_rg + dir * 512 + ch0), big = *(const float4*)(p.b_ig + dir * 512 + ch0), sp = *(const float4*)(p.spl + dir * 512 + ch0);
            const float br[4] = {brg.x, brg.y, brg.z, brg.w}, bi[4] = {big.x, big.y, big.z, big.w}, spv[4] = {sp.x, sp.y, sp.z, sp.w};
#pragma unroll
            for (int j = 0; j < 2; ++j) {
                const int T = tm * 128 + 64 * wn + 32 * j + cl;
                const uint2 xr = *(const uint2*)(p.xc + (size_t)T * 512 + ch0);
                const float xv[4] = {__uint_as_float(xr.x << 16), __uint_as_float(xr.x & 0xffff0000u), __uint_as_float(xr.y << 16), __uint_as_float(xr.y & 0xffff0000u)};
                float am[4], bx[4];
#pragma unroll
                for (int e = 0; e < 4; ++e) {
                    const float rg = __builtin_amdgcn_rcpf(1.f + __expf(-(acc[0][j][4 * gq + e] + br[e]))), ig = __builtin_amdgcn_rcpf(1.f + __expf(-(acc[1][j][4 * gq + e] + bi[e])));
                    const float la = -8.f * rg * spv[e];
                    const float av = __expf(la);
                    am[e] = 1.f - av;
                    bx[e] = __builtin_amdgcn_sqrtf(fmaxf(1.f - av * av, 0.f)) * ig * xv[e];
                }
                *(uint2*)(p.a1m + ((size_t)T * 2 + dir) * 512 + ch0) = make_uint2(pack_bf16(am[0], am[1]), pack_bf16(am[2], am[3]));
                *(uint2*)(p.bxb + ((size_t)T * 2 + dir) * 512 + ch0) = make_uint2(pack_bf16(bx[0], bx[1]), pack_bf16(bx[2], bx[3]));
            }
        }
    }
}

#define N_ATT (64 + 256)
#define SCH 64
#define NCHK (T_TOK / SCH)
#define N_S1 (NCHK * 2)
__device__ void scan_s1_item(const Params& p, int it) {
    const int chunk = it >> 1, dc = (it & 1) * 512 + tidx(), dir = dc >> 9, ch = dc & 511;
    const int T0 = chunk * SCH;
    float A = 1.f, B = 0.f;
#pragma unroll 8
    for (int i = 0; i < SCH; ++i) {
        const int T = dir ? (T0 + SCH - 1 - i) : (T0 + i);
        const float av = 1.f - bf2f(p.a1m[((size_t)T * 2 + dir) * 512 + ch]), bv = bf2f(p.bxb[((size_t)T * 2 + dir) * 512 + ch]);
        A *= av; B = B * av + bv;
    }
    *(float2*)(p.agg + (((size_t)chunk * 2 + dir) * 512 + ch) * 2) = make_float2(A, B);
}

__device__ __forceinline__ int perm23(int r) { return (r & 0x13) | ((r & 4) << 1) | ((r & 8) >> 1); }
__device__ void attn_item_mfma(const Params& p, int it) {
    int seq, h, qb, Sk, T0, R0; size_t vbase;
    if (it < 64) { seq = it >> 2; h = it & 3; qb = 0; Sk = 256; T0 = seq * 256; R0 = seq * 256; vbase = (size_t)(seq * 4 + h) * 128 * 256; }
    else { const int u = it - 64; seq = u >> 5; h = (u >> 3) & 3; qb = u & 7; Sk = 2304; T0 = T_CTX + seq * 2048 + qb * 256; R0 = T_CTX + seq * 2304; vbase = (size_t)T_CTX * 512 + (size_t)(seq * 4 + h) * 128 * 2304; }
    const int tid = tidx(), lane = tid & 63, wid = tid >> 6, hl = lane >> 5, cl = lane & 31;
    bf16x8_t qf[12];
    {
        const bf16_t* qrow = p.q + (size_t)(T0 + 32 * wid + cl) * 768 + h * 192 + 8 * hl;
#pragma unroll
        for (int ks = 0; ks < 12; ++ks) qf[ks] = __builtin_bit_cast(bf16x8_t, *(const u32x4*)(qrow + 16 * ks));
        if (it >= 64) {
            const int sp = qb * 256 + 32 * wid + cl, gr = sp >> 6, gc = sp & 63;
#pragma unroll
            for (int ks = 8; ks < 12; ++ks) {
                const u32x4 w = __builtin_bit_cast(u32x4, qf[ks]); u32x4 o;
#pragma unroll
                for (int i = 0; i < 4; ++i) {
                    const int pr = 8 * (ks - 8) + 4 * hl + i;
                    const float cs = ks < 10 ? p.ropetab[gr * 16 + pr] : p.ropetab[1024 + gc * 16 + (pr - 16)];
                    const float sn = ks < 10 ? p.ropetab[512 + gr * 16 + pr] : p.ropetab[2048 + gc * 16 + (pr - 16)];
                    const float x0 = __uint_as_float(w[i] << 16), x1 = __uint_as_float(w[i] & 0xffff0000u);
                    o[i] = pack_bf16(x0 * cs - x1 * sn, x0 * sn + x1 * cs);
                }
                qf[ks] = __builtin_bit_cast(bf16x8_t, o);
            }
        }
    }
    f32x16 oacc[4];
#pragma unroll
    for (int d = 0; d < 4; ++d)
#pragma unroll
        for (int r = 0; r < 16; ++r) oacc[d][r] = 0.f;
    float m = -1e30f, lsum = 0.f;
    const bf16_t* gk = p.Kn + (size_t)(R0 + (tid >> 4)) * 512 + h * 128 + (tid & 15) * 8;
    const bf16_t* gr = p.kropek + (size_t)(R0 + (tid >> 3)) * 64 + (tid & 7) * 8;
    const bf16_t* gv = p.vT + vbase + (size_t)(tid >> 3) * Sk + (tid & 7) * 8;
    u32x4 rk[2], rr, rv[2];
    const int nt = Sk >> 6;
#pragma unroll
    for (int i = 0; i < 2; ++i) rk[i] = *(const u32x4*)(gk + (size_t)(32 * i) * 512);
    rr = *(const u32x4*)gr;
#pragma unroll
    for (int i = 0; i < 2; ++i) rv[i] = *(const u32x4*)(gv + (size_t)(64 * i) * Sk);
    __syncthreads();
    for (int t = 0; t < nt; ++t) {
#pragma unroll
        for (int i = 0; i < 2; ++i) *(u32x4*)(smem + ((tid & 15) >> 3) * 8192 + lds_off((tid >> 4) + 32 * i, tid & 7)) = rk[i];
        *(u32x4*)(smem + 16384 + lds_off(tid >> 3, tid & 7)) = rr;
#pragma unroll
        for (int i = 0; i < 2; ++i) *(u32x4*)(smem + 24576 + lds_off((tid >> 3) + 64 * i, tid & 7)) = rv[i];
        __syncthreads();
        if (t + 1 < nt) {
            const size_t ko = (size_t)(t + 1) * 64;
#pragma unroll
            for (int i = 0; i < 2; ++i) rk[i] = *(const u32x4*)(gk + (ko + 32 * i) * 512);
            rr = *(const u32x4*)(gr + ko * 64);
#pragma unroll
            for (int i = 0; i < 2; ++i) rv[i] = *(const u32x4*)(gv + (size_t)(64 * i) * Sk + ko);
        }
        f32x16 sacc[2];
#pragma unroll
        for (int kb = 0; kb < 2; ++kb) {
            __builtin_amdgcn_sched_barrier(0);
#pragma unroll
            for (int r = 0; r < 16; ++r) sacc[kb][r] = 0.f;
            const int krow = 32 * kb + perm23(cl);
#pragma unroll
            for (int ks = 0; ks < 12; ++ks) {
                const bf16x8_t kf = __builtin_bit_cast(bf16x8_t, *(const u32x4*)(smem + (ks >> 2) * 8192 + lds_off(krow, 2 * (ks & 3) + hl)));
                sacc[kb] = __builtin_amdgcn_mfma_f32_32x32x16_bf16(kf, qf[ks], sacc[kb], 0, 0, 0);
            }
        }
        float mx = sacc[0][0];
#pragma unroll
        for (int r = 1; r < 16; ++r) mx = fmaxf(mx, sacc[0][r]);
#pragma unroll
        for (int r = 0; r < 16; ++r) mx = fmaxf(mx, sacc[1][r]);
        mx = fmaxf(mx, __shfl_xor(mx, 32));
        const bool resc = !__all(mx - m <= 8.f);
        const float mn = resc ? fmaxf(m, mx) : m, alpha = resc ? __builtin_amdgcn_exp2f(m - mn) : 1.f;
        m = mn;
        float ps = 0.f;
        bf16x8_t pf[2][2];
#pragma unroll
        for (int kb = 0; kb < 2; ++kb)
#pragma unroll
            for (int s2 = 0; s2 < 2; ++s2) {
                float e[8];
#pragma unroll
                for (int j = 0; j < 8; ++j) { e[j] = __builtin_amdgcn_exp2f(sacc[kb][8 * s2 + j] - mn); ps += e[j]; }
                u32x4 w; w.x = pack_bf16(e[0], e[1]); w.y = pack_bf16(e[2], e[3]); w.z = pack_bf16(e[4], e[5]); w.w = pack_bf16(e[6], e[7]);
                pf[kb][s2] = __builtin_bit_cast(bf16x8_t, w);
            }
        lsum = lsum * alpha + ps;
        if (resc) {
#pragma unroll
            for (int d = 0; d < 4; ++d)
#pragma unroll
                for (int r = 0; r < 16; ++r) oacc[d][r] *= alpha;
        }
#pragma unroll
        for (int d = 0; d < 4; ++d) {
            __builtin_amdgcn_sched_barrier(0);
#pragma unroll
            for (int kb = 0; kb < 2; ++kb)
#pragma unroll
                for (int s2 = 0; s2 < 2; ++s2) {
                    const bf16x8_t vf = __builtin_bit_cast(bf16x8_t, *(const u32x4*)(smem + 24576 + lds_off(32 * d + cl, 4 * kb + 2 * s2 + hl)));
                    oacc[d] = __builtin_amdgcn_mfma_f32_32x32x16_bf16(vf, pf[kb][s2], oacc[d], 0, 0, 0);
                }
        }
        __builtin_amdgcn_sched_barrier(0);
        __syncthreads();
    }
    lsum += __shfl_xor(lsum, 32);
    const float inv = 1.f / lsum;
    bf16_t* dst = p.hbuf + (size_t)(T0 + 32 * wid + cl) * 1024 + h * 128 + 4 * hl;
#pragma unroll
    for (int d = 0; d < 4; ++d)
#pragma unroll
        for (int g = 0; g < 4; ++g) {
            uint2 w; w.x = pack_bf16(oacc[d][4 * g] * inv, oacc[d][4 * g + 1] * inv); w.y = pack_bf16(oacc[d][4 * g + 2] * inv, oacc[d][4 * g + 3] * inv);
            *(uint2*)(dst + 32 * d + 8 * g) = w;
        }
}
__device__ void st_attn_s1(const Params& p) {
    for (int item = blockIdx.x; item < N_ATT + N_S1; item += gridDim.x) {
        if (item < N_ATT) {
            attn_item_mfma(p, N_ATT - 1 - item);
        }
        else scan_s1_item(p, item - N_ATT);
    }
}

__device__ void st_scan3(const Params& p) {
    const int tid = tidx();
    float* hf = (float*)smem;
    float* hb = hf + SCH * 256;
    float* o_lru = p.out + 22282240;
    for (int item = blockIdx.x; item < NCHK * 2; item += gridDim.x) {
        const int chunk = item >> 1, cgp = item & 1, T0 = chunk * SCH;
        const TokInfo ti = tokinfo(T0);
        const int nch = ti.S / SCH, cpos = ti.s / SCH, c0 = chunk - cpos;
        const int dir = tid >> 8, ch = cgp * 256 + (tid & 255);
        float hcur = ti.smp ? p.state_lru[((size_t)ti.b * 2 + dir) * 512 + ch] : 0.f;
        if (dir == 0) { for (int cc = 0; cc < cpos; ++cc) { const float2 ab = *(const float2*)(p.agg + (((size_t)(c0 + cc) * 2 + 0) * 512 + ch) * 2); hcur = ab.x * hcur + ab.y; } }
        else { for (int cc = nch - 1; cc > cpos; --cc) { const float2 ab = *(const float2*)(p.agg + (((size_t)(c0 + cc) * 2 + 1) * 512 + ch) * 2); hcur = ab.x * hcur + ab.y; } }
        __syncthreads();
#pragma unroll 8
        for (int i = 0; i < SCH; ++i) {
            const int tl = dir ? SCH - 1 - i : i, T = T0 + tl;
            const float av = 1.f - bf2f(p.a1m[((size_t)T * 2 + dir) * 512 + ch]), bv = bf2f(p.bxb[((size_t)T * 2 + dir) * 512 + ch]);
            hcur = av * hcur + bv;
            (dir ? hb : hf)[tl * 256 + (tid & 255)] = hcur;
        }
        if (!ti.smp) {
            if (dir == 0 && cpos == nch - 1) o_lru[((size_t)ti.b * 2 + 0) * 512 + ch] = hcur;
            if (dir == 1 && cpos == 0) o_lru[((size_t)ti.b * 2 + 1) * 512 + ch] = hcur;
        }
        __syncthreads();
        for (int i = tid; i < SCH * 128; i += NTHR) {
            const int tl = i >> 7, c = (i & 127) * 2, T = T0 + tl, chh = cgp * 256 + c;
            const unsigned ugp = *(const unsigned*)(p.ug + (size_t)T * 512 + chh);
            const float g0 = gelu_tanh(__uint_as_float(ugp << 16)), g1 = gelu_tanh(__uint_as_float(ugp & 0xffff0000u));
            const float2 f = *(const float2*)(hf + tl * 256 + c), bb = *(const float2*)(hb + tl * 256 + c);
            *(unsigned*)(p.hbuf + (size_t)T * 1024 + 512 + chh) = pack_bf16((f.x + bb.x) * g0, (f.y + bb.y) * g1);
        }
    }
}

__device__ void st_gemm_o(const Params& p) {
    pg8::TileOrder S; S.nN = 4; S.total = 80 * 4; S.A = (const char*)p.hbuf; S.B = (const char*)p.wt_o; S.tA = (size_t)256 * 1024 * 2; S.tB = (size_t)256 * 1024 * 2;
    EpiStoreBf16 E; E.O = p.mix; E.ldc = 1024;
    pg8::gemm_phase<EpiStoreBf16, pg8::TileOrder, true, true>((LAS unsigned char*)smem, 1024, 1024, 1024, S, E);
}

__device__ __forceinline__ void ce_desc(float& a, float& b) { const float hi = fmaxf(a, b), lo = fminf(a, b); a = hi; b = lo; }
__device__ __forceinline__ void ins16(float (&top)[16], float x) {
#pragma unroll
    for (int i = 0; i < 16; ++i) { const float hi = fmaxf(top[i], x); x = fminf(top[i], x); top[i] = hi; }
}
__device__ __forceinline__ void bitonic_merge16(float (&v)[16]) {
#pragma unroll
    for (int j = 8; j >= 1; j >>= 1)
#pragma unroll
        for (int i = 0; i < 16; ++i) { const int l = i ^ j; if (l > i) ce_desc(v[i], v[l]); }
}
__device__ __forceinline__ void sort16(float (&v)[16]) {
#pragma unroll
    for (int k = 2; k <= 16; k <<= 1)
#pragma unroll
        for (int j = k >> 1; j >= 1; j >>= 1)
#pragma unroll
            for (int i = 0; i < 16; ++i) { const int l = i ^ j; if (l > i) { if ((i & k) == 0) ce_desc(v[i], v[l]); else ce_desc(v[l], v[i]); } }
}
__device__ __forceinline__ void merge_top16(float (&a)[16], const float (&b)[16]) {
#pragma unroll
    for (int i = 0; i < 16; ++i) a[i] = fmaxf(a[i], b[15 - i]);
    bitonic_merge16(a);
}
#define PKV(x) __uint_as_float(__float_as_uint(x) & 0xffffff80u)
#define CAND(i, j) __uint_as_float((__float_as_uint(PKV(top[0][i]) + PKV(top[1][j])) & 0xffffff00u) | (unsigned)((i) * 16 + (j)))
__device__ void st_peer_topk(const Params& p, int l) {
    __builtin_amdgcn_sched_barrier(0);
    const int half = tidx() >> 8, lane = tidx() & 63, wid = (tidx() >> 6) & 3, hl = lane >> 5, cl = lane & 31;
    for (int item = blockIdx.x; item < 80 * 8; item += gridDim.x) {
        const int lt = item >> 3, h = lt & 7, tm = 2 * ((lt >> 3) * 8 + (item & 7)) + half;
        const int T = tm * 128 + 32 * wid + cl;
        float top[2][16];
#pragma unroll
        for (int pp = 0; pp < 2; ++pp) {
            f32x16 acc[4][1];
            gemm_acc<4, 1, 1, 4>(p.keysb[l] + (size_t)(h * 2 + pp) * 128 * 128, 128, p.qp + (size_t)tm * 128 * 2048 + h * 256 + pp * 128, 2048, 128, acc);
#pragma unroll
            for (int i = 0; i < 4; ++i) {
                __builtin_amdgcn_sched_barrier(0);
                float g[16];
#pragma unroll
                for (int r = 0; r < 16; ++r) {
                    const int n = ACC_ROW(4, 0, i, r, hl);
                    g[r] = __uint_as_float((__float_as_uint(acc[i][0][r]) & 0xffffff80u) | (unsigned)n);
                }
                sort16(g);
                if (i == 0) {
#pragma unroll
                    for (int r = 0; r < 16; ++r) top[pp][r] = g[r];
                } else merge_top16(top[pp], g);
            }
            __builtin_amdgcn_sched_barrier(0);
            float oth[16];
#pragma unroll
            for (int i = 0; i < 16; ++i) oth[i] = __shfl_xor(top[pp][i], 32);
            merge_top16(top[pp], oth);
        }
        __builtin_amdgcn_sched_barrier(0);
        float fv[16], t2[16];
#pragma unroll
        for (int j = 0; j < 16; ++j) fv[j] = CAND(0, j);
        t2[15] = -INFINITY;
#pragma unroll
        for (int i = 1; i < 16; ++i) t2[i - 1] = CAND(i, 0);
        merge_top16(fv, t2);
        t2[0] = CAND(1, 1); t2[1] = CAND(1, 2); t2[2] = CAND(1, 3); t2[3] = CAND(1, 4); t2[4] = CAND(1, 5); t2[5] = CAND(1, 6); t2[6] = CAND(1, 7);
        t2[7] = CAND(2, 1); t2[8] = CAND(2, 2); t2[9] = CAND(2, 3); t2[10] = CAND(2, 4); t2[11] = CAND(3, 1); t2[12] = CAND(3, 2); t2[13] = CAND(3, 3);
        t2[14] = CAND(4, 1); t2[15] = CAND(4, 2);
        sort16(t2);
        merge_top16(fv, t2);
        ins16(fv, CAND(5, 1)); ins16(fv, CAND(6, 1)); ins16(fv, CAND(7, 1));
        unsigned* tab = (unsigned*)(smem + half * 65536) + (size_t)(tidx() & 255) * 8;
#pragma unroll
        for (int k = 0; k < 4; ++k) {
            tab[k] = (__float_as_uint(top[0][4 * k]) & 127u) | ((__float_as_uint(top[0][4 * k + 1]) & 127u) << 8) | ((__float_as_uint(top[0][4 * k + 2]) & 127u) << 16) | ((__float_as_uint(top[0][4 * k + 3]) & 127u) << 24);
            tab[4 + k] = (__float_as_uint(top[1][4 * k]) & 127u) | ((__float_as_uint(top[1][4 * k + 1]) & 127u) << 8) | ((__float_as_uint(top[1][4 * k + 2]) & 127u) << 16) | ((__float_as_uint(top[1][4 * k + 3]) & 127u) << 24);
        }
        const u8_t* tabb = (const u8_t*)tab;
        int fe[16];
#pragma unroll
        for (int i = 0; i < 16; ++i) {
            const unsigned code = __float_as_uint(fv[i]) & 255u;
            fe[i] = (int)tabb[code >> 4] * 128 + (int)tabb[16 + (code & 15u)];
            fv[i] = __uint_as_float(__float_as_uint(fv[i]) & 0xffffff00u);
        }
        float sum = 0.f, ev[16];
#pragma unroll
        for (int i = 0; i < 16; ++i) { ev[i] = __expf(fv[i] - fv[0]); sum += ev[i]; }
        const float inv = 1.f / sum;
        if (hl == 0) {
            float4* gp = (float4*)(p.gates + (size_t)T * 128 + h * 16); int4* ep = (int4*)(p.eidx + (size_t)T * 128 + h * 16);
#pragma unroll
            for (int i = 0; i < 4; ++i) { gp[i] = make_float4(ev[4 * i] * inv, ev[4 * i + 1] * inv, ev[4 * i + 2] * inv, ev[4 * i + 3] * inv); ep[i] = make_int4(fe[4 * i], fe[4 * i + 1], fe[4 * i + 2], fe[4 * i + 3]); }
        }
    }
}

__device__ void st_gemm_pq(const Params& p, int l) {
    pg8::TileOrder S; S.nN = 8; S.total = 80 * 8; S.A = (const char*)p.hbuf; S.B = (const char*)p.wt_pq[l]; S.tA = (size_t)256 * 1024 * 2; S.tB = (size_t)256 * 1024 * 2;
    EpiStoreBf16 E; E.O = p.qp; E.ldc = 2048;
    pg8::gemm_phase<EpiStoreBf16, pg8::TileOrder, true, true>((LAS unsigned char*)smem, 1024, 1024, 1024, S, E);
    asm volatile("s_waitcnt vmcnt(0)" ::: "memory");
    __syncthreads();
    st_peer_topk(p, l);
}

#define GT_TPW 10
#define FP4X(dw, b) __builtin_amdgcn_cvt_scalef32_pk_f32_fp4(dw, 1.0f, b)
#define FP4B(dw, b) __builtin_amdgcn_cvt_scalef32_pk_bf16_fp4(dw, 1.0f, b)
__device__ void st_peer_gather(const Params& p, int l) {
    const int lane = tidx() & 63, wid = __builtin_amdgcn_readfirstlane(tidx() >> 6), g = lane >> 3, pc = lane & 7;
    const u8_t* U = p.u8[l]; const u8_t* V = p.v8[l]; const float* SU = p.su[l]; const float* SV = p.sv[l];
    const bool b0 = (lane & 1) != 0, b1 = (lane & 2) != 0, b2 = (lane & 4) != 0, b3 = (lane & 8) != 0;
    const int stride = gridDim.x * NWV, Tfirst = blockIdx.x * NWV + wid;
    const int ka = 16 * g + pc, kb = ka + 8;
    LAS unsigned* eo_l = (LAS unsigned*)(smem + wid * (GT_TPW * 1024));
    LAS float* zw_l = (LAS float*)(smem + wid * (GT_TPW * 1024) + GT_TPW * 512);
#pragma unroll 1
    for (int Tr = Tfirst; Tr < T_TOK; Tr += stride * GT_TPW) {
#pragma unroll
        for (int k = 0; k < GT_TPW; ++k) {
            const int T = Tr + k * stride;
            if (T < T_TOK) { const int2 e = *(const int2*)(p.eidx + (size_t)T * 128 + 2 * lane); *(LAS u32x2*)(eo_l + k * 128 + 2 * lane) = (u32x2){(unsigned)e.x * 512u, (unsigned)e.y * 512u}; }
        }
        __builtin_amdgcn_wave_barrier();
#pragma unroll 1
        for (int c = 0; c < 4; ++c) {
#pragma unroll 1
            for (int k = 0; k < GT_TPW; ++k) {
                const int T = Tr + k * stride;
                if (T >= T_TOK) break;
                u32x4 eo[4];
#pragma unroll
                for (int q = 0; q < 4; ++q) eo[q] = *(LAS const u32x4*)(eo_l + k * 128 + 16 * g + 4 * q);
                const u32x4 hh4 = *(const u32x4*)(p.hqh + (size_t)T * 128 + c * 32 + pc * 4), hl4 = *(const u32x4*)(p.hql + (size_t)T * 128 + c * 32 + pc * 4);
                u32x4 r[16];
#pragma unroll
                for (int i = 0; i < 16; ++i) r[i] = *(const u32x4*)(U + (eo[i >> 2][i & 3] + (unsigned)(c * 128 + pc * 16)));
                float za = 0.f, zb = 0.f;
                if (c > 0) { za = zw_l[k * 128 + ka]; zb = zw_l[k * 128 + kb]; }
#pragma unroll
                for (int hh = 0; hh < 2; ++hh) {
                    float d[8];
#pragma unroll
                    for (int ii = 0; ii < 8; ++ii) {
                        int ah = 0, al = 0;
#pragma unroll
                        for (int q = 0; q < 4; ++q) { ah = __builtin_amdgcn_sdot8((int)r[8 * hh + ii][q], (int)hh4[q], ah, false); al = __builtin_amdgcn_sdot8((int)r[8 * hh + ii][q], (int)hl4[q], al, false); }
                        d[ii] = (float)(ah * 16 + al);
                    }
                    float a4[4], a2[2];
#pragma unroll
                    for (int j = 0; j < 4; ++j) { const float kp = b2 ? d[j + 4] : d[j], sn = b2 ? d[j] : d[j + 4]; a4[j] = kp + DPP_F(sn, 0x141); }
#pragma unroll
                    for (int j = 0; j < 2; ++j) { const float kp = b1 ? a4[j + 2] : a4[j], sn = b1 ? a4[j] : a4[j + 2]; a2[j] = kp + DPP_F(sn, 0x4E); }
                    const float kp = b0 ? a2[1] : a2[0], sn = b0 ? a2[0] : a2[1];
                    const float z = kp + DPP_F(sn, 0xB1);
                    if (hh == 0) za += z; else zb += z;
                }
                if (c < 3) { zw_l[k * 128 + ka] = za; zw_l[k * 128 + kb] = zb; }
                else {
                    const unsigned ea = eo_l[k * 128 + ka] >> 9, eb = eo_l[k * 128 + kb] >> 9;
                    const float ga = p.gates[(size_t)T * 128 + ka], gb = p.gates[(size_t)T * 128 + kb];
                    const float hs = p.hsc[T];
                    zw_l[k * 128 + ka] = ga * gelu_tanh(za * (SU[ea] * hs)) * SV[ea];
                    zw_l[k * 128 + kb] = gb * gelu_tanh(zb * (SU[eb] * hs)) * SV[eb];
                }
            }
        }
        __builtin_amdgcn_wave_barrier();
#pragma unroll 1
        for (int c = 0; c < 4; ++c) {
#pragma unroll 1
            for (int k = 0; k < GT_TPW; ++k) {
                const int T = Tr + k * stride;
                if (T >= T_TOK) break;
                u32x4 eo[4]; f32x4v wv[4];
#pragma unroll
                for (int q = 0; q < 4; ++q) { eo[q] = *(LAS const u32x4*)(eo_l + k * 128 + 16 * g + 4 * q); wv[q] = *(LAS const f32x4v*)(zw_l + k * 128 + 16 * g + 4 * q); }
                u32x4 r[16];
#pragma unroll
                for (int i = 0; i < 16; ++i) r[i] = *(const u32x4*)(V + (eo[i >> 2][i & 3] + (unsigned)(c * 128 + pc * 16)));
                f32x2 acc2[16];
#pragma unroll
                for (int j = 0; j < 16; ++j) acc2[j] = (f32x2){0.f, 0.f};
#pragma unroll
                for (int i = 0; i < 16; ++i) {
                    const f32x2 wk2 = {wv[i >> 2][i & 3], wv[i >> 2][i & 3]};
#pragma unroll
                    for (int q = 0; q < 4; ++q) {
                        acc2[4 * q] = FP4X(r[i][q], 0) * wk2 + acc2[4 * q]; acc2[4 * q + 1] = FP4X(r[i][q], 1) * wk2 + acc2[4 * q + 1];
                        acc2[4 * q + 2] = FP4X(r[i][q], 2) * wk2 + acc2[4 * q + 2]; acc2[4 * q + 3] = FP4X(r[i][q], 3) * wk2 + acc2[4 * q + 3];
                    }
                    __builtin_amdgcn_sched_barrier(0);
                }
                float acc[32];
#pragma unroll
                for (int j = 0; j < 16; ++j) { acc[2 * j] = acc2[j].x; acc[2 * j + 1] = acc2[j].y; }
                float s1[16], s2[8], s3[4];
#pragma unroll
                for (int j = 0; j < 16; ++j) { const u32x2 rr = __builtin_amdgcn_permlane32_swap(__float_as_uint(acc[j]), __float_as_uint(acc[j + 16]), false, false); s1[j] = __uint_as_float(rr[0]) + __uint_as_float(rr[1]); }
#pragma unroll
                for (int j = 0; j < 8; ++j) { const u32x2 rr = __builtin_amdgcn_permlane16_swap(__float_as_uint(s1[j]), __float_as_uint(s1[j + 8]), false, false); s2[j] = __uint_as_float(rr[0]) + __uint_as_float(rr[1]); }
#pragma unroll
                for (int j = 0; j < 4; ++j) { const float kp = b3 ? s2[j + 4] : s2[j], sn = b3 ? s2[j] : s2[j + 4]; s3[j] = kp + DPP_F(sn, 0x128); }
                *(uint2*)(p.mix + (size_t)T * 1024 + c * 256 + pc * 32 + g * 4) = make_uint2(pack_bf16(s3[0], s3[1]), pack_bf16(s3[2], s3[3]));
            }
        }
        __builtin_amdgcn_wave_barrier();
    }
    asm volatile("s_waitcnt vmcnt(0)" ::: "memory");
#pragma unroll 1
    for (int T = Tfirst; T < T_TOK; T += stride) {
        const TokInfo ti = tokinfo(T);
        const int cb = lane * 16;
        float o16[16];
        { const uint4* op = (const uint4*)(p.mix + (size_t)T * 1024 + cb); float t8[8]; unpack8(op[0], t8);
#pragma unroll
          for (int j = 0; j < 8; ++j) o16[j] = t8[j];
          unpack8(op[1], t8);
#pragma unroll
          for (int j = 0; j < 8; ++j) o16[8 + j] = t8[j]; }
        bf16_t* xr = p.xres + (size_t)T * 1024 + cb;
        const float* gt = modv(p, l, ti.mi, 5) + cb;
        float xn[16]; float ss = 0.f;
        { const uint4* xp = (const uint4*)xr; float t8[8]; unpack8(xp[0], t8);
#pragma unroll
          for (int j = 0; j < 8; ++j) xn[j] = t8[j] + gt[j] * o16[j];
          unpack8(xp[1], t8);
#pragma unroll
          for (int j = 0; j < 8; ++j) xn[8 + j] = t8[j] + gt[8 + j] * o16[8 + j]; }
#pragma unroll
        for (int j = 0; j < 16; ++j) ss += xn[j] * xn[j];
        ss = wave_sum(ss);
        const float rstd = rsqrtf(ss * (1.f / 1024.f) + 1e-6f);
        if (l == 0) {
#pragma unroll
            for (int j = 0; j < 1; ++j) { uint4* xw = (uint4*)xr;
                xw[0] = make_uint4(pack_bf16(xn[0], xn[1]), pack_bf16(xn[2], xn[3]), pack_bf16(xn[4], xn[5]), pack_bf16(xn[6], xn[7]));
                xw[1] = make_uint4(pack_bf16(xn[8], xn[9]), pack_bf16(xn[10], xn[11]), pack_bf16(xn[12], xn[13]), pack_bf16(xn[14], xn[15])); }
            const float* sh = modv(p, 1, ti.mi, 0) + cb; const float* sc = modv(p, 1, ti.mi, 1) + cb; const float* gg = p.g_mix[1] + cb;
            unsigned w[8];
#pragma unroll
            for (int j = 0; j < 8; ++j) w[j] = pack_bf16(xn[2 * j] * rstd * gg[2 * j] * (1.f + sc[2 * j]) + sh[2 * j], xn[2 * j + 1] * rstd * gg[2 * j + 1] * (1.f + sc[2 * j + 1]) + sh[2 * j + 1]);
            uint4* dd = (uint4*)(p.h3 + (size_t)T * 1024 + cb);
            dd[0] = make_uint4(w[0], w[1], w[2], w[3]); dd[1] = make_uint4(w[4], w[5], w[6], w[7]);
        } else {
            const float* gg = p.g_final + cb;
            float* y = p.out + (size_t)T * 1024 + cb;
#pragma unroll
            for (int j = 0; j < 4; ++j) *(float4*)(y + 4 * j) = make_float4(xn[4 * j] * rstd * gg[4 * j], xn[4 * j + 1] * rstd * gg[4 * j + 1], xn[4 * j + 2] * rstd * gg[4 * j + 2], xn[4 * j + 3] * rstd * gg[4 * j + 3]);
        }
    }
}

template <int W>
__device__ __forceinline__ void pool_tok(const Params& p, int T, int ck) {
    const TokInfo ti = tokinfo(T);
    const bf16_t* base = p.h3 + (size_t)(T - ti.s) * 1024 + ck * 8;
    uint4 raw[W];
#pragma unroll
    for (int k = 0; k < W; ++k) {
        const int t2 = ti.s - W / 2 + k;
        raw[k] = (t2 >= 0 && t2 < ti.S) ? *(const uint4*)(base + (size_t)t2 * 1024) : make_uint4(0u, 0u, 0u, 0u);
    }
    float acc[8];
#pragma unroll
    for (int j = 0; j < 8; ++j) acc[j] = 0.f;
#pragma unroll
    for (int k = 0; k < W; ++k) { float f[8]; unpack8(raw[k], f);
#pragma unroll
        for (int j = 0; j < 8; ++j) acc[j] += f[j]; }
    float c[8]; unpack8(raw[W / 2], c);
    const int lo = max(ti.s - W / 2, 0), hi = min(ti.s + W / 2, ti.S);
    const float inv = 1.f / (float)(hi - lo);
    uint4 o;
    o.x = pack_bf16(acc[0] * inv - c[0], acc[1] * inv - c[1]); o.y = pack_bf16(acc[2] * inv - c[2], acc[3] * inv - c[3]);
    o.z = pack_bf16(acc[4] * inv - c[4], acc[5] * inv - c[5]); o.w = pack_bf16(acc[6] * inv - c[6], acc[7] * inv - c[7]);
    *(uint4*)(p.hbuf + (size_t)T * 1024 + ck * 8) = o;
}
__device__ void st_pool(const Params& p) {
    const int tid = tidx(), lane = tid & 63, wv = tid >> 6, g = wv & 3, ck = g * 32 + (lane & 31), tsub = (wv >> 2) * 2 + (lane >> 5);
    const int per = (T_TOK + gridDim.x - 1) / gridDim.x, Tb = blockIdx.x * per, Te = min(Tb + per, T_TOK);
    for (int T = Tb + tsub; T < Te; T += 4) {
        if (g == 0) pool_tok<2>(p, T, ck); else if (g == 1) pool_tok<4>(p, T, ck); else if (g == 2) pool_tok<8>(p, T, ck); else pool_tok<16>(p, T, ck);
    }
}

__device__ void st_gemm_pool(const Params& p) {
    struct OrderPool {
        const char* A; const char* B;
        __device__ __forceinline__ bool next(int i, pg8::Unit& u) const {
            const int item = blockIdx.x + i * gridDim.x; if (item >= 80 * 4) return false;
            const int lt = item >> 3; u.pn = lt & 3; u.pm = (lt >> 2) * 8 + (item & 7);
            u.A = A + (size_t)u.pm * 256 * 1024 * 2 + (size_t)u.pn * 256 * 2; u.B = B + (size_t)u.pn * 256 * 256 * 2; return true;
        }
    } S; S.A = (const char*)p.hbuf; S.B = (const char*)p.wt_pool;
    EpiStoreBf16 E; E.O = p.mix; E.ldc = 1024;
    pg8::gemm_phase<EpiStoreBf16, OrderPool, true, true>((LAS unsigned char*)smem, 1024, 256, 256, S, E);
}

__device__ __forceinline__ void run_stage(const Params& p, int s) {
#ifdef ONLY_STAGE
    if (s != ONLY_STAGE) return;
#endif
    switch (s) {
        case 0: st_prologue(p); break;
        case 1: st_norm<0>(p, 0, 0, p.g_mix[0], p.hbuf); break;
        case 2: st_gemm1(p); break;
        case 3: st_postproj(p); break;
        case 4: st_gemm234(p); break;
        case 18: st_gates(p); break;
        case 5: st_attn_s1(p); break;
        case 6: st_scan3(p); break;
        case 7: st_gemm_o(p); break;
        case 8: st_resnorm<1>(p, 0); break;
        case 9: st_gemm_pq(p, 0); break;
        case 11: st_peer_gather(p, 0); break;
        case 12: st_pool(p); break;
        case 13: st_gemm_pool(p); break;
        case 14: st_resnorm<0>(p, 1); break;
        case 15: st_gemm_pq(p, 1); break;
        case 17: st_peer_gather(p, 1); break;
        default: break;
    }
}

__global__ void __launch_bounds__(NTHR, 2) fwd_mega(Params p) {
    cg::grid_group grid = cg::this_grid();
    volatile LAS unsigned* st = (volatile LAS unsigned*)(smem + 131072);
    if (threadIdx.x == 0) { st[0] = 0; st[1] = 0; st[2] = 0; st[3] = 0; }
    wtab_init();
    __syncthreads();
    XcdBarrier b = xcd_barrier_post(p.bar, st);
    if (p.bar == nullptr) grid.sync();
#ifndef REP_MASK
#define REP_MASK 0
#endif
#define MK_ST(k) run_stage(p, k); if ((REP_MASK >> (k)) & 1) { xcd_barrier(b); run_stage(p, k); } if ((k) != 17) xcd_barrier(b);
    MK_ST(0) MK_ST(1) MK_ST(2) MK_ST(3) run_stage(p, 4); MK_ST(18) MK_ST(5) MK_ST(6) MK_ST(7) MK_ST(8) MK_ST(9) MK_ST(11) MK_ST(12) MK_ST(13) MK_ST(14) MK_ST(15) MK_ST(17)
}

extern "C" void kernel_launch(void* const* d_in, const int* in_sizes, int n_in, void* d_out, int out_size, void* d_ws, size_t ws_size, hipStream_t stream) {
    constexpr size_t kDynLds = 131072 + 512;
    static int grid_blocks = 0;
    if (!grid_blocks) {
        int dev = 0, cus = 0, per_cu = 0;
        (void)hipGetDevice(&dev);
        (void)hipDeviceGetAttribute(&cus, hipDeviceAttributeMultiprocessorCount, dev);
        (void)hipFuncSetAttribute((const void*)fwd_mega, hipFuncAttributeMaxDynamicSharedMemorySize, (int)kDynLds);
        (void)hipOccupancyMaxActiveBlocksPerMultiprocessor(&per_cu, fwd_mega, NTHR, kDynLds);
        if (per_cu > 1) per_cu = 1;
        if (per_cu < 1) per_cu = 1;
        grid_blocks = cus * per_cu;
    }
    Params p{};
    const float* const* in = (const float* const*)d_in;
    p.x_prompt = in[0]; p.x_sample = in[1]; p.cache_ckv = in[2]; p.cache_krope = in[3]; p.state_lru = in[4]; p.c = in[5]; p.c_ctx = in[6];
    p.w_mod[0] = in[7]; p.b_mod[0] = in[8]; p.w_mod[1] = in[9]; p.b_mod[1] = in[10];
    p.g_mix[0] = in[11]; p.g_ffn[0] = in[12]; p.g_mix[1] = in[13]; p.g_ffn[1] = in[14];
    p.w_in = in[15]; p.g_q = in[16]; p.w_uq = in[17]; p.g_kv = in[18]; p.w_ukv = in[19]; p.conv_w = in[20]; p.conv_b = in[21];
    p.w_rg = in[22]; p.b_rg = in[23]; p.w_ig = in[24]; p.b_ig = in[25]; p.lam = in[26]; p.w_o = in[27]; p.w_pool = in[28]; p.s_pool = in[29];
    p.peer_wq[0] = in[30]; p.peer_keys[0] = in[31]; p.peer_u[0] = in[32]; p.peer_v[0] = in[33];
    p.peer_wq[1] = in[34]; p.peer_keys[1] = in[35]; p.peer_u[1] = in[36]; p.peer_v[1] = in[37];
    p.g_final = in[38];
    p.out = (float*)d_out;
    char* base = (char*)d_ws; size_t off = 0;
    auto take = [&](size_t bytes) { char* r = base + off; off += (bytes + 255) & ~(size_t)255; return r; };
    const size_t MiB = 1u << 20;
    p.bar = (unsigned*)take(16384);
    p.mod = (float*)take((size_t)2 * 9 * 6144 * 4);
    p.ropetab = (float*)take(3072 * 4); p.spl = (float*)take(1024 * 4);
    p.wt_in = (bf16_t*)take((size_t)NW_IN * 2); p.wt_uq = (bf16_t*)take((size_t)NW_UQ * 2); p.wt_ukv = (bf16_t*)take((size_t)NW_UKV * 2);
    p.wt_gate = (bf16_t*)take((size_t)NW_GATE * 2); p.wt_o = (bf16_t*)take((size_t)NW_O * 2); p.wt_pool = (bf16_t*)take((size_t)NW_POOL * 2);
    p.wt_pq[0] = (bf16_t*)take((size_t)NW_PQ * 2); p.wt_pq[1] = (bf16_t*)take((size_t)NW_PQ * 2);
    p.keysb[0] = (bf16_t*)take((size_t)NW_KEYS * 2); p.keysb[1] = (bf16_t*)take((size_t)NW_KEYS * 2);
    for (int l = 0; l < 2; ++l) { p.u8[l] = (u8_t*)take(16 * MiB); p.v8[l] = (u8_t*)take(16 * MiB); p.su[l] = (float*)take(65536); p.sv[l] = (float*)take(65536); }
    char* regX = take(80 * MiB);
    char* regQ = take(80 * MiB);
    char* regH = take(40 * MiB);
    p.P = (bf16_t*)regX; p.a = (float*)regX; p.a1m = (bf16_t*)regX; p.xres = (bf16_t*)regX;
    p.bxb = (bf16_t*)regQ; p.q = (bf16_t*)(regQ + 40 * MiB); p.agg = (float*)(regQ + 70 * MiB); p.qp = (bf16_t*)regQ; p.h3 = (bf16_t*)regQ;
    p.hbuf = (bf16_t*)regH;
    p.cqn = (bf16_t*)take((size_t)T_TOK * 384 * 2); p.ckvk = (bf16_t*)take((size_t)R_KEYS * 256 * 2); p.kropek = (bf16_t*)take((size_t)R_KEYS * 64 * 2);
    p.xc = (bf16_t*)take((size_t)T_TOK * 512 * 2); p.ug = (bf16_t*)take((size_t)T_TOK * 512 * 2);
    p.mix = p.xc;
    p.Kn = (bf16_t*)take((size_t)R_KEYS * 512 * 2); p.vT = (bf16_t*)take((size_t)R_KEYS * 512 * 2);
    p.zbuf = (float*)p.vT; p.wbuf = p.zbuf + (size_t)T_TOK * 128;
    p.hqh = (unsigned*)p.cqn; p.hql = (unsigned*)p.ckvk; p.hsc = (float*)p.kropek;
    p.gates = (float*)p.Kn; p.eidx = (int*)((char*)p.Kn + (size_t)T_TOK * 128 * 4);
    if (off > ws_size) fprintf(stderr, "workspace too small: need %zu have %zu\n", off, ws_size);
    (void)hipMemsetAsync(d_ws, 0, 16384, stream);
    void* args[] = {&p};
    hipError_t e = hipLaunchCooperativeKernel((void*)fwd_mega, dim3(grid_blocks), dim3(NTHR), args, kDynLds, stream);
    if (e != hipSuccess) fprintf(stderr, "cooperative launch failed: %s (grid %d)\n", hipGetErrorString(e), grid_blocks);
}
```

```cpp
#include <hip/hip_runtime.h>
#include <hip/hip_cooperative_groups.h>
#include <cstdio>
#include <cstdint>
namespace cg = cooperative_groups;


typedef unsigned short bf16_t;
typedef unsigned char u8_t;
typedef float f32x16 __attribute__((ext_vector_type(16)));
typedef float f32x2 __attribute__((ext_vector_type(2)));
typedef unsigned u32x4 __attribute__((ext_vector_type(4)));
typedef float f32x4v __attribute__((ext_vector_type(4)));

#define T_TOK 20480
#define T_CTX 4096
#define R_KEYS 22528
#define NSTAGE 19
#define NTHR 512
#define NWV 8
#define LAS __attribute__((address_space(3)))

#define XB_TMO      128
#define XB_XCNT(j)  (256  + 64 * (j))
#define XB_XSUB(j)  (1280 + 64 * (j))
#define XB_XGEN(j)  (2304 + 64 * (j))
#define XB_TOP      3328
#define XB_TOPGEN   3392
#define XCD_BAR_WORDS 3456
#define XB_SPIN_CAP (1u << 22)
__device__ __forceinline__ unsigned xb_ld(unsigned* p)              { return __hip_atomic_load(p, __ATOMIC_RELAXED, __HIP_MEMORY_SCOPE_AGENT); }
__device__ __forceinline__ unsigned xb_add(unsigned* p, unsigned v) { return __hip_atomic_fetch_add(p, v, __ATOMIC_RELAXED, __HIP_MEMORY_SCOPE_AGENT); }
__device__ __forceinline__ unsigned xb_xcc_id() { return (unsigned)__builtin_amdgcn_s_getreg((3 << 11) | 20) & 0xFu; }
#define XB_SPIN(cond, bar) do { unsigned _sp = 0; while (cond) { __builtin_amdgcn_s_sleep(1); \
    if ((++_sp & 255u) == 0u) { if (xb_ld(&(bar)[XB_TMO])) break; if (_sp > XB_SPIN_CAP) { atomicAdd(&(bar)[XB_TMO], 1u); break; } } } } while (0)
struct XcdBarrier { unsigned* bar; unsigned x; volatile LAS unsigned* st; };
__device__ __forceinline__ XcdBarrier xcd_barrier_post(unsigned* bar, volatile LAS unsigned* st) {
    XcdBarrier b; b.bar = bar; b.x = xb_xcc_id(); b.st = st;
    if (threadIdx.x == 0) (void)xb_add(&bar[XB_XCNT(b.x)], 1u);
    return b;
}
__device__ __forceinline__ void xcd_barrier_complete(unsigned* bar, unsigned x, unsigned& nloc, unsigned& nx) {
    const unsigned G = gridDim.x * gridDim.y * gridDim.z;
    unsigned sum, cnt, mine, sp = 0u;
    for (;;) {
        sum = 0u; cnt = 0u; mine = 0u;
#pragma unroll
        for (unsigned j = 0; j < 16; ++j) { const unsigned c = xb_ld(&bar[XB_XCNT(j)]); sum += c; cnt += (c > 0u) ? 1u : 0u; mine = (j == x) ? c : mine; }
        if (sum == G) break;
        __builtin_amdgcn_s_sleep(1);
        if ((++sp & 255u) == 0u) { if (xb_ld(&bar[XB_TMO])) break; if (sp > XB_SPIN_CAP) { atomicAdd(&bar[XB_TMO], 1u); break; } }
    }
    nloc = mine > 0u ? mine : 1u; nx = cnt > 0u ? cnt : 1u;
}
__device__ __forceinline__ int tidx();
__device__ __forceinline__ void xcd_barrier(const XcdBarrier& b) {
    asm volatile("s_waitcnt vmcnt(0)" ::: "memory");
    __syncthreads();
    if (tidx() == 0) {
        unsigned* bar = b.bar;
        __builtin_amdgcn_s_waitcnt(0);
        unsigned nloc = b.st[0], nx = b.st[1];
        if (nloc == 0u) { xcd_barrier_complete(bar, b.x, nloc, nx); b.st[0] = nloc; b.st[1] = nx; }
        const unsigned old = xb_add(&bar[XB_XSUB(b.x)], 1u);
        const unsigned gen = old / nloc;
        if (old + 1u == (gen + 1u) * nloc) {
            __builtin_amdgcn_fence(__ATOMIC_RELEASE, "agent");
            asm volatile("s_waitcnt vmcnt(0)" ::: "memory");
            const unsigned og = xb_add(&bar[XB_TOP], 1u);
            const unsigned tg = og / nx;
            if (og + 1u == (tg + 1u) * nx) xb_add(&bar[XB_TOPGEN], 1u);
            else XB_SPIN(xb_ld(&bar[XB_TOPGEN]) == tg, bar);
            __builtin_amdgcn_fence(__ATOMIC_ACQUIRE, "agent");
            xb_add(&bar[XB_XGEN(b.x)], 1u);
            asm volatile("s_waitcnt vmcnt(0)" ::: "memory");
        } else {
            XB_SPIN(xb_ld(&bar[XB_XGEN(b.x)]) == gen, bar);
            __builtin_amdgcn_fence(__ATOMIC_ACQUIRE, "agent");
            asm volatile("s_waitcnt vmcnt(0)" ::: "memory");
        }
    }
    __syncthreads();
}

struct Params {
    const float *x_prompt, *x_sample, *cache_ckv, *cache_krope, *state_lru, *c, *c_ctx;
    const float *w_mod[2], *b_mod[2], *g_mix[2], *g_ffn[2];
    const float *w_in, *g_q, *w_uq, *g_kv, *w_ukv, *conv_w, *conv_b, *w_rg, *b_rg, *w_ig, *b_ig, *lam, *w_o, *w_pool, *s_pool;
    const float *peer_wq[2], *peer_keys[2], *peer_u[2], *peer_v[2];
    const float* g_final;
    float* out;
    unsigned* bar; float* mod; float* ropetab;
    bf16_t *wt_in, *wt_uq, *wt_ukv, *wt_gate, *wt_o, *wt_pool, *wt_pq[2], *keysb[2];
    u8_t *u8[2], *v8[2]; float *su[2], *sv[2];
    bf16_t *hbuf, *P, *cqn, *ckvk, *kropek, *xc, *ug, *q, *Kn, *vT, *bxb, *qp, *h3;
    float *a, *agg, *gates; int* eidx; bf16_t* xres;
    bf16_t* mix; float *zbuf, *wbuf; unsigned *hqh, *hql; float* hsc; float* spl; bf16_t* a1m;
};

extern __shared__ __attribute__((aligned(16))) unsigned char smem[];
#define WTAB_OFF (131072 + 64)
__device__ __forceinline__ int hw_wave_slot() { return (int)(__builtin_amdgcn_s_getreg(0x2804) & 63u); }
__device__ __forceinline__ void wtab_init() { if ((threadIdx.x & 63) == 0) ((volatile int*)(smem + WTAB_OFF))[hw_wave_slot()] = (int)(threadIdx.x >> 6); }
__device__ __forceinline__ int tidx() {
    const int w = __builtin_amdgcn_readfirstlane(((volatile int*)(smem + WTAB_OFF))[hw_wave_slot()]);
    return (w << 6) | (int)__builtin_amdgcn_mbcnt_hi(~0u, __builtin_amdgcn_mbcnt_lo(~0u, 0u));
}
__device__ __forceinline__ float bf2f(bf16_t v) { return __uint_as_float(((unsigned)v) << 16); }
typedef __bf16 bf16x2_t __attribute__((ext_vector_type(2)));
__device__ __forceinline__ bf16_t f2bf(float f) { return __builtin_bit_cast(unsigned short, (__bf16)f); }
__device__ __forceinline__ unsigned pack_bf16(float a, float b) { bf16x2_t v = {(__bf16)a, (__bf16)b}; return __builtin_bit_cast(unsigned, v); }
typedef unsigned u32x2 __attribute__((ext_vector_type(2)));
typedef int i32x4 __attribute__((ext_vector_type(4)));
#define DPP_F(v, ctrl) __int_as_float(__builtin_amdgcn_update_dpp(0, __float_as_int(v), ctrl, 0xf, 0xf, true))
__device__ __forceinline__ float wave_sum(float v) {
    v += DPP_F(v, 0xB1); v += DPP_F(v, 0x4E); v += DPP_F(v, 0x141); v += DPP_F(v, 0x128);
    u32x2 r = __builtin_amdgcn_permlane16_swap(__float_as_uint(v), __float_as_uint(v), false, false);
    v = __uint_as_float(r[0]) + __uint_as_float(r[1]);
    r = __builtin_amdgcn_permlane32_swap(__float_as_uint(v), __float_as_uint(v), false, false);
    return __uint_as_float(r[0]) + __uint_as_float(r[1]);
}
__device__ __forceinline__ float wave_max(float v) {
    v = fmaxf(v, DPP_F(v, 0xB1)); v = fmaxf(v, DPP_F(v, 0x4E)); v = fmaxf(v, DPP_F(v, 0x141)); v = fmaxf(v, DPP_F(v, 0x128));
    u32x2 r = __builtin_amdgcn_permlane16_swap(__float_as_uint(v), __float_as_uint(v), false, false);
    v = fmaxf(__uint_as_float(r[0]), __uint_as_float(r[1]));
    r = __builtin_amdgcn_permlane32_swap(__float_as_uint(v), __float_as_uint(v), false, false);
    return fmaxf(__uint_as_float(r[0]), __uint_as_float(r[1]));
}
__device__ __forceinline__ float gelu_tanh(float x) {
    const float u = 0.7978845608028654f * (x + 0.044715f * x * x * x);
    const float e = __expf(2.f * u);
    const float th = 1.f - 2.f / (e + 1.f);
    return 0.5f * x * (1.f + th);
}
__device__ __forceinline__ float sigmoidf_(float x) { return 1.f / (1.f + __expf(-x)); }
__device__ __forceinline__ float silu_(float x) { return x / (1.f + __expf(-x)); }

struct TokInfo { int smp, b, s, S, mi, keyrow; };
__device__ __forceinline__ TokInfo tokinfo(int T) {
    TokInfo t;
    if (T < T_CTX) { t.smp = 0; t.b = T >> 8; t.s = T & 255; t.S = 256; t.mi = 0; t.keyrow = T; }
    else { const int u = T - T_CTX; t.smp = 1; t.b = u >> 11; t.s = u & 2047; t.S = 2048; t.mi = 1 + t.b; t.keyrow = T_CTX + t.b * 2304 + 256 + t.s; }
    return t;
}
__device__ __forceinline__ const float* x_in_row(const Params& p, int T) { return T < T_CTX ? p.x_prompt + (size_t)T * 1024 : p.x_sample + (size_t)(T - T_CTX) * 1024; }
__device__ __forceinline__ const float* modv(const Params& p, int l, int mi, int j) { return p.mod + ((size_t)(l * 9 + mi) * 6 + j) * 1024; }

__device__ __forceinline__ void unpack8(const uint4 r, float (&f)[8]) {
    f[0] = __uint_as_float(r.x << 16); f[1] = __uint_as_float(r.x & 0xffff0000u);
    f[2] = __uint_as_float(r.y << 16); f[3] = __uint_as_float(r.y & 0xffff0000u);
    f[4] = __uint_as_float(r.z << 16); f[5] = __uint_as_float(r.z & 0xffff0000u);
    f[6] = __uint_as_float(r.w << 16); f[7] = __uint_as_float(r.w & 0xffff0000u);
}

namespace pg8 {
typedef short bf16x8 __attribute__((ext_vector_type(8)));
typedef float f32x4 __attribute__((ext_vector_type(4)));
constexpr int BM = 256, BK = 64, HALF = 128, HTB = HALF * BK * 2  , STAGE_BYTES = 8 * HTB;
__device__ __forceinline__ int lds_byte(int r, int c) { const int st = (r >> 4) * 2 + (c >> 5), rr = r & 15, cc = c & 31, ob = rr * 64 + cc * 2; return st * 1024 + (ob ^ (((ob >> 9) & 1) << 5)); }
__device__ __forceinline__ void stage_rc(int b, int& R, int& C) { const int st = b / 1024, sb = b % 1024, swz = sb ^ (((sb >> 9) & 1) << 5); R = (st >> 1) * 16 + swz / 64; C = (st & 1) * 32 + (swz % 64) / 2; }
__device__ __forceinline__ int perm32(int rho) { const int n = rho >> 4, i = rho & 15; return 8 * (i >> 2) + 4 * n + (i & 3); }
struct Unit { int pm, pn; const char* A; const char* B; };
template <class Epi, class Sched, bool ALIGN_EPI, bool SP2>
__device__ __forceinline__ void gemm_phase(LAS unsigned char* lds, const int lda, const int ldb, const int K, const Sched& S, const Epi& E) {
    __builtin_amdgcn_sched_barrier(0);
    const int tid = tidx(), wid = __builtin_amdgcn_readfirstlane(tid >> 6), lane = tid & 63, wr = wid >> 2, wc = wid & 3, fr = lane & 15, fq = lane >> 4;
    const int nt = K / BK;
    unsigned voffA[2], voffB[2];
#pragma unroll
    for (int i = 0; i < 2; ++i) { int R, C; stage_rc(tid * 16 + i * 8192, R, C); const int Rb = Epi::PERM ? ((R & ~31) + perm32(R & 31)) : R;
        voffA[i] = (unsigned)(R * lda + C) * 2u; voffB[i] = (unsigned)(Rb * ldb + C) * 2u; }
    const size_t kstep = (size_t)(BK * 2);
    const size_t hstepA = (size_t)HALF * lda * 2, hstepB = (size_t)HALF * ldb * 2;
    const unsigned ldsw = (unsigned)wid * 1024u;
    const int aoff = lds_byte(wr * 64 + fr, fq * 8), boff = lds_byte(wc * 32 + fr, fq * 8);
#define PG8_SA(b, h) (((b) * 2 + (h)) * HTB)
#define PG8_SB(b, h) ((4 + (b) * 2 + (h)) * HTB)
#define PG8_STAGE(bufoff, gbase, voff) do { _Pragma("unroll") for (int _i = 0; _i < 2; ++_i) \
        __builtin_amdgcn_global_load_lds((const unsigned*)((const char*)(gbase) + (voff)[_i]), (LAS unsigned*)(lds + (bufoff) + ldsw + _i * 8192), 16, 0, 0); } while (0)
#define PG8_LDA(dst, b, h) do { _Pragma("unroll") for (int m = 0; m < 4; ++m) _Pragma("unroll") for (int k = 0; k < 2; ++k) dst[m][k] = *(const LAS bf16x8*)(lds + PG8_SA(b, h) + aoff + m * 2048 + k * 1024); } while (0)
#define PG8_LDB(dst, b, h) do { _Pragma("unroll") for (int n = 0; n < 2; ++n) _Pragma("unroll") for (int k = 0; k < 2; ++k) dst[n][k] = *(const LAS bf16x8*)(lds + PG8_SB(b, h) + boff + n * 2048 + k * 1024); } while (0)
#define PG8_MMA(ai, bj, At, Bt) do { __builtin_amdgcn_s_setprio(1); _Pragma("unroll") for (int m = 0; m < 4; ++m) _Pragma("unroll") for (int n = 0; n < 2; ++n) _Pragma("unroll") for (int k = 0; k < 2; ++k) \
        acc[ai][bj][m][n] = __builtin_amdgcn_mfma_f32_16x16x32_bf16(Bt[n][k], At[m][k], acc[ai][bj][m][n], 0, 0, 0); __builtin_amdgcn_s_setprio(0); } while (0)
#define PG8_WAIT_V(n) asm volatile("s_waitcnt vmcnt(" #n ")" ::: "memory")
#define PG8_WAIT_L(n) asm volatile("s_waitcnt lgkmcnt(" #n ")" ::: "memory")
#define PG8_BAR __builtin_amdgcn_s_barrier()
#define PG8_SCHED __builtin_amdgcn_sched_barrier(0)
    Unit cur, nxt; int ui = 0;
    if (!S.next(0, cur)) return;
    f32x4 acc[2][2][4][2];
#pragma unroll
    for (int a = 0; a < 2; ++a)
#pragma unroll
        for (int b = 0; b < 2; ++b)
#pragma unroll
            for (int m = 0; m < 4; ++m)
#pragma unroll
                for (int n = 0; n < 2; ++n) acc[a][b][m][n] = (f32x4){0.f, 0.f, 0.f, 0.f};
    bf16x8 At[4][2], B0[2][2], B1[2][2];
    const char* cA = cur.A; const char* cB = cur.B;
    if constexpr (SP2) {
        PG8_STAGE(PG8_SB(0, 0), cB, voffB); PG8_STAGE(PG8_SB(0, 1), cB + hstepB, voffB); PG8_STAGE(PG8_SA(0, 0), cA, voffA); PG8_STAGE(PG8_SA(0, 1), cA + hstepA, voffA);
        if (wr == 1) PG8_BAR;
        PG8_WAIT_V(2); PG8_BAR;
        PG8_STAGE(PG8_SB(1, 0), cB + kstep, voffB); PG8_STAGE(PG8_SA(1, 0), cA + kstep, voffA); PG8_STAGE(PG8_SB(1, 1), cB + hstepB + kstep, voffB);
        PG8_WAIT_V(6); PG8_BAR;
    } else {
        PG8_STAGE(PG8_SB(0, 0), cB, voffB); PG8_STAGE(PG8_SA(0, 0), cA, voffA); PG8_STAGE(PG8_SB(0, 1), cB + hstepB, voffB); PG8_STAGE(PG8_SA(0, 1), cA + hstepA, voffA);
        if (wr == 1) PG8_BAR;
        PG8_WAIT_V(4); PG8_BAR;
        PG8_STAGE(PG8_SB(1, 0), cB + kstep, voffB); PG8_STAGE(PG8_SA(1, 0), cA + kstep, voffA); PG8_STAGE(PG8_SB(1, 1), cB + hstepB + kstep, voffB);
        PG8_WAIT_V(6); PG8_BAR;
    }
    for (;;) {
        const bool has_next = S.next(ui + 1, nxt);
        const char* nA = has_next ? nxt.A : cA; const char* nB = has_next ? nxt.B : cB;
#pragma unroll 1
        for (int t = 0; t < nt; t += 2) {
            const bool last = (t == nt - 2);
            const char* a1 = cA + (size_t)(t + 1) * kstep;
            const char* a2 = last ? nA : cA + (size_t)(t + 2) * kstep; const char* b2 = last ? nB : cB + (size_t)(t + 2) * kstep;
            const char* a3 = a2 + kstep; const char* b3 = b2 + kstep;
            if constexpr (SP2) {
            PG8_LDB(B0, 0, 0); PG8_LDB(B1, 0, 1); PG8_SCHED; PG8_LDA(At, 0, 0); PG8_STAGE(PG8_SA(1, 1), a1 + hstepA, voffA);
            PG8_WAIT_V(8); PG8_WAIT_L(0); PG8_BAR; PG8_MMA(0, 0, At, B0); PG8_MMA(0, 1, At, B1); PG8_BAR; PG8_SCHED;
            PG8_LDA(At, 0, 1); PG8_STAGE(PG8_SB(0, 0), b2, voffB); PG8_STAGE(PG8_SB(0, 1), b2 + hstepB, voffB); PG8_STAGE(PG8_SA(0, 0), a2, voffA);
            PG8_WAIT_V(8); PG8_WAIT_L(0); PG8_BAR; PG8_MMA(1, 0, At, B0); PG8_MMA(1, 1, At, B1); PG8_BAR; PG8_SCHED;
            PG8_LDB(B0, 1, 0); PG8_LDB(B1, 1, 1); PG8_SCHED; PG8_LDA(At, 1, 0); PG8_STAGE(PG8_SA(0, 1), a2 + hstepA, voffA);
            PG8_WAIT_V(8); PG8_WAIT_L(0); PG8_BAR; PG8_MMA(0, 0, At, B0); PG8_MMA(0, 1, At, B1); PG8_BAR; PG8_SCHED;
            PG8_LDA(At, 1, 1); PG8_STAGE(PG8_SB(1, 0), b3, voffB); PG8_STAGE(PG8_SB(1, 1), b3 + hstepB, voffB); PG8_STAGE(PG8_SA(1, 0), a3, voffA);
            PG8_WAIT_V(8); PG8_WAIT_L(0); PG8_BAR; PG8_MMA(1, 0, At, B0); PG8_MMA(1, 1, At, B1); PG8_BAR; PG8_SCHED;
            } else {
            PG8_LDB(B0, 0, 0); PG8_SCHED; PG8_LDA(At, 0, 0); PG8_STAGE(PG8_SA(1, 1), a1 + hstepA, voffA);
            PG8_WAIT_L(8); PG8_BAR; PG8_WAIT_L(0); PG8_MMA(0, 0, At, B0); PG8_BAR; PG8_SCHED;
            PG8_LDB(B1, 0, 1); PG8_STAGE(PG8_SB(0, 0), b2, voffB);
            PG8_BAR; PG8_WAIT_L(0); PG8_MMA(0, 1, At, B1); PG8_BAR;
            PG8_LDA(At, 0, 1); PG8_STAGE(PG8_SA(0, 0), a2, voffA);
            PG8_BAR; PG8_WAIT_L(0); PG8_MMA(1, 0, At, B0); PG8_BAR; PG8_SCHED;
            PG8_STAGE(PG8_SB(0, 1), b2 + hstepB, voffB);
            PG8_WAIT_V(6); PG8_BAR; PG8_MMA(1, 1, At, B1); PG8_BAR;
            PG8_LDB(B0, 1, 0); PG8_SCHED; PG8_LDA(At, 1, 0); PG8_STAGE(PG8_SA(0, 1), a2 + hstepA, voffA);
            PG8_WAIT_L(8); PG8_BAR; PG8_WAIT_L(0); PG8_MMA(0, 0, At, B0); PG8_BAR; PG8_SCHED;
            PG8_LDB(B1, 1, 1); PG8_STAGE(PG8_SB(1, 0), b3, voffB);
            PG8_BAR; PG8_WAIT_L(0); PG8_MMA(0, 1, At, B1); PG8_BAR;
            PG8_LDA(At, 1, 1); PG8_STAGE(PG8_SA(1, 0), a3, voffA);
            PG8_BAR; PG8_WAIT_L(0); PG8_MMA(1, 0, At, B0); PG8_BAR; PG8_SCHED;
            PG8_STAGE(PG8_SB(1, 1), b3 + hstepB, voffB);
            PG8_WAIT_V(6); PG8_BAR; PG8_MMA(1, 1, At, B1); PG8_BAR;
            }
        }
        if constexpr (ALIGN_EPI) { if (wr == 0) PG8_BAR; }
        E(acc, cur, wr, wc, fr, fq);
        if (!has_next) break;
#pragma unroll
        for (int a = 0; a < 2; ++a)
#pragma unroll
            for (int b = 0; b < 2; ++b)
#pragma unroll
                for (int m = 0; m < 4; ++m)
#pragma unroll
                    for (int n = 0; n < 2; ++n) acc[a][b][m][n] = (f32x4){0.f, 0.f, 0.f, 0.f};
        cur = nxt; cA = nA; cB = nB; ++ui;
        if constexpr (ALIGN_EPI) { if (wr == 1) PG8_BAR; }
    }
    PG8_WAIT_V(0);
    if constexpr (!ALIGN_EPI) { if (wr == 0) PG8_BAR; }
    PG8_BAR;
    __builtin_amdgcn_sched_barrier(0);
#undef PG8_SA
#undef PG8_SB
#undef PG8_STAGE
#undef PG8_LDA
#undef PG8_LDB
#undef PG8_MMA
#undef PG8_WAIT_V
#undef PG8_WAIT_L
#undef PG8_BAR
#undef PG8_SCHED
}
struct TileOrder {
    int nN, total; const char* A; const char* B; size_t tA, tB;
    __device__ __forceinline__ bool next(int i, Unit& u) const {
        const int item = blockIdx.x + i * gridDim.x; if (item >= total) return false;
        const int lt = item >> 3; u.pn = lt % nN; u.pm = (lt / nN) * 8 + (item & 7);
        u.A = A + (size_t)u.pm * tA; u.B = B + (size_t)u.pn * tB; return true;
    }
};
}

typedef __bf16 bf16x8_t __attribute__((ext_vector_type(8)));
__device__ __forceinline__ int lds_off(int row, int chunk) { return row * 128 + ((chunk ^ ((row >> 1) & 7)) << 4); }
template <int TM, int TN, int WM, int WN>
__device__ __forceinline__ void gemm_acc(const bf16_t* __restrict__ As, int lda, const bf16_t* __restrict__ Bs, int ldb, int K, f32x16 (&acc)[TM][TN]) {
    static_assert(TM * WM == 4 && TN * WN == 4 && WM * WN == 4, "tile is 128 x 128, 4 waves");
    const int tid = tidx() & 255, lane = tid & 63, wid = tid >> 6, wm = wid / WN, wn = wid % WN, hl = lane >> 5, cl = lane & 31;
    unsigned char* sm = smem + (tidx() >> 8) * 65536;
#pragma unroll
    for (int i = 0; i < TM; ++i)
#pragma unroll
        for (int j = 0; j < TN; ++j)
#pragma unroll
            for (int r = 0; r < 16; ++r) acc[i][j][r] = 0.f;
    const int srow0 = wid * 32 + (lane >> 3), pc = lane & 7;
    const bf16_t* ga[4]; const bf16_t* gb[4];
#pragma unroll
    for (int i = 0; i < 4; ++i) {
        const int row = srow0 + 8 * i, lc = pc ^ ((row >> 1) & 7);
        ga[i] = As + (size_t)row * lda + lc * 8; gb[i] = Bs + (size_t)row * ldb + lc * 8;
    }
    unsigned char* lbase = sm + wid * 4096 + lane * 16;
    __syncthreads();
#pragma unroll
    for (int i = 0; i < 4; ++i) {
        __builtin_amdgcn_global_load_lds((const unsigned*)ga[i], (unsigned*)(lbase + i * 1024), 16, 0, 0);
        __builtin_amdgcn_global_load_lds((const unsigned*)gb[i], (unsigned*)(lbase + 16384 + i * 1024), 16, 0, 0);
    }
    asm volatile("s_waitcnt vmcnt(0)" ::: "memory");
    __syncthreads();
    const int nk = K >> 6;
    for (int kt = 0; kt < nk; ++kt) {
        const int cur = (kt & 1) * 32768, nxt = 32768 - cur;
        if (kt + 1 < nk) {
#pragma unroll
            for (int i = 0; i < 4; ++i) {
                __builtin_amdgcn_global_load_lds((const unsigned*)(ga[i] + (kt + 1) * 64), (unsigned*)(lbase + nxt + i * 1024), 16, 0, 0);
                __builtin_amdgcn_global_load_lds((const unsigned*)(gb[i] + (kt + 1) * 64), (unsigned*)(lbase + nxt + 16384 + i * 1024), 16, 0, 0);
            }
        }
#pragma unroll
        for (int ks = 0; ks < 4; ++ks) {
            bf16x8_t af[TM], bfr[TN];
#pragma unroll
            for (int i = 0; i < TM; ++i) af[i] = __builtin_bit_cast(bf16x8_t, *(const u32x4*)(sm + cur + lds_off(32 * (TM * wm + i) + cl, 2 * ks + hl)));
#pragma unroll
            for (int j = 0; j < TN; ++j) bfr[j] = __builtin_bit_cast(bf16x8_t, *(const u32x4*)(sm + cur + 16384 + lds_off(32 * (TN * wn + j) + cl, 2 * ks + hl)));
#pragma unroll
            for (int i = 0; i < TM; ++i)
#pragma unroll
                for (int j = 0; j < TN; ++j) acc[i][j] = __builtin_amdgcn_mfma_f32_32x32x16_bf16(af[i], bfr[j], acc[i][j], 0, 0, 0);
        }
        asm volatile("s_waitcnt vmcnt(0)" ::: "memory");
        __syncthreads();
    }
}
#define ACC_ROW(TMv, wm, i, r, hl) (32 * ((TMv) * (wm) + (i)) + ((r) & 3) + 8 * ((r) >> 2) + 4 * (hl))
#define ACC_COL(TNv, wn, j, cl)    (32 * ((TNv) * (wn) + (j)) + (cl))

#define N_ADA 384
#define NW_IN   (1792 * 1024)
#define NW_UQ   (768 * 384)
#define NW_UKV  (1024 * 256)
#define NW_GATE (4 * 512 * 128)
#define NW_O    (1024 * 1024)
#define NW_POOL (4 * 256 * 256)
#define NW_PQ   (2048 * 1024)
#define NW_KEYS (16 * 128 * 128)
#define NW_CKV  (8 * 256 * 256)
#define NW_CKR  (8 * 256 * 64)
#define NW_ROPE 3072
#define NW_SP 1024
#define NT_IN 448
#define NT_UQ 72
#define NT_UKV 64
#define NT_O 256
#define NT_POOL 64
#define NT_PQ 512
#define N_TR (NT_IN + NT_UQ + NT_UKV + NT_O + NT_POOL + 2 * NT_PQ)
#define NE_TOTAL (NW_GATE + 2 * NW_KEYS + NW_CKV + NW_CKR + NW_ROPE + NW_SP)
#define N_CONV_ITEMS ((NE_TOTAL + 4095) / 4096)
#define N_FP8_ITEMS (65536 / NWV / 4)

__device__ __forceinline__ void conv_elem(const Params& p, int e) {
    if (e < NW_GATE) {
        const int c = e & 127, cg = (e >> 7) & 511, nb = e >> 16;
        const int dir = cg >> 8, dg = (cg >> 6) & 3, ri = (cg >> 5) & 1, d = dg * 32 + (cg & 31);
        const float* src = ri ? p.w_ig : p.w_rg;
        p.wt_gate[e] = f2bf(src[(((size_t)dir * 4 + nb) * 128 + c) * 128 + d]); return; } e -= NW_GATE;
#pragma unroll
    for (int l = 0; l < 2; ++l) { if (e < NW_KEYS) { p.keysb[l][e] = f2bf(p.peer_keys[l][e]); return; } e -= NW_KEYS; }
    if (e < NW_CKV) { const int col = e & 255, j = (e >> 8) & 255, b = e >> 16; p.ckvk[(size_t)(T_CTX + b * 2304 + j) * 256 + col] = f2bf(p.cache_ckv[e]); return; } e -= NW_CKV;
    if (e < NW_CKR) { const int col = e & 63, j = (e >> 6) & 255, b = e >> 14; p.kropek[(size_t)(T_CTX + b * 2304 + j) * 64 + col] = f2bf(p.cache_krope[e]); return; } e -= NW_CKR;
    if (e < NW_ROPE) {
        int idx = e, isrow = e < 1024; if (!isrow) idx -= 1024;
        const int half = isrow ? 512 : 1024; const int sn = idx >= half; if (sn) idx -= half;
        const int pos = idx >> 4, fi = idx & 15;
        const float invf = exp2f(-(float)fi * (13.287712379549449f / 16.f));
        const float ang = (float)pos * invf;
        p.ropetab[e] = sn ? sinf(ang) : cosf(ang); return; } e -= NW_ROPE;
    if (e < NW_SP) { const float nl = -p.lam[e]; p.spl[e] = fmaxf(nl, 0.f) + log1pf(__expf(-fabsf(nl))); return; }
}
__device__ __forceinline__ void tr_tile(const float* __restrict__ src, int ldsrc, int nvalid, bf16_t* __restrict__ dst, int lddst, int k0, int n0, float scl = 1.f) {
    float* tile = (float*)(smem + (tidx() >> 8) * 32768);
    const int tid = tidx() & 255;
    __syncthreads();
#pragma unroll
    for (int i = 0; i < 4; ++i) {
        const int k = (tid >> 4) + 16 * i, n = (tid & 15) * 4;
        float4 v = make_float4(0.f, 0.f, 0.f, 0.f);
        if (n0 + n < nvalid) v = *(const float4*)(src + (size_t)(k0 + k) * ldsrc + n0 + n);
        tile[k * 65 + n] = v.x; tile[k * 65 + n + 1] = v.y; tile[k * 65 + n + 2] = v.z; tile[k * 65 + n + 3] = v.w;
    }
    __syncthreads();
    const int n = tid >> 2, kq = (tid & 3) * 16;
    unsigned w[8];
#pragma unroll
    for (int j = 0; j < 8; ++j) w[j] = pack_bf16(tile[(kq + 2 * j) * 65 + n] * scl, tile[(kq + 2 * j + 1) * 65 + n] * scl);
    uint4* d = (uint4*)(dst + (size_t)(n0 + n) * lddst + k0 + kq);
    d[0] = make_uint4(w[0], w[1], w[2], w[3]); d[1] = make_uint4(w[4], w[5], w[6], w[7]);
}
__device__ __forceinline__ void tr_item(const Params& p, int t) {
    if (t < NT_IN) { tr_tile(p.w_in, 1728, 1728, p.wt_in, 1024, (t % 16) * 64, (t / 16) * 64); return; } t -= NT_IN;
    if (t < NT_UQ) { tr_tile(p.w_uq, 768, 768, p.wt_uq, 384, (t % 6) * 64, (t / 6) * 64, 0.07216878364870322f * 1.4426950408889634f  ); return; } t -= NT_UQ;
    if (t < NT_UKV) {
        const int n0 = (t / 4) * 64, h = n0 >> 8, kv = (n0 >> 7) & 1, nn = kv * 512 + h * 128 + (n0 & 127);
        tr_tile(p.w_ukv, 1024, 1024, p.wt_ukv + ((ptrdiff_t)nn - n0) * 256, 256, (t % 4) * 64, n0); return; } t -= NT_UKV;
    if (t < NT_O) { tr_tile(p.w_o, 1024, 1024, p.wt_o, 1024, (t % 16) * 64, (t / 16) * 64); return; } t -= NT_O;
    if (t < NT_POOL) { const int g = t >> 4, tt = t & 15; tr_tile(p.w_pool + (size_t)g * 65536, 256, 256, p.wt_pool + (size_t)g * 65536, 256, (tt & 3) * 64, (tt >> 2) * 64); return; } t -= NT_POOL;
    if (t < NT_PQ) { tr_tile(p.peer_wq[0], 2048, 2048, p.wt_pq[0], 1024, (t % 16) * 64, (t / 16) * 64); return; } t -= NT_PQ;
    tr_tile(p.peer_wq[1], 2048, 2048, p.wt_pq[1], 1024, (t % 16) * 64, (t / 16) * 64);
}

__device__ void st_prologue(const Params& p) {
    const int tid = tidx(), lane = tid & 63, wid = tid >> 6;
    const int n_items = N_ADA + N_TR / 2 + N_CONV_ITEMS + N_FP8_ITEMS;
    for (int item = blockIdx.x; item < n_items; item += gridDim.x) {
        if (item < N_ADA) {
            float* svec = (float*)smem;
            float* red = (float*)(smem + 9 * 4096);
            __syncthreads();
            for (int i = tid; i < 9 * 1024; i += NTHR) { const int bc = i >> 10, k = i & 1023; const float cv = bc == 0 ? p.c_ctx[k] : p.c[(size_t)(bc - 1) * 1024 + k]; svec[i] = silu_(cv); }
            __syncthreads();
            const int cidx = item * 32 + (lane & 7) * 4, l = cidx / 6144, col = cidx % 6144, k0 = (wid * 8 + (lane >> 3)) * 16;
            const float* w = p.w_mod[l] + (size_t)k0 * 6144 + col;
            float acc[9][4];
#pragma unroll
            for (int b = 0; b < 9; ++b) { acc[b][0] = 0.f; acc[b][1] = 0.f; acc[b][2] = 0.f; acc[b][3] = 0.f; }
#pragma unroll 8
            for (int k = 0; k < 16; ++k) {
                const float4 wv = *(const float4*)(w + (size_t)k * 6144);
#pragma unroll
                for (int b = 0; b < 9; ++b) { const float sv = svec[b * 1024 + k0 + k]; acc[b][0] += wv.x * sv; acc[b][1] += wv.y * sv; acc[b][2] += wv.z * sv; acc[b][3] += wv.w * sv; }
            }
#pragma unroll
            for (int b = 0; b < 9; ++b)
#pragma unroll
                for (int j = 0; j < 4; ++j) { float v = acc[b][j]; v += __shfl_xor(v, 8); v += __shfl_xor(v, 16); v += __shfl_xor(v, 32); acc[b][j] = v; }
            if (lane < 8) {
#pragma unroll
                for (int b = 0; b < 9; ++b)
#pragma unroll
                    for (int j = 0; j < 4; ++j) red[(wid * 9 + b) * 32 + lane * 4 + j] = acc[b][j];
            }
            __syncthreads();
            for (int i = tid; i < 9 * 32; i += NTHR) {
                const int b = i >> 5, c = i & 31;
                const int ci = item * 32 + c, ll = ci / 6144, cc = ci % 6144;
                float v = 0.f;
#pragma unroll
                for (int w8 = 0; w8 < 8; ++w8) v += red[(w8 * 9 + b) * 32 + c];
                p.mod[(size_t)(ll * 9 + b) * 6144 + cc] = v + p.b_mod[ll][cc];
            }
        } else if (item < N_ADA + N_TR / 2) {
            tr_item(p, (item - N_ADA) * 2 + (tid >> 8));
        } else if (item < N_ADA + N_TR / 2 + N_CONV_ITEMS) {
            const int base = (item - N_ADA - N_TR / 2) * 4096;
            for (int i = tid; i < 4096; i += NTHR) { const int e = base + i; if (e < NE_TOTAL) conv_elem(p, e); }
        } else {
            const int row0 = ((item - N_ADA - N_TR / 2 - N_CONV_ITEMS) * NWV + wid) * 4;
            const int tb = row0 >> 14, er0 = row0 & 16383, l = tb >> 1;
            const float* src = ((tb & 1) ? p.peer_v[l] : p.peer_u[l]) + (size_t)er0 * 1024 + lane * 16;
            u8_t* dst = ((tb & 1) ? p.v8[l] : p.u8[l]) + (size_t)er0 * 512 + lane * 8;
            float* sc = ((tb & 1) ? p.sv[l] : p.su[l]) + er0;
            f32x4v f[4][4];
#pragma unroll
            for (int r = 0; r < 4; ++r)
#pragma unroll
                for (int j = 0; j < 4; ++j) f[r][j] = __builtin_nontemporal_load((const f32x4v*)(src + (size_t)r * 1024 + 4 * j));
#pragma unroll
            for (int r = 0; r < 4; ++r) {
                float am = 0.f, sq = 0.f;
#pragma unroll
                for (int j = 0; j < 4; ++j) {
                    am = fmaxf(fmaxf(am, fmaxf(fabsf(f[r][j][0]), fabsf(f[r][j][1]))), fmaxf(fabsf(f[r][j][2]), fabsf(f[r][j][3])));
                    sq += (f[r][j][0] * f[r][j][0] + f[r][j][1] * f[r][j][1]) + (f[r][j][2] * f[r][j][2] + f[r][j][3] * f[r][j][3]);
                }
                unsigned w[2]; float scale;
                if (tb & 1) {
                    sq = wave_sum(sq);
                    const float rms = sqrtf(sq * (1.f / 1024.f));
                    scale = rms > 0.f ? 0.3352f * rms : 1.f; const float inv = 1.f / scale;
#pragma unroll
                    for (int j = 0; j < 2; ++j) {
                        unsigned pk = 0u;
#pragma unroll
                        for (int i = 0; i < 8; ++i) {
                            const float x = f[r][2 * j + (i >> 2)][i & 3] * inv;
                            const int q = (int)fminf(fmaxf(rintf(x), -8.f), 7.f) + 8;
                            pk |= (unsigned)q << (8 * (i & 3) + 4 * (i >> 2));
                        }
                        w[j] = pk;
                    }
                } else {
                    sq = wave_sum(sq);
                    const float rms = sqrtf(sq * (1.f / 1024.f));
                    scale = rms > 0.f ? 0.3352f * rms : 1.f; const float inv = 1.f / scale;
#pragma unroll
                    for (int j = 0; j < 2; ++j) {
                        unsigned pk = 0u;
#pragma unroll
                        for (int i = 0; i < 8; ++i) {
                            const float x = f[r][2 * j + (i >> 2)][i & 3] * inv;
                            const int q = (int)fminf(fmaxf(rintf(x), -8.f), 7.f);
                            pk |= ((unsigned)q & 15u) << (4 * i);
                        }
                        w[j] = pk;
                    }
                }
                *(uint2*)(dst + (size_t)r * 512) = make_uint2(w[0], w[1]);
                if (lane == 0) sc[r] = scale;
            }
        }
    }
}

template <int FIRST>
__device__ void st_resnorm(const Params& p, int l) {
    const int lane = tidx() & 63, wid = tidx() >> 6, stride = gridDim.x * NWV;
    for (int T0 = blockIdx.x * NWV + wid; T0 < T_TOK; T0 += 2 * stride) {
        float4 xa[2][4]; uint4 xb[2][2]; uint4 ma[2][2];
#pragma unroll
        for (int u = 0; u < 2; ++u) {
            const int T = min(T0 + u * stride, T_TOK - 1);
            const uint4* mp = (const uint4*)(p.mix + (size_t)T * 1024 + lane * 16);
            if (FIRST) { const float* x0 = x_in_row(p, T) + lane * 16;
#pragma unroll
                for (int j = 0; j < 4; ++j) xa[u][j] = *(const float4*)(x0 + 4 * j); }
            else { const uint4* xp = (const uint4*)(p.xres + (size_t)T * 1024 + lane * 16); xb[u][0] = xp[0]; xb[u][1] = xp[1]; }
            ma[u][0] = mp[0]; ma[u][1] = mp[1];
        }
#pragma unroll
        for (int u = 0; u < 2; ++u) {
            const int T = T0 + u * stride;
            if (T < T_TOK) {
                const TokInfo ti = tokinfo(T);
                bf16_t* xr = p.xres + (size_t)T * 1024 + lane * 16;
                const float* gt = modv(p, l, ti.mi, 2) + lane * 16;
                float x0v[16];
                if (FIRST) {
#pragma unroll
                    for (int j = 0; j < 4; ++j) { x0v[4 * j] = xa[u][j].x; x0v[4 * j + 1] = xa[u][j].y; x0v[4 * j + 2] = xa[u][j].z; x0v[4 * j + 3] = xa[u][j].w; }
                } else { float t8[8]; unpack8(xb[u][0], t8);
#pragma unroll
                    for (int j = 0; j < 8; ++j) x0v[j] = t8[j];
                    unpack8(xb[u][1], t8);
#pragma unroll
                    for (int j = 0; j < 8; ++j) x0v[8 + j] = t8[j]; }
                float m[16]; { float t8[8]; unpack8(ma[u][0], t8);
#pragma unroll
                    for (int j = 0; j < 8; ++j) m[j] = t8[j];
                    unpack8(ma[u][1], t8);
#pragma unroll
                    for (int j = 0; j < 8; ++j) m[8 + j] = t8[j]; }
                float v[16]; float ss = 0.f;
#pragma unroll
                for (int j = 0; j < 4; ++j) {
                    float4 g = *(const float4*)(gt + 4 * j);
                    if (!FIRST) { const float4 sp = *(const float4*)(p.s_pool + lane * 16 + 4 * j); g.x *= sp.x; g.y *= sp.y; g.z *= sp.z; g.w *= sp.w; }
                    v[4 * j] = x0v[4 * j] + g.x * m[4 * j]; v[4 * j + 1] = x0v[4 * j + 1] + g.y * m[4 * j + 1]; v[4 * j + 2] = x0v[4 * j + 2] + g.z * m[4 * j + 2]; v[4 * j + 3] = x0v[4 * j + 3] + g.w * m[4 * j + 3];
                }
                { uint4* xw = (uint4*)xr;
                  xw[0] = make_uint4(pack_bf16(v[0], v[1]), pack_bf16(v[2], v[3]), pack_bf16(v[4], v[5]), pack_bf16(v[6], v[7]));
                  xw[1] = make_uint4(pack_bf16(v[8], v[9]), pack_bf16(v[10], v[11]), pack_bf16(v[12], v[13]), pack_bf16(v[14], v[15])); }
#pragma unroll
                for (int j = 0; j < 16; ++j) ss += v[j] * v[j];
                ss = wave_sum(ss);
                const float rstd = rsqrtf(ss * (1.f / 1024.f) + 1e-6f);
                const float* sh = modv(p, l, ti.mi, 3) + lane * 16; const float* sc = modv(p, l, ti.mi, 4) + lane * 16; const float* gg = p.g_ffn[l] + lane * 16;
                float hval[16]; float hm = 0.f;
#pragma unroll
                for (int j = 0; j < 16; ++j) { hval[j] = v[j] * rstd * gg[j] * (1.f + sc[j]) + sh[j]; hm = fmaxf(hm, fabsf(hval[j])); }
                unsigned w[8];
#pragma unroll
                for (int j = 0; j < 8; ++j) w[j] = pack_bf16(hval[2 * j], hval[2 * j + 1]);
                uint4* d = (uint4*)(p.hbuf + (size_t)T * 1024 + lane * 16);
                d[0] = make_uint4(w[0], w[1], w[2], w[3]); d[1] = make_uint4(w[4], w[5], w[6], w[7]);
                hm = wave_max(hm);
                const float hs = hm > 0.f ? hm * (1.f / 119.f) : 1.f, hinv = 1.f / hs;
                unsigned ph[2] = {0u, 0u}, pl[2] = {0u, 0u};
#pragma unroll
                for (int j = 0; j < 16; ++j) {
                    const int h8 = (int)rintf(hval[j] * hinv);
                    const int lo = ((h8 + 8) & 15) - 8, hi = (h8 - lo) >> 4;
                    ph[j >> 3] |= ((unsigned)hi & 15u) << (4 * (j & 7)); pl[j >> 3] |= ((unsigned)lo & 15u) << (4 * (j & 7));
                }
                *(uint2*)(p.hqh + (size_t)T * 128 + lane * 2) = make_uint2(ph[0], ph[1]);
                *(uint2*)(p.hql + (size_t)T * 128 + lane * 2) = make_uint2(pl[0], pl[1]);
                if (lane == 0) p.hsc[T] = hs;
            }
        }
    }
}

template <int SRC>
__device__ void st_norm(const Params& p, int l, int which, const float* g, bf16_t* dst) {
    const int lane = tidx() & 63, wid = tidx() >> 6, stride = gridDim.x * NWV;
    for (int T0 = blockIdx.x * NWV + wid; T0 < T_TOK; T0 += 2 * stride) {
        float v[2][16];
#pragma unroll
        for (int u = 0; u < 2; ++u) {
            const int T = min(T0 + u * stride, T_TOK - 1);
            const float* src = x_in_row(p, T) + lane * 16;
#pragma unroll
            for (int j = 0; j < 4; ++j) { const float4 f = *(const float4*)(src + 4 * j); v[u][4 * j] = f.x; v[u][4 * j + 1] = f.y; v[u][4 * j + 2] = f.z; v[u][4 * j + 3] = f.w; }
        }
#pragma unroll
        for (int u = 0; u < 2; ++u) {
            const int T = T0 + u * stride;
            if (T < T_TOK) {
                const TokInfo ti = tokinfo(T);
                float ss = 0.f;
#pragma unroll
                for (int j = 0; j < 16; ++j) ss += v[u][j] * v[u][j];
                ss = wave_sum(ss);
                const float rstd = rsqrtf(ss * (1.f / 1024.f) + 1e-6f);
                const float* sh = modv(p, l, ti.mi, which ? 3 : 0) + lane * 16; const float* sc = modv(p, l, ti.mi, which ? 4 : 1) + lane * 16; const float* gg = g + lane * 16;
                unsigned w[8];
#pragma unroll
                for (int j = 0; j < 8; ++j) w[j] = pack_bf16(v[u][2 * j] * rstd * gg[2 * j] * (1.f + sc[2 * j]) + sh[2 * j], v[u][2 * j + 1] * rstd * gg[2 * j + 1] * (1.f + sc[2 * j + 1]) + sh[2 * j + 1]);
                uint4* d = (uint4*)(dst + (size_t)T * 1024 + lane * 16);
                d[0] = make_uint4(w[0], w[1], w[2], w[3]); d[1] = make_uint4(w[4], w[5], w[6], w[7]);
            }
        }
    }
}

struct EpiStoreBf16 {
    static constexpr bool PERM = true;
    bf16_t* O; int ldc;
    __device__ __forceinline__ void operator()(const pg8::f32x4 (&acc)[2][2][4][2], const pg8::Unit& u, int wr, int wc, int fr, int fq) const {
#pragma unroll
        for (int ai = 0; ai < 2; ++ai)
#pragma unroll
            for (int m = 0; m < 4; ++m) {
                bf16_t* rowp = O + (size_t)(u.pm * 256 + ai * 128 + wr * 64 + m * 16 + fr) * ldc + u.pn * 256 + wc * 32 + 8 * fq;
#pragma unroll
                for (int bj = 0; bj < 2; ++bj) {
                    const pg8::f32x4 v0 = acc[ai][bj][m][0], v1 = acc[ai][bj][m][1];
                    *(uint4*)(rowp + bj * 128) = make_uint4(pack_bf16(v0[0], v0[1]), pack_bf16(v0[2], v0[3]), pack_bf16(v1[0], v1[1]), pack_bf16(v1[2], v1[3]));
                }
            }
    }
};
__device__ void st_gemm1(const Params& p) {
    pg8::TileOrder S; S.nN = 7; S.total = 80 * 7; S.A = (const char*)p.hbuf; S.B = (const char*)p.wt_in; S.tA = (size_t)256 * 1024 * 2; S.tB = (size_t)256 * 1024 * 2;
    EpiStoreBf16 E; E.O = p.P; E.ldc = 1792;
    pg8::gemm_phase<EpiStoreBf16, pg8::TileOrder, true, true>((LAS unsigned char*)smem, 1024, 1024, 1024, S, E);
}

__device__ void st_postproj(const Params& p) {
    const int lane = tidx() & 63, wid = tidx() >> 6;
    float* o_ckv = p.out + 20971520, *o_kr = p.out + 22020096;
    for (int T = blockIdx.x * NWV + wid; T < T_TOK; T += gridDim.x * NWV) {
        const TokInfo ti = tokinfo(T);
        const bf16_t* Pr = p.P + (size_t)T * 1792;
        float cq[8], ck[8];
#pragma unroll
        for (int j = 0; j < 8; ++j) { cq[j] = 0.f; ck[j] = 0.f; }
        if (lane < 48) unpack8(*(const uint4*)(Pr + lane * 8), cq);
        if (lane < 32) unpack8(*(const uint4*)(Pr + 384 + lane * 8), ck);
        float s1 = 0.f, s2 = 0.f;
#pragma unroll
        for (int j = 0; j < 8; ++j) { s1 += cq[j] * cq[j]; s2 += ck[j] * ck[j]; }
        s1 = wave_sum(s1); s2 = wave_sum(s2);
        const float r1 = rsqrtf(s1 * (1.f / 384.f) + 1e-6f), r2 = rsqrtf(s2 * (1.f / 256.f) + 1e-6f);
        if (lane < 48) {
            const float4 ga = *(const float4*)(p.g_q + lane * 8), gb = *(const float4*)(p.g_q + lane * 8 + 4);
            uint4 o; o.x = pack_bf16(cq[0] * r1 * ga.x, cq[1] * r1 * ga.y); o.y = pack_bf16(cq[2] * r1 * ga.z, cq[3] * r1 * ga.w);
            o.z = pack_bf16(cq[4] * r1 * gb.x, cq[5] * r1 * gb.y); o.w = pack_bf16(cq[6] * r1 * gb.z, cq[7] * r1 * gb.w);
            *(uint4*)(p.cqn + (size_t)T * 384 + lane * 8) = o;
        }
        if (lane < 32) {
            const float4 ga = *(const float4*)(p.g_kv + lane * 8), gb = *(const float4*)(p.g_kv + lane * 8 + 4);
            float y[8] = {ck[0] * r2 * ga.x, ck[1] * r2 * ga.y, ck[2] * r2 * ga.z, ck[3] * r2 * ga.w, ck[4] * r2 * gb.x, ck[5] * r2 * gb.y, ck[6] * r2 * gb.z, ck[7] * r2 * gb.w};
            uint4 o; o.x = pack_bf16(y[0], y[1]); o.y = pack_bf16(y[2], y[3]); o.z = pack_bf16(y[4], y[5]); o.w = pack_bf16(y[6], y[7]);
            *(uint4*)(p.ckvk + (size_t)ti.keyrow * 256 + lane * 8) = o;
            if (!ti.smp) { float4* d = (float4*)(o_ckv + (size_t)T * 256 + lane * 8); d[0] = make_float4(y[0], y[1], y[2], y[3]); d[1] = make_float4(y[4], y[5], y[6], y[7]); }
        }
        if (lane < 8) {
            float v[8]; unpack8(*(const uint4*)(Pr + 640 + lane * 8), v);
            float y[8];
            if (ti.smp) {
                const int gr = ti.s >> 6, gc = ti.s & 63;
#pragma unroll
                for (int i = 0; i < 4; ++i) {
                    const int pr = lane * 4 + i;
                    const float cs = pr < 16 ? p.ropetab[gr * 16 + pr] : p.ropetab[1024 + gc * 16 + (pr - 16)];
                    const float sn = pr < 16 ? p.ropetab[512 + gr * 16 + pr] : p.ropetab[2048 + gc * 16 + (pr - 16)];
                    y[2 * i] = v[2 * i] * cs - v[2 * i + 1] * sn; y[2 * i + 1] = v[2 * i] * sn + v[2 * i + 1] * cs;
                }
            } else {
#pragma unroll
                for (int i = 0; i < 8; ++i) y[i] = v[i];
                float4* d = (float4*)(o_kr + (size_t)T * 64 + lane * 8); d[0] = make_float4(v[0], v[1], v[2], v[3]); d[1] = make_float4(v[4], v[5], v[6], v[7]);
            }
            uint4 o; o.x = pack_bf16(y[0], y[1]); o.y = pack_bf16(y[2], y[3]); o.z = pack_bf16(y[4], y[5]); o.w = pack_bf16(y[6], y[7]);
            *(uint4*)(p.kropek + (size_t)ti.keyrow * 64 + lane * 8) = o;
        }
        {
            const int ch = lane * 8;
            float y[8];
            { const float4 a = *(const float4*)(p.conv_b + ch), b = *(const float4*)(p.conv_b + ch + 4); y[0] = a.x; y[1] = a.y; y[2] = a.z; y[3] = a.w; y[4] = b.x; y[5] = b.y; y[6] = b.z; y[7] = b.w; }
#pragma unroll
            for (int k = 0; k < 4; ++k) {
                const int s2i = ti.s + k - 2;
                if (s2i >= 0 && s2i < ti.S) {
                    float u[8]; unpack8(*(const uint4*)(p.P + (size_t)(T + k - 2) * 1792 + 704 + ch), u);
                    const float4 a = *(const float4*)(p.conv_w + k * 512 + ch), b = *(const float4*)(p.conv_w + k * 512 + ch + 4);
                    y[0] += a.x * u[0]; y[1] += a.y * u[1]; y[2] += a.z * u[2]; y[3] += a.w * u[3]; y[4] += b.x * u[4]; y[5] += b.y * u[5]; y[6] += b.z * u[6]; y[7] += b.w * u[7];
                }
            }
            uint4 o; o.x = pack_bf16(y[0], y[1]); o.y = pack_bf16(y[2], y[3]); o.z = pack_bf16(y[4], y[5]); o.w = pack_bf16(y[6], y[7]);
            *(uint4*)(p.xc + (size_t)T * 512 + ch) = o;
            *(uint4*)(p.ug + (size_t)T * 512 + ch) = *(const uint4*)(Pr + 1216 + ch);
        }
    }
}

struct EpiVT {
    static constexpr bool PERM = true;
    bf16_t* vT;
    __device__ __forceinline__ void operator()(const pg8::f32x4 (&acc)[2][2][4][2], const pg8::Unit& u, int wr, int wc, int fr, int fq) const {
        const int R0 = u.pn * 256;
        size_t sbase; int Sk, pos0;
        if (R0 < T_CTX) { Sk = 256; pos0 = 0; sbase = (size_t)(R0 >> 8) * 4 * 128 * 256; }
        else { const int uu = R0 - T_CTX; const int sq = uu / 2304; Sk = 2304; pos0 = uu - sq * 2304; sbase = (size_t)T_CTX * 512 + (size_t)sq * 4 * 128 * 2304; }
        bf16_t* vb = vT + sbase + pos0 + wc * 32 + 8 * fq;
#pragma unroll
        for (int ai = 0; ai < 2; ++ai)
#pragma unroll
            for (int m = 0; m < 4; ++m) {
                const int r = u.pm * 256 + ai * 128 + wr * 64 + m * 16 + fr;
                bf16_t* rowp = vb + (size_t)r * Sk;
#pragma unroll
                for (int bj = 0; bj < 2; ++bj) {
                    const pg8::f32x4 v0 = acc[ai][bj][m][0], v1 = acc[ai][bj][m][1];
                    *(uint4*)(rowp + bj * 128) = make_uint4(pack_bf16(v0[0], v0[1]), pack_bf16(v0[2], v0[3]), pack_bf16(v1[0], v1[1]), pack_bf16(v1[2], v1[3]));
                }
            }
    }
};
#define N_G4 (160 * 16)
__device__ void st_gemm234(const Params& p) {
    {
        pg8::TileOrder S; S.nN = 3; S.total = 80 * 3; S.A = (const char*)p.cqn; S.B = (const char*)p.wt_uq; S.tA = (size_t)256 * 384 * 2; S.tB = (size_t)256 * 384 * 2;
        EpiStoreBf16 E; E.O = p.q; E.ldc = 768;
        pg8::gemm_phase<EpiStoreBf16, pg8::TileOrder, true, true>((LAS unsigned char*)smem, 384, 384, 384, S, E);
    }
    {
        pg8::TileOrder S; S.nN = 2; S.total = 88 * 2; S.A = (const char*)p.ckvk; S.B = (const char*)p.wt_ukv; S.tA = (size_t)256 * 256 * 2; S.tB = (size_t)256 * 256 * 2;
        EpiStoreBf16 E; E.O = p.Kn; E.ldc = 512;
        pg8::gemm_phase<EpiStoreBf16, pg8::TileOrder, true, true>((LAS unsigned char*)smem, 256, 256, 256, S, E);
    }
    {
        struct OrderVT {
            const char* W; const char* Kr;
            __device__ __forceinline__ bool next(int i, pg8::Unit& u) const {
                const int item = blockIdx.x + i * gridDim.x; if (item >= 88 * 2) return false;
                const int lt = item >> 3; u.pm = lt & 1; u.pn = (lt >> 1) * 8 + (item & 7);
                u.A = W + (size_t)u.pm * 256 * 256 * 2; u.B = Kr + (size_t)u.pn * 256 * 256 * 2; return true;
            }
        } S; S.W = (const char*)(p.wt_ukv + (size_t)512 * 256); S.Kr = (const char*)p.ckvk;
        EpiVT E; E.vT = p.vT;
        pg8::gemm_phase<EpiVT, OrderVT, true, true>((LAS unsigned char*)smem, 256, 256, 256, S, E);
    }
}

__device__ void st_gates(const Params& p) {
    const int half = tidx() >> 8, lane = tidx() & 63, wid = (tidx() >> 6) & 3, wm = wid >> 1, wn = wid & 1, hl = lane >> 5, cl = lane & 31;
    for (int item = blockIdx.x; item < N_G4 / 2; item += gridDim.x) {
        f32x16 acc[2][2];
        const int lt = (item >> 3) * 2 + half, tj = lt & 3, nb = (lt >> 2) & 3, tm = (lt >> 4) * 8 + (item & 7);
        gemm_acc<2, 2, 2, 2>(p.wt_gate + ((size_t)nb * 512 + tj * 128) * 128, 128, p.xc + (size_t)tm * 128 * 512 + nb * 128, 512, 128, acc);
        const int dir = tj >> 1, dg = (tj & 1) * 2 + wm;
#pragma unroll
        for (int gq = 0; gq < 4; ++gq) {
            const int ch0 = nb * 128 + dg * 32 + 8 * gq + 4 * hl;
            const float4 brg = *(const float4*)(p.b_rg + dir * 512 + ch0), big = *(const float4*)(p.b_ig + dir * 512 + ch0), sp = *(const float4*)(p.spl + dir * 512 + ch0);
            const float br[4] = {brg.x, brg.y, brg.z, brg.w}, bi[4] = {big.x, big.y, big.z, big.w}, spv[4] = {sp.x, sp.y, sp.z, sp.w};
#pragma unroll
            for (int j = 0; j < 2; ++j) {
                const int T = tm * 128 + 64 * wn + 32 * j + cl;
                const uint2 xr = *(const uint2*)(p.xc + (size_t)T * 512 + ch0);
                const float xv[4] = {__uint_as_float(xr.x << 16), __uint_as_float(xr.x & 0xffff0000u), __uint_as_float(xr.y << 16), __uint_as_float(xr.y & 0xffff0000u)};
                float am[4], bx[4];
#pragma unroll
                for (int e = 0; e < 4; ++e) {
                    const float rg = __builtin_amdgcn_rcpf(1.f + __expf(-(acc[0][j][4 * gq + e] + br[e]))), ig = __builtin_amdgcn_rcpf(1.f + __expf(-(acc[1][j][4 * gq + e] + bi[e])));
                    const float la = -8.f * rg * spv[e];
                    const float av = __expf(la);
                    am[e] = 1.f - av;
                    bx[e] = __builtin_amdgcn_sqrtf(fmaxf(1.f - av * av, 0.f)) * ig * xv[e];
                }
                *(uint2*)(p.a1m + ((size_t)T * 2 + dir) * 512 + ch0) = make_uint2(pack_bf16(am[0], am[1]), pack_bf16(am[2], am[3]));
                *(uint2*)(p.bxb + ((size_t)T * 2 + dir) * 512 + ch0) = make_uint2(pack_bf16(bx[0], bx[1]), pack_bf16(bx[2], bx[3]));
            }
        }
    }
}

#define N_ATT (64 + 256)
#define SCH 64
#define NCHK (T_TOK / SCH)
#define N_S1 (NCHK * 2)
__device__ void scan_s1_item(const Params& p, int it) {
    const int chunk = it >> 1, dc = (it & 1) * 512 + tidx(), dir = dc >> 9, ch = dc & 511;
    const int T0 = chunk * SCH;
    float A = 1.f, B = 0.f;
#pragma unroll 8
    for (int i = 0; i < SCH; ++i) {
        const int T = dir ? (T0 + SCH - 1 - i) : (T0 + i);
        const float av = 1.f - bf2f(p.a1m[((size_t)T * 2 + dir) * 512 + ch]), bv = bf2f(p.bxb[((size_t)T * 2 + dir) * 512 + ch]);
        A *= av; B = B * av + bv;
    }
    *(float2*)(p.agg + (((size_t)chunk * 2 + dir) * 512 + ch) * 2) = make_float2(A, B);
}

__device__ __forceinline__ int perm23(int r) { return (r & 0x13) | ((r & 4) << 1) | ((r & 8) >> 1); }
__device__ void attn_item_mfma(const Params& p, int it) {
    int seq, h, qb, Sk, T0, R0; size_t vbase;
    if (it < 64) { seq = it >> 2; h = it & 3; qb = 0; Sk = 256; T0 = seq * 256; R0 = seq * 256; vbase = (size_t)(seq * 4 + h) * 128 * 256; }
    else { const int u = it - 64; seq = u >> 5; h = (u >> 3) & 3; qb = u & 7; Sk = 2304; T0 = T_CTX + seq * 2048 + qb * 256; R0 = T_CTX + seq * 2304; vbase = (size_t)T_CTX * 512 + (size_t)(seq * 4 + h) * 128 * 2304; }
    const int tid = tidx(), lane = tid & 63, wid = tid >> 6, hl = lane >> 5, cl = lane & 31;
    bf16x8_t qf[12];
    {
        const bf16_t* qrow = p.q + (size_t)(T0 + 32 * wid + cl) * 768 + h * 192 + 8 * hl;
#pragma unroll
        for (int ks = 0; ks < 12; ++ks) qf[ks] = __builtin_bit_cast(bf16x8_t, *(const u32x4*)(qrow + 16 * ks));
        if (it >= 64) {
            const int sp = qb * 256 + 32 * wid + cl, gr = sp >> 6, gc = sp & 63;
#pragma unroll
            for (int ks = 8; ks < 12; ++ks) {
                const u32x4 w = __builtin_bit_cast(u32x4, qf[ks]); u32x4 o;
#pragma unroll
                for (int i = 0; i < 4; ++i) {
                    const int pr = 8 * (ks - 8) + 4 * hl + i;
                    const float cs = ks < 10 ? p.ropetab[gr * 16 + pr] : p.ropetab[1024 + gc * 16 + (pr - 16)];
                    const float sn = ks < 10 ? p.ropetab[512 + gr * 16 + pr] : p.ropetab[2048 + gc * 16 + (pr - 16)];
                    const float x0 = __uint_as_float(w[i] << 16), x1 = __uint_as_float(w[i] & 0xffff0000u);
                    o[i] = pack_bf16(x0 * cs - x1 * sn, x0 * sn + x1 * cs);
                }
                qf[ks] = __builtin_bit_cast(bf16x8_t, o);
            }
        }
    }
    f32x16 oacc[4];
#pragma unroll
    for (int d = 0; d < 4; ++d)
#pragma unroll
        for (int r = 0; r < 16; ++r) oacc[d][r] = 0.f;
    float m = -1e30f, lsum = 0.f;
    const bf16_t* gk = p.Kn + (size_t)(R0 + (tid >> 4)) * 512 + h * 128 + (tid & 15) * 8;
    const bf16_t* gr = p.kropek + (size_t)(R0 + (tid >> 3)) * 64 + (tid & 7) * 8;
    const bf16_t* gv = p.vT + vbase + (size_t)(tid >> 3) * Sk + (tid & 7) * 8;
    u32x4 rk[2], rr, rv[2];
    const int nt = Sk >> 6;
#pragma unroll
    for (int i = 0; i < 2; ++i) rk[i] = *(const u32x4*)(gk + (size_t)(32 * i) * 512);
    rr = *(const u32x4*)gr;
#pragma unroll
    for (int i = 0; i < 2; ++i) rv[i] = *(const u32x4*)(gv + (size_t)(64 * i) * Sk);
    __syncthreads();
    for (int t = 0; t < nt; ++t) {
#pragma unroll
        for (int i = 0; i < 2; ++i) *(u32x4*)(smem + ((tid & 15) >> 3) * 8192 + lds_off((tid >> 4) + 32 * i, tid & 7)) = rk[i];
        *(u32x4*)(smem + 16384 + lds_off(tid >> 3, tid & 7)) = rr;
#pragma unroll
        for (int i = 0; i < 2; ++i) *(u32x4*)(smem + 24576 + lds_off((tid >> 3) + 64 * i, tid & 7)) = rv[i];
        __syncthreads();
        if (t + 1 < nt) {
            const size_t ko = (size_t)(t + 1) * 64;
#pragma unroll
            for (int i = 0; i < 2; ++i) rk[i] = *(const u32x4*)(gk + (ko + 32 * i) * 512);
            rr = *(const u32x4*)(gr + ko * 64);
#pragma unroll
            for (int i = 0; i < 2; ++i) rv[i] = *(const u32x4*)(gv + (size_t)(64 * i) * Sk + ko);
        }
        f32x16 sacc[2];
#pragma unroll
        for (int kb = 0; kb < 2; ++kb) {
            __builtin_amdgcn_sched_barrier(0);
#pragma unroll
            for (int r = 0; r < 16; ++r) sacc[kb][r] = 0.f;
            const int krow = 32 * kb + perm23(cl);
#pragma unroll
            for (int ks = 0; ks < 12; ++ks) {
                const bf16x8_t kf = __builtin_bit_cast(bf16x8_t, *(const u32x4*)(smem + (ks >> 2) * 8192 + lds_off(krow, 2 * (ks & 3) + hl)));
                sacc[kb] = __builtin_amdgcn_mfma_f32_32x32x16_bf16(kf, qf[ks], sacc[kb], 0, 0, 0);
            }
        }
        float mx = sacc[0][0];
#pragma unroll
        for (int r = 1; r < 16; ++r) mx = fmaxf(mx, sacc[0][r]);
#pragma unroll
        for (int r = 0; r < 16; ++r) mx = fmaxf(mx, sacc[1][r]);
        mx = fmaxf(mx, __shfl_xor(mx, 32));
        const bool resc = !__all(mx - m <= 8.f);
        const float mn = resc ? fmaxf(m, mx) : m, alpha = resc ? __builtin_amdgcn_exp2f(m - mn) : 1.f;
        m = mn;
        float ps = 0.f;
        bf16x8_t pf[2][2];
#pragma unroll
        for (int kb = 0; kb < 2; ++kb)
#pragma unroll
            for (int s2 = 0; s2 < 2; ++s2) {
                float e[8];
#pragma unroll
                for (int j = 0; j < 8; ++j) { e[j] = __builtin_amdgcn_exp2f(sacc[kb][8 * s2 + j] - mn); ps += e[j]; }
                u32x4 w; w.x = pack_bf16(e[0], e[1]); w.y = pack_bf16(e[2], e[3]); w.z = pack_bf16(e[4], e[5]); w.w = pack_bf16(e[6], e[7]);
                pf[kb][s2] = __builtin_bit_cast(bf16x8_t, w);
            }
        lsum = lsum * alpha + ps;
        if (resc) {
#pragma unroll
            for (int d = 0; d < 4; ++d)
#pragma unroll
                for (int r = 0; r < 16; ++r) oacc[d][r] *= alpha;
        }
#pragma unroll
        for (int d = 0; d < 4; ++d) {
            __builtin_amdgcn_sched_barrier(0);
#pragma unroll
            for (int kb = 0; kb < 2; ++kb)
#pragma unroll
                for (int s2 = 0; s2 < 2; ++s2) {
                    const bf16x8_t vf = __builtin_bit_cast(bf16x8_t, *(const u32x4*)(smem + 24576 + lds_off(32 * d + cl, 4 * kb + 2 * s2 + hl)));
                    oacc[d] = __builtin_amdgcn_mfma_f32_32x32x16_bf16(vf, pf[kb][s2], oacc[d], 0, 0, 0);
                }
        }
        __builtin_amdgcn_sched_barrier(0);
        __syncthreads();
    }
    lsum += __shfl_xor(lsum, 32);
    const float inv = 1.f / lsum;
    bf16_t* dst = p.hbuf + (size_t)(T0 + 32 * wid + cl) * 1024 + h * 128 + 4 * hl;
#pragma unroll
    for (int d = 0; d < 4; ++d)
#pragma unroll
        for (int g = 0; g < 4; ++g) {
            uint2 w; w.x = pack_bf16(oacc[d][4 * g] * inv, oacc[d][4 * g + 1] * inv); w.y = pack_bf16(oacc[d][4 * g + 2] * inv, oacc[d][4 * g + 3] * inv);
            *(uint2*)(dst + 32 * d + 8 * g) = w;
        }
}
__device__ void st_attn_s1(const Params& p) {
    for (int item = blockIdx.x; item < N_ATT + N_S1; item += gridDim.x) {
        if (item < N_ATT) {
            attn_item_mfma(p, N_ATT - 1 - item);
        }
        else scan_s1_item(p, item - N_ATT);
    }
}

__device__ void st_scan3(const Params& p) {
    const int tid = tidx();
    float* hf = (float*)smem;
    float* hb = hf + SCH * 256;
    float* o_lru = p.out + 22282240;
    for (int item = blockIdx.x; item < NCHK * 2; item += gridDim.x) {
        const int chunk = item >> 1, cgp = item & 1, T0 = chunk * SCH;
        const TokInfo ti = tokinfo(T0);
        const int nch = ti.S / SCH, cpos = ti.s / SCH, c0 = chunk - cpos;
        const int dir = tid >> 8, ch = cgp * 256 + (tid & 255);
        float hcur = ti.smp ? p.state_lru[((size_t)ti.b * 2 + dir) * 512 + ch] : 0.f;
        if (dir == 0) { for (int cc = 0; cc < cpos; ++cc) { const float2 ab = *(const float2*)(p.agg + (((size_t)(c0 + cc) * 2 + 0) * 512 + ch) * 2); hcur = ab.x * hcur + ab.y; } }
        else { for (int cc = nch - 1; cc > cpos; --cc) { const float2 ab = *(const float2*)(p.agg + (((size_t)(c0 + cc) * 2 + 1) * 512 + ch) * 2); hcur = ab.x * hcur + ab.y; } }
        __syncthreads();
#pragma unroll 8
        for (int i = 0; i < SCH; ++i) {
            const int tl = dir ? SCH - 1 - i : i, T = T0 + tl;
            const float av = 1.f - bf2f(p.a1m[((size_t)T * 2 + dir) * 512 + ch]), bv = bf2f(p.bxb[((size_t)T * 2 + dir) * 512 + ch]);
            hcur = av * hcur + bv;
            (dir ? hb : hf)[tl * 256 + (tid & 255)] = hcur;
        }
        if (!ti.smp) {
            if (dir == 0 && cpos == nch - 1) o_lru[((size_t)ti.b * 2 + 0) * 512 + ch] = hcur;
            if (dir == 1 && cpos == 0) o_lru[((size_t)ti.b * 2 + 1) * 512 + ch] = hcur;
        }
        __syncthreads();
        for (int i = tid; i < SCH * 128; i += NTHR) {
            const int tl = i >> 7, c = (i & 127) * 2, T = T0 + tl, chh = cgp * 256 + c;
            const unsigned ugp = *(const unsigned*)(p.ug + (size_t)T * 512 + chh);
            const float g0 = gelu_tanh(__uint_as_float(ugp << 16)), g1 = gelu_tanh(__uint_as_float(ugp & 0xffff0000u));
            const float2 f = *(const float2*)(hf + tl * 256 + c), bb = *(const float2*)(hb + tl * 256 + c);
            *(unsigned*)(p.hbuf + (size_t)T * 1024 + 512 + chh) = pack_bf16((f.x + bb.x) * g0, (f.y + bb.y) * g1);
        }
    }
}

__device__ void st_gemm_o(const Params& p) {
    pg8::TileOrder S; S.nN = 4; S.total = 80 * 4; S.A = (const char*)p.hbuf; S.B = (const char*)p.wt_o; S.tA = (size_t)256 * 1024 * 2; S.tB = (size_t)256 * 1024 * 2;
    EpiStoreBf16 E; E.O = p.mix; E.ldc = 1024;
    pg8::gemm_phase<EpiStoreBf16, pg8::TileOrder, true, true>((LAS unsigned char*)smem, 1024, 1024, 1024, S, E);
}

__device__ __forceinline__ void ce_desc(float& a, float& b) { const float hi = fmaxf(a, b), lo = fminf(a, b); a = hi; b = lo; }
__device__ __forceinline__ void ins16(float (&top)[16], float x) {
#pragma unroll
    for (int i = 0; i < 16; ++i) { const float hi = fmaxf(top[i], x); x = fminf(top[i], x); top[i] = hi; }
}
__device__ __forceinline__ void bitonic_merge16(float (&v)[16]) {
#pragma unroll
    for (int j = 8; j >= 1; j >>= 1)
#pragma unroll
        for (int i = 0; i < 16; ++i) { const int l = i ^ j; if (l > i) ce_desc(v[i], v[l]); }
}
__device__ __forceinline__ void sort16(float (&v)[16]) {
#pragma unroll
    for (int k = 2; k <= 16; k <<= 1)
#pragma unroll
        for (int j = k >> 1; j >= 1; j >>= 1)
#pragma unroll
            for (int i = 0; i < 16; ++i) { const int l = i ^ j; if (l > i) { if ((i & k) == 0) ce_desc(v[i], v[l]); else ce_desc(v[l], v[i]); } }
}
__device__ __forceinline__ void merge_top16(float (&a)[16], const float (&b)[16]) {
#pragma unroll
    for (int i = 0; i < 16; ++i) a[i] = fmaxf(a[i], b[15 - i]);
    bitonic_merge16(a);
}
#define PKV(x) __uint_as_float(__float_as_uint(x) & 0xffffff80u)
#define CAND(i, j) __uint_as_float((__float_as_uint(PKV(top[0][i]) + PKV(top[1][j])) & 0xffffff00u) | (unsigned)((i) * 16 + (j)))
__device__ void st_peer_topk(const Params& p, int l) {
    __builtin_amdgcn_sched_barrier(0);
    const int half = tidx() >> 8, lane = tidx() & 63, wid = (tidx() >> 6) & 3, hl = lane >> 5, cl = lane & 31;
    for (int item = blockIdx.x; item < 80 * 8; item += gridDim.x) {
        const int lt = item >> 3, h = lt & 7, tm = 2 * ((lt >> 3) * 8 + (item & 7)) + half;
        const int T = tm * 128 + 32 * wid + cl;
        float top[2][16];
#pragma unroll
        for (int pp = 0; pp < 2; ++pp) {
            f32x16 acc[4][1];
            gemm_acc<4, 1, 1, 4>(p.keysb[l] + (size_t)(h * 2 + pp) * 128 * 128, 128, p.qp + (size_t)tm * 128 * 2048 + h * 256 + pp * 128, 2048, 128, acc);
#pragma unroll
            for (int i = 0; i < 4; ++i) {
                __builtin_amdgcn_sched_barrier(0);
                float g[16];
#pragma unroll
                for (int r = 0; r < 16; ++r) {
                    const int n = ACC_ROW(4, 0, i, r, hl);
                    g[r] = __uint_as_float((__float_as_uint(acc[i][0][r]) & 0xffffff80u) | (unsigned)n);
                }
                sort16(g);
                if (i == 0) {
#pragma unroll
                    for (int r = 0; r < 16; ++r) top[pp][r] = g[r];
                } else merge_top16(top[pp], g);
            }
            __builtin_amdgcn_sched_barrier(0);
            float oth[16];
#pragma unroll
            for (int i = 0; i < 16; ++i) oth[i] = __shfl_xor(top[pp][i], 32);
            merge_top16(top[pp], oth);
        }
        __builtin_amdgcn_sched_barrier(0);
        float fv[16], t2[16];
#pragma unroll
        for (int j = 0; j < 16; ++j) fv[j] = CAND(0, j);
        t2[15] = -INFINITY;
#pragma unroll
        for (int i = 1; i < 16; ++i) t2[i - 1] = CAND(i, 0);
        merge_top16(fv, t2);
        t2[0] = CAND(1, 1); t2[1] = CAND(1, 2); t2[2] = CAND(1, 3); t2[3] = CAND(1, 4); t2[4] = CAND(1, 5); t2[5] = CAND(1, 6); t2[6] = CAND(1, 7);
        t2[7] = CAND(2, 1); t2[8] = CAND(2, 2); t2[9] = CAND(2, 3); t2[10] = CAND(2, 4); t2[11] = CAND(3, 1); t2[12] = CAND(3, 2); t2[13] = CAND(3, 3);
        t2[14] = CAND(4, 1); t2[15] = CAND(4, 2);
        sort16(t2);
        merge_top16(fv, t2);
        ins16(fv, CAND(5, 1)); ins16(fv, CAND(6, 1)); ins16(fv, CAND(7, 1));
        unsigned* tab = (unsigned*)(smem + half * 65536) + (size_t)(tidx() & 255) * 8;
#pragma unroll
        for (int k = 0; k < 4; ++k) {
            tab[k] = (__float_as_uint(top[0][4 * k]) & 127u) | ((__float_as_uint(top[0][4 * k + 1]) & 127u) << 8) | ((__float_as_uint(top[0][4 * k + 2]) & 127u) << 16) | ((__float_as_uint(top[0][4 * k + 3]) & 127u) << 24);
            tab[4 + k] = (__float_as_uint(top[1][4 * k]) & 127u) | ((__float_as_uint(top[1][4 * k + 1]) & 127u) << 8) | ((__float_as_uint(top[1][4 * k + 2]) & 127u) << 16) | ((__float_as_uint(top[1][4 * k + 3]) & 127u) << 24);
        }
        const u8_t* tabb = (const u8_t*)tab;
        int fe[16];
#pragma unroll
        for (int i = 0; i < 16; ++i) {
            const unsigned code = __float_as_uint(fv[i]) & 255u;
            fe[i] = (int)tabb[code >> 4] * 128 + (int)tabb[16 + (code & 15u)];
            fv[i] = __uint_as_float(__float_as_uint(fv[i]) & 0xffffff00u);
        }
        float sum = 0.f, ev[16];
#pragma unroll
        for (int i = 0; i < 16; ++i) { ev[i] = __expf(fv[i] - fv[0]); sum += ev[i]; }
        const float inv = 1.f / sum;
        if (hl == 0) {
            float4* gp = (float4*)(p.gates + (size_t)T * 128 + h * 16); int4* ep = (int4*)(p.eidx + (size_t)T * 128 + h * 16);
#pragma unroll
            for (int i = 0; i < 4; ++i) { gp[i] = make_float4(ev[4 * i] * inv, ev[4 * i + 1] * inv, ev[4 * i + 2] * inv, ev[4 * i + 3] * inv); ep[i] = make_int4(fe[4 * i], fe[4 * i + 1], fe[4 * i + 2], fe[4 * i + 3]); }
        }
    }
}

__device__ void st_gemm_pq(const Params& p, int l) {
    pg8::TileOrder S; S.nN = 8; S.total = 80 * 8; S.A = (const char*)p.hbuf; S.B = (const char*)p.wt_pq[l]; S.tA = (size_t)256 * 1024 * 2; S.tB = (size_t)256 * 1024 * 2;
    EpiStoreBf16 E; E.O = p.qp; E.ldc = 2048;
    pg8::gemm_phase<EpiStoreBf16, pg8::TileOrder, true, true>((LAS unsigned char*)smem, 1024, 1024, 1024, S, E);
    asm volatile("s_waitcnt vmcnt(0)" ::: "memory");
    __syncthreads();
    st_peer_topk(p, l);
}

#define GT_TPW 10
#define GT_WAVE_LDS 12288
#define FP4X(dw, b) __builtin_amdgcn_cvt_scalef32_pk_f32_fp4(dw, 1.0f, b)
#define FP4B(dw, b) __builtin_amdgcn_cvt_scalef32_pk_bf16_fp4(dw, 1.0f, b)
__device__ void st_peer_gather(const Params& p, int l) {
    const int lane = tidx() & 63, wid = __builtin_amdgcn_readfirstlane(tidx() >> 6), g = lane >> 3, pc = lane & 7;
    const u8_t* U = p.u8[l]; const u8_t* V = p.v8[l]; const float* SU = p.su[l]; const float* SV = p.sv[l];
    const bool b0 = (lane & 1) != 0, b1 = (lane & 2) != 0, b2 = (lane & 4) != 0, b3 = (lane & 8) != 0;
    const int stride = gridDim.x * NWV, Tfirst = blockIdx.x * NWV + wid;
    const int ka = 16 * g + pc, kb = ka + 8;
    LAS unsigned* eo_l = (LAS unsigned*)(smem + wid * GT_WAVE_LDS);
    LAS float* zw_l = (LAS float*)(smem + wid * GT_WAVE_LDS + GT_TPW * 512);
    LAS unsigned char* wq_l = (LAS unsigned char*)(smem + wid * GT_WAVE_LDS + GT_TPW * 1024);
    LAS float* tsc_l = (LAS float*)(smem + wid * GT_WAVE_LDS + GT_TPW * 1152);
    const int vj = lane & 15, vg = lane >> 4;
    unsigned selb[4];
#pragma unroll
    for (int bb = 0; bb < 4; ++bb) selb[bb] = (0x0C0C0C0Cu & ~(0xFFu << (8 * (lane & 3)))) | ((unsigned)bb << (8 * (lane & 3)));
#pragma unroll 1
    for (int Tr = Tfirst; Tr < T_TOK; Tr += stride * GT_TPW) {
#pragma unroll
        for (int k = 0; k < GT_TPW; ++k) {
            const int T = Tr + k * stride;
            if (T < T_TOK) { const int2 e = *(const int2*)(p.eidx + (size_t)T * 128 + 2 * lane); *(LAS u32x2*)(eo_l + k * 128 + 2 * lane) = (u32x2){(unsigned)e.x * 512u, (unsigned)e.y * 512u}; }
        }
        __builtin_amdgcn_wave_barrier();
#pragma unroll 1
        for (int c = 0; c < 4; ++c) {
#pragma unroll 1
            for (int k = 0; k < GT_TPW; ++k) {
                const int T = Tr + k * stride;
                if (T >= T_TOK) break;
                u32x4 eo[4];
#pragma unroll
                for (int q = 0; q < 4; ++q) eo[q] = *(LAS const u32x4*)(eo_l + k * 128 + 16 * g + 4 * q);
                const u32x4 hh4 = *(const u32x4*)(p.hqh + (size_t)T * 128 + c * 32 + pc * 4), hl4 = *(const u32x4*)(p.hql + (size_t)T * 128 + c * 32 + pc * 4);
                u32x4 r[16];
#pragma unroll
                for (int i = 0; i < 16; ++i) r[i] = *(const u32x4*)(U + (eo[i >> 2][i & 3] + (unsigned)(c * 128 + pc * 16)));
                float za = 0.f, zb = 0.f;
                if (c > 0) { za = zw_l[k * 128 + ka]; zb = zw_l[k * 128 + kb]; }
#pragma unroll
                for (int hh = 0; hh < 2; ++hh) {
                    float d[8];
#pragma unroll
                    for (int ii = 0; ii < 8; ++ii) {
                        int ah = 0, al = 0;
#pragma unroll
                        for (int q = 0; q < 4; ++q) { ah = __builtin_amdgcn_sdot8((int)r[8 * hh + ii][q], (int)hh4[q], ah, false); al = __builtin_amdgcn_sdot8((int)r[8 * hh + ii][q], (int)hl4[q], al, false); }
                        d[ii] = (float)(ah * 16 + al);
                    }
                    float a4[4], a2[2];
#pragma unroll
                    for (int j = 0; j < 4; ++j) { const float kp = b2 ? d[j + 4] : d[j], sn = b2 ? d[j] : d[j + 4]; a4[j] = kp + DPP_F(sn, 0x141); }
#pragma unroll
                    for (int j = 0; j < 2; ++j) { const float kp = b1 ? a4[j + 2] : a4[j], sn = b1 ? a4[j] : a4[j + 2]; a2[j] = kp + DPP_F(sn, 0x4E); }
                    const float kp = b0 ? a2[1] : a2[0], sn = b0 ? a2[0] : a2[1];
                    const float z = kp + DPP_F(sn, 0xB1);
                    if (hh == 0) za += z; else zb += z;
                }
                if (c < 3) { zw_l[k * 128 + ka] = za; zw_l[k * 128 + kb] = zb; }
                else {
                    const unsigned ea = eo_l[k * 128 + ka] >> 9, eb = eo_l[k * 128 + kb] >> 9;
                    const float ga = p.gates[(size_t)T * 128 + ka], gb = p.gates[(size_t)T * 128 + kb];
                    const float hs = p.hsc[T];
                    const float wa = ga * gelu_tanh(za * (SU[ea] * hs)) * SV[ea], wb = gb * gelu_tanh(zb * (SU[eb] * hs)) * SV[eb];
                    const float wmax = wave_max(fmaxf(fabsf(wa), fabsf(wb)));
                    const float winv = wmax > 0.f ? 127.f / wmax : 0.f;
                    const float qa = rintf(wa * winv), qb = rintf(wb * winv);
                    wq_l[k * 128 + ka] = (unsigned char)(int)qa; wq_l[k * 128 + kb] = (unsigned char)(int)qb;
                    const float qs = wave_sum(qa + qb);
                    if (lane == 0) { tsc_l[k * 2] = wmax * (1.f / 127.f); tsc_l[k * 2 + 1] = 8.f * qs; }
                }
            }
        }
        __builtin_amdgcn_wave_barrier();
#pragma unroll 1
        for (int c = 0; c < 4; ++c) {
#pragma unroll 1
            for (int k = 0; k < GT_TPW; ++k) {
                const int T = Tr + k * stride;
                if (T >= T_TOK) break;
                i32x4 acc[4];
#pragma unroll
                for (int a = 0; a < 4; ++a) acc[a] = (i32x4){0, 0, 0, 0};
#pragma unroll
                for (int hf = 0; hf < 2; ++hf) {
                    u32x4 eo[4];
#pragma unroll
                    for (int q = 0; q < 4; ++q) eo[q] = *(LAS const u32x4*)(eo_l + k * 128 + 32 * vg + 16 * hf + 4 * q);
                    const u32x4 W = *(LAS const u32x4*)(wq_l + k * 128 + 32 * vg + 16 * hf);
                    u32x2 r[16];
#pragma unroll
                    for (int i = 0; i < 16; ++i) r[i] = *(const u32x2*)(V + (eo[i >> 2][i & 3] + (unsigned)(c * 128 + vj * 8)));
#pragma unroll
                    for (int i = 0; i < 16; ++i) {
                        i32x4 B, A;
                        B[0] = (int)(r[i][0] & 0x0F0F0F0Fu); B[1] = (int)((r[i][0] >> 4) & 0x0F0F0F0Fu); B[2] = (int)(r[i][1] & 0x0F0F0F0Fu); B[3] = (int)((r[i][1] >> 4) & 0x0F0F0F0Fu);
                        const unsigned sw = __builtin_amdgcn_perm(0u, W[i >> 2], selb[i & 3]);
#pragma unroll
                        for (int d = 0; d < 4; ++d) A[d] = ((vj >> 2) == d) ? (int)sw : 0;
                        acc[i & 3] = __builtin_amdgcn_mfma_i32_16x16x64_i8(A, B, acc[i & 3], 0, 0, 0);
                    }
                }
                const i32x4 tot = (acc[0] + acc[1]) + (acc[2] + acc[3]);
                const float sc = tsc_l[k * 2], c8 = tsc_l[k * 2 + 1];
                *(uint2*)(p.mix + (size_t)T * 1024 + c * 256 + vj * 16 + vg * 4) = make_uint2(pack_bf16(((float)tot[0] - c8) * sc, ((float)tot[1] - c8) * sc), pack_bf16(((float)tot[2] - c8) * sc, ((float)tot[3] - c8) * sc));
            }
        }
        __builtin_amdgcn_wave_barrier();
    }
    asm volatile("s_waitcnt vmcnt(0)" ::: "memory");
#pragma unroll 1
    for (int T = Tfirst; T < T_TOK; T += stride) {
        const TokInfo ti = tokinfo(T);
        const int cb = lane * 16;
        float o16[16];
        { const uint4* op = (const uint4*)(p.mix + (size_t)T * 1024 + cb); float t8[8]; unpack8(op[0], t8);
#pragma unroll
          for (int j = 0; j < 8; ++j) o16[j] = t8[j];
          unpack8(op[1], t8);
#pragma unroll
          for (int j = 0; j < 8; ++j) o16[8 + j] = t8[j]; }
        bf16_t* xr = p.xres + (size_t)T * 1024 + cb;
        const float* gt = modv(p, l, ti.mi, 5) + cb;
        float xn[16]; float ss = 0.f;
        { const uint4* xp = (const uint4*)xr; float t8[8]; unpack8(xp[0], t8);
#pragma unroll
          for (int j = 0; j < 8; ++j) xn[j] = t8[j] + gt[j] * o16[j];
          unpack8(xp[1], t8);
#pragma unroll
          for (int j = 0; j < 8; ++j) xn[8 + j] = t8[j] + gt[8 + j] * o16[8 + j]; }
#pragma unroll
        for (int j = 0; j < 16; ++j) ss += xn[j] * xn[j];
        ss = wave_sum(ss);
        const float rstd = rsqrtf(ss * (1.f / 1024.f) + 1e-6f);
        if (l == 0) {
#pragma unroll
            for (int j = 0; j < 1; ++j) { uint4* xw = (uint4*)xr;
                xw[0] = make_uint4(pack_bf16(xn[0], xn[1]), pack_bf16(xn[2], xn[3]), pack_bf16(xn[4], xn[5]), pack_bf16(xn[6], xn[7]));
                xw[1] = make_uint4(pack_bf16(xn[8], xn[9]), pack_bf16(xn[10], xn[11]), pack_bf16(xn[12], xn[13]), pack_bf16(xn[14], xn[15])); }
            const float* sh = modv(p, 1, ti.mi, 0) + cb; const float* sc = modv(p, 1, ti.mi, 1) + cb; const float* gg = p.g_mix[1] + cb;
            unsigned w[8];
#pragma unroll
            for (int j = 0; j < 8; ++j) w[j] = pack_bf16(xn[2 * j] * rstd * gg[2 * j] * (1.f + sc[2 * j]) + sh[2 * j], xn[2 * j + 1] * rstd * gg[2 * j + 1] * (1.f + sc[2 * j + 1]) + sh[2 * j + 1]);
            uint4* dd = (uint4*)(p.h3 + (size_t)T * 1024 + cb);
            dd[0] = make_uint4(w[0], w[1], w[2], w[3]); dd[1] = make_uint4(w[4], w[5], w[6], w[7]);
        } else {
            const float* gg = p.g_final + cb;
            float* y = p.out + (size_t)T * 1024 + cb;
#pragma unroll
            for (int j = 0; j < 4; ++j) *(float4*)(y + 4 * j) = make_float4(xn[4 * j] * rstd * gg[4 * j], xn[4 * j + 1] * rstd * gg[4 * j + 1], xn[4 * j + 2] * rstd * gg[4 * j + 2], xn[4 * j + 3] * rstd * gg[4 * j + 3]);
        }
    }
}

template <int W>
__device__ __forceinline__ void pool_tok(const Params& p, int T, int ck) {
    const TokInfo ti = tokinfo(T);
    const bf16_t* base = p.h3 + (size_t)(T - ti.s) * 1024 + ck * 8;
    uint4 raw[W];
#pragma unroll
    for (int k = 0; k < W; ++k) {
        const int t2 = ti.s - W / 2 + k;
        raw[k] = (t2 >= 0 && t2 < ti.S) ? *(const uint4*)(base + (size_t)t2 * 1024) : make_uint4(0u, 0u, 0u, 0u);
    }
    float acc[8];
#pragma unroll
    for (int j = 0; j < 8; ++j) acc[j] = 0.f;
#pragma unroll
    for (int k = 0; k < W; ++k) { float f[8]; unpack8(raw[k], f);
#pragma unroll
        for (int j = 0; j < 8; ++j) acc[j] += f[j]; }
    float c[8]; unpack8(raw[W / 2], c);
    const int lo = max(ti.s - W / 2, 0), hi = min(ti.s + W / 2, ti.S);
    const float inv = 1.f / (float)(hi - lo);
    uint4 o;
    o.x = pack_bf16(acc[0] * inv - c[0], acc[1] * inv - c[1]); o.y = pack_bf16(acc[2] * inv - c[2], acc[3] * inv - c[3]);
    o.z = pack_bf16(acc[4] * inv - c[4], acc[5] * inv - c[5]); o.w = pack_bf16(acc[6] * inv - c[6], acc[7] * inv - c[7]);
    *(uint4*)(p.hbuf + (size_t)T * 1024 + ck * 8) = o;
}
__device__ void st_pool(const Params& p) {
    const int tid = tidx(), lane = tid & 63, wv = tid >> 6, g = wv & 3, ck = g * 32 + (lane & 31), tsub = (wv >> 2) * 2 + (lane >> 5);
    const int per = (T_TOK + gridDim.x - 1) / gridDim.x, Tb = blockIdx.x * per, Te = min(Tb + per, T_TOK);
    for (int T = Tb + tsub; T < Te; T += 4) {
        if (g == 0) pool_tok<2>(p, T, ck); else if (g == 1) pool_tok<4>(p, T, ck); else if (g == 2) pool_tok<8>(p, T, ck); else pool_tok<16>(p, T, ck);
    }
}

__device__ void st_gemm_pool(const Params& p) {
    struct OrderPool {
        const char* A; const char* B;
        __device__ __forceinline__ bool next(int i, pg8::Unit& u) const {
            const int item = blockIdx.x + i * gridDim.x; if (item >= 80 * 4) return false;
            const int lt = item >> 3; u.pn = lt & 3; u.pm = (lt >> 2) * 8 + (item & 7);
            u.A = A + (size_t)u.pm * 256 * 1024 * 2 + (size_t)u.pn * 256 * 2; u.B = B + (size_t)u.pn * 256 * 256 * 2; return true;
        }
    } S; S.A = (const char*)p.hbuf; S.B = (const char*)p.wt_pool;
    EpiStoreBf16 E; E.O = p.mix; E.ldc = 1024;
    pg8::gemm_phase<EpiStoreBf16, OrderPool, true, true>((LAS unsigned char*)smem, 1024, 256, 256, S, E);
}

__device__ __forceinline__ void run_stage(const Params& p, int s) {
#ifdef ONLY_STAGE
    if (s != ONLY_STAGE) return;
#endif
    switch (s) {
        case 0: st_prologue(p); break;
        case 1: st_norm<0>(p, 0, 0, p.g_mix[0], p.hbuf); break;
        case 2: st_gemm1(p); break;
        case 3: st_postproj(p); break;
        case 4: st_gemm234(p); break;
        case 18: st_gates(p); break;
        case 5: st_attn_s1(p); break;
        case 6: st_scan3(p); break;
        case 7: st_gemm_o(p); break;
        case 8: st_resnorm<1>(p, 0); break;
        case 9: st_gemm_pq(p, 0); break;
        case 11: st_peer_gather(p, 0); break;
        case 12: st_pool(p); break;
        case 13: st_gemm_pool(p); break;
        case 14: st_resnorm<0>(p, 1); break;
        case 15: st_gemm_pq(p, 1); break;
        case 17: st_peer_gather(p, 1); break;
        default: break;
    }
}

__global__ void __launch_bounds__(NTHR, 2) fwd_mega(Params p) {
    cg::grid_group grid = cg::this_grid();
    volatile LAS unsigned* st = (volatile LAS unsigned*)(smem + 131072);
    if (threadIdx.x == 0) { st[0] = 0; st[1] = 0; st[2] = 0; st[3] = 0; }
    wtab_init();
    __syncthreads();
    XcdBarrier b = xcd_barrier_post(p.bar, st);
    if (p.bar == nullptr) grid.sync();
#ifndef REP_MASK
#define REP_MASK 0
#endif
#define MK_ST(k) run_stage(p, k); if ((REP_MASK >> (k)) & 1) { xcd_barrier(b); run_stage(p, k); } if ((k) != 17) xcd_barrier(b);
    MK_ST(0) MK_ST(1) MK_ST(2) MK_ST(3) run_stage(p, 4); MK_ST(18) MK_ST(5) MK_ST(6) MK_ST(7) MK_ST(8) MK_ST(9) MK_ST(11) MK_ST(12) MK_ST(13) MK_ST(14) MK_ST(15) MK_ST(17)
}

extern "C" void kernel_launch(void* const* d_in, const int* in_sizes, int n_in, void* d_out, int out_size, void* d_ws, size_t ws_size, hipStream_t stream) {
    constexpr size_t kDynLds = 131072 + 512;
    static int grid_blocks = 0;
    if (!grid_blocks) {
        int dev = 0, cus = 0, per_cu = 0;
        (void)hipGetDevice(&dev);
        (void)hipDeviceGetAttribute(&cus, hipDeviceAttributeMultiprocessorCount, dev);
        (void)hipFuncSetAttribute((const void*)fwd_mega, hipFuncAttributeMaxDynamicSharedMemorySize, (int)kDynLds);
        (void)hipOccupancyMaxActiveBlocksPerMultiprocessor(&per_cu, fwd_mega, NTHR, kDynLds);
        if (per_cu > 1) per_cu = 1;
        if (per_cu < 1) per_cu = 1;
        grid_blocks = cus * per_cu;
    }
    Params p{};
    const float* const* in = (const float* const*)d_in;
    p.x_prompt = in[0]; p.x_sample = in[1]; p.cache_ckv = in[2]; p.cache_krope = in[3]; p.state_lru = in[4]; p.c = in[5]; p.c_ctx = in[6];
    p.w_mod[0] = in[7]; p.b_mod[0] = in[8]; p.w_mod[1] = in[9]; p.b_mod[1] = in[10];
    p.g_mix[0] = in[11]; p.g_ffn[0] = in[12]; p.g_mix[1] = in[13]; p.g_ffn[1] = in[14];
    p.w_in = in[15]; p.g_q = in[16]; p.w_uq = in[17]; p.g_kv = in[18]; p.w_ukv = in[19]; p.conv_w = in[20]; p.conv_b = in[21];
    p.w_rg = in[22]; p.b_rg = in[23]; p.w_ig = in[24]; p.b_ig = in[25]; p.lam = in[26]; p.w_o = in[27]; p.w_pool = in[28]; p.s_pool = in[29];
    p.peer_wq[0] = in[30]; p.peer_keys[0] = in[31]; p.peer_u[0] = in[32]; p.peer_v[0] = in[33];
    p.peer_wq[1] = in[34]; p.peer_keys[1] = in[35]; p.peer_u[1] = in[36]; p.peer_v[1] = in[37];
    p.g_final = in[38];
    p.out = (float*)d_out;
    char* base = (char*)d_ws; size_t off = 0;
    auto take = [&](size_t bytes) { char* r = base + off; off += (bytes + 255) & ~(size_t)255; return r; };
    const size_t MiB = 1u << 20;
    p.bar = (unsigned*)take(16384);
    p.mod = (float*)take((size_t)2 * 9 * 6144 * 4);
    p.ropetab = (float*)take(3072 * 4); p.spl = (float*)take(1024 * 4);
    p.wt_in = (bf16_t*)take((size_t)NW_IN * 2); p.wt_uq = (bf16_t*)take((size_t)NW_UQ * 2); p.wt_ukv = (bf16_t*)take((size_t)NW_UKV * 2);
    p.wt_gate = (bf16_t*)take((size_t)NW_GATE * 2); p.wt_o = (bf16_t*)take((size_t)NW_O * 2); p.wt_pool = (bf16_t*)take((size_t)NW_POOL * 2);
    p.wt_pq[0] = (bf16_t*)take((size_t)NW_PQ * 2); p.wt_pq[1] = (bf16_t*)take((size_t)NW_PQ * 2);
    p.keysb[0] = (bf16_t*)take((size_t)NW_KEYS * 2); p.keysb[1] = (bf16_t*)take((size_t)NW_KEYS * 2);
    for (int l = 0; l < 2; ++l) { p.u8[l] = (u8_t*)take(16 * MiB); p.v8[l] = (u8_t*)take(16 * MiB); p.su[l] = (float*)take(65536); p.sv[l] = (float*)take(65536); }
    char* regX = take(80 * MiB);
    char* regQ = take(80 * MiB);
    char* regH = take(40 * MiB);
    p.P = (bf16_t*)regX; p.a = (float*)regX; p.a1m = (bf16_t*)regX; p.xres = (bf16_t*)regX;
    p.bxb = (bf16_t*)regQ; p.q = (bf16_t*)(regQ + 40 * MiB); p.agg = (float*)(regQ + 70 * MiB); p.qp = (bf16_t*)regQ; p.h3 = (bf16_t*)regQ;
    p.hbuf = (bf16_t*)regH;
    p.cqn = (bf16_t*)take((size_t)T_TOK * 384 * 2); p.ckvk = (bf16_t*)take((size_t)R_KEYS * 256 * 2); p.kropek = (bf16_t*)take((size_t)R_KEYS * 64 * 2);
    p.xc = (bf16_t*)take((size_t)T_TOK * 512 * 2); p.ug = (bf16_t*)take((size_t)T_TOK * 512 * 2);
    p.mix = p.xc;
    p.Kn = (bf16_t*)take((size_t)R_KEYS * 512 * 2); p.vT = (bf16_t*)take((size_t)R_KEYS * 512 * 2);
    p.zbuf = (float*)p.vT; p.wbuf = p.zbuf + (size_t)T_TOK * 128;
    p.hqh = (unsigned*)p.cqn; p.hql = (unsigned*)p.ckvk; p.hsc = (float*)p.kropek;
    p.gates = (float*)p.Kn; p.eidx = (int*)((char*)p.Kn + (size_t)T_TOK * 128 * 4);
    if (off > ws_size) fprintf(stderr, "workspace too small: need %zu have %zu\n", off, ws_size);
    (void)hipMemsetAsync(d_ws, 0, 16384, stream);
    void* args[] = {&p};
    hipError_t e = hipLaunchCooperativeKernel((void*)fwd_mega, dim3(grid_blocks), dim3(NTHR), args, kDynLds, stream);
    if (e != hipSuccess) fprintf(stderr, "cooperative launch failed: %s (grid %d)\n", hipGetErrorString(e), grid_blocks);
}
```

```cpp
#include <hip/hip_runtime.h>
#include <hip/hip_cooperative_groups.h>
#include <cstdio>
#include <cstdint>
namespace cg = cooperative_groups;


typedef unsigned short bf16_t;
typedef unsigned char u8_t;
typedef float f32x16 __attribute__((ext_vector_type(16)));
typedef float f32x2 __attribute__((ext_vector_type(2)));
typedef unsigned u32x4 __attribute__((ext_vector_type(4)));
typedef float f32x4v __attribute__((ext_vector_type(4)));

#define T_TOK 20480
#define T_CTX 4096
#define R_KEYS 22528
#define NSTAGE 19
#define NTHR 512
#define NWV 8
#define LAS __attribute__((address_space(3)))

#define XB_TMO      128
#define XB_XCNT(j)  (256  + 64 * (j))
#define XB_XSUB(j)  (1280 + 64 * (j))
#define XB_XGEN(j)  (2304 + 64 * (j))
#define XB_TOP      3328
#define XB_TOPGEN   3392
#define XCD_BAR_WORDS 3456
#define XB_SPIN_CAP (1u << 22)
__device__ __forceinline__ unsigned xb_ld(unsigned* p)              { return __hip_atomic_load(p, __ATOMIC_RELAXED, __HIP_MEMORY_SCOPE_AGENT); }
__device__ __forceinline__ unsigned xb_add(unsigned* p, unsigned v) { return __hip_atomic_fetch_add(p, v, __ATOMIC_RELAXED, __HIP_MEMORY_SCOPE_AGENT); }
__device__ __forceinline__ unsigned xb_xcc_id() { return (unsigned)__builtin_amdgcn_s_getreg((3 << 11) | 20) & 0xFu; }
#define XB_SPIN(cond, bar) do { unsigned _sp = 0; while (cond) { __builtin_amdgcn_s_sleep(1); \
    if ((++_sp & 255u) == 0u) { if (xb_ld(&(bar)[XB_TMO])) break; if (_sp > XB_SPIN_CAP) { atomicAdd(&(bar)[XB_TMO], 1u); break; } } } } while (0)
struct XcdBarrier { unsigned* bar; unsigned x; volatile LAS unsigned* st; };
__device__ __forceinline__ XcdBarrier xcd_barrier_post(unsigned* bar, volatile LAS unsigned* st) {
    XcdBarrier b; b.bar = bar; b.x = xb_xcc_id(); b.st = st;
    if (threadIdx.x == 0) (void)xb_add(&bar[XB_XCNT(b.x)], 1u);
    return b;
}
__device__ __forceinline__ void xcd_barrier_complete(unsigned* bar, unsigned x, unsigned& nloc, unsigned& nx) {
    const unsigned G = gridDim.x * gridDim.y * gridDim.z;
    unsigned sum, cnt, mine, sp = 0u;
    for (;;) {
        sum = 0u; cnt = 0u; mine = 0u;
#pragma unroll
        for (unsigned j = 0; j < 16; ++j) { const unsigned c = xb_ld(&bar[XB_XCNT(j)]); sum += c; cnt += (c > 0u) ? 1u : 0u; mine = (j == x) ? c : mine; }
        if (sum == G) break;
        __builtin_amdgcn_s_sleep(1);
        if ((++sp & 255u) == 0u) { if (xb_ld(&bar[XB_TMO])) break; if (sp > XB_SPIN_CAP) { atomicAdd(&bar[XB_TMO], 1u); break; } }
    }
    nloc = mine > 0u ? mine : 1u; nx = cnt > 0u ? cnt : 1u;
}
__device__ __forceinline__ int tidx();
__device__ __forceinline__ void xcd_barrier(const XcdBarrier& b) {
    asm volatile("s_waitcnt vmcnt(0)" ::: "memory");
    __syncthreads();
    if (tidx() == 0) {
        unsigned* bar = b.bar;
        __builtin_amdgcn_s_waitcnt(0);
        unsigned nloc = b.st[0], nx = b.st[1];
        if (nloc == 0u) { xcd_barrier_complete(bar, b.x, nloc, nx); b.st[0] = nloc; b.st[1] = nx; }
        const unsigned old = xb_add(&bar[XB_XSUB(b.x)], 1u);
        const unsigned gen = old / nloc;
        if (old + 1u == (gen + 1u) * nloc) {
            __builtin_amdgcn_fence(__ATOMIC_RELEASE, "agent");
            asm volatile("s_waitcnt vmcnt(0)" ::: "memory");
            const unsigned og = xb_add(&bar[XB_TOP], 1u);
            const unsigned tg = og / nx;
            if (og + 1u == (tg + 1u) * nx) xb_add(&bar[XB_TOPGEN], 1u);
            else XB_SPIN(xb_ld(&bar[XB_TOPGEN]) == tg, bar);
            __builtin_amdgcn_fence(__ATOMIC_ACQUIRE, "agent");
            xb_add(&bar[XB_XGEN(b.x)], 1u);
            asm volatile("s_waitcnt vmcnt(0)" ::: "memory");
        } else {
            XB_SPIN(xb_ld(&bar[XB_XGEN(b.x)]) == gen, bar);
            __builtin_amdgcn_fence(__ATOMIC_ACQUIRE, "agent");
            asm volatile("s_waitcnt vmcnt(0)" ::: "memory");
        }
    }
    __syncthreads();
}

struct Params {
    const float *x_prompt, *x_sample, *cache_ckv, *cache_krope, *state_lru, *c, *c_ctx;
    const float *w_mod[2], *b_mod[2], *g_mix[2], *g_ffn[2];
    const float *w_in, *g_q, *w_uq, *g_kv, *w_ukv, *conv_w, *conv_b, *w_rg, *b_rg, *w_ig, *b_ig, *lam, *w_o, *w_pool, *s_pool;
    const float *peer_wq[2], *peer_keys[2], *peer_u[2], *peer_v[2];
    const float* g_final;
    float* out;
    unsigned* bar; float* mod; float* ropetab;
    bf16_t *wt_in, *wt_uq, *wt_ukv, *wt_gate, *wt_o, *wt_pool, *wt_pq[2], *keysb[2];
    u8_t *u8[2], *v8[2]; float *su[2], *sv[2];
    bf16_t *hbuf, *P, *cqn, *ckvk, *kropek, *xc, *ug, *q, *Kn, *vT, *bxb, *qp, *h3;
    float *a, *agg, *gates; int* eidx; bf16_t* xres;
    bf16_t* mix; float *zbuf, *wbuf; unsigned *hqh, *hql; float* hsc; float* spl; bf16_t* a1m;
};

extern __shared__ __attribute__((aligned(16))) unsigned char smem[];
#define WTAB_OFF (131072 + 64)
__device__ __forceinline__ int hw_wave_slot() { return (int)(__builtin_amdgcn_s_getreg(0x2804) & 63u); }
__device__ __forceinline__ void wtab_init() { if ((threadIdx.x & 63) == 0) ((volatile int*)(smem + WTAB_OFF))[hw_wave_slot()] = (int)(threadIdx.x >> 6); }
__device__ __forceinline__ int tidx() {
    const int w = __builtin_amdgcn_readfirstlane(((volatile int*)(smem + WTAB_OFF))[hw_wave_slot()]);
    return (w << 6) | (int)__builtin_amdgcn_mbcnt_hi(~0u, __builtin_amdgcn_mbcnt_lo(~0u, 0u));
}
__device__ __forceinline__ float bf2f(bf16_t v) { return __uint_as_float(((unsigned)v) << 16); }
typedef __bf16 bf16x2_t __attribute__((ext_vector_type(2)));
__device__ __forceinline__ bf16_t f2bf(float f) { return __builtin_bit_cast(unsigned short, (__bf16)f); }
__device__ __forceinline__ unsigned pack_bf16(float a, float b) { bf16x2_t v = {(__bf16)a, (__bf16)b}; return __builtin_bit_cast(unsigned, v); }
typedef unsigned u32x2 __attribute__((ext_vector_type(2)));
typedef int i32x4 __attribute__((ext_vector_type(4)));
#define DPP_F(v, ctrl) __int_as_float(__builtin_amdgcn_update_dpp(0, __float_as_int(v), ctrl, 0xf, 0xf, true))
__device__ __forceinline__ float wave_sum(float v) {
    v += DPP_F(v, 0xB1); v += DPP_F(v, 0x4E); v += DPP_F(v, 0x141); v += DPP_F(v, 0x128);
    u32x2 r = __builtin_amdgcn_permlane16_swap(__float_as_uint(v), __float_as_uint(v), false, false);
    v = __uint_as_float(r[0]) + __uint_as_float(r[1]);
    r = __builtin_amdgcn_permlane32_swap(__float_as_uint(v), __float_as_uint(v), false, false);
    return __uint_as_float(r[0]) + __uint_as_float(r[1]);
}
__device__ __forceinline__ float wave_max(float v) {
    v = fmaxf(v, DPP_F(v, 0xB1)); v = fmaxf(v, DPP_F(v, 0x4E)); v = fmaxf(v, DPP_F(v, 0x141)); v = fmaxf(v, DPP_F(v, 0x128));
    u32x2 r = __builtin_amdgcn_permlane16_swap(__float_as_uint(v), __float_as_uint(v), false, false);
    v = fmaxf(__uint_as_float(r[0]), __uint_as_float(r[1]));
    r = __builtin_amdgcn_permlane32_swap(__float_as_uint(v), __float_as_uint(v), false, false);
    return fmaxf(__uint_as_float(r[0]), __uint_as_float(r[1]));
}
__device__ __forceinline__ float gelu_tanh(float x) {
    const float u = 0.7978845608028654f * (x + 0.044715f * x * x * x);
    const float e = __expf(2.f * u);
    const float th = 1.f - 2.f / (e + 1.f);
    return 0.5f * x * (1.f + th);
}
__device__ __forceinline__ float sigmoidf_(float x) { return 1.f / (1.f + __expf(-x)); }
__device__ __forceinline__ float silu_(float x) { return x / (1.f + __expf(-x)); }

struct TokInfo { int smp, b, s, S, mi, keyrow; };
__device__ __forceinline__ TokInfo tokinfo(int T) {
    TokInfo t;
    if (T < T_CTX) { t.smp = 0; t.b = T >> 8; t.s = T & 255; t.S = 256; t.mi = 0; t.keyrow = T; }
    else { const int u = T - T_CTX; t.smp = 1; t.b = u >> 11; t.s = u & 2047; t.S = 2048; t.mi = 1 + t.b; t.keyrow = T_CTX + t.b * 2304 + 256 + t.s; }
    return t;
}
__device__ __forceinline__ const float* x_in_row(const Params& p, int T) { return T < T_CTX ? p.x_prompt + (size_t)T * 1024 : p.x_sample + (size_t)(T - T_CTX) * 1024; }
__device__ __forceinline__ const float* modv(const Params& p, int l, int mi, int j) { return p.mod + ((size_t)(l * 9 + mi) * 6 + j) * 1024; }

__device__ __forceinline__ void unpack8(const uint4 r, float (&f)[8]) {
    f[0] = __uint_as_float(r.x << 16); f[1] = __uint_as_float(r.x & 0xffff0000u);
    f[2] = __uint_as_float(r.y << 16); f[3] = __uint_as_float(r.y & 0xffff0000u);
    f[4] = __uint_as_float(r.z << 16); f[5] = __uint_as_float(r.z & 0xffff0000u);
    f[6] = __uint_as_float(r.w << 16); f[7] = __uint_as_float(r.w & 0xffff0000u);
}

namespace pg8 {
typedef short bf16x8 __attribute__((ext_vector_type(8)));
typedef float f32x4 __attribute__((ext_vector_type(4)));
constexpr int BM = 256, BK = 64, HALF = 128, HTB = HALF * BK * 2  , STAGE_BYTES = 8 * HTB;
__device__ __forceinline__ int lds_byte(int r, int c) { const int st = (r >> 4) * 2 + (c >> 5), rr = r & 15, cc = c & 31, ob = rr * 64 + cc * 2; return st * 1024 + (ob ^ (((ob >> 9) & 1) << 5)); }
__device__ __forceinline__ void stage_rc(int b, int& R, int& C) { const int st = b / 1024, sb = b % 1024, swz = sb ^ (((sb >> 9) & 1) << 5); R = (st >> 1) * 16 + swz / 64; C = (st & 1) * 32 + (swz % 64) / 2; }
__device__ __forceinline__ int perm32(int rho) { const int n = rho >> 4, i = rho & 15; return 8 * (i >> 2) + 4 * n + (i & 3); }
struct Unit { int pm, pn; const char* A; const char* B; };
template <class Epi, class Sched, bool ALIGN_EPI, bool SP2>
__device__ __forceinline__ void gemm_phase(LAS unsigned char* lds, const int lda, const int ldb, const int K, const Sched& S, const Epi& E) {
    __builtin_amdgcn_sched_barrier(0);
    const int tid = tidx(), wid = __builtin_amdgcn_readfirstlane(tid >> 6), lane = tid & 63, wr = wid >> 2, wc = wid & 3, fr = lane & 15, fq = lane >> 4;
    const int nt = K / BK;
    unsigned voffA[2], voffB[2];
#pragma unroll
    for (int i = 0; i < 2; ++i) { int R, C; stage_rc(tid * 16 + i * 8192, R, C); const int Rb = Epi::PERM ? ((R & ~31) + perm32(R & 31)) : R;
        voffA[i] = (unsigned)(R * lda + C) * 2u; voffB[i] = (unsigned)(Rb * ldb + C) * 2u; }
    const size_t kstep = (size_t)(BK * 2);
    const size_t hstepA = (size_t)HALF * lda * 2, hstepB = (size_t)HALF * ldb * 2;
    const unsigned ldsw = (unsigned)wid * 1024u;
    const int aoff = lds_byte(wr * 64 + fr, fq * 8), boff = lds_byte(wc * 32 + fr, fq * 8);
#define PG8_SA(b, h) (((b) * 2 + (h)) * HTB)
#define PG8_SB(b, h) ((4 + (b) * 2 + (h)) * HTB)
#define PG8_STAGE(bufoff, gbase, voff) do { _Pragma("unroll") for (int _i = 0; _i < 2; ++_i) \
        __builtin_amdgcn_global_load_lds((const unsigned*)((const char*)(gbase) + (voff)[_i]), (LAS unsigned*)(lds + (bufoff) + ldsw + _i * 8192), 16, 0, 0); } while (0)
#define PG8_LDA(dst, b, h) do { _Pragma("unroll") for (int m = 0; m < 4; ++m) _Pragma("unroll") for (int k = 0; k < 2; ++k) dst[m][k] = *(const LAS bf16x8*)(lds + PG8_SA(b, h) + aoff + m * 2048 + k * 1024); } while (0)
#define PG8_LDB(dst, b, h) do { _Pragma("unroll") for (int n = 0; n < 2; ++n) _Pragma("unroll") for (int k = 0; k < 2; ++k) dst[n][k] = *(const LAS bf16x8*)(lds + PG8_SB(b, h) + boff + n * 2048 + k * 1024); } while (0)
#define PG8_MMA(ai, bj, At, Bt) do { __builtin_amdgcn_s_setprio(1); _Pragma("unroll") for (int m = 0; m < 4; ++m) _Pragma("unroll") for (int n = 0; n < 2; ++n) _Pragma("unroll") for (int k = 0; k < 2; ++k) \
        acc[ai][bj][m][n] = __builtin_amdgcn_mfma_f32_16x16x32_bf16(Bt[n][k], At[m][k], acc[ai][bj][m][n], 0, 0, 0); __builtin_amdgcn_s_setprio(0); } while (0)
#define PG8_WAIT_V(n) asm volatile("s_waitcnt vmcnt(" #n ")" ::: "memory")
#define PG8_WAIT_L(n) asm volatile("s_waitcnt lgkmcnt(" #n ")" ::: "memory")
#define PG8_BAR __builtin_amdgcn_s_barrier()
#define PG8_SCHED __builtin_amdgcn_sched_barrier(0)
    Unit cur, nxt; int ui = 0;
    if (!S.next(0, cur)) return;
    f32x4 acc[2][2][4][2];
#pragma unroll
    for (int a = 0; a < 2; ++a)
#pragma unroll
        for (int b = 0; b < 2; ++b)
#pragma unroll
            for (int m = 0; m < 4; ++m)
#pragma unroll
                for (int n = 0; n < 2; ++n) acc[a][b][m][n] = (f32x4){0.f, 0.f, 0.f, 0.f};
    bf16x8 At[4][2], B0[2][2], B1[2][2];
    const char* cA = cur.A; const char* cB = cur.B;
    if constexpr (SP2) {
        PG8_STAGE(PG8_SB(0, 0), cB, voffB); PG8_STAGE(PG8_SB(0, 1), cB + hstepB, voffB); PG8_STAGE(PG8_SA(0, 0), cA, voffA); PG8_STAGE(PG8_SA(0, 1), cA + hstepA, voffA);
        if (wr == 1) PG8_BAR;
        PG8_WAIT_V(2); PG8_BAR;
        PG8_STAGE(PG8_SB(1, 0), cB + kstep, voffB); PG8_STAGE(PG8_SA(1, 0), cA + kstep, voffA); PG8_STAGE(PG8_SB(1, 1), cB + hstepB + kstep, voffB);
        PG8_WAIT_V(6); PG8_BAR;
    } else {
        PG8_STAGE(PG8_SB(0, 0), cB, voffB); PG8_STAGE(PG8_SA(0, 0), cA, voffA); PG8_STAGE(PG8_SB(0, 1), cB + hstepB, voffB); PG8_STAGE(PG8_SA(0, 1), cA + hstepA, voffA);
        if (wr == 1) PG8_BAR;
        PG8_WAIT_V(4); PG8_BAR;
        PG8_STAGE(PG8_SB(1, 0), cB + kstep, voffB); PG8_STAGE(PG8_SA(1, 0), cA + kstep, voffA); PG8_STAGE(PG8_SB(1, 1), cB + hstepB + kstep, voffB);
        PG8_WAIT_V(6); PG8_BAR;
    }
    for (;;) {
        const bool has_next = S.next(ui + 1, nxt);
        const char* nA = has_next ? nxt.A : cA; const char* nB = has_next ? nxt.B : cB;
#pragma unroll 1
        for (int t = 0; t < nt; t += 2) {
            const bool last = (t == nt - 2);
            const char* a1 = cA + (size_t)(t + 1) * kstep;
            const char* a2 = last ? nA : cA + (size_t)(t + 2) * kstep; const char* b2 = last ? nB : cB + (size_t)(t + 2) * kstep;
            const char* a3 = a2 + kstep; const char* b3 = b2 + kstep;
            if constexpr (SP2) {
            PG8_LDB(B0, 0, 0); PG8_LDB(B1, 0, 1); PG8_SCHED; PG8_LDA(At, 0, 0); PG8_STAGE(PG8_SA(1, 1), a1 + hstepA, voffA);
            PG8_WAIT_V(8); PG8_WAIT_L(0); PG8_BAR; PG8_MMA(0, 0, At, B0); PG8_MMA(0, 1, At, B1); PG8_BAR; PG8_SCHED;
            PG8_LDA(At, 0, 1); PG8_STAGE(PG8_SB(0, 0), b2, voffB); PG8_STAGE(PG8_SB(0, 1), b2 + hstepB, voffB); PG8_STAGE(PG8_SA(0, 0), a2, voffA);
            PG8_WAIT_V(8); PG8_WAIT_L(0); PG8_BAR; PG8_MMA(1, 0, At, B0); PG8_MMA(1, 1, At, B1); PG8_BAR; PG8_SCHED;
            PG8_LDB(B0, 1, 0); PG8_LDB(B1, 1, 1); PG8_SCHED; PG8_LDA(At, 1, 0); PG8_STAGE(PG8_SA(0, 1), a2 + hstepA, voffA);
            PG8_WAIT_V(8); PG8_WAIT_L(0); PG8_BAR; PG8_MMA(0, 0, At, B0); PG8_MMA(0, 1, At, B1); PG8_BAR; PG8_SCHED;
            PG8_LDA(At, 1, 1); PG8_STAGE(PG8_SB(1, 0), b3, voffB); PG8_STAGE(PG8_SB(1, 1), b3 + hstepB, voffB); PG8_STAGE(PG8_SA(1, 0), a3, voffA);
            PG8_WAIT_V(8); PG8_WAIT_L(0); PG8_BAR; PG8_MMA(1, 0, At, B0); PG8_MMA(1, 1, At, B1); PG8_BAR; PG8_SCHED;
            } else {
            PG8_LDB(B0, 0, 0); PG8_SCHED; PG8_LDA(At, 0, 0); PG8_STAGE(PG8_SA(1, 1), a1 + hstepA, voffA);
            PG8_WAIT_L(8); PG8_BAR; PG8_WAIT_L(0); PG8_MMA(0, 0, At, B0); PG8_BAR; PG8_SCHED;
            PG8_LDB(B1, 0, 1); PG8_STAGE(PG8_SB(0, 0), b2, voffB);
            PG8_BAR; PG8_WAIT_L(0); PG8_MMA(0, 1, At, B1); PG8_BAR;
            PG8_LDA(At, 0, 1); PG8_STAGE(PG8_SA(0, 0), a2, voffA);
            PG8_BAR; PG8_WAIT_L(0); PG8_MMA(1, 0, At, B0); PG8_BAR; PG8_SCHED;
            PG8_STAGE(PG8_SB(0, 1), b2 + hstepB, voffB);
            PG8_WAIT_V(6); PG8_BAR; PG8_MMA(1, 1, At, B1); PG8_BAR;
            PG8_LDB(B0, 1, 0); PG8_SCHED; PG8_LDA(At, 1, 0); PG8_STAGE(PG8_SA(0, 1), a2 + hstepA, voffA);
            PG8_WAIT_L(8); PG8_BAR; PG8_WAIT_L(0); PG8_MMA(0, 0, At, B0); PG8_BAR; PG8_SCHED;
            PG8_LDB(B1, 1, 1); PG8_STAGE(PG8_SB(1, 0), b3, voffB);
            PG8_BAR; PG8_WAIT_L(0); PG8_MMA(0, 1, At, B1); PG8_BAR;
            PG8_LDA(At, 1, 1); PG8_STAGE(PG8_SA(1, 0), a3, voffA);
            PG8_BAR; PG8_WAIT_L(0); PG8_MMA(1, 0, At, B0); PG8_BAR; PG8_SCHED;
            PG8_STAGE(PG8_SB(1, 1), b3 + hstepB, voffB);
            PG8_WAIT_V(6); PG8_BAR; PG8_MMA(1, 1, At, B1); PG8_BAR;
            }
        }
        if constexpr (ALIGN_EPI) { if (wr == 0) PG8_BAR; }
        E(acc, cur, wr, wc, fr, fq);
        if (!has_next) break;
#pragma unroll
        for (int a = 0; a < 2; ++a)
#pragma unroll
            for (int b = 0; b < 2; ++b)
#pragma unroll
                for (int m = 0; m < 4; ++m)
#pragma unroll
                    for (int n = 0; n < 2; ++n) acc[a][b][m][n] = (f32x4){0.f, 0.f, 0.f, 0.f};
        cur = nxt; cA = nA; cB = nB; ++ui;
        if constexpr (ALIGN_EPI) { if (wr == 1) PG8_BAR; }
    }
    PG8_WAIT_V(0);
    if constexpr (!ALIGN_EPI) { if (wr == 0) PG8_BAR; }
    PG8_BAR;
    __builtin_amdgcn_sched_barrier(0);
#undef PG8_SA
#undef PG8_SB
#undef PG8_STAGE
#undef PG8_LDA
#undef PG8_LDB
#undef PG8_MMA
#undef PG8_WAIT_V
#undef PG8_WAIT_L
#undef PG8_BAR
#undef PG8_SCHED
}
struct TileOrder {
    int nN, total; const char* A; const char* B; size_t tA, tB;
    __device__ __forceinline__ bool next(int i, Unit& u) const {
        const int item = blockIdx.x + i * gridDim.x; if (item >= total) return false;
        const int lt = item >> 3; u.pn = lt % nN; u.pm = (lt / nN) * 8 + (item & 7);
        u.A = A + (size_t)u.pm * tA; u.B = B + (size_t)u.pn * tB; return true;
    }
};
}

typedef __bf16 bf16x8_t __attribute__((ext_vector_type(8)));
__device__ __forceinline__ int lds_off(int row, int chunk) { return row * 128 + ((chunk ^ ((row >> 1) & 7)) << 4); }
template <int TM, int TN, int WM, int WN>
__device__ __forceinline__ void gemm_acc(const bf16_t* __restrict__ As, int lda, const bf16_t* __restrict__ Bs, int ldb, int K, f32x16 (&acc)[TM][TN]) {
    static_assert(TM * WM == 4 && TN * WN == 4 && WM * WN == 4, "tile is 128 x 128, 4 waves");
    const int tid = tidx() & 255, lane = tid & 63, wid = tid >> 6, wm = wid / WN, wn = wid % WN, hl = lane >> 5, cl = lane & 31;
    unsigned char* sm = smem + (tidx() >> 8) * 65536;
#pragma unroll
    for (int i = 0; i < TM; ++i)
#pragma unroll
        for (int j = 0; j < TN; ++j)
#pragma unroll
            for (int r = 0; r < 16; ++r) acc[i][j][r] = 0.f;
    const int srow0 = wid * 32 + (lane >> 3), pc = lane & 7;
    const bf16_t* ga[4]; const bf16_t* gb[4];
#pragma unroll
    for (int i = 0; i < 4; ++i) {
        const int row = srow0 + 8 * i, lc = pc ^ ((row >> 1) & 7);
        ga[i] = As + (size_t)row * lda + lc * 8; gb[i] = Bs + (size_t)row * ldb + lc * 8;
    }
    unsigned char* lbase = sm + wid * 4096 + lane * 16;
    __syncthreads();
#pragma unroll
    for (int i = 0; i < 4; ++i) {
        __builtin_amdgcn_global_load_lds((const unsigned*)ga[i], (unsigned*)(lbase + i * 1024), 16, 0, 0);
        __builtin_amdgcn_global_load_lds((const unsigned*)gb[i], (unsigned*)(lbase + 16384 + i * 1024), 16, 0, 0);
    }
    asm volatile("s_waitcnt vmcnt(0)" ::: "memory");
    __syncthreads();
    const int nk = K >> 6;
    for (int kt = 0; kt < nk; ++kt) {
        const int cur = (kt & 1) * 32768, nxt = 32768 - cur;
        if (kt + 1 < nk) {
#pragma unroll
            for (int i = 0; i < 4; ++i) {
                __builtin_amdgcn_global_load_lds((const unsigned*)(ga[i] + (kt + 1) * 64), (unsigned*)(lbase + nxt + i * 1024), 16, 0, 0);
                __builtin_amdgcn_global_load_lds((const unsigned*)(gb[i] + (kt + 1) * 64), (unsigned*)(lbase + nxt + 16384 + i * 1024), 16, 0, 0);
            }
        }
#pragma unroll
        for (int ks = 0; ks < 4; ++ks) {
            bf16x8_t af[TM], bfr[TN];
#pragma unroll
            for (int i = 0; i < TM; ++i) af[i] = __builtin_bit_cast(bf16x8_t, *(const u32x4*)(sm + cur + lds_off(32 * (TM * wm + i) + cl, 2 * ks + hl)));
#pragma unroll
            for (int j = 0; j < TN; ++j) bfr[j] = __builtin_bit_cast(bf16x8_t, *(const u32x4*)(sm + cur + 16384 + lds_off(32 * (TN * wn + j) + cl, 2 * ks + hl)));
#pragma unroll
            for (int i = 0; i < TM; ++i)
#pragma unroll
                for (int j = 0; j < TN; ++j) acc[i][j] = __builtin_amdgcn_mfma_f32_32x32x16_bf16(af[i], bfr[j], acc[i][j], 0, 0, 0);
        }
        asm volatile("s_waitcnt vmcnt(0)" ::: "memory");
        __syncthreads();
    }
}
#define ACC_ROW(TMv, wm, i, r, hl) (32 * ((TMv) * (wm) + (i)) + ((r) & 3) + 8 * ((r) >> 2) + 4 * (hl))
#define ACC_COL(TNv, wn, j, cl)    (32 * ((TNv) * (wn) + (j)) + (cl))

#define N_ADA 384
#define NW_IN   (1792 * 1024)
#define NW_UQ   (768 * 384)
#define NW_UKV  (1024 * 256)
#define NW_GATE (4 * 512 * 128)
#define NW_O    (1024 * 1024)
#define NW_POOL (4 * 256 * 256)
#define NW_PQ   (2048 * 1024)
#define NW_KEYS (16 * 128 * 128)
#define NW_CKV  (8 * 256 * 256)
#define NW_CKR  (8 * 256 * 64)
#define NW_ROPE 3072
#define NW_SP 1024
#define NT_IN 448
#define NT_UQ 72
#define NT_UKV 64
#define NT_O 256
#define NT_POOL 64
#define NT_PQ 512
#define N_TR (NT_IN + NT_UQ + NT_UKV + NT_O + NT_POOL + 2 * NT_PQ)
#define NE_TOTAL (NW_GATE + 2 * NW_KEYS + NW_CKV + NW_CKR + NW_ROPE + NW_SP)
#define N_CONV_ITEMS ((NE_TOTAL + 4095) / 4096)
#define N_FP8_ITEMS (65536 / NWV / 4)

__device__ __forceinline__ void conv_elem(const Params& p, int e) {
    if (e < NW_GATE) {
        const int c = e & 127, cg = (e >> 7) & 511, nb = e >> 16;
        const int dir = cg >> 8, dg = (cg >> 6) & 3, ri = (cg >> 5) & 1, d = dg * 32 + (cg & 31);
        const float* src = ri ? p.w_ig : p.w_rg;
        p.wt_gate[e] = f2bf(src[(((size_t)dir * 4 + nb) * 128 + c) * 128 + d]); return; } e -= NW_GATE;
#pragma unroll
    for (int l = 0; l < 2; ++l) { if (e < NW_KEYS) { p.keysb[l][e] = f2bf(p.peer_keys[l][e]); return; } e -= NW_KEYS; }
    if (e < NW_CKV) { const int col = e & 255, j = (e >> 8) & 255, b = e >> 16; p.ckvk[(size_t)(T_CTX + b * 2304 + j) * 256 + col] = f2bf(p.cache_ckv[e]); return; } e -= NW_CKV;
    if (e < NW_CKR) { const int col = e & 63, j = (e >> 6) & 255, b = e >> 14; p.kropek[(size_t)(T_CTX + b * 2304 + j) * 64 + col] = f2bf(p.cache_krope[e]); return; } e -= NW_CKR;
    if (e < NW_ROPE) {
        int idx = e, isrow = e < 1024; if (!isrow) idx -= 1024;
        const int half = isrow ? 512 : 1024; const int sn = idx >= half; if (sn) idx -= half;
        const int pos = idx >> 4, fi = idx & 15;
        const float invf = exp2f(-(float)fi * (13.287712379549449f / 16.f));
        const float ang = (float)pos * invf;
        p.ropetab[e] = sn ? sinf(ang) : cosf(ang); return; } e -= NW_ROPE;
    if (e < NW_SP) { const float nl = -p.lam[e]; p.spl[e] = fmaxf(nl, 0.f) + log1pf(__expf(-fabsf(nl))); return; }
}
__device__ __forceinline__ void tr_tile(const float* __restrict__ src, int ldsrc, int nvalid, bf16_t* __restrict__ dst, int lddst, int k0, int n0, float scl = 1.f) {
    float* tile = (float*)(smem + (tidx() >> 8) * 32768);
    const int tid = tidx() & 255;
    __syncthreads();
#pragma unroll
    for (int i = 0; i < 4; ++i) {
        const int k = (tid >> 4) + 16 * i, n = (tid & 15) * 4;
        float4 v = make_float4(0.f, 0.f, 0.f, 0.f);
        if (n0 + n < nvalid) v = *(const float4*)(src + (size_t)(k0 + k) * ldsrc + n0 + n);
        tile[k * 65 + n] = v.x; tile[k * 65 + n + 1] = v.y; tile[k * 65 + n + 2] = v.z; tile[k * 65 + n + 3] = v.w;
    }
    __syncthreads();
    const int n = tid >> 2, kq = (tid & 3) * 16;
    unsigned w[8];
#pragma unroll
    for (int j = 0; j < 8; ++j) w[j] = pack_bf16(tile[(kq + 2 * j) * 65 + n] * scl, tile[(kq + 2 * j + 1) * 65 + n] * scl);
    uint4* d = (uint4*)(dst + (size_t)(n0 + n) * lddst + k0 + kq);
    d[0] = make_uint4(w[0], w[1], w[2], w[3]); d[1] = make_uint4(w[4], w[5], w[6], w[7]);
}
__device__ __forceinline__ void tr_item(const Params& p, int t) {
    if (t < NT_IN) { tr_tile(p.w_in, 1728, 1728, p.wt_in, 1024, (t % 16) * 64, (t / 16) * 64); return; } t -= NT_IN;
    if (t < NT_UQ) { tr_tile(p.w_uq, 768, 768, p.wt_uq, 384, (t % 6) * 64, (t / 6) * 64, 0.07216878364870322f * 1.4426950408889634f  ); return; } t -= NT_UQ;
    if (t < NT_UKV) {
        const int n0 = (t / 4) * 64, h = n0 >> 8, kv = (n0 >> 7) & 1, nn = kv * 512 + h * 128 + (n0 & 127);
        tr_tile(p.w_ukv, 1024, 1024, p.wt_ukv + ((ptrdiff_t)nn - n0) * 256, 256, (t % 4) * 64, n0); return; } t -= NT_UKV;
    if (t < NT_O) { tr_tile(p.w_o, 1024, 1024, p.wt_o, 1024, (t % 16) * 64, (t / 16) * 64); return; } t -= NT_O;
    if (t < NT_POOL) { const int g = t >> 4, tt = t & 15; tr_tile(p.w_pool + (size_t)g * 65536, 256, 256, p.wt_pool + (size_t)g * 65536, 256, (tt & 3) * 64, (tt >> 2) * 64); return; } t -= NT_POOL;
    if (t < NT_PQ) { tr_tile(p.peer_wq[0], 2048, 2048, p.wt_pq[0], 1024, (t % 16) * 64, (t / 16) * 64); return; } t -= NT_PQ;
    tr_tile(p.peer_wq[1], 2048, 2048, p.wt_pq[1], 1024, (t % 16) * 64, (t / 16) * 64);
}

__device__ void st_prologue(const Params& p) {
    const int tid = tidx(), lane = tid & 63, wid = tid >> 6;
    const int n_items = N_ADA + N_TR / 2 + N_CONV_ITEMS + N_FP8_ITEMS;
    for (int item = blockIdx.x; item < n_items; item += gridDim.x) {
        if (item < N_ADA) {
            float* svec = (float*)smem;
            float* red = (float*)(smem + 9 * 4096);
            __syncthreads();
            for (int i = tid; i < 9 * 1024; i += NTHR) { const int bc = i >> 10, k = i & 1023; const float cv = bc == 0 ? p.c_ctx[k] : p.c[(size_t)(bc - 1) * 1024 + k]; svec[i] = silu_(cv); }
            __syncthreads();
            const int cidx = item * 32 + (lane & 7) * 4, l = cidx / 6144, col = cidx % 6144, k0 = (wid * 8 + (lane >> 3)) * 16;
            const float* w = p.w_mod[l] + (size_t)k0 * 6144 + col;
            float acc[9][4];
#pragma unroll
            for (int b = 0; b < 9; ++b) { acc[b][0] = 0.f; acc[b][1] = 0.f; acc[b][2] = 0.f; acc[b][3] = 0.f; }
#pragma unroll 8
            for (int k = 0; k < 16; ++k) {
                const float4 wv = *(const float4*)(w + (size_t)k * 6144);
#pragma unroll
                for (int b = 0; b < 9; ++b) { const float sv = svec[b * 1024 + k0 + k]; acc[b][0] += wv.x * sv; acc[b][1] += wv.y * sv; acc[b][2] += wv.z * sv; acc[b][3] += wv.w * sv; }
            }
#pragma unroll
            for (int b = 0; b < 9; ++b)
#pragma unroll
                for (int j = 0; j < 4; ++j) { float v = acc[b][j]; v += __shfl_xor(v, 8); v += __shfl_xor(v, 16); v += __shfl_xor(v, 32); acc[b][j] = v; }
            if (lane < 8) {
#pragma unroll
                for (int b = 0; b < 9; ++b)
#pragma unroll
                    for (int j = 0; j < 4; ++j) red[(wid * 9 + b) * 32 + lane * 4 + j] = acc[b][j];
            }
            __syncthreads();
            for (int i = tid; i < 9 * 32; i += NTHR) {
                const int b = i >> 5, c = i & 31;
                const int ci = item * 32 + c, ll = ci / 6144, cc = ci % 6144;
                float v = 0.f;
#pragma unroll
                for (int w8 = 0; w8 < 8; ++w8) v += red[(w8 * 9 + b) * 32 + c];
                p.mod[(size_t)(ll * 9 + b) * 6144 + cc] = v + p.b_mod[ll][cc];
            }
        } else if (item < N_ADA + N_TR / 2) {
            tr_item(p, (item - N_ADA) * 2 + (tid >> 8));
        } else if (item < N_ADA + N_TR / 2 + N_CONV_ITEMS) {
            const int base = (item - N_ADA - N_TR / 2) * 4096;
            for (int i = tid; i < 4096; i += NTHR) { const int e = base + i; if (e < NE_TOTAL) conv_elem(p, e); }
        } else {
            const int row0 = ((item - N_ADA - N_TR / 2 - N_CONV_ITEMS) * NWV + wid) * 4;
            const int tb = row0 >> 14, er0 = row0 & 16383, l = tb >> 1;
            const float* src = ((tb & 1) ? p.peer_v[l] : p.peer_u[l]) + (size_t)er0 * 1024 + lane * 16;
            u8_t* dst = ((tb & 1) ? p.v8[l] : p.u8[l]) + (size_t)er0 * 512 + lane * 8;
            float* sc = ((tb & 1) ? p.sv[l] : p.su[l]) + er0;
            f32x4v f[4][4];
#pragma unroll
            for (int r = 0; r < 4; ++r)
#pragma unroll
                for (int j = 0; j < 4; ++j) f[r][j] = __builtin_nontemporal_load((const f32x4v*)(src + (size_t)r * 1024 + 4 * j));
#pragma unroll
            for (int r = 0; r < 4; ++r) {
                float am = 0.f, sq = 0.f;
#pragma unroll
                for (int j = 0; j < 4; ++j) {
                    am = fmaxf(fmaxf(am, fmaxf(fabsf(f[r][j][0]), fabsf(f[r][j][1]))), fmaxf(fabsf(f[r][j][2]), fabsf(f[r][j][3])));
                    sq += (f[r][j][0] * f[r][j][0] + f[r][j][1] * f[r][j][1]) + (f[r][j][2] * f[r][j][2] + f[r][j][3] * f[r][j][3]);
                }
                unsigned w[2]; float scale;
                if (tb & 1) {
                    sq = wave_sum(sq);
                    const float rms = sqrtf(sq * (1.f / 1024.f));
                    scale = rms > 0.f ? 0.3352f * rms : 1.f; const float inv = 1.f / scale;
#pragma unroll
                    for (int j = 0; j < 2; ++j) {
                        unsigned pk = 0u;
#pragma unroll
                        for (int i = 0; i < 8; ++i) {
                            const float x = f[r][2 * j + (i >> 2)][i & 3] * inv;
                            const int q = (int)fminf(fmaxf(rintf(x), -8.f), 7.f) + 8;
                            pk |= (unsigned)q << (8 * (i & 3) + 4 * (i >> 2));
                        }
                        w[j] = pk;
                    }
                } else {
                    sq = wave_sum(sq);
                    const float rms = sqrtf(sq * (1.f / 1024.f));
                    scale = rms > 0.f ? 0.3352f * rms : 1.f; const float inv = 1.f / scale;
#pragma unroll
                    for (int j = 0; j < 2; ++j) {
                        unsigned pk = 0u;
#pragma unroll
                        for (int i = 0; i < 8; ++i) {
                            const float x = f[r][2 * j + (i >> 2)][i & 3] * inv;
                            const int q = (int)fminf(fmaxf(rintf(x), -8.f), 7.f);
                            pk |= ((unsigned)q & 15u) << (4 * i);
                        }
                        w[j] = pk;
                    }
                }
                *(uint2*)(dst + (size_t)r * 512) = make_uint2(w[0], w[1]);
                if (lane == 0) sc[r] = scale;
            }
        }
    }
}

template <int FIRST>
__device__ void st_resnorm(const Params& p, int l) {
    const int lane = tidx() & 63, wid = tidx() >> 6, stride = gridDim.x * NWV;
    for (int T0 = blockIdx.x * NWV + wid; T0 < T_TOK; T0 += 2 * stride) {
        float4 xa[2][4]; uint4 xb[2][2]; uint4 ma[2][2];
#pragma unroll
        for (int u = 0; u < 2; ++u) {
            const int T = min(T0 + u * stride, T_TOK - 1);
            const uint4* mp = (const uint4*)(p.mix + (size_t)T * 1024 + lane * 16);
            if (FIRST) { const float* x0 = x_in_row(p, T) + lane * 16;
#pragma unroll
                for (int j = 0; j < 4; ++j) xa[u][j] = *(const float4*)(x0 + 4 * j); }
            else { const uint4* xp = (const uint4*)(p.xres + (size_t)T * 1024 + lane * 16); xb[u][0] = xp[0]; xb[u][1] = xp[1]; }
            ma[u][0] = mp[0]; ma[u][1] = mp[1];
        }
#pragma unroll
        for (int u = 0; u < 2; ++u) {
            const int T = T0 + u * stride;
            if (T < T_TOK) {
                const TokInfo ti = tokinfo(T);
                bf16_t* xr = p.xres + (size_t)T * 1024 + lane * 16;
                const float* gt = modv(p, l, ti.mi, 2) + lane * 16;
                float x0v[16];
                if (FIRST) {
#pragma unroll
                    for (int j = 0; j < 4; ++j) { x0v[4 * j] = xa[u][j].x; x0v[4 * j + 1] = xa[u][j].y; x0v[4 * j + 2] = xa[u][j].z; x0v[4 * j + 3] = xa[u][j].w; }
                } else { float t8[8]; unpack8(xb[u][0], t8);
#pragma unroll
                    for (int j = 0; j < 8; ++j) x0v[j] = t8[j];
                    unpack8(xb[u][1], t8);
#pragma unroll
                    for (int j = 0; j < 8; ++j) x0v[8 + j] = t8[j]; }
                float m[16]; { float t8[8]; unpack8(ma[u][0], t8);
#pragma unroll
                    for (int j = 0; j < 8; ++j) m[j] = t8[j];
                    unpack8(ma[u][1], t8);
#pragma unroll
                    for (int j = 0; j < 8; ++j) m[8 + j] = t8[j]; }
                if (!FIRST) {
                    const int W = 2 << (lane >> 4), wlo = max(ti.s - (W >> 1), 0), whi = min(ti.s + (W >> 1), ti.S);
                    const bf16_t* base = p.mix + (size_t)(T - ti.s) * 1024 + lane * 16;
                    float pa[16];
#pragma unroll
                    for (int j = 0; j < 16; ++j) pa[j] = 0.f;
#pragma unroll 1
                    for (int kc = 0; kc < 16; kc += 4) {
                        uint4 ra[4][2];
#pragma unroll
                        for (int k = 0; k < 4; ++k) {
                            const int t2 = ti.s - (W >> 1) + kc + k;
                            const bool ok = (kc + k < W) && t2 >= wlo && t2 < whi;
                            const uint4* rp = (const uint4*)(base + (size_t)(ok ? t2 : ti.s) * 1024);
                            ra[k][0] = ok ? rp[0] : make_uint4(0u, 0u, 0u, 0u); ra[k][1] = ok ? rp[1] : make_uint4(0u, 0u, 0u, 0u);
                        }
#pragma unroll
                        for (int k = 0; k < 4; ++k) { float t8[8]; unpack8(ra[k][0], t8);
#pragma unroll
                            for (int j = 0; j < 8; ++j) pa[j] += t8[j];
                            unpack8(ra[k][1], t8);
#pragma unroll
                            for (int j = 0; j < 8; ++j) pa[8 + j] += t8[j]; }
                    }
                    const float winv = 1.f / (float)(whi - wlo);
#pragma unroll
                    for (int j = 0; j < 16; ++j) m[j] = pa[j] * winv - m[j];
                }
                float v[16]; float ss = 0.f;
#pragma unroll
                for (int j = 0; j < 4; ++j) {
                    float4 g = *(const float4*)(gt + 4 * j);
                    if (!FIRST) { const float4 sp = *(const float4*)(p.s_pool + lane * 16 + 4 * j); g.x *= sp.x; g.y *= sp.y; g.z *= sp.z; g.w *= sp.w; }
                    v[4 * j] = x0v[4 * j] + g.x * m[4 * j]; v[4 * j + 1] = x0v[4 * j + 1] + g.y * m[4 * j + 1]; v[4 * j + 2] = x0v[4 * j + 2] + g.z * m[4 * j + 2]; v[4 * j + 3] = x0v[4 * j + 3] + g.w * m[4 * j + 3];
                }
                { uint4* xw = (uint4*)xr;
                  xw[0] = make_uint4(pack_bf16(v[0], v[1]), pack_bf16(v[2], v[3]), pack_bf16(v[4], v[5]), pack_bf16(v[6], v[7]));
                  xw[1] = make_uint4(pack_bf16(v[8], v[9]), pack_bf16(v[10], v[11]), pack_bf16(v[12], v[13]), pack_bf16(v[14], v[15])); }
#pragma unroll
                for (int j = 0; j < 16; ++j) ss += v[j] * v[j];
                ss = wave_sum(ss);
                const float rstd = rsqrtf(ss * (1.f / 1024.f) + 1e-6f);
                const float* sh = modv(p, l, ti.mi, 3) + lane * 16; const float* sc = modv(p, l, ti.mi, 4) + lane * 16; const float* gg = p.g_ffn[l] + lane * 16;
                float hval[16]; float hm = 0.f;
#pragma unroll
                for (int j = 0; j < 16; ++j) { hval[j] = v[j] * rstd * gg[j] * (1.f + sc[j]) + sh[j]; hm = fmaxf(hm, fabsf(hval[j])); }
                unsigned w[8];
#pragma unroll
                for (int j = 0; j < 8; ++j) w[j] = pack_bf16(hval[2 * j], hval[2 * j + 1]);
                uint4* d = (uint4*)(p.hbuf + (size_t)T * 1024 + lane * 16);
                d[0] = make_uint4(w[0], w[1], w[2], w[3]); d[1] = make_uint4(w[4], w[5], w[6], w[7]);
                hm = wave_max(hm);
                const float hs = hm > 0.f ? hm * (1.f / 119.f) : 1.f, hinv = 1.f / hs;
                unsigned ph[2] = {0u, 0u}, pl[2] = {0u, 0u};
#pragma unroll
                for (int j = 0; j < 16; ++j) {
                    const int h8 = (int)rintf(hval[j] * hinv);
                    const int lo = ((h8 + 8) & 15) - 8, hi = (h8 - lo) >> 4;
                    ph[j >> 3] |= ((unsigned)hi & 15u) << (4 * (j & 7)); pl[j >> 3] |= ((unsigned)lo & 15u) << (4 * (j & 7));
                }
                *(uint2*)(p.hqh + (size_t)T * 128 + lane * 2) = make_uint2(ph[0], ph[1]);
                *(uint2*)(p.hql + (size_t)T * 128 + lane * 2) = make_uint2(pl[0], pl[1]);
                if (lane == 0) p.hsc[T] = hs;
            }
        }
    }
}

template <int SRC>
__device__ void st_norm(const Params& p, int l, int which, const float* g, bf16_t* dst) {
    const int lane = tidx() & 63, wid = tidx() >> 6, stride = gridDim.x * NWV;
    for (int T0 = blockIdx.x * NWV + wid; T0 < T_TOK; T0 += 2 * stride) {
        float v[2][16];
#pragma unroll
        for (int u = 0; u < 2; ++u) {
            const int T = min(T0 + u * stride, T_TOK - 1);
            const float* src = x_in_row(p, T) + lane * 16;
#pragma unroll
            for (int j = 0; j < 4; ++j) { const float4 f = *(const float4*)(src + 4 * j); v[u][4 * j] = f.x; v[u][4 * j + 1] = f.y; v[u][4 * j + 2] = f.z; v[u][4 * j + 3] = f.w; }
        }
#pragma unroll
        for (int u = 0; u < 2; ++u) {
            const int T = T0 + u * stride;
            if (T < T_TOK) {
                const TokInfo ti = tokinfo(T);
                float ss = 0.f;
#pragma unroll
                for (int j = 0; j < 16; ++j) ss += v[u][j] * v[u][j];
                ss = wave_sum(ss);
                const float rstd = rsqrtf(ss * (1.f / 1024.f) + 1e-6f);
                const float* sh = modv(p, l, ti.mi, which ? 3 : 0) + lane * 16; const float* sc = modv(p, l, ti.mi, which ? 4 : 1) + lane * 16; const float* gg = g + lane * 16;
                unsigned w[8];
#pragma unroll
                for (int j = 0; j < 8; ++j) w[j] = pack_bf16(v[u][2 * j] * rstd * gg[2 * j] * (1.f + sc[2 * j]) + sh[2 * j], v[u][2 * j + 1] * rstd * gg[2 * j + 1] * (1.f + sc[2 * j + 1]) + sh[2 * j + 1]);
                uint4* d = (uint4*)(dst + (size_t)T * 1024 + lane * 16);
                d[0] = make_uint4(w[0], w[1], w[2], w[3]); d[1] = make_uint4(w[4], w[5], w[6], w[7]);
            }
        }
    }
}

struct EpiStoreBf16 {
    static constexpr bool PERM = true;
    bf16_t* O; int ldc;
    __device__ __forceinline__ void operator()(const pg8::f32x4 (&acc)[2][2][4][2], const pg8::Unit& u, int wr, int wc, int fr, int fq) const {
#pragma unroll
        for (int ai = 0; ai < 2; ++ai)
#pragma unroll
            for (int m = 0; m < 4; ++m) {
                bf16_t* rowp = O + (size_t)(u.pm * 256 + ai * 128 + wr * 64 + m * 16 + fr) * ldc + u.pn * 256 + wc * 32 + 8 * fq;
#pragma unroll
                for (int bj = 0; bj < 2; ++bj) {
                    const pg8::f32x4 v0 = acc[ai][bj][m][0], v1 = acc[ai][bj][m][1];
                    *(uint4*)(rowp + bj * 128) = make_uint4(pack_bf16(v0[0], v0[1]), pack_bf16(v0[2], v0[3]), pack_bf16(v1[0], v1[1]), pack_bf16(v1[2], v1[3]));
                }
            }
    }
};
__device__ void st_gemm1(const Params& p) {
    pg8::TileOrder S; S.nN = 7; S.total = 80 * 7; S.A = (const char*)p.hbuf; S.B = (const char*)p.wt_in; S.tA = (size_t)256 * 1024 * 2; S.tB = (size_t)256 * 1024 * 2;
    EpiStoreBf16 E; E.O = p.P; E.ldc = 1792;
    pg8::gemm_phase<EpiStoreBf16, pg8::TileOrder, true, true>((LAS unsigned char*)smem, 1024, 1024, 1024, S, E);
}

__device__ void st_postproj(const Params& p) {
    const int lane = tidx() & 63, wid = tidx() >> 6;
    float* o_ckv = p.out + 20971520, *o_kr = p.out + 22020096;
    for (int T = blockIdx.x * NWV + wid; T < T_TOK; T += gridDim.x * NWV) {
        const TokInfo ti = tokinfo(T);
        const bf16_t* Pr = p.P + (size_t)T * 1792;
        float cq[8], ck[8];
#pragma unroll
        for (int j = 0; j < 8; ++j) { cq[j] = 0.f; ck[j] = 0.f; }
        if (lane < 48) unpack8(*(const uint4*)(Pr + lane * 8), cq);
        if (lane < 32) unpack8(*(const uint4*)(Pr + 384 + lane * 8), ck);
        float s1 = 0.f, s2 = 0.f;
#pragma unroll
        for (int j = 0; j < 8; ++j) { s1 += cq[j] * cq[j]; s2 += ck[j] * ck[j]; }
        s1 = wave_sum(s1); s2 = wave_sum(s2);
        const float r1 = rsqrtf(s1 * (1.f / 384.f) + 1e-6f), r2 = rsqrtf(s2 * (1.f / 256.f) + 1e-6f);
        if (lane < 48) {
            const float4 ga = *(const float4*)(p.g_q + lane * 8), gb = *(const float4*)(p.g_q + lane * 8 + 4);
            uint4 o; o.x = pack_bf16(cq[0] * r1 * ga.x, cq[1] * r1 * ga.y); o.y = pack_bf16(cq[2] * r1 * ga.z, cq[3] * r1 * ga.w);
            o.z = pack_bf16(cq[4] * r1 * gb.x, cq[5] * r1 * gb.y); o.w = pack_bf16(cq[6] * r1 * gb.z, cq[7] * r1 * gb.w);
            *(uint4*)(p.cqn + (size_t)T * 384 + lane * 8) = o;
        }
        if (lane < 32) {
            const float4 ga = *(const float4*)(p.g_kv + lane * 8), gb = *(const float4*)(p.g_kv + lane * 8 + 4);
            float y[8] = {ck[0] * r2 * ga.x, ck[1] * r2 * ga.y, ck[2] * r2 * ga.z, ck[3] * r2 * ga.w, ck[4] * r2 * gb.x, ck[5] * r2 * gb.y, ck[6] * r2 * gb.z, ck[7] * r2 * gb.w};
            uint4 o; o.x = pack_bf16(y[0], y[1]); o.y = pack_bf16(y[2], y[3]); o.z = pack_bf16(y[4], y[5]); o.w = pack_bf16(y[6], y[7]);
            *(uint4*)(p.ckvk + (size_t)ti.keyrow * 256 + lane * 8) = o;
            if (!ti.smp) { float4* d = (float4*)(o_ckv + (size_t)T * 256 + lane * 8); d[0] = make_float4(y[0], y[1], y[2], y[3]); d[1] = make_float4(y[4], y[5], y[6], y[7]); }
        }
        if (lane < 8) {
            float v[8]; unpack8(*(const uint4*)(Pr + 640 + lane * 8), v);
            float y[8];
            if (ti.smp) {
                const int gr = ti.s >> 6, gc = ti.s & 63;
#pragma unroll
                for (int i = 0; i < 4; ++i) {
                    const int pr = lane * 4 + i;
                    const float cs = pr < 16 ? p.ropetab[gr * 16 + pr] : p.ropetab[1024 + gc * 16 + (pr - 16)];
                    const float sn = pr < 16 ? p.ropetab[512 + gr * 16 + pr] : p.ropetab[2048 + gc * 16 + (pr - 16)];
                    y[2 * i] = v[2 * i] * cs - v[2 * i + 1] * sn; y[2 * i + 1] = v[2 * i] * sn + v[2 * i + 1] * cs;
                }
            } else {
#pragma unroll
                for (int i = 0; i < 8; ++i) y[i] = v[i];
                float4* d = (float4*)(o_kr + (size_t)T * 64 + lane * 8); d[0] = make_float4(v[0], v[1], v[2], v[3]); d[1] = make_float4(v[4], v[5], v[6], v[7]);
            }
            uint4 o; o.x = pack_bf16(y[0], y[1]); o.y = pack_bf16(y[2], y[3]); o.z = pack_bf16(y[4], y[5]); o.w = pack_bf16(y[6], y[7]);
            *(uint4*)(p.kropek + (size_t)ti.keyrow * 64 + lane * 8) = o;
        }
        {
            const int ch = lane * 8;
            float y[8];
            { const float4 a = *(const float4*)(p.conv_b + ch), b = *(const float4*)(p.conv_b + ch + 4); y[0] = a.x; y[1] = a.y; y[2] = a.z; y[3] = a.w; y[4] = b.x; y[5] = b.y; y[6] = b.z; y[7] = b.w; }
#pragma unroll
            for (int k = 0; k < 4; ++k) {
                const int s2i = ti.s + k - 2;
                if (s2i >= 0 && s2i < ti.S) {
                    float u[8]; unpack8(*(const uint4*)(p.P + (size_t)(T + k - 2) * 1792 + 704 + ch), u);
                    const float4 a = *(const float4*)(p.conv_w + k * 512 + ch), b = *(const float4*)(p.conv_w + k * 512 + ch + 4);
                    y[0] += a.x * u[0]; y[1] += a.y * u[1]; y[2] += a.z * u[2]; y[3] += a.w * u[3]; y[4] += b.x * u[4]; y[5] += b.y * u[5]; y[6] += b.z * u[6]; y[7] += b.w * u[7];
                }
            }
            uint4 o; o.x = pack_bf16(y[0], y[1]); o.y = pack_bf16(y[2], y[3]); o.z = pack_bf16(y[4], y[5]); o.w = pack_bf16(y[6], y[7]);
            *(uint4*)(p.xc + (size_t)T * 512 + ch) = o;
            *(uint4*)(p.ug + (size_t)T * 512 + ch) = *(const uint4*)(Pr + 1216 + ch);
        }
    }
}

struct EpiVT {
    static constexpr bool PERM = true;
    bf16_t* vT;
    __device__ __forceinline__ void operator()(const pg8::f32x4 (&acc)[2][2][4][2], const pg8::Unit& u, int wr, int wc, int fr, int fq) const {
        const int R0 = u.pn * 256;
        size_t sbase; int Sk, pos0;
        if (R0 < T_CTX) { Sk = 256; pos0 = 0; sbase = (size_t)(R0 >> 8) * 4 * 128 * 256; }
        else { const int uu = R0 - T_CTX; const int sq = uu / 2304; Sk = 2304; pos0 = uu - sq * 2304; sbase = (size_t)T_CTX * 512 + (size_t)sq * 4 * 128 * 2304; }
        bf16_t* vb = vT + sbase + pos0 + wc * 32 + 8 * fq;
#pragma unroll
        for (int ai = 0; ai < 2; ++ai)
#pragma unroll
            for (int m = 0; m < 4; ++m) {
                const int r = u.pm * 256 + ai * 128 + wr * 64 + m * 16 + fr;
                bf16_t* rowp = vb + (size_t)r * Sk;
#pragma unroll
                for (int bj = 0; bj < 2; ++bj) {
                    const pg8::f32x4 v0 = acc[ai][bj][m][0], v1 = acc[ai][bj][m][1];
                    *(uint4*)(rowp + bj * 128) = make_uint4(pack_bf16(v0[0], v0[1]), pack_bf16(v0[2], v0[3]), pack_bf16(v1[0], v1[1]), pack_bf16(v1[2], v1[3]));
                }
            }
    }
};
#define N_G4 (160 * 16)
__device__ void st_gemm234(const Params& p) {
    {
        pg8::TileOrder S; S.nN = 3; S.total = 80 * 3; S.A = (const char*)p.cqn; S.B = (const char*)p.wt_uq; S.tA = (size_t)256 * 384 * 2; S.tB = (size_t)256 * 384 * 2;
        EpiStoreBf16 E; E.O = p.q; E.ldc = 768;
        pg8::gemm_phase<EpiStoreBf16, pg8::TileOrder, true, true>((LAS unsigned char*)smem, 384, 384, 384, S, E);
    }
    {
        pg8::TileOrder S; S.nN = 2; S.total = 88 * 2; S.A = (const char*)p.ckvk; S.B = (const char*)p.wt_ukv; S.tA = (size_t)256 * 256 * 2; S.tB = (size_t)256 * 256 * 2;
        EpiStoreBf16 E; E.O = p.Kn; E.ldc = 512;
        pg8::gemm_phase<EpiStoreBf16, pg8::TileOrder, true, true>((LAS unsigned char*)smem, 256, 256, 256, S, E);
    }
    {
        struct OrderVT {
            const char* W; const char* Kr;
            __device__ __forceinline__ bool next(int i, pg8::Unit& u) const {
                const int item = blockIdx.x + i * gridDim.x; if (item >= 88 * 2) return false;
                const int lt = item >> 3; u.pm = lt & 1; u.pn = (lt >> 1) * 8 + (item & 7);
                u.A = W + (size_t)u.pm * 256 * 256 * 2; u.B = Kr + (size_t)u.pn * 256 * 256 * 2; return true;
            }
        } S; S.W = (const char*)(p.wt_ukv + (size_t)512 * 256); S.Kr = (const char*)p.ckvk;
        EpiVT E; E.vT = p.vT;
        pg8::gemm_phase<EpiVT, OrderVT, true, true>((LAS unsigned char*)smem, 256, 256, 256, S, E);
    }
}

__device__ void st_gates(const Params& p) {
    const int half = tidx() >> 8, lane = tidx() & 63, wid = (tidx() >> 6) & 3, wm = wid >> 1, wn = wid & 1, hl = lane >> 5, cl = lane & 31;
    for (int item = blockIdx.x; item < N_G4 / 2; item += gridDim.x) {
        f32x16 acc[2][2];
        const int lt = (item >> 3) * 2 + half, tj = lt & 3, nb = (lt >> 2) & 3, tm = (lt >> 4) * 8 + (item & 7);
        gemm_acc<2, 2, 2, 2>(p.wt_gate + ((size_t)nb * 512 + tj * 128) * 128, 128, p.xc + (size_t)tm * 128 * 512 + nb * 128, 512, 128, acc);
        const int dir = tj >> 1, dg = (tj & 1) * 2 + wm;
#pragma unroll
        for (int gq = 0; gq < 4; ++gq) {
            const int ch0 = nb * 128 + dg * 32 + 8 * gq + 4 * hl;
            const float4 brg = *(const float4*)(p.b_rg + dir * 512 + ch0), big = *(const float4*)(p.b_ig + dir * 512 + ch0), sp = *(const float4*)(p.spl + dir * 512 + ch0);
            const float br[4] = {brg.x, brg.y, brg.z, brg.w}, bi[4] = {big.x, big.y, big.z, big.w}, spv[4] = {sp.x, sp.y, sp.z, sp.w};
#pragma unroll
            for (int j = 0; j < 2; ++j) {
                const int T = tm * 128 + 64 * wn + 32 * j + cl;
                const uint2 xr = *(const uint2*)(p.xc + (size_t)T * 512 + ch0);
                const float xv[4] = {__uint_as_float(xr.x << 16), __uint_as_float(xr.x & 0xffff0000u), __uint_as_float(xr.y << 16), __uint_as_float(xr.y & 0xffff0000u)};
                float am[4], bx[4];
#pragma unroll
                for (int e = 0; e < 4; ++e) {
                    const float rg = __builtin_amdgcn_rcpf(1.f + __expf(-(acc[0][j][4 * gq + e] + br[e]))), ig = __builtin_amdgcn_rcpf(1.f + __expf(-(acc[1][j][4 * gq + e] + bi[e])));
                    const float la = -8.f * rg * spv[e];
                    const float av = __expf(la);
                    am[e] = 1.f - av;
                    bx[e] = __builtin_amdgcn_sqrtf(fmaxf(1.f - av * av, 0.f)) * ig * xv[e];
                }
                *(uint2*)(p.a1m + ((size_t)T * 2 + dir) * 512 + ch0) = make_uint2(pack_bf16(am[0], am[1]), pack_bf16(am[2], am[3]));
                *(uint2*)(p.bxb + ((size_t)T * 2 + dir) * 512 + ch0) = make_uint2(pack_bf16(bx[0], bx[1]), pack_bf16(bx[2], bx[3]));
            }
        }
    }
}

#define N_ATT (64 + 256)
#define SCH 64
#define NCHK (T_TOK / SCH)
#define N_S1 (NCHK * 2)
__device__ void scan_s1_item(const Params& p, int it) {
    const int chunk = it >> 1, dc = (it & 1) * 512 + tidx(), dir = dc >> 9, ch = dc & 511;
    const int T0 = chunk * SCH;
    float A = 1.f, B = 0.f;
#pragma unroll 8
    for (int i = 0; i < SCH; ++i) {
        const int T = dir ? (T0 + SCH - 1 - i) : (T0 + i);
        const float av = 1.f - bf2f(p.a1m[((size_t)T * 2 + dir) * 512 + ch]), bv = bf2f(p.bxb[((size_t)T * 2 + dir) * 512 + ch]);
        A *= av; B = B * av + bv;
    }
    *(float2*)(p.agg + (((size_t)chunk * 2 + dir) * 512 + ch) * 2) = make_float2(A, B);
}

__device__ __forceinline__ int perm23(int r) { return (r & 0x13) | ((r & 4) << 1) | ((r & 8) >> 1); }
__device__ void attn_item_mfma(const Params& p, int it) {
    int seq, h, qb, Sk, T0, R0; size_t vbase;
    if (it < 64) { seq = it >> 2; h = it & 3; qb = 0; Sk = 256; T0 = seq * 256; R0 = seq * 256; vbase = (size_t)(seq * 4 + h) * 128 * 256; }
    else { const int u = it - 64; seq = u >> 5; h = (u >> 3) & 3; qb = u & 7; Sk = 2304; T0 = T_CTX + seq * 2048 + qb * 256; R0 = T_CTX + seq * 2304; vbase = (size_t)T_CTX * 512 + (size_t)(seq * 4 + h) * 128 * 2304; }
    const int tid = tidx(), lane = tid & 63, wid = tid >> 6, hl = lane >> 5, cl = lane & 31;
    bf16x8_t qf[12];
    {
        const bf16_t* qrow = p.q + (size_t)(T0 + 32 * wid + cl) * 768 + h * 192 + 8 * hl;
#pragma unroll
        for (int ks = 0; ks < 12; ++ks) qf[ks] = __builtin_bit_cast(bf16x8_t, *(const u32x4*)(qrow + 16 * ks));
        if (it >= 64) {
            const int sp = qb * 256 + 32 * wid + cl, gr = sp >> 6, gc = sp & 63;
#pragma unroll
            for (int ks = 8; ks < 12; ++ks) {
                const u32x4 w = __builtin_bit_cast(u32x4, qf[ks]); u32x4 o;
#pragma unroll
                for (int i = 0; i < 4; ++i) {
                    const int pr = 8 * (ks - 8) + 4 * hl + i;
                    const float cs = ks < 10 ? p.ropetab[gr * 16 + pr] : p.ropetab[1024 + gc * 16 + (pr - 16)];
                    const float sn = ks < 10 ? p.ropetab[512 + gr * 16 + pr] : p.ropetab[2048 + gc * 16 + (pr - 16)];
                    const float x0 = __uint_as_float(w[i] << 16), x1 = __uint_as_float(w[i] & 0xffff0000u);
                    o[i] = pack_bf16(x0 * cs - x1 * sn, x0 * sn + x1 * cs);
                }
                qf[ks] = __builtin_bit_cast(bf16x8_t, o);
            }
        }
    }
    f32x16 oacc[4];
#pragma unroll
    for (int d = 0; d < 4; ++d)
#pragma unroll
        for (int r = 0; r < 16; ++r) oacc[d][r] = 0.f;
    float m = -1e30f, lsum = 0.f;
    const bf16_t* gk = p.Kn + (size_t)(R0 + (tid >> 4)) * 512 + h * 128 + (tid & 15) * 8;
    const bf16_t* gr = p.kropek + (size_t)(R0 + (tid >> 3)) * 64 + (tid & 7) * 8;
    const bf16_t* gv = p.vT + vbase + (size_t)(tid >> 3) * Sk + (tid & 7) * 8;
    u32x4 rk[2], rr, rv[2];
    const int nt = Sk >> 6;
#pragma unroll
    for (int i = 0; i < 2; ++i) rk[i] = *(const u32x4*)(gk + (size_t)(32 * i) * 512);
    rr = *(const u32x4*)gr;
#pragma unroll
    for (int i = 0; i < 2; ++i) rv[i] = *(const u32x4*)(gv + (size_t)(64 * i) * Sk);
    __syncthreads();
    for (int t = 0; t < nt; ++t) {
#pragma unroll
        for (int i = 0; i < 2; ++i) *(u32x4*)(smem + ((tid & 15) >> 3) * 8192 + lds_off((tid >> 4) + 32 * i, tid & 7)) = rk[i];
        *(u32x4*)(smem + 16384 + lds_off(tid >> 3, tid & 7)) = rr;
#pragma unroll
        for (int i = 0; i < 2; ++i) *(u32x4*)(smem + 24576 + lds_off((tid >> 3) + 64 * i, tid & 7)) = rv[i];
        __syncthreads();
        if (t + 1 < nt) {
            const size_t ko = (size_t)(t + 1) * 64;
#pragma unroll
            for (int i = 0; i < 2; ++i) rk[i] = *(const u32x4*)(gk + (ko + 32 * i) * 512);
            rr = *(const u32x4*)(gr + ko * 64);
#pragma unroll
            for (int i = 0; i < 2; ++i) rv[i] = *(const u32x4*)(gv + (size_t)(64 * i) * Sk + ko);
        }
        f32x16 sacc[2];
#pragma unroll
        for (int kb = 0; kb < 2; ++kb) {
            __builtin_amdgcn_sched_barrier(0);
#pragma unroll
            for (int r = 0; r < 16; ++r) sacc[kb][r] = 0.f;
            const int krow = 32 * kb + perm23(cl);
#pragma unroll
            for (int ks = 0; ks < 12; ++ks) {
                const bf16x8_t kf = __builtin_bit_cast(bf16x8_t, *(const u32x4*)(smem + (ks >> 2) * 8192 + lds_off(krow, 2 * (ks & 3) + hl)));
                sacc[kb] = __builtin_amdgcn_mfma_f32_32x32x16_bf16(kf, qf[ks], sacc[kb], 0, 0, 0);
            }
        }
        float mx = sacc[0][0];
#pragma unroll
        for (int r = 1; r < 16; ++r) mx = fmaxf(mx, sacc[0][r]);
#pragma unroll
        for (int r = 0; r < 16; ++r) mx = fmaxf(mx, sacc[1][r]);
        mx = fmaxf(mx, __shfl_xor(mx, 32));
        const bool resc = !__all(mx - m <= 8.f);
        const float mn = resc ? fmaxf(m, mx) : m, alpha = resc ? __builtin_amdgcn_exp2f(m - mn) : 1.f;
        m = mn;
        float ps = 0.f;
        bf16x8_t pf[2][2];
#pragma unroll
        for (int kb = 0; kb < 2; ++kb)
#pragma unroll
            for (int s2 = 0; s2 < 2; ++s2) {
                float e[8];
#pragma unroll
                for (int j = 0; j < 8; ++j) { e[j] = __builtin_amdgcn_exp2f(sacc[kb][8 * s2 + j] - mn); ps += e[j]; }
                u32x4 w; w.x = pack_bf16(e[0], e[1]); w.y = pack_bf16(e[2], e[3]); w.z = pack_bf16(e[4], e[5]); w.w = pack_bf16(e[6], e[7]);
                pf[kb][s2] = __builtin_bit_cast(bf16x8_t, w);
            }
        lsum = lsum * alpha + ps;
        if (resc) {
#pragma unroll
            for (int d = 0; d < 4; ++d)
#pragma unroll
                for (int r = 0; r < 16; ++r) oacc[d][r] *= alpha;
        }
#pragma unroll
        for (int d = 0; d < 4; ++d) {
            __builtin_amdgcn_sched_barrier(0);
#pragma unroll
            for (int kb = 0; kb < 2; ++kb)
#pragma unroll
                for (int s2 = 0; s2 < 2; ++s2) {
                    const bf16x8_t vf = __builtin_bit_cast(bf16x8_t, *(const u32x4*)(smem + 24576 + lds_off(32 * d + cl, 4 * kb + 2 * s2 + hl)));
                    oacc[d] = __builtin_amdgcn_mfma_f32_32x32x16_bf16(vf, pf[kb][s2], oacc[d], 0, 0, 0);
                }
        }
        __builtin_amdgcn_sched_barrier(0);
        __syncthreads();
    }
    lsum += __shfl_xor(lsum, 32);
    const float inv = 1.f / lsum;
    bf16_t* dst = p.hbuf + (size_t)(T0 + 32 * wid + cl) * 1024 + h * 128 + 4 * hl;
#pragma unroll
    for (int d = 0; d < 4; ++d)
#pragma unroll
        for (int g = 0; g < 4; ++g) {
            uint2 w; w.x = pack_bf16(oacc[d][4 * g] * inv, oacc[d][4 * g + 1] * inv); w.y = pack_bf16(oacc[d][4 * g + 2] * inv, oacc[d][4 * g + 3] * inv);
            *(uint2*)(dst + 32 * d + 8 * g) = w;
        }
}
__device__ void st_attn_s1(const Params& p) {
    for (int item = blockIdx.x; item < N_ATT + N_S1; item += gridDim.x) {
        if (item < N_ATT) {
            attn_item_mfma(p, N_ATT - 1 - item);
        }
        else scan_s1_item(p, item - N_ATT);
    }
}

__device__ void st_scan3(const Params& p) {
    const int tid = tidx();
    float* hf = (float*)smem;
    float* hb = hf + SCH * 256;
    float* o_lru = p.out + 22282240;
    for (int item = blockIdx.x; item < NCHK * 2; item += gridDim.x) {
        const int chunk = item >> 1, cgp = item & 1, T0 = chunk * SCH;
        const TokInfo ti = tokinfo(T0);
        const int nch = ti.S / SCH, cpos = ti.s / SCH, c0 = chunk - cpos;
        const int dir = tid >> 8, ch = cgp * 256 + (tid & 255);
        float hcur = ti.smp ? p.state_lru[((size_t)ti.b * 2 + dir) * 512 + ch] : 0.f;
        if (dir == 0) { for (int cc = 0; cc < cpos; ++cc) { const float2 ab = *(const float2*)(p.agg + (((size_t)(c0 + cc) * 2 + 0) * 512 + ch) * 2); hcur = ab.x * hcur + ab.y; } }
        else { for (int cc = nch - 1; cc > cpos; --cc) { const float2 ab = *(const float2*)(p.agg + (((size_t)(c0 + cc) * 2 + 1) * 512 + ch) * 2); hcur = ab.x * hcur + ab.y; } }
        __syncthreads();
#pragma unroll 8
        for (int i = 0; i < SCH; ++i) {
            const int tl = dir ? SCH - 1 - i : i, T = T0 + tl;
            const float av = 1.f - bf2f(p.a1m[((size_t)T * 2 + dir) * 512 + ch]), bv = bf2f(p.bxb[((size_t)T * 2 + dir) * 512 + ch]);
            hcur = av * hcur + bv;
            (dir ? hb : hf)[tl * 256 + (tid & 255)] = hcur;
        }
        if (!ti.smp) {
            if (dir == 0 && cpos == nch - 1) o_lru[((size_t)ti.b * 2 + 0) * 512 + ch] = hcur;
            if (dir == 1 && cpos == 0) o_lru[((size_t)ti.b * 2 + 1) * 512 + ch] = hcur;
        }
        __syncthreads();
        for (int i = tid; i < SCH * 128; i += NTHR) {
            const int tl = i >> 7, c = (i & 127) * 2, T = T0 + tl, chh = cgp * 256 + c;
            const unsigned ugp = *(const unsigned*)(p.ug + (size_t)T * 512 + chh);
            const float g0 = gelu_tanh(__uint_as_float(ugp << 16)), g1 = gelu_tanh(__uint_as_float(ugp & 0xffff0000u));
            const float2 f = *(const float2*)(hf + tl * 256 + c), bb = *(const float2*)(hb + tl * 256 + c);
            *(unsigned*)(p.hbuf + (size_t)T * 1024 + 512 + chh) = pack_bf16((f.x + bb.x) * g0, (f.y + bb.y) * g1);
        }
    }
}

__device__ void st_gemm_o(const Params& p) {
    pg8::TileOrder S; S.nN = 4; S.total = 80 * 4; S.A = (const char*)p.hbuf; S.B = (const char*)p.wt_o; S.tA = (size_t)256 * 1024 * 2; S.tB = (size_t)256 * 1024 * 2;
    EpiStoreBf16 E; E.O = p.mix; E.ldc = 1024;
    pg8::gemm_phase<EpiStoreBf16, pg8::TileOrder, true, true>((LAS unsigned char*)smem, 1024, 1024, 1024, S, E);
}

__device__ __forceinline__ void ce_desc(float& a, float& b) { const float hi = fmaxf(a, b), lo = fminf(a, b); a = hi; b = lo; }
__device__ __forceinline__ void ins16(float (&top)[16], float x) {
#pragma unroll
    for (int i = 0; i < 16; ++i) { const float hi = fmaxf(top[i], x); x = fminf(top[i], x); top[i] = hi; }
}
__device__ __forceinline__ void bitonic_merge16(float (&v)[16]) {
#pragma unroll
    for (int j = 8; j >= 1; j >>= 1)
#pragma unroll
        for (int i = 0; i < 16; ++i) { const int l = i ^ j; if (l > i) ce_desc(v[i], v[l]); }
}
__device__ __forceinline__ void sort16(float (&v)[16]) {
#pragma unroll
    for (int k = 2; k <= 16; k <<= 1)
#pragma unroll
        for (int j = k >> 1; j >= 1; j >>= 1)
#pragma unroll
            for (int i = 0; i < 16; ++i) { const int l = i ^ j; if (l > i) { if ((i & k) == 0) ce_desc(v[i], v[l]); else ce_desc(v[l], v[i]); } }
}
__device__ __forceinline__ void merge_top16(float (&a)[16], const float (&b)[16]) {
#pragma unroll
    for (int i = 0; i < 16; ++i) a[i] = fmaxf(a[i], b[15 - i]);
    bitonic_merge16(a);
}
#define PKV(x) __uint_as_float(__float_as_uint(x) & 0xffffff80u)
#define CAND(i, j) __uint_as_float((__float_as_uint(PKV(top[0][i]) + PKV(top[1][j])) & 0xffffff00u) | (unsigned)((i) * 16 + (j)))
__device__ void st_peer_topk(const Params& p, int l) {
    __builtin_amdgcn_sched_barrier(0);
    const int half = tidx() >> 8, lane = tidx() & 63, wid = (tidx() >> 6) & 3, hl = lane >> 5, cl = lane & 31;
    for (int item = blockIdx.x; item < 80 * 8; item += gridDim.x) {
        const int lt = item >> 3, h = lt & 7, tm = 2 * ((lt >> 3) * 8 + (item & 7)) + half;
        const int T = tm * 128 + 32 * wid + cl;
        float top[2][16];
#pragma unroll
        for (int pp = 0; pp < 2; ++pp) {
            f32x16 acc[4][1];
            gemm_acc<4, 1, 1, 4>(p.keysb[l] + (size_t)(h * 2 + pp) * 128 * 128, 128, p.qp + (size_t)tm * 128 * 2048 + h * 256 + pp * 128, 2048, 128, acc);
#pragma unroll
            for (int i = 0; i < 4; ++i) {
                __builtin_amdgcn_sched_barrier(0);
                float g[16];
#pragma unroll
                for (int r = 0; r < 16; ++r) {
                    const int n = ACC_ROW(4, 0, i, r, hl);
                    g[r] = __uint_as_float((__float_as_uint(acc[i][0][r]) & 0xffffff80u) | (unsigned)n);
                }
                sort16(g);
                if (i == 0) {
#pragma unroll
                    for (int r = 0; r < 16; ++r) top[pp][r] = g[r];
                } else merge_top16(top[pp], g);
            }
            __builtin_amdgcn_sched_barrier(0);
            float oth[16];
#pragma unroll
            for (int i = 0; i < 16; ++i) oth[i] = __shfl_xor(top[pp][i], 32);
            merge_top16(top[pp], oth);
        }
        __builtin_amdgcn_sched_barrier(0);
        float fv[16], t2[16];
#pragma unroll
        for (int j = 0; j < 16; ++j) fv[j] = CAND(0, j);
        t2[15] = -INFINITY;
#pragma unroll
        for (int i = 1; i < 16; ++i) t2[i - 1] = CAND(i, 0);
        merge_top16(fv, t2);
        t2[0] = CAND(1, 1); t2[1] = CAND(1, 2); t2[2] = CAND(1, 3); t2[3] = CAND(1, 4); t2[4] = CAND(1, 5); t2[5] = CAND(1, 6); t2[6] = CAND(1, 7);
        t2[7] = CAND(2, 1); t2[8] = CAND(2, 2); t2[9] = CAND(2, 3); t2[10] = CAND(2, 4); t2[11] = CAND(3, 1); t2[12] = CAND(3, 2); t2[13] = CAND(3, 3);
        t2[14] = CAND(4, 1); t2[15] = CAND(4, 2);
        sort16(t2);
        merge_top16(fv, t2);
        ins16(fv, CAND(5, 1)); ins16(fv, CAND(6, 1)); ins16(fv, CAND(7, 1));
        unsigned* tab = (unsigned*)(smem + half * 65536) + (size_t)(tidx() & 255) * 8;
#pragma unroll
        for (int k = 0; k < 4; ++k) {
            tab[k] = (__float_as_uint(top[0][4 * k]) & 127u) | ((__float_as_uint(top[0][4 * k + 1]) & 127u) << 8) | ((__float_as_uint(top[0][4 * k + 2]) & 127u) << 16) | ((__float_as_uint(top[0][4 * k + 3]) & 127u) << 24);
            tab[4 + k] = (__float_as_uint(top[1][4 * k]) & 127u) | ((__float_as_uint(top[1][4 * k + 1]) & 127u) << 8) | ((__float_as_uint(top[1][4 * k + 2]) & 127u) << 16) | ((__float_as_uint(top[1][4 * k + 3]) & 127u) << 24);
        }
        const u8_t* tabb = (const u8_t*)tab;
        int fe[16];
#pragma unroll
        for (int i = 0; i < 16; ++i) {
            const unsigned code = __float_as_uint(fv[i]) & 255u;
            fe[i] = (int)tabb[code >> 4] * 128 + (int)tabb[16 + (code & 15u)];
            fv[i] = __uint_as_float(__float_as_uint(fv[i]) & 0xffffff00u);
        }
        float sum = 0.f, ev[16];
#pragma unroll
        for (int i = 0; i < 16; ++i) { ev[i] = __expf(fv[i] - fv[0]); sum += ev[i]; }
        const float inv = 1.f / sum;
        if (hl == 0) {
            float4* gp = (float4*)(p.gates + (size_t)T * 128 + h * 16); int4* ep = (int4*)(p.eidx + (size_t)T * 128 + h * 16);
#pragma unroll
            for (int i = 0; i < 4; ++i) { gp[i] = make_float4(ev[4 * i] * inv, ev[4 * i + 1] * inv, ev[4 * i + 2] * inv, ev[4 * i + 3] * inv); ep[i] = make_int4(fe[4 * i], fe[4 * i + 1], fe[4 * i + 2], fe[4 * i + 3]); }
        }
    }
}

__device__ void st_gemm_pq(const Params& p, int l) {
    pg8::TileOrder S; S.nN = 8; S.total = 80 * 8; S.A = (const char*)p.hbuf; S.B = (const char*)p.wt_pq[l]; S.tA = (size_t)256 * 1024 * 2; S.tB = (size_t)256 * 1024 * 2;
    EpiStoreBf16 E; E.O = p.qp; E.ldc = 2048;
    pg8::gemm_phase<EpiStoreBf16, pg8::TileOrder, true, true>((LAS unsigned char*)smem, 1024, 1024, 1024, S, E);
    asm volatile("s_waitcnt vmcnt(0)" ::: "memory");
    __syncthreads();
    st_peer_topk(p, l);
}

#define GT_TPW 10
#define GT_WAVE_LDS 12288
#define FP4X(dw, b) __builtin_amdgcn_cvt_scalef32_pk_f32_fp4(dw, 1.0f, b)
#define FP4B(dw, b) __builtin_amdgcn_cvt_scalef32_pk_bf16_fp4(dw, 1.0f, b)
__device__ void st_peer_gather(const Params& p, int l) {
    const int lane = tidx() & 63, wid = __builtin_amdgcn_readfirstlane(tidx() >> 6), g = lane >> 3, pc = lane & 7;
    const u8_t* U = p.u8[l]; const u8_t* V = p.v8[l]; const float* SU = p.su[l]; const float* SV = p.sv[l];
    const bool b0 = (lane & 1) != 0, b1 = (lane & 2) != 0, b2 = (lane & 4) != 0, b3 = (lane & 8) != 0;
    const int stride = gridDim.x * NWV, Tfirst = blockIdx.x * NWV + wid;
    const int ka = 16 * g + pc, kb = ka + 8;
    LAS unsigned* eo_l = (LAS unsigned*)(smem + wid * GT_WAVE_LDS);
    LAS float* zw_l = (LAS float*)(smem + wid * GT_WAVE_LDS + GT_TPW * 512);
    LAS unsigned char* wq_l = (LAS unsigned char*)(smem + wid * GT_WAVE_LDS + GT_TPW * 1024);
    LAS float* tsc_l = (LAS float*)(smem + wid * GT_WAVE_LDS + GT_TPW * 1152);
    const int vj = lane & 15, vg = lane >> 4;
    unsigned selb[4];
#pragma unroll
    for (int bb = 0; bb < 4; ++bb) selb[bb] = (0x0C0C0C0Cu & ~(0xFFu << (8 * (lane & 3)))) | ((unsigned)bb << (8 * (lane & 3)));
#pragma unroll 1
    for (int Tr = Tfirst; Tr < T_TOK; Tr += stride * GT_TPW) {
#pragma unroll
        for (int k = 0; k < GT_TPW; ++k) {
            const int T = Tr + k * stride;
            if (T < T_TOK) { const int2 e = *(const int2*)(p.eidx + (size_t)T * 128 + 2 * lane); *(LAS u32x2*)(eo_l + k * 128 + 2 * lane) = (u32x2){(unsigned)e.x * 512u, (unsigned)e.y * 512u}; }
        }
        __builtin_amdgcn_wave_barrier();
#pragma unroll 1
        for (int c = 0; c < 4; ++c) {
#pragma unroll 1
            for (int k = 0; k < GT_TPW; ++k) {
                const int T = Tr + k * stride;
                if (T >= T_TOK) break;
                u32x4 eo[4];
#pragma unroll
                for (int q = 0; q < 4; ++q) eo[q] = *(LAS const u32x4*)(eo_l + k * 128 + 16 * g + 4 * q);
                const u32x4 hh4 = *(const u32x4*)(p.hqh + (size_t)T * 128 + c * 32 + pc * 4), hl4 = *(const u32x4*)(p.hql + (size_t)T * 128 + c * 32 + pc * 4);
                u32x4 r[16];
#pragma unroll
                for (int i = 0; i < 16; ++i) r[i] = *(const u32x4*)(U + (eo[i >> 2][i & 3] + (unsigned)(c * 128 + pc * 16)));
                float za = 0.f, zb = 0.f;
                if (c > 0) { za = zw_l[k * 128 + ka]; zb = zw_l[k * 128 + kb]; }
#pragma unroll
                for (int hh = 0; hh < 2; ++hh) {
                    float d[8];
#pragma unroll
                    for (int ii = 0; ii < 8; ++ii) {
                        int ah = 0, al = 0;
#pragma unroll
                        for (int q = 0; q < 4; ++q) { ah = __builtin_amdgcn_sdot8((int)r[8 * hh + ii][q], (int)hh4[q], ah, false); al = __builtin_amdgcn_sdot8((int)r[8 * hh + ii][q], (int)hl4[q], al, false); }
                        d[ii] = (float)(ah * 16 + al);
                    }
                    float a4[4], a2[2];
#pragma unroll
                    for (int j = 0; j < 4; ++j) { const float kp = b2 ? d[j + 4] : d[j], sn = b2 ? d[j] : d[j + 4]; a4[j] = kp + DPP_F(sn, 0x141); }
#pragma unroll
                    for (int j = 0; j < 2; ++j) { const float kp = b1 ? a4[j + 2] : a4[j], sn = b1 ? a4[j] : a4[j + 2]; a2[j] = kp + DPP_F(sn, 0x4E); }
                    const float kp = b0 ? a2[1] : a2[0], sn = b0 ? a2[0] : a2[1];
                    const float z = kp + DPP_F(sn, 0xB1);
                    if (hh == 0) za += z; else zb += z;
                }
                if (c < 3) { zw_l[k * 128 + ka] = za; zw_l[k * 128 + kb] = zb; }
                else {
                    const unsigned ea = eo_l[k * 128 + ka] >> 9, eb = eo_l[k * 128 + kb] >> 9;
                    const float ga = p.gates[(size_t)T * 128 + ka], gb = p.gates[(size_t)T * 128 + kb];
                    const float hs = p.hsc[T];
                    const float wa = ga * gelu_tanh(za * (SU[ea] * hs)) * SV[ea], wb = gb * gelu_tanh(zb * (SU[eb] * hs)) * SV[eb];
                    const float wmax = wave_max(fmaxf(fabsf(wa), fabsf(wb)));
                    const float winv = wmax > 0.f ? 127.f / wmax : 0.f;
                    const float qa = rintf(wa * winv), qb = rintf(wb * winv);
                    wq_l[k * 128 + ka] = (unsigned char)(int)qa; wq_l[k * 128 + kb] = (unsigned char)(int)qb;
                    const float qs = wave_sum(qa + qb);
                    if (lane == 0) { tsc_l[k * 2] = wmax * (1.f / 127.f); tsc_l[k * 2 + 1] = 8.f * qs; }
                }
            }
        }
        __builtin_amdgcn_wave_barrier();
#pragma unroll 1
        for (int c = 0; c < 4; ++c) {
#pragma unroll 1
            for (int k = 0; k < GT_TPW; ++k) {
                const int T = Tr + k * stride;
                if (T >= T_TOK) break;
                i32x4 acc[4];
#pragma unroll
                for (int a = 0; a < 4; ++a) acc[a] = (i32x4){0, 0, 0, 0};
#pragma unroll
                for (int hf = 0; hf < 2; ++hf) {
                    u32x4 eo[4];
#pragma unroll
                    for (int q = 0; q < 4; ++q) eo[q] = *(LAS const u32x4*)(eo_l + k * 128 + 32 * vg + 16 * hf + 4 * q);
                    const u32x4 W = *(LAS const u32x4*)(wq_l + k * 128 + 32 * vg + 16 * hf);
                    u32x2 r[16];
#pragma unroll
                    for (int i = 0; i < 16; ++i) r[i] = *(const u32x2*)(V + (eo[i >> 2][i & 3] + (unsigned)(c * 128 + vj * 8)));
#pragma unroll
                    for (int i = 0; i < 16; ++i) {
                        i32x4 B, A;
                        B[0] = (int)(r[i][0] & 0x0F0F0F0Fu); B[1] = (int)((r[i][0] >> 4) & 0x0F0F0F0Fu); B[2] = (int)(r[i][1] & 0x0F0F0F0Fu); B[3] = (int)((r[i][1] >> 4) & 0x0F0F0F0Fu);
                        const unsigned sw = __builtin_amdgcn_perm(0u, W[i >> 2], selb[i & 3]);
#pragma unroll
                        for (int d = 0; d < 4; ++d) A[d] = ((vj >> 2) == d) ? (int)sw : 0;
                        acc[i & 3] = __builtin_amdgcn_mfma_i32_16x16x64_i8(A, B, acc[i & 3], 0, 0, 0);
                    }
                }
                const i32x4 tot = (acc[0] + acc[1]) + (acc[2] + acc[3]);
                const float sc = tsc_l[k * 2], c8 = tsc_l[k * 2 + 1];
                *(uint2*)(p.mix + (size_t)T * 1024 + c * 256 + vj * 16 + vg * 4) = make_uint2(pack_bf16(((float)tot[0] - c8) * sc, ((float)tot[1] - c8) * sc), pack_bf16(((float)tot[2] - c8) * sc, ((float)tot[3] - c8) * sc));
            }
        }
        __builtin_amdgcn_wave_barrier();
    }
    asm volatile("s_waitcnt vmcnt(0)" ::: "memory");
#pragma unroll 1
    for (int T = Tfirst; T < T_TOK; T += stride) {
        const TokInfo ti = tokinfo(T);
        const int cb = lane * 16;
        float o16[16];
        { const uint4* op = (const uint4*)(p.mix + (size_t)T * 1024 + cb); float t8[8]; unpack8(op[0], t8);
#pragma unroll
          for (int j = 0; j < 8; ++j) o16[j] = t8[j];
          unpack8(op[1], t8);
#pragma unroll
          for (int j = 0; j < 8; ++j) o16[8 + j] = t8[j]; }
        bf16_t* xr = p.xres + (size_t)T * 1024 + cb;
        const float* gt = modv(p, l, ti.mi, 5) + cb;
        float xn[16]; float ss = 0.f;
        { const uint4* xp = (const uint4*)xr; float t8[8]; unpack8(xp[0], t8);
#pragma unroll
          for (int j = 0; j < 8; ++j) xn[j] = t8[j] + gt[j] * o16[j];
          unpack8(xp[1], t8);
#pragma unroll
          for (int j = 0; j < 8; ++j) xn[8 + j] = t8[j] + gt[8 + j] * o16[8 + j]; }
#pragma unroll
        for (int j = 0; j < 16; ++j) ss += xn[j] * xn[j];
        ss = wave_sum(ss);
        const float rstd = rsqrtf(ss * (1.f / 1024.f) + 1e-6f);
        if (l == 0) {
#pragma unroll
            for (int j = 0; j < 1; ++j) { uint4* xw = (uint4*)xr;
                xw[0] = make_uint4(pack_bf16(xn[0], xn[1]), pack_bf16(xn[2], xn[3]), pack_bf16(xn[4], xn[5]), pack_bf16(xn[6], xn[7]));
                xw[1] = make_uint4(pack_bf16(xn[8], xn[9]), pack_bf16(xn[10], xn[11]), pack_bf16(xn[12], xn[13]), pack_bf16(xn[14], xn[15])); }
            const float* sh = modv(p, 1, ti.mi, 0) + cb; const float* sc = modv(p, 1, ti.mi, 1) + cb; const float* gg = p.g_mix[1] + cb;
            unsigned w[8];
#pragma unroll
            for (int j = 0; j < 8; ++j) w[j] = pack_bf16(xn[2 * j] * rstd * gg[2 * j] * (1.f + sc[2 * j]) + sh[2 * j], xn[2 * j + 1] * rstd * gg[2 * j + 1] * (1.f + sc[2 * j + 1]) + sh[2 * j + 1]);
            uint4* dd = (uint4*)(p.h3 + (size_t)T * 1024 + cb);
            dd[0] = make_uint4(w[0], w[1], w[2], w[3]); dd[1] = make_uint4(w[4], w[5], w[6], w[7]);
        } else {
            const float* gg = p.g_final + cb;
            float* y = p.out + (size_t)T * 1024 + cb;
#pragma unroll
            for (int j = 0; j < 4; ++j) *(float4*)(y + 4 * j) = make_float4(xn[4 * j] * rstd * gg[4 * j], xn[4 * j + 1] * rstd * gg[4 * j + 1], xn[4 * j + 2] * rstd * gg[4 * j + 2], xn[4 * j + 3] * rstd * gg[4 * j + 3]);
        }
    }
}

__device__ void st_gemm_pool(const Params& p) {
    struct OrderPool {
        const char* A; const char* B;
        __device__ __forceinline__ bool next(int i, pg8::Unit& u) const {
            const int item = blockIdx.x + i * gridDim.x; if (item >= 80 * 4) return false;
            const int lt = item >> 3; u.pn = lt & 3; u.pm = (lt >> 2) * 8 + (item & 7);
            u.A = A + (size_t)u.pm * 256 * 1024 * 2 + (size_t)u.pn * 256 * 2; u.B = B + (size_t)u.pn * 256 * 256 * 2; return true;
        }
    } S; S.A = (const char*)p.h3; S.B = (const char*)p.wt_pool;
    EpiStoreBf16 E; E.O = p.mix; E.ldc = 1024;
    pg8::gemm_phase<EpiStoreBf16, OrderPool, true, true>((LAS unsigned char*)smem, 1024, 256, 256, S, E);
}

__device__ __forceinline__ void run_stage(const Params& p, int s) {
#ifdef ONLY_STAGE
    if (s != ONLY_STAGE) return;
#endif
    switch (s) {
        case 0: st_prologue(p); break;
        case 1: st_norm<0>(p, 0, 0, p.g_mix[0], p.hbuf); break;
        case 2: st_gemm1(p); break;
        case 3: st_postproj(p); break;
        case 4: st_gemm234(p); break;
        case 18: st_gates(p); break;
        case 5: st_attn_s1(p); break;
        case 6: st_scan3(p); break;
        case 7: st_gemm_o(p); break;
        case 8: st_resnorm<1>(p, 0); break;
        case 9: st_gemm_pq(p, 0); break;
        case 11: st_peer_gather(p, 0); break;
        case 13: st_gemm_pool(p); break;
        case 14: st_resnorm<0>(p, 1); break;
        case 15: st_gemm_pq(p, 1); break;
        case 17: st_peer_gather(p, 1); break;
        default: break;
    }
}

__global__ void __launch_bounds__(NTHR, 2) fwd_mega(Params p) {
    cg::grid_group grid = cg::this_grid();
    volatile LAS unsigned* st = (volatile LAS unsigned*)(smem + 131072);
    if (threadIdx.x == 0) { st[0] = 0; st[1] = 0; st[2] = 0; st[3] = 0; }
    wtab_init();
    __syncthreads();
    XcdBarrier b = xcd_barrier_post(p.bar, st);
    if (p.bar == nullptr) grid.sync();
#ifndef REP_MASK
#define REP_MASK 0
#endif
#define MK_ST(k) run_stage(p, k); if ((REP_MASK >> (k)) & 1) { xcd_barrier(b); run_stage(p, k); } if ((k) != 17) xcd_barrier(b);
    MK_ST(0) MK_ST(1) MK_ST(2) MK_ST(3) run_stage(p, 4); MK_ST(18) MK_ST(5) MK_ST(6) MK_ST(7) MK_ST(8) MK_ST(9) MK_ST(11) MK_ST(13) MK_ST(14) MK_ST(15) MK_ST(17)
}

extern "C" void kernel_launch(void* const* d_in, const int* in_sizes, int n_in, void* d_out, int out_size, void* d_ws, size_t ws_size, hipStream_t stream) {
    constexpr size_t kDynLds = 131072 + 512;
    static int grid_blocks = 0;
    if (!grid_blocks) {
        int dev = 0, cus = 0, per_cu = 0;
        (void)hipGetDevice(&dev);
        (void)hipDeviceGetAttribute(&cus, hipDeviceAttributeMultiprocessorCount, dev);
        (void)hipFuncSetAttribute((const void*)fwd_mega, hipFuncAttributeMaxDynamicSharedMemorySize, (int)kDynLds);
        (void)hipOccupancyMaxActiveBlocksPerMultiprocessor(&per_cu, fwd_mega, NTHR, kDynLds);
        if (per_cu > 1) per_cu = 1;
        if (per_cu < 1) per_cu = 1;
        grid_blocks = cus * per_cu;
    }
    Params p{};
    const float* const* in = (const float* const*)d_in;
    p.x_prompt = in[0]; p.x_sample = in[1]; p.cache_ckv = in[2]; p.cache_krope = in[3]; p.state_lru = in[4]; p.c = in[5]; p.c_ctx = in[6];
    p.w_mod[0] = in[7]; p.b_mod[0] = in[8]; p.w_mod[1] = in[9]; p.b_mod[1] = in[10];
    p.g_mix[0] = in[11]; p.g_ffn[0] = in[12]; p.g_mix[1] = in[13]; p.g_ffn[1] = in[14];
    p.w_in = in[15]; p.g_q = in[16]; p.w_uq = in[17]; p.g_kv = in[18]; p.w_ukv = in[19]; p.conv_w = in[20]; p.conv_b = in[21];
    p.w_rg = in[22]; p.b_rg = in[23]; p.w_ig = in[24]; p.b_ig = in[25]; p.lam = in[26]; p.w_o = in[27]; p.w_pool = in[28]; p.s_pool = in[29];
    p.peer_wq[0] = in[30]; p.peer_keys[0] = in[31]; p.peer_u[0] = in[32]; p.peer_v[0] = in[33];
    p.peer_wq[1] = in[34]; p.peer_keys[1] = in[35]; p.peer_u[1] = in[36]; p.peer_v[1] = in[37];
    p.g_final = in[38];
    p.out = (float*)d_out;
    char* base = (char*)d_ws; size_t off = 0;
    auto take = [&](size_t bytes) { char* r = base + off; off += (bytes + 255) & ~(size_t)255; return r; };
    const size_t MiB = 1u << 20;
    p.bar = (unsigned*)take(16384);
    p.mod = (float*)take((size_t)2 * 9 * 6144 * 4);
    p.ropetab = (float*)take(3072 * 4); p.spl = (float*)take(1024 * 4);
    p.wt_in = (bf16_t*)take((size_t)NW_IN * 2); p.wt_uq = (bf16_t*)take((size_t)NW_UQ * 2); p.wt_ukv = (bf16_t*)take((size_t)NW_UKV * 2);
    p.wt_gate = (bf16_t*)take((size_t)NW_GATE * 2); p.wt_o = (bf16_t*)take((size_t)NW_O * 2); p.wt_pool = (bf16_t*)take((size_t)NW_POOL * 2);
    p.wt_pq[0] = (bf16_t*)take((size_t)NW_PQ * 2); p.wt_pq[1] = (bf16_t*)take((size_t)NW_PQ * 2);
    p.keysb[0] = (bf16_t*)take((size_t)NW_KEYS * 2); p.keysb[1] = (bf16_t*)take((size_t)NW_KEYS * 2);
    for (int l = 0; l < 2; ++l) { p.u8[l] = (u8_t*)take(16 * MiB); p.v8[l] = (u8_t*)take(16 * MiB); p.su[l] = (float*)take(65536); p.sv[l] = (float*)take(65536); }
    char* regX = take(80 * MiB);
    char* regQ = take(80 * MiB);
    char* regH = take(40 * MiB);
    p.P = (bf16_t*)regX; p.a = (float*)regX; p.a1m = (bf16_t*)regX; p.xres = (bf16_t*)regX;
    p.bxb = (bf16_t*)regQ; p.q = (bf16_t*)(regQ + 40 * MiB); p.agg = (float*)(regQ + 70 * MiB); p.qp = (bf16_t*)regQ; p.h3 = (bf16_t*)regQ;
    p.hbuf = (bf16_t*)regH;
    p.cqn = (bf16_t*)take((size_t)T_TOK * 384 * 2); p.ckvk = (bf16_t*)take((size_t)R_KEYS * 256 * 2); p.kropek = (bf16_t*)take((size_t)R_KEYS * 64 * 2);
    p.xc = (bf16_t*)take((size_t)T_TOK * 512 * 2); p.ug = (bf16_t*)take((size_t)T_TOK * 512 * 2);
    p.mix = p.xc;
    p.Kn = (bf16_t*)take((size_t)R_KEYS * 512 * 2); p.vT = (bf16_t*)take((size_t)R_KEYS * 512 * 2);
    p.zbuf = (float*)p.vT; p.wbuf = p.zbuf + (size_t)T_TOK * 128;
    p.hqh = (unsigned*)p.cqn; p.hql = (unsigned*)p.ckvk; p.hsc = (float*)p.kropek;
    p.gates = (float*)p.Kn; p.eidx = (int*)((char*)p.Kn + (size_t)T_TOK * 128 * 4);
    if (off > ws_size) fprintf(stderr, "workspace too small: need %zu have %zu\n", off, ws_size);
    (void)hipMemsetAsync(d_ws, 0, 16384, stream);
    void* args[] = {&p};
    hipError_t e = hipLaunchCooperativeKernel((void*)fwd_mega, dim3(grid_blocks), dim3(NTHR), args, kDynLds, stream);
    if (e != hipSuccess) fprintf(stderr, "cooperative launch failed: %s (grid %d)\n", hipGetErrorString(e), grid_blocks);
}
```

```cpp
#include <hip/hip_runtime.h>
#include <hip/hip_cooperative_groups.h>
#include <cstdio>
#include <cstdint>
namespace cg = cooperative_groups;


typedef unsigned short bf16_t;
typedef unsigned char u8_t;
typedef float f32x16 __attribute__((ext_vector_type(16)));
typedef float f32x2 __attribute__((ext_vector_type(2)));
typedef unsigned u32x4 __attribute__((ext_vector_type(4)));
typedef float f32x4v __attribute__((ext_vector_type(4)));

#define T_TOK 20480
#define T_CTX 4096
#define R_KEYS 22528
#define NSTAGE 19
#define NTHR 512
#define NWV 8
#define LAS __attribute__((address_space(3)))

#define XB_TMO      128
#define XB_XCNT(j)  (256  + 64 * (j))
#define XB_XSUB(j)  (1280 + 64 * (j))
#define XB_XGEN(j)  (2304 + 64 * (j))
#define XB_TOP      3328
#define XB_TOPGEN   3392
#define XCD_BAR_WORDS 3456
#define XB_STEAL    3584
#define XB_CLAIM    3840
#define XB_GMASK    8
#define XB_GCNT(g)  (136 + 16 * (g))
#define XB_SPIN_CAP (1u << 22)
__device__ __forceinline__ unsigned xb_ld(unsigned* p)              { return __hip_atomic_load(p, __ATOMIC_RELAXED, __HIP_MEMORY_SCOPE_AGENT); }
__device__ __forceinline__ unsigned xb_add(unsigned* p, unsigned v) { return __hip_atomic_fetch_add(p, v, __ATOMIC_RELAXED, __HIP_MEMORY_SCOPE_AGENT); }
__device__ __forceinline__ unsigned xb_xcc_id() { return (unsigned)__builtin_amdgcn_s_getreg((3 << 11) | 20) & 0xFu; }
#define XB_SPIN(cond, bar) do { unsigned _sp = 0; while (cond) { __builtin_amdgcn_s_sleep(1); \
    if ((++_sp & 255u) == 0u) { if (xb_ld(&(bar)[XB_TMO])) break; if (_sp > XB_SPIN_CAP) { atomicAdd(&(bar)[XB_TMO], 1u); break; } } } } while (0)
struct XcdBarrier { unsigned* bar; unsigned x; volatile LAS unsigned* st; };
__device__ __forceinline__ XcdBarrier xcd_barrier_post(unsigned* bar, volatile LAS unsigned* st) {
    XcdBarrier b; b.bar = bar; b.x = xb_xcc_id(); b.st = st;
    if (threadIdx.x == 0) (void)xb_add(&bar[XB_XCNT(b.x)], 1u);
    return b;
}
__device__ __forceinline__ void xcd_barrier_complete(unsigned* bar, unsigned x, unsigned& nloc, unsigned& nx) {
    const unsigned G = gridDim.x * gridDim.y * gridDim.z;
    unsigned sum, cnt, mine, sp = 0u;
    for (;;) {
        sum = 0u; cnt = 0u; mine = 0u;
#pragma unroll
        for (unsigned j = 0; j < 16; ++j) { const unsigned c = xb_ld(&bar[XB_XCNT(j)]); sum += c; cnt += (c > 0u) ? 1u : 0u; mine = (j == x) ? c : mine; }
        if (sum == G) break;
        __builtin_amdgcn_s_sleep(1);
        if ((++sp & 255u) == 0u) { if (xb_ld(&bar[XB_TMO])) break; if (sp > XB_SPIN_CAP) { atomicAdd(&bar[XB_TMO], 1u); break; } }
    }
    nloc = mine > 0u ? mine : 1u; nx = cnt > 0u ? cnt : 1u;
}
__device__ __forceinline__ int tidx();
__device__ __forceinline__ void xcd_barrier(const XcdBarrier& b) {
    asm volatile("s_waitcnt vmcnt(0)" ::: "memory");
    __syncthreads();
    if (tidx() == 0) {
        unsigned* bar = b.bar;
        __builtin_amdgcn_s_waitcnt(0);
        unsigned nloc = b.st[0], nx = b.st[1];
        if (nloc == 0u) { xcd_barrier_complete(bar, b.x, nloc, nx); b.st[0] = nloc; b.st[1] = nx; }
        const unsigned old = xb_add(&bar[XB_XSUB(b.x)], 1u);
        const unsigned gen = old / nloc;
        if (old + 1u == (gen + 1u) * nloc) {
            __builtin_amdgcn_fence(__ATOMIC_RELEASE, "agent");
            asm volatile("s_waitcnt vmcnt(0)" ::: "memory");
            const unsigned og = xb_add(&bar[XB_TOP], 1u);
            const unsigned tg = og / nx;
            if (og + 1u == (tg + 1u) * nx) xb_add(&bar[XB_TOPGEN], 1u);
            else XB_SPIN(xb_ld(&bar[XB_TOPGEN]) == tg, bar);
            __builtin_amdgcn_fence(__ATOMIC_ACQUIRE, "agent");
            xb_add(&bar[XB_XGEN(b.x)], 1u);
            asm volatile("s_waitcnt vmcnt(0)" ::: "memory");
        } else {
            XB_SPIN(xb_ld(&bar[XB_XGEN(b.x)]) == gen, bar);
            __builtin_amdgcn_fence(__ATOMIC_ACQUIRE, "agent");
            asm volatile("s_waitcnt vmcnt(0)" ::: "memory");
        }
    }
    __syncthreads();
}

__device__ __forceinline__ void grp_barrier(unsigned* bar) {
    asm volatile("s_waitcnt vmcnt(0)" ::: "memory");
    __syncthreads();
    if (tidx() == 0) {
        unsigned* c = &bar[XB_GCNT(blockIdx.x & 7)];
        const unsigned old = xb_add(c, 1u), tgt = (old / 32u + 1u) * 32u;
        XB_SPIN(xb_ld(c) < tgt, bar);
        __builtin_amdgcn_fence(__ATOMIC_ACQUIRE, "agent");
        asm volatile("s_waitcnt vmcnt(0)" ::: "memory");
    }
    __syncthreads();
}
#define FAST_GROUPS() (__builtin_amdgcn_readfirstlane((int)((volatile LAS unsigned*)(smem + 131072))[2]) != 0)

struct Params {
    const float *x_prompt, *x_sample, *cache_ckv, *cache_krope, *state_lru, *c, *c_ctx;
    const float *w_mod[2], *b_mod[2], *g_mix[2], *g_ffn[2];
    const float *w_in, *g_q, *w_uq, *g_kv, *w_ukv, *conv_w, *conv_b, *w_rg, *b_rg, *w_ig, *b_ig, *lam, *w_o, *w_pool, *s_pool;
    const float *peer_wq[2], *peer_keys[2], *peer_u[2], *peer_v[2];
    const float* g_final;
    float* out;
    unsigned* bar; float* mod; bf16_t* modb; float* ropetab;
    bf16_t *wt_in, *wt_uq, *wt_ukv, *wt_gate, *wt_o, *wt_pool, *wt_pq[2], *keysb[2];
    u8_t *u8[2], *v8[2]; float *su[2], *sv[2];
    bf16_t *hbuf, *P, *cqn, *ckvk, *kropek, *xc, *ug, *q, *Kn, *vT, *bxb, *qp, *h3;
    float *a, *agg, *gates; int* eidx; bf16_t* xres;
    bf16_t* mix; float *zbuf, *wbuf; unsigned *hqh, *hql; float* hsc; float* spl; bf16_t* a1m; unsigned* abx;
};

extern __shared__ __attribute__((aligned(16))) unsigned char smem[];
#define WTAB_OFF (131072 + 64)
#define TKTAB_OFF (131072 + 512)
__device__ __forceinline__ int hw_wave_slot() { return (int)(__builtin_amdgcn_s_getreg(0x2804) & 63u); }
__device__ __forceinline__ void wtab_init() { if ((threadIdx.x & 63) == 0) ((volatile LAS int*)(smem + WTAB_OFF))[hw_wave_slot()] = (int)(threadIdx.x >> 6); }
__device__ __forceinline__ int tidx() {
    const int w = __builtin_amdgcn_readfirstlane(((volatile LAS int*)(smem + WTAB_OFF))[hw_wave_slot()]);
    return (w << 6) | (int)__builtin_amdgcn_mbcnt_hi(~0u, __builtin_amdgcn_mbcnt_lo(~0u, 0u));
}
__device__ __forceinline__ float bf2f(bf16_t v) { return __uint_as_float(((unsigned)v) << 16); }
typedef __bf16 bf16x2_t __attribute__((ext_vector_type(2)));
__device__ __forceinline__ bf16_t f2bf(float f) { return __builtin_bit_cast(unsigned short, (__bf16)f); }
__device__ __forceinline__ unsigned pack_bf16(float a, float b) { bf16x2_t v = {(__bf16)a, (__bf16)b}; return __builtin_bit_cast(unsigned, v); }
typedef unsigned u32x2 __attribute__((ext_vector_type(2)));
typedef int i32x4 __attribute__((ext_vector_type(4)));
#define DPP_F(v, ctrl) __int_as_float(__builtin_amdgcn_update_dpp(0, __float_as_int(v), ctrl, 0xf, 0xf, true))
__device__ __forceinline__ float wave_sum(float v) {
    v += DPP_F(v, 0xB1); v += DPP_F(v, 0x4E); v += DPP_F(v, 0x141); v += DPP_F(v, 0x128);
    u32x2 r = __builtin_amdgcn_permlane16_swap(__float_as_uint(v), __float_as_uint(v), false, false);
    v = __uint_as_float(r[0]) + __uint_as_float(r[1]);
    r = __builtin_amdgcn_permlane32_swap(__float_as_uint(v), __float_as_uint(v), false, false);
    return __uint_as_float(r[0]) + __uint_as_float(r[1]);
}
__device__ __forceinline__ float wave_max(float v) {
    v = fmaxf(v, DPP_F(v, 0xB1)); v = fmaxf(v, DPP_F(v, 0x4E)); v = fmaxf(v, DPP_F(v, 0x141)); v = fmaxf(v, DPP_F(v, 0x128));
    u32x2 r = __builtin_amdgcn_permlane16_swap(__float_as_uint(v), __float_as_uint(v), false, false);
    v = fmaxf(__uint_as_float(r[0]), __uint_as_float(r[1]));
    r = __builtin_amdgcn_permlane32_swap(__float_as_uint(v), __float_as_uint(v), false, false);
    return fmaxf(__uint_as_float(r[0]), __uint_as_float(r[1]));
}
__device__ __forceinline__ float gelu_tanh(float x) {
    const float u = 0.7978845608028654f * (x + 0.044715f * x * x * x);
    const float e = __expf(2.f * u);
    const float th = 1.f - 2.f / (e + 1.f);
    return 0.5f * x * (1.f + th);
}
__device__ __forceinline__ float sigmoidf_(float x) { return 1.f / (1.f + __expf(-x)); }
__device__ __forceinline__ float silu_(float x) { return x / (1.f + __expf(-x)); }

struct TokInfo { int smp, b, s, S, mi, keyrow; };
__device__ __forceinline__ TokInfo tokinfo(int T) {
    TokInfo t;
    if (T < T_CTX) { t.smp = 0; t.b = T >> 8; t.s = T & 255; t.S = 256; t.mi = 0; t.keyrow = T; }
    else { const int u = T - T_CTX; t.smp = 1; t.b = u >> 11; t.s = u & 2047; t.S = 2048; t.mi = 1 + t.b; t.keyrow = T_CTX + t.b * 2304 + 256 + t.s; }
    return t;
}
__device__ __forceinline__ const float* x_in_row(const Params& p, int T) { return T < T_CTX ? p.x_prompt + (size_t)T * 1024 : p.x_sample + (size_t)(T - T_CTX) * 1024; }
__device__ __forceinline__ const float* modv(const Params& p, int l, int mi, int j) { return p.mod + ((size_t)(l * 9 + mi) * 6 + j) * 1024; }
__device__ __forceinline__ const bf16_t* modvb(const Params& p, int l, int mi, int j) { return p.modb + ((size_t)(l * 9 + mi) * 6 + j) * 1024; }

__device__ __forceinline__ void unpack8(const uint4 r, float (&f)[8]) {
    f[0] = __uint_as_float(r.x << 16); f[1] = __uint_as_float(r.x & 0xffff0000u);
    f[2] = __uint_as_float(r.y << 16); f[3] = __uint_as_float(r.y & 0xffff0000u);
    f[4] = __uint_as_float(r.z << 16); f[5] = __uint_as_float(r.z & 0xffff0000u);
    f[6] = __uint_as_float(r.w << 16); f[7] = __uint_as_float(r.w & 0xffff0000u);
}

namespace pg8 {
typedef short bf16x8 __attribute__((ext_vector_type(8)));
typedef float f32x4 __attribute__((ext_vector_type(4)));
constexpr int BM = 256, BK = 64, HALF = 128, HTB = HALF * BK * 2  , STAGE_BYTES = 8 * HTB;
__device__ __forceinline__ int lds_byte(int r, int c) { const int st = (r >> 4) * 2 + (c >> 5), rr = r & 15, cc = c & 31, ob = rr * 64 + cc * 2; return st * 1024 + (ob ^ (((ob >> 9) & 1) << 5)); }
__device__ __forceinline__ void stage_rc(int b, int& R, int& C) { const int st = b / 1024, sb = b % 1024, swz = sb ^ (((sb >> 9) & 1) << 5); R = (st >> 1) * 16 + swz / 64; C = (st & 1) * 32 + (swz % 64) / 2; }
__device__ __forceinline__ int perm32(int rho) { const int n = rho >> 4, i = rho & 15; return 8 * (i >> 2) + 4 * n + (i & 3); }
struct Unit { int pm, pn; const char* A; const char* B; };
template <class Epi, class Sched, bool ALIGN_EPI, bool SP2>
__device__ __forceinline__ void gemm_phase(LAS unsigned char* lds, const int lda, const int ldb, const int K, const Sched& S, const Epi& E) {
    __builtin_amdgcn_sched_barrier(0);
    int tid = tidx(); asm volatile("" : "+v"(tid));
    const int wid = __builtin_amdgcn_readfirstlane(tid >> 6), lane = tid & 63, wr = wid >> 2, wc = wid & 3, fr = lane & 15, fq = lane >> 4;
    const int nt = K / BK;
    unsigned voffA[2], voffB[2];
#pragma unroll
    for (int i = 0; i < 2; ++i) { int R, C; stage_rc(tid * 16 + i * 8192, R, C); const int Rb = Epi::PERM ? ((R & ~31) + perm32(R & 31)) : R;
        voffA[i] = (unsigned)(R * lda + C) * 2u; voffB[i] = (unsigned)(Rb * ldb + C) * 2u; }
    const size_t kstep = (size_t)(BK * 2);
    const size_t hstepA = (size_t)HALF * lda * 2, hstepB = (size_t)HALF * ldb * 2;
    const unsigned ldsw = (unsigned)wid * 1024u;
    const int aoff = lds_byte(wr * 64 + fr, fq * 8), boff = lds_byte(wc * 32 + fr, fq * 8);
#define PG8_SA(b, h) (((b) * 2 + (h)) * HTB)
#define PG8_SB(b, h) ((4 + (b) * 2 + (h)) * HTB)
#define PG8_STAGE(bufoff, gbase, voff) do { _Pragma("unroll") for (int _i = 0; _i < 2; ++_i) \
        __builtin_amdgcn_global_load_lds((const unsigned*)((const char*)(gbase) + (voff)[_i]), (LAS unsigned*)(lds + (bufoff) + ldsw + _i * 8192), 16, 0, 0); } while (0)
#define PG8_LDA(dst, b, h) do { _Pragma("unroll") for (int m = 0; m < 4; ++m) _Pragma("unroll") for (int k = 0; k < 2; ++k) dst[m][k] = *(const LAS bf16x8*)(lds + PG8_SA(b, h) + aoff + m * 2048 + k * 1024); } while (0)
#define PG8_LDB(dst, b, h) do { _Pragma("unroll") for (int n = 0; n < 2; ++n) _Pragma("unroll") for (int k = 0; k < 2; ++k) dst[n][k] = *(const LAS bf16x8*)(lds + PG8_SB(b, h) + boff + n * 2048 + k * 1024); } while (0)
#define PG8_MMA(ai, bj, At, Bt) do { __builtin_amdgcn_s_setprio(1); _Pragma("unroll") for (int m = 0; m < 4; ++m) _Pragma("unroll") for (int n = 0; n < 2; ++n) _Pragma("unroll") for (int k = 0; k < 2; ++k) \
        acc[ai][bj][m][n] = __builtin_amdgcn_mfma_f32_16x16x32_bf16(Bt[n][k], At[m][k], acc[ai][bj][m][n], 0, 0, 0); __builtin_amdgcn_s_setprio(0); } while (0)
#define PG8_WAIT_V(n) asm volatile("s_waitcnt vmcnt(" #n ")" ::: "memory")
#define PG8_WAIT_L(n) asm volatile("s_waitcnt lgkmcnt(" #n ")" ::: "memory")
#define PG8_BAR __builtin_amdgcn_s_barrier()
#define PG8_SCHED __builtin_amdgcn_sched_barrier(0)
    Unit cur, nxt; int ui = 0;
    if (!S.next(0, cur)) return;
    f32x4 acc[2][2][4][2];
#pragma unroll
    for (int a = 0; a < 2; ++a)
#pragma unroll
        for (int b = 0; b < 2; ++b)
#pragma unroll
            for (int m = 0; m < 4; ++m)
#pragma unroll
                for (int n = 0; n < 2; ++n) acc[a][b][m][n] = (f32x4){0.f, 0.f, 0.f, 0.f};
    bf16x8 At[4][2], B0[2][2], B1[2][2];
    const char* cA = cur.A; const char* cB = cur.B;
    if constexpr (SP2) {
        PG8_STAGE(PG8_SB(0, 0), cB, voffB); PG8_STAGE(PG8_SB(0, 1), cB + hstepB, voffB); PG8_STAGE(PG8_SA(0, 0), cA, voffA); PG8_STAGE(PG8_SA(0, 1), cA + hstepA, voffA);
        if (wr == 1) PG8_BAR;
        PG8_WAIT_V(2); PG8_BAR;
        PG8_STAGE(PG8_SB(1, 0), cB + kstep, voffB); PG8_STAGE(PG8_SA(1, 0), cA + kstep, voffA); PG8_STAGE(PG8_SB(1, 1), cB + hstepB + kstep, voffB);
        PG8_WAIT_V(6); PG8_BAR;
    } else {
        PG8_STAGE(PG8_SB(0, 0), cB, voffB); PG8_STAGE(PG8_SA(0, 0), cA, voffA); PG8_STAGE(PG8_SB(0, 1), cB + hstepB, voffB); PG8_STAGE(PG8_SA(0, 1), cA + hstepA, voffA);
        if (wr == 1) PG8_BAR;
        PG8_WAIT_V(4); PG8_BAR;
        PG8_STAGE(PG8_SB(1, 0), cB + kstep, voffB); PG8_STAGE(PG8_SA(1, 0), cA + kstep, voffA); PG8_STAGE(PG8_SB(1, 1), cB + hstepB + kstep, voffB);
        PG8_WAIT_V(6); PG8_BAR;
    }
    for (;;) {
        const bool has_next = S.next(ui + 1, nxt);
        const char* nA = has_next ? nxt.A : cA; const char* nB = has_next ? nxt.B : cB;
#pragma unroll 1
        for (int t = 0; t < nt; t += 2) {
            const bool last = (t == nt - 2);
            const char* a1 = cA + (size_t)(t + 1) * kstep;
            const char* a2 = last ? nA : cA + (size_t)(t + 2) * kstep; const char* b2 = last ? nB : cB + (size_t)(t + 2) * kstep;
            const char* a3 = a2 + kstep; const char* b3 = b2 + kstep;
            if constexpr (SP2) {
            PG8_LDB(B0, 0, 0); PG8_LDB(B1, 0, 1); PG8_SCHED; PG8_LDA(At, 0, 0); PG8_STAGE(PG8_SA(1, 1), a1 + hstepA, voffA);
            PG8_WAIT_V(8); PG8_WAIT_L(0); PG8_BAR; PG8_MMA(0, 0, At, B0); PG8_MMA(0, 1, At, B1); PG8_BAR; PG8_SCHED;
            PG8_LDA(At, 0, 1); PG8_STAGE(PG8_SB(0, 0), b2, voffB); PG8_STAGE(PG8_SB(0, 1), b2 + hstepB, voffB); PG8_STAGE(PG8_SA(0, 0), a2, voffA);
            PG8_WAIT_V(8); PG8_WAIT_L(0); PG8_BAR; PG8_MMA(1, 0, At, B0); PG8_MMA(1, 1, At, B1); PG8_BAR; PG8_SCHED;
            PG8_LDB(B0, 1, 0); PG8_LDB(B1, 1, 1); PG8_SCHED; PG8_LDA(At, 1, 0); PG8_STAGE(PG8_SA(0, 1), a2 + hstepA, voffA);
            PG8_WAIT_V(8); PG8_WAIT_L(0); PG8_BAR; PG8_MMA(0, 0, At, B0); PG8_MMA(0, 1, At, B1); PG8_BAR; PG8_SCHED;
            PG8_LDA(At, 1, 1); PG8_STAGE(PG8_SB(1, 0), b3, voffB); PG8_STAGE(PG8_SB(1, 1), b3 + hstepB, voffB); PG8_STAGE(PG8_SA(1, 0), a3, voffA);
            PG8_WAIT_V(8); PG8_WAIT_L(0); PG8_BAR; PG8_MMA(1, 0, At, B0); PG8_MMA(1, 1, At, B1); PG8_BAR; PG8_SCHED;
            } else {
            PG8_LDB(B0, 0, 0); PG8_SCHED; PG8_LDA(At, 0, 0); PG8_STAGE(PG8_SA(1, 1), a1 + hstepA, voffA);
            PG8_WAIT_L(8); PG8_BAR; PG8_WAIT_L(0); PG8_MMA(0, 0, At, B0); PG8_BAR; PG8_SCHED;
            PG8_LDB(B1, 0, 1); PG8_STAGE(PG8_SB(0, 0), b2, voffB);
            PG8_BAR; PG8_WAIT_L(0); PG8_MMA(0, 1, At, B1); PG8_BAR;
            PG8_LDA(At, 0, 1); PG8_STAGE(PG8_SA(0, 0), a2, voffA);
            PG8_BAR; PG8_WAIT_L(0); PG8_MMA(1, 0, At, B0); PG8_BAR; PG8_SCHED;
            PG8_STAGE(PG8_SB(0, 1), b2 + hstepB, voffB);
            PG8_WAIT_V(6); PG8_BAR; PG8_MMA(1, 1, At, B1); PG8_BAR;
            PG8_LDB(B0, 1, 0); PG8_SCHED; PG8_LDA(At, 1, 0); PG8_STAGE(PG8_SA(0, 1), a2 + hstepA, voffA);
            PG8_WAIT_L(8); PG8_BAR; PG8_WAIT_L(0); PG8_MMA(0, 0, At, B0); PG8_BAR; PG8_SCHED;
            PG8_LDB(B1, 1, 1); PG8_STAGE(PG8_SB(1, 0), b3, voffB);
            PG8_BAR; PG8_WAIT_L(0); PG8_MMA(0, 1, At, B1); PG8_BAR;
            PG8_LDA(At, 1, 1); PG8_STAGE(PG8_SA(1, 0), a3, voffA);
            PG8_BAR; PG8_WAIT_L(0); PG8_MMA(1, 0, At, B0); PG8_BAR; PG8_SCHED;
            PG8_STAGE(PG8_SB(1, 1), b3 + hstepB, voffB);
            PG8_WAIT_V(6); PG8_BAR; PG8_MMA(1, 1, At, B1); PG8_BAR;
            }
        }
        if constexpr (ALIGN_EPI) { if (wr == 0) PG8_BAR; }
        E(acc, cur, wr, wc, fr, fq);
        if (!has_next) break;
#pragma unroll
        for (int a = 0; a < 2; ++a)
#pragma unroll
            for (int b = 0; b < 2; ++b)
#pragma unroll
                for (int m = 0; m < 4; ++m)
#pragma unroll
                    for (int n = 0; n < 2; ++n) acc[a][b][m][n] = (f32x4){0.f, 0.f, 0.f, 0.f};
        cur = nxt; cA = nA; cB = nB; ++ui;
        if constexpr (ALIGN_EPI) { if (wr == 1) PG8_BAR; }
    }
    PG8_WAIT_V(0);
    if constexpr (!ALIGN_EPI) { if (wr == 0) PG8_BAR; }
    PG8_BAR;
    __builtin_amdgcn_sched_barrier(0);
#undef PG8_SA
#undef PG8_SB
#undef PG8_STAGE
#undef PG8_LDA
#undef PG8_LDB
#undef PG8_MMA
#undef PG8_WAIT_V
#undef PG8_WAIT_L
#undef PG8_BAR
#undef PG8_SCHED
}
struct TileOrder {
    int nN, total; const char* A; const char* B; size_t tA, tB;
    __device__ __forceinline__ bool next(int i, Unit& u) const {
        const int item = blockIdx.x + i * gridDim.x; if (item >= total) return false;
        const int lt = item >> 3; u.pn = lt % nN; u.pm = (lt / nN) * 8 + (item & 7);
        u.A = A + (size_t)u.pm * tA; u.B = B + (size_t)u.pn * tB; return true;
    }
};
}

typedef __bf16 bf16x8_t __attribute__((ext_vector_type(8)));
__device__ __forceinline__ int lds_off(int row, int chunk) { return row * 128 + ((chunk ^ ((row >> 1) & 7)) << 4); }
template <int TM, int TN, int WM, int WN>
__device__ __forceinline__ void gemm_acc(const bf16_t* __restrict__ As, int lda, const bf16_t* __restrict__ Bs, int ldb, int K, f32x16 (&acc)[TM][TN]) {
    static_assert(TM * WM == 4 && TN * WN == 4 && WM * WN == 4, "tile is 128 x 128, 4 waves");
    const int tid = tidx() & 255, lane = tid & 63, wid = tid >> 6, wm = wid / WN, wn = wid % WN, hl = lane >> 5, cl = lane & 31;
    unsigned char* sm = smem + (tidx() >> 8) * 65536;
#pragma unroll
    for (int i = 0; i < TM; ++i)
#pragma unroll
        for (int j = 0; j < TN; ++j)
#pragma unroll
            for (int r = 0; r < 16; ++r) acc[i][j][r] = 0.f;
    const int srow0 = wid * 32 + (lane >> 3), pc = lane & 7;
    const bf16_t* ga[4]; const bf16_t* gb[4];
#pragma unroll
    for (int i = 0; i < 4; ++i) {
        const int row = srow0 + 8 * i, lc = pc ^ ((row >> 1) & 7);
        ga[i] = As + (size_t)row * lda + lc * 8; gb[i] = Bs + (size_t)row * ldb + lc * 8;
    }
    unsigned char* lbase = sm + wid * 4096 + lane * 16;
    __syncthreads();
#pragma unroll
    for (int i = 0; i < 4; ++i) {
        __builtin_amdgcn_global_load_lds((const unsigned*)ga[i], (unsigned*)(lbase + i * 1024), 16, 0, 0);
        __builtin_amdgcn_global_load_lds((const unsigned*)gb[i], (unsigned*)(lbase + 16384 + i * 1024), 16, 0, 0);
    }
    asm volatile("s_waitcnt vmcnt(0)" ::: "memory");
    __syncthreads();
    const int nk = K >> 6;
    for (int kt = 0; kt < nk; ++kt) {
        const int cur = (kt & 1) * 32768, nxt = 32768 - cur;
        if (kt + 1 < nk) {
#pragma unroll
            for (int i = 0; i < 4; ++i) {
                __builtin_amdgcn_global_load_lds((const unsigned*)(ga[i] + (kt + 1) * 64), (unsigned*)(lbase + nxt + i * 1024), 16, 0, 0);
                __builtin_amdgcn_global_load_lds((const unsigned*)(gb[i] + (kt + 1) * 64), (unsigned*)(lbase + nxt + 16384 + i * 1024), 16, 0, 0);
            }
        }
#pragma unroll
        for (int ks = 0; ks < 4; ++ks) {
            bf16x8_t af[TM], bfr[TN];
#pragma unroll
            for (int i = 0; i < TM; ++i) af[i] = __builtin_bit_cast(bf16x8_t, *(const u32x4*)(sm + cur + lds_off(32 * (TM * wm + i) + cl, 2 * ks + hl)));
#pragma unroll
            for (int j = 0; j < TN; ++j) bfr[j] = __builtin_bit_cast(bf16x8_t, *(const u32x4*)(sm + cur + 16384 + lds_off(32 * (TN * wn + j) + cl, 2 * ks + hl)));
#pragma unroll
            for (int i = 0; i < TM; ++i)
#pragma unroll
                for (int j = 0; j < TN; ++j) acc[i][j] = __builtin_amdgcn_mfma_f32_32x32x16_bf16(af[i], bfr[j], acc[i][j], 0, 0, 0);
        }
        asm volatile("s_waitcnt vmcnt(0)" ::: "memory");
        __syncthreads();
    }
}
template <int TM, int TN, int WM, int WN>
__device__ __forceinline__ void gemm128_issue(const bf16_t* __restrict__ As, int lda, const bf16_t* __restrict__ Bs, int ldb) {
    const int tid = tidx() & 255, lane = tid & 63, wid = tid >> 6;
    unsigned char* sm = smem + (tidx() >> 8) * 65536;
    const int srow0 = wid * 32 + (lane >> 3), pc = lane & 7;
    unsigned char* lbase = sm + wid * 4096 + lane * 16;
#pragma unroll
    for (int i = 0; i < 4; ++i) {
        const int row = srow0 + 8 * i, lc = pc ^ ((row >> 1) & 7);
        const bf16_t* ga = As + (size_t)row * lda + lc * 8; const bf16_t* gb = Bs + (size_t)row * ldb + lc * 8;
#pragma unroll
        for (int kt = 0; kt < 2; ++kt) {
            __builtin_amdgcn_global_load_lds((const unsigned*)(ga + kt * 64), (unsigned*)(lbase + kt * 32768 + i * 1024), 16, 0, 0);
            __builtin_amdgcn_global_load_lds((const unsigned*)(gb + kt * 64), (unsigned*)(lbase + kt * 32768 + 16384 + i * 1024), 16, 0, 0);
        }
    }
}
template <int TM, int TN, int WM, int WN>
__device__ __forceinline__ void gemm128_compute(f32x16 (&acc)[TM][TN]) {
    static_assert(TM * WM == 4 && TN * WN == 4 && WM * WN == 4, "tile is 128 x 128, 4 waves");
    const int tid = tidx() & 255, lane = tid & 63, wid = tid >> 6, wm = wid / WN, wn = wid % WN, hl = lane >> 5, cl = lane & 31;
    unsigned char* sm = smem + (tidx() >> 8) * 65536;
#pragma unroll
    for (int i = 0; i < TM; ++i)
#pragma unroll
        for (int j = 0; j < TN; ++j)
#pragma unroll
            for (int r = 0; r < 16; ++r) acc[i][j][r] = 0.f;
    asm volatile("s_waitcnt vmcnt(0)" ::: "memory");
    __syncthreads();
#pragma unroll
    for (int kt = 0; kt < 2; ++kt)
#pragma unroll
        for (int ks = 0; ks < 4; ++ks) {
            bf16x8_t af[TM], bfr[TN];
#pragma unroll
            for (int i = 0; i < TM; ++i) af[i] = __builtin_bit_cast(bf16x8_t, *(const u32x4*)(sm + kt * 32768 + lds_off(32 * (TM * wm + i) + cl, 2 * ks + hl)));
#pragma unroll
            for (int j = 0; j < TN; ++j) bfr[j] = __builtin_bit_cast(bf16x8_t, *(const u32x4*)(sm + kt * 32768 + 16384 + lds_off(32 * (TN * wn + j) + cl, 2 * ks + hl)));
#pragma unroll
            for (int i = 0; i < TM; ++i)
#pragma unroll
                for (int j = 0; j < TN; ++j) acc[i][j] = __builtin_amdgcn_mfma_f32_32x32x16_bf16(af[i], bfr[j], acc[i][j], 0, 0, 0);
        }
    __syncthreads();
}
#define ACC_ROW(TMv, wm, i, r, hl) (32 * ((TMv) * (wm) + (i)) + ((r) & 3) + 8 * ((r) >> 2) + 4 * (hl))
#define ACC_COL(TNv, wn, j, cl)    (32 * ((TNv) * (wn) + (j)) + (cl))

#define N_ADA 384
#define NW_IN   (1792 * 1024)
#define NW_UQ   (768 * 384)
#define NW_UKV  (1024 * 256)
#define NW_GATE (4 * 512 * 128)
#define NW_O    (1024 * 1024)
#define NW_POOL (4 * 256 * 256)
#define NW_PQ   (2048 * 1024)
#define NW_KEYS (16 * 128 * 128)
#define NW_CKV  (8 * 256 * 256)
#define NW_CKR  (8 * 256 * 64)
#define NW_ROPE 3072
#define NW_SP 1024
#define NT_IN 448
#define NT_UQ 72
#define NT_UKV 64
#define NT_O 256
#define NT_POOL 64
#define NT_PQ 512
#define N_TR (NT_IN + NT_UQ + NT_UKV + NT_O + NT_POOL + 2 * NT_PQ)
#define NE_TOTAL (NW_GATE + 2 * NW_KEYS + NW_CKV + NW_CKR + NW_ROPE + NW_SP)
#define N_CONV_ITEMS ((NE_TOTAL + 4095) / 4096)
#define N_FP8_ITEMS (65536 / NWV / 4)

__device__ __forceinline__ void conv_elem(const Params& p, int e) {
    if (e < NW_GATE) {
        const int c = e & 127, cg = (e >> 7) & 511, nb = e >> 16;
        const int dir = cg >> 8, dg = (cg >> 6) & 3, ri = (cg >> 5) & 1, d = dg * 32 + (cg & 31);
        const float* src = ri ? p.w_ig : p.w_rg;
        p.wt_gate[e] = f2bf(src[(((size_t)dir * 4 + nb) * 128 + c) * 128 + d]); return; } e -= NW_GATE;
#pragma unroll
    for (int l = 0; l < 2; ++l) { if (e < NW_KEYS) { p.keysb[l][e] = f2bf(p.peer_keys[l][e]); return; } e -= NW_KEYS; }
    if (e < NW_CKV) { const int col = e & 255, j = (e >> 8) & 255, b = e >> 16; p.ckvk[(size_t)(T_CTX + b * 2304 + j) * 256 + col] = f2bf(p.cache_ckv[e]); return; } e -= NW_CKV;
    if (e < NW_CKR) { const int col = e & 63, j = (e >> 6) & 255, b = e >> 14; p.kropek[(size_t)(T_CTX + b * 2304 + j) * 64 + col] = f2bf(p.cache_krope[e]); return; } e -= NW_CKR;
    if (e < NW_ROPE) {
        int idx = e, isrow = e < 1024; if (!isrow) idx -= 1024;
        const int half = isrow ? 512 : 1024; const int sn = idx >= half; if (sn) idx -= half;
        const int pos = idx >> 4, fi = idx & 15;
        const float invf = exp2f(-(float)fi * (13.287712379549449f / 16.f));
        const float ang = (float)pos * invf;
        p.ropetab[e] = sn ? sinf(ang) : cosf(ang); return; } e -= NW_ROPE;
    if (e < NW_SP) { const float nl = -p.lam[e]; p.spl[e] = fmaxf(nl, 0.f) + log1pf(__expf(-fabsf(nl))); return; }
}
__device__ __forceinline__ void tr_tile(const float* __restrict__ src, int ldsrc, int nvalid, bf16_t* __restrict__ dst, int lddst, int k0, int n0, float scl = 1.f) {
    float* tile = (float*)(smem + (tidx() >> 8) * 32768);
    const int tid = tidx() & 255;
    __syncthreads();
#pragma unroll
    for (int i = 0; i < 4; ++i) {
        const int k = (tid >> 4) + 16 * i, n = (tid & 15) * 4;
        float4 v = make_float4(0.f, 0.f, 0.f, 0.f);
        if (n0 + n < nvalid) v = *(const float4*)(src + (size_t)(k0 + k) * ldsrc + n0 + n);
        tile[k * 65 + n] = v.x; tile[k * 65 + n + 1] = v.y; tile[k * 65 + n + 2] = v.z; tile[k * 65 + n + 3] = v.w;
    }
    __syncthreads();
    const int n = tid >> 2, kq = (tid & 3) * 16;
    unsigned w[8];
#pragma unroll
    for (int j = 0; j < 8; ++j) w[j] = pack_bf16(tile[(kq + 2 * j) * 65 + n] * scl, tile[(kq + 2 * j + 1) * 65 + n] * scl);
    uint4* d = (uint4*)(dst + (size_t)(n0 + n) * lddst + k0 + kq);
    d[0] = make_uint4(w[0], w[1], w[2], w[3]); d[1] = make_uint4(w[4], w[5], w[6], w[7]);
}
__device__ __forceinline__ void tr_item(const Params& p, int t) {
    if (t < NT_IN) { tr_tile(p.w_in, 1728, 1728, p.wt_in, 1024, (t % 16) * 64, (t / 16) * 64); return; } t -= NT_IN;
    if (t < NT_UQ) { tr_tile(p.w_uq, 768, 768, p.wt_uq, 384, (t % 6) * 64, (t / 6) * 64, 0.07216878364870322f * 1.4426950408889634f  ); return; } t -= NT_UQ;
    if (t < NT_UKV) {
        const int n0 = (t / 4) * 64, h = n0 >> 8, kv = (n0 >> 7) & 1, nn = kv * 512 + h * 128 + (n0 & 127);
        tr_tile(p.w_ukv, 1024, 1024, p.wt_ukv + ((ptrdiff_t)nn - n0) * 256, 256, (t % 4) * 64, n0); return; } t -= NT_UKV;
    if (t < NT_O) { tr_tile(p.w_o, 1024, 1024, p.wt_o, 1024, (t % 16) * 64, (t / 16) * 64); return; } t -= NT_O;
    if (t < NT_POOL) { const int g = t >> 4, tt = t & 15; tr_tile(p.w_pool + (size_t)g * 65536, 256, 256, p.wt_pool + (size_t)g * 65536, 256, (tt & 3) * 64, (tt >> 2) * 64); return; } t -= NT_POOL;
    if (t < NT_PQ) { tr_tile(p.peer_wq[0], 2048, 2048, p.wt_pq[0], 1024, (t % 16) * 64, (t / 16) * 64); return; } t -= NT_PQ;
    tr_tile(p.peer_wq[1], 2048, 2048, p.wt_pq[1], 1024, (t % 16) * 64, (t / 16) * 64);
}

__device__ __forceinline__ void st_prologue(const Params& p) {
    const int tid = tidx(), lane = tid & 63, wid = tid >> 6;
    const int n_items = N_ADA + N_TR / 2 + N_CONV_ITEMS + N_FP8_ITEMS;
    const int n_mine = (n_items - (int)blockIdx.x + (int)gridDim.x - 1) / (int)gridDim.x, rot = ((int)(blockIdx.x >> 3) * 7 + (int)(blockIdx.x & 7) * 2) % max(n_mine, 1);
    for (int it = 0; it < n_mine; ++it) {
        const int ii = it + rot < n_mine ? it + rot : it + rot - n_mine, item = blockIdx.x + ii * gridDim.x;
        if (item < N_ADA) {
            float* svec = (float*)smem;
            float* red = (float*)(smem + 9 * 4096);
            __syncthreads();
            for (int i = tid; i < 9 * 1024; i += NTHR) { const int bc = i >> 10, k = i & 1023; const float cv = bc == 0 ? p.c_ctx[k] : p.c[(size_t)(bc - 1) * 1024 + k]; svec[i] = silu_(cv); }
            __syncthreads();
            const int cidx = item * 32 + (lane & 7) * 4, l = cidx / 6144, col = cidx % 6144, k0 = (wid * 8 + (lane >> 3)) * 16;
            const float* w = p.w_mod[l] + (size_t)k0 * 6144 + col;
            float acc[9][4];
#pragma unroll
            for (int b = 0; b < 9; ++b) { acc[b][0] = 0.f; acc[b][1] = 0.f; acc[b][2] = 0.f; acc[b][3] = 0.f; }
#pragma unroll 8
            for (int k = 0; k < 16; ++k) {
                const float4 wv = *(const float4*)(w + (size_t)k * 6144);
#pragma unroll
                for (int b = 0; b < 9; ++b) { const float sv = svec[b * 1024 + k0 + k]; acc[b][0] += wv.x * sv; acc[b][1] += wv.y * sv; acc[b][2] += wv.z * sv; acc[b][3] += wv.w * sv; }
            }
#pragma unroll
            for (int b = 0; b < 9; ++b)
#pragma unroll
                for (int j = 0; j < 4; ++j) { float v = acc[b][j]; v += __shfl_xor(v, 8); v += __shfl_xor(v, 16); v += __shfl_xor(v, 32); acc[b][j] = v; }
            if (lane < 8) {
#pragma unroll
                for (int b = 0; b < 9; ++b)
#pragma unroll
                    for (int j = 0; j < 4; ++j) red[(wid * 9 + b) * 32 + lane * 4 + j] = acc[b][j];
            }
            __syncthreads();
            for (int i = tid; i < 9 * 32; i += NTHR) {
                const int b = i >> 5, c = i & 31;
                const int ci = item * 32 + c, ll = ci / 6144, cc = ci % 6144;
                float v = 0.f;
#pragma unroll
                for (int w8 = 0; w8 < 8; ++w8) v += red[(w8 * 9 + b) * 32 + c];
                const float mv = v + p.b_mod[ll][cc];
                p.mod[(size_t)(ll * 9 + b) * 6144 + cc] = mv;
                const int jj = cc >> 10, col = cc & 1023;
                p.modb[(size_t)(ll * 9 + b) * 6144 + cc] = f2bf(jj == 1 ? p.g_mix[ll][col] * (1.f + mv) : (jj == 4 ? p.g_ffn[ll][col] * (1.f + mv) : mv));
            }
        } else if (item < N_ADA + N_TR / 2) {
            tr_item(p, (item - N_ADA) * 2 + (tid >> 8));
        } else if (item < N_ADA + N_TR / 2 + N_CONV_ITEMS) {
            const int base = (item - N_ADA - N_TR / 2) * 4096;
            for (int i = tid; i < 4096; i += NTHR) { const int e = base + i; if (e < NE_TOTAL) conv_elem(p, e); }
        } else {
            const int row0 = ((item - N_ADA - N_TR / 2 - N_CONV_ITEMS) * NWV + wid) * 4;
            const int tb = row0 >> 14, er0 = row0 & 16383, l = tb >> 1;
            const float* src = ((tb & 1) ? p.peer_v[l] : p.peer_u[l]) + (size_t)er0 * 1024 + lane * 16;
            u8_t* dst = ((tb & 1) ? p.v8[l] : p.u8[l]) + (size_t)er0 * 512 + lane * 8;
            float* sc = ((tb & 1) ? p.sv[l] : p.su[l]) + er0;
            f32x4v f[4][4];
#pragma unroll
            for (int r = 0; r < 4; ++r)
#pragma unroll
                for (int j = 0; j < 4; ++j) f[r][j] = *(const f32x4v*)(src + (size_t)r * 1024 + 4 * j);
#pragma unroll
            for (int r = 0; r < 4; ++r) {
                float am = 0.f, sq = 0.f;
#pragma unroll
                for (int j = 0; j < 4; ++j) {
                    am = fmaxf(fmaxf(am, fmaxf(fabsf(f[r][j][0]), fabsf(f[r][j][1]))), fmaxf(fabsf(f[r][j][2]), fabsf(f[r][j][3])));
                    sq += (f[r][j][0] * f[r][j][0] + f[r][j][1] * f[r][j][1]) + (f[r][j][2] * f[r][j][2] + f[r][j][3] * f[r][j][3]);
                }
                unsigned w[2]; float scale;
                if (tb & 1) {
                    sq = wave_sum(sq);
                    const float rms = sqrtf(sq * (1.f / 1024.f));
                    scale = rms > 0.f ? 0.3352f * rms : 1.f; const float inv = 1.f / scale;
#pragma unroll
                    for (int j = 0; j < 2; ++j) {
                        unsigned pk = 0u;
#pragma unroll
                        for (int i = 0; i < 8; ++i) {
                            const float x = f[r][2 * j + (i >> 2)][i & 3] * inv;
                            const int q = (int)fminf(fmaxf(rintf(x), -8.f), 7.f) + 8;
                            pk |= (unsigned)q << (8 * (i & 3) + 4 * (i >> 2));
                        }
                        w[j] = pk;
                    }
                } else {
                    sq = wave_sum(sq);
                    const float rms = sqrtf(sq * (1.f / 1024.f));
                    scale = rms > 0.f ? 0.3352f * rms : 1.f; const float inv = 1.f / scale;
#pragma unroll
                    for (int j = 0; j < 2; ++j) {
                        unsigned pk = 0u;
#pragma unroll
                        for (int i = 0; i < 8; ++i) {
                            const float x = f[r][2 * j + (i >> 2)][i & 3] * inv;
                            const int q = (int)fminf(fmaxf(rintf(x), -8.f), 7.f);
                            pk |= ((unsigned)q & 15u) << (4 * i);
                        }
                        w[j] = pk;
                    }
                }
                *(uint2*)(dst + (size_t)r * 512) = make_uint2(w[0], w[1]);
                if (lane == 0) sc[r] = scale;
            }
        }
    }
}

template <int FIRST>
__device__ __forceinline__ void st_resnorm(const Params& p, int l) {
    const bool fastg = FAST_GROUPS();
    const int lane = tidx() & 63, wid = tidx() >> 6, per = (T_TOK + gridDim.x * NWV - 1) / (gridDim.x * NWV), gq = blockIdx.x & 7;
    const int Tb = fastg ? ((blockIdx.x >> 3) * NWV + wid) * per : (blockIdx.x * NWV + wid) * per, Te = min(Tb + per, fastg ? 2560 : T_TOK);
    const int Tmap = fastg ? ((((Tb >> 8) * 8 + gq) << 8) + (Tb & 255)) - Tb : 0, rbrk = fastg ? (Tb | 255) : 0x7fffffff;
#define RN_TOK(r_) ((r_) + Tmap + ((r_) > rbrk ? 7 * 256 : 0))
    int cur_mi = -1; float gtv[16], gsc[16], shv[16];
    float pa[16]; int pT = -2;
#pragma unroll
    for (int j = 0; j < 16; ++j) pa[j] = 0.f;
    for (int T0 = Tb; T0 < Te; T0 += 2) {
        float4 xa[2][4]; uint4 xb[2][2]; uint4 ma[2][2];
#pragma unroll
        for (int u = 0; u < 2; ++u) {
            const int T = RN_TOK(min(T0 + u, Te - 1));
            const uint4* mp = (const uint4*)(p.mix + (size_t)T * 1024 + lane * 16);
            if (FIRST) { const float* x0 = x_in_row(p, T) + lane * 16;
#pragma unroll
                for (int j = 0; j < 4; ++j) xa[u][j] = *(const float4*)(x0 + 4 * j); }
            else { const uint4* xp = (const uint4*)(p.xres + (size_t)T * 1024 + lane * 16); xb[u][0] = xp[0]; xb[u][1] = xp[1]; }
            ma[u][0] = mp[0]; ma[u][1] = mp[1];
        }
#pragma unroll
        for (int u = 0; u < 2; ++u) {
            if (T0 + u < Te) {
                const int T = RN_TOK(T0 + u);
                const TokInfo ti = tokinfo(T);
                bf16_t* xr = p.xres + (size_t)T * 1024 + lane * 16;
                if (ti.mi != cur_mi) {
                    cur_mi = ti.mi;
                    const float* gt = modv(p, l, ti.mi, 2) + lane * 16; const float* sh = modv(p, l, ti.mi, 3) + lane * 16; const float* sc = modv(p, l, ti.mi, 4) + lane * 16; const float* gg = p.g_ffn[l] + lane * 16;
#pragma unroll
                    for (int j = 0; j < 16; ++j) { gtv[j] = FIRST ? gt[j] : gt[j] * p.s_pool[lane * 16 + j]; gsc[j] = gg[j] * (1.f + sc[j]); shv[j] = sh[j]; }
                }
                float x0v[16];
                if (FIRST) {
#pragma unroll
                    for (int j = 0; j < 4; ++j) { x0v[4 * j] = xa[u][j].x; x0v[4 * j + 1] = xa[u][j].y; x0v[4 * j + 2] = xa[u][j].z; x0v[4 * j + 3] = xa[u][j].w; }
                } else { float t8[8]; unpack8(xb[u][0], t8);
#pragma unroll
                    for (int j = 0; j < 8; ++j) x0v[j] = t8[j];
                    unpack8(xb[u][1], t8);
#pragma unroll
                    for (int j = 0; j < 8; ++j) x0v[8 + j] = t8[j]; }
                float m[16]; { float t8[8]; unpack8(ma[u][0], t8);
#pragma unroll
                    for (int j = 0; j < 8; ++j) m[j] = t8[j];
                    unpack8(ma[u][1], t8);
#pragma unroll
                    for (int j = 0; j < 8; ++j) m[8 + j] = t8[j]; }
                if (!FIRST) {
                    const int W = 2 << (lane >> 4), wlo = max(ti.s - (W >> 1), 0), whi = min(ti.s + (W >> 1), ti.S);
                    const bf16_t* base = p.mix + (size_t)(T - ti.s) * 1024 + lane * 16;
                    if (T == pT + 1 && ti.s > 0) {
                        const int tin = ti.s + (W >> 1) - 1, tout = ti.s - 1 - (W >> 1);
                        uint4 a0 = make_uint4(0u, 0u, 0u, 0u), a1 = a0, b0 = a0, b1 = a0;
                        if (tin < ti.S) { const uint4* rp = (const uint4*)(base + (size_t)tin * 1024); a0 = rp[0]; a1 = rp[1]; }
                        if (tout >= 0) { const uint4* rp = (const uint4*)(base + (size_t)tout * 1024); b0 = rp[0]; b1 = rp[1]; }
                        float ta[8], tb[8]; unpack8(a0, ta); unpack8(b0, tb);
#pragma unroll
                        for (int j = 0; j < 8; ++j) pa[j] += ta[j] - tb[j];
                        unpack8(a1, ta); unpack8(b1, tb);
#pragma unroll
                        for (int j = 0; j < 8; ++j) pa[8 + j] += ta[j] - tb[j];
                    } else {
#pragma unroll
                    for (int j = 0; j < 16; ++j) pa[j] = 0.f;
#pragma unroll 1
                    for (int kc = 0; kc < 16; kc += 4) {
                        uint4 ra[4][2];
#pragma unroll
                        for (int k = 0; k < 4; ++k) {
                            const int t2 = ti.s - (W >> 1) + kc + k;
                            const bool ok = (kc + k < W) && t2 >= wlo && t2 < whi;
                            const uint4* rp = (const uint4*)(base + (size_t)(ok ? t2 : ti.s) * 1024);
                            ra[k][0] = ok ? rp[0] : make_uint4(0u, 0u, 0u, 0u); ra[k][1] = ok ? rp[1] : make_uint4(0u, 0u, 0u, 0u);
                        }
#pragma unroll
                        for (int k = 0; k < 4; ++k) { float t8[8]; unpack8(ra[k][0], t8);
#pragma unroll
                            for (int j = 0; j < 8; ++j) pa[j] += t8[j];
                            unpack8(ra[k][1], t8);
#pragma unroll
                            for (int j = 0; j < 8; ++j) pa[8 + j] += t8[j]; }
                    }
                    }
                    pT = T;
                    const float winv = 1.f / (float)(whi - wlo);
#pragma unroll
                    for (int j = 0; j < 16; ++j) m[j] = pa[j] * winv - m[j];
                }
                float v[16]; float ss = 0.f;
#pragma unroll
                for (int j = 0; j < 16; ++j) v[j] = x0v[j] + gtv[j] * m[j];
                { uint4* xw = (uint4*)xr;
                  xw[0] = make_uint4(pack_bf16(v[0], v[1]), pack_bf16(v[2], v[3]), pack_bf16(v[4], v[5]), pack_bf16(v[6], v[7]));
                  xw[1] = make_uint4(pack_bf16(v[8], v[9]), pack_bf16(v[10], v[11]), pack_bf16(v[12], v[13]), pack_bf16(v[14], v[15])); }
#pragma unroll
                for (int j = 0; j < 16; ++j) ss += v[j] * v[j];
                ss = wave_sum(ss);
                const float rstd = rsqrtf(ss * (1.f / 1024.f) + 1e-6f);
                float hval[16]; float hm = 0.f;
#pragma unroll
                for (int j = 0; j < 16; ++j) { hval[j] = v[j] * rstd * gsc[j] + shv[j]; hm = fmaxf(hm, fabsf(hval[j])); }
                unsigned w[8];
#pragma unroll
                for (int j = 0; j < 8; ++j) w[j] = pack_bf16(hval[2 * j], hval[2 * j + 1]);
                uint4* d = (uint4*)(p.hbuf + (size_t)T * 1024 + lane * 16);
                d[0] = make_uint4(w[0], w[1], w[2], w[3]); d[1] = make_uint4(w[4], w[5], w[6], w[7]);
                hm = wave_max(hm);
                const float hs = hm > 0.f ? hm * (1.f / 119.f) : 1.f, hinv = 1.f / hs;
                unsigned ph[2] = {0u, 0u}, pl[2] = {0u, 0u};
#pragma unroll
                for (int j = 0; j < 16; ++j) {
                    const int h8 = (int)rintf(hval[j] * hinv);
                    const int lo = ((h8 + 8) & 15) - 8, hi = (h8 - lo) >> 4;
                    ph[j >> 3] |= ((unsigned)hi & 15u) << (4 * (j & 7)); pl[j >> 3] |= ((unsigned)lo & 15u) << (4 * (j & 7));
                }
                *(uint2*)(p.hqh + (size_t)T * 128 + lane * 2) = make_uint2(ph[0], ph[1]);
                *(uint2*)(p.hql + (size_t)T * 128 + lane * 2) = make_uint2(pl[0], pl[1]);
                if (lane == 0) p.hsc[T] = hs;
            }
        }
    }
}

template <int SRC>
__device__ __forceinline__ void st_norm(const Params& p, int l, int which, const float* g, bf16_t* dst) {
    const int lane = tidx() & 63, wid = tidx() >> 6, stride = gridDim.x * NWV;
    for (int T0 = FAST_GROUPS() ? (int)(blockIdx.x & 7) * 256 + (int)(blockIdx.x >> 3) * NWV + wid : (int)blockIdx.x * NWV + wid; T0 < T_TOK; T0 += 2 * stride) {
        float v[2][16];
#pragma unroll
        for (int u = 0; u < 2; ++u) {
            const int T = min(T0 + u * stride, T_TOK - 1);
            const float* src = x_in_row(p, T) + lane * 16;
#pragma unroll
            for (int j = 0; j < 4; ++j) { const float4 f = *(const float4*)(src + 4 * j); v[u][4 * j] = f.x; v[u][4 * j + 1] = f.y; v[u][4 * j + 2] = f.z; v[u][4 * j + 3] = f.w; }
        }
#pragma unroll
        for (int u = 0; u < 2; ++u) {
            const int T = T0 + u * stride;
            if (T < T_TOK) {
                const TokInfo ti = tokinfo(T);
                float ss = 0.f;
#pragma unroll
                for (int j = 0; j < 16; ++j) ss += v[u][j] * v[u][j];
                ss = wave_sum(ss);
                const float rstd = rsqrtf(ss * (1.f / 1024.f) + 1e-6f);
                const uint4* shp = (const uint4*)(modvb(p, l, ti.mi, which ? 3 : 0) + lane * 16); const uint4* gsp = (const uint4*)(modvb(p, l, ti.mi, which ? 4 : 1) + lane * 16);
                float shv[16], gsc[16];
                { float t8[8]; unpack8(shp[0], t8);
#pragma unroll
                  for (int j = 0; j < 8; ++j) shv[j] = t8[j];
                  unpack8(shp[1], t8);
#pragma unroll
                  for (int j = 0; j < 8; ++j) shv[8 + j] = t8[j];
                  unpack8(gsp[0], t8);
#pragma unroll
                  for (int j = 0; j < 8; ++j) gsc[j] = t8[j];
                  unpack8(gsp[1], t8);
#pragma unroll
                  for (int j = 0; j < 8; ++j) gsc[8 + j] = t8[j]; }
                unsigned w[8];
#pragma unroll
                for (int j = 0; j < 8; ++j) w[j] = pack_bf16(v[u][2 * j] * rstd * gsc[2 * j] + shv[2 * j], v[u][2 * j + 1] * rstd * gsc[2 * j + 1] + shv[2 * j + 1]);
                uint4* d = (uint4*)(dst + (size_t)T * 1024 + lane * 16);
                d[0] = make_uint4(w[0], w[1], w[2], w[3]); d[1] = make_uint4(w[4], w[5], w[6], w[7]);
            }
        }
    }
}

struct EpiStoreBf16 {
    static constexpr bool PERM = true;
    bf16_t* O; int ldc;
    __device__ __forceinline__ void operator()(const pg8::f32x4 (&acc)[2][2][4][2], const pg8::Unit& u, int wr, int wc, int fr, int fq) const {
#pragma unroll
        for (int ai = 0; ai < 2; ++ai)
#pragma unroll
            for (int m = 0; m < 4; ++m) {
                bf16_t* rowp = O + (size_t)(u.pm * 256 + ai * 128 + wr * 64 + m * 16 + fr) * ldc + u.pn * 256 + wc * 32 + 8 * fq;
#pragma unroll
                for (int bj = 0; bj < 2; ++bj) {
                    const pg8::f32x4 v0 = acc[ai][bj][m][0], v1 = acc[ai][bj][m][1];
                    *(uint4*)(rowp + bj * 128) = make_uint4(pack_bf16(v0[0], v0[1]), pack_bf16(v0[2], v0[3]), pack_bf16(v1[0], v1[1]), pack_bf16(v1[2], v1[3]));
                }
            }
    }
};
__device__ __forceinline__ void st_gemm1(const Params& p) {
    pg8::TileOrder S; S.nN = 7; S.total = 80 * 7; S.A = (const char*)p.hbuf; S.B = (const char*)p.wt_in; S.tA = (size_t)256 * 1024 * 2; S.tB = (size_t)256 * 1024 * 2;
    EpiStoreBf16 E; E.O = p.P; E.ldc = 1792;
    pg8::gemm_phase<EpiStoreBf16, pg8::TileOrder, true, true>((LAS unsigned char*)smem, 1024, 1024, 1024, S, E);
}

__device__ __forceinline__ void st_postproj(const Params& p) {
    const int lane = tidx() & 63, wid = tidx() >> 6;
    float* o_ckv = p.out + 20971520, *o_kr = p.out + 22020096;
#define PP_LOAD(Tx_, CQ, CK, KR, TAP, UG) do { const TokInfo tx_ = tokinfo(Tx_); const bf16_t* px_ = p.P + (size_t)(Tx_) * 1792; \
        CQ = make_uint4(0u, 0u, 0u, 0u); CK = CQ; KR = CQ; \
        if (lane < 48) CQ = *(const uint4*)(px_ + lane * 8); \
        if (lane < 32) CK = *(const uint4*)(px_ + 384 + lane * 8); \
        if (lane < 8) KR = *(const uint4*)(px_ + 640 + lane * 8); \
        _Pragma("unroll") for (int k = 0; k < 4; ++k) { const int s2_ = tx_.s + k - 2; TAP[k] = make_uint4(0u, 0u, 0u, 0u); if (s2_ >= 0 && s2_ < tx_.S) TAP[k] = *(const uint4*)(p.P + (size_t)((Tx_) + k - 2) * 1792 + 704 + lane * 8); } \
        UG = *(const uint4*)(px_ + 1216 + lane * 8); } while (0)
    const int pstr = gridDim.x * NWV;
    uint4 n_cq, n_ck, n_kr, n_tap[4], n_ug;
    { const int Tf = min((int)blockIdx.x * NWV + wid, T_TOK - 1); PP_LOAD(Tf, n_cq, n_ck, n_kr, n_tap, n_ug); }
#pragma unroll 1
    for (int T = blockIdx.x * NWV + wid; T < T_TOK; T += pstr) {
        const TokInfo ti = tokinfo(T);
        const bf16_t* Pr = p.P + (size_t)T * 1792;
        const uint4 r_cq = n_cq, r_ck = n_ck, r_kr = n_kr, r_ug = n_ug; uint4 r_tap[4];
#pragma unroll
        for (int k = 0; k < 4; ++k) r_tap[k] = n_tap[k];
        { const int Tn = T + pstr < T_TOK ? T + pstr : T; PP_LOAD(Tn, n_cq, n_ck, n_kr, n_tap, n_ug); }
        float cq[8], ck[8];
        unpack8(r_cq, cq); unpack8(r_ck, ck);
        float s1 = 0.f, s2 = 0.f;
#pragma unroll
        for (int j = 0; j < 8; ++j) { s1 += cq[j] * cq[j]; s2 += ck[j] * ck[j]; }
        s1 = wave_sum(s1); s2 = wave_sum(s2);
        const float r1 = rsqrtf(s1 * (1.f / 384.f) + 1e-6f), r2 = rsqrtf(s2 * (1.f / 256.f) + 1e-6f);
        if (lane < 48) {
            const float4 ga = *(const float4*)(p.g_q + lane * 8), gb = *(const float4*)(p.g_q + lane * 8 + 4);
            uint4 o; o.x = pack_bf16(cq[0] * r1 * ga.x, cq[1] * r1 * ga.y); o.y = pack_bf16(cq[2] * r1 * ga.z, cq[3] * r1 * ga.w);
            o.z = pack_bf16(cq[4] * r1 * gb.x, cq[5] * r1 * gb.y); o.w = pack_bf16(cq[6] * r1 * gb.z, cq[7] * r1 * gb.w);
            *(uint4*)(p.cqn + (size_t)T * 384 + lane * 8) = o;
        }
        if (lane < 32) {
            const float4 ga = *(const float4*)(p.g_kv + lane * 8), gb = *(const float4*)(p.g_kv + lane * 8 + 4);
            float y[8] = {ck[0] * r2 * ga.x, ck[1] * r2 * ga.y, ck[2] * r2 * ga.z, ck[3] * r2 * ga.w, ck[4] * r2 * gb.x, ck[5] * r2 * gb.y, ck[6] * r2 * gb.z, ck[7] * r2 * gb.w};
            uint4 o; o.x = pack_bf16(y[0], y[1]); o.y = pack_bf16(y[2], y[3]); o.z = pack_bf16(y[4], y[5]); o.w = pack_bf16(y[6], y[7]);
            *(uint4*)(p.ckvk + (size_t)ti.keyrow * 256 + lane * 8) = o;
            if (!ti.smp) { float4* d = (float4*)(o_ckv + (size_t)T * 256 + lane * 8); d[0] = make_float4(y[0], y[1], y[2], y[3]); d[1] = make_float4(y[4], y[5], y[6], y[7]); }
        }
        if (lane < 8) {
            float v[8]; unpack8(r_kr, v);
            float y[8];
            if (ti.smp) {
                const int gr = ti.s >> 6, gc = ti.s & 63;
#pragma unroll
                for (int i = 0; i < 4; ++i) {
                    const int pr = lane * 4 + i;
                    const float cs = pr < 16 ? p.ropetab[gr * 16 + pr] : p.ropetab[1024 + gc * 16 + (pr - 16)];
                    const float sn = pr < 16 ? p.ropetab[512 + gr * 16 + pr] : p.ropetab[2048 + gc * 16 + (pr - 16)];
                    y[2 * i] = v[2 * i] * cs - v[2 * i + 1] * sn; y[2 * i + 1] = v[2 * i] * sn + v[2 * i + 1] * cs;
                }
            } else {
#pragma unroll
                for (int i = 0; i < 8; ++i) y[i] = v[i];
                float4* d = (float4*)(o_kr + (size_t)T * 64 + lane * 8); d[0] = make_float4(v[0], v[1], v[2], v[3]); d[1] = make_float4(v[4], v[5], v[6], v[7]);
            }
            uint4 o; o.x = pack_bf16(y[0], y[1]); o.y = pack_bf16(y[2], y[3]); o.z = pack_bf16(y[4], y[5]); o.w = pack_bf16(y[6], y[7]);
            *(uint4*)(p.kropek + (size_t)ti.keyrow * 64 + lane * 8) = o;
        }
        {
            const int ch = lane * 8;
            float y[8];
            { const float4 a = *(const float4*)(p.conv_b + ch), b = *(const float4*)(p.conv_b + ch + 4); y[0] = a.x; y[1] = a.y; y[2] = a.z; y[3] = a.w; y[4] = b.x; y[5] = b.y; y[6] = b.z; y[7] = b.w; }
#pragma unroll
            for (int k = 0; k < 4; ++k) {
                const int s2i = ti.s + k - 2;
                if (s2i >= 0 && s2i < ti.S) {
                    float u[8]; unpack8(r_tap[k], u);
                    const float4 a = *(const float4*)(p.conv_w + k * 512 + ch), b = *(const float4*)(p.conv_w + k * 512 + ch + 4);
                    y[0] += a.x * u[0]; y[1] += a.y * u[1]; y[2] += a.z * u[2]; y[3] += a.w * u[3]; y[4] += b.x * u[4]; y[5] += b.y * u[5]; y[6] += b.z * u[6]; y[7] += b.w * u[7];
                }
            }
            uint4 o; o.x = pack_bf16(y[0], y[1]); o.y = pack_bf16(y[2], y[3]); o.z = pack_bf16(y[4], y[5]); o.w = pack_bf16(y[6], y[7]);
            *(uint4*)(p.xc + (size_t)T * 512 + ch) = o;
            *(uint4*)(p.ug + (size_t)T * 512 + ch) = r_ug;
        }
    }
}

struct EpiVT {
    static constexpr bool PERM = true;
    bf16_t* vT;
    __device__ __forceinline__ void operator()(const pg8::f32x4 (&acc)[2][2][4][2], const pg8::Unit& u, int wr, int wc, int fr, int fq) const {
        const int R0 = u.pn * 256;
        size_t sbase; int Sk, pos0;
        if (R0 < T_CTX) { Sk = 256; pos0 = 0; sbase = (size_t)(R0 >> 8) * 4 * 128 * 256; }
        else { const int uu = R0 - T_CTX; const int sq = uu / 2304; Sk = 2304; pos0 = uu - sq * 2304; sbase = (size_t)T_CTX * 512 + (size_t)sq * 4 * 128 * 2304; }
        bf16_t* vb = vT + sbase + pos0 + wc * 32 + 8 * fq;
#pragma unroll
        for (int ai = 0; ai < 2; ++ai)
#pragma unroll
            for (int m = 0; m < 4; ++m) {
                const int r = u.pm * 256 + ai * 128 + wr * 64 + m * 16 + fr;
                bf16_t* rowp = vb + (size_t)r * Sk;
#pragma unroll
                for (int bj = 0; bj < 2; ++bj) {
                    const pg8::f32x4 v0 = acc[ai][bj][m][0], v1 = acc[ai][bj][m][1];
                    *(uint4*)(rowp + bj * 128) = make_uint4(pack_bf16(v0[0], v0[1]), pack_bf16(v0[2], v0[3]), pack_bf16(v1[0], v1[1]), pack_bf16(v1[2], v1[3]));
                }
            }
    }
};
#define N_G4 (160 * 16)
__device__ __forceinline__ void st_gemm234(const Params& p) {
    {
        pg8::TileOrder S; S.nN = 3; S.total = 80 * 3; S.A = (const char*)p.cqn; S.B = (const char*)p.wt_uq; S.tA = (size_t)256 * 384 * 2; S.tB = (size_t)256 * 384 * 2;
        EpiStoreBf16 E; E.O = p.q; E.ldc = 768;
        pg8::gemm_phase<EpiStoreBf16, pg8::TileOrder, true, true>((LAS unsigned char*)smem, 384, 384, 384, S, E);
    }
    {
        pg8::TileOrder S; S.nN = 2; S.total = 88 * 2; S.A = (const char*)p.ckvk; S.B = (const char*)p.wt_ukv; S.tA = (size_t)256 * 256 * 2; S.tB = (size_t)256 * 256 * 2;
        EpiStoreBf16 E; E.O = p.Kn; E.ldc = 512;
        pg8::gemm_phase<EpiStoreBf16, pg8::TileOrder, true, true>((LAS unsigned char*)smem, 256, 256, 256, S, E);
    }
    {
        struct OrderVT {
            const char* W; const char* Kr;
            __device__ __forceinline__ bool next(int i, pg8::Unit& u) const {
                const int item = blockIdx.x + i * gridDim.x; if (item >= 88 * 2) return false;
                const int lt = item >> 3; u.pm = lt & 1; u.pn = (lt >> 1) * 8 + (item & 7);
                u.A = W + (size_t)u.pm * 256 * 256 * 2; u.B = Kr + (size_t)u.pn * 256 * 256 * 2; return true;
            }
        } S; S.W = (const char*)(p.wt_ukv + (size_t)512 * 256); S.Kr = (const char*)p.ckvk;
        EpiVT E; E.vT = p.vT;
        pg8::gemm_phase<EpiVT, OrderVT, true, true>((LAS unsigned char*)smem, 256, 256, 256, S, E);
    }
}

__device__ __forceinline__ void st_gates(const Params& p) {
    const int half = tidx() >> 8, lane = tidx() & 63, wid = (tidx() >> 6) & 3, wm = wid >> 1, wn = wid & 1, hl = lane >> 5, cl = lane & 31;
    for (int item = blockIdx.x; item < N_G4 / 2; item += gridDim.x) {
        f32x16 acc[2][2];
        const int lt = (item >> 3) * 2 + half, tj = lt & 3, nb = (lt >> 2) & 3, tm = (lt >> 4) * 8 + (item & 7);
        gemm_acc<2, 2, 2, 2>(p.wt_gate + ((size_t)nb * 512 + tj * 128) * 128, 128, p.xc + (size_t)tm * 128 * 512 + nb * 128, 512, 128, acc);
        const int dir = tj >> 1, dg = (tj & 1) * 2 + wm;
        float4 brg4[4], big4[4], sp4[4]; uint2 xr8[4][2];
#pragma unroll
        for (int gq = 0; gq < 4; ++gq) {
            const int ch0 = nb * 128 + dg * 32 + 8 * gq + 4 * hl;
            brg4[gq] = *(const float4*)(p.b_rg + dir * 512 + ch0); big4[gq] = *(const float4*)(p.b_ig + dir * 512 + ch0); sp4[gq] = *(const float4*)(p.spl + dir * 512 + ch0);
#pragma unroll
            for (int j = 0; j < 2; ++j) xr8[gq][j] = *(const uint2*)(p.xc + (size_t)(tm * 128 + 64 * wn + 32 * j + cl) * 512 + ch0);
        }
#pragma unroll
        for (int gq = 0; gq < 4; ++gq) {
            const int ch0 = nb * 128 + dg * 32 + 8 * gq + 4 * hl;
            const float4 brg = brg4[gq], big = big4[gq], sp = sp4[gq];
            const float br[4] = {brg.x, brg.y, brg.z, brg.w}, bi[4] = {big.x, big.y, big.z, big.w}, spv[4] = {sp.x, sp.y, sp.z, sp.w};
#pragma unroll
            for (int j = 0; j < 2; ++j) {
                const int T = tm * 128 + 64 * wn + 32 * j + cl;
                const uint2 xr = xr8[gq][j];
                const float xv[4] = {__uint_as_float(xr.x << 16), __uint_as_float(xr.x & 0xffff0000u), __uint_as_float(xr.y << 16), __uint_as_float(xr.y & 0xffff0000u)};
                float am[4], bx[4];
#pragma unroll
                for (int e = 0; e < 4; ++e) {
                    const float rg = __builtin_amdgcn_rcpf(1.f + __expf(-(acc[0][j][4 * gq + e] + br[e]))), ig = __builtin_amdgcn_rcpf(1.f + __expf(-(acc[1][j][4 * gq + e] + bi[e])));
                    const float la = -8.f * rg * spv[e];
                    const float av = __expf(la);
                    am[e] = 1.f - av;
                    bx[e] = __builtin_amdgcn_sqrtf(fmaxf(1.f - av * av, 0.f)) * ig * xv[e];
                }
                *(uint4*)(p.abx + ((size_t)T * 2 + dir) * 512 + ch0) = make_uint4(pack_bf16(am[0], bx[0]), pack_bf16(am[1], bx[1]), pack_bf16(am[2], bx[2]), pack_bf16(am[3], bx[3]));
            }
        }
    }
}

#define N_ATT (64 + 256)
#define SCH 64
#define NCHK (T_TOK / SCH)
#define N_S1 (NCHK * 2)
__device__ __forceinline__ void scan_s1_item(const Params& p, int it) {
    const int chunk = it >> 1, dc = (it & 1) * 512 + tidx(), dir = dc >> 9, ch = dc & 511;
    const int T0 = chunk * SCH;
    float A = 1.f, B = 0.f;
#pragma unroll 8
    for (int i = 0; i < SCH; ++i) {
        const int T = dir ? (T0 + SCH - 1 - i) : (T0 + i);
        const unsigned wab = p.abx[((size_t)T * 2 + dir) * 512 + ch];
        const float av = 1.f - __uint_as_float(wab << 16), bv = __uint_as_float(wab & 0xffff0000u);
        A *= av; B = B * av + bv;
    }
    *(float2*)(p.agg + (((size_t)chunk * 2 + dir) * 512 + ch) * 2) = make_float2(A, B);
}

template <int NI>
__device__ __forceinline__ void scan_s1_multi(const Params& p, int it0, int it1, int it2, int it3) {
    const int its[4] = {it0, it1, it2, it3};
    const unsigned* ap[NI]; ptrdiff_t st[NI]; float A[NI], B[NI];
#pragma unroll
    for (int n = 0; n < NI; ++n) {
        const int chunk = its[n] >> 1, dir = its[n] & 1, ch = tidx(), T0 = chunk * SCH;
        ap[n] = p.abx + ((size_t)(dir ? T0 + SCH - 1 : T0) * 2 + dir) * 512 + ch; st[n] = dir ? -1024 : 1024;
        A[n] = 1.f; B[n] = 0.f;
    }
#pragma unroll 8
    for (int i = 0; i < SCH; ++i) {
#pragma unroll
        for (int n = 0; n < NI; ++n) {
            const unsigned wab = ap[n][(ptrdiff_t)i * st[n]];
            const float av = 1.f - __uint_as_float(wab << 16), bv = __uint_as_float(wab & 0xffff0000u);
            A[n] *= av; B[n] = B[n] * av + bv;
        }
    }
#pragma unroll
    for (int n = 0; n < NI; ++n) { const int chunk = its[n] >> 1, dir = its[n] & 1; *(float2*)(p.agg + (((size_t)chunk * 2 + dir) * 512 + tidx()) * 2) = make_float2(A[n], B[n]); }
}

__device__ __forceinline__ int perm23(int r) { return (r & 0x13) | ((r & 4) << 1) | ((r & 8) >> 1); }
__device__ __forceinline__ void attn_item_mfma(const Params& p, int it) {
    int seq, h, qb, Sk, T0, R0; size_t vbase;
    if (it < 64) { seq = it >> 2; h = it & 3; qb = 0; Sk = 256; T0 = seq * 256; R0 = seq * 256; vbase = (size_t)(seq * 4 + h) * 128 * 256; }
    else { const int u = it - 64; seq = u >> 5; h = (u >> 3) & 3; qb = u & 7; Sk = 2304; T0 = T_CTX + seq * 2048 + qb * 256; R0 = T_CTX + seq * 2304; vbase = (size_t)T_CTX * 512 + (size_t)(seq * 4 + h) * 128 * 2304; }
    const int tid = tidx(), lane = tid & 63, wid = tid >> 6, hl = lane >> 5, cl = lane & 31;
    bf16x8_t qf[12];
    {
        const bf16_t* qrow = p.q + (size_t)(T0 + 32 * wid + cl) * 768 + h * 192 + 8 * hl;
#pragma unroll
        for (int ks = 0; ks < 12; ++ks) qf[ks] = __builtin_bit_cast(bf16x8_t, *(const u32x4*)(qrow + 16 * ks));
        if (it >= 64) {
            const int sp = qb * 256 + 32 * wid + cl, gr = sp >> 6, gc = sp & 63;
#pragma unroll
            for (int ks = 8; ks < 12; ++ks) {
                const u32x4 w = __builtin_bit_cast(u32x4, qf[ks]); u32x4 o;
#pragma unroll
                for (int i = 0; i < 4; ++i) {
                    const int pr = 8 * (ks - 8) + 4 * hl + i;
                    const float cs = ks < 10 ? p.ropetab[gr * 16 + pr] : p.ropetab[1024 + gc * 16 + (pr - 16)];
                    const float sn = ks < 10 ? p.ropetab[512 + gr * 16 + pr] : p.ropetab[2048 + gc * 16 + (pr - 16)];
                    const float x0 = __uint_as_float(w[i] << 16), x1 = __uint_as_float(w[i] & 0xffff0000u);
                    o[i] = pack_bf16(x0 * cs - x1 * sn, x0 * sn + x1 * cs);
                }
                qf[ks] = __builtin_bit_cast(bf16x8_t, o);
            }
        }
    }
    f32x16 oacc[4];
#pragma unroll
    for (int d = 0; d < 4; ++d)
#pragma unroll
        for (int r = 0; r < 16; ++r) oacc[d][r] = 0.f;
    float m = -1e30f, lsum = 0.f;
    const bf16_t* gk = p.Kn + (size_t)(R0 + (tid >> 4)) * 512 + h * 128 + (tid & 15) * 8;
    const bf16_t* gr = p.kropek + (size_t)(R0 + (tid >> 3)) * 64 + (tid & 7) * 8;
    const bf16_t* gv = p.vT + vbase + (size_t)(tid >> 3) * Sk + (tid & 7) * 8;
    u32x4 rk[2], rr, rv[2];
    const int nt = Sk >> 6;
#pragma unroll
    for (int i = 0; i < 2; ++i) rk[i] = *(const u32x4*)(gk + (size_t)(32 * i) * 512);
    rr = *(const u32x4*)gr;
#pragma unroll
    for (int i = 0; i < 2; ++i) rv[i] = *(const u32x4*)(gv + (size_t)(64 * i) * Sk);
    __syncthreads();
    for (int t = 0; t < nt; ++t) {
#pragma unroll
        for (int i = 0; i < 2; ++i) *(u32x4*)(smem + ((tid & 15) >> 3) * 8192 + lds_off((tid >> 4) + 32 * i, tid & 7)) = rk[i];
        *(u32x4*)(smem + 16384 + lds_off(tid >> 3, tid & 7)) = rr;
#pragma unroll
        for (int i = 0; i < 2; ++i) *(u32x4*)(smem + 24576 + lds_off((tid >> 3) + 64 * i, tid & 7)) = rv[i];
        __syncthreads();
        if (t + 1 < nt) {
            const size_t ko = (size_t)(t + 1) * 64;
#pragma unroll
            for (int i = 0; i < 2; ++i) rk[i] = *(const u32x4*)(gk + (ko + 32 * i) * 512);
            rr = *(const u32x4*)(gr + ko * 64);
#pragma unroll
            for (int i = 0; i < 2; ++i) rv[i] = *(const u32x4*)(gv + (size_t)(64 * i) * Sk + ko);
        }
        f32x16 sacc[2];
#pragma unroll
        for (int kb = 0; kb < 2; ++kb) {
            __builtin_amdgcn_sched_barrier(0);
#pragma unroll
            for (int r = 0; r < 16; ++r) sacc[kb][r] = 0.f;
            const int krow = 32 * kb + perm23(cl);
#pragma unroll
            for (int ks = 0; ks < 12; ++ks) {
                const bf16x8_t kf = __builtin_bit_cast(bf16x8_t, *(const u32x4*)(smem + (ks >> 2) * 8192 + lds_off(krow, 2 * (ks & 3) + hl)));
                sacc[kb] = __builtin_amdgcn_mfma_f32_32x32x16_bf16(kf, qf[ks], sacc[kb], 0, 0, 0);
            }
        }
        float mx = sacc[0][0];
#pragma unroll
        for (int r = 1; r < 16; ++r) mx = fmaxf(mx, sacc[0][r]);
#pragma unroll
        for (int r = 0; r < 16; ++r) mx = fmaxf(mx, sacc[1][r]);
        mx = fmaxf(mx, __shfl_xor(mx, 32));
        const bool resc = !__all(mx - m <= 8.f);
        const float mn = resc ? fmaxf(m, mx) : m, alpha = resc ? __builtin_amdgcn_exp2f(m - mn) : 1.f;
        m = mn;
        float ps = 0.f;
        bf16x8_t pf[2][2];
#pragma unroll
        for (int kb = 0; kb < 2; ++kb)
#pragma unroll
            for (int s2 = 0; s2 < 2; ++s2) {
                float e[8];
#pragma unroll
                for (int j = 0; j < 8; ++j) { e[j] = __builtin_amdgcn_exp2f(sacc[kb][8 * s2 + j] - mn); ps += e[j]; }
                u32x4 w; w.x = pack_bf16(e[0], e[1]); w.y = pack_bf16(e[2], e[3]); w.z = pack_bf16(e[4], e[5]); w.w = pack_bf16(e[6], e[7]);
                pf[kb][s2] = __builtin_bit_cast(bf16x8_t, w);
            }
        lsum = lsum * alpha + ps;
        if (resc) {
#pragma unroll
            for (int d = 0; d < 4; ++d)
#pragma unroll
                for (int r = 0; r < 16; ++r) oacc[d][r] *= alpha;
        }
#pragma unroll
        for (int d = 0; d < 4; ++d) {
            __builtin_amdgcn_sched_barrier(0);
#pragma unroll
            for (int kb = 0; kb < 2; ++kb)
#pragma unroll
                for (int s2 = 0; s2 < 2; ++s2) {
                    const bf16x8_t vf = __builtin_bit_cast(bf16x8_t, *(const u32x4*)(smem + 24576 + lds_off(32 * d + cl, 4 * kb + 2 * s2 + hl)));
                    oacc[d] = __builtin_amdgcn_mfma_f32_32x32x16_bf16(vf, pf[kb][s2], oacc[d], 0, 0, 0);
                }
        }
        __builtin_amdgcn_sched_barrier(0);
        __syncthreads();
    }
    lsum += __shfl_xor(lsum, 32);
    const float inv = 1.f / lsum;
    bf16_t* dst = p.hbuf + (size_t)(T0 + 32 * wid + cl) * 1024 + h * 128 + 4 * hl;
#pragma unroll
    for (int d = 0; d < 4; ++d)
#pragma unroll
        for (int g = 0; g < 4; ++g) {
            uint2 w; w.x = pack_bf16(oacc[d][4 * g] * inv, oacc[d][4 * g + 1] * inv); w.y = pack_bf16(oacc[d][4 * g + 2] * inv, oacc[d][4 * g + 3] * inv);
            *(uint2*)(dst + 32 * d + 8 * g) = w;
        }
}
__device__ __forceinline__ void st_attn_s1(const Params& p) {
    if (gridDim.x == 256) {
        attn_item_mfma(p, 64 + (int)(blockIdx.x & 7) * 32 + (int)(blockIdx.x >> 3));
        if (blockIdx.x < 64) attn_item_mfma(p, 63 - (int)blockIdx.x);
        else { const int j = (int)blockIdx.x - 64;
               if (j < 64) scan_s1_multi<4>(p, j, j + 192, j + 384, 576 + j); else scan_s1_multi<3>(p, j, j + 192, j + 384, 0); }
        return;
    }
    for (int item = blockIdx.x; item < N_ATT + N_S1; item += gridDim.x) {
        if (item < N_ATT) {
            attn_item_mfma(p, N_ATT - 1 - item);
        }
        else scan_s1_item(p, item - N_ATT);
    }
}

__device__ __forceinline__ void st_scan3(const Params& p) {
    const int tid = tidx();
    float* hf = (float*)smem;
    float* hb = hf + SCH * 256;
    float* o_lru = p.out + 22282240;
    const bool fastg = FAST_GROUPS();
    for (int it = fastg ? (int)(blockIdx.x >> 3) : (int)blockIdx.x; it < (fastg ? 80 : NCHK * 2); it += fastg ? 32 : (int)gridDim.x) {
        const int item = fastg ? ((((it >> 3) * 8 + (int)(blockIdx.x & 7)) * 4 + ((it >> 1) & 3)) << 1) + (it & 1) : it;
        const int chunk = item >> 1, cgp = item & 1, T0 = chunk * SCH;
        const TokInfo ti = tokinfo(T0);
        const int nch = ti.S / SCH, cpos = ti.s / SCH, c0 = chunk - cpos;
        const int dir = tid >> 8, ch = cgp * 256 + (tid & 255);
        float hcur = ti.smp ? p.state_lru[((size_t)ti.b * 2 + dir) * 512 + ch] : 0.f;
        {
            const int cnt = dir ? nch - 1 - cpos : cpos, cstart = dir ? nch - 1 : 0, cstep = dir ? -1 : 1;
            const float* ap = p.agg + (((size_t)(c0 + cstart) * 2 + dir) * 512 + ch) * 2;
            const ptrdiff_t astep = (ptrdiff_t)cstep * 2 * 512 * 2;
            for (int j0 = 0; j0 < cnt; j0 += 16) {
                float2 ab[16];
#pragma unroll
                for (int j = 0; j < 16; ++j) ab[j] = (j0 + j < cnt) ? *(const float2*)(ap + (ptrdiff_t)(j0 + j) * astep) : make_float2(1.f, 0.f);
#pragma unroll
                for (int j = 0; j < 16; ++j) hcur = ab[j].x * hcur + ab[j].y;
            }
        }
        __syncthreads();
#pragma unroll 8
        for (int i = 0; i < SCH; ++i) {
            const int tl = dir ? SCH - 1 - i : i, T = T0 + tl;
            const unsigned wab = p.abx[((size_t)T * 2 + dir) * 512 + ch];
            const float av = 1.f - __uint_as_float(wab << 16), bv = __uint_as_float(wab & 0xffff0000u);
            hcur = av * hcur + bv;
            (dir ? hb : hf)[tl * 256 + (tid & 255)] = hcur;
        }
        if (!ti.smp) {
            if (dir == 0 && cpos == nch - 1) o_lru[((size_t)ti.b * 2 + 0) * 512 + ch] = hcur;
            if (dir == 1 && cpos == 0) o_lru[((size_t)ti.b * 2 + 1) * 512 + ch] = hcur;
        }
        __syncthreads();
        uint4 nug = *(const uint4*)(p.ug + (size_t)(T0 + (tid >> 5)) * 512 + cgp * 256 + (tid & 31) * 8);
#pragma unroll 1
        for (int i = tid; i < SCH * 32; i += NTHR) {
            const int tl = i >> 5, c = (i & 31) * 8, T = T0 + tl, chh = cgp * 256 + c;
            const uint4 cug = nug;
            { const int in_ = i + NTHR < SCH * 32 ? i + NTHR : i; nug = *(const uint4*)(p.ug + (size_t)(T0 + (in_ >> 5)) * 512 + cgp * 256 + (in_ & 31) * 8); }
            float ugf[8]; unpack8(cug, ugf);
            const f32x4v f0 = *(const f32x4v*)(hf + tl * 256 + c), f1 = *(const f32x4v*)(hf + tl * 256 + c + 4), b0 = *(const f32x4v*)(hb + tl * 256 + c), b1 = *(const f32x4v*)(hb + tl * 256 + c + 4);
            float o[8];
#pragma unroll
            for (int j = 0; j < 4; ++j) { o[j] = (f0[j] + b0[j]) * gelu_tanh(ugf[j]); o[4 + j] = (f1[j] + b1[j]) * gelu_tanh(ugf[4 + j]); }
            *(uint4*)(p.hbuf + (size_t)T * 1024 + 512 + chh) = make_uint4(pack_bf16(o[0], o[1]), pack_bf16(o[2], o[3]), pack_bf16(o[4], o[5]), pack_bf16(o[6], o[7]));
        }
    }
}

__device__ __forceinline__ void st_gemm_o(const Params& p) {
    pg8::TileOrder S; S.nN = 4; S.total = 80 * 4; S.A = (const char*)p.hbuf; S.B = (const char*)p.wt_o; S.tA = (size_t)256 * 1024 * 2; S.tB = (size_t)256 * 1024 * 2;
    EpiStoreBf16 E; E.O = p.mix; E.ldc = 1024;
    pg8::gemm_phase<EpiStoreBf16, pg8::TileOrder, true, true>((LAS unsigned char*)smem, 1024, 1024, 1024, S, E);
}

__device__ __forceinline__ void ce_desc(float& a, float& b) { const float hi = fmaxf(a, b), lo = fminf(a, b); a = hi; b = lo; }
__device__ __forceinline__ void ins16(float (&top)[16], float x) {
#pragma unroll
    for (int i = 0; i < 16; ++i) { const float hi = fmaxf(top[i], x); x = fminf(top[i], x); top[i] = hi; }
}
__device__ __forceinline__ void bitonic_merge16(float (&v)[16]) {
#pragma unroll
    for (int j = 8; j >= 1; j >>= 1)
#pragma unroll
        for (int i = 0; i < 16; ++i) { const int l = i ^ j; if (l > i) ce_desc(v[i], v[l]); }
}
__device__ __forceinline__ void sort16(float (&v)[16]) {
#pragma unroll
    for (int k = 2; k <= 16; k <<= 1)
#pragma unroll
        for (int j = k >> 1; j >= 1; j >>= 1)
#pragma unroll
            for (int i = 0; i < 16; ++i) { const int l = i ^ j; if (l > i) { if ((i & k) == 0) ce_desc(v[i], v[l]); else ce_desc(v[l], v[i]); } }
}
__device__ __forceinline__ void merge_top16(float (&a)[16], const float (&b)[16]) {
#pragma unroll
    for (int i = 0; i < 16; ++i) a[i] = fmaxf(a[i], b[15 - i]);
    bitonic_merge16(a);
}
#define PKV(x) __uint_as_float(__float_as_uint(x) & 0xffffff80u)
#define CAND(i, j) __uint_as_float((__float_as_uint(PKV(top[0][i]) + PKV(top[1][j])) & 0xffffff00u) | (unsigned)((i) * 16 + (j)))
__device__ __forceinline__ void st_peer_topk(const Params& p, int l) {
    __builtin_amdgcn_sched_barrier(0);
    const int half = tidx() >> 8, lane = tidx() & 63, wid = (tidx() >> 6) & 3, hl = lane >> 5, cl = lane & 31;
#define TK_TM(item_) (2 * ((((item_) >> 3) >> 3) * 8 + ((item_) & 7)) + half)
#define TK_ISSUE(item_, pp_) gemm128_issue<4, 1, 1, 4>(p.keysb[l] + (size_t)((((item_) >> 3) & 7) * 2 + (pp_)) * 128 * 128, 128, p.qp + (size_t)TK_TM(item_) * 128 * 2048 + (((item_) >> 3) & 7) * 256 + (pp_) * 128, 2048)
    const int G = gridDim.x, bid = blockIdx.x;
    const bool steal = (G == 256);
    const int n_units = steal ? 3 : (80 * 8 - bid + G - 1) / G;
    volatile LAS unsigned* dec = (volatile LAS unsigned*)(smem + 131072) + 3;
#define TK_UNIT(i_) (steal ? (bid < 128 ? ((i_) < 2 ? bid + 256 * ((i_) + 1) : bid) : ((i_) < 2 ? bid + 256 * (i_) : bid - 128)) : bid + (i_) * G)
    if (n_units > 0) TK_ISSUE(TK_UNIT(0), 0);
    for (int ui = 0; ui < n_units; ++ui) {
        const int item = TK_UNIT(ui);
        if (steal && ui == 2) {
            if (tidx() == 0) {
                const int pr = bid & 127;
                unsigned* fl = p.bar + XB_STEAL + l * 128 + pr; unsigned* cl_ = p.bar + XB_CLAIM + l * 128 + pr;
                unsigned take = 0u;
                if (bid < 128) take = (atomicCAS(cl_, 0u, 1u) == 0u) ? 1u : 0u;
                else {
                    XB_SPIN(xb_ld(fl) == 0u, p.bar);
                    if (xb_ld(fl) == 1u + xb_xcc_id()) take = (atomicCAS(cl_, 0u, 2u) == 0u) ? 1u : 0u;
                }
                if (take) { __builtin_amdgcn_fence(__ATOMIC_ACQUIRE, "agent"); asm volatile("s_waitcnt vmcnt(0)" ::: "memory"); }
                *dec = take;
            }
            __syncthreads();
            const unsigned take = *dec;
            __syncthreads();
            if (!take) break;
            TK_ISSUE(item, 0);
        }
        const int lt = item >> 3, h = lt & 7, tm = 2 * ((lt >> 3) * 8 + (item & 7)) + half;
        const int T = tm * 128 + 32 * wid + cl;
        float top[2][16];
#pragma unroll
        for (int pp = 0; pp < 2; ++pp) {
            f32x16 acc[4][1];
            gemm128_compute<4, 1, 1, 4>(acc);
            if (pp == 0) TK_ISSUE(item, 1);
            else if (ui + 1 < n_units && !(steal && ui + 1 == 2)) TK_ISSUE(TK_UNIT(ui + 1), 0);
#pragma unroll
            for (int i = 0; i < 4; ++i) {
                __builtin_amdgcn_sched_barrier(0);
                float g[16];
#pragma unroll
                for (int r = 0; r < 16; ++r) {
                    const int n = ACC_ROW(4, 0, i, r, hl);
                    g[r] = __uint_as_float((__float_as_uint(acc[i][0][r]) & 0xffffff80u) | (unsigned)n);
                }
                sort16(g);
                if (i == 0) {
#pragma unroll
                    for (int r = 0; r < 16; ++r) top[pp][r] = g[r];
                } else merge_top16(top[pp], g);
            }
            __builtin_amdgcn_sched_barrier(0);
            float oth[16];
#pragma unroll
            for (int i = 0; i < 16; ++i) oth[i] = __shfl_xor(top[pp][i], 32);
            merge_top16(top[pp], oth);
        }
        __builtin_amdgcn_sched_barrier(0);
        float fv[16], t2[16];
#pragma unroll
        for (int j = 0; j < 16; ++j) fv[j] = CAND(0, j);
        t2[15] = -INFINITY;
#pragma unroll
        for (int i = 1; i < 16; ++i) t2[i - 1] = CAND(i, 0);
        merge_top16(fv, t2);
        t2[0] = CAND(1, 1); t2[1] = CAND(1, 2); t2[2] = CAND(1, 3); t2[3] = CAND(1, 4); t2[4] = CAND(1, 5); t2[5] = CAND(1, 6); t2[6] = CAND(1, 7);
        t2[7] = CAND(2, 1); t2[8] = CAND(2, 2); t2[9] = CAND(2, 3); t2[10] = CAND(2, 4); t2[11] = CAND(3, 1); t2[12] = CAND(3, 2); t2[13] = CAND(3, 3);
        t2[14] = CAND(4, 1); t2[15] = CAND(4, 2);
        sort16(t2);
        merge_top16(fv, t2);
        ins16(fv, CAND(5, 1)); ins16(fv, CAND(6, 1)); ins16(fv, CAND(7, 1));
        unsigned* tab = (unsigned*)(smem + TKTAB_OFF + half * 8192) + (size_t)(tidx() & 255) * 8;
#pragma unroll
        for (int k = 0; k < 4; ++k) {
            tab[k] = (__float_as_uint(top[0][4 * k]) & 127u) | ((__float_as_uint(top[0][4 * k + 1]) & 127u) << 8) | ((__float_as_uint(top[0][4 * k + 2]) & 127u) << 16) | ((__float_as_uint(top[0][4 * k + 3]) & 127u) << 24);
            tab[4 + k] = (__float_as_uint(top[1][4 * k]) & 127u) | ((__float_as_uint(top[1][4 * k + 1]) & 127u) << 8) | ((__float_as_uint(top[1][4 * k + 2]) & 127u) << 16) | ((__float_as_uint(top[1][4 * k + 3]) & 127u) << 24);
        }
        const u8_t* tabb = (const u8_t*)tab;
        int fe[16];
#pragma unroll
        for (int i = 0; i < 16; ++i) {
            const unsigned code = __float_as_uint(fv[i]) & 255u;
            fe[i] = (int)tabb[code >> 4] * 128 + (int)tabb[16 + (code & 15u)];
            fv[i] = __uint_as_float(__float_as_uint(fv[i]) & 0xffffff00u);
        }
        float sum = 0.f, ev[16];
#pragma unroll
        for (int i = 0; i < 16; ++i) { ev[i] = __expf(fv[i] - fv[0]); sum += ev[i]; }
        const float inv = 1.f / sum;
        if (hl == 0) {
            float4* gp = (float4*)(p.gates + (size_t)T * 128 + h * 16); int4* ep = (int4*)(p.eidx + (size_t)T * 128 + h * 16);
#pragma unroll
            for (int i = 0; i < 4; ++i) { gp[i] = make_float4(ev[4 * i] * inv, ev[4 * i + 1] * inv, ev[4 * i + 2] * inv, ev[4 * i + 3] * inv); ep[i] = make_int4(fe[4 * i], fe[4 * i + 1], fe[4 * i + 2], fe[4 * i + 3]); }
        }
    }
}

__device__ __forceinline__ void st_gemm_pq(const Params& p, int l) {
    pg8::TileOrder S; S.nN = 8; S.total = 80 * 8; S.A = (const char*)p.hbuf; S.B = (const char*)p.wt_pq[l]; S.tA = (size_t)256 * 1024 * 2; S.tB = (size_t)256 * 1024 * 2;
    EpiStoreBf16 E; E.O = p.qp; E.ldc = 2048;
    pg8::gemm_phase<EpiStoreBf16, pg8::TileOrder, true, true>((LAS unsigned char*)smem, 1024, 1024, 1024, S, E);
    asm volatile("s_waitcnt vmcnt(0)" ::: "memory");
    __syncthreads();
    if (gridDim.x == 256 && blockIdx.x < 128 && tidx() == 0)
        __hip_atomic_store(p.bar + XB_STEAL + l * 128 + blockIdx.x, 1u + xb_xcc_id(), __ATOMIC_RELAXED, __HIP_MEMORY_SCOPE_AGENT);
    st_peer_topk(p, l);
}

#define GT_TPW 10
#define GT_WAVE_LDS 12288
#define FP4X(dw, b) __builtin_amdgcn_cvt_scalef32_pk_f32_fp4(dw, 1.0f, b)
#define FP4B(dw, b) __builtin_amdgcn_cvt_scalef32_pk_bf16_fp4(dw, 1.0f, b)
__device__ __forceinline__ void st_peer_gather(const Params& p, int l) {
    const int lane = tidx() & 63, wid = __builtin_amdgcn_readfirstlane(tidx() >> 6), g = lane >> 3, pc = lane & 7;
    const u8_t* U = p.u8[l]; const u8_t* V = p.v8[l]; const float* SU = p.su[l]; const float* SV = p.sv[l];
    const bool b0 = (lane & 1) != 0, b1 = (lane & 2) != 0, b2 = (lane & 4) != 0, b3 = (lane & 8) != 0;
    const int stride = gridDim.x * NWV, Tfirst = FAST_GROUPS() ? (int)(blockIdx.x & 7) * 256 + (int)(blockIdx.x >> 3) * NWV + wid : (int)blockIdx.x * NWV + wid;
    const int ka = 16 * g + pc, kb = ka + 8;
    LAS unsigned* eo_l = (LAS unsigned*)(smem + wid * GT_WAVE_LDS);
    LAS float* zw_l = (LAS float*)(smem + wid * GT_WAVE_LDS + GT_TPW * 512);
    LAS unsigned char* wq_l = (LAS unsigned char*)(smem + wid * GT_WAVE_LDS + GT_TPW * 1024);
    LAS float* tsc_l = (LAS float*)(smem + wid * GT_WAVE_LDS + GT_TPW * 1152);
    const int vj = lane & 15, vg = lane >> 4;
    unsigned selb[4];
#pragma unroll
    for (int bb = 0; bb < 4; ++bb) selb[bb] = (0x0C0C0C0Cu & ~(0xFFu << (8 * (lane & 3)))) | ((unsigned)bb << (8 * (lane & 3)));
#pragma unroll 1
    for (int Tr = Tfirst; Tr < T_TOK; Tr += stride * GT_TPW) {
        {
            int2 ev[GT_TPW];
#pragma unroll
            for (int k = 0; k < GT_TPW; ++k) ev[k] = *(const int2*)(p.eidx + (size_t)min(Tr + k * stride, T_TOK - 1) * 128 + 2 * lane);
#pragma unroll
            for (int k = 0; k < GT_TPW; ++k) *(LAS u32x2*)(eo_l + k * 128 + 2 * lane) = (u32x2){(unsigned)ev[k].x * 512u, (unsigned)ev[k].y * 512u};
        }
        __builtin_amdgcn_wave_barrier();
#pragma unroll 1
        for (int c = 0; c < 4; ++c) {
#pragma unroll 1
            for (int k = 0; k < GT_TPW; ++k) {
                const int T = Tr + k * stride;
                if (T >= T_TOK) break;
                u32x4 eo[4];
#pragma unroll
                for (int q = 0; q < 4; ++q) eo[q] = *(LAS const u32x4*)(eo_l + k * 128 + 16 * g + 4 * q);
                const u32x4 hh4 = *(const u32x4*)(p.hqh + (size_t)T * 128 + c * 32 + pc * 4), hl4 = *(const u32x4*)(p.hql + (size_t)T * 128 + c * 32 + pc * 4);
                u32x4 r[16];
#pragma unroll
                for (int i = 0; i < 16; ++i) r[i] = *(const u32x4*)(U + (eo[i >> 2][i & 3] + (unsigned)(c * 128 + pc * 16)));
                float za = 0.f, zb = 0.f;
                if (c > 0) { za = zw_l[k * 128 + ka]; zb = zw_l[k * 128 + kb]; }
#pragma unroll
                for (int hh = 0; hh < 2; ++hh) {
                    float d[8];
#pragma unroll
                    for (int ii = 0; ii < 8; ++ii) {
                        int ah = 0, al = 0;
#pragma unroll
                        for (int q = 0; q < 4; ++q) { ah = __builtin_amdgcn_sdot8((int)r[8 * hh + ii][q], (int)hh4[q], ah, false); al = __builtin_amdgcn_sdot8((int)r[8 * hh + ii][q], (int)hl4[q], al, false); }
                        d[ii] = (float)(ah * 16 + al);
                    }
                    float a4[4], a2[2];
#pragma unroll
                    for (int j = 0; j < 4; ++j) { const float kp = b2 ? d[j + 4] : d[j], sn = b2 ? d[j] : d[j + 4]; a4[j] = kp + DPP_F(sn, 0x141); }
#pragma unroll
                    for (int j = 0; j < 2; ++j) { const float kp = b1 ? a4[j + 2] : a4[j], sn = b1 ? a4[j] : a4[j + 2]; a2[j] = kp + DPP_F(sn, 0x4E); }
                    const float kp = b0 ? a2[1] : a2[0], sn = b0 ? a2[0] : a2[1];
                    const float z = kp + DPP_F(sn, 0xB1);
                    if (hh == 0) za += z; else zb += z;
                }
                if (c < 3) { zw_l[k * 128 + ka] = za; zw_l[k * 128 + kb] = zb; }
                else {
                    const unsigned ea = eo_l[k * 128 + ka] >> 9, eb = eo_l[k * 128 + kb] >> 9;
                    const float ga = p.gates[(size_t)T * 128 + ka], gb = p.gates[(size_t)T * 128 + kb];
                    const float hs = p.hsc[T];
                    const float wa = ga * gelu_tanh(za * (SU[ea] * hs)) * SV[ea], wb = gb * gelu_tanh(zb * (SU[eb] * hs)) * SV[eb];
                    const float wmax = wave_max(fmaxf(fabsf(wa), fabsf(wb)));
                    const float winv = wmax > 0.f ? 127.f / wmax : 0.f;
                    const float qa = rintf(wa * winv), qb = rintf(wb * winv);
                    wq_l[k * 128 + ka] = (unsigned char)(int)qa; wq_l[k * 128 + kb] = (unsigned char)(int)qb;
                    const float qs = wave_sum(qa + qb);
                    if (lane == 0) { tsc_l[k * 2] = wmax * (1.f / 127.f); tsc_l[k * 2 + 1] = 8.f * qs; }
                }
            }
        }
        __builtin_amdgcn_wave_barrier();
#pragma unroll 1
        for (int c = 0; c < 4; ++c) {
#pragma unroll 1
            for (int k = 0; k < GT_TPW; ++k) {
                const int T = Tr + k * stride;
                if (T >= T_TOK) break;
                i32x4 acc[4];
#pragma unroll
                for (int a = 0; a < 4; ++a) acc[a] = (i32x4){0, 0, 0, 0};
#pragma unroll
                for (int hf = 0; hf < 2; ++hf) {
                    u32x4 eo[4];
#pragma unroll
                    for (int q = 0; q < 4; ++q) eo[q] = *(LAS const u32x4*)(eo_l + k * 128 + 32 * vg + 16 * hf + 4 * q);
                    const u32x4 W = *(LAS const u32x4*)(wq_l + k * 128 + 32 * vg + 16 * hf);
                    u32x2 r[16];
#pragma unroll
                    for (int i = 0; i < 16; ++i) r[i] = *(const u32x2*)(V + (eo[i >> 2][i & 3] + (unsigned)(c * 128 + vj * 8)));
#pragma unroll
                    for (int i = 0; i < 16; ++i) {
                        i32x4 B, A;
                        B[0] = (int)(r[i][0] & 0x0F0F0F0Fu); B[1] = (int)((r[i][0] >> 4) & 0x0F0F0F0Fu); B[2] = (int)(r[i][1] & 0x0F0F0F0Fu); B[3] = (int)((r[i][1] >> 4) & 0x0F0F0F0Fu);
                        const unsigned sw = __builtin_amdgcn_perm(0u, W[i >> 2], selb[i & 3]);
#pragma unroll
                        for (int d = 0; d < 4; ++d) A[d] = ((vj >> 2) == d) ? (int)sw : 0;
                        acc[i & 3] = __builtin_amdgcn_mfma_i32_16x16x64_i8(A, B, acc[i & 3], 0, 0, 0);
                    }
                }
                const i32x4 tot = (acc[0] + acc[1]) + (acc[2] + acc[3]);
                const float sc = tsc_l[k * 2], c8 = tsc_l[k * 2 + 1];
                *(uint2*)(p.mix + (size_t)T * 1024 + c * 256 + vj * 16 + vg * 4) = make_uint2(pack_bf16(((float)tot[0] - c8) * sc, ((float)tot[1] - c8) * sc), pack_bf16(((float)tot[2] - c8) * sc, ((float)tot[3] - c8) * sc));
            }
        }
        __builtin_amdgcn_wave_barrier();
    }
    asm volatile("s_waitcnt vmcnt(0)" ::: "memory");
    __syncthreads();
    const int base_b = Tfirst - wid, ntb = (T_TOK - base_b + stride - 1) / stride;
    int cur_mi = -1; float gtv[16], gsc[16], shv[16];
    const int cb = lane * 16, tlast = wid * ntb + ntb - 1;
    uint4 pm0, pm1, px0, px1;
    { const int T0 = min(base_b + ((wid * ntb) & 7) + ((wid * ntb) >> 3) * stride, T_TOK - 1);
      const uint4* op = (const uint4*)(p.mix + (size_t)T0 * 1024 + cb); const uint4* xp = (const uint4*)(p.xres + (size_t)T0 * 1024 + cb);
      pm0 = op[0]; pm1 = op[1]; px0 = xp[0]; px1 = xp[1]; }
#pragma unroll 1
    for (int t = wid * ntb; t <= tlast; ++t) {
        const int T = base_b + (t & 7) + (t >> 3) * stride;
        const uint4 cm0 = pm0, cm1 = pm1, cx0 = px0, cx1 = px1;
        { const int tn = min(t + 1, tlast), Tn = min(base_b + (tn & 7) + (tn >> 3) * stride, T_TOK - 1);
          const uint4* op = (const uint4*)(p.mix + (size_t)Tn * 1024 + cb); const uint4* xp = (const uint4*)(p.xres + (size_t)Tn * 1024 + cb);
          pm0 = op[0]; pm1 = op[1]; px0 = xp[0]; px1 = xp[1]; }
        if (T >= T_TOK) continue;
        const TokInfo ti = tokinfo(T);
        if (ti.mi != cur_mi) {
            cur_mi = ti.mi;
            { const uint4* gp = (const uint4*)(modvb(p, l, ti.mi, 5) + cb); float t8[8]; unpack8(gp[0], t8);
#pragma unroll
              for (int j = 0; j < 8; ++j) gtv[j] = t8[j];
              unpack8(gp[1], t8);
#pragma unroll
              for (int j = 0; j < 8; ++j) gtv[8 + j] = t8[j]; }
            if (l == 0) { const uint4* sp = (const uint4*)(modvb(p, 1, ti.mi, 0) + cb); const uint4* qp = (const uint4*)(modvb(p, 1, ti.mi, 1) + cb); float t8[8];
              unpack8(sp[0], t8);
#pragma unroll
              for (int j = 0; j < 8; ++j) shv[j] = t8[j];
              unpack8(sp[1], t8);
#pragma unroll
              for (int j = 0; j < 8; ++j) shv[8 + j] = t8[j];
              unpack8(qp[0], t8);
#pragma unroll
              for (int j = 0; j < 8; ++j) gsc[j] = t8[j];
              unpack8(qp[1], t8);
#pragma unroll
              for (int j = 0; j < 8; ++j) gsc[8 + j] = t8[j]; }
            else { const float* gg = p.g_final + cb;
#pragma unroll
              for (int j = 0; j < 16; ++j) { gsc[j] = gg[j]; shv[j] = 0.f; } }
        }
        float o16[16];
        { float t8[8]; unpack8(cm0, t8);
#pragma unroll
          for (int j = 0; j < 8; ++j) o16[j] = t8[j];
          unpack8(cm1, t8);
#pragma unroll
          for (int j = 0; j < 8; ++j) o16[8 + j] = t8[j]; }
        bf16_t* xr = p.xres + (size_t)T * 1024 + cb;
        float xn[16]; float ss = 0.f;
        { float t8[8]; unpack8(cx0, t8);
#pragma unroll
          for (int j = 0; j < 8; ++j) xn[j] = t8[j] + gtv[j] * o16[j];
          unpack8(cx1, t8);
#pragma unroll
          for (int j = 0; j < 8; ++j) xn[8 + j] = t8[j] + gtv[8 + j] * o16[8 + j]; }
#pragma unroll
        for (int j = 0; j < 16; ++j) ss += xn[j] * xn[j];
        ss = wave_sum(ss);
        const float rstd = rsqrtf(ss * (1.f / 1024.f) + 1e-6f);
        if (l == 0) {
#pragma unroll
            for (int j = 0; j < 1; ++j) { uint4* xw = (uint4*)xr;
                xw[0] = make_uint4(pack_bf16(xn[0], xn[1]), pack_bf16(xn[2], xn[3]), pack_bf16(xn[4], xn[5]), pack_bf16(xn[6], xn[7]));
                xw[1] = make_uint4(pack_bf16(xn[8], xn[9]), pack_bf16(xn[10], xn[11]), pack_bf16(xn[12], xn[13]), pack_bf16(xn[14], xn[15])); }
            unsigned w[8];
#pragma unroll
            for (int j = 0; j < 8; ++j) w[j] = pack_bf16(xn[2 * j] * rstd * gsc[2 * j] + shv[2 * j], xn[2 * j + 1] * rstd * gsc[2 * j + 1] + shv[2 * j + 1]);
            uint4* dd = (uint4*)(p.h3 + (size_t)T * 1024 + cb);
            dd[0] = make_uint4(w[0], w[1], w[2], w[3]); dd[1] = make_uint4(w[4], w[5], w[6], w[7]);
        } else {
            float* y = p.out + (size_t)T * 1024 + cb;
#pragma unroll
            for (int j = 0; j < 4; ++j) *(float4*)(y + 4 * j) = make_float4(xn[4 * j] * rstd * gsc[4 * j], xn[4 * j + 1] * rstd * gsc[4 * j + 1], xn[4 * j + 2] * rstd * gsc[4 * j + 2], xn[4 * j + 3] * rstd * gsc[4 * j + 3]);
        }
    }
}

__device__ __forceinline__ void st_gemm_pool(const Params& p) {
    struct OrderPool {
        const char* A; const char* B;
        __device__ __forceinline__ bool next(int i, pg8::Unit& u) const {
            const int item = blockIdx.x + i * gridDim.x; if (item >= 80 * 4) return false;
            const int lt = item >> 3; u.pn = lt & 3; u.pm = (lt >> 2) * 8 + (item & 7);
            u.A = A + (size_t)u.pm * 256 * 1024 * 2 + (size_t)u.pn * 256 * 2; u.B = B + (size_t)u.pn * 256 * 256 * 2; return true;
        }
    } S; S.A = (const char*)p.h3; S.B = (const char*)p.wt_pool;
    EpiStoreBf16 E; E.O = p.mix; E.ldc = 1024;
    pg8::gemm_phase<EpiStoreBf16, OrderPool, true, true>((LAS unsigned char*)smem, 1024, 256, 256, S, E);
}

__device__ __forceinline__ void run_stage(const Params& p, int s) {
#ifdef ONLY_STAGE
    if (s != ONLY_STAGE) return;
#endif
    switch (s) {
        case 0: st_prologue(p); break;
        case 1: st_norm<0>(p, 0, 0, p.g_mix[0], p.hbuf); break;
        case 2: st_gemm1(p); break;
        case 3: st_postproj(p); break;
        case 4: st_gemm234(p); break;
        case 18: st_gates(p); break;
        case 5: st_attn_s1(p); break;
        case 6: st_scan3(p); break;
        case 7: st_gemm_o(p); break;
        case 8: st_resnorm<1>(p, 0); break;
        case 9: st_gemm_pq(p, 0); break;
        case 11: st_peer_gather(p, 0); break;
        case 13: st_gemm_pool(p); break;
        case 14: st_resnorm<0>(p, 1); break;
        case 15: st_gemm_pq(p, 1); break;
        case 17: st_peer_gather(p, 1); break;
        default: break;
    }
}

__global__ void __launch_bounds__(NTHR, 2) fwd_mega(Params p) {
    cg::grid_group grid = cg::this_grid();
    volatile LAS unsigned* st = (volatile LAS unsigned*)(smem + 131072);
    if (threadIdx.x == 0) { st[0] = 0; st[1] = 0; st[2] = 0; st[3] = 0; }
    wtab_init();
    __syncthreads();
    XcdBarrier b = xcd_barrier_post(p.bar, st);
    if (threadIdx.x == 0) atomicOr(&p.bar[XB_GMASK + (blockIdx.x & 7)], 1u << xb_xcc_id());
    if (p.bar == nullptr) grid.sync();
#ifndef REP_MASK
#define REP_MASK 0
#endif
#define MK_ST(k) run_stage(p, k); if ((REP_MASK >> (k)) & 1) { xcd_barrier(b); run_stage(p, k); } if ((k) != 17) xcd_barrier(b);
#define MK_STL(k) run_stage(p, k); if (FAST_GROUPS()) grp_barrier(p.bar); else xcd_barrier(b);
    MK_ST(0)
    if (tidx() == 0) {
        unsigned ok = (gridDim.x == 256u) ? 1u : 0u;
        for (int g8 = 0; g8 < 8; ++g8) { const unsigned mk = xb_ld(&p.bar[XB_GMASK + g8]); if (mk == 0u || (mk & (mk - 1u)) != 0u) ok = 0u; }
        st[2] = ok;
    }
    __syncthreads();
    MK_STL(1) MK_ST(2) MK_ST(3) run_stage(p, 4); MK_ST(18) MK_ST(5) MK_STL(6) MK_STL(7) MK_STL(8) MK_STL(9) MK_STL(11) MK_ST(13) MK_STL(14) MK_STL(15) MK_ST(17)
}

extern "C" void kernel_launch(void* const* d_in, const int* in_sizes, int n_in, void* d_out, int out_size, void* d_ws, size_t ws_size, hipStream_t stream) {
    constexpr size_t kDynLds = 131072 + 512 + 16384;
    static int grid_blocks = 0;
    if (!grid_blocks) {
        int dev = 0, cus = 0, per_cu = 0;
        (void)hipGetDevice(&dev);
        (void)hipDeviceGetAttribute(&cus, hipDeviceAttributeMultiprocessorCount, dev);
        (void)hipFuncSetAttribute((const void*)fwd_mega, hipFuncAttributeMaxDynamicSharedMemorySize, (int)kDynLds);
        (void)hipOccupancyMaxActiveBlocksPerMultiprocessor(&per_cu, fwd_mega, NTHR, kDynLds);
        if (per_cu > 1) per_cu = 1;
        if (per_cu < 1) per_cu = 1;
        grid_blocks = cus * per_cu;
    }
    Params p{};
    const float* const* in = (const float* const*)d_in;
    p.x_prompt = in[0]; p.x_sample = in[1]; p.cache_ckv = in[2]; p.cache_krope = in[3]; p.state_lru = in[4]; p.c = in[5]; p.c_ctx = in[6];
    p.w_mod[0] = in[7]; p.b_mod[0] = in[8]; p.w_mod[1] = in[9]; p.b_mod[1] = in[10];
    p.g_mix[0] = in[11]; p.g_ffn[0] = in[12]; p.g_mix[1] = in[13]; p.g_ffn[1] = in[14];
    p.w_in = in[15]; p.g_q = in[16]; p.w_uq = in[17]; p.g_kv = in[18]; p.w_ukv = in[19]; p.conv_w = in[20]; p.conv_b = in[21];
    p.w_rg = in[22]; p.b_rg = in[23]; p.w_ig = in[24]; p.b_ig = in[25]; p.lam = in[26]; p.w_o = in[27]; p.w_pool = in[28]; p.s_pool = in[29];
    p.peer_wq[0] = in[30]; p.peer_keys[0] = in[31]; p.peer_u[0] = in[32]; p.peer_v[0] = in[33];
    p.peer_wq[1] = in[34]; p.peer_keys[1] = in[35]; p.peer_u[1] = in[36]; p.peer_v[1] = in[37];
    p.g_final = in[38];
    p.out = (float*)d_out;
    char* base = (char*)d_ws; size_t off = 0;
    auto take = [&](size_t bytes) { char* r = base + off; off += (bytes + 255) & ~(size_t)255; return r; };
    const size_t MiB = 1u << 20;
    p.bar = (unsigned*)take(16384);
    p.mod = (float*)take((size_t)2 * 9 * 6144 * 4); p.modb = (bf16_t*)take((size_t)2 * 9 * 6144 * 2);
    p.ropetab = (float*)take(3072 * 4); p.spl = (float*)take(1024 * 4);
    p.wt_in = (bf16_t*)take((size_t)NW_IN * 2); p.wt_uq = (bf16_t*)take((size_t)NW_UQ * 2); p.wt_ukv = (bf16_t*)take((size_t)NW_UKV * 2);
    p.wt_gate = (bf16_t*)take((size_t)NW_GATE * 2); p.wt_o = (bf16_t*)take((size_t)NW_O * 2); p.wt_pool = (bf16_t*)take((size_t)NW_POOL * 2);
    p.wt_pq[0] = (bf16_t*)take((size_t)NW_PQ * 2); p.wt_pq[1] = (bf16_t*)take((size_t)NW_PQ * 2);
    p.keysb[0] = (bf16_t*)take((size_t)NW_KEYS * 2); p.keysb[1] = (bf16_t*)take((size_t)NW_KEYS * 2);
    for (int l = 0; l < 2; ++l) { p.u8[l] = (u8_t*)take(16 * MiB); p.v8[l] = (u8_t*)take(16 * MiB); p.su[l] = (float*)take(65536); p.sv[l] = (float*)take(65536); }
    char* regX = take(80 * MiB);
    char* regQ = take(80 * MiB);
    char* regH = take(40 * MiB);
    p.P = (bf16_t*)regX; p.a = (float*)regX; p.a1m = (bf16_t*)regX; p.abx = (unsigned*)regX; p.xres = (bf16_t*)regX;
    p.bxb = (bf16_t*)regQ; p.q = (bf16_t*)(regQ + 40 * MiB); p.agg = (float*)(regQ + 70 * MiB); p.qp = (bf16_t*)regQ; p.h3 = (bf16_t*)regQ;
    p.hbuf = (bf16_t*)regH;
    p.cqn = (bf16_t*)take((size_t)T_TOK * 384 * 2); p.ckvk = (bf16_t*)take((size_t)R_KEYS * 256 * 2); p.kropek = (bf16_t*)take((size_t)R_KEYS * 64 * 2);
    p.xc = (bf16_t*)take((size_t)T_TOK * 512 * 2); p.ug = (bf16_t*)take((size_t)T_TOK * 512 * 2);
    p.mix = p.xc;
    p.Kn = (bf16_t*)take((size_t)R_KEYS * 512 * 2); p.vT = (bf16_t*)take((size_t)R_KEYS * 512 * 2);
    p.zbuf = (float*)p.vT; p.wbuf = p.zbuf + (size_t)T_TOK * 128;
    p.hqh = (unsigned*)p.cqn; p.hql = (unsigned*)p.ckvk; p.hsc = (float*)p.kropek;
    p.gates = (float*)p.Kn; p.eidx = (int*)((char*)p.Kn + (size_t)T_TOK * 128 * 4);
    if (off > ws_size) fprintf(stderr, "workspace too small: need %zu have %zu\n", off, ws_size);
    (void)hipMemsetAsync(d_ws, 0, 16384, stream);
    void* args[] = {&p};
    hipError_t e = hipLaunchCooperativeKernel((void*)fwd_mega, dim3(grid_blocks), dim3(NTHR), args, kDynLds, stream);
    if (e != hipSuccess) fprintf(stderr, "cooperative launch failed: %s (grid %d)\n", hipGetErrorString(e), grid_blocks);
}
```
